# Optimizing an MI355X kernel written in HIP

```python
import math
import jax, jax.numpy as jnp
from jax import lax
import numpy as np

D_MODEL = 2048
BATCH = 4
SEQ = 8192
DEPTH = 1

HEAD_DIM = 128
HEADS_A = D_MODEL // 256
KV_HEADS_A = HEADS_A // 4
HEADS_B = D_MODEL // 256
KV_HEADS_B = HEADS_B // 4
Q_WIDTH_A = HEADS_A * HEAD_DIM
KV_WIDTH_A = KV_HEADS_A * HEAD_DIM
Q_WIDTH_B = HEADS_B * HEAD_DIM
KV_WIDTH_B = KV_HEADS_B * HEAD_DIM
IN_WIDTH = Q_WIDTH_A + 2 * KV_WIDTH_A + Q_WIDTH_B + 2 * KV_WIDTH_B + 2 * D_MODEL
BLOCK = 128
WINDOW = 128
GRID_W = 64
ROPE_THETA = 10000.0
NUM_BUCKETS = 32
MAX_DISTANCE = 128
N_EXPERTS = 16
CAPACITY_FACTOR = 2
D_FF_EXPERT = D_MODEL // 2
EPS = 1e-6
NEG = -1e30

kernel_name = "hybrid_gated_gqa_window_ecmoe"


def rmsnorm(x, g):
    xf = x.astype(jnp.float32)
    y = xf * lax.rsqrt(jnp.mean(xf * xf, axis=-1, keepdims=True) + EPS)
    return (y * g.astype(jnp.float32)).astype(x.dtype)


def rotate_half(xh, cos, sin):
    n = xh.shape[-1] // 2
    x1, x2 = xh[..., :n], xh[..., n:]
    return jnp.concatenate([x1 * cos - x2 * sin, x2 * cos + x1 * sin], axis=-1)


def axial_rope(x, seq_len):
    rows = seq_len // GRID_W
    r = jnp.repeat(jnp.arange(rows, dtype=jnp.float32), GRID_W)
    c = jnp.tile(jnp.arange(GRID_W, dtype=jnp.float32), rows)
    half = HEAD_DIM // 2
    inv = 1.0 / (ROPE_THETA ** (jnp.arange(0, half, 2, dtype=jnp.float32) / half))
    ang_r = r[:, None, None] * inv
    ang_c = c[:, None, None] * inv
    xr = rotate_half(x[..., :half], jnp.cos(ang_r), jnp.sin(ang_r))
    xc = rotate_half(x[..., half:], jnp.cos(ang_c), jnp.sin(ang_c))
    return jnp.concatenate([xr, xc], axis=-1)


def t5_bucket(rel):
    half = NUM_BUCKETS // 2
    ret = jnp.where(rel > 0, half, 0)
    n = jnp.abs(rel)
    max_exact = half // 2
    nf = jnp.maximum(n, 1).astype(jnp.float32)
    large = max_exact + (jnp.log(nf / max_exact) / math.log(MAX_DISTANCE / max_exact)
                         * (half - max_exact)).astype(jnp.int32)
    large = jnp.minimum(large, half - 1)
    return ret + jnp.where(n < max_exact, n, large)


def global_axial_gqa(q, k, v, qn, kn):
    bsz, s, _, hd = q.shape
    g = HEADS_A // KV_HEADS_A
    nb = s // BLOCK
    q = axial_rope(rmsnorm(q.astype(jnp.float32), qn), s)
    k = axial_rope(rmsnorm(k.astype(jnp.float32), kn), s)
    v = v.astype(jnp.float32)
    scale = 1.0 / math.sqrt(hd)
    qblocks = q.reshape(bsz, nb, BLOCK, KV_HEADS_A, g, hd).transpose(1, 0, 3, 4, 2, 5)
    kt = k.transpose(0, 2, 1, 3)
    vt = v.transpose(0, 2, 1, 3)

    def one_block(qb):
        sc = jnp.einsum('bkgqd,bksd->bkgqs', qb, kt) * scale
        p = jax.nn.softmax(sc, axis=-1)
        return jnp.einsum('bkgqs,bksd->bkgqd', p, vt)

    o = lax.map(one_block, qblocks)
    return o.transpose(1, 0, 4, 2, 3, 5).reshape(bsz, s, HEADS_A * hd)


def window_sink_gqa(q, k, v, sink, rel_bias):
    bsz, s, _, hd = q.shape
    g = HEADS_B // KV_HEADS_B
    nb = s // BLOCK
    scale = 1.0 / math.sqrt(hd)
    q = q.astype(jnp.float32).reshape(bsz, nb, BLOCK, KV_HEADS_B, g, hd)
    pad = ((0, 0), (WINDOW, WINDOW), (0, 0), (0, 0))
    kp = jnp.pad(k.astype(jnp.float32), pad).reshape(bsz, nb + 2, BLOCK, KV_HEADS_B, hd)
    vp = jnp.pad(v.astype(jnp.float32), pad).reshape(bsz, nb + 2, BLOCK, KV_HEADS_B, hd)
    kband = jnp.concatenate([kp[:, :-2], kp[:, 1:-1], kp[:, 2:]], axis=2)
    vband = jnp.concatenate([vp[:, :-2], vp[:, 1:-1], vp[:, 2:]], axis=2)
    sc = jnp.einsum('bnqkgd,bnjkd->bnkgqj', q, kband) * scale
    rel = (jnp.arange(3 * BLOCK) - BLOCK)[None, :] - jnp.arange(BLOCK)[:, None]
    bias = rel_bias.astype(jnp.float32)[t5_bucket(rel)]
    bias = bias.transpose(2, 0, 1).reshape(KV_HEADS_B, g, BLOCK, 3 * BLOCK)
    kpos = jnp.arange(nb)[:, None] * BLOCK - BLOCK + jnp.arange(3 * BLOCK)[None, :]
    valid = (jnp.abs(rel) <= WINDOW)[None] & ((kpos >= 0) & (kpos < s))[:, None, :]
    valid = valid[None, :, None, None]
    sc = jnp.where(valid, sc + bias, NEG)
    sk = sink.astype(jnp.float32).reshape(KV_HEADS_B, g, 1, 1)
    m = jnp.maximum(jnp.max(sc, axis=-1, keepdims=True), sk)
    e = jnp.exp(sc - m)
    p = e / (jnp.sum(e, axis=-1, keepdims=True) + jnp.exp(sk - m))
    o = jnp.einsum('bnkgqj,bnjkd->bnqkgd', p, vband)
    return o.reshape(bsz, s, HEADS_B * hd)


def expert_choice_moe(h, w_router, w_gate_e, w_up_e, w_down_e):
    bsz, s, d = h.shape
    cap = CAPACITY_FACTOR * s // N_EXPERTS
    logits = jnp.einsum('bsd,de->bse', h, w_router).astype(jnp.float32)
    aff = jax.nn.softmax(logits, axis=-1).transpose(0, 2, 1)
    gates, idx = lax.top_k(aff, cap)
    xin = jax.vmap(lambda hb, ib: hb[ib])(h, idx)
    a = jnp.einsum('becd,edf->becf', xin, w_gate_e)
    u = jnp.einsum('becd,edf->becf', xin, w_up_e)
    y = jnp.einsum('becf,efd->becd', jax.nn.silu(a) * u, w_down_e)
    y = y * gates[..., None].astype(y.dtype)

    def scatter(ib, yb):
        return jnp.zeros((s, d), yb.dtype).at[ib.reshape(-1)].add(yb.reshape(-1, d))

    return jax.vmap(scatter)(idx, y)


def setup_inputs(seed: int = 0) -> dict:
    key = jax.random.key(seed)
    ks = jax.random.split(key, 20)
    f32 = jnp.float32
    nrm = lambda k, shape, sc: jax.random.normal(k, shape, f32) * sc
    return {
        "x": nrm(ks[0], (BATCH, SEQ, D_MODEL), 1.0),
        "g_mix": 1.0 + nrm(ks[1], (DEPTH, D_MODEL), 0.05),
        "w_in": nrm(ks[2], (DEPTH, D_MODEL, IN_WIDTH), D_MODEL ** -0.5),
        "b_gate": nrm(ks[3], (DEPTH, 2 * D_MODEL), 0.1),
        "qn_a": 1.0 + nrm(ks[4], (DEPTH, HEAD_DIM), 0.05),
        "kn_a": 1.0 + nrm(ks[5], (DEPTH, HEAD_DIM), 0.05),
        "w_proj_a": nrm(ks[6], (DEPTH, Q_WIDTH_A, D_MODEL), Q_WIDTH_A ** -0.5),
        "sink_b": nrm(ks[7], (DEPTH, HEADS_B), 0.5),
        "rel_bias": nrm(ks[8], (NUM_BUCKETS, HEADS_B), 0.5),
        "w_proj_b": nrm(ks[9], (DEPTH, Q_WIDTH_B, D_MODEL), Q_WIDTH_B ** -0.5),
        "w_o": nrm(ks[10], (DEPTH, D_MODEL, D_MODEL), D_MODEL ** -0.5),
        "g_ffn": 1.0 + nrm(ks[11], (DEPTH, D_MODEL), 0.05),
        "w_router": nrm(ks[12], (DEPTH, D_MODEL, N_EXPERTS), D_MODEL ** -0.5),
        "w_gate_e": nrm(ks[13], (DEPTH, N_EXPERTS, D_MODEL, D_FF_EXPERT), D_MODEL ** -0.5),
        "w_up_e": nrm(ks[14], (DEPTH, N_EXPERTS, D_MODEL, D_FF_EXPERT), D_MODEL ** -0.5),
        "w_down_e": nrm(ks[15], (DEPTH, N_EXPERTS, D_FF_EXPERT, D_MODEL), D_FF_EXPERT ** -0.5),
        "g_final": 1.0 + nrm(ks[16], (D_MODEL,), 0.05),
    }


def reference(x, g_mix, w_in, b_gate, qn_a, kn_a, w_proj_a, sink_b, rel_bias, w_proj_b,
              w_o, g_ffn, w_router, w_gate_e, w_up_e, w_down_e, g_final):
    bsz, s, d = x.shape
    splits = np.cumsum([Q_WIDTH_A, KV_WIDTH_A, KV_WIDTH_A, Q_WIDTH_B, KV_WIDTH_B, KV_WIDTH_B, D_MODEL]).tolist()
    for l in range(DEPTH):
        h = rmsnorm(x, g_mix[l])
        proj = jnp.einsum('bsd,dn->bsn', h, w_in[l])
        qa, ka, va, qb, kb, vb, ga, gb = jnp.split(proj, splits, axis=-1)
        oa = global_axial_gqa(qa.reshape(bsz, s, HEADS_A, HEAD_DIM),
                              ka.reshape(bsz, s, KV_HEADS_A, HEAD_DIM),
                              va.reshape(bsz, s, KV_HEADS_A, HEAD_DIM), qn_a[l], kn_a[l]).astype(x.dtype)
        ob = window_sink_gqa(qb.reshape(bsz, s, HEADS_B, HEAD_DIM),
                             kb.reshape(bsz, s, KV_HEADS_B, HEAD_DIM),
                             vb.reshape(bsz, s, KV_HEADS_B, HEAD_DIM), sink_b[l], rel_bias).astype(x.dtype)
        gate_a = jax.nn.sigmoid(ga + b_gate[l, :D_MODEL])
        gate_b = jax.nn.sigmoid(gb + b_gate[l, D_MODEL:])
        merged = gate_a * jnp.einsum('bsc,cd->bsd', oa, w_proj_a[l]) \
            + gate_b * jnp.einsum('bsc,cd->bsd', ob, w_proj_b[l])
        x = x + jnp.einsum('bsd,de->bse', merged, w_o[l])
        x = x + expert_choice_moe(rmsnorm(x, g_ffn[l]), w_router[l], w_gate_e[l], w_up_e[l], w_down_e[l])
    return rmsnorm(x, g_final)
```

```cpp
#include <hip/hip_runtime.h>
#include <cstdio>
#include <cstdint>

#ifndef MK_N_LAUNCHES
#define MK_N_LAUNCHES 1
#endif
#ifndef DBG_LEVEL
#define DBG_LEVEL 4
#endif

#ifndef REP_PHASE
#define REP_PHASE -1
#endif
#define REPS(k) ((REP_PHASE == (k)) ? 2 : 1)
#define GAS __attribute__((address_space(1)))
#define LAS __attribute__((address_space(3)))
typedef unsigned short bf16_t;
typedef short bf16x8 __attribute__((ext_vector_type(8)));
typedef short s16x4 __attribute__((ext_vector_type(4)));
typedef float f32x2 __attribute__((ext_vector_type(2)));
typedef float f32x4 __attribute__((ext_vector_type(4)));
typedef float f32x8 __attribute__((ext_vector_type(8)));
typedef float f32x16 __attribute__((ext_vector_type(16)));
typedef unsigned u32x2 __attribute__((ext_vector_type(2)));
typedef unsigned u32x4 __attribute__((ext_vector_type(4)));
typedef GAS unsigned gu32;

constexpr int BATCH = 4, SEQ = 8192, DM = 2048, NTOK = BATCH * SEQ, HD = 128;
constexpr int NHA = 8, NHB = 8;
constexpr int QW = 1024, KVW = 256, INW = 7168;
constexpr int NEXP = 16, CAP = 1024, DFF = 1024, NLIST = BATCH * NEXP, NSLOT = NLIST * CAP;
constexpr float EPS = 1e-6f, LOG2E = 1.4426950408889634f;

constexpr size_t MiB = 1u << 20;
constexpr size_t WS_CTL = 0, CTL_ZERO_BYTES = 1 * MiB;
constexpr size_t WS_ROPE = 1 * MiB;
constexpr size_t WS_AFF = 2 * MiB;
constexpr size_t WS_IDX = 4 * MiB;
constexpr size_t WS_GATEV = 4 * MiB + 256 * 1024;
constexpr size_t WS_INV = 5 * MiB;
constexpr size_t WS_WIN = 8 * MiB;
constexpr size_t WS_WPA = 36 * MiB;
constexpr size_t WS_WPB = 40 * MiB;
constexpr size_t WS_WO = 44 * MiB;
constexpr size_t WS_WGU = 52 * MiB;
constexpr size_t WS_WD = 180 * MiB;
constexpr size_t WS_H = 244 * MiB;
constexpr size_t WS_GA = 372 * MiB;
constexpr size_t WS_GB = 500 * MiB;
constexpr size_t WS_QA = 628 * MiB, WS_KA = 692 * MiB, WS_VA = 708 * MiB, WS_QB = 724 * MiB, WS_KB = 788 * MiB, WS_VB = 804 * MiB;
constexpr size_t WS_Y = 500 * MiB;
constexpr size_t WS_OA = 820 * MiB, WS_OB = 884 * MiB;
constexpr size_t WS_ATT = 820 * MiB;
constexpr size_t WS_END = 948 * MiB;
constexpr int CW_TMO = 0;
constexpr int CW_BAR = 4096;

constexpr int LDS_SCRATCH = 155648;
constexpr int LDSCTL_OFF = LDS_SCRATCH;
constexpr int LDS_BYTES = LDS_SCRATCH + 512;

__device__ __forceinline__ unsigned cvt_pk_bf16(float lo, float hi) { unsigned r; asm volatile("v_cvt_pk_bf16_f32 %0, %1, %2" : "=v"(r) : "v"(lo), "v"(hi)); return r; }
__device__ __forceinline__ float bf2f(unsigned short v) { return __uint_as_float(((unsigned)v) << 16); }
__device__ __forceinline__ unsigned short f2bf(float f) { return (unsigned short)(cvt_pk_bf16(f, 0.f) & 0xffffu); }
__device__ __forceinline__ float wave_sum(float v) {
#pragma unroll
    for (int o = 1; o < 64; o <<= 1) v += __shfl_xor(v, o);
    return v;
}
__device__ __forceinline__ float sigmoidf_fast(float z) { return __builtin_amdgcn_rcpf(1.f + __builtin_amdgcn_exp2f(-z * LOG2E)); }
#define LDS_WAIT() asm volatile("s_waitcnt lgkmcnt(0)" ::: "memory")
#define VM_WAIT() asm volatile("s_waitcnt vmcnt(0)" ::: "memory")

namespace pg8 {
constexpr int BM = 256, BK = 64, HALF = 128, HTB = HALF * BK * 2, STAGE_BYTES = 8 * HTB;
__host__ __device__ __forceinline__ int lds_byte(int r, int c) { const int st = (r >> 4) * 2 + (c >> 5), rr = r & 15, cc = c & 31, ob = rr * 64 + cc * 2; return st * 1024 + (ob ^ (((ob >> 9) & 1) << 5)); }
__host__ __device__ __forceinline__ void stage_rc(int b, int& R, int& C) { const int st = b / 1024, sb = b % 1024, swz = sb ^ (((sb >> 9) & 1) << 5); R = (st >> 1) * 16 + swz / 64; C = (st & 1) * 32 + (swz % 64) / 2; }
__host__ __device__ __forceinline__ int perm32(int rho) { const int n = rho >> 4, i = rho & 15; return 8 * (i >> 2) + 4 * n + (i & 3); }

struct Unit { int pm, pn, ord; };

struct StaticOrder {
    int nM, nN, nwg, G, c;
    __device__ void init(int M, int N, int G_, int c_) { nM = M / BM; nN = N / BM; nwg = nM * nN; G = G_; c = c_; }
    __device__ bool next(int i, Unit& u) const {
        const long L = (long)i * G + c; if (L >= nwg) return false;
        int wgid = (int)L; { const int q = nwg / 8, r = nwg % 8, xcd = wgid % 8, off = wgid / 8; wgid = (xcd < r ? xcd * (q + 1) : r * (q + 1) + (xcd - r) * q) + off; }
        const int nig = 8 * nN, gid = wgid / nig, fm = gid * 8, gsz = (nM - fm) < 8 ? (nM - fm) : 8;
        u.pm = fm + ((wgid % nig) % gsz); u.pn = (wgid % nig) / gsz; u.ord = i; return true;
    }
};

template <class Epi, class Prob, bool ALIGN_EPI>
__device__ __forceinline__ void gemm_phase(LAS unsigned char* lds, const Prob& P, const Epi& E) {
    const int tid = threadIdx.x, wid = __builtin_amdgcn_readfirstlane(tid >> 6), lane = tid & 63, wr = wid >> 2, wc = wid & 3, fr = lane & 15, fq = lane >> 4;
    constexpr int K = Prob::K, nt = K / BK;
    int Rs[2], Cs[2]; unsigned voffB[2];
#pragma unroll
    for (int i = 0; i < 2; ++i) { int R, C; stage_rc(tid * 16 + i * 8192, R, C); const int Rb = Epi::PERM ? ((R & ~31) + perm32(R & 31)) : R;
        Rs[i] = R; Cs[i] = C; voffB[i] = (unsigned)(Rb * K + C) * 2u; }
    constexpr size_t kstep = (size_t)(BK * 2);
    constexpr size_t hstepB = (size_t)HALF * K * 2;
    const unsigned ldsw = (unsigned)wid * 1024u;
    const int aoff = lds_byte(wr * 64 + fr, fq * 8), boff = lds_byte(wc * 32 + fr, fq * 8);
#define PG8_SA(b, h) (((b) * 2 + (h)) * HTB)
#define PG8_SB(b, h) ((4 + (b) * 2 + (h)) * HTB)
#define PG8_STAGE(bufoff, gbase, voff) do { _Pragma("unroll") for (int _i = 0; _i < 2; ++_i) \
        __builtin_amdgcn_global_load_lds((const unsigned*)((const char*)(gbase) + (voff)[_i]), (LAS unsigned*)(lds + (bufoff) + ldsw + _i * 8192), 16, 0, 0); } while (0)
#define PG8_LDA(dst, b, h) do { _Pragma("unroll") for (int m = 0; m < 4; ++m) _Pragma("unroll") for (int k = 0; k < 2; ++k) dst[m][k] = *(const LAS bf16x8*)(lds + PG8_SA(b, h) + aoff + m * 2048 + k * 1024); } while (0)
#define PG8_LDB(dst, b, h) do { _Pragma("unroll") for (int n = 0; n < 2; ++n) _Pragma("unroll") for (int k = 0; k < 2; ++k) dst[n][k] = *(const LAS bf16x8*)(lds + PG8_SB(b, h) + boff + n * 2048 + k * 1024); } while (0)
#define PG8_MMA(ai, bj, At, Bt) do { __builtin_amdgcn_s_setprio(1); _Pragma("unroll") for (int m = 0; m < 4; ++m) _Pragma("unroll") for (int n = 0; n < 2; ++n) _Pragma("unroll") for (int k = 0; k < 2; ++k) \
        acc[ai][bj][m][n] = __builtin_amdgcn_mfma_f32_16x16x32_bf16(Bt[n][k], At[m][k], acc[ai][bj][m][n], 0, 0, 0); __builtin_amdgcn_s_setprio(0); } while (0)
#define PG8_WAIT_V(n) asm volatile("s_waitcnt vmcnt(" #n ")" ::: "memory")
#define PG8_WAIT_L(n) asm volatile("s_waitcnt lgkmcnt(" #n ")" ::: "memory")
#define PG8_BAR __builtin_amdgcn_s_barrier()
#define PG8_SCHED __builtin_amdgcn_sched_barrier(0)
    Unit cur, nxt; int ui = 0;
    if (!P.next(0, cur)) return;
    unsigned vAc[2][2], vAn[2][2];
    P.a_voff(cur, Rs, Cs, vAc);
    f32x4 acc[2][2][4][2];
#pragma unroll
    for (int a = 0; a < 2; ++a)
#pragma unroll
        for (int b = 0; b < 2; ++b)
#pragma unroll
            for (int m = 0; m < 4; ++m)
#pragma unroll
                for (int n = 0; n < 2; ++n) acc[a][b][m][n] = (f32x4){0.f, 0.f, 0.f, 0.f};
    bf16x8 At[4][2], B0[2][2], B1[2][2];
    const char* cA = P.a_base(cur); const char* cB = P.b_base(cur);
    PG8_STAGE(PG8_SB(0, 0), cB, voffB); PG8_STAGE(PG8_SB(0, 1), cB + hstepB, voffB); PG8_STAGE(PG8_SA(0, 0), cA, vAc[0]); PG8_STAGE(PG8_SA(0, 1), cA, vAc[1]);
    if (wr == 1) PG8_BAR;
    PG8_WAIT_V(2); PG8_BAR;
    PG8_STAGE(PG8_SB(1, 0), cB + kstep, voffB); PG8_STAGE(PG8_SA(1, 0), cA + kstep, vAc[0]); PG8_STAGE(PG8_SB(1, 1), cB + hstepB + kstep, voffB);
    PG8_WAIT_V(6); PG8_BAR;
    for (;;) {
        const bool has_next = P.next(ui + 1, nxt);
        const char* nA = has_next ? P.a_base(nxt) : cA; const char* nB = has_next ? P.b_base(nxt) : cB;
        if (has_next) P.a_voff(nxt, Rs, Cs, vAn);
        else { vAn[0][0] = vAc[0][0]; vAn[0][1] = vAc[0][1]; vAn[1][0] = vAc[1][0]; vAn[1][1] = vAc[1][1]; }
        for (int t = 0; t < nt; t += 2) {
            const bool last = (t == nt - 2);
            const char* a1 = cA + (size_t)(t + 1) * kstep;
            const char* a2 = last ? nA : cA + (size_t)(t + 2) * kstep; const char* b2 = last ? nB : cB + (size_t)(t + 2) * kstep;
            const char* a3 = a2 + kstep; const char* b3 = b2 + kstep;
            unsigned va2[2][2];
            va2[0][0] = last ? vAn[0][0] : vAc[0][0]; va2[0][1] = last ? vAn[0][1] : vAc[0][1]; va2[1][0] = last ? vAn[1][0] : vAc[1][0]; va2[1][1] = last ? vAn[1][1] : vAc[1][1];
            PG8_LDB(B0, 0, 0); PG8_LDB(B1, 0, 1); PG8_SCHED; PG8_LDA(At, 0, 0); PG8_STAGE(PG8_SA(1, 1), a1, vAc[1]);
            PG8_WAIT_V(8); PG8_WAIT_L(0); PG8_BAR; PG8_MMA(0, 0, At, B0); PG8_MMA(0, 1, At, B1); PG8_BAR; PG8_SCHED;
            PG8_LDA(At, 0, 1); PG8_STAGE(PG8_SB(0, 0), b2, voffB); PG8_STAGE(PG8_SB(0, 1), b2 + hstepB, voffB); PG8_STAGE(PG8_SA(0, 0), a2, va2[0]);
            PG8_WAIT_V(8); PG8_WAIT_L(0); PG8_BAR; PG8_MMA(1, 0, At, B0); PG8_MMA(1, 1, At, B1); PG8_BAR; PG8_SCHED;
            PG8_LDB(B0, 1, 0); PG8_LDB(B1, 1, 1); PG8_SCHED; PG8_LDA(At, 1, 0); PG8_STAGE(PG8_SA(0, 1), a2, va2[1]);
            PG8_WAIT_V(8); PG8_WAIT_L(0); PG8_BAR; PG8_MMA(0, 0, At, B0); PG8_MMA(0, 1, At, B1); PG8_BAR; PG8_SCHED;
            PG8_LDA(At, 1, 1); PG8_STAGE(PG8_SB(1, 0), b3, voffB); PG8_STAGE(PG8_SB(1, 1), b3 + hstepB, voffB); PG8_STAGE(PG8_SA(1, 0), a3, va2[0]);
            PG8_WAIT_V(8); PG8_WAIT_L(0); PG8_BAR; PG8_MMA(1, 0, At, B0); PG8_MMA(1, 1, At, B1); PG8_BAR; PG8_SCHED;
        }
        if constexpr (ALIGN_EPI) { if (wr == 0) PG8_BAR; }
        E(acc, cur, wr, wc, fr, fq);
        if (!has_next) break;
#pragma unroll
        for (int a = 0; a < 2; ++a)
#pragma unroll
            for (int b = 0; b < 2; ++b)
#pragma unroll
                for (int m = 0; m < 4; ++m)
#pragma unroll
                    for (int n = 0; n < 2; ++n) acc[a][b][m][n] = (f32x4){0.f, 0.f, 0.f, 0.f};
        cur = nxt; cA = nA; cB = nB; ++ui;
        vAc[0][0] = vAn[0][0]; vAc[0][1] = vAn[0][1]; vAc[1][0] = vAn[1][0]; vAc[1][1] = vAn[1][1];
        if constexpr (ALIGN_EPI) { if (wr == 1) PG8_BAR; }
    }
    PG8_WAIT_V(0);
    if constexpr (!ALIGN_EPI) { if (wr == 0) PG8_BAR; }
    PG8_BAR;
#undef PG8_SA
#undef PG8_SB
#undef PG8_STAGE
#undef PG8_LDA
#undef PG8_LDB
#undef PG8_MMA
#undef PG8_WAIT_V
#undef PG8_WAIT_L
#undef PG8_BAR
#undef PG8_SCHED
}

template <int K_> struct DenseProb {
    static constexpr int K = K_;
    const bf16_t* A; const bf16_t* Bt; StaticOrder S;
    __device__ __forceinline__ bool next(int i, Unit& u) const { return S.next(i, u); }
    __device__ __forceinline__ const char* a_base(const Unit& u) const { return (const char*)(A + (size_t)u.pm * BM * K); }
    __device__ __forceinline__ const char* b_base(const Unit& u) const { return (const char*)(Bt + (size_t)u.pn * BM * K); }
    __device__ __forceinline__ void a_voff(const Unit&, const int (&Rs)[2], const int (&Cs)[2], unsigned (&vo)[2][2]) const {
#pragma unroll
        for (int h = 0; h < 2; ++h)
#pragma unroll
            for (int i = 0; i < 2; ++i) vo[h][i] = (unsigned)((h * HALF + Rs[i]) * K + Cs[i]) * 2u;
    }
};
__device__ __forceinline__ bool moe_unit(int i, int G, int vcu, Unit& u, int& e, int& b) {
    const int L = i * G + vcu; if (L >= 2048) return false;
    const int x = (L & 255) >> 5, w = L & 31, r = L >> 8;
    e = 2 * x + (r >> 2); b = r & 3; u.pm = (b * NEXP + e) * 4 + (w >> 3); u.pn = w & 7; u.ord = i; return true;
}
struct GuProb {
    static constexpr int K = DM;
    const bf16_t* H2; const bf16_t* W; const LAS unsigned* rowoff; int G, vcu;
    __device__ __forceinline__ bool next(int i, Unit& u) const { int e, b; return moe_unit(i, G, vcu, u, e, b); }
    __device__ __forceinline__ const char* a_base(const Unit& u) const { const int b = (u.pm >> 2) / NEXP; return (const char*)(H2 + (size_t)b * SEQ * DM); }
    __device__ __forceinline__ const char* b_base(const Unit& u) const { const int e = (u.pm >> 2) % NEXP; return (const char*)(W + ((size_t)e * 2048 + (size_t)u.pn * BM) * DM); }
    __device__ __forceinline__ void a_voff(const Unit& u, const int (&Rs)[2], const int (&Cs)[2], unsigned (&vo)[2][2]) const {
#pragma unroll
        for (int h = 0; h < 2; ++h)
#pragma unroll
            for (int i = 0; i < 2; ++i) vo[h][i] = rowoff[u.ord * 256 + h * HALF + Rs[i]] + (unsigned)Cs[i] * 2u;
    }
};
struct DownProb {
    static constexpr int K = DFF;
    const bf16_t* HID; const bf16_t* W; int G, vcu;
    __device__ __forceinline__ bool next(int i, Unit& u) const { int e, b; return moe_unit(i, G, vcu, u, e, b); }
    __device__ __forceinline__ const char* a_base(const Unit& u) const { return (const char*)(HID + (size_t)u.pm * BM * DFF); }
    __device__ __forceinline__ const char* b_base(const Unit& u) const { const int e = (u.pm >> 2) % NEXP; return (const char*)(W + ((size_t)e * 2048 + (size_t)u.pn * BM) * DFF); }
    __device__ __forceinline__ void a_voff(const Unit&, const int (&Rs)[2], const int (&Cs)[2], unsigned (&vo)[2][2]) const {
#pragma unroll
        for (int h = 0; h < 2; ++h)
#pragma unroll
            for (int i = 0; i < 2; ++i) vo[h][i] = (unsigned)((h * HALF + Rs[i]) * DFF + Cs[i]) * 2u;
    }
};

typedef const f32x4 (&AccRef)[2][2][4][2];
struct EpiInProj {
    static constexpr bool PERM = true;
    bf16_t *QA, *KA, *VA, *QB, *KB, *VB, *GA, *GB; const float* bgate;
    __device__ __forceinline__ void operator()(AccRef acc, const Unit& u, int wr, int wc, int fr, int fq) const {
        const int pn = u.pn; bf16_t* base; int ldc, colt; bool gate = false;
        if (pn < 4) { base = QA; ldc = QW; colt = pn * 256; }
        else if (pn == 4) { base = KA; ldc = KVW; colt = 0; }
        else if (pn == 5) { base = VA; ldc = KVW; colt = 0; }
        else if (pn < 10) { base = QB; ldc = QW; colt = (pn - 6) * 256; }
        else if (pn == 10) { base = KB; ldc = KVW; colt = 0; }
        else if (pn == 11) { base = VB; ldc = KVW; colt = 0; }
        else if (pn < 20) { base = GA; ldc = DM; colt = (pn - 12) * 256; gate = true; }
        else { base = GB; ldc = DM; colt = (pn - 20) * 256; gate = true; }
        const int row0 = u.pm * BM + wr * 64 + fr, col0 = colt + wc * 32 + 8 * fq;
        f32x4 bv[2][2];
#pragma unroll
        for (int bj = 0; bj < 2; ++bj)
#pragma unroll
            for (int n = 0; n < 2; ++n) bv[bj][n] = gate ? *(const f32x4*)(bgate + (pn - 12) * 256 + wc * 32 + 8 * fq + bj * HALF + 4 * n) : (f32x4){0.f, 0.f, 0.f, 0.f};
#pragma unroll
        for (int ai = 0; ai < 2; ++ai)
#pragma unroll
            for (int m = 0; m < 4; ++m) { bf16_t* rowp = base + (size_t)(row0 + ai * HALF + m * 16) * ldc + col0;
#pragma unroll
                for (int bj = 0; bj < 2; ++bj) { f32x4 v0 = acc[ai][bj][m][0] + bv[bj][0], v1 = acc[ai][bj][m][1] + bv[bj][1];
                    if (gate) {
#pragma unroll
                        for (int j = 0; j < 4; ++j) { v0[j] = sigmoidf_fast(v0[j]); v1[j] = sigmoidf_fast(v1[j]); } }
                    u32x4 w; w.x = cvt_pk_bf16(v0[0], v0[1]); w.y = cvt_pk_bf16(v0[2], v0[3]); w.z = cvt_pk_bf16(v1[0], v1[1]); w.w = cvt_pk_bf16(v1[2], v1[3]);
                    *(u32x4*)(rowp + bj * HALF) = w; } }
    }
};
template <int MODE> struct EpiGated {
    static constexpr bool PERM = true;
    bf16_t* G1; const bf16_t* G2;
    __device__ __forceinline__ void operator()(AccRef acc, const Unit& u, int wr, int wc, int fr, int fq) const {
        const int row0 = u.pm * BM + wr * 64 + fr, col0 = u.pn * BM + wc * 32 + 8 * fq;
#pragma unroll
        for (int ai = 0; ai < 2; ++ai)
#pragma unroll
            for (int m = 0; m < 4; ++m) { const size_t off = (size_t)(row0 + ai * HALF + m * 16) * DM + col0;
#pragma unroll
                for (int bj = 0; bj < 2; ++bj) {
                    const bf16x8 g1 = (MODE == 2) ? (bf16x8){0, 0, 0, 0, 0, 0, 0, 0} : *(const bf16x8*)(G1 + off + bj * HALF);
                    bf16x8 g2 = g1; if (MODE >= 1) g2 = *(const bf16x8*)(G2 + off + bj * HALF);
                    float o[8];
#pragma unroll
                    for (int j = 0; j < 8; ++j) { const float a = acc[ai][bj][m][j >> 2][j & 3];
                        if (MODE == 0) o[j] = bf2f((unsigned short)g1[j]) * a;
                        else if (MODE == 1) o[j] = bf2f((unsigned short)g1[j]) + bf2f((unsigned short)g2[j]) * a;
                        else o[j] = bf2f((unsigned short)g2[j]) * a; }
                    u32x4 w; w.x = cvt_pk_bf16(o[0], o[1]); w.y = cvt_pk_bf16(o[2], o[3]); w.z = cvt_pk_bf16(o[4], o[5]); w.w = cvt_pk_bf16(o[6], o[7]);
                    *(u32x4*)(G1 + off + bj * HALF) = w; } }
    }
};
struct EpiAtt {
    static constexpr bool PERM = true;
    bf16_t* O;
    __device__ __forceinline__ void operator()(AccRef acc, const Unit& u, int wr, int wc, int fr, int fq) const {
        const int row0 = u.pm * BM + wr * 64 + fr, col0 = u.pn * BM + wc * 32 + 8 * fq;
#pragma unroll
        for (int ai = 0; ai < 2; ++ai)
#pragma unroll
            for (int m = 0; m < 4; ++m) { bf16_t* rowp = O + (size_t)(row0 + ai * HALF + m * 16) * DM + col0;
#pragma unroll
                for (int bj = 0; bj < 2; ++bj) { const f32x4 v0 = acc[ai][bj][m][0], v1 = acc[ai][bj][m][1];
                    u32x4 w; w.x = cvt_pk_bf16(v0[0], v0[1]); w.y = cvt_pk_bf16(v0[2], v0[3]); w.z = cvt_pk_bf16(v1[0], v1[1]); w.w = cvt_pk_bf16(v1[2], v1[3]);
                    *(u32x4*)(rowp + bj * HALF) = w; } }
    }
};
struct EpiSwiglu {
    static constexpr bool PERM = true;
    bf16_t* HID;
    __device__ __forceinline__ void operator()(AccRef acc, const Unit& u, int wr, int wc, int fr, int fq) const {
        const int row0 = u.pm * BM + wr * 64 + fr, col0 = u.pn * HALF + wc * 32 + 8 * fq;
#pragma unroll
        for (int ai = 0; ai < 2; ++ai)
#pragma unroll
            for (int m = 0; m < 4; ++m) { float o[8];
#pragma unroll
                for (int j = 0; j < 8; ++j) { const float a = acc[ai][0][m][j >> 2][j & 3], up = acc[ai][1][m][j >> 2][j & 3]; o[j] = a * sigmoidf_fast(a) * up; }
                u32x4 w; w.x = cvt_pk_bf16(o[0], o[1]); w.y = cvt_pk_bf16(o[2], o[3]); w.z = cvt_pk_bf16(o[4], o[5]); w.w = cvt_pk_bf16(o[6], o[7]);
                *(u32x4*)(HID + (size_t)(row0 + ai * HALF + m * 16) * DFF + col0) = w; }
    }
};
struct EpiDown {
    static constexpr bool PERM = true;
    bf16_t* Y; const float* gatev;
    __device__ __forceinline__ void operator()(AccRef acc, const Unit& u, int wr, int wc, int fr, int fq) const {
        const int row0 = u.pm * BM + wr * 64 + fr, col0 = u.pn * BM + wc * 32 + 8 * fq;
#pragma unroll
        for (int ai = 0; ai < 2; ++ai)
#pragma unroll
            for (int m = 0; m < 4; ++m) { const int row = row0 + ai * HALF + m * 16; const float g = gatev[row];
#pragma unroll
                for (int bj = 0; bj < 2; ++bj) { const f32x4 v0 = acc[ai][bj][m][0] * g, v1 = acc[ai][bj][m][1] * g;
                    u32x4 w; w.x = cvt_pk_bf16(v0[0], v0[1]); w.y = cvt_pk_bf16(v0[2], v0[3]); w.z = cvt_pk_bf16(v1[0], v1[1]); w.w = cvt_pk_bf16(v1[2], v1[3]);
                    *(u32x4*)(Y + (size_t)row * DM + col0 + bj * HALF) = w; } }
    }
};
}

namespace att {
constexpr int D = 128, NW = 8, QBLK = 32, KVBLK = 64;
constexpr float SCALE = 0.088388347648318440f, C = SCALE * LOG2E;
constexpr float THR = 8.f;
constexpr int LDQ = QW, LDK = KVW;
constexpr int SHM_V = KVBLK * D * 2, SHM_K = KVBLK * D * 2;
constexpr int BUFB = SHM_V + SHM_K, NBUF = 3;
constexpr int OFF_WS = NBUF * BUFB, OFF_TAB = OFF_WS + NW * 64 * 4, LDS_END = OFF_TAB + 4 * 768 * 4, OFF_OST = 0;
static_assert(LDS_END <= LDS_SCRATCH, "attention LDS");
#define KSWZ(row, colB) ((row) * 256 + ((colB) ^ (((row) & 7) << 4)))
#define SBAR() __builtin_amdgcn_sched_barrier(0)
__device__ __forceinline__ int crow(int r, int hi) { return (r & 3) + 8 * (r >> 2) + 4 * hi; }
__device__ __forceinline__ unsigned cvtpk(float lo, float hi) { unsigned r; asm volatile("v_cvt_pk_bf16_f32 %0, %1, %2" : "=v"(r) : "v"(lo), "v"(hi)); return r; }

__device__ __forceinline__ void partialSM(f32x16& p0, f32x16& p1, float& m_reg, float& mn, float& alpha) {
  float pmax = p0[0];
#pragma unroll
  for (int r = 1; r < 16; ++r) pmax = fmaxf(pmax, p0[r]);
#pragma unroll
  for (int r = 0; r < 16; ++r) pmax = fmaxf(pmax, p1[r]);
  { auto rr = __builtin_amdgcn_permlane32_swap(__float_as_uint(pmax), __float_as_uint(pmax), false, false);
    pmax = fmaxf(__uint_as_float(rr[0]), __uint_as_float(rr[1])); }
  if (__builtin_expect(__all(pmax - m_reg <= THR / SCALE), 1)) { mn = m_reg; alpha = 1.f; }
  else { mn = fmaxf(m_reg, pmax); alpha = __builtin_amdgcn_exp2f((m_reg - mn) * C); m_reg = mn; }
  float mnC = -mn * C;
#pragma unroll
  for (int r = 0; r < 16; ++r) p0[r] = fmaf(p0[r], C, mnC);
#pragma unroll
  for (int r = 0; r < 16; ++r) p1[r] = fmaf(p1[r], C, mnC);
#pragma unroll
  for (int r = 0; r < 16; ++r) p0[r] = __builtin_amdgcn_exp2f(p0[r]);
}
__device__ __forceinline__ void partialSM_B(f32x16& p0, f32x16& p1, float& m_reg, float& mn, float& alpha, const float* tb) {
#pragma unroll
  for (int r = 0; r < 16; ++r) { const int o = (r & 3) + 8 * (r >> 2); p0[r] = fmaf(p0[r], C, tb[o]); p1[r] = fmaf(p1[r], C, tb[32 + o]); }
  float pmax = p0[0];
#pragma unroll
  for (int r = 1; r < 16; ++r) pmax = fmaxf(pmax, p0[r]);
#pragma unroll
  for (int r = 0; r < 16; ++r) pmax = fmaxf(pmax, p1[r]);
  { auto rr = __builtin_amdgcn_permlane32_swap(__float_as_uint(pmax), __float_as_uint(pmax), false, false);
    pmax = fmaxf(__uint_as_float(rr[0]), __uint_as_float(rr[1])); }
  if (__builtin_expect(__all(pmax - m_reg <= THR * LOG2E), 1)) { mn = m_reg; alpha = 1.f; }
  else { mn = fmaxf(m_reg, pmax); alpha = __builtin_amdgcn_exp2f(m_reg - mn); m_reg = mn; }
#pragma unroll
  for (int r = 0; r < 16; ++r) p0[r] = p0[r] - mn;
#pragma unroll
  for (int r = 0; r < 16; ++r) p1[r] = p1[r] - mn;
#pragma unroll
  for (int r = 0; r < 16; ++r) p0[r] = __builtin_amdgcn_exp2f(p0[r]);
}
__device__ __forceinline__ void finishSM(f32x16& p0, f32x16& p1, float alpha, float& l_reg, bf16x8& pa0, bf16x8& pa1, bf16x8& pa2, bf16x8& pa3) {
#pragma unroll
  for (int r = 0; r < 16; ++r) p1[r] = __builtin_amdgcn_exp2f(p1[r]);
  float ps = 0;
#pragma unroll
  for (int r = 0; r < 16; ++r) ps += p0[r];
#pragma unroll
  for (int r = 0; r < 16; ++r) ps += p1[r];
  { auto rr = __builtin_amdgcn_permlane32_swap(__float_as_uint(ps), __float_as_uint(ps), false, false);
    ps = __uint_as_float(rr[0]) + __uint_as_float(rr[1]); }
  l_reg = l_reg * alpha + ps;
#define PK4(P, BASE, OUT) do { unsigned a0 = cvtpk(P[BASE + 0], P[BASE + 1]), a1 = cvtpk(P[BASE + 2], P[BASE + 3]);   \
    unsigned b0 = cvtpk(P[BASE + 4], P[BASE + 5]), b1 = cvtpk(P[BASE + 6], P[BASE + 7]);                              \
    auto r0 = __builtin_amdgcn_permlane32_swap(a0, b0, false, false); auto r1 = __builtin_amdgcn_permlane32_swap(a1, b1, false, false); \
    u32x4 w = {r0[0], r1[0], r0[1], r1[1]}; OUT = *reinterpret_cast<bf16x8*>(&w); } while (0)
  PK4(p0, 0, pa0); PK4(p0, 8, pa1); PK4(p1, 0, pa2); PK4(p1, 8, pa3);
#undef PK4
}
__device__ __forceinline__ void qkt(f32x16& p0, f32x16& p1, const bf16_t* Ks, const bf16x8* qr, int r32, int hi, float init = 0.f) {
#pragma unroll
  for (int r = 0; r < 16; ++r) { p0[r] = init; p1[r] = init; }
#pragma unroll
  for (int d0 = 0; d0 < 8; ++d0) { int cb = (d0 * 16 + hi * 8) * 2;
    bf16x8 b0 = *reinterpret_cast<const bf16x8*>((const char*)Ks + KSWZ(r32, cb));
    bf16x8 b1 = *reinterpret_cast<const bf16x8*>((const char*)Ks + KSWZ(32 + r32, cb));
    p0 = __builtin_amdgcn_mfma_f32_32x32x16_bf16(b0, qr[d0], p0, 0, 0, 0);
    p1 = __builtin_amdgcn_mfma_f32_32x32x16_bf16(b1, qr[d0], p1, 0, 0, 0); }
}
__device__ __forceinline__ int v_st(int k, int c) { const int kk = (k & ~0xC) | ((k & 4) << 1) | ((k & 8) >> 1); return ((kk >> 3) * 4 + (c >> 5)) * 512 + ((kk & 7) * 32 + (c & 31)) * 2; }
__device__ __forceinline__ int v_rd_base(int lane) { return ((lane & 3) << 3) | (((lane >> 2) & 3) << 6) | (((lane >> 4) & 1) << 5) | (((lane >> 5) & 1) << 8); }
constexpr int v_rd_off(int d0, int ks, int half) { return d0 * 512 + ks * 4096 + half * 2048; }
template <int OFF> __device__ __forceinline__ s16x4 tr_read(int vb) {
  s16x4 r; asm volatile("ds_read_b64_tr_b16 %0, %1 offset:%2" : "=&v"(r) : "v"(vb), "i"(OFF) : "memory"); return r;
}
template <int D0> __device__ __forceinline__ void pv_one(f32x16& od, int vb, bf16x8 pa0, bf16x8 pa1, bf16x8 pa2, bf16x8 pa3) {
  const s16x4 l0 = tr_read<v_rd_off(D0, 0, 0)>(vb), h0 = tr_read<v_rd_off(D0, 0, 1)>(vb), l1 = tr_read<v_rd_off(D0, 1, 0)>(vb), h1 = tr_read<v_rd_off(D0, 1, 1)>(vb);
  const s16x4 l2 = tr_read<v_rd_off(D0, 2, 0)>(vb), h2 = tr_read<v_rd_off(D0, 2, 1)>(vb), l3 = tr_read<v_rd_off(D0, 3, 0)>(vb), h3 = tr_read<v_rd_off(D0, 3, 1)>(vb);
  asm volatile("s_waitcnt lgkmcnt(0)" ::: "memory"); SBAR();
#define PK(L, H) (bf16x8){L[0], L[1], L[2], L[3], H[0], H[1], H[2], H[3]}
  od = __builtin_amdgcn_mfma_f32_32x32x16_bf16(pa0, PK(l0, h0), od, 0, 0, 0);
  od = __builtin_amdgcn_mfma_f32_32x32x16_bf16(pa1, PK(l1, h1), od, 0, 0, 0);
  od = __builtin_amdgcn_mfma_f32_32x32x16_bf16(pa2, PK(l2, h2), od, 0, 0, 0);
  od = __builtin_amdgcn_mfma_f32_32x32x16_bf16(pa3, PK(l3, h3), od, 0, 0, 0);
#undef PK
}
__device__ __forceinline__ void pv_d0(f32x16* o, int vb, bf16x8 pa0, bf16x8 pa1, bf16x8 pa2, bf16x8 pa3) {
  pv_one<0>(o[0], vb, pa0, pa1, pa2, pa3); pv_one<1>(o[1], vb, pa0, pa1, pa2, pa3); pv_one<2>(o[2], vb, pa0, pa1, pa2, pa3); pv_one<3>(o[3], vb, pa0, pa1, pa2, pa3);
}
template <int MODE>
__device__ __forceinline__ void pv_psm(f32x16* o, int vb, bf16x8 pa0, bf16x8 pa1, bf16x8 pa2, bf16x8 pa3, f32x16& p0, f32x16& p1, float& m_reg, float& mn, float& alpha, const float* tb) {
  pv_one<0>(o[0], vb, pa0, pa1, pa2, pa3);
  if constexpr (MODE == 1) {
#pragma unroll
    for (int r = 0; r < 16; ++r) { const int of = (r & 3) + 8 * (r >> 2); p0[r] = fmaf(p0[r], C, tb[of]); p1[r] = fmaf(p1[r], C, tb[32 + of]); }
  }
  float pmax = p0[0];
#pragma unroll
  for (int r = 1; r < 16; ++r) pmax = fmaxf(pmax, p0[r]);
#pragma unroll
  for (int r = 0; r < 16; ++r) pmax = fmaxf(pmax, p1[r]);
  { auto rr = __builtin_amdgcn_permlane32_swap(__float_as_uint(pmax), __float_as_uint(pmax), false, false);
    pmax = fmaxf(__uint_as_float(rr[0]), __uint_as_float(rr[1])); }
  SBAR();
  pv_one<1>(o[1], vb, pa0, pa1, pa2, pa3);
  float sub;
  if constexpr (MODE == 0) {
    if (__builtin_expect(__all(pmax - m_reg <= THR / SCALE), 1)) { mn = m_reg; alpha = 1.f; }
    else { mn = fmaxf(m_reg, pmax); alpha = __builtin_amdgcn_exp2f((m_reg - mn) * C); m_reg = mn; }
    sub = -mn * C;
#pragma unroll
    for (int r = 0; r < 16; ++r) p0[r] = fmaf(p0[r], C, sub);
  } else {
    if (__builtin_expect(__all(pmax - m_reg <= THR * LOG2E), 1)) { mn = m_reg; alpha = 1.f; }
    else { mn = fmaxf(m_reg, pmax); alpha = __builtin_amdgcn_exp2f(m_reg - mn); m_reg = mn; }
    sub = -mn;
#pragma unroll
    for (int r = 0; r < 16; ++r) p0[r] = p0[r] + sub;
  }
  SBAR();
  pv_one<2>(o[2], vb, pa0, pa1, pa2, pa3);
#pragma unroll
  for (int r = 0; r < 16; ++r) { if constexpr (MODE == 0) p1[r] = fmaf(p1[r], C, sub); else p1[r] = p1[r] + sub; }
#pragma unroll
  for (int r = 0; r < 6; ++r) p0[r] = __builtin_amdgcn_exp2f(p0[r]);
  SBAR();
  pv_one<3>(o[3], vb, pa0, pa1, pa2, pa3);
#pragma unroll
  for (int r = 6; r < 16; ++r) p0[r] = __builtin_amdgcn_exp2f(p0[r]);
}
__device__ __forceinline__ f32x8 bf8_to_f32(bf16x8 v) { f32x8 r;
#pragma unroll
  for (int j = 0; j < 8; ++j) r[j] = bf2f((unsigned short)v[j]);
  return r; }
__device__ __forceinline__ bf16x8 f32_to_bf8(f32x8 x) { u32x4 w = {cvtpk(x[0], x[1]), cvtpk(x[2], x[3]), cvtpk(x[4], x[5]), cvtpk(x[6], x[7])}; return *reinterpret_cast<bf16x8*>(&w); }
__device__ __forceinline__ int t5_bucket(int rel) {
  const int n = rel < 0 ? -rel : rel; int bk;
  if (n < 8) bk = n; else if (n < 12) bk = 8; else if (n < 16) bk = 9; else if (n < 23) bk = 10; else if (n < 32) bk = 11; else if (n < 46) bk = 12; else if (n < 64) bk = 13; else if (n < 91) bk = 14; else bk = 15;
  return bk + (rel > 0 ? 16 : 0);
}
struct Aux { const float* cosT; const float* sinT; const float* qn; const float* kn; const float* relb; const float* sink; };

template <int MODE>
__device__ __forceinline__ void attn_unit(const bf16_t* Qb, const bf16_t* __restrict__ Kh, const bf16_t* __restrict__ Vh, bf16_t* Ob, int kbeg, int kend, int q0, int head, char* lds, const Aux& aux) {
  int tid = threadIdx.x; asm volatile("" : "+v"(tid));
  const int wid = tid >> 6, lane = tid & 63, r32 = lane & 31, hi = lane >> 5;
  char* V_lds = lds; char* K_lds = lds + SHM_V;
  float* ws = (float*)(lds + OFF_WS) + wid * 64; float* li_l = ws; float* al_l = ws + 32;
  float* tab = (float*)(lds + OFF_TAB);
  float m_reg = -1e30f, l_reg = 0; f32x16 o[4] = {}; bf16x8 qr[8];
  const bf16_t* Qw = Qb + (long)(wid * QBLK + r32) * LDQ + hi * 8;
#pragma unroll
  for (int d0 = 0; d0 < 8; ++d0) qr[d0] = *reinterpret_cast<const bf16x8*>(Qw + d0 * 16);
  if constexpr (MODE == 1) {
    for (int i = tid; i < 768; i += 512) { const int rel = i - 383, n = rel < 0 ? -rel : rel; float v = -1e30f; if (n <= 128) v = aux.relb[t5_bucket(rel) * NHB + head] * LOG2E; tab[i] = v; }
    m_reg = aux.sink[head] * LOG2E; l_reg = 1.0f;
  }
  const int tbase = kbeg - q0 - wid * QBLK - r32 + 383 + 4 * hi;
  const int sr = tid >> 4, sc = (tid & 15) * 8, vst0 = v_st(sr, sc), vst1 = v_st(32 + sr, sc);
  const int vb0 = (int)(uintptr_t)V_lds + v_rd_base(lane);
  struct { bf16x8 vs0, vs1, ks0, ks1; } sr_[2];
#define SLOAD(i, k0) do { sr_[i].vs0 = *reinterpret_cast<const bf16x8*>(&Vh[(long)(kbeg + (k0) + sr) * LDK + sc]); sr_[i].vs1 = *reinterpret_cast<const bf16x8*>(&Vh[(long)(kbeg + (k0) + 32 + sr) * LDK + sc]); \
    sr_[i].ks0 = *reinterpret_cast<const bf16x8*>(&Kh[(long)(kbeg + (k0) + sr) * LDK + sc]); sr_[i].ks1 = *reinterpret_cast<const bf16x8*>(&Kh[(long)(kbeg + (k0) + 32 + sr) * LDK + sc]); } while (0)
#define SWRITE(bo, i) do { *(bf16x8*)(V_lds + (bo) + vst0) = sr_[i].vs0;          \
    *(bf16x8*)(V_lds + (bo) + vst1) = sr_[i].vs1; int kc = sc * 2;               \
    *(bf16x8*)(K_lds + (bo) + KSWZ(sr, kc)) = sr_[i].ks0;                       \
    *(bf16x8*)(K_lds + (bo) + KSWZ(32 + sr, kc)) = sr_[i].ks1; } while (0)
#define SWAIT() asm volatile("s_waitcnt vmcnt(4)" ::: "memory")
#define RESC(a) do { if (__any((a) < 1.f)) { if (hi == 0) al_l[r32] = (a); asm volatile("s_waitcnt lgkmcnt(0)" ::: "memory"); \
    _Pragma("unroll") for (int d = 0; d < 4; ++d) _Pragma("unroll") for (int r = 0; r < 16; ++r) o[d][r] *= al_l[crow(r, hi)]; } } while (0)
#define PSM(P0, P1, MN, AL, j) do { if constexpr (MODE == 0) partialSM(P0, P1, m_reg, MN, AL); else partialSM_B(P0, P1, m_reg, MN, AL, tab + tbase + (j) * KVBLK); } while (0)
#define ROT() do { const int t_ = o_prev; o_prev = o_cur; o_cur = o_next; o_next = t_; } while (0)
  f32x16 pA0, pA1, pB0, pB1; float mnA, mnB, alA, alB; bf16x8 pa0, pa1, pa2, pa3; const int NT = (kend - kbeg) / KVBLK;
  constexpr int SE = 0, SO = 1;
  int o_prev = 2 * BUFB, o_cur = 0, o_next = BUFB;
  SLOAD(SE, 0); asm volatile("s_waitcnt vmcnt(0)" ::: "memory"); SWRITE(0, SE);
  SLOAD(SO, KVBLK); SLOAD(SE, 2 * KVBLK);
  __syncthreads();
  qkt(pA0, pA1, (const bf16_t*)(K_lds + o_cur), qr, r32, hi); PSM(pA0, pA1, mnA, alA, 0);
  SWAIT(); SWRITE(o_next, SO); RESC(alA); __syncthreads();
  ROT();
  for (int j = 1; j + 1 < NT; j += 2) {
    SBAR(); qkt(pB0, pB1, (const bf16_t*)(K_lds + o_cur), qr, r32, hi);
    finishSM(pA0, pA1, alA, l_reg, pa0, pa1, pa2, pa3); SBAR();
    SLOAD(SO, (j + 2) * KVBLK); SBAR();
    pv_psm<MODE>(o, vb0 + o_prev, pa0, pa1, pa2, pa3, pB0, pB1, m_reg, mnB, alB, tab + tbase + j * KVBLK);
    SWAIT(); SWRITE(o_next, SE);
    RESC(alB); __syncthreads(); ROT();
    SBAR(); qkt(pA0, pA1, (const bf16_t*)(K_lds + o_cur), qr, r32, hi);
    finishSM(pB0, pB1, alB, l_reg, pa0, pa1, pa2, pa3); SBAR();
    SLOAD(SE, (j + 3 < NT ? j + 3 : NT - 1) * KVBLK); SBAR();
    pv_psm<MODE>(o, vb0 + o_prev, pa0, pa1, pa2, pa3, pA0, pA1, m_reg, mnA, alA, tab + tbase + (j + 1) * KVBLK);
    SWAIT(); SWRITE(o_next, SO);
    RESC(alA); __syncthreads(); ROT();
  }
  SBAR(); qkt(pB0, pB1, (const bf16_t*)(K_lds + o_cur), qr, r32, hi);
  finishSM(pA0, pA1, alA, l_reg, pa0, pa1, pa2, pa3); SBAR();
  pv_psm<MODE>(o, vb0 + o_prev, pa0, pa1, pa2, pa3, pB0, pB1, m_reg, mnB, alB, tab + tbase + (NT - 1) * KVBLK);
  RESC(alB);
  finishSM(pB0, pB1, alB, l_reg, pa0, pa1, pa2, pa3); SBAR();
  pv_d0(o, vb0 + o_cur, pa0, pa1, pa2, pa3);
  if (hi == 0) li_l[r32] = l_reg; asm volatile("s_waitcnt lgkmcnt(0)" ::: "memory");
  float rli[16];
#pragma unroll
  for (int r = 0; r < 16; ++r) rli[r] = __builtin_amdgcn_rcpf(li_l[crow(r, hi)]);
  asm volatile("s_waitcnt vmcnt(0)" ::: "memory");
  __syncthreads();
  char* ost = lds + OFF_OST + wid * 8192;
#pragma unroll
  for (int r = 0; r < 16; ++r) { const int orow = crow(r, hi);
#pragma unroll
    for (int d0 = 0; d0 < 4; ++d0) *(unsigned short*)(ost + orow * 256 + (d0 * 32 + r32) * 2) = f2bf(o[d0][r] * rli[r]); }
  asm volatile("s_waitcnt lgkmcnt(0)" ::: "memory");
  bf16_t* Ow = Ob + (long)(wid * QBLK) * LDQ;
#pragma unroll
  for (int i = 0; i < 8; ++i) { const int ch = i * 64 + lane, row = ch >> 4, c16 = ch & 15;
    const u32x4 v = *(const u32x4*)(ost + row * 256 + c16 * 16); *(u32x4*)(Ow + (long)row * LDQ + c16 * 8) = v; }
  asm volatile("s_waitcnt lgkmcnt(0)" ::: "memory");
  __syncthreads();
#undef ROT
#undef SLOAD
#undef SWRITE
#undef SWAIT
#undef RESC
#undef PSM
}

template <int MODE>
__device__ __forceinline__ void softmax_tile(f32x16& p0, f32x16& p1, float& m_reg, float& l_reg, float& alpha, bf16x8& pa0, bf16x8& pa1, bf16x8& pa2, bf16x8& pa3, const float* tb) {
  if constexpr (MODE == 0) {
    alpha = 1.f;
    if (__builtin_expect(m_reg != 0.f, 0)) {
#pragma unroll
      for (int r = 0; r < 16; ++r) { p0[r] -= m_reg; p1[r] -= m_reg; } }
#pragma unroll
    for (int r = 0; r < 16; ++r) { p0[r] = __builtin_amdgcn_exp2f(p0[r]); p1[r] = __builtin_amdgcn_exp2f(p1[r]); }
  } else {
  if constexpr (MODE == 1) {
#pragma unroll
    for (int r = 0; r < 16; ++r) { const int of = (r & 3) + 8 * (r >> 2); p0[r] = fmaf(p0[r], C, tb[of]); p1[r] = fmaf(p1[r], C, tb[32 + of]); }
  }
  float pmax = p0[0];
#pragma unroll
  for (int r = 1; r < 16; ++r) pmax = fmaxf(pmax, p0[r]);
#pragma unroll
  for (int r = 0; r < 16; ++r) pmax = fmaxf(pmax, p1[r]);
  { auto rr = __builtin_amdgcn_permlane32_swap(__float_as_uint(pmax), __float_as_uint(pmax), false, false);
    pmax = fmaxf(__uint_as_float(rr[0]), __uint_as_float(rr[1])); }
  float mn, sub;
  if constexpr (MODE == 0) {
    if (__builtin_expect(__all(pmax - m_reg <= THR / SCALE), 1)) { mn = m_reg; alpha = 1.f; }
    else { mn = fmaxf(m_reg, pmax); alpha = __builtin_amdgcn_exp2f((m_reg - mn) * C); m_reg = mn; }
    sub = -mn * C;
#pragma unroll
    for (int r = 0; r < 16; ++r) { p0[r] = __builtin_amdgcn_exp2f(fmaf(p0[r], C, sub)); p1[r] = __builtin_amdgcn_exp2f(fmaf(p1[r], C, sub)); }
  } else {
    if (__builtin_expect(__all(pmax - m_reg <= THR * LOG2E), 1)) { mn = m_reg; alpha = 1.f; }
    else { mn = fmaxf(m_reg, pmax); alpha = __builtin_amdgcn_exp2f(m_reg - mn); m_reg = mn; }
    sub = -mn;
#pragma unroll
    for (int r = 0; r < 16; ++r) { p0[r] = __builtin_amdgcn_exp2f(p0[r] + sub); p1[r] = __builtin_amdgcn_exp2f(p1[r] + sub); }
  }
  }
  float ps = 0;
#pragma unroll
  for (int r = 0; r < 16; ++r) ps += p0[r];
#pragma unroll
  for (int r = 0; r < 16; ++r) ps += p1[r];
  { auto rr = __builtin_amdgcn_permlane32_swap(__float_as_uint(ps), __float_as_uint(ps), false, false);
    ps = __uint_as_float(rr[0]) + __uint_as_float(rr[1]); }
  l_reg = l_reg * alpha + ps;
#define PK4(P, BASE, OUT) do { unsigned a0 = cvtpk(P[BASE + 0], P[BASE + 1]), a1 = cvtpk(P[BASE + 2], P[BASE + 3]);   \
    unsigned b0 = cvtpk(P[BASE + 4], P[BASE + 5]), b1 = cvtpk(P[BASE + 6], P[BASE + 7]);                              \
    auto r0 = __builtin_amdgcn_permlane32_swap(a0, b0, false, false); auto r1 = __builtin_amdgcn_permlane32_swap(a1, b1, false, false); \
    u32x4 w = {r0[0], r1[0], r0[1], r1[1]}; OUT = *reinterpret_cast<bf16x8*>(&w); } while (0)
  PK4(p0, 0, pa0); PK4(p0, 8, pa1); PK4(p1, 0, pa2); PK4(p1, 8, pa3);
#undef PK4
}
typedef short v4i16_t __attribute__((ext_vector_type(4)));
__device__ __forceinline__ bf16x8 ld_frag2(int sp, const LAS char* kb, const int (&kx)[4], const LAS char* vb) {
  if (sp >= 16) { const int s = sp - 16, d0 = s >> 1; return *(const LAS bf16x8*)(kb + kx[d0 & 3] + (d0 >> 2) * 128 + (s & 1) * 8192); }
  const int D0 = sp >> 2, ks = sp & 3;
  const s16x4 lo = __builtin_bit_cast(s16x4, __builtin_amdgcn_ds_read_tr16_b64_v4i16((LAS v4i16_t*)(vb + v_rd_off(D0, ks, 0))));
  const s16x4 hi = __builtin_bit_cast(s16x4, __builtin_amdgcn_ds_read_tr16_b64_v4i16((LAS v4i16_t*)(vb + v_rd_off(D0, ks, 1))));
  return (bf16x8){lo[0], lo[1], lo[2], lo[3], hi[0], hi[1], hi[2], hi[3]};
}
template <int SB, int SE, bool PRE>
__device__ __forceinline__ void mrun(bf16x8 (&f)[8], f32x16& p0, f32x16& p1, f32x16* o, const bf16x8* qr, bf16x8 pa0, bf16x8 pa1, bf16x8 pa2, bf16x8 pa3, const LAS char* kb, const int (&kx)[4], const LAS char* vb, float init) {
  if (SE > 16) { p0 = f32x16{}; p1 = f32x16{}; }
  SBAR();
  if (!PRE) {
#pragma unroll
    for (int s = SB; s < SB + 8; ++s) f[s & 7] = ld_frag2(s, kb, kx, vb);
    SBAR(); }
#pragma unroll
  for (int sp = SB; sp < SE; ++sp) {
    if (sp >= 16) { const int s = sp - 16; if (s & 1) p1 = __builtin_amdgcn_mfma_f32_32x32x16_bf16(f[sp & 7], qr[s >> 1], p1, 0, 0, 0); else p0 = __builtin_amdgcn_mfma_f32_32x32x16_bf16(f[sp & 7], qr[s >> 1], p0, 0, 0, 0); }
    else { const int D0 = sp >> 2, ks = sp & 3; const bf16x8 pa = ks == 0 ? pa0 : ks == 1 ? pa1 : ks == 2 ? pa2 : pa3;
      o[D0] = __builtin_amdgcn_mfma_f32_32x32x16_bf16(pa, f[sp & 7], o[D0], 0, 0, 0); }
    if (sp + 8 < SE) f[sp & 7] = ld_frag2(sp + 8, kb, kx, vb);
    SBAR();
  }
}
template <int MODE>
__device__ __forceinline__ void attn_unit_pp(const bf16_t* Qb, const bf16_t* __restrict__ Kh, const bf16_t* __restrict__ Vh, bf16_t* Ob, int kbeg, int kend, int q0, int head, char* lds, const Aux& aux) {
  int tid = threadIdx.x; asm volatile("" : "+v"(tid));
  const int wid = tid >> 6, lane = tid & 63, r32 = lane & 31, hi = lane >> 5;
  const int widu = __builtin_amdgcn_readfirstlane(wid), half = widu >> 2;
  const int hsub = widu >> 1, rsub = (widu & 1) * QBLK;
  const int rw0 = q0 + rsub;
#define NEED(j) (MODE == 0 || ((kbeg + (j) * KVBLK + KVBLK - 1 >= rw0 - 128) && (kbeg + (j) * KVBLK <= rw0 + QBLK - 1 + 128)))
  char* V_lds = lds; char* K_lds = lds + SHM_V;
  float* ws = (float*)(lds + OFF_WS) + wid * 64; float* li_l = ws; float* al_l = ws + 32;
  float* tab = (float*)(lds + OFF_TAB) + hsub * 768;
  float m_reg = -1e30f, l_reg = 0; f32x16 o[4] = {}; bf16x8 qr[8];
  const bf16_t* Qw = Qb + (long)(rsub + r32) * LDQ + hsub * HD + hi * 8;
#pragma unroll
  for (int d0 = 0; d0 < 8; ++d0) qr[d0] = *reinterpret_cast<const bf16x8*>(Qw + d0 * 16);
  if constexpr (MODE == 1) {
    m_reg = aux.sink[head + hsub] * LOG2E; l_reg = 1.0f;
  }
  const int tbase = kbeg - q0 - rsub - r32 + 383 + 4 * hi;
  float qk_init = 0.f;
  if constexpr (MODE == 0) {
    float mq = fmaxf(fabsf(aux.qn[lane]), fabsf(aux.qn[64 + lane])), mk = fmaxf(fabsf(aux.kn[lane]), fabsf(aux.kn[64 + lane]));
#pragma unroll
    for (int of = 1; of < 64; of <<= 1) { mq = fmaxf(mq, __shfl_xor(mq, of)); mk = fmaxf(mk, __shfl_xor(mk, of)); }
    const float bound = C * 128.0f * mq * mk * 1.01f + 0.5f;
    m_reg = __builtin_amdgcn_readfirstlane(__float_as_int(bound > 64.f ? bound - 64.f : 0.f)) ? (bound - 64.f) : 0.f; (void)qk_init; }
  const int sr = tid >> 4, sc = (tid & 15) * 8, vst0 = v_st(sr, sc), vst1 = v_st(32 + sr, sc);
  const int vb0 = (int)(uintptr_t)V_lds + v_rd_base(lane);
  int kx[4];
#pragma unroll
  for (int d = 0; d < 4; ++d) kx[d] = r32 * 256 + ((d * 32 + hi * 16) ^ ((r32 & 7) << 4));
  const LAS char* k3 = (const LAS char*)K_lds; const LAS char* v3 = (const LAS char*)V_lds + v_rd_base(lane);
  bf16x8 fr_[8];
  bf16x8 s_v0, s_v1, s_k0, s_k1;
#define SLOAD(k0) do { s_v0 = *reinterpret_cast<const bf16x8*>(&Vh[(long)(kbeg + (k0) + sr) * LDK + sc]); s_v1 = *reinterpret_cast<const bf16x8*>(&Vh[(long)(kbeg + (k0) + 32 + sr) * LDK + sc]); \
    s_k0 = *reinterpret_cast<const bf16x8*>(&Kh[(long)(kbeg + (k0) + sr) * LDK + sc]); s_k1 = *reinterpret_cast<const bf16x8*>(&Kh[(long)(kbeg + (k0) + 32 + sr) * LDK + sc]); } while (0)
#define SWRITE(bo) do { *(bf16x8*)(V_lds + (bo) + vst0) = s_v0; *(bf16x8*)(V_lds + (bo) + vst1) = s_v1; const int kc = sc * 2;  \
    *(bf16x8*)(K_lds + (bo) + KSWZ(sr, kc)) = s_k0; *(bf16x8*)(K_lds + (bo) + KSWZ(32 + sr, kc)) = s_k1; } while (0)
#define VMW0() asm volatile("s_waitcnt vmcnt(0)" ::: "memory")
#define BAR() asm volatile("s_waitcnt lgkmcnt(0)\n\ts_barrier" ::: "memory")
#define RESC(a) do { if (__any((a) < 1.f)) { if (hi == 0) al_l[r32] = (a); asm volatile("s_waitcnt lgkmcnt(0)" ::: "memory"); \
    _Pragma("unroll") for (int d = 0; d < 4; ++d) _Pragma("unroll") for (int r = 0; r < 16; ++r) o[d][r] *= al_l[crow(r, hi)]; } } while (0)
#define ROT() do { const int t_ = o_prev; o_prev = o_cur; o_cur = o_next; o_next = t_; } while (0)
#define VSEG(j) do { VMW0(); SWRITE(o_next); { const int nx_ = (j) + 2 + half; SLOAD((nx_ < NT ? nx_ : NT - 1) * KVBLK); } SBAR(); \
    if (NEED(j)) { softmax_tile<MODE>(p0, p1, m_reg, l_reg, alpha, pa0, pa1, pa2, pa3, tab + tbase + (j) * KVBLK); if constexpr (MODE == 1) { RESC(alpha); } } SBAR(); } while (0)
#define PVPRE() do { if constexpr (MODE == 0) { _Pragma("unroll") for (int s_ = 0; s_ < 8; ++s_) fr_[s_] = ld_frag2(s_, k3, kx, v3 + o_cur); SBAR(); } } while (0)
  f32x16 p0, p1; float alpha; bf16x8 pa0, pa1, pa2, pa3; const int NT = (kend - kbeg) / KVBLK;
  int o_prev = 2 * BUFB, o_cur = 0, o_next = BUFB;
  { bf16x8 t_v0, t_v1, t_k0, t_k1;
    t_v0 = *reinterpret_cast<const bf16x8*>(&Vh[(long)(kbeg + sr) * LDK + sc]); t_v1 = *reinterpret_cast<const bf16x8*>(&Vh[(long)(kbeg + 32 + sr) * LDK + sc]);
    t_k0 = *reinterpret_cast<const bf16x8*>(&Kh[(long)(kbeg + sr) * LDK + sc]); t_k1 = *reinterpret_cast<const bf16x8*>(&Kh[(long)(kbeg + 32 + sr) * LDK + sc]);
    SLOAD(KVBLK); VMW0();
    *(bf16x8*)(V_lds + vst0) = t_v0; *(bf16x8*)(V_lds + vst1) = t_v1; { const int kc = sc * 2; *(bf16x8*)(K_lds + KSWZ(sr, kc)) = t_k0; *(bf16x8*)(K_lds + KSWZ(32 + sr, kc)) = t_k1; }
    if (half) { SWRITE(BUFB); SLOAD(2 * KVBLK); } }
  BAR();
#define MSEG_QK(j) do { SBAR(); if (NEED(j)) qkt(p0, p1, (const bf16_t*)(K_lds + o_cur), qr, r32, hi, qk_init); SBAR(); } while (0)
#define MSEG(j) do { SBAR(); if (NEED(j)) qkt(p0, p1, (const bf16_t*)(K_lds + o_cur), qr, r32, hi, qk_init); if (NEED((j) - 1)) pv_d0(o, vb0 + o_prev, pa0, pa1, pa2, pa3); SBAR(); } while (0)
#define MSEG_PV() do { SBAR(); if (NEED(NT - 1)) pv_d0(o, vb0 + o_prev, pa0, pa1, pa2, pa3); SBAR(); } while (0)
  if (half == 0) {
    MSEG_QK(0); VSEG(0);
    BAR(); ROT();
    for (int j = 1; j < NT; ++j) { MSEG(j); VSEG(j); BAR(); ROT(); }
    MSEG_PV();
  } else {
    MSEG_QK(0);
    BAR(); ROT();
    for (int j = 1; j < NT; ++j) { VSEG(j - 1); MSEG(j); BAR(); ROT(); }
    VSEG(NT - 1); MSEG_PV();
  }
#undef MSEG_QK
#undef MSEG
#undef MSEG_PV
  if (hi == 0) li_l[r32] = l_reg; asm volatile("s_waitcnt lgkmcnt(0)" ::: "memory");
  float rli[16];
#pragma unroll
  for (int r = 0; r < 16; ++r) rli[r] = __builtin_amdgcn_rcpf(li_l[crow(r, hi)]);
  VMW0();
  __syncthreads();
  char* ost = lds + OFF_OST + wid * 8192;
#pragma unroll
  for (int r = 0; r < 16; ++r) { const int orow = crow(r, hi);
#pragma unroll
    for (int d0 = 0; d0 < 4; ++d0) *(unsigned short*)(ost + orow * 256 + (d0 * 32 + r32) * 2) = f2bf(o[d0][r] * rli[r]); }
  asm volatile("s_waitcnt lgkmcnt(0)" ::: "memory");
  bf16_t* Ow = Ob + (long)rsub * LDQ + hsub * HD;
#pragma unroll
  for (int i = 0; i < 8; ++i) { const int ch = i * 64 + lane, row = ch >> 4, c16 = ch & 15;
    const u32x4 v = *(const u32x4*)(ost + row * 256 + c16 * 16); *(u32x4*)(Ow + (long)row * LDQ + c16 * 8) = v; }
  asm volatile("s_waitcnt lgkmcnt(0)" ::: "memory");
  __syncthreads();
#undef SLOAD
#undef SWRITE
#undef VMW0
#undef BAR
#undef RESC
#undef ROT
#undef VSEG
#undef PVPRE
#undef NEED
}

__device__ __forceinline__ int offK16(int row, int ch) { return row * 256 + 16 * (ch ^ (row & 15)); }
__device__ __forceinline__ int offV16(int row, int ch) { return row * 256 + 16 * (ch ^ ((row & 7) << 1)); }
__device__ __forceinline__ bf16x8 ld_frag16(int sp, const LAS char* kb, const int (&ka)[4], const LAS char* vb, const int (&va)[8]) {
  if (sp >= 16) { const int s = sp - 16, kblk = s >> 2, ks = s & 3; return *(const LAS bf16x8*)(kb + ka[ks] + kblk * 4096); }
  const int db = sp >> 1, s = sp & 1;
  const s16x4 lo = __builtin_bit_cast(s16x4, __builtin_amdgcn_ds_read_tr16_b64_v4i16((LAS v4i16_t*)(vb + va[db] + s * 8192)));
  const s16x4 hi = __builtin_bit_cast(s16x4, __builtin_amdgcn_ds_read_tr16_b64_v4i16((LAS v4i16_t*)(vb + va[db] + s * 8192 + 4096)));
  return (bf16x8){lo[0], lo[1], lo[2], lo[3], hi[0], hi[1], hi[2], hi[3]};
}
template <int SB, int SE, bool PRE>
__device__ __forceinline__ void mrun16(bf16x8 (&f)[8], f32x4 (&S)[4][2], f32x4 (&O)[8][2], const bf16x8 (&qf)[2][4], const bf16x8 (&pf)[2][2], const LAS char* kb, const int (&ka)[4], const LAS char* vb, const int (&va)[8]) {
  if (SE > 16) {
#pragma unroll
    for (int i = 0; i < 4; ++i) { S[i][0] = (f32x4){0.f, 0.f, 0.f, 0.f}; S[i][1] = (f32x4){0.f, 0.f, 0.f, 0.f}; } }
  SBAR();
  if (!PRE) {
#pragma unroll
    for (int s = SB; s < SB + 8; ++s) f[s & 7] = ld_frag16(s, kb, ka, vb, va);
    SBAR(); }
#pragma unroll
  for (int sp = SB; sp < SE; ++sp) {
    if (sp >= 16) { const int s = sp - 16, kblk = s >> 2, ks = s & 3;
      S[kblk][0] = __builtin_amdgcn_mfma_f32_16x16x32_bf16(f[sp & 7], qf[0][ks], S[kblk][0], 0, 0, 0); S[kblk][1] = __builtin_amdgcn_mfma_f32_16x16x32_bf16(f[sp & 7], qf[1][ks], S[kblk][1], 0, 0, 0); }
    else { const int db = sp >> 1, s = sp & 1;
      O[db][0] = __builtin_amdgcn_mfma_f32_16x16x32_bf16(f[sp & 7], pf[0][s], O[db][0], 0, 0, 0); O[db][1] = __builtin_amdgcn_mfma_f32_16x16x32_bf16(f[sp & 7], pf[1][s], O[db][1], 0, 0, 0); }
    if (sp + 8 < SE) f[sp & 7] = ld_frag16(sp + 8, kb, ka, vb, va);
    SBAR();
  }
}
__device__ __forceinline__ void attn_unit16(const bf16_t* Qb, const bf16_t* __restrict__ Kh, const bf16_t* __restrict__ Vh, bf16_t* Ob, int nkeys, int q0, char* lds, const Aux& aux) {
  int tid = threadIdx.x; asm volatile("" : "+v"(tid));
  const int wid = tid >> 6, lane = tid & 63, fr = lane & 15, fq = lane >> 4;
  const int half = __builtin_amdgcn_readfirstlane(wid >> 2);
  char* V_lds = lds; char* K_lds = lds + SHM_V;
  float shift;
  { float mq = fmaxf(fabsf(aux.qn[lane]), fabsf(aux.qn[64 + lane])), mk = fmaxf(fabsf(aux.kn[lane]), fabsf(aux.kn[64 + lane]));
#pragma unroll
    for (int of = 1; of < 64; of <<= 1) { mq = fmaxf(mq, __shfl_xor(mq, of)); mk = fmaxf(mk, __shfl_xor(mk, of)); }
    const float bound = C * 128.0f * mq * mk * 1.01f + 0.5f; shift = bound > 64.f ? bound - 64.f : 0.f; }
  bf16x8 qf[2][4];
#pragma unroll
  for (int qb = 0; qb < 2; ++qb)
#pragma unroll
    for (int ks = 0; ks < 4; ++ks) qf[qb][ks] = *reinterpret_cast<const bf16x8*>(Qb + (long)(wid * QBLK + 16 * qb + fr) * LDQ + 32 * ks + 8 * fq);
#pragma unroll
  for (int qb = 0; qb < 2; ++qb) {
    float ss = 0.f;
#pragma unroll
    for (int ks = 0; ks < 4; ++ks) { const f32x8 x = bf8_to_f32(qf[qb][ks]);
#pragma unroll
      for (int e = 0; e < 8; ++e) ss += x[e] * x[e]; }
    ss += __shfl_xor(ss, 16); ss += __shfl_xor(ss, 32);
    const float rinv = C / sqrtf(ss * (1.0f / 128.0f) + EPS);
    const int t = q0 + wid * QBLK + 16 * qb + fr;
#pragma unroll
    for (int hf = 0; hf < 2; ++hf) { const int posx = hf ? (t & 63) : (t >> 6);
      const f32x8 cs = *reinterpret_cast<const f32x8*>(aux.cosT + posx * 32 + 8 * fq), sn = *reinterpret_cast<const f32x8*>(aux.sinT + posx * 32 + 8 * fq);
      const f32x8 g1 = *reinterpret_cast<const f32x8*>(aux.qn + hf * 64 + 8 * fq), g2 = *reinterpret_cast<const f32x8*>(aux.qn + hf * 64 + 32 + 8 * fq);
      const f32x8 x1 = bf8_to_f32(qf[qb][2 * hf]) * rinv * g1, x2 = bf8_to_f32(qf[qb][2 * hf + 1]) * rinv * g2;
      qf[qb][2 * hf] = f32_to_bf8(x1 * cs - x2 * sn); qf[qb][2 * hf + 1] = f32_to_bf8(x2 * cs + x1 * sn); } }
  f32x4 O[8][2], S[4][2]; bf16x8 pf[2][2]; float lsum[2] = {0.f, 0.f};
#pragma unroll
  for (int i = 0; i < 8; ++i) { O[i][0] = (f32x4){0.f, 0.f, 0.f, 0.f}; O[i][1] = (f32x4){0.f, 0.f, 0.f, 0.f}; }
  int ka[4], va[8];
#pragma unroll
  for (int ks = 0; ks < 4; ++ks) ka[ks] = offK16(fr, 4 * ks + fq);
  { const int q = (lane & 15) >> 2, p = lane & 3;
#pragma unroll
    for (int c = 0; c < 8; ++c) va[c] = offV16(4 * fq + q, 2 * c + (p >> 1)) + 8 * (p & 1); }
  const LAS char* k3 = (const LAS char*)K_lds; const LAS char* v3 = (const LAS char*)V_lds;
  bf16x8 fr_[8];
  const int sr = tid >> 4, scc = tid & 15, kst = offK16(sr, scc), vst = offV16(sr, scc);
  bf16x8 s_v0, s_v1, s_k0, s_k1;
#define SLOAD(k0) do { s_v0 = *reinterpret_cast<const bf16x8*>(&Vh[(long)((k0) + sr) * LDK + scc * 8]); s_v1 = *reinterpret_cast<const bf16x8*>(&Vh[(long)((k0) + 32 + sr) * LDK + scc * 8]); \
    s_k0 = *reinterpret_cast<const bf16x8*>(&Kh[(long)((k0) + sr) * LDK + scc * 8]); s_k1 = *reinterpret_cast<const bf16x8*>(&Kh[(long)((k0) + 32 + sr) * LDK + scc * 8]); } while (0)
#define SWRITE(bo) do { *(bf16x8*)(V_lds + (bo) + vst) = s_v0; *(bf16x8*)(V_lds + (bo) + vst + 8192) = s_v1; *(bf16x8*)(K_lds + (bo) + kst) = s_k0; *(bf16x8*)(K_lds + (bo) + kst + 8192) = s_k1; } while (0)
#define VMW0() asm volatile("s_waitcnt vmcnt(0)" ::: "memory")
#define BAR() asm volatile("s_waitcnt lgkmcnt(0)\n\ts_barrier" ::: "memory")
#define ROT() do { const int t_ = o_prev; o_prev = o_cur; o_cur = o_next; o_next = t_; } while (0)
#define VSEG(j, wbuf_, pbuf_) do { VMW0(); SWRITE(wbuf_); { const int nx_ = (j) + 2 + half; SLOAD((nx_ < NT ? nx_ : NT - 1) * KVBLK); } SBAR(); \
    if (__builtin_expect(shift != 0.f, 0)) { _Pragma("unroll") for (int i_ = 0; i_ < 4; ++i_) { S[i_][0] -= shift; S[i_][1] -= shift; } } \
    _Pragma("unroll") for (int qb_ = 0; qb_ < 2; ++qb_) { \
      _Pragma("unroll") for (int i_ = 0; i_ < 4; ++i_) _Pragma("unroll") for (int r_ = 0; r_ < 4; ++r_) S[i_][qb_][r_] = __builtin_amdgcn_exp2f(S[i_][qb_][r_]); \
      float a_ = 0.f; _Pragma("unroll") for (int i_ = 0; i_ < 4; ++i_) a_ += (S[i_][qb_][0] + S[i_][qb_][1]) + (S[i_][qb_][2] + S[i_][qb_][3]); lsum[qb_] += a_; \
      _Pragma("unroll") for (int s_ = 0; s_ < 2; ++s_) { u32x4 w_ = {cvtpk(S[2 * s_][qb_][0], S[2 * s_][qb_][1]), cvtpk(S[2 * s_][qb_][2], S[2 * s_][qb_][3]), cvtpk(S[2 * s_ + 1][qb_][0], S[2 * s_ + 1][qb_][1]), cvtpk(S[2 * s_ + 1][qb_][2], S[2 * s_ + 1][qb_][3])}; \
        pf[qb_][s_] = *reinterpret_cast<bf16x8*>(&w_); } } \
    SBAR(); _Pragma("unroll") for (int s_ = 0; s_ < 8; ++s_) fr_[s_] = ld_frag16(s_, k3, ka, v3 + (pbuf_), va); SBAR(); } while (0)
  const int NT = nkeys / KVBLK;
  int o_prev = 2 * BUFB, o_cur = 0, o_next = BUFB;
  SLOAD(0); VMW0(); SWRITE(0);
  if (half) { SLOAD(KVBLK); VMW0(); SWRITE(BUFB); SLOAD(2 * KVBLK); } else { SLOAD(KVBLK); }
  BAR();
  if (half == 0) {
    mrun16<16, 32, false>(fr_, S, O, qf, pf, k3 + o_cur, ka, v3 + o_prev, va);
    VSEG(0, o_next, o_cur);
    BAR(); ROT();
    for (int j = 1; j < NT; ++j) {
      mrun16<0, 32, true>(fr_, S, O, qf, pf, k3 + o_cur, ka, v3 + o_prev, va);
      VSEG(j, o_next, o_cur);
      BAR(); ROT();
    }
    mrun16<0, 16, true>(fr_, S, O, qf, pf, k3 + o_cur, ka, v3 + o_prev, va);
  } else {
    mrun16<16, 32, false>(fr_, S, O, qf, pf, k3 + o_cur, ka, v3 + o_prev, va);
    BAR(); ROT();
    for (int j = 1; j < NT; ++j) {
      VSEG(j - 1, o_next, o_prev);
      mrun16<0, 32, true>(fr_, S, O, qf, pf, k3 + o_cur, ka, v3 + o_prev, va);
      BAR(); ROT();
    }
    VSEG(NT - 1, o_next, o_prev);
    mrun16<0, 16, true>(fr_, S, O, qf, pf, k3 + o_cur, ka, v3 + o_prev, va);
  }
  float rl[2];
#pragma unroll
  for (int qb = 0; qb < 2; ++qb) { float l = lsum[qb]; l += __shfl_xor(l, 16); l += __shfl_xor(l, 32); rl[qb] = __builtin_amdgcn_rcpf(l); }
  VMW0();
  __syncthreads();
  char* ost = lds + OFF_OST + wid * 8192;
#pragma unroll
  for (int db = 0; db < 8; ++db)
#pragma unroll
    for (int qb = 0; qb < 2; ++qb) { const f32x4 v = O[db][qb] * rl[qb]; u32x2 w; w.x = cvtpk(v[0], v[1]); w.y = cvtpk(v[2], v[3]);
      *(u32x2*)(ost + (16 * qb + fr) * 256 + (16 * db + 4 * fq) * 2) = w; }
  asm volatile("s_waitcnt lgkmcnt(0)" ::: "memory");
  bf16_t* Ow = Ob + (long)(wid * QBLK) * LDQ;
#pragma unroll
  for (int i = 0; i < 8; ++i) { const int ch = i * 64 + lane, row = ch >> 4, c16 = ch & 15;
    const u32x4 v = *(const u32x4*)(ost + row * 256 + c16 * 16); *(u32x4*)(Ow + (long)row * LDQ + c16 * 8) = v; }
  asm volatile("s_waitcnt lgkmcnt(0)" ::: "memory");
  __syncthreads();
#undef SLOAD
#undef SWRITE
#undef VMW0
#undef BAR
#undef ROT
#undef VSEG
}
}

#define XB_TMO      128
#define XB_XCNT(j)  (256  + 64 * (j))
#define XB_XSUB(j)  (1280 + 64 * (j))
#define XB_XGEN(j)  (2304 + 64 * (j))
#define XB_TOP      3328
#define XB_TOPGEN   3392
#define XCD_BAR_WORDS 3456
#define XB_SPIN_CAP (1u << 18)
__device__ __forceinline__ unsigned xb_ld(unsigned* p)              { return __hip_atomic_load(p, __ATOMIC_RELAXED, __HIP_MEMORY_SCOPE_AGENT); }
__device__ __forceinline__ unsigned xb_add(unsigned* p, unsigned v) { return __hip_atomic_fetch_add(p, v, __ATOMIC_RELAXED, __HIP_MEMORY_SCOPE_AGENT); }
__device__ __forceinline__ unsigned xb_xcc_id() { return (unsigned)__builtin_amdgcn_s_getreg((3 << 11) | 20) & 0xFu; }
#define XB_SPIN(cond, bar) do { unsigned _sp = 0; while (cond) { __builtin_amdgcn_s_sleep(1); \
    if ((++_sp & 255u) == 0u) { if (xb_ld(&(bar)[XB_TMO])) break; if (_sp > XB_SPIN_CAP) { atomicAdd(&(bar)[XB_TMO], 1u); break; } } } } while (0)
struct XcdBarrier { unsigned* bar; unsigned x; volatile LAS unsigned* st; };
__device__ __forceinline__ XcdBarrier xcd_barrier_post(unsigned* bar, volatile LAS unsigned* st) {
    XcdBarrier b; b.bar = bar; b.x = xb_xcc_id(); b.st = st;
    if (threadIdx.x == 0) (void)xb_add(&bar[XB_XCNT(b.x)], 1u);
    return b;
}
__device__ __forceinline__ void xcd_barrier_complete(unsigned* bar, unsigned x, unsigned& nloc, unsigned& nx) {
    const unsigned G = gridDim.x * gridDim.y * gridDim.z;
    unsigned sum, cnt, mine, sp = 0u;
    for (;;) {
        sum = 0u; cnt = 0u; mine = 0u;
#pragma unroll
        for (unsigned j = 0; j < 16; ++j) { const unsigned c = xb_ld(&bar[XB_XCNT(j)]); sum += c; cnt += (c > 0u) ? 1u : 0u; mine = (j == x) ? c : mine; }
        if (sum == G) break;
        __builtin_amdgcn_s_sleep(1);
        if ((++sp & 255u) == 0u) { if (xb_ld(&bar[XB_TMO])) break; if (sp > XB_SPIN_CAP) { atomicAdd(&bar[XB_TMO], 1u); break; } }
    }
    nloc = mine > 0u ? mine : 1u; nx = cnt > 0u ? cnt : 1u;
}
__device__ __forceinline__ void xcd_barrier(const XcdBarrier& b) {
    asm volatile("s_waitcnt vmcnt(0)" ::: "memory");
    __syncthreads();
    if (threadIdx.x == 0) {
        unsigned* bar = b.bar;
        __builtin_amdgcn_s_waitcnt(0);
        unsigned nloc = b.st[0], nx = b.st[1];
        if (nloc == 0u) { xcd_barrier_complete(bar, b.x, nloc, nx); b.st[0] = nloc; b.st[1] = nx; }
        const unsigned old = xb_add(&bar[XB_XSUB(b.x)], 1u);
        const unsigned gen = old / nloc;
        if (old + 1u == (gen + 1u) * nloc) {
            __builtin_amdgcn_fence(__ATOMIC_RELEASE, "agent");
            asm volatile("s_waitcnt vmcnt(0)" ::: "memory");
            const unsigned og = xb_add(&bar[XB_TOP], 1u);
            const unsigned tg = og / nx;
            if (og + 1u == (tg + 1u) * nx) xb_add(&bar[XB_TOPGEN], 1u);
            else XB_SPIN(xb_ld(&bar[XB_TOPGEN]) == tg, bar);
            __builtin_amdgcn_fence(__ATOMIC_ACQUIRE, "agent");
            xb_add(&bar[XB_XGEN(b.x)], 1u);
            asm volatile("s_waitcnt vmcnt(0)" ::: "memory");
        } else {
            XB_SPIN(xb_ld(&bar[XB_XGEN(b.x)]) == gen, bar);
            __builtin_amdgcn_fence(__ATOMIC_ACQUIRE, "agent");
            asm volatile("s_waitcnt vmcnt(0)" ::: "memory");
        }
    }
    __syncthreads();
}

struct Args { const float* in[17]; float* out; unsigned char* ws; int ph_lo, ph_hi, li, pad; };
struct Frame { LAS unsigned char* lds; int tid, lane, wave, vcu, G; };
constexpr int NWAVES = 8;

__device__ __forceinline__ void tr_item(const float* W, int N, int k0, int n0, bf16_t* WT, int Kd, int drow0, LAS float* scr, int lane) {
    float tv[32];
#pragma unroll
    for (int i = 0; i < 32; ++i) { const int kk = 2 * i + (lane >> 5); tv[i] = W[(size_t)(k0 + kk) * N + n0 + (lane & 31)]; }
#pragma unroll
    for (int i = 0; i < 32; ++i) { const int kk = 2 * i + (lane >> 5); scr[kk * 33 + (lane & 31)] = tv[i]; }
    LDS_WAIT(); asm volatile("" ::: "memory");
    const int c = lane & 7;
#pragma unroll
    for (int j = 0; j < 4; ++j) { const int n = (lane >> 3) + 8 * j; const LAS float* s = scr + (8 * c) * 33 + n;
        u32x4 o; o.x = cvt_pk_bf16(s[0 * 33], s[1 * 33]); o.y = cvt_pk_bf16(s[2 * 33], s[3 * 33]); o.z = cvt_pk_bf16(s[4 * 33], s[5 * 33]); o.w = cvt_pk_bf16(s[6 * 33], s[7 * 33]);
        *(GAS u32x4*)(WT + (size_t)(drow0 + n) * Kd + k0 + 8 * c) = o; }
    LDS_WAIT(); asm volatile("" ::: "memory");
}
__device__ __forceinline__ void rms_row_to_bf16(const float* xrow, const float* g, bf16_t* orow, int lane) {
    const GAS f32x4* xr = (const GAS f32x4*)xrow + lane; const GAS f32x4* gr = (const GAS f32x4*)g + lane;
    f32x4 v[8]; float s = 0.f;
#pragma unroll
    for (int j = 0; j < 8; ++j) { v[j] = xr[64 * j]; s += (v[j].x * v[j].x + v[j].y * v[j].y) + (v[j].z * v[j].z + v[j].w * v[j].w); }
    const float rinv = 1.0f / sqrtf(wave_sum(s) * (1.f / DM) + EPS);
    GAS u32x2* o8 = (GAS u32x2*)orow + lane;
#pragma unroll
    for (int j = 0; j < 8; ++j) { const f32x4 gv = gr[64 * j]; u32x2 w; w.x = cvt_pk_bf16(v[j].x * rinv * gv.x, v[j].y * rinv * gv.y); w.y = cvt_pk_bf16(v[j].z * rinv * gv.z, v[j].w * rinv * gv.w); o8[64 * j] = w; }
}

__device__ __forceinline__ void p0_prologue(const Frame& F, const Args& a) {
    unsigned char* ws = a.ws;
    LAS float* scr = (LAS float*)(F.lds + F.wave * 16384);
    const int gw = F.vcu * NWAVES + F.wave, NGW = F.G * NWAVES;
    constexpr int I_IN = (DM / 64) * (INW / 32), I_P = (QW / 64) * (DM / 32), I_O = (DM / 64) * (DM / 32);
    constexpr int NITEMS = I_IN + 2 * I_P + I_O;
    for (int it = gw; it < NITEMS; it += NGW) {
        int r = it;
        if (r < I_IN) { const int nb = INW / 32, kb = r / nb, n0 = (r % nb) * 32; tr_item(a.in[2], INW, kb * 64, n0, (bf16_t*)(ws + WS_WIN), DM, n0, scr, F.lane); continue; } r -= I_IN;
        if (r < I_P) { const int nb = DM / 32, kb = r / nb, n0 = (r % nb) * 32; tr_item(a.in[6], DM, kb * 64, n0, (bf16_t*)(ws + WS_WPA), QW, n0, scr, F.lane); continue; } r -= I_P;
        if (r < I_P) { const int nb = DM / 32, kb = r / nb, n0 = (r % nb) * 32; tr_item(a.in[9], DM, kb * 64, n0, (bf16_t*)(ws + WS_WPB), QW, n0, scr, F.lane); continue; } r -= I_P;
        { const int nb = DM / 32, kb = r / nb, n0 = (r % nb) * 32; tr_item(a.in[10], DM, kb * 64, n0, (bf16_t*)(ws + WS_WO), DM, n0, scr, F.lane); }
    }
    float* cosT = (float*)(ws + WS_ROPE); float* sinT = cosT + 128 * 32;
    for (int i = blockIdx.x * 512 + F.tid; i < 128 * 32; i += F.G * 512) { const int pos = i >> 5, p = i & 31;
        const float inv = 1.0f / powf(10000.0f, (float)(2 * p) / 64.0f); const float ang = (float)pos * inv; cosT[i] = cosf(ang); sinT[i] = sinf(ang); }
    { const float* X = a.in[0]; const float* gm = a.in[1]; bf16_t* H = (bf16_t*)(ws + WS_H); const int lane = F.lane;
      f32x4 nx[8]; int m = gw;
      if (m < NTOK) { const GAS f32x4* xr = (const GAS f32x4*)(X + (size_t)m * DM) + lane;
#pragma unroll
          for (int j = 0; j < 8; ++j) nx[j] = xr[64 * j]; }
      for (; m < NTOK; m += NGW) { f32x4 v[8]; float s = 0.f;
#pragma unroll
          for (int j = 0; j < 8; ++j) { v[j] = nx[j]; s += (v[j].x * v[j].x + v[j].y * v[j].y) + (v[j].z * v[j].z + v[j].w * v[j].w); }
          { const int nm = m + NGW; if (nm < NTOK) { const GAS f32x4* xr = (const GAS f32x4*)(X + (size_t)nm * DM) + lane;
#pragma unroll
              for (int j = 0; j < 8; ++j) nx[j] = xr[64 * j]; } }
          const float rinv = 1.0f / sqrtf(wave_sum(s) * (1.f / DM) + EPS);
          GAS u32x2* o8 = (GAS u32x2*)(H + (size_t)m * DM) + lane;
#pragma unroll
          for (int j = 0; j < 8; ++j) { const f32x4 gv = ((const GAS f32x4*)gm + lane)[64 * j]; u32x2 w; w.x = cvt_pk_bf16(v[j].x * rinv * gv.x, v[j].y * rinv * gv.y); w.y = cvt_pk_bf16(v[j].z * rinv * gv.z, v[j].w * rinv * gv.w); o8[64 * j] = w; } } }
}

constexpr int CW_WCTR = 8192;
__device__ __forceinline__ void p_moe_weights(const Frame& F, const Args& a) {
    unsigned char* ws = a.ws; LAS float* scr = (LAS float*)(F.lds + F.wave * 16384);
    constexpr int I_GU = NEXP * (DM / 64) * (DFF / 32), I_D = NEXP * (DFF / 64) * (DM / 32), NIT = 2 * I_GU + I_D;
    unsigned* ctr = (unsigned*)(ws + WS_CTL) + CW_WCTR;
    for (;;) {
        unsigned it0 = 0; if (F.lane == 0) it0 = __hip_atomic_fetch_add(ctr, 4u, __ATOMIC_RELAXED, __HIP_MEMORY_SCOPE_AGENT);
        it0 = (unsigned)__builtin_amdgcn_readfirstlane((int)it0);
        if (it0 >= (unsigned)NIT) break;
        for (int k4 = 0; k4 < 4; ++k4) { int r = (int)it0 + k4; if (r >= NIT) break;
            if (r < 2 * I_GU) { const int up = r >= I_GU; if (up) r -= I_GU; constexpr int per = (DM / 64) * (DFF / 32); const int e = r / per, q = r % per, nb = DFF / 32, kb = q / nb, n0 = (q % nb) * 32;
                tr_item(a.in[up ? 14 : 13] + (size_t)e * DM * DFF, DFF, kb * 64, n0, (bf16_t*)(ws + WS_WGU) + (size_t)e * 2048 * DM, DM, (n0 >> 7) * 256 + (n0 & 127) + (up ? 128 : 0), scr, F.lane); continue; }
            r -= 2 * I_GU;
            { constexpr int per = (DFF / 64) * (DM / 32); const int e = r / per, q = r % per, nb = DM / 32, kb = q / nb, n0 = (q % nb) * 32;
                tr_item(a.in[15] + (size_t)e * DFF * DM, DM, kb * 64, n0, (bf16_t*)(ws + WS_WD) + (size_t)e * 2048 * DFF, DFF, n0, scr, F.lane); } }
    }
}

__device__ __forceinline__ void prep_vecs(const Frame& F, bf16_t* T, int ld, int nh_log2, const float* gain, const float* cosT, const float* sinT, float oscale) {
    const int gw = F.vcu * NWAVES + F.wave, NGW = F.G * NWAVES;
    const int sub = F.lane & 15, half = sub >> 3, q = sub & 7;
    const int nvec = NTOK << nh_log2;
    const f32x4 g1 = *(const f32x4*)(gain + half * 64 + 4 * q), g2 = *(const f32x4*)(gain + half * 64 + 32 + 4 * q);
    for (int it = gw; it < nvec / 16; it += NGW) {
        bf16_t* base[4]; u32x2 w1[4], w2[4]; int posx[4];
#pragma unroll
        for (int u = 0; u < 4; ++u) { const int vec = it * 16 + u * 4 + (F.lane >> 4);
            const int tok = vec >> nh_log2, hd = vec & ((1 << nh_log2) - 1), pos = tok & (SEQ - 1); posx[u] = half ? (pos & 63) : (pos >> 6);
            base[u] = T + (size_t)tok * ld + hd * HD + half * 64 + 4 * q; w1[u] = *(const u32x2*)base[u]; w2[u] = *(const u32x2*)(base[u] + 32); }
#pragma unroll
        for (int u = 0; u < 4; ++u) {
            float x1[4] = {bf2f(w1[u].x & 0xffff), bf2f(w1[u].x >> 16), bf2f(w1[u].y & 0xffff), bf2f(w1[u].y >> 16)}, x2[4] = {bf2f(w2[u].x & 0xffff), bf2f(w2[u].x >> 16), bf2f(w2[u].y & 0xffff), bf2f(w2[u].y >> 16)};
            float ss = 0.f;
#pragma unroll
            for (int j = 0; j < 4; ++j) ss += x1[j] * x1[j] + x2[j] * x2[j];
            ss += __shfl_xor(ss, 1); ss += __shfl_xor(ss, 2); ss += __shfl_xor(ss, 4); ss += __shfl_xor(ss, 8);
            const float rinv = 1.0f / sqrtf(ss * (1.0f / 128.0f) + EPS);
            const f32x4 cs = *(const f32x4*)(cosT + posx[u] * 32 + 4 * q), sn = *(const f32x4*)(sinT + posx[u] * 32 + 4 * q);
            float y1[4], y2[4];
#pragma unroll
            for (int j = 0; j < 4; ++j) { const float a1 = x1[j] * rinv * g1[j], a2 = x2[j] * rinv * g2[j]; y1[j] = (a1 * cs[j] - a2 * sn[j]) * oscale; y2[j] = (a2 * cs[j] + a1 * sn[j]) * oscale; }
            u32x2 o1, o2; o1.x = cvt_pk_bf16(y1[0], y1[1]); o1.y = cvt_pk_bf16(y1[2], y1[3]); o2.x = cvt_pk_bf16(y2[0], y2[1]); o2.y = cvt_pk_bf16(y2[2], y2[3]);
            *(u32x2*)base[u] = o1; *(u32x2*)(base[u] + 32) = o2; }
    }
}
__device__ __forceinline__ void p2_qkprep(const Frame& F, const Args& a) {
    const float* cosT = (const float*)(a.ws + WS_ROPE); const float* sinT = cosT + 128 * 32;
    prep_vecs(F, (bf16_t*)(a.ws + WS_KA), KVW, 1, a.in[5], cosT, sinT, 1.0f);
}

template <int MODE> __device__ __forceinline__ void p3_attention(const Frame& F, const Args& a, char* lds) {
    unsigned char* ws = a.ws;
    const bf16_t* Q = (const bf16_t*)(ws + (MODE == 0 ? WS_QA : WS_QB)); const bf16_t* K = (const bf16_t*)(ws + (MODE == 0 ? WS_KA : WS_KB)); const bf16_t* V = (const bf16_t*)(ws + (MODE == 0 ? WS_VA : WS_VB));
    att::Aux aux; aux.cosT = (const float*)(ws + WS_ROPE); aux.sinT = aux.cosT + 128 * 32; aux.qn = a.in[4]; aux.kn = a.in[5]; aux.relb = a.in[8]; aux.sink = a.in[7];
#define BUILD_TABS(kvh_) do { float* tabs_ = (float*)(lds + att::OFF_TAB); for (int i_ = F.tid; i_ < 4 * 768; i_ += 512) { const int hh_ = i_ / 768, ii_ = i_ - hh_ * 768, rel_ = ii_ - 383, n_ = rel_ < 0 ? -rel_ : rel_; float v_ = -1e30f; \
        if (n_ <= 128) v_ = aux.relb[att::t5_bucket(rel_) * NHB + (kvh_) * 4 + hh_] * LOG2E; tabs_[i_] = v_; } } while (0)
    const bool shared_tabs = (F.G == 256);
    if (MODE == 1 && shared_tabs) { BUILD_TABS((F.vcu >> 5) & 1); __syncthreads(); }
    for (int i = 0;; ++i) {
        const int L = i * F.G + F.vcu; if (L >= 1024) break;
        const int x = (L & 255) >> 5, b = x >> 1, kvh = x & 1;
        const int qb = (MODE == 0) ? (L & 31) : ((L >> 8) * 32 + (L & 31));
        const int head = (MODE == 0) ? kvh * 4 + (L >> 8) : kvh * 4, q0 = qb * ((MODE == 0) ? 256 : 64);
        const bf16_t* Qb = Q + ((size_t)b * SEQ + q0) * QW + head * HD;
        const bf16_t* Kh = K + (size_t)b * SEQ * KVW + kvh * HD; const bf16_t* Vh = V + (size_t)b * SEQ * KVW + kvh * HD;
        int kbeg = 0, kend = SEQ;
        if (MODE == 1) { kbeg = q0 - 128 < 0 ? 0 : q0 - 128; kend = q0 + 192 > SEQ ? SEQ : q0 + 192; }
        if (MODE == 1 && !shared_tabs) { __syncthreads(); BUILD_TABS(kvh); __syncthreads(); }
        bf16_t* Ob = (bf16_t*)(ws + (MODE == 0 ? WS_OA : WS_OB)) + ((size_t)b * SEQ + q0) * QW + head * HD;
        if constexpr (MODE == 0) att::attn_unit16(Qb, Kh, Vh, Ob, SEQ, q0, lds, aux);
        else att::attn_unit_pp<MODE>(Qb, Kh, Vh, Ob, kbeg, kend, q0, head, lds, aux);
    }
#undef BUILD_TABS
}

__device__ __forceinline__ void p7_router(const Frame& F, const Args& a) {
    LAS float* wl = (LAS float*)F.lds;
    const float* wr = a.in[12];
    for (int i = F.tid; i < DM * NEXP / 4; i += 512) { const f32x4 v = *(const f32x4*)(wr + 4 * i); const int k = i >> 2, e0 = (i & 3) * 4;
        wl[(e0 + 0) * DM + k] = v.x; wl[(e0 + 1) * DM + k] = v.y; wl[(e0 + 2) * DM + k] = v.z; wl[(e0 + 3) * DM + k] = v.w; }
    __syncthreads();
    const float* X = a.in[0]; const bf16_t* ATT = (const bf16_t*)(a.ws + WS_ATT); bf16_t* H2 = (bf16_t*)(a.ws + WS_H); float* AFF = (float*)(a.ws + WS_AFF); const float* g = a.in[11];
    const int gw = F.vcu * NWAVES + F.wave, NGW = F.G * NWAVES, lane = F.lane;
    f32x4 nx[2][8]; u32x2 na[2][8];
#define RT_LOAD(rp_) do { _Pragma("unroll") for (int rr = 0; rr < 2; ++rr) { const size_t row_ = (size_t)(2 * (rp_) + rr); const GAS f32x4* xr = (const GAS f32x4*)(X + row_ * DM) + lane; const GAS u32x2* ar = (const GAS u32x2*)(ATT + row_ * DM) + lane; \
        _Pragma("unroll") for (int j = 0; j < 8; ++j) { nx[rr][j] = xr[64 * j]; if (DBG_LEVEL >= 3) na[rr][j] = ar[64 * j]; else na[rr][j] = (u32x2){0u, 0u}; } } } while (0)
    int rp = gw;
    if (rp < NTOK / 2) RT_LOAD(rp);
    for (; rp < NTOK / 2; rp += NGW) {
        f32x4 h[2][8]; float rinv[2];
#pragma unroll
        for (int rr = 0; rr < 2; ++rr) { float s = 0.f;
#pragma unroll
            for (int j = 0; j < 8; ++j) { f32x4 v = nx[rr][j]; const u32x2 w = na[rr][j]; v.x += __uint_as_float(w.x << 16); v.y += __uint_as_float(w.x & 0xffff0000u); v.z += __uint_as_float(w.y << 16); v.w += __uint_as_float(w.y & 0xffff0000u);
                h[rr][j] = v; s += (v.x * v.x + v.y * v.y) + (v.z * v.z + v.w * v.w); }
            rinv[rr] = s; }
#if DBG_LEVEL >= 3
#pragma unroll
        for (int rr = 0; rr < 2; ++rr) { GAS u32x2* x8 = (GAS u32x2*)((bf16_t*)(a.ws + WS_ATT) + (size_t)(2 * rp + rr) * DM) + lane;
#pragma unroll
            for (int j = 0; j < 8; ++j) { u32x2 w; w.x = cvt_pk_bf16(h[rr][j].x, h[rr][j].y); w.y = cvt_pk_bf16(h[rr][j].z, h[rr][j].w); x8[64 * j] = w; } }
#endif
        { const int nrp = rp + NGW; if (nrp < NTOK / 2) RT_LOAD(nrp); }
#pragma unroll
        for (int rr = 0; rr < 2; ++rr) { rinv[rr] = 1.0f / sqrtf(wave_sum(rinv[rr]) * (1.f / DM) + EPS);
            GAS u32x2* o8 = (GAS u32x2*)(H2 + (size_t)(2 * rp + rr) * DM) + lane;
#pragma unroll
            for (int j = 0; j < 8; ++j) { const f32x4 gv = ((const GAS f32x4*)g + lane)[64 * j]; h[rr][j] = h[rr][j] * rinv[rr] * gv;
                u32x2 w; w.x = cvt_pk_bf16(h[rr][j].x, h[rr][j].y); w.y = cvt_pk_bf16(h[rr][j].z, h[rr][j].w); o8[64 * j] = w; } }
        float v[32];
#pragma unroll
        for (int e = 0; e < NEXP; ++e) { float s0 = 0.f, s1 = 0.f;
#pragma unroll
            for (int j = 0; j < 8; ++j) { const f32x4 w = *(const LAS f32x4*)(wl + e * DM + 4 * lane + 256 * j);
                s0 += (h[0][j].x * w.x + h[0][j].y * w.y) + (h[0][j].z * w.z + h[0][j].w * w.w); s1 += (h[1][j].x * w.x + h[1][j].y * w.y) + (h[1][j].z * w.z + h[1][j].w * w.w); }
            v[e] = s0; v[16 + e] = s1; }
#pragma unroll
        for (int off = 16; off >= 1; off >>= 1) { const bool up = (lane & off) != 0;
#pragma unroll
            for (int i = 0; i < off; ++i) { const float lo = v[i], hi = v[i + off]; const float keep = up ? hi : lo, send = up ? lo : hi; v[i] = keep + __shfl_xor(send, off); } }
        const float mine = v[0] + __shfl_xor(v[0], 32);
        float mx = mine; mx = fmaxf(mx, __shfl_xor(mx, 1)); mx = fmaxf(mx, __shfl_xor(mx, 2)); mx = fmaxf(mx, __shfl_xor(mx, 4)); mx = fmaxf(mx, __shfl_xor(mx, 8));
        const float ex = expf(mine - mx); float sm = ex; sm += __shfl_xor(sm, 1); sm += __shfl_xor(sm, 2); sm += __shfl_xor(sm, 4); sm += __shfl_xor(sm, 8);
        if (lane < 32) { const int row = 2 * rp + (lane >> 4), e = lane & 15, b = row >> 13, s = row & (SEQ - 1); AFF[((size_t)(b * NEXP + e)) * SEQ + s] = ex / sm; }
    }
#undef RT_LOAD
    __syncthreads();
}

__device__ __forceinline__ int block_excl_scan(int v, LAS int* sc, int tid, int& total) {
    const int lane = tid & 63, w = tid >> 6; int x = v;
#pragma unroll
    for (int o = 1; o < 64; o <<= 1) { const int y = __shfl_up(x, o); if (lane >= o) x += y; }
    __syncthreads();
    if (lane == 63) sc[w] = x;
    __syncthreads();
    int pre = 0, tot = 0;
#pragma unroll
    for (int j = 0; j < 8; ++j) { const int s = sc[j]; if (j < w) pre += s; tot += s; }
    total = tot; return pre + x - v;
}
__device__ __forceinline__ void p8_topk(const Frame& F, const Args& a) {
    const float* AFF = (const float*)(a.ws + WS_AFF); int* IDX = (int*)(a.ws + WS_IDX); float* GATEV = (float*)(a.ws + WS_GATEV); int* INV = (int*)(a.ws + WS_INV);
    LAS int* hist = (LAS int*)F.lds; LAS int* sc = hist + 256; LAS int* res = sc + 16;
    const int tid = F.tid, lane = F.lane;
    for (int list = F.vcu; list < NLIST; list += F.G) {
        const int b = list / NEXP, e = list % NEXP;
        unsigned key[16];
        { const u32x4* src = (const u32x4*)(AFF + (size_t)list * SEQ + tid * 16);
#pragma unroll
            for (int j = 0; j < 4; ++j) { const u32x4 v = src[j]; key[4 * j] = v.x; key[4 * j + 1] = v.y; key[4 * j + 2] = v.z; key[4 * j + 3] = v.w; } }
        unsigned prefix = 0u, pmask = 0u; int krem = CAP;
#pragma unroll 1
        for (int pass = 0; pass < 4; ++pass) { const int shift = 24 - 8 * pass;
            __syncthreads();
            if (tid < 256) hist[tid] = 0;
            __syncthreads();
#pragma unroll
            for (int j = 0; j < 16; ++j) if ((key[j] & pmask) == prefix) __hip_atomic_fetch_add(&hist[(key[j] >> shift) & 255u], 1, __ATOMIC_RELAXED, __HIP_MEMORY_SCOPE_WORKGROUP);
            __syncthreads();
            if (tid < 64) {
                int c[4]; int s = 0;
#pragma unroll
                for (int j = 0; j < 4; ++j) { c[j] = hist[4 * lane + j]; s += c[j]; }
                int suf = s;
#pragma unroll
                for (int o = 1; o < 64; o <<= 1) { const int y = __shfl_down(suf, o); if (lane + o < 64) suf += y; }
                const int excl = suf - s;
                if (suf >= krem && excl < krem) { int cum = excl, bin = 4 * lane, kn = krem;
#pragma unroll
                    for (int j = 3; j >= 0; --j) { if (cum < krem && cum + c[j] >= krem) { bin = 4 * lane + j; kn = krem - cum; } cum += c[j]; }
                    res[0] = bin; res[1] = kn; }
            }
            __syncthreads();
            const int bin = res[0]; krem = res[1];
            prefix |= ((unsigned)bin) << shift; pmask |= 255u << shift;
        }
        const unsigned T = prefix;
        int ceq = 0;
#pragma unroll
        for (int j = 0; j < 16; ++j) ceq += (key[j] == T) ? 1 : 0;
        int toteq; const int eqb = block_excl_scan(ceq, sc, tid, toteq);
        int csel = 0, er = eqb; unsigned selmask = 0u;
#pragma unroll
        for (int j = 0; j < 16; ++j) { bool s = key[j] > T; if (key[j] == T) { s = er < krem; ++er; } if (s) { selmask |= 1u << j; ++csel; } }
        int totsel; int pos = block_excl_scan(csel, sc, tid, totsel);
#pragma unroll
        for (int j = 0; j < 16; ++j) { const int tokpos = tid * 16 + j; int slot = -1;
            if (selmask & (1u << j)) { slot = list * CAP + pos; IDX[slot] = tokpos; GATEV[slot] = __uint_as_float(key[j]); ++pos; }
            INV[((size_t)b * SEQ + tokpos) * NEXP + e] = slot; }
        __syncthreads();
    }
}

__device__ __forceinline__ void p11_final(const Frame& F, const Args& a, bool with_moe) {
    const float* X = a.in[0]; float* OUT = a.out; const bf16_t* ATT = (const bf16_t*)(a.ws + WS_ATT); const bf16_t* Y = (const bf16_t*)(a.ws + WS_Y); const int* INV = (const int*)(a.ws + WS_INV); const float* g = a.in[16];
    const int gw = F.vcu * NWAVES + F.wave, NGW = F.G * NWAVES, lane = F.lane;
    f32x4 nx[8]; u32x2 na[8]; int ninv = -1;
#define FN_LOAD(m_) do { const GAS f32x4* xr = (const GAS f32x4*)(X + (size_t)(m_) * DM) + lane; const GAS u32x2* ar = (const GAS u32x2*)(ATT + (size_t)(m_) * DM) + lane; \
        _Pragma("unroll") for (int j = 0; j < 8; ++j) { if (DBG_LEVEL >= 3) na[j] = ar[64 * j]; else nx[j] = xr[64 * j]; } \
        ninv = (with_moe && lane < NEXP) ? INV[(size_t)(m_) * NEXP + lane] : -1; } while (0)
    int m = gw;
    if (m < NTOK) FN_LOAD(m);
    for (; m < NTOK; m += NGW) {
        f32x4 v[8]; const int myinv = ninv;
#pragma unroll
        for (int j = 0; j < 8; ++j) { if (DBG_LEVEL >= 3) { const u32x2 w = na[j]; v[j].x = __uint_as_float(w.x << 16); v[j].y = __uint_as_float(w.x & 0xffff0000u); v[j].z = __uint_as_float(w.y << 16); v[j].w = __uint_as_float(w.y & 0xffff0000u); } else v[j] = nx[j]; }
        unsigned long long mask = __ballot(myinv >= 0);
        u32x2 y0[8]; const bool has0 = mask != 0ull;
        if (has0) { const int e = __builtin_ctzll(mask); mask &= mask - 1; const int slot = __builtin_amdgcn_readlane(myinv, e); const GAS u32x2* yr = (const GAS u32x2*)(Y + (size_t)slot * DM) + lane;
#pragma unroll
            for (int j = 0; j < 8; ++j) y0[j] = yr[64 * j]; }
        { const int nm = m + NGW; if (nm < NTOK) FN_LOAD(nm); }
        if (has0) {
#pragma unroll
            for (int j = 0; j < 8; ++j) { const u32x2 w = y0[j]; v[j].x += __uint_as_float(w.x << 16); v[j].y += __uint_as_float(w.x & 0xffff0000u); v[j].z += __uint_as_float(w.y << 16); v[j].w += __uint_as_float(w.y & 0xffff0000u); } }
        while (mask) { const int e = __builtin_ctzll(mask); mask &= mask - 1; const int slot = __builtin_amdgcn_readlane(myinv, e);
            const GAS u32x2* yr = (const GAS u32x2*)(Y + (size_t)slot * DM) + lane;
#pragma unroll
            for (int j = 0; j < 8; ++j) { const u32x2 w = yr[64 * j]; v[j].x += __uint_as_float(w.x << 16); v[j].y += __uint_as_float(w.x & 0xffff0000u); v[j].z += __uint_as_float(w.y << 16); v[j].w += __uint_as_float(w.y & 0xffff0000u); } }
        float s = 0.f;
#pragma unroll
        for (int j = 0; j < 8; ++j) s += (v[j].x * v[j].x + v[j].y * v[j].y) + (v[j].z * v[j].z + v[j].w * v[j].w);
        const float rinv = 1.0f / sqrtf(wave_sum(s) * (1.f / DM) + EPS);
        GAS f32x4* orow = (GAS f32x4*)(OUT + (size_t)m * DM) + lane;
#pragma unroll
        for (int j = 0; j < 8; ++j) { const f32x4 gv = ((const GAS f32x4*)g + lane)[64 * j]; orow[64 * j] = v[j] * rinv * gv; }
    }
#undef FN_LOAD
}
__device__ __forceinline__ void p_copy_x(const Frame& F, const Args& a) {
    const f32x4* src = (const f32x4*)a.in[0]; f32x4* dst = (f32x4*)a.out;
    for (size_t i = (size_t)blockIdx.x * 512 + F.tid; i < (size_t)NTOK * DM / 4; i += (size_t)F.G * 512) dst[i] = src[i];
}

constexpr int NPHASE = 10;
__global__ void __launch_bounds__(NWAVES * 64, 2) fwd_kernel(Args args) {
    extern __shared__ __attribute__((aligned(16))) unsigned char lds[];
    Frame F;
    F.lds = (LAS unsigned char*)lds;
    F.tid = threadIdx.x; F.lane = F.tid & 63; F.wave = __builtin_amdgcn_readfirstlane(F.tid >> 6);
    F.G = gridDim.x; { const int bx = blockIdx.x; F.vcu = (F.G % 8 == 0) ? (bx % 8) * (F.G / 8) + bx / 8 : bx; }
    unsigned char* ws = args.ws;
    gu32* ctl = (gu32*)(ws + WS_CTL);
    for (int u = F.tid; u < (LDS_BYTES - LDSCTL_OFF) / 4; u += NWAVES * 64) ((LAS unsigned*)(F.lds + LDSCTL_OFF))[u] = 0u;
    __syncthreads();
    XcdBarrier bar; bar.bar = (unsigned*)(ctl + CW_BAR); bar.x = 0; bar.st = nullptr;
    if (MK_N_LAUNCHES == 1) bar = xcd_barrier_post((unsigned*)(ctl + CW_BAR), (volatile LAS unsigned*)(F.lds + LDSCTL_OFF + 64));
    const int lo = args.ph_lo, hi = args.ph_hi;
#define IN(k) (lo <= (k) && (k) < hi)
#define SEAM(k) do { if (IN(k) && IN((k) + 1)) xcd_barrier(bar); } while (0)

    if (IN(0)) { for (int rep = 0; rep < REPS(0); ++rep) p0_prologue(F, args); }
    SEAM(0);
    if (IN(1)) {
#if DBG_LEVEL >= 3
        pg8::DenseProb<DM> P; P.A = (const bf16_t*)(ws + WS_H); P.Bt = (const bf16_t*)(ws + WS_WIN); P.S.init(NTOK, INW, F.G, (int)blockIdx.x);
        pg8::EpiInProj E{(bf16_t*)(ws + WS_QA), (bf16_t*)(ws + WS_KA), (bf16_t*)(ws + WS_VA), (bf16_t*)(ws + WS_QB), (bf16_t*)(ws + WS_KB), (bf16_t*)(ws + WS_VB), (bf16_t*)(ws + WS_GA), (bf16_t*)(ws + WS_GB), args.in[3]};
        for (int rep = 0; rep < REPS(1); ++rep) pg8::gemm_phase<pg8::EpiInProj, pg8::DenseProb<DM>, true>(F.lds, P, E);
#endif
    }
    SEAM(1);
    if (IN(2)) {
#if DBG_LEVEL >= 4
        p2_qkprep(F, args);
#endif
    }
    SEAM(2);
    if (IN(3)) {
#if DBG_LEVEL >= 4
        for (int rep = 0; rep < REPS(3); ++rep) p3_attention<0>(F, args, (char*)lds);
#endif
#if DBG_LEVEL >= 3
        __syncthreads();
        for (int rep = 0; rep < REPS(13); ++rep) p3_attention<1>(F, args, (char*)lds);
        __syncthreads();
#endif
    }
    SEAM(3);
    if (IN(4)) {
#if DBG_LEVEL >= 4
        { pg8::DenseProb<QW> P; P.A = (const bf16_t*)(ws + WS_OA); P.Bt = (const bf16_t*)(ws + WS_WPA); P.S.init(NTOK, DM, F.G, (int)blockIdx.x);
          pg8::EpiGated<0> E{(bf16_t*)(ws + WS_GA), nullptr};
          pg8::gemm_phase<pg8::EpiGated<0>, pg8::DenseProb<QW>, true>(F.lds, P, E); }
        { pg8::DenseProb<QW> P; P.A = (const bf16_t*)(ws + WS_OB); P.Bt = (const bf16_t*)(ws + WS_WPB); P.S.init(NTOK, DM, F.G, (int)blockIdx.x);
          pg8::EpiGated<1> E{(bf16_t*)(ws + WS_GA), (const bf16_t*)(ws + WS_GB)};
          pg8::gemm_phase<pg8::EpiGated<1>, pg8::DenseProb<QW>, true>(F.lds, P, E); }
#elif DBG_LEVEL >= 3
        { pg8::DenseProb<QW> P; P.A = (const bf16_t*)(ws + WS_OB); P.Bt = (const bf16_t*)(ws + WS_WPB); P.S.init(NTOK, DM, F.G, (int)blockIdx.x);
          pg8::EpiGated<2> E{(bf16_t*)(ws + WS_GA), (const bf16_t*)(ws + WS_GB)};
          pg8::gemm_phase<pg8::EpiGated<2>, pg8::DenseProb<QW>, true>(F.lds, P, E); }
#endif
    }
    SEAM(4);
    if (IN(5)) {
#if DBG_LEVEL >= 3
        pg8::DenseProb<DM> P; P.A = (const bf16_t*)(ws + WS_GA); P.Bt = (const bf16_t*)(ws + WS_WO); P.S.init(NTOK, DM, F.G, (int)blockIdx.x);
        pg8::EpiAtt E{(bf16_t*)(ws + WS_ATT)};
        for (int rep = 0; rep < REPS(5); ++rep) pg8::gemm_phase<pg8::EpiAtt, pg8::DenseProb<DM>, true>(F.lds, P, E);
#endif
    }
    SEAM(5);
    if (IN(6)) {
#if DBG_LEVEL >= 2
        for (int rep = 0; rep < REPS(6); ++rep) p7_router(F, args);
#endif
    }
    SEAM(6);
    if (IN(7)) {
#if DBG_LEVEL >= 2
        for (int rep = 0; rep < REPS(7); ++rep) p8_topk(F, args);
        __syncthreads();
        p_moe_weights(F, args);
#endif
    }
    SEAM(7);
    if (IN(8)) {
#if DBG_LEVEL >= 2
        LAS unsigned* rowoff = (LAS unsigned*)(F.lds + pg8::STAGE_BYTES);
        const int* IDX = (const int*)(ws + WS_IDX);
        for (int i = 0; i < 8; ++i) { pg8::Unit u; int e, b; if (!pg8::moe_unit(i, F.G, F.vcu, u, e, b)) break;
            if (F.tid < 256) rowoff[i * 256 + F.tid] = (unsigned)IDX[u.pm * 256 + F.tid] * (unsigned)(DM * 2); }
        __syncthreads();
        pg8::GuProb P; P.H2 = (const bf16_t*)(ws + WS_H); P.W = (const bf16_t*)(ws + WS_WGU); P.rowoff = rowoff; P.G = F.G; P.vcu = F.vcu;
        pg8::EpiSwiglu E{(bf16_t*)(ws + WS_GA)};
        for (int rep = 0; rep < REPS(8); ++rep) pg8::gemm_phase<pg8::EpiSwiglu, pg8::GuProb, true>(F.lds, P, E);
#endif
    }
    SEAM(8);
    if (IN(9)) {
#if DBG_LEVEL >= 2
        pg8::DownProb P; P.HID = (const bf16_t*)(ws + WS_GA); P.W = (const bf16_t*)(ws + WS_WD); P.G = F.G; P.vcu = F.vcu;
        pg8::EpiDown E{(bf16_t*)(ws + WS_Y), (const float*)(ws + WS_GATEV)};
        for (int rep = 0; rep < REPS(9); ++rep) pg8::gemm_phase<pg8::EpiDown, pg8::DownProb, true>(F.lds, P, E);
#endif
    }
    SEAM(9);
    if (IN(10)) { p11_final(F, args, DBG_LEVEL >= 2); }
#undef IN
#undef SEAM
}

extern "C" void kernel_launch(void* const* d_in, const int* in_sizes, int n_in, void* d_out, int out_size, void* d_ws, size_t ws_size, hipStream_t stream) {
    static int grid = 0;
    if (grid == 0) {
        if (n_in != 17 || in_sizes[0] != NTOK * DM || out_size != NTOK * DM || ws_size < WS_END) { fprintf(stderr, "kernel_launch: unexpected shapes (n_in %d, in0 %d, out %d, ws %zu); nothing launched\n", n_in, n_in > 0 ? in_sizes[0] : -1, out_size, ws_size); grid = -1; return; }
        int dev = 0, cus = 0, per_cu = 0;
        if (hipGetDevice(&dev) != hipSuccess || hipDeviceGetAttribute(&cus, hipDeviceAttributeMultiprocessorCount, dev) != hipSuccess) { grid = -1; return; }
        if (hipFuncSetAttribute((const void*)fwd_kernel, hipFuncAttributeMaxDynamicSharedMemorySize, LDS_BYTES) != hipSuccess) { fprintf(stderr, "kernel_launch: hipFuncSetAttribute failed\n"); grid = -1; return; }
        if (hipOccupancyMaxActiveBlocksPerMultiprocessor(&per_cu, (const void*)fwd_kernel, NWAVES * 64, LDS_BYTES) != hipSuccess || per_cu < 1)
            fprintf(stderr, "kernel_launch: note: occupancy query reports %d workgroups per CU\n", per_cu);
        (void)hipGetLastError();
        grid = cus;
    }
    if (grid < 0) return;
    (void)hipMemsetAsync((char*)d_ws + WS_CTL, 0, CTL_ZERO_BYTES, stream);
    Args a{};
    for (int i = 0; i < 17; ++i) a.in[i] = (const float*)d_in[i];
    a.out = (float*)d_out; a.ws = (unsigned char*)d_ws;
#if MK_N_LAUNCHES == 1
    a.ph_lo = 0; a.ph_hi = NPHASE + 1; a.li = 0;
    hipLaunchKernelGGL(fwd_kernel, dim3(grid), dim3(NWAVES * 64), LDS_BYTES, stream, a);
#else
    for (int li = 0; li <= NPHASE; ++li) { a.ph_lo = li; a.ph_hi = li + 1; a.li = li;
        hipLaunchKernelGGL(fwd_kernel, dim3(grid), dim3(NWAVES * 64), LDS_BYTES, stream, a); }
#endif
    const hipError_t le = hipPeekAtLastError();
    if (le != hipSuccess) fprintf(stderr, "kernel_launch: launch failed: %s\n", hipGetErrorName(le));
}
```

```cpp
#include <hip/hip_runtime.h>
#include <cstdio>
#include <cstdint>

#ifndef MK_N_LAUNCHES
#define MK_N_LAUNCHES 1
#endif
#ifndef DBG_LEVEL
#define DBG_LEVEL 4
#endif

#ifndef REP_PHASE
#define REP_PHASE -1
#endif
#define REPS(k) ((REP_PHASE == (k)) ? 2 : 1)
#define GAS __attribute__((address_space(1)))
#define LAS __attribute__((address_space(3)))
typedef unsigned short bf16_t;
typedef short bf16x8 __attribute__((ext_vector_type(8)));
typedef short s16x4 __attribute__((ext_vector_type(4)));
typedef float f32x2 __attribute__((ext_vector_type(2)));
typedef float f32x4 __attribute__((ext_vector_type(4)));
typedef float f32x8 __attribute__((ext_vector_type(8)));
typedef float f32x16 __attribute__((ext_vector_type(16)));
typedef unsigned u32x2 __attribute__((ext_vector_type(2)));
typedef unsigned u32x4 __attribute__((ext_vector_type(4)));
typedef GAS unsigned gu32;

constexpr int BATCH = 4, SEQ = 8192, DM = 2048, NTOK = BATCH * SEQ, HD = 128;
constexpr int NHA = 8, NHB = 8;
constexpr int QW = 1024, KVW = 256, INW = 7168;
constexpr int NEXP = 16, CAP = 1024, DFF = 1024, NLIST = BATCH * NEXP, NSLOT = NLIST * CAP;
constexpr float EPS = 1e-6f, LOG2E = 1.4426950408889634f;

constexpr size_t MiB = 1u << 20;
constexpr size_t WS_CTL = 0, CTL_ZERO_BYTES = 1 * MiB;
constexpr size_t WS_ROPE = 1 * MiB;
constexpr size_t WS_AFF = 2 * MiB;
constexpr size_t WS_IDX = 4 * MiB;
constexpr size_t WS_GATEV = 4 * MiB + 256 * 1024;
constexpr size_t WS_INV = 5 * MiB;
constexpr size_t WS_WIN = 8 * MiB;
constexpr size_t WS_WPA = 36 * MiB;
constexpr size_t WS_WPB = 40 * MiB;
constexpr size_t WS_WO = 44 * MiB;
constexpr size_t WS_WGU = 52 * MiB;
constexpr size_t WS_WD = 180 * MiB;
constexpr size_t WS_H = 244 * MiB;
constexpr size_t WS_GA = 372 * MiB;
constexpr size_t WS_GB = 500 * MiB;
constexpr size_t WS_QA = 628 * MiB, WS_KA = 692 * MiB, WS_VA = 708 * MiB, WS_QB = 724 * MiB, WS_KB = 788 * MiB, WS_VB = 804 * MiB;
constexpr size_t WS_Y = 500 * MiB;
constexpr size_t WS_OA = 820 * MiB, WS_OB = 884 * MiB;
constexpr size_t WS_ATT = 820 * MiB;
constexpr size_t WS_K8 = 948 * MiB;
constexpr size_t WS_V8T = 956 * MiB;
constexpr size_t WS_END = 964 * MiB;
constexpr int CW_TMO = 0;
constexpr int CW_BAR = 4096;

constexpr int LDS_SCRATCH = 155648;
constexpr int LDSCTL_OFF = LDS_SCRATCH;
constexpr int LDS_BYTES = LDS_SCRATCH + 512;

__device__ __forceinline__ unsigned cvt_pk_bf16(float lo, float hi) { unsigned r; asm volatile("v_cvt_pk_bf16_f32 %0, %1, %2" : "=v"(r) : "v"(lo), "v"(hi)); return r; }
__device__ __forceinline__ float bf2f(unsigned short v) { return __uint_as_float(((unsigned)v) << 16); }
__device__ __forceinline__ unsigned short f2bf(float f) { return (unsigned short)(cvt_pk_bf16(f, 0.f) & 0xffffu); }
__device__ __forceinline__ float wave_sum(float v) {
#pragma unroll
    for (int o = 1; o < 64; o <<= 1) v += __shfl_xor(v, o);
    return v;
}
__device__ __forceinline__ float sigmoidf_fast(float z) { return __builtin_amdgcn_rcpf(1.f + __builtin_amdgcn_exp2f(-z * LOG2E)); }
#define LDS_WAIT() asm volatile("s_waitcnt lgkmcnt(0)" ::: "memory")
#define VM_WAIT() asm volatile("s_waitcnt vmcnt(0)" ::: "memory")

namespace pg8 {
constexpr int BM = 256, BK = 64, HALF = 128, HTB = HALF * BK * 2, STAGE_BYTES = 8 * HTB;
__host__ __device__ __forceinline__ int lds_byte(int r, int c) { const int st = (r >> 4) * 2 + (c >> 5), rr = r & 15, cc = c & 31, ob = rr * 64 + cc * 2; return st * 1024 + (ob ^ (((ob >> 9) & 1) << 5)); }
__host__ __device__ __forceinline__ void stage_rc(int b, int& R, int& C) { const int st = b / 1024, sb = b % 1024, swz = sb ^ (((sb >> 9) & 1) << 5); R = (st >> 1) * 16 + swz / 64; C = (st & 1) * 32 + (swz % 64) / 2; }
__host__ __device__ __forceinline__ int perm32(int rho) { const int n = rho >> 4, i = rho & 15; return 8 * (i >> 2) + 4 * n + (i & 3); }

struct Unit { int pm, pn, ord; };

struct StaticOrder {
    int nM, nN, nwg, G, c;
    __device__ void init(int M, int N, int G_, int c_) { nM = M / BM; nN = N / BM; nwg = nM * nN; G = G_; c = c_; }
    __device__ bool next(int i, Unit& u) const {
        const long L = (long)i * G + c; if (L >= nwg) return false;
        int wgid = (int)L; { const int q = nwg / 8, r = nwg % 8, xcd = wgid % 8, off = wgid / 8; wgid = (xcd < r ? xcd * (q + 1) : r * (q + 1) + (xcd - r) * q) + off; }
        const int nig = 8 * nN, gid = wgid / nig, fm = gid * 8, gsz = (nM - fm) < 8 ? (nM - fm) : 8;
        u.pm = fm + ((wgid % nig) % gsz); u.pn = (wgid % nig) / gsz; u.ord = i; return true;
    }
};

template <class Epi, class Prob, bool ALIGN_EPI>
__device__ __forceinline__ void gemm_phase(LAS unsigned char* lds, const Prob& P, const Epi& E) {
    const int tid = threadIdx.x, wid = __builtin_amdgcn_readfirstlane(tid >> 6), lane = tid & 63, wr = wid >> 2, wc = wid & 3, fr = lane & 15, fq = lane >> 4;
    constexpr int K = Prob::K, nt = K / BK;
    int Rs[2], Cs[2]; unsigned voffB[2];
#pragma unroll
    for (int i = 0; i < 2; ++i) { int R, C; stage_rc(tid * 16 + i * 8192, R, C); const int Rb = Epi::PERM ? ((R & ~31) + perm32(R & 31)) : R;
        Rs[i] = R; Cs[i] = C; voffB[i] = (unsigned)(Rb * K + C) * 2u; }
    constexpr size_t kstep = (size_t)(BK * 2);
    constexpr size_t hstepB = (size_t)HALF * K * 2;
    const unsigned ldsw = (unsigned)wid * 1024u;
    const int aoff = lds_byte(wr * 64 + fr, fq * 8), boff = lds_byte(wc * 32 + fr, fq * 8);
#define PG8_SA(b, h) (((b) * 2 + (h)) * HTB)
#define PG8_SB(b, h) ((4 + (b) * 2 + (h)) * HTB)
#define PG8_STAGE(bufoff, gbase, voff) do { _Pragma("unroll") for (int _i = 0; _i < 2; ++_i) \
        __builtin_amdgcn_global_load_lds((const unsigned*)((const char*)(gbase) + (voff)[_i]), (LAS unsigned*)(lds + (bufoff) + ldsw + _i * 8192), 16, 0, 0); } while (0)
#define PG8_LDA(dst, b, h) do { _Pragma("unroll") for (int m = 0; m < 4; ++m) _Pragma("unroll") for (int k = 0; k < 2; ++k) dst[m][k] = *(const LAS bf16x8*)(lds + PG8_SA(b, h) + aoff + m * 2048 + k * 1024); } while (0)
#define PG8_LDB(dst, b, h) do { _Pragma("unroll") for (int n = 0; n < 2; ++n) _Pragma("unroll") for (int k = 0; k < 2; ++k) dst[n][k] = *(const LAS bf16x8*)(lds + PG8_SB(b, h) + boff + n * 2048 + k * 1024); } while (0)
#define PG8_MMA(ai, bj, At, Bt) do { __builtin_amdgcn_s_setprio(1); _Pragma("unroll") for (int m = 0; m < 4; ++m) _Pragma("unroll") for (int n = 0; n < 2; ++n) _Pragma("unroll") for (int k = 0; k < 2; ++k) \
        acc[ai][bj][m][n] = __builtin_amdgcn_mfma_f32_16x16x32_bf16(Bt[n][k], At[m][k], acc[ai][bj][m][n], 0, 0, 0); __builtin_amdgcn_s_setprio(0); } while (0)
#define PG8_WAIT_V(n) asm volatile("s_waitcnt vmcnt(" #n ")" ::: "memory")
#define PG8_WAIT_L(n) asm volatile("s_waitcnt lgkmcnt(" #n ")" ::: "memory")
#define PG8_BAR __builtin_amdgcn_s_barrier()
#define PG8_SCHED __builtin_amdgcn_sched_barrier(0)
    Unit cur, nxt; int ui = 0;
    if (!P.next(0, cur)) return;
    unsigned vAc[2][2], vAn[2][2];
    P.a_voff(cur, Rs, Cs, vAc);
    f32x4 acc[2][2][4][2];
#pragma unroll
    for (int a = 0; a < 2; ++a)
#pragma unroll
        for (int b = 0; b < 2; ++b)
#pragma unroll
            for (int m = 0; m < 4; ++m)
#pragma unroll
                for (int n = 0; n < 2; ++n) acc[a][b][m][n] = (f32x4){0.f, 0.f, 0.f, 0.f};
    bf16x8 At[4][2], B0[2][2], B1[2][2];
    const char* cA = P.a_base(cur); const char* cB = P.b_base(cur);
    PG8_STAGE(PG8_SB(0, 0), cB, voffB); PG8_STAGE(PG8_SB(0, 1), cB + hstepB, voffB); PG8_STAGE(PG8_SA(0, 0), cA, vAc[0]); PG8_STAGE(PG8_SA(0, 1), cA, vAc[1]);
    if (wr == 1) PG8_BAR;
    PG8_WAIT_V(2); PG8_BAR;
    PG8_STAGE(PG8_SB(1, 0), cB + kstep, voffB); PG8_STAGE(PG8_SA(1, 0), cA + kstep, vAc[0]); PG8_STAGE(PG8_SB(1, 1), cB + hstepB + kstep, voffB);
    PG8_WAIT_V(6); PG8_BAR;
    for (;;) {
        const bool has_next = P.next(ui + 1, nxt);
        const char* nA = has_next ? P.a_base(nxt) : cA; const char* nB = has_next ? P.b_base(nxt) : cB;
        if (has_next) P.a_voff(nxt, Rs, Cs, vAn);
        else { vAn[0][0] = vAc[0][0]; vAn[0][1] = vAc[0][1]; vAn[1][0] = vAc[1][0]; vAn[1][1] = vAc[1][1]; }
        for (int t = 0; t < nt; t += 2) {
            const bool last = (t == nt - 2);
            const char* a1 = cA + (size_t)(t + 1) * kstep;
            const char* a2 = last ? nA : cA + (size_t)(t + 2) * kstep; const char* b2 = last ? nB : cB + (size_t)(t + 2) * kstep;
            const char* a3 = a2 + kstep; const char* b3 = b2 + kstep;
            unsigned va2[2][2];
            va2[0][0] = last ? vAn[0][0] : vAc[0][0]; va2[0][1] = last ? vAn[0][1] : vAc[0][1]; va2[1][0] = last ? vAn[1][0] : vAc[1][0]; va2[1][1] = last ? vAn[1][1] : vAc[1][1];
            PG8_LDB(B0, 0, 0); PG8_LDB(B1, 0, 1); PG8_SCHED; PG8_LDA(At, 0, 0); PG8_STAGE(PG8_SA(1, 1), a1, vAc[1]);
            PG8_WAIT_V(8); PG8_WAIT_L(0); PG8_BAR; PG8_MMA(0, 0, At, B0); PG8_MMA(0, 1, At, B1); PG8_BAR; PG8_SCHED;
            PG8_LDA(At, 0, 1); PG8_STAGE(PG8_SB(0, 0), b2, voffB); PG8_STAGE(PG8_SB(0, 1), b2 + hstepB, voffB); PG8_STAGE(PG8_SA(0, 0), a2, va2[0]);
            PG8_WAIT_V(8); PG8_WAIT_L(0); PG8_BAR; PG8_MMA(1, 0, At, B0); PG8_MMA(1, 1, At, B1); PG8_BAR; PG8_SCHED;
            PG8_LDB(B0, 1, 0); PG8_LDB(B1, 1, 1); PG8_SCHED; PG8_LDA(At, 1, 0); PG8_STAGE(PG8_SA(0, 1), a2, va2[1]);
            PG8_WAIT_V(8); PG8_WAIT_L(0); PG8_BAR; PG8_MMA(0, 0, At, B0); PG8_MMA(0, 1, At, B1); PG8_BAR; PG8_SCHED;
            PG8_LDA(At, 1, 1); PG8_STAGE(PG8_SB(1, 0), b3, voffB); PG8_STAGE(PG8_SB(1, 1), b3 + hstepB, voffB); PG8_STAGE(PG8_SA(1, 0), a3, va2[0]);
            PG8_WAIT_V(8); PG8_WAIT_L(0); PG8_BAR; PG8_MMA(1, 0, At, B0); PG8_MMA(1, 1, At, B1); PG8_BAR; PG8_SCHED;
        }
        if constexpr (ALIGN_EPI) { if (wr == 0) PG8_BAR; }
        E(acc, cur, wr, wc, fr, fq);
        if (!has_next) break;
#pragma unroll
        for (int a = 0; a < 2; ++a)
#pragma unroll
            for (int b = 0; b < 2; ++b)
#pragma unroll
                for (int m = 0; m < 4; ++m)
#pragma unroll
                    for (int n = 0; n < 2; ++n) acc[a][b][m][n] = (f32x4){0.f, 0.f, 0.f, 0.f};
        cur = nxt; cA = nA; cB = nB; ++ui;
        vAc[0][0] = vAn[0][0]; vAc[0][1] = vAn[0][1]; vAc[1][0] = vAn[1][0]; vAc[1][1] = vAn[1][1];
        if constexpr (ALIGN_EPI) { if (wr == 1) PG8_BAR; }
    }
    PG8_WAIT_V(0);
    if constexpr (!ALIGN_EPI) { if (wr == 0) PG8_BAR; }
    PG8_BAR;
#undef PG8_SA
#undef PG8_SB
#undef PG8_STAGE
#undef PG8_LDA
#undef PG8_LDB
#undef PG8_MMA
#undef PG8_WAIT_V
#undef PG8_WAIT_L
#undef PG8_BAR
#undef PG8_SCHED
}

template <int K_> struct DenseProb {
    static constexpr int K = K_;
    const bf16_t* A; const bf16_t* Bt; StaticOrder S;
    __device__ __forceinline__ bool next(int i, Unit& u) const { return S.next(i, u); }
    __device__ __forceinline__ const char* a_base(const Unit& u) const { return (const char*)(A + (size_t)u.pm * BM * K); }
    __device__ __forceinline__ const char* b_base(const Unit& u) const { return (const char*)(Bt + (size_t)u.pn * BM * K); }
    __device__ __forceinline__ void a_voff(const Unit&, const int (&Rs)[2], const int (&Cs)[2], unsigned (&vo)[2][2]) const {
#pragma unroll
        for (int h = 0; h < 2; ++h)
#pragma unroll
            for (int i = 0; i < 2; ++i) vo[h][i] = (unsigned)((h * HALF + Rs[i]) * K + Cs[i]) * 2u;
    }
};
__device__ __forceinline__ bool moe_unit(int i, int G, int vcu, Unit& u, int& e, int& b) {
    const int L = i * G + vcu; if (L >= 2048) return false;
    const int x = (L & 255) >> 5, w = L & 31, r = L >> 8;
    e = 2 * x + (r >> 2); b = r & 3; u.pm = (b * NEXP + e) * 4 + (w >> 3); u.pn = w & 7; u.ord = i; return true;
}
struct GuProb {
    static constexpr int K = DM;
    const bf16_t* H2; const bf16_t* W; const LAS unsigned* rowoff; int G, vcu;
    __device__ __forceinline__ bool next(int i, Unit& u) const { int e, b; return moe_unit(i, G, vcu, u, e, b); }
    __device__ __forceinline__ const char* a_base(const Unit& u) const { const int b = (u.pm >> 2) / NEXP; return (const char*)(H2 + (size_t)b * SEQ * DM); }
    __device__ __forceinline__ const char* b_base(const Unit& u) const { const int e = (u.pm >> 2) % NEXP; return (const char*)(W + ((size_t)e * 2048 + (size_t)u.pn * BM) * DM); }
    __device__ __forceinline__ void a_voff(const Unit& u, const int (&Rs)[2], const int (&Cs)[2], unsigned (&vo)[2][2]) const {
#pragma unroll
        for (int h = 0; h < 2; ++h)
#pragma unroll
            for (int i = 0; i < 2; ++i) vo[h][i] = rowoff[u.ord * 256 + h * HALF + Rs[i]] + (unsigned)Cs[i] * 2u;
    }
};
struct DownProb {
    static constexpr int K = DFF;
    const bf16_t* HID; const bf16_t* W; int G, vcu;
    __device__ __forceinline__ bool next(int i, Unit& u) const { int e, b; return moe_unit(i, G, vcu, u, e, b); }
    __device__ __forceinline__ const char* a_base(const Unit& u) const { return (const char*)(HID + (size_t)u.pm * BM * DFF); }
    __device__ __forceinline__ const char* b_base(const Unit& u) const { const int e = (u.pm >> 2) % NEXP; return (const char*)(W + ((size_t)e * 2048 + (size_t)u.pn * BM) * DFF); }
    __device__ __forceinline__ void a_voff(const Unit&, const int (&Rs)[2], const int (&Cs)[2], unsigned (&vo)[2][2]) const {
#pragma unroll
        for (int h = 0; h < 2; ++h)
#pragma unroll
            for (int i = 0; i < 2; ++i) vo[h][i] = (unsigned)((h * HALF + Rs[i]) * DFF + Cs[i]) * 2u;
    }
};

typedef const f32x4 (&AccRef)[2][2][4][2];
struct EpiInProj {
    static constexpr bool PERM = true;
    bf16_t *QA, *KA, *VA, *QB, *KB, *VB, *GA, *GB; const float* bgate;
    __device__ __forceinline__ void operator()(AccRef acc, const Unit& u, int wr, int wc, int fr, int fq) const {
        const int pn = u.pn; bf16_t* base; int ldc, colt; bool gate = false;
        if (pn < 4) { base = QA; ldc = QW; colt = pn * 256; }
        else if (pn == 4) { base = KA; ldc = KVW; colt = 0; }
        else if (pn == 5) { base = VA; ldc = KVW; colt = 0; }
        else if (pn < 10) { base = QB; ldc = QW; colt = (pn - 6) * 256; }
        else if (pn == 10) { base = KB; ldc = KVW; colt = 0; }
        else if (pn == 11) { base = VB; ldc = KVW; colt = 0; }
        else if (pn < 20) { base = GA; ldc = DM; colt = (pn - 12) * 256; gate = true; }
        else { base = GB; ldc = DM; colt = (pn - 20) * 256; gate = true; }
        const int row0 = u.pm * BM + wr * 64 + fr, col0 = colt + wc * 32 + 8 * fq;
        f32x4 bv[2][2];
#pragma unroll
        for (int bj = 0; bj < 2; ++bj)
#pragma unroll
            for (int n = 0; n < 2; ++n) bv[bj][n] = gate ? *(const f32x4*)(bgate + (pn - 12) * 256 + wc * 32 + 8 * fq + bj * HALF + 4 * n) : (f32x4){0.f, 0.f, 0.f, 0.f};
#pragma unroll
        for (int ai = 0; ai < 2; ++ai)
#pragma unroll
            for (int m = 0; m < 4; ++m) { bf16_t* rowp = base + (size_t)(row0 + ai * HALF + m * 16) * ldc + col0;
#pragma unroll
                for (int bj = 0; bj < 2; ++bj) { f32x4 v0 = acc[ai][bj][m][0] + bv[bj][0], v1 = acc[ai][bj][m][1] + bv[bj][1];
                    if (gate) {
#pragma unroll
                        for (int j = 0; j < 4; ++j) { v0[j] = sigmoidf_fast(v0[j]); v1[j] = sigmoidf_fast(v1[j]); } }
                    u32x4 w; w.x = cvt_pk_bf16(v0[0], v0[1]); w.y = cvt_pk_bf16(v0[2], v0[3]); w.z = cvt_pk_bf16(v1[0], v1[1]); w.w = cvt_pk_bf16(v1[2], v1[3]);
                    *(u32x4*)(rowp + bj * HALF) = w; } }
    }
};
template <int MODE> struct EpiGated {
    static constexpr bool PERM = true;
    bf16_t* G1; const bf16_t* G2;
    __device__ __forceinline__ void operator()(AccRef acc, const Unit& u, int wr, int wc, int fr, int fq) const {
        const int row0 = u.pm * BM + wr * 64 + fr, col0 = u.pn * BM + wc * 32 + 8 * fq;
#pragma unroll
        for (int ai = 0; ai < 2; ++ai)
#pragma unroll
            for (int m = 0; m < 4; ++m) { const size_t off = (size_t)(row0 + ai * HALF + m * 16) * DM + col0;
#pragma unroll
                for (int bj = 0; bj < 2; ++bj) {
                    const bf16x8 g1 = (MODE == 2) ? (bf16x8){0, 0, 0, 0, 0, 0, 0, 0} : *(const bf16x8*)(G1 + off + bj * HALF);
                    bf16x8 g2 = g1; if (MODE >= 1) g2 = *(const bf16x8*)(G2 + off + bj * HALF);
                    float o[8];
#pragma unroll
                    for (int j = 0; j < 8; ++j) { const float a = acc[ai][bj][m][j >> 2][j & 3];
                        if (MODE == 0) o[j] = bf2f((unsigned short)g1[j]) * a;
                        else if (MODE == 1) o[j] = bf2f((unsigned short)g1[j]) + bf2f((unsigned short)g2[j]) * a;
                        else o[j] = bf2f((unsigned short)g2[j]) * a; }
                    u32x4 w; w.x = cvt_pk_bf16(o[0], o[1]); w.y = cvt_pk_bf16(o[2], o[3]); w.z = cvt_pk_bf16(o[4], o[5]); w.w = cvt_pk_bf16(o[6], o[7]);
                    *(u32x4*)(G1 + off + bj * HALF) = w; } }
    }
};
struct EpiAtt {
    static constexpr bool PERM = true;
    bf16_t* O;
    __device__ __forceinline__ void operator()(AccRef acc, const Unit& u, int wr, int wc, int fr, int fq) const {
        const int row0 = u.pm * BM + wr * 64 + fr, col0 = u.pn * BM + wc * 32 + 8 * fq;
#pragma unroll
        for (int ai = 0; ai < 2; ++ai)
#pragma unroll
            for (int m = 0; m < 4; ++m) { bf16_t* rowp = O + (size_t)(row0 + ai * HALF + m * 16) * DM + col0;
#pragma unroll
                for (int bj = 0; bj < 2; ++bj) { const f32x4 v0 = acc[ai][bj][m][0], v1 = acc[ai][bj][m][1];
                    u32x4 w; w.x = cvt_pk_bf16(v0[0], v0[1]); w.y = cvt_pk_bf16(v0[2], v0[3]); w.z = cvt_pk_bf16(v1[0], v1[1]); w.w = cvt_pk_bf16(v1[2], v1[3]);
                    *(u32x4*)(rowp + bj * HALF) = w; } }
    }
};
struct EpiSwiglu {
    static constexpr bool PERM = true;
    bf16_t* HID;
    __device__ __forceinline__ void operator()(AccRef acc, const Unit& u, int wr, int wc, int fr, int fq) const {
        const int row0 = u.pm * BM + wr * 64 + fr, col0 = u.pn * HALF + wc * 32 + 8 * fq;
#pragma unroll
        for (int ai = 0; ai < 2; ++ai)
#pragma unroll
            for (int m = 0; m < 4; ++m) { float o[8];
#pragma unroll
                for (int j = 0; j < 8; ++j) { const float a = acc[ai][0][m][j >> 2][j & 3], up = acc[ai][1][m][j >> 2][j & 3]; o[j] = a * sigmoidf_fast(a) * up; }
                u32x4 w; w.x = cvt_pk_bf16(o[0], o[1]); w.y = cvt_pk_bf16(o[2], o[3]); w.z = cvt_pk_bf16(o[4], o[5]); w.w = cvt_pk_bf16(o[6], o[7]);
                *(u32x4*)(HID + (size_t)(row0 + ai * HALF + m * 16) * DFF + col0) = w; }
    }
};
struct EpiDown {
    static constexpr bool PERM = true;
    bf16_t* Y; const float* gatev;
    __device__ __forceinline__ void operator()(AccRef acc, const Unit& u, int wr, int wc, int fr, int fq) const {
        const int row0 = u.pm * BM + wr * 64 + fr, col0 = u.pn * BM + wc * 32 + 8 * fq;
#pragma unroll
        for (int ai = 0; ai < 2; ++ai)
#pragma unroll
            for (int m = 0; m < 4; ++m) { const int row = row0 + ai * HALF + m * 16; const float g = gatev[row];
#pragma unroll
                for (int bj = 0; bj < 2; ++bj) { const f32x4 v0 = acc[ai][bj][m][0] * g, v1 = acc[ai][bj][m][1] * g;
                    u32x4 w; w.x = cvt_pk_bf16(v0[0], v0[1]); w.y = cvt_pk_bf16(v0[2], v0[3]); w.z = cvt_pk_bf16(v1[0], v1[1]); w.w = cvt_pk_bf16(v1[2], v1[3]);
                    *(u32x4*)(Y + (size_t)row * DM + col0 + bj * HALF) = w; } }
    }
};
}

namespace att {
constexpr int D = 128, NW = 8, QBLK = 32, KVBLK = 64;
constexpr float SCALE = 0.088388347648318440f, C = SCALE * LOG2E;
constexpr float THR = 8.f;
constexpr int LDQ = QW, LDK = KVW;
constexpr int SHM_V = KVBLK * D * 2, SHM_K = KVBLK * D * 2;
constexpr int BUFB = SHM_V + SHM_K, NBUF = 4;
constexpr int OFF_WS = NBUF * BUFB, OFF_TAB = OFF_WS + NW * 64 * 4, LDS_END = OFF_TAB + 4 * 768 * 4, OFF_OST = 0;
static_assert(LDS_END <= LDS_SCRATCH, "attention LDS");
#define KSWZ(row, colB) ((row) * 256 + ((colB) ^ (((row) & 7) << 4)))
#define SBAR() __builtin_amdgcn_sched_barrier(0)
__device__ __forceinline__ int crow(int r, int hi) { return (r & 3) + 8 * (r >> 2) + 4 * hi; }
__device__ __forceinline__ unsigned cvtpk(float lo, float hi) { unsigned r; asm volatile("v_cvt_pk_bf16_f32 %0, %1, %2" : "=v"(r) : "v"(lo), "v"(hi)); return r; }

__device__ __forceinline__ void partialSM(f32x16& p0, f32x16& p1, float& m_reg, float& mn, float& alpha) {
  float pmax = p0[0];
#pragma unroll
  for (int r = 1; r < 16; ++r) pmax = fmaxf(pmax, p0[r]);
#pragma unroll
  for (int r = 0; r < 16; ++r) pmax = fmaxf(pmax, p1[r]);
  { auto rr = __builtin_amdgcn_permlane32_swap(__float_as_uint(pmax), __float_as_uint(pmax), false, false);
    pmax = fmaxf(__uint_as_float(rr[0]), __uint_as_float(rr[1])); }
  if (__builtin_expect(__all(pmax - m_reg <= THR / SCALE), 1)) { mn = m_reg; alpha = 1.f; }
  else { mn = fmaxf(m_reg, pmax); alpha = __builtin_amdgcn_exp2f((m_reg - mn) * C); m_reg = mn; }
  float mnC = -mn * C;
#pragma unroll
  for (int r = 0; r < 16; ++r) p0[r] = fmaf(p0[r], C, mnC);
#pragma unroll
  for (int r = 0; r < 16; ++r) p1[r] = fmaf(p1[r], C, mnC);
#pragma unroll
  for (int r = 0; r < 16; ++r) p0[r] = __builtin_amdgcn_exp2f(p0[r]);
}
__device__ __forceinline__ void partialSM_B(f32x16& p0, f32x16& p1, float& m_reg, float& mn, float& alpha, const float* tb) {
#pragma unroll
  for (int r = 0; r < 16; ++r) { const int o = (r & 3) + 8 * (r >> 2); p0[r] = fmaf(p0[r], C, tb[o]); p1[r] = fmaf(p1[r], C, tb[32 + o]); }
  float pmax = p0[0];
#pragma unroll
  for (int r = 1; r < 16; ++r) pmax = fmaxf(pmax, p0[r]);
#pragma unroll
  for (int r = 0; r < 16; ++r) pmax = fmaxf(pmax, p1[r]);
  { auto rr = __builtin_amdgcn_permlane32_swap(__float_as_uint(pmax), __float_as_uint(pmax), false, false);
    pmax = fmaxf(__uint_as_float(rr[0]), __uint_as_float(rr[1])); }
  if (__builtin_expect(__all(pmax - m_reg <= THR * LOG2E), 1)) { mn = m_reg; alpha = 1.f; }
  else { mn = fmaxf(m_reg, pmax); alpha = __builtin_amdgcn_exp2f(m_reg - mn); m_reg = mn; }
#pragma unroll
  for (int r = 0; r < 16; ++r) p0[r] = p0[r] - mn;
#pragma unroll
  for (int r = 0; r < 16; ++r) p1[r] = p1[r] - mn;
#pragma unroll
  for (int r = 0; r < 16; ++r) p0[r] = __builtin_amdgcn_exp2f(p0[r]);
}
__device__ __forceinline__ void finishSM(f32x16& p0, f32x16& p1, float alpha, float& l_reg, bf16x8& pa0, bf16x8& pa1, bf16x8& pa2, bf16x8& pa3) {
#pragma unroll
  for (int r = 0; r < 16; ++r) p1[r] = __builtin_amdgcn_exp2f(p1[r]);
  float ps = 0;
#pragma unroll
  for (int r = 0; r < 16; ++r) ps += p0[r];
#pragma unroll
  for (int r = 0; r < 16; ++r) ps += p1[r];
  { auto rr = __builtin_amdgcn_permlane32_swap(__float_as_uint(ps), __float_as_uint(ps), false, false);
    ps = __uint_as_float(rr[0]) + __uint_as_float(rr[1]); }
  l_reg = l_reg * alpha + ps;
#define PK4(P, BASE, OUT) do { unsigned a0 = cvtpk(P[BASE + 0], P[BASE + 1]), a1 = cvtpk(P[BASE + 2], P[BASE + 3]);   \
    unsigned b0 = cvtpk(P[BASE + 4], P[BASE + 5]), b1 = cvtpk(P[BASE + 6], P[BASE + 7]);                              \
    auto r0 = __builtin_amdgcn_permlane32_swap(a0, b0, false, false); auto r1 = __builtin_amdgcn_permlane32_swap(a1, b1, false, false); \
    u32x4 w = {r0[0], r1[0], r0[1], r1[1]}; OUT = *reinterpret_cast<bf16x8*>(&w); } while (0)
  PK4(p0, 0, pa0); PK4(p0, 8, pa1); PK4(p1, 0, pa2); PK4(p1, 8, pa3);
#undef PK4
}
__device__ __forceinline__ void qkt(f32x16& p0, f32x16& p1, const bf16_t* Ks, const bf16x8* qr, int r32, int hi, float init = 0.f) {
#pragma unroll
  for (int r = 0; r < 16; ++r) { p0[r] = init; p1[r] = init; }
#pragma unroll
  for (int d0 = 0; d0 < 8; ++d0) { int cb = (d0 * 16 + hi * 8) * 2;
    bf16x8 b0 = *reinterpret_cast<const bf16x8*>((const char*)Ks + KSWZ(r32, cb));
    bf16x8 b1 = *reinterpret_cast<const bf16x8*>((const char*)Ks + KSWZ(32 + r32, cb));
    p0 = __builtin_amdgcn_mfma_f32_32x32x16_bf16(b0, qr[d0], p0, 0, 0, 0);
    p1 = __builtin_amdgcn_mfma_f32_32x32x16_bf16(b1, qr[d0], p1, 0, 0, 0); }
}
__device__ __forceinline__ int v_st(int k, int c) { const int kk = (k & ~0xC) | ((k & 4) << 1) | ((k & 8) >> 1); return ((kk >> 3) * 4 + (c >> 5)) * 512 + ((kk & 7) * 32 + (c & 31)) * 2; }
__device__ __forceinline__ int v_rd_base(int lane) { return ((lane & 3) << 3) | (((lane >> 2) & 3) << 6) | (((lane >> 4) & 1) << 5) | (((lane >> 5) & 1) << 8); }
constexpr int v_rd_off(int d0, int ks, int half) { return d0 * 512 + ks * 4096 + half * 2048; }
template <int OFF> __device__ __forceinline__ s16x4 tr_read(int vb) {
  s16x4 r; asm volatile("ds_read_b64_tr_b16 %0, %1 offset:%2" : "=&v"(r) : "v"(vb), "i"(OFF) : "memory"); return r;
}
template <int D0> __device__ __forceinline__ void pv_one(f32x16& od, int vb, bf16x8 pa0, bf16x8 pa1, bf16x8 pa2, bf16x8 pa3) {
  const s16x4 l0 = tr_read<v_rd_off(D0, 0, 0)>(vb), h0 = tr_read<v_rd_off(D0, 0, 1)>(vb), l1 = tr_read<v_rd_off(D0, 1, 0)>(vb), h1 = tr_read<v_rd_off(D0, 1, 1)>(vb);
  const s16x4 l2 = tr_read<v_rd_off(D0, 2, 0)>(vb), h2 = tr_read<v_rd_off(D0, 2, 1)>(vb), l3 = tr_read<v_rd_off(D0, 3, 0)>(vb), h3 = tr_read<v_rd_off(D0, 3, 1)>(vb);
  asm volatile("s_waitcnt lgkmcnt(0)" ::: "memory"); SBAR();
#define PK(L, H) (bf16x8){L[0], L[1], L[2], L[3], H[0], H[1], H[2], H[3]}
  od = __builtin_amdgcn_mfma_f32_32x32x16_bf16(pa0, PK(l0, h0), od, 0, 0, 0);
  od = __builtin_amdgcn_mfma_f32_32x32x16_bf16(pa1, PK(l1, h1), od, 0, 0, 0);
  od = __builtin_amdgcn_mfma_f32_32x32x16_bf16(pa2, PK(l2, h2), od, 0, 0, 0);
  od = __builtin_amdgcn_mfma_f32_32x32x16_bf16(pa3, PK(l3, h3), od, 0, 0, 0);
#undef PK
}
__device__ __forceinline__ void pv_d0(f32x16* o, int vb, bf16x8 pa0, bf16x8 pa1, bf16x8 pa2, bf16x8 pa3) {
  pv_one<0>(o[0], vb, pa0, pa1, pa2, pa3); pv_one<1>(o[1], vb, pa0, pa1, pa2, pa3); pv_one<2>(o[2], vb, pa0, pa1, pa2, pa3); pv_one<3>(o[3], vb, pa0, pa1, pa2, pa3);
}
template <int MODE>
__device__ __forceinline__ void pv_psm(f32x16* o, int vb, bf16x8 pa0, bf16x8 pa1, bf16x8 pa2, bf16x8 pa3, f32x16& p0, f32x16& p1, float& m_reg, float& mn, float& alpha, const float* tb) {
  pv_one<0>(o[0], vb, pa0, pa1, pa2, pa3);
  if constexpr (MODE == 1) {
#pragma unroll
    for (int r = 0; r < 16; ++r) { const int of = (r & 3) + 8 * (r >> 2); p0[r] = fmaf(p0[r], C, tb[of]); p1[r] = fmaf(p1[r], C, tb[32 + of]); }
  }
  float pmax = p0[0];
#pragma unroll
  for (int r = 1; r < 16; ++r) pmax = fmaxf(pmax, p0[r]);
#pragma unroll
  for (int r = 0; r < 16; ++r) pmax = fmaxf(pmax, p1[r]);
  { auto rr = __builtin_amdgcn_permlane32_swap(__float_as_uint(pmax), __float_as_uint(pmax), false, false);
    pmax = fmaxf(__uint_as_float(rr[0]), __uint_as_float(rr[1])); }
  SBAR();
  pv_one<1>(o[1], vb, pa0, pa1, pa2, pa3);
  float sub;
  if constexpr (MODE == 0) {
    if (__builtin_expect(__all(pmax - m_reg <= THR / SCALE), 1)) { mn = m_reg; alpha = 1.f; }
    else { mn = fmaxf(m_reg, pmax); alpha = __builtin_amdgcn_exp2f((m_reg - mn) * C); m_reg = mn; }
    sub = -mn * C;
#pragma unroll
    for (int r = 0; r < 16; ++r) p0[r] = fmaf(p0[r], C, sub);
  } else {
    if (__builtin_expect(__all(pmax - m_reg <= THR * LOG2E), 1)) { mn = m_reg; alpha = 1.f; }
    else { mn = fmaxf(m_reg, pmax); alpha = __builtin_amdgcn_exp2f(m_reg - mn); m_reg = mn; }
    sub = -mn;
#pragma unroll
    for (int r = 0; r < 16; ++r) p0[r] = p0[r] + sub;
  }
  SBAR();
  pv_one<2>(o[2], vb, pa0, pa1, pa2, pa3);
#pragma unroll
  for (int r = 0; r < 16; ++r) { if constexpr (MODE == 0) p1[r] = fmaf(p1[r], C, sub); else p1[r] = p1[r] + sub; }
#pragma unroll
  for (int r = 0; r < 6; ++r) p0[r] = __builtin_amdgcn_exp2f(p0[r]);
  SBAR();
  pv_one<3>(o[3], vb, pa0, pa1, pa2, pa3);
#pragma unroll
  for (int r = 6; r < 16; ++r) p0[r] = __builtin_amdgcn_exp2f(p0[r]);
}
__device__ __forceinline__ f32x8 bf8_to_f32(bf16x8 v) { f32x8 r;
#pragma unroll
  for (int j = 0; j < 8; ++j) r[j] = bf2f((unsigned short)v[j]);
  return r; }
__device__ __forceinline__ bf16x8 f32_to_bf8(f32x8 x) { u32x4 w = {cvtpk(x[0], x[1]), cvtpk(x[2], x[3]), cvtpk(x[4], x[5]), cvtpk(x[6], x[7])}; return *reinterpret_cast<bf16x8*>(&w); }
__device__ __forceinline__ int t5_bucket(int rel) {
  const int n = rel < 0 ? -rel : rel; int bk;
  if (n < 8) bk = n; else if (n < 12) bk = 8; else if (n < 16) bk = 9; else if (n < 23) bk = 10; else if (n < 32) bk = 11; else if (n < 46) bk = 12; else if (n < 64) bk = 13; else if (n < 91) bk = 14; else bk = 15;
  return bk + (rel > 0 ? 16 : 0);
}
struct Aux { const float* cosT; const float* sinT; const float* qn; const float* kn; const float* relb; const float* sink; };

template <int MODE>
__device__ __forceinline__ void attn_unit(const bf16_t* Qb, const bf16_t* __restrict__ Kh, const bf16_t* __restrict__ Vh, bf16_t* Ob, int kbeg, int kend, int q0, int head, char* lds, const Aux& aux) {
  int tid = threadIdx.x; asm volatile("" : "+v"(tid));
  const int wid = tid >> 6, lane = tid & 63, r32 = lane & 31, hi = lane >> 5;
  char* V_lds = lds; char* K_lds = lds + SHM_V;
  float* ws = (float*)(lds + OFF_WS) + wid * 64; float* li_l = ws; float* al_l = ws + 32;
  float* tab = (float*)(lds + OFF_TAB);
  float m_reg = -1e30f, l_reg = 0; f32x16 o[4] = {}; bf16x8 qr[8];
  const bf16_t* Qw = Qb + (long)(wid * QBLK + r32) * LDQ + hi * 8;
#pragma unroll
  for (int d0 = 0; d0 < 8; ++d0) qr[d0] = *reinterpret_cast<const bf16x8*>(Qw + d0 * 16);
  if constexpr (MODE == 1) {
    for (int i = tid; i < 768; i += 512) { const int rel = i - 383, n = rel < 0 ? -rel : rel; float v = -1e30f; if (n <= 128) v = aux.relb[t5_bucket(rel) * NHB + head] * LOG2E; tab[i] = v; }
    m_reg = aux.sink[head] * LOG2E; l_reg = 1.0f;
  }
  const int tbase = kbeg - q0 - wid * QBLK - r32 + 383 + 4 * hi;
  const int sr = tid >> 4, sc = (tid & 15) * 8, vst0 = v_st(sr, sc), vst1 = v_st(32 + sr, sc);
  const int vb0 = (int)(uintptr_t)V_lds + v_rd_base(lane);
  struct { bf16x8 vs0, vs1, ks0, ks1; } sr_[2];
#define SLOAD(i, k0) do { sr_[i].vs0 = *reinterpret_cast<const bf16x8*>(&Vh[(long)(kbeg + (k0) + sr) * LDK + sc]); sr_[i].vs1 = *reinterpret_cast<const bf16x8*>(&Vh[(long)(kbeg + (k0) + 32 + sr) * LDK + sc]); \
    sr_[i].ks0 = *reinterpret_cast<const bf16x8*>(&Kh[(long)(kbeg + (k0) + sr) * LDK + sc]); sr_[i].ks1 = *reinterpret_cast<const bf16x8*>(&Kh[(long)(kbeg + (k0) + 32 + sr) * LDK + sc]); } while (0)
#define SWRITE(bo, i) do { *(bf16x8*)(V_lds + (bo) + vst0) = sr_[i].vs0;          \
    *(bf16x8*)(V_lds + (bo) + vst1) = sr_[i].vs1; int kc = sc * 2;               \
    *(bf16x8*)(K_lds + (bo) + KSWZ(sr, kc)) = sr_[i].ks0;                       \
    *(bf16x8*)(K_lds + (bo) + KSWZ(32 + sr, kc)) = sr_[i].ks1; } while (0)
#define SWAIT() asm volatile("s_waitcnt vmcnt(4)" ::: "memory")
#define RESC(a) do { if (__any((a) < 1.f)) { if (hi == 0) al_l[r32] = (a); asm volatile("s_waitcnt lgkmcnt(0)" ::: "memory"); \
    _Pragma("unroll") for (int d = 0; d < 4; ++d) _Pragma("unroll") for (int r = 0; r < 16; ++r) o[d][r] *= al_l[crow(r, hi)]; } } while (0)
#define PSM(P0, P1, MN, AL, j) do { if constexpr (MODE == 0) partialSM(P0, P1, m_reg, MN, AL); else partialSM_B(P0, P1, m_reg, MN, AL, tab + tbase + (j) * KVBLK); } while (0)
#define ROT() do { const int t_ = o_prev; o_prev = o_cur; o_cur = o_next; o_next = t_; } while (0)
  f32x16 pA0, pA1, pB0, pB1; float mnA, mnB, alA, alB; bf16x8 pa0, pa1, pa2, pa3; const int NT = (kend - kbeg) / KVBLK;
  constexpr int SE = 0, SO = 1;
  int o_prev = 2 * BUFB, o_cur = 0, o_next = BUFB;
  SLOAD(SE, 0); asm volatile("s_waitcnt vmcnt(0)" ::: "memory"); SWRITE(0, SE);
  SLOAD(SO, KVBLK); SLOAD(SE, 2 * KVBLK);
  __syncthreads();
  qkt(pA0, pA1, (const bf16_t*)(K_lds + o_cur), qr, r32, hi); PSM(pA0, pA1, mnA, alA, 0);
  SWAIT(); SWRITE(o_next, SO); RESC(alA); __syncthreads();
  ROT();
  for (int j = 1; j + 1 < NT; j += 2) {
    SBAR(); qkt(pB0, pB1, (const bf16_t*)(K_lds + o_cur), qr, r32, hi);
    finishSM(pA0, pA1, alA, l_reg, pa0, pa1, pa2, pa3); SBAR();
    SLOAD(SO, (j + 2) * KVBLK); SBAR();
    pv_psm<MODE>(o, vb0 + o_prev, pa0, pa1, pa2, pa3, pB0, pB1, m_reg, mnB, alB, tab + tbase + j * KVBLK);
    SWAIT(); SWRITE(o_next, SE);
    RESC(alB); __syncthreads(); ROT();
    SBAR(); qkt(pA0, pA1, (const bf16_t*)(K_lds + o_cur), qr, r32, hi);
    finishSM(pB0, pB1, alB, l_reg, pa0, pa1, pa2, pa3); SBAR();
    SLOAD(SE, (j + 3 < NT ? j + 3 : NT - 1) * KVBLK); SBAR();
    pv_psm<MODE>(o, vb0 + o_prev, pa0, pa1, pa2, pa3, pA0, pA1, m_reg, mnA, alA, tab + tbase + (j + 1) * KVBLK);
    SWAIT(); SWRITE(o_next, SO);
    RESC(alA); __syncthreads(); ROT();
  }
  SBAR(); qkt(pB0, pB1, (const bf16_t*)(K_lds + o_cur), qr, r32, hi);
  finishSM(pA0, pA1, alA, l_reg, pa0, pa1, pa2, pa3); SBAR();
  pv_psm<MODE>(o, vb0 + o_prev, pa0, pa1, pa2, pa3, pB0, pB1, m_reg, mnB, alB, tab + tbase + (NT - 1) * KVBLK);
  RESC(alB);
  finishSM(pB0, pB1, alB, l_reg, pa0, pa1, pa2, pa3); SBAR();
  pv_d0(o, vb0 + o_cur, pa0, pa1, pa2, pa3);
  if (hi == 0) li_l[r32] = l_reg; asm volatile("s_waitcnt lgkmcnt(0)" ::: "memory");
  float rli[16];
#pragma unroll
  for (int r = 0; r < 16; ++r) rli[r] = __builtin_amdgcn_rcpf(li_l[crow(r, hi)]);
  asm volatile("s_waitcnt vmcnt(0)" ::: "memory");
  __syncthreads();
  char* ost = lds + OFF_OST + wid * 8192;
#pragma unroll
  for (int r = 0; r < 16; ++r) { const int orow = crow(r, hi);
#pragma unroll
    for (int d0 = 0; d0 < 4; ++d0) *(unsigned short*)(ost + orow * 256 + (d0 * 32 + r32) * 2) = f2bf(o[d0][r] * rli[r]); }
  asm volatile("s_waitcnt lgkmcnt(0)" ::: "memory");
  bf16_t* Ow = Ob + (long)(wid * QBLK) * LDQ;
#pragma unroll
  for (int i = 0; i < 8; ++i) { const int ch = i * 64 + lane, row = ch >> 4, c16 = ch & 15;
    const u32x4 v = *(const u32x4*)(ost + row * 256 + c16 * 16); *(u32x4*)(Ow + (long)row * LDQ + c16 * 8) = v; }
  asm volatile("s_waitcnt lgkmcnt(0)" ::: "memory");
  __syncthreads();
#undef ROT
#undef SLOAD
#undef SWRITE
#undef SWAIT
#undef RESC
#undef PSM
}

template <int MODE>
__device__ __forceinline__ void softmax_tile(f32x16& p0, f32x16& p1, float& m_reg, float& l_reg, float& alpha, bf16x8& pa0, bf16x8& pa1, bf16x8& pa2, bf16x8& pa3, const float* tb) {
  if constexpr (MODE == 0) {
    alpha = 1.f;
    if (__builtin_expect(m_reg != 0.f, 0)) {
#pragma unroll
      for (int r = 0; r < 16; ++r) { p0[r] -= m_reg; p1[r] -= m_reg; } }
#pragma unroll
    for (int r = 0; r < 16; ++r) { p0[r] = __builtin_amdgcn_exp2f(p0[r]); p1[r] = __builtin_amdgcn_exp2f(p1[r]); }
  } else {
  if constexpr (MODE == 1) {
#pragma unroll
    for (int r = 0; r < 16; ++r) { const int of = (r & 3) + 8 * (r >> 2); p0[r] = fmaf(p0[r], C, tb[of]); p1[r] = fmaf(p1[r], C, tb[32 + of]); }
  }
  float pmax = p0[0];
#pragma unroll
  for (int r = 1; r < 16; ++r) pmax = fmaxf(pmax, p0[r]);
#pragma unroll
  for (int r = 0; r < 16; ++r) pmax = fmaxf(pmax, p1[r]);
  { auto rr = __builtin_amdgcn_permlane32_swap(__float_as_uint(pmax), __float_as_uint(pmax), false, false);
    pmax = fmaxf(__uint_as_float(rr[0]), __uint_as_float(rr[1])); }
  float mn, sub;
  if constexpr (MODE == 0) {
    if (__builtin_expect(__all(pmax - m_reg <= THR / SCALE), 1)) { mn = m_reg; alpha = 1.f; }
    else { mn = fmaxf(m_reg, pmax); alpha = __builtin_amdgcn_exp2f((m_reg - mn) * C); m_reg = mn; }
    sub = -mn * C;
#pragma unroll
    for (int r = 0; r < 16; ++r) { p0[r] = __builtin_amdgcn_exp2f(fmaf(p0[r], C, sub)); p1[r] = __builtin_amdgcn_exp2f(fmaf(p1[r], C, sub)); }
  } else {
    if (__builtin_expect(__all(pmax - m_reg <= THR * LOG2E), 1)) { mn = m_reg; alpha = 1.f; }
    else { mn = fmaxf(m_reg, pmax); alpha = __builtin_amdgcn_exp2f(m_reg - mn); m_reg = mn; }
    sub = -mn;
#pragma unroll
    for (int r = 0; r < 16; ++r) { p0[r] = __builtin_amdgcn_exp2f(p0[r] + sub); p1[r] = __builtin_amdgcn_exp2f(p1[r] + sub); }
  }
  }
  float ps = 0;
#pragma unroll
  for (int r = 0; r < 16; ++r) ps += p0[r];
#pragma unroll
  for (int r = 0; r < 16; ++r) ps += p1[r];
  { auto rr = __builtin_amdgcn_permlane32_swap(__float_as_uint(ps), __float_as_uint(ps), false, false);
    ps = __uint_as_float(rr[0]) + __uint_as_float(rr[1]); }
  l_reg = l_reg * alpha + ps;
#define PK4(P, BASE, OUT) do { unsigned a0 = cvtpk(P[BASE + 0], P[BASE + 1]), a1 = cvtpk(P[BASE + 2], P[BASE + 3]);   \
    unsigned b0 = cvtpk(P[BASE + 4], P[BASE + 5]), b1 = cvtpk(P[BASE + 6], P[BASE + 7]);                              \
    auto r0 = __builtin_amdgcn_permlane32_swap(a0, b0, false, false); auto r1 = __builtin_amdgcn_permlane32_swap(a1, b1, false, false); \
    u32x4 w = {r0[0], r1[0], r0[1], r1[1]}; OUT = *reinterpret_cast<bf16x8*>(&w); } while (0)
  PK4(p0, 0, pa0); PK4(p0, 8, pa1); PK4(p1, 0, pa2); PK4(p1, 8, pa3);
#undef PK4
}
typedef short v4i16_t __attribute__((ext_vector_type(4)));
__device__ __forceinline__ bf16x8 ld_frag2(int sp, const LAS char* kb, const int (&kx)[4], const LAS char* vb) {
  if (sp >= 16) { const int s = sp - 16, d0 = s >> 1; return *(const LAS bf16x8*)(kb + kx[d0 & 3] + (d0 >> 2) * 128 + (s & 1) * 8192); }
  const int D0 = sp >> 2, ks = sp & 3;
  const s16x4 lo = __builtin_bit_cast(s16x4, __builtin_amdgcn_ds_read_tr16_b64_v4i16((LAS v4i16_t*)(vb + v_rd_off(D0, ks, 0))));
  const s16x4 hi = __builtin_bit_cast(s16x4, __builtin_amdgcn_ds_read_tr16_b64_v4i16((LAS v4i16_t*)(vb + v_rd_off(D0, ks, 1))));
  return (bf16x8){lo[0], lo[1], lo[2], lo[3], hi[0], hi[1], hi[2], hi[3]};
}
template <int SB, int SE, bool PRE>
__device__ __forceinline__ void mrun(bf16x8 (&f)[8], f32x16& p0, f32x16& p1, f32x16* o, const bf16x8* qr, bf16x8 pa0, bf16x8 pa1, bf16x8 pa2, bf16x8 pa3, const LAS char* kb, const int (&kx)[4], const LAS char* vb, float init) {
  if (SE > 16) { p0 = f32x16{}; p1 = f32x16{}; }
  SBAR();
  if (!PRE) {
#pragma unroll
    for (int s = SB; s < SB + 8; ++s) f[s & 7] = ld_frag2(s, kb, kx, vb);
    SBAR(); }
#pragma unroll
  for (int sp = SB; sp < SE; ++sp) {
    if (sp >= 16) { const int s = sp - 16; if (s & 1) p1 = __builtin_amdgcn_mfma_f32_32x32x16_bf16(f[sp & 7], qr[s >> 1], p1, 0, 0, 0); else p0 = __builtin_amdgcn_mfma_f32_32x32x16_bf16(f[sp & 7], qr[s >> 1], p0, 0, 0, 0); }
    else { const int D0 = sp >> 2, ks = sp & 3; const bf16x8 pa = ks == 0 ? pa0 : ks == 1 ? pa1 : ks == 2 ? pa2 : pa3;
      o[D0] = __builtin_amdgcn_mfma_f32_32x32x16_bf16(pa, f[sp & 7], o[D0], 0, 0, 0); }
    if (sp + 8 < SE) f[sp & 7] = ld_frag2(sp + 8, kb, kx, vb);
    SBAR();
  }
}
template <int MODE>
__device__ __forceinline__ void attn_unit_pp(const bf16_t* Qb, const bf16_t* __restrict__ Kh, const bf16_t* __restrict__ Vh, bf16_t* Ob, int kbeg, int kend, int q0, int head, char* lds, const Aux& aux) {
  int tid = threadIdx.x; asm volatile("" : "+v"(tid));
  const int wid = tid >> 6, lane = tid & 63, r32 = lane & 31, hi = lane >> 5;
  const int widu = __builtin_amdgcn_readfirstlane(wid), half = widu >> 2;
  const int hsub = widu >> 1, rsub = (widu & 1) * QBLK;
  const int rw0 = q0 + rsub;
#define NEED(j) (MODE == 0 || ((kbeg + (j) * KVBLK + KVBLK - 1 >= rw0 - 128) && (kbeg + (j) * KVBLK <= rw0 + QBLK - 1 + 128)))
  char* V_lds = lds; char* K_lds = lds + SHM_V;
  float* ws = (float*)(lds + OFF_WS) + wid * 64; float* li_l = ws; float* al_l = ws + 32;
  float* tab = (float*)(lds + OFF_TAB) + hsub * 768;
  float m_reg = -1e30f, l_reg = 0; f32x16 o[4] = {}; bf16x8 qr[8];
  const bf16_t* Qw = Qb + (long)(rsub + r32) * LDQ + hsub * HD + hi * 8;
#pragma unroll
  for (int d0 = 0; d0 < 8; ++d0) qr[d0] = *reinterpret_cast<const bf16x8*>(Qw + d0 * 16);
  if constexpr (MODE == 1) {
    m_reg = aux.sink[head + hsub] * LOG2E; l_reg = 1.0f;
  }
  const int tbase = kbeg - q0 - rsub - r32 + 383 + 4 * hi;
  float qk_init = 0.f;
  if constexpr (MODE == 0) {
    float mq = fmaxf(fabsf(aux.qn[lane]), fabsf(aux.qn[64 + lane])), mk = fmaxf(fabsf(aux.kn[lane]), fabsf(aux.kn[64 + lane]));
#pragma unroll
    for (int of = 1; of < 64; of <<= 1) { mq = fmaxf(mq, __shfl_xor(mq, of)); mk = fmaxf(mk, __shfl_xor(mk, of)); }
    const float bound = C * 128.0f * mq * mk * 1.01f + 0.5f;
    m_reg = __builtin_amdgcn_readfirstlane(__float_as_int(bound > 64.f ? bound - 64.f : 0.f)) ? (bound - 64.f) : 0.f; (void)qk_init; }
  const int sr = tid >> 4, sc = (tid & 15) * 8, vst0 = v_st(sr, sc), vst1 = v_st(32 + sr, sc);
  const int vb0 = (int)(uintptr_t)V_lds + v_rd_base(lane);
  int kx[4];
#pragma unroll
  for (int d = 0; d < 4; ++d) kx[d] = r32 * 256 + ((d * 32 + hi * 16) ^ ((r32 & 7) << 4));
  const LAS char* k3 = (const LAS char*)K_lds; const LAS char* v3 = (const LAS char*)V_lds + v_rd_base(lane);
  bf16x8 fr_[8];
  bf16x8 s_v0, s_v1, s_k0, s_k1;
#define SLOAD(k0) do { s_v0 = *reinterpret_cast<const bf16x8*>(&Vh[(long)(kbeg + (k0) + sr) * LDK + sc]); s_v1 = *reinterpret_cast<const bf16x8*>(&Vh[(long)(kbeg + (k0) + 32 + sr) * LDK + sc]); \
    s_k0 = *reinterpret_cast<const bf16x8*>(&Kh[(long)(kbeg + (k0) + sr) * LDK + sc]); s_k1 = *reinterpret_cast<const bf16x8*>(&Kh[(long)(kbeg + (k0) + 32 + sr) * LDK + sc]); } while (0)
#define SWRITE(bo) do { *(bf16x8*)(V_lds + (bo) + vst0) = s_v0; *(bf16x8*)(V_lds + (bo) + vst1) = s_v1; const int kc = sc * 2;  \
    *(bf16x8*)(K_lds + (bo) + KSWZ(sr, kc)) = s_k0; *(bf16x8*)(K_lds + (bo) + KSWZ(32 + sr, kc)) = s_k1; } while (0)
#define VMW0() asm volatile("s_waitcnt vmcnt(0)" ::: "memory")
#define BAR() asm volatile("s_waitcnt lgkmcnt(0)\n\ts_barrier" ::: "memory")
#define RESC(a) do { if (__any((a) < 1.f)) { if (hi == 0) al_l[r32] = (a); asm volatile("s_waitcnt lgkmcnt(0)" ::: "memory"); \
    _Pragma("unroll") for (int d = 0; d < 4; ++d) _Pragma("unroll") for (int r = 0; r < 16; ++r) o[d][r] *= al_l[crow(r, hi)]; } } while (0)
#define ROT() do { const int t_ = o_prev; o_prev = o_cur; o_cur = o_next; o_next = t_; } while (0)
#define VSEG(j) do { VMW0(); SWRITE(o_next); { const int nx_ = (j) + 2 + half; SLOAD((nx_ < NT ? nx_ : NT - 1) * KVBLK); } SBAR(); \
    if (NEED(j)) { softmax_tile<MODE>(p0, p1, m_reg, l_reg, alpha, pa0, pa1, pa2, pa3, tab + tbase + (j) * KVBLK); if constexpr (MODE == 1) { RESC(alpha); } } SBAR(); } while (0)
#define PVPRE() do { if constexpr (MODE == 0) { _Pragma("unroll") for (int s_ = 0; s_ < 8; ++s_) fr_[s_] = ld_frag2(s_, k3, kx, v3 + o_cur); SBAR(); } } while (0)
  f32x16 p0, p1; float alpha; bf16x8 pa0, pa1, pa2, pa3; const int NT = (kend - kbeg) / KVBLK;
  int o_prev = 2 * BUFB, o_cur = 0, o_next = BUFB;
  { bf16x8 t_v0, t_v1, t_k0, t_k1;
    t_v0 = *reinterpret_cast<const bf16x8*>(&Vh[(long)(kbeg + sr) * LDK + sc]); t_v1 = *reinterpret_cast<const bf16x8*>(&Vh[(long)(kbeg + 32 + sr) * LDK + sc]);
    t_k0 = *reinterpret_cast<const bf16x8*>(&Kh[(long)(kbeg + sr) * LDK + sc]); t_k1 = *reinterpret_cast<const bf16x8*>(&Kh[(long)(kbeg + 32 + sr) * LDK + sc]);
    SLOAD(KVBLK); VMW0();
    *(bf16x8*)(V_lds + vst0) = t_v0; *(bf16x8*)(V_lds + vst1) = t_v1; { const int kc = sc * 2; *(bf16x8*)(K_lds + KSWZ(sr, kc)) = t_k0; *(bf16x8*)(K_lds + KSWZ(32 + sr, kc)) = t_k1; }
    if (half) { SWRITE(BUFB); SLOAD(2 * KVBLK); } }
  BAR();
#define MSEG_QK(j) do { SBAR(); if (NEED(j)) qkt(p0, p1, (const bf16_t*)(K_lds + o_cur), qr, r32, hi, qk_init); SBAR(); } while (0)
#define MSEG(j) do { SBAR(); if (NEED(j)) qkt(p0, p1, (const bf16_t*)(K_lds + o_cur), qr, r32, hi, qk_init); if (NEED((j) - 1)) pv_d0(o, vb0 + o_prev, pa0, pa1, pa2, pa3); SBAR(); } while (0)
#define MSEG_PV() do { SBAR(); if (NEED(NT - 1)) pv_d0(o, vb0 + o_prev, pa0, pa1, pa2, pa3); SBAR(); } while (0)
  if (half == 0) {
    MSEG_QK(0); VSEG(0);
    BAR(); ROT();
    for (int j = 1; j < NT; ++j) { MSEG(j); VSEG(j); BAR(); ROT(); }
    MSEG_PV();
  } else {
    MSEG_QK(0);
    BAR(); ROT();
    for (int j = 1; j < NT; ++j) { VSEG(j - 1); MSEG(j); BAR(); ROT(); }
    VSEG(NT - 1); MSEG_PV();
  }
#undef MSEG_QK
#undef MSEG
#undef MSEG_PV
  if (hi == 0) li_l[r32] = l_reg; asm volatile("s_waitcnt lgkmcnt(0)" ::: "memory");
  float rli[16];
#pragma unroll
  for (int r = 0; r < 16; ++r) rli[r] = __builtin_amdgcn_rcpf(li_l[crow(r, hi)]);
  VMW0();
  __syncthreads();
  char* ost = lds + OFF_OST + wid * 8192;
#pragma unroll
  for (int r = 0; r < 16; ++r) { const int orow = crow(r, hi);
#pragma unroll
    for (int d0 = 0; d0 < 4; ++d0) *(unsigned short*)(ost + orow * 256 + (d0 * 32 + r32) * 2) = f2bf(o[d0][r] * rli[r]); }
  asm volatile("s_waitcnt lgkmcnt(0)" ::: "memory");
  bf16_t* Ow = Ob + (long)rsub * LDQ + hsub * HD;
#pragma unroll
  for (int i = 0; i < 8; ++i) { const int ch = i * 64 + lane, row = ch >> 4, c16 = ch & 15;
    const u32x4 v = *(const u32x4*)(ost + row * 256 + c16 * 16); *(u32x4*)(Ow + (long)row * LDQ + c16 * 8) = v; }
  asm volatile("s_waitcnt lgkmcnt(0)" ::: "memory");
  __syncthreads();
#undef SLOAD
#undef SWRITE
#undef VMW0
#undef BAR
#undef RESC
#undef ROT
#undef VSEG
#undef PVPRE
#undef NEED
}

__device__ __forceinline__ int offK16(int row, int ch) { return row * 256 + 16 * (ch ^ (row & 15)); }
__device__ __forceinline__ int offV16(int row, int ch) { return row * 256 + 16 * (ch ^ ((row & 7) << 1)); }
__device__ __forceinline__ bf16x8 ld_frag16(int sp, const LAS char* kb, const int (&ka)[4], const LAS char* vb, const int (&va)[8]) {
  if (sp >= 16) { const int s = sp - 16, kblk = s >> 2, ks = s & 3; return *(const LAS bf16x8*)(kb + ka[ks] + kblk * 4096); }
  const int db = sp >> 1, s = sp & 1;
  const s16x4 lo = __builtin_bit_cast(s16x4, __builtin_amdgcn_ds_read_tr16_b64_v4i16((LAS v4i16_t*)(vb + va[db] + s * 8192)));
  const s16x4 hi = __builtin_bit_cast(s16x4, __builtin_amdgcn_ds_read_tr16_b64_v4i16((LAS v4i16_t*)(vb + va[db] + s * 8192 + 4096)));
  return (bf16x8){lo[0], lo[1], lo[2], lo[3], hi[0], hi[1], hi[2], hi[3]};
}
template <int SB, int SE, bool PRE>
__device__ __forceinline__ void mrun16(bf16x8 (&f)[8], f32x4 (&S)[4][2], f32x4 (&O)[8][2], const bf16x8 (&qf)[2][4], const bf16x8 (&pf)[2][2], const LAS char* kb, const int (&ka)[4], const LAS char* vb, const int (&va)[8]) {
  if (SE > 16) {
#pragma unroll
    for (int i = 0; i < 4; ++i) { S[i][0] = (f32x4){0.f, 0.f, 0.f, 0.f}; S[i][1] = (f32x4){0.f, 0.f, 0.f, 0.f}; } }
  SBAR();
  if (!PRE) {
#pragma unroll
    for (int s = SB; s < SB + 8; ++s) f[s & 7] = ld_frag16(s, kb, ka, vb, va);
    SBAR(); }
#pragma unroll
  for (int sp = SB; sp < SE; ++sp) {
    if (sp >= 16) { const int s = sp - 16, kblk = s >> 2, ks = s & 3;
      S[kblk][0] = __builtin_amdgcn_mfma_f32_16x16x32_bf16(f[sp & 7], qf[0][ks], S[kblk][0], 0, 0, 0); S[kblk][1] = __builtin_amdgcn_mfma_f32_16x16x32_bf16(f[sp & 7], qf[1][ks], S[kblk][1], 0, 0, 0); }
    else { const int db = sp >> 1, s = sp & 1;
      O[db][0] = __builtin_amdgcn_mfma_f32_16x16x32_bf16(f[sp & 7], pf[0][s], O[db][0], 0, 0, 0); O[db][1] = __builtin_amdgcn_mfma_f32_16x16x32_bf16(f[sp & 7], pf[1][s], O[db][1], 0, 0, 0); }
    if (sp + 8 < SE) f[sp & 7] = ld_frag16(sp + 8, kb, ka, vb, va);
    SBAR();
  }
}
__device__ __forceinline__ void attn_unit16(const bf16_t* Qb, const bf16_t* __restrict__ Kh, const bf16_t* __restrict__ Vh, bf16_t* Ob, int nkeys, int q0, char* lds, const Aux& aux) {
  int tid = threadIdx.x; asm volatile("" : "+v"(tid));
  const int wid = tid >> 6, lane = tid & 63, fr = lane & 15, fq = lane >> 4;
  const int half = __builtin_amdgcn_readfirstlane(wid >> 2);
  char* V_lds = lds; char* K_lds = lds + SHM_V;
  float shift;
  { float mq = fmaxf(fabsf(aux.qn[lane]), fabsf(aux.qn[64 + lane])), mk = fmaxf(fabsf(aux.kn[lane]), fabsf(aux.kn[64 + lane]));
#pragma unroll
    for (int of = 1; of < 64; of <<= 1) { mq = fmaxf(mq, __shfl_xor(mq, of)); mk = fmaxf(mk, __shfl_xor(mk, of)); }
    const float bound = C * 128.0f * mq * mk * 1.01f + 0.5f; shift = bound > 64.f ? bound - 64.f : 0.f; }
  bf16x8 qf[2][4];
#pragma unroll
  for (int qb = 0; qb < 2; ++qb)
#pragma unroll
    for (int ks = 0; ks < 4; ++ks) qf[qb][ks] = *reinterpret_cast<const bf16x8*>(Qb + (long)(wid * QBLK + 16 * qb + fr) * LDQ + 32 * ks + 8 * fq);
#pragma unroll
  for (int qb = 0; qb < 2; ++qb) {
    float ss = 0.f;
#pragma unroll
    for (int ks = 0; ks < 4; ++ks) { const f32x8 x = bf8_to_f32(qf[qb][ks]);
#pragma unroll
      for (int e = 0; e < 8; ++e) ss += x[e] * x[e]; }
    ss += __shfl_xor(ss, 16); ss += __shfl_xor(ss, 32);
    const float rinv = C / sqrtf(ss * (1.0f / 128.0f) + EPS);
    const int t = q0 + wid * QBLK + 16 * qb + fr;
#pragma unroll
    for (int hf = 0; hf < 2; ++hf) { const int posx = hf ? (t & 63) : (t >> 6);
      const f32x8 cs = *reinterpret_cast<const f32x8*>(aux.cosT + posx * 32 + 8 * fq), sn = *reinterpret_cast<const f32x8*>(aux.sinT + posx * 32 + 8 * fq);
      const f32x8 g1 = *reinterpret_cast<const f32x8*>(aux.qn + hf * 64 + 8 * fq), g2 = *reinterpret_cast<const f32x8*>(aux.qn + hf * 64 + 32 + 8 * fq);
      const f32x8 x1 = bf8_to_f32(qf[qb][2 * hf]) * rinv * g1, x2 = bf8_to_f32(qf[qb][2 * hf + 1]) * rinv * g2;
      qf[qb][2 * hf] = f32_to_bf8(x1 * cs - x2 * sn); qf[qb][2 * hf + 1] = f32_to_bf8(x2 * cs + x1 * sn); } }
  f32x4 O[8][2], S[4][2]; bf16x8 pf[2][2]; float lsum[2] = {0.f, 0.f};
#pragma unroll
  for (int i = 0; i < 8; ++i) { O[i][0] = (f32x4){0.f, 0.f, 0.f, 0.f}; O[i][1] = (f32x4){0.f, 0.f, 0.f, 0.f}; }
  int ka[4], va[8];
#pragma unroll
  for (int ks = 0; ks < 4; ++ks) ka[ks] = offK16(fr, 4 * ks + fq);
  { const int q = (lane & 15) >> 2, p = lane & 3;
#pragma unroll
    for (int c = 0; c < 8; ++c) va[c] = offV16(4 * fq + q, 2 * c + (p >> 1)) + 8 * (p & 1); }
  const LAS char* k3 = (const LAS char*)K_lds; const LAS char* v3 = (const LAS char*)V_lds;
  bf16x8 fr_[8];
  const int sr = tid >> 4, scc = tid & 15, kst = offK16(sr, scc), vst = offV16(sr, scc);
  bf16x8 s_v0, s_v1, s_k0, s_k1;
#define SLOAD(k0) do { s_v0 = *reinterpret_cast<const bf16x8*>(&Vh[(long)((k0) + sr) * LDK + scc * 8]); s_v1 = *reinterpret_cast<const bf16x8*>(&Vh[(long)((k0) + 32 + sr) * LDK + scc * 8]); \
    s_k0 = *reinterpret_cast<const bf16x8*>(&Kh[(long)((k0) + sr) * LDK + scc * 8]); s_k1 = *reinterpret_cast<const bf16x8*>(&Kh[(long)((k0) + 32 + sr) * LDK + scc * 8]); } while (0)
#define SWRITE(bo) do { *(bf16x8*)(V_lds + (bo) + vst) = s_v0; *(bf16x8*)(V_lds + (bo) + vst + 8192) = s_v1; *(bf16x8*)(K_lds + (bo) + kst) = s_k0; *(bf16x8*)(K_lds + (bo) + kst + 8192) = s_k1; } while (0)
#define VMW0() asm volatile("s_waitcnt vmcnt(0)" ::: "memory")
#define BAR() asm volatile("s_waitcnt lgkmcnt(0)\n\ts_barrier" ::: "memory")
#define ROT() do { const int t_ = o_prev; o_prev = o_cur; o_cur = o_next; o_next = t_; } while (0)
#define VSEG(j, wbuf_, pbuf_) do { VMW0(); SWRITE(wbuf_); { const int nx_ = (j) + 2 + half; SLOAD((nx_ < NT ? nx_ : NT - 1) * KVBLK); } SBAR(); \
    if (__builtin_expect(shift != 0.f, 0)) { _Pragma("unroll") for (int i_ = 0; i_ < 4; ++i_) { S[i_][0] -= shift; S[i_][1] -= shift; } } \
    _Pragma("unroll") for (int qb_ = 0; qb_ < 2; ++qb_) { \
      _Pragma("unroll") for (int i_ = 0; i_ < 4; ++i_) _Pragma("unroll") for (int r_ = 0; r_ < 4; ++r_) S[i_][qb_][r_] = __builtin_amdgcn_exp2f(S[i_][qb_][r_]); \
      float a_ = 0.f; _Pragma("unroll") for (int i_ = 0; i_ < 4; ++i_) a_ += (S[i_][qb_][0] + S[i_][qb_][1]) + (S[i_][qb_][2] + S[i_][qb_][3]); lsum[qb_] += a_; \
      _Pragma("unroll") for (int s_ = 0; s_ < 2; ++s_) { u32x4 w_ = {cvtpk(S[2 * s_][qb_][0], S[2 * s_][qb_][1]), cvtpk(S[2 * s_][qb_][2], S[2 * s_][qb_][3]), cvtpk(S[2 * s_ + 1][qb_][0], S[2 * s_ + 1][qb_][1]), cvtpk(S[2 * s_ + 1][qb_][2], S[2 * s_ + 1][qb_][3])}; \
        pf[qb_][s_] = *reinterpret_cast<bf16x8*>(&w_); } } \
    SBAR(); _Pragma("unroll") for (int s_ = 0; s_ < 8; ++s_) fr_[s_] = ld_frag16(s_, k3, ka, v3 + (pbuf_), va); SBAR(); } while (0)
  const int NT = nkeys / KVBLK;
  int o_prev = 2 * BUFB, o_cur = 0, o_next = BUFB;
  SLOAD(0); VMW0(); SWRITE(0);
  if (half) { SLOAD(KVBLK); VMW0(); SWRITE(BUFB); SLOAD(2 * KVBLK); } else { SLOAD(KVBLK); }
  BAR();
  if (half == 0) {
    mrun16<16, 32, false>(fr_, S, O, qf, pf, k3 + o_cur, ka, v3 + o_prev, va);
    VSEG(0, o_next, o_cur);
    BAR(); ROT();
    for (int j = 1; j < NT; ++j) {
      mrun16<0, 32, true>(fr_, S, O, qf, pf, k3 + o_cur, ka, v3 + o_prev, va);
      VSEG(j, o_next, o_cur);
      BAR(); ROT();
    }
    mrun16<0, 16, true>(fr_, S, O, qf, pf, k3 + o_cur, ka, v3 + o_prev, va);
  } else {
    mrun16<16, 32, false>(fr_, S, O, qf, pf, k3 + o_cur, ka, v3 + o_prev, va);
    BAR(); ROT();
    for (int j = 1; j < NT; ++j) {
      VSEG(j - 1, o_next, o_prev);
      mrun16<0, 32, true>(fr_, S, O, qf, pf, k3 + o_cur, ka, v3 + o_prev, va);
      BAR(); ROT();
    }
    VSEG(NT - 1, o_next, o_prev);
    mrun16<0, 16, true>(fr_, S, O, qf, pf, k3 + o_cur, ka, v3 + o_prev, va);
  }
  float rl[2];
#pragma unroll
  for (int qb = 0; qb < 2; ++qb) { float l = lsum[qb]; l += __shfl_xor(l, 16); l += __shfl_xor(l, 32); rl[qb] = __builtin_amdgcn_rcpf(l); }
  VMW0();
  __syncthreads();
  char* ost = lds + OFF_OST + wid * 8192;
#pragma unroll
  for (int db = 0; db < 8; ++db)
#pragma unroll
    for (int qb = 0; qb < 2; ++qb) { const f32x4 v = O[db][qb] * rl[qb]; u32x2 w; w.x = cvtpk(v[0], v[1]); w.y = cvtpk(v[2], v[3]);
      *(u32x2*)(ost + (16 * qb + fr) * 256 + (16 * db + 4 * fq) * 2) = w; }
  asm volatile("s_waitcnt lgkmcnt(0)" ::: "memory");
  bf16_t* Ow = Ob + (long)(wid * QBLK) * LDQ;
#pragma unroll
  for (int i = 0; i < 8; ++i) { const int ch = i * 64 + lane, row = ch >> 4, c16 = ch & 15;
    const u32x4 v = *(const u32x4*)(ost + row * 256 + c16 * 16); *(u32x4*)(Ow + (long)row * LDQ + c16 * 8) = v; }
  asm volatile("s_waitcnt lgkmcnt(0)" ::: "memory");
  __syncthreads();
#undef SLOAD
#undef SWRITE
#undef VMW0
#undef BAR
#undef ROT
#undef VSEG
}

typedef int v8i_t __attribute__((ext_vector_type(8)));
typedef short v2s_t __attribute__((ext_vector_type(2)));
__device__ __forceinline__ int off8(int row, int c16) { return row * 128 + 16 * (c16 ^ (((row >> 1) & 1) | (((row >> 2) & 1) << 2))); }
__device__ __forceinline__ v8i_t ld_frag8(const LAS char* img, int a0, int a1, int blk) {
  const u32x4 lo = *(const LAS u32x4*)(img + blk * 2048 + a0), hi = *(const LAS u32x4*)(img + blk * 2048 + a1);
  return (v8i_t){(int)lo.x, (int)lo.y, (int)lo.z, (int)lo.w, (int)hi.x, (int)hi.y, (int)hi.z, (int)hi.w};
}
__device__ __forceinline__ void exp_pack8(f32x4 (&S)[4][2], v8i_t (&pf)[2], float (&lsum)[2], float pscale, int h) {
#pragma unroll
  for (int qb = 0; qb < 2; ++qb) { float a = 0.f;
#pragma unroll
    for (int i = 0; i < 4; ++i) { f32x4 e;
#pragma unroll
      for (int r = 0; r < 4; ++r) e[r] = __builtin_amdgcn_exp2f(S[i][qb][r]);
      a += (e[0] + e[1]) + (e[2] + e[3]);
      v2s_t p = {0, 0}; p = __builtin_amdgcn_cvt_scalef32_pk_bf8_f32(p, e[0], e[1], pscale, false); p = __builtin_amdgcn_cvt_scalef32_pk_bf8_f32(p, e[2], e[3], pscale, true);
      const int w = __builtin_bit_cast(int, p);
      if (h == 0) { if (i == 0) pf[qb][0] = w; else if (i == 1) pf[qb][1] = w; else if (i == 2) pf[qb][2] = w; else pf[qb][3] = w; }
      else { if (i == 0) pf[qb][4] = w; else if (i == 1) pf[qb][5] = w; else if (i == 2) pf[qb][6] = w; else pf[qb][7] = w; } }
    lsum[qb] += a; }
}
template <bool DO_PV, bool DO_QK, bool PRE>
__device__ __forceinline__ void mrun8(v8i_t (&f)[2], f32x4 (&S)[4][2], f32x4 (&O)[8][2], const v8i_t (&qf)[2], v8i_t (&pf)[2], float (&lsum)[2], float pscale, const LAS char* kimg, const LAS char* vimg, int a0, int a1) {
  constexpr int SB = DO_PV ? 0 : 8, SE = DO_QK ? 16 : 8;
  SBAR();
  if (!PRE) {
#pragma unroll
    for (int s = SB; s < SB + 2; ++s) f[s & 1] = (s >= 8) ? ld_frag8(kimg, a0, a1, s - 8) : ld_frag8(vimg, a0, a1, s);
    SBAR(); }
#pragma unroll
  for (int sp = SB; sp < SE; ++sp) {
    if (sp >= 8) { const int kb = sp - 8; const f32x4 z = {0.f, 0.f, 0.f, 0.f};
      S[kb & 3][0] = __builtin_amdgcn_mfma_scale_f32_16x16x128_f8f6f4(f[sp & 1], qf[0], z, 0, 0, 0, 0, 0, 0); S[kb & 3][1] = __builtin_amdgcn_mfma_scale_f32_16x16x128_f8f6f4(f[sp & 1], qf[1], z, 0, 0, 0, 0, 0, 0); }
    else { O[sp][0] = __builtin_amdgcn_mfma_scale_f32_16x16x128_f8f6f4(f[sp & 1], pf[0], O[sp][0], 0, 1, 0, 0, 0, 0); O[sp][1] = __builtin_amdgcn_mfma_scale_f32_16x16x128_f8f6f4(f[sp & 1], pf[1], O[sp][1], 0, 1, 0, 0, 0, 0); }
    if (sp + 2 < SE) f[sp & 1] = (sp + 2 >= 8) ? ld_frag8(kimg, a0, a1, sp + 2 - 8) : ld_frag8(vimg, a0, a1, sp + 2);
    SBAR();
    if (sp == 11) { exp_pack8(S, pf, lsum, pscale, 0); SBAR(); }
  }
}
__device__ __forceinline__ float xsum16(float x) { auto r = __builtin_amdgcn_permlane16_swap(__float_as_uint(x), __float_as_uint(x), false, false); return __uint_as_float(r[0]) + __uint_as_float(r[1]); }
__device__ __forceinline__ float xsum32(float x) { auto r = __builtin_amdgcn_permlane32_swap(__float_as_uint(x), __float_as_uint(x), false, false); return __uint_as_float(r[0]) + __uint_as_float(r[1]); }
__device__ __forceinline__ float xchg16(float x, bool odd) { auto r = __builtin_amdgcn_permlane16_swap(__float_as_uint(x), __float_as_uint(x), false, false); return __uint_as_float(odd ? r[0] : r[1]); }
__device__ __forceinline__ void attn_unit8(const bf16_t* Qb, const unsigned char* __restrict__ K8, const unsigned char* __restrict__ V8T, bf16_t* Ob, int q0, char* lds, const Aux& aux, float pscale) {
  int tid = threadIdx.x; asm volatile("" : "+v"(tid));
  const int wid = tid >> 6, lane = tid & 63, fr = lane & 15, g = lane >> 4;
  const int half = __builtin_amdgcn_readfirstlane(wid >> 2);
  v8i_t qf[2];
  { char* qs = lds + 3 * BUFB + wid * 4096;
#pragma unroll
    for (int qb = 0; qb < 2; ++qb) {
      bf16x8 q16[4]; float ss = 0.f;
#pragma unroll
      for (int ks = 0; ks < 4; ++ks) { q16[ks] = *reinterpret_cast<const bf16x8*>(Qb + (long)(wid * QBLK + 16 * qb + fr) * LDQ + 32 * ks + 8 * g); const f32x8 x = bf8_to_f32(q16[ks]);
#pragma unroll
        for (int e = 0; e < 8; ++e) ss += x[e] * x[e]; }
      ss = xsum32(xsum16(ss));
      const float rinv = C / sqrtf(ss * (1.0f / 128.0f) + EPS);
      const int t = q0 + wid * QBLK + 16 * qb + fr;
#pragma unroll
      for (int hf = 0; hf < 2; ++hf) { const int posx = hf ? (t & 63) : (t >> 6);
        const f32x8 cs = *reinterpret_cast<const f32x8*>(aux.cosT + posx * 32 + 8 * g), sn = *reinterpret_cast<const f32x8*>(aux.sinT + posx * 32 + 8 * g);
        const f32x8 g1 = *reinterpret_cast<const f32x8*>(aux.qn + hf * 64 + 8 * g), g2 = *reinterpret_cast<const f32x8*>(aux.qn + hf * 64 + 32 + 8 * g);
        const f32x8 x1 = bf8_to_f32(q16[2 * hf]) * rinv * g1, x2 = bf8_to_f32(q16[2 * hf + 1]) * rinv * g2;
        const f32x8 y1 = x1 * cs - x2 * sn, y2 = x2 * cs + x1 * sn;
        int a0_ = 0, a1_ = 0, b0_ = 0, b1_ = 0;
        a0_ = __builtin_amdgcn_cvt_pk_fp8_f32(y1[0], y1[1], a0_, false); a0_ = __builtin_amdgcn_cvt_pk_fp8_f32(y1[2], y1[3], a0_, true); a1_ = __builtin_amdgcn_cvt_pk_fp8_f32(y1[4], y1[5], a1_, false); a1_ = __builtin_amdgcn_cvt_pk_fp8_f32(y1[6], y1[7], a1_, true);
        b0_ = __builtin_amdgcn_cvt_pk_fp8_f32(y2[0], y2[1], b0_, false); b0_ = __builtin_amdgcn_cvt_pk_fp8_f32(y2[2], y2[3], b0_, true); b1_ = __builtin_amdgcn_cvt_pk_fp8_f32(y2[4], y2[5], b1_, false); b1_ = __builtin_amdgcn_cvt_pk_fp8_f32(y2[6], y2[7], b1_, true);
        *(u32x2*)(qs + (16 * qb + fr) * 128 + 32 * (2 * hf) + 8 * g) = (u32x2){(unsigned)a0_, (unsigned)a1_}; *(u32x2*)(qs + (16 * qb + fr) * 128 + 32 * (2 * hf + 1) + 8 * g) = (u32x2){(unsigned)b0_, (unsigned)b1_}; }
    }
    asm volatile("s_waitcnt lgkmcnt(0)" ::: "memory");
#pragma unroll
    for (int qb = 0; qb < 2; ++qb) { const u32x4 lo = *(const u32x4*)(qs + (16 * qb + fr) * 128 + 32 * g), hi = *(const u32x4*)(qs + (16 * qb + fr) * 128 + 32 * g + 16);
      qf[qb] = (v8i_t){(int)lo.x, (int)lo.y, (int)lo.z, (int)lo.w, (int)hi.x, (int)hi.y, (int)hi.z, (int)hi.w}; }
    asm volatile("s_waitcnt lgkmcnt(0)" ::: "memory"); }
  f32x4 O[8][2], S[4][2]; v8i_t pf[2]; float lsum[2] = {0.f, 0.f};
#pragma unroll
  for (int i = 0; i < 8; ++i) { O[i][0] = (f32x4){0.f, 0.f, 0.f, 0.f}; O[i][1] = (f32x4){0.f, 0.f, 0.f, 0.f}; }
  const int a0 = off8(fr, 2 * g), a1 = off8(fr, 2 * g + 1);
  char* V_lds = lds; char* K_lds = lds + SHM_V;
  const LAS char* k3 = (const LAS char*)K_lds; const LAS char* v3 = (const LAS char*)V_lds;
  v8i_t fr_[2];
  const int widu = __builtin_amdgcn_readfirstlane(wid);
  unsigned dso[2];
#pragma unroll
  for (int i = 0; i < 2; ++i) { const int c = (wid * 2 + i) * 64 + lane, row = c >> 3, p = c & 7; dso[i] = (unsigned)(row * 128 + ((p ^ (((row >> 1) & 1) | (((row >> 2) & 1) << 2))) << 4)); }
  const unsigned ldsw = (unsigned)widu * 2048u; LAS unsigned char* l3 = (LAS unsigned char*)lds;
#define DMA_TILE(t_) do { const unsigned char* kg_ = K8 + (size_t)(t_) * 16384; const unsigned char* vg_ = V8T + (size_t)(t_) * 16384; const unsigned bo_ = (unsigned)(((t_) & 3) * BUFB); \
    _Pragma("unroll") for (int i_ = 0; i_ < 2; ++i_) { \
      __builtin_amdgcn_global_load_lds((const unsigned*)(vg_ + dso[i_]), (LAS unsigned*)(l3 + bo_ + ldsw + i_ * 1024), 16, 0, 0); \
      __builtin_amdgcn_global_load_lds((const unsigned*)(kg_ + dso[i_]), (LAS unsigned*)(l3 + bo_ + SHM_V + ldsw + i_ * 1024), 16, 0, 0); } } while (0)
#define VMW0() asm volatile("s_waitcnt vmcnt(0)" ::: "memory")
#define BAR() asm volatile("s_waitcnt lgkmcnt(0)\n\ts_barrier" ::: "memory")
#define VSEG(j, pbuf_) do { VMW0(); { const int nx_ = (j) + 2 + half; if (nx_ < NT) DMA_TILE(nx_); } SBAR(); \
    exp_pack8(S, pf, lsum, pscale, 1); \
    SBAR(); _Pragma("unroll") for (int s_ = 0; s_ < 2; ++s_) fr_[s_] = ld_frag8(v3 + (pbuf_), a0, a1, s_); SBAR(); } while (0)
  constexpr int NT = SEQ / 128;
  DMA_TILE(0); DMA_TILE(1); if (half) DMA_TILE(2);
  VMW0(); BAR();
  if (half) BAR();
  mrun8<false, true, false>(fr_, S, O, qf, pf, lsum, pscale, k3, v3, a0, a1);
  BAR();
  VSEG(0, 0);
  BAR();
  for (int j = 1; j < NT; ++j) {
    mrun8<true, true, true>(fr_, S, O, qf, pf, lsum, pscale, k3 + (j & 3) * BUFB, v3 + ((j - 1) & 3) * BUFB, a0, a1);
    BAR();
    VSEG(j, (j & 3) * BUFB);
    BAR();
  }
  mrun8<true, false, true>(fr_, S, O, qf, pf, lsum, pscale, k3, v3 + ((NT - 1) & 3) * BUFB, a0, a1);
  if (!half) BAR();
  float rl[2];
#pragma unroll
  for (int qb = 0; qb < 2; ++qb) { const float l = xsum32(xsum16(lsum[qb])); rl[qb] = pscale * __builtin_amdgcn_rcpf(l); }
  VMW0();
  __syncthreads();
  char* ost = lds + OFF_OST + wid * 8192;
#pragma unroll
  for (int db = 0; db < 8; ++db)
#pragma unroll
    for (int qb = 0; qb < 2; ++qb) { const f32x4 v = O[db][qb] * rl[qb]; u32x2 w; w.x = cvtpk(v[0], v[1]); w.y = cvtpk(v[2], v[3]);
      *(u32x2*)(ost + (16 * qb + fr) * 256 + (16 * db + 4 * g) * 2) = w; }
  asm volatile("s_waitcnt lgkmcnt(0)" ::: "memory");
  bf16_t* Ow = Ob + (long)(wid * QBLK) * LDQ;
#pragma unroll
  for (int i = 0; i < 8; ++i) { const int ch = i * 64 + lane, row = ch >> 4, c16 = ch & 15;
    const u32x4 v = *(const u32x4*)(ost + row * 256 + c16 * 16); *(u32x4*)(Ow + (long)row * LDQ + c16 * 8) = v; }
  asm volatile("s_waitcnt lgkmcnt(0)" ::: "memory");
  __syncthreads();
#undef DMA_TILE
#undef VMW0
#undef BAR
#undef VSEG
}
}

#define XB_TMO      128
#define XB_XCNT(j)  (256  + 64 * (j))
#define XB_XSUB(j)  (1280 + 64 * (j))
#define XB_XGEN(j)  (2304 + 64 * (j))
#define XB_TOP      3328
#define XB_TOPGEN   3392
#define XCD_BAR_WORDS 3456
#define XB_SPIN_CAP (1u << 18)
__device__ __forceinline__ unsigned xb_ld(unsigned* p)              { return __hip_atomic_load(p, __ATOMIC_RELAXED, __HIP_MEMORY_SCOPE_AGENT); }
__device__ __forceinline__ unsigned xb_add(unsigned* p, unsigned v) { return __hip_atomic_fetch_add(p, v, __ATOMIC_RELAXED, __HIP_MEMORY_SCOPE_AGENT); }
__device__ __forceinline__ unsigned xb_xcc_id() { return (unsigned)__builtin_amdgcn_s_getreg((3 << 11) | 20) & 0xFu; }
#define XB_SPIN(cond, bar) do { unsigned _sp = 0; while (cond) { __builtin_amdgcn_s_sleep(1); \
    if ((++_sp & 255u) == 0u) { if (xb_ld(&(bar)[XB_TMO])) break; if (_sp > XB_SPIN_CAP) { atomicAdd(&(bar)[XB_TMO], 1u); break; } } } } while (0)
struct XcdBarrier { unsigned* bar; unsigned x; volatile LAS unsigned* st; };
__device__ __forceinline__ XcdBarrier xcd_barrier_post(unsigned* bar, volatile LAS unsigned* st) {
    XcdBarrier b; b.bar = bar; b.x = xb_xcc_id(); b.st = st;
    if (threadIdx.x == 0) (void)xb_add(&bar[XB_XCNT(b.x)], 1u);
    return b;
}
__device__ __forceinline__ void xcd_barrier_complete(unsigned* bar, unsigned x, unsigned& nloc, unsigned& nx) {
    const unsigned G = gridDim.x * gridDim.y * gridDim.z;
    unsigned sum, cnt, mine, sp = 0u;
    for (;;) {
        sum = 0u; cnt = 0u; mine = 0u;
#pragma unroll
        for (unsigned j = 0; j < 16; ++j) { const unsigned c = xb_ld(&bar[XB_XCNT(j)]); sum += c; cnt += (c > 0u) ? 1u : 0u; mine = (j == x) ? c : mine; }
        if (sum == G) break;
        __builtin_amdgcn_s_sleep(1);
        if ((++sp & 255u) == 0u) { if (xb_ld(&bar[XB_TMO])) break; if (sp > XB_SPIN_CAP) { atomicAdd(&bar[XB_TMO], 1u); break; } }
    }
    nloc = mine > 0u ? mine : 1u; nx = cnt > 0u ? cnt : 1u;
}
__device__ __forceinline__ void xcd_barrier(const XcdBarrier& b) {
    asm volatile("s_waitcnt vmcnt(0)" ::: "memory");
    __syncthreads();
    if (threadIdx.x == 0) {
        unsigned* bar = b.bar;
        __builtin_amdgcn_s_waitcnt(0);
        unsigned nloc = b.st[0], nx = b.st[1];
        if (nloc == 0u) { xcd_barrier_complete(bar, b.x, nloc, nx); b.st[0] = nloc; b.st[1] = nx; }
        const unsigned old = xb_add(&bar[XB_XSUB(b.x)], 1u);
        const unsigned gen = old / nloc;
        if (old + 1u == (gen + 1u) * nloc) {
            __builtin_amdgcn_fence(__ATOMIC_RELEASE, "agent");
            asm volatile("s_waitcnt vmcnt(0)" ::: "memory");
            const unsigned og = xb_add(&bar[XB_TOP], 1u);
            const unsigned tg = og / nx;
            if (og + 1u == (tg + 1u) * nx) xb_add(&bar[XB_TOPGEN], 1u);
            else XB_SPIN(xb_ld(&bar[XB_TOPGEN]) == tg, bar);
            __builtin_amdgcn_fence(__ATOMIC_ACQUIRE, "agent");
            xb_add(&bar[XB_XGEN(b.x)], 1u);
            asm volatile("s_waitcnt vmcnt(0)" ::: "memory");
        } else {
            XB_SPIN(xb_ld(&bar[XB_XGEN(b.x)]) == gen, bar);
            __builtin_amdgcn_fence(__ATOMIC_ACQUIRE, "agent");
            asm volatile("s_waitcnt vmcnt(0)" ::: "memory");
        }
    }
    __syncthreads();
}

struct Args { const float* in[17]; float* out; unsigned char* ws; int ph_lo, ph_hi, li, pad; };
struct Frame { LAS unsigned char* lds; int tid, lane, wave, vcu, G; };
constexpr int NWAVES = 8;

__device__ __forceinline__ void tr_item(const float* W, int N, int k0, int n0, bf16_t* WT, int Kd, int drow0, LAS float* scr, int lane) {
    float tv[32];
#pragma unroll
    for (int i = 0; i < 32; ++i) { const int kk = 2 * i + (lane >> 5); tv[i] = W[(size_t)(k0 + kk) * N + n0 + (lane & 31)]; }
#pragma unroll
    for (int i = 0; i < 32; ++i) { const int kk = 2 * i + (lane >> 5); scr[kk * 33 + (lane & 31)] = tv[i]; }
    LDS_WAIT(); asm volatile("" ::: "memory");
    const int c = lane & 7;
#pragma unroll
    for (int j = 0; j < 4; ++j) { const int n = (lane >> 3) + 8 * j; const LAS float* s = scr + (8 * c) * 33 + n;
        u32x4 o; o.x = cvt_pk_bf16(s[0 * 33], s[1 * 33]); o.y = cvt_pk_bf16(s[2 * 33], s[3 * 33]); o.z = cvt_pk_bf16(s[4 * 33], s[5 * 33]); o.w = cvt_pk_bf16(s[6 * 33], s[7 * 33]);
        *(GAS u32x4*)(WT + (size_t)(drow0 + n) * Kd + k0 + 8 * c) = o; }
    LDS_WAIT(); asm volatile("" ::: "memory");
}
__device__ __forceinline__ void rms_row_to_bf16(const float* xrow, const float* g, bf16_t* orow, int lane) {
    const GAS f32x4* xr = (const GAS f32x4*)xrow + lane; const GAS f32x4* gr = (const GAS f32x4*)g + lane;
    f32x4 v[8]; float s = 0.f;
#pragma unroll
    for (int j = 0; j < 8; ++j) { v[j] = xr[64 * j]; s += (v[j].x * v[j].x + v[j].y * v[j].y) + (v[j].z * v[j].z + v[j].w * v[j].w); }
    const float rinv = 1.0f / sqrtf(wave_sum(s) * (1.f / DM) + EPS);
    GAS u32x2* o8 = (GAS u32x2*)orow + lane;
#pragma unroll
    for (int j = 0; j < 8; ++j) { const f32x4 gv = gr[64 * j]; u32x2 w; w.x = cvt_pk_bf16(v[j].x * rinv * gv.x, v[j].y * rinv * gv.y); w.y = cvt_pk_bf16(v[j].z * rinv * gv.z, v[j].w * rinv * gv.w); o8[64 * j] = w; }
}

__device__ __forceinline__ void p0_prologue(const Frame& F, const Args& a) {
    unsigned char* ws = a.ws;
    LAS float* scr = (LAS float*)(F.lds + F.wave * 16384);
    const int gw = F.vcu * NWAVES + F.wave, NGW = F.G * NWAVES;
    constexpr int I_IN = (DM / 64) * (INW / 32), I_P = (QW / 64) * (DM / 32), I_O = (DM / 64) * (DM / 32);
    constexpr int NITEMS = I_IN + 2 * I_P + I_O;
    for (int it = gw; it < NITEMS; it += NGW) {
        int r = it;
        if (r < I_IN) { const int nb = INW / 32, kb = r / nb, n0 = (r % nb) * 32; tr_item(a.in[2], INW, kb * 64, n0, (bf16_t*)(ws + WS_WIN), DM, n0, scr, F.lane); continue; } r -= I_IN;
        if (r < I_P) { const int nb = DM / 32, kb = r / nb, n0 = (r % nb) * 32; tr_item(a.in[6], DM, kb * 64, n0, (bf16_t*)(ws + WS_WPA), QW, n0, scr, F.lane); continue; } r -= I_P;
        if (r < I_P) { const int nb = DM / 32, kb = r / nb, n0 = (r % nb) * 32; tr_item(a.in[9], DM, kb * 64, n0, (bf16_t*)(ws + WS_WPB), QW, n0, scr, F.lane); continue; } r -= I_P;
        { const int nb = DM / 32, kb = r / nb, n0 = (r % nb) * 32; tr_item(a.in[10], DM, kb * 64, n0, (bf16_t*)(ws + WS_WO), DM, n0, scr, F.lane); }
    }
    float* cosT = (float*)(ws + WS_ROPE); float* sinT = cosT + 128 * 32;
    for (int i = blockIdx.x * 512 + F.tid; i < 128 * 32; i += F.G * 512) { const int pos = i >> 5, p = i & 31;
        const float inv = 1.0f / powf(10000.0f, (float)(2 * p) / 64.0f); const float ang = (float)pos * inv; cosT[i] = cosf(ang); sinT[i] = sinf(ang); }
    { const float* X = a.in[0]; const float* gm = a.in[1]; bf16_t* H = (bf16_t*)(ws + WS_H); const int lane = F.lane;
      f32x4 nx[8]; int m = gw;
      if (m < NTOK) { const GAS f32x4* xr = (const GAS f32x4*)(X + (size_t)m * DM) + lane;
#pragma unroll
          for (int j = 0; j < 8; ++j) nx[j] = xr[64 * j]; }
      for (; m < NTOK; m += NGW) { f32x4 v[8]; float s = 0.f;
#pragma unroll
          for (int j = 0; j < 8; ++j) { v[j] = nx[j]; s += (v[j].x * v[j].x + v[j].y * v[j].y) + (v[j].z * v[j].z + v[j].w * v[j].w); }
          { const int nm = m + NGW; if (nm < NTOK) { const GAS f32x4* xr = (const GAS f32x4*)(X + (size_t)nm * DM) + lane;
#pragma unroll
              for (int j = 0; j < 8; ++j) nx[j] = xr[64 * j]; } }
          const float rinv = 1.0f / sqrtf(wave_sum(s) * (1.f / DM) + EPS);
          GAS u32x2* o8 = (GAS u32x2*)(H + (size_t)m * DM) + lane;
#pragma unroll
          for (int j = 0; j < 8; ++j) { const f32x4 gv = ((const GAS f32x4*)gm + lane)[64 * j]; u32x2 w; w.x = cvt_pk_bf16(v[j].x * rinv * gv.x, v[j].y * rinv * gv.y); w.y = cvt_pk_bf16(v[j].z * rinv * gv.z, v[j].w * rinv * gv.w); o8[64 * j] = w; } } }
}

constexpr int CW_WCTR = 8192;
__device__ __forceinline__ void p_moe_weights(const Frame& F, const Args& a) {
    unsigned char* ws = a.ws; LAS float* scr = (LAS float*)(F.lds + F.wave * 16384);
    constexpr int I_GU = NEXP * (DM / 64) * (DFF / 32), I_D = NEXP * (DFF / 64) * (DM / 32), NIT = 2 * I_GU + I_D;
    unsigned* ctr = (unsigned*)(ws + WS_CTL) + CW_WCTR;
    for (;;) {
        unsigned it0 = 0; if (F.lane == 0) it0 = __hip_atomic_fetch_add(ctr, 4u, __ATOMIC_RELAXED, __HIP_MEMORY_SCOPE_AGENT);
        it0 = (unsigned)__builtin_amdgcn_readfirstlane((int)it0);
        if (it0 >= (unsigned)NIT) break;
        for (int k4 = 0; k4 < 4; ++k4) { int r = (int)it0 + k4; if (r >= NIT) break;
            if (r < 2 * I_GU) { const int up = r >= I_GU; if (up) r -= I_GU; constexpr int per = (DM / 64) * (DFF / 32); const int e = r / per, q = r % per, nb = DFF / 32, kb = q / nb, n0 = (q % nb) * 32;
                tr_item(a.in[up ? 14 : 13] + (size_t)e * DM * DFF, DFF, kb * 64, n0, (bf16_t*)(ws + WS_WGU) + (size_t)e * 2048 * DM, DM, (n0 >> 7) * 256 + (n0 & 127) + (up ? 128 : 0), scr, F.lane); continue; }
            r -= 2 * I_GU;
            { constexpr int per = (DFF / 64) * (DM / 32); const int e = r / per, q = r % per, nb = DM / 32, kb = q / nb, n0 = (q % nb) * 32;
                tr_item(a.in[15] + (size_t)e * DFF * DM, DM, kb * 64, n0, (bf16_t*)(ws + WS_WD) + (size_t)e * 2048 * DFF, DFF, n0, scr, F.lane); } }
    }
}

__device__ __forceinline__ void prep_vecs(const Frame& F, bf16_t* T, int ld, int nh_log2, const float* gain, const float* cosT, const float* sinT, float oscale, unsigned char* out8) {
    const int gw = F.vcu * NWAVES + F.wave, NGW = F.G * NWAVES;
    const int sub = F.lane & 15, half = sub >> 3, q = sub & 7;
    const int nvec = NTOK << nh_log2;
    const f32x4 g1 = *(const f32x4*)(gain + half * 64 + 4 * q), g2 = *(const f32x4*)(gain + half * 64 + 32 + 4 * q);
    for (int it = gw; it < nvec / 16; it += NGW) {
        bf16_t* base[4]; u32x2 w1[4], w2[4]; int posx[4];
#pragma unroll
        for (int u = 0; u < 4; ++u) { const int vec = it * 16 + u * 4 + (F.lane >> 4);
            const int tok = vec >> nh_log2, hd = vec & ((1 << nh_log2) - 1), pos = tok & (SEQ - 1); posx[u] = half ? (pos & 63) : (pos >> 6);
            base[u] = T + (size_t)tok * ld + hd * HD + half * 64 + 4 * q; w1[u] = *(const u32x2*)base[u]; w2[u] = *(const u32x2*)(base[u] + 32); }
#pragma unroll
        for (int u = 0; u < 4; ++u) {
            float x1[4] = {bf2f(w1[u].x & 0xffff), bf2f(w1[u].x >> 16), bf2f(w1[u].y & 0xffff), bf2f(w1[u].y >> 16)}, x2[4] = {bf2f(w2[u].x & 0xffff), bf2f(w2[u].x >> 16), bf2f(w2[u].y & 0xffff), bf2f(w2[u].y >> 16)};
            float ss = 0.f;
#pragma unroll
            for (int j = 0; j < 4; ++j) ss += x1[j] * x1[j] + x2[j] * x2[j];
            ss += __shfl_xor(ss, 1); ss += __shfl_xor(ss, 2); ss += __shfl_xor(ss, 4); ss += __shfl_xor(ss, 8);
            const float rinv = 1.0f / sqrtf(ss * (1.0f / 128.0f) + EPS);
            const f32x4 cs = *(const f32x4*)(cosT + posx[u] * 32 + 4 * q), sn = *(const f32x4*)(sinT + posx[u] * 32 + 4 * q);
            float y1[4], y2[4];
#pragma unroll
            for (int j = 0; j < 4; ++j) { const float a1 = x1[j] * rinv * g1[j], a2 = x2[j] * rinv * g2[j]; y1[j] = (a1 * cs[j] - a2 * sn[j]) * oscale; y2[j] = (a2 * cs[j] + a1 * sn[j]) * oscale; }
            if (out8) {
                const int vec = it * 16 + u * 4 + (F.lane >> 4), tok = vec >> nh_log2, hd = vec & ((1 << nh_log2) - 1);
                unsigned char* o8 = out8 + ((size_t)(((tok >> 13) << nh_log2) + hd) * SEQ + (tok & (SEQ - 1))) * HD + half * 64 + 4 * q;
                int w1 = 0, w2 = 0; w1 = __builtin_amdgcn_cvt_pk_fp8_f32(y1[0], y1[1], w1, false); w1 = __builtin_amdgcn_cvt_pk_fp8_f32(y1[2], y1[3], w1, true);
                w2 = __builtin_amdgcn_cvt_pk_fp8_f32(y2[0], y2[1], w2, false); w2 = __builtin_amdgcn_cvt_pk_fp8_f32(y2[2], y2[3], w2, true);
                *(int*)o8 = w1; *(int*)(o8 + 32) = w2;
            } else {
            u32x2 o1, o2; o1.x = cvt_pk_bf16(y1[0], y1[1]); o1.y = cvt_pk_bf16(y1[2], y1[3]); o2.x = cvt_pk_bf16(y2[0], y2[1]); o2.y = cvt_pk_bf16(y2[2], y2[3]);
            *(u32x2*)base[u] = o1; *(u32x2*)(base[u] + 32) = o2; } }
    }
}
__device__ __forceinline__ void p2_qkprep(const Frame& F, const Args& a) {
    const float* cosT = (const float*)(a.ws + WS_ROPE); const float* sinT = cosT + 128 * 32;
    prep_vecs(F, (bf16_t*)(a.ws + WS_KA), KVW, 1, a.in[5], cosT, sinT, 1.0f, a.ws + WS_K8);
    { const bf16_t* VA = (const bf16_t*)(a.ws + WS_VA); unsigned char* V8T = a.ws + WS_V8T; LAS bf16_t* tl = (LAS bf16_t*)F.lds; constexpr int TP = 132;
      for (int T = F.vcu; T < BATCH * 2 * 64; T += F.G) { const int bk = T >> 6, t = T & 63, b = bk >> 1, kvh = bk & 1;
        { const int r = F.tid >> 2, qd = F.tid & 3; const bf16_t* src = VA + ((size_t)b * SEQ + 128 * t + r) * KVW + kvh * HD + qd * 32;
#pragma unroll
          for (int i = 0; i < 4; ++i) { const u32x4 v = *(const u32x4*)(src + 8 * i); LAS unsigned* d = (LAS unsigned*)(tl + r * TP + qd * 32 + 8 * i); d[0] = v.x; d[1] = v.y; d[2] = v.z; d[3] = v.w; } }
        __syncthreads();
        { const int d = F.tid >> 2, g = F.tid & 3; int w[8];
#pragma unroll
          for (int kb = 0; kb < 8; ++kb) { float x[4];
#pragma unroll
            for (int r = 0; r < 4; ++r) x[r] = bf2f(tl[(16 * kb + 4 * g + r) * TP + d]);
            int ww = 0; ww = __builtin_amdgcn_cvt_pk_fp8_f32(x[0], x[1], ww, false); ww = __builtin_amdgcn_cvt_pk_fp8_f32(x[2], x[3], ww, true); w[kb] = ww; }
          unsigned char* dst = V8T + ((size_t)T * HD + d) * 128 + 32 * g;
          *(u32x4*)dst = (u32x4){(unsigned)w[0], (unsigned)w[1], (unsigned)w[2], (unsigned)w[3]}; *(u32x4*)(dst + 16) = (u32x4){(unsigned)w[4], (unsigned)w[5], (unsigned)w[6], (unsigned)w[7]}; }
        __syncthreads(); } }
}

template <int MODE> __device__ __forceinline__ void p3_attention(const Frame& F, const Args& a, char* lds) {
    unsigned char* ws = a.ws;
    const bf16_t* Q = (const bf16_t*)(ws + (MODE == 0 ? WS_QA : WS_QB)); const bf16_t* K = (const bf16_t*)(ws + (MODE == 0 ? WS_KA : WS_KB)); const bf16_t* V = (const bf16_t*)(ws + (MODE == 0 ? WS_VA : WS_VB));
    att::Aux aux; aux.cosT = (const float*)(ws + WS_ROPE); aux.sinT = aux.cosT + 128 * 32; aux.qn = a.in[4]; aux.kn = a.in[5]; aux.relb = a.in[8]; aux.sink = a.in[7];
#define BUILD_TABS(kvh_) do { float* tabs_ = (float*)(lds + att::OFF_TAB); for (int i_ = F.tid; i_ < 4 * 768; i_ += 512) { const int hh_ = i_ / 768, ii_ = i_ - hh_ * 768, rel_ = ii_ - 383, n_ = rel_ < 0 ? -rel_ : rel_; float v_ = -1e30f; \
        if (n_ <= 128) v_ = aux.relb[att::t5_bucket(rel_) * NHB + (kvh_) * 4 + hh_] * LOG2E; tabs_[i_] = v_; } } while (0)
    float pscale = 1.f;
    if (MODE == 0) { float mq = fmaxf(fabsf(aux.qn[F.lane]), fabsf(aux.qn[64 + F.lane])), mk = fmaxf(fabsf(aux.kn[F.lane]), fabsf(aux.kn[64 + F.lane]));
#pragma unroll
        for (int of = 1; of < 64; of <<= 1) { mq = fmaxf(mq, __shfl_xor(mq, of)); mk = fmaxf(mk, __shfl_xor(mk, of)); }
        const float bound = att::C * 128.0f * mq * mk * 1.13f + 0.5f; pscale = __builtin_amdgcn_exp2f(fmaxf(ceilf(bound) - 15.f, 0.f));
        pscale = __uint_as_float(__builtin_amdgcn_readfirstlane(__float_as_uint(pscale))); }
    const bool shared_tabs = (F.G == 256);
    if (MODE == 1 && shared_tabs) { BUILD_TABS((F.vcu >> 5) & 1); __syncthreads(); }
    for (int i = 0;; ++i) {
        const int L = i * F.G + F.vcu; if (L >= 1024) break;
        const int x = (L & 255) >> 5, b = x >> 1, kvh = x & 1;
        const int qb = (MODE == 0) ? (L & 31) : ((L >> 8) * 32 + (L & 31));
        const int head = (MODE == 0) ? kvh * 4 + (L >> 8) : kvh * 4, q0 = qb * ((MODE == 0) ? 256 : 64);
        const bf16_t* Qb = Q + ((size_t)b * SEQ + q0) * QW + head * HD;
        const bf16_t* Kh = K + (size_t)b * SEQ * KVW + kvh * HD; const bf16_t* Vh = V + (size_t)b * SEQ * KVW + kvh * HD;
        int kbeg = 0, kend = SEQ;
        if (MODE == 1) { kbeg = q0 - 128 < 0 ? 0 : q0 - 128; kend = q0 + 192 > SEQ ? SEQ : q0 + 192; }
        if (MODE == 1 && !shared_tabs) { __syncthreads(); BUILD_TABS(kvh); __syncthreads(); }
        bf16_t* Ob = (bf16_t*)(ws + (MODE == 0 ? WS_OA : WS_OB)) + ((size_t)b * SEQ + q0) * QW + head * HD;
        if constexpr (MODE == 0) att::attn_unit8(Qb, a.ws + WS_K8 + (size_t)(b * 2 + kvh) * SEQ * HD, a.ws + WS_V8T + (size_t)(b * 2 + kvh) * 64 * 16384, Ob, q0, lds, aux, pscale);
        else att::attn_unit_pp<MODE>(Qb, Kh, Vh, Ob, kbeg, kend, q0, head, lds, aux);
    }
#undef BUILD_TABS
}

__device__ __forceinline__ void p7_router(const Frame& F, const Args& a) {
    LAS float* wl = (LAS float*)F.lds;
    const float* wr = a.in[12];
    for (int i = F.tid; i < DM * NEXP / 4; i += 512) { const f32x4 v = *(const f32x4*)(wr + 4 * i); const int k = i >> 2, e0 = (i & 3) * 4;
        wl[(e0 + 0) * DM + k] = v.x; wl[(e0 + 1) * DM + k] = v.y; wl[(e0 + 2) * DM + k] = v.z; wl[(e0 + 3) * DM + k] = v.w; }
    __syncthreads();
    const float* X = a.in[0]; const bf16_t* ATT = (const bf16_t*)(a.ws + WS_ATT); bf16_t* H2 = (bf16_t*)(a.ws + WS_H); float* AFF = (float*)(a.ws + WS_AFF); const float* g = a.in[11];
    const int gw = F.vcu * NWAVES + F.wave, NGW = F.G * NWAVES, lane = F.lane;
    f32x4 nx[2][8]; u32x2 na[2][8];
#define RT_LOAD(rp_) do { _Pragma("unroll") for (int rr = 0; rr < 2; ++rr) { const size_t row_ = (size_t)(2 * (rp_) + rr); const GAS f32x4* xr = (const GAS f32x4*)(X + row_ * DM) + lane; const GAS u32x2* ar = (const GAS u32x2*)(ATT + row_ * DM) + lane; \
        _Pragma("unroll") for (int j = 0; j < 8; ++j) { nx[rr][j] = xr[64 * j]; if (DBG_LEVEL >= 3) na[rr][j] = ar[64 * j]; else na[rr][j] = (u32x2){0u, 0u}; } } } while (0)
    int rp = gw;
    if (rp < NTOK / 2) RT_LOAD(rp);
    for (; rp < NTOK / 2; rp += NGW) {
        f32x4 h[2][8]; float rinv[2];
#pragma unroll
        for (int rr = 0; rr < 2; ++rr) { float s = 0.f;
#pragma unroll
            for (int j = 0; j < 8; ++j) { f32x4 v = nx[rr][j]; const u32x2 w = na[rr][j]; v.x += __uint_as_float(w.x << 16); v.y += __uint_as_float(w.x & 0xffff0000u); v.z += __uint_as_float(w.y << 16); v.w += __uint_as_float(w.y & 0xffff0000u);
                h[rr][j] = v; s += (v.x * v.x + v.y * v.y) + (v.z * v.z + v.w * v.w); }
            rinv[rr] = s; }
#if DBG_LEVEL >= 3
#pragma unroll
        for (int rr = 0; rr < 2; ++rr) { GAS u32x2* x8 = (GAS u32x2*)((bf16_t*)(a.ws + WS_ATT) + (size_t)(2 * rp + rr) * DM) + lane;
#pragma unroll
            for (int j = 0; j < 8; ++j) { u32x2 w; w.x = cvt_pk_bf16(h[rr][j].x, h[rr][j].y); w.y = cvt_pk_bf16(h[rr][j].z, h[rr][j].w); x8[64 * j] = w; } }
#endif
        { const int nrp = rp + NGW; if (nrp < NTOK / 2) RT_LOAD(nrp); }
#pragma unroll
        for (int rr = 0; rr < 2; ++rr) { rinv[rr] = 1.0f / sqrtf(wave_sum(rinv[rr]) * (1.f / DM) + EPS);
            GAS u32x2* o8 = (GAS u32x2*)(H2 + (size_t)(2 * rp + rr) * DM) + lane;
#pragma unroll
            for (int j = 0; j < 8; ++j) { const f32x4 gv = ((const GAS f32x4*)g + lane)[64 * j]; h[rr][j] = h[rr][j] * rinv[rr] * gv;
                u32x2 w; w.x = cvt_pk_bf16(h[rr][j].x, h[rr][j].y); w.y = cvt_pk_bf16(h[rr][j].z, h[rr][j].w); o8[64 * j] = w; } }
        float v[32];
#pragma unroll
        for (int e = 0; e < NEXP; ++e) { float s0 = 0.f, s1 = 0.f;
#pragma unroll
            for (int j = 0; j < 8; ++j) { const f32x4 w = *(const LAS f32x4*)(wl + e * DM + 4 * lane + 256 * j);
                s0 += (h[0][j].x * w.x + h[0][j].y * w.y) + (h[0][j].z * w.z + h[0][j].w * w.w); s1 += (h[1][j].x * w.x + h[1][j].y * w.y) + (h[1][j].z * w.z + h[1][j].w * w.w); }
            v[e] = s0; v[16 + e] = s1; }
#pragma unroll
        for (int off = 16; off >= 1; off >>= 1) { const bool up = (lane & off) != 0;
#pragma unroll
            for (int i = 0; i < off; ++i) { const float lo = v[i], hi = v[i + off]; const float keep = up ? hi : lo, send = up ? lo : hi; v[i] = keep + __shfl_xor(send, off); } }
        const float mine = v[0] + __shfl_xor(v[0], 32);
        float mx = mine; mx = fmaxf(mx, __shfl_xor(mx, 1)); mx = fmaxf(mx, __shfl_xor(mx, 2)); mx = fmaxf(mx, __shfl_xor(mx, 4)); mx = fmaxf(mx, __shfl_xor(mx, 8));
        const float ex = expf(mine - mx); float sm = ex; sm += __shfl_xor(sm, 1); sm += __shfl_xor(sm, 2); sm += __shfl_xor(sm, 4); sm += __shfl_xor(sm, 8);
        if (lane < 32) { const int row = 2 * rp + (lane >> 4), e = lane & 15, b = row >> 13, s = row & (SEQ - 1); AFF[((size_t)(b * NEXP + e)) * SEQ + s] = ex / sm; }
    }
#undef RT_LOAD
    __syncthreads();
}

__device__ __forceinline__ int block_excl_scan(int v, LAS int* sc, int tid, int& total) {
    const int lane = tid & 63, w = tid >> 6; int x = v;
#pragma unroll
    for (int o = 1; o < 64; o <<= 1) { const int y = __shfl_up(x, o); if (lane >= o) x += y; }
    __syncthreads();
    if (lane == 63) sc[w] = x;
    __syncthreads();
    int pre = 0, tot = 0;
#pragma unroll
    for (int j = 0; j < 8; ++j) { const int s = sc[j]; if (j < w) pre += s; tot += s; }
    total = tot; return pre + x - v;
}
__device__ __forceinline__ void p8_topk(const Frame& F, const Args& a) {
    const float* AFF = (const float*)(a.ws + WS_AFF); int* IDX = (int*)(a.ws + WS_IDX); float* GATEV = (float*)(a.ws + WS_GATEV); int* INV = (int*)(a.ws + WS_INV);
    LAS int* hist = (LAS int*)F.lds; LAS int* sc = hist + 256; LAS int* res = sc + 16;
    const int tid = F.tid, lane = F.lane;
    for (int list = F.vcu; list < NLIST; list += F.G) {
        const int b = list / NEXP, e = list % NEXP;
        unsigned key[16];
        { const u32x4* src = (const u32x4*)(AFF + (size_t)list * SEQ + tid * 16);
#pragma unroll
            for (int j = 0; j < 4; ++j) { const u32x4 v = src[j]; key[4 * j] = v.x; key[4 * j + 1] = v.y; key[4 * j + 2] = v.z; key[4 * j + 3] = v.w; } }
        unsigned prefix = 0u, pmask = 0u; int krem = CAP;
#pragma unroll 1
        for (int pass = 0; pass < 4; ++pass) { const int shift = 24 - 8 * pass;
            __syncthreads();
            if (tid < 256) hist[tid] = 0;
            __syncthreads();
#pragma unroll
            for (int j = 0; j < 16; ++j) if ((key[j] & pmask) == prefix) __hip_atomic_fetch_add(&hist[(key[j] >> shift) & 255u], 1, __ATOMIC_RELAXED, __HIP_MEMORY_SCOPE_WORKGROUP);
            __syncthreads();
            if (tid < 64) {
                int c[4]; int s = 0;
#pragma unroll
                for (int j = 0; j < 4; ++j) { c[j] = hist[4 * lane + j]; s += c[j]; }
                int suf = s;
#pragma unroll
                for (int o = 1; o < 64; o <<= 1) { const int y = __shfl_down(suf, o); if (lane + o < 64) suf += y; }
                const int excl = suf - s;
                if (suf >= krem && excl < krem) { int cum = excl, bin = 4 * lane, kn = krem;
#pragma unroll
                    for (int j = 3; j >= 0; --j) { if (cum < krem && cum + c[j] >= krem) { bin = 4 * lane + j; kn = krem - cum; } cum += c[j]; }
                    res[0] = bin; res[1] = kn; }
            }
            __syncthreads();
            const int bin = res[0]; krem = res[1];
            prefix |= ((unsigned)bin) << shift; pmask |= 255u << shift;
        }
        const unsigned T = prefix;
        int ceq = 0;
#pragma unroll
        for (int j = 0; j < 16; ++j) ceq += (key[j] == T) ? 1 : 0;
        int toteq; const int eqb = block_excl_scan(ceq, sc, tid, toteq);
        int csel = 0, er = eqb; unsigned selmask = 0u;
#pragma unroll
        for (int j = 0; j < 16; ++j) { bool s = key[j] > T; if (key[j] == T) { s = er < krem; ++er; } if (s) { selmask |= 1u << j; ++csel; } }
        int totsel; int pos = block_excl_scan(csel, sc, tid, totsel);
#pragma unroll
        for (int j = 0; j < 16; ++j) { const int tokpos = tid * 16 + j; int slot = -1;
            if (selmask & (1u << j)) { slot = list * CAP + pos; IDX[slot] = tokpos; GATEV[slot] = __uint_as_float(key[j]); ++pos; }
            INV[((size_t)b * SEQ + tokpos) * NEXP + e] = slot; }
        __syncthreads();
    }
}

__device__ __forceinline__ void p11_final(const Frame& F, const Args& a, bool with_moe) {
    const float* X = a.in[0]; float* OUT = a.out; const bf16_t* ATT = (const bf16_t*)(a.ws + WS_ATT); const bf16_t* Y = (const bf16_t*)(a.ws + WS_Y); const int* INV = (const int*)(a.ws + WS_INV); const float* g = a.in[16];
    const int gw = F.vcu * NWAVES + F.wave, NGW = F.G * NWAVES, lane = F.lane;
    f32x4 nx[8]; u32x2 na[8]; int ninv = -1;
#define FN_LOAD(m_) do { const GAS f32x4* xr = (const GAS f32x4*)(X + (size_t)(m_) * DM) + lane; const GAS u32x2* ar = (const GAS u32x2*)(ATT + (size_t)(m_) * DM) + lane; \
        _Pragma("unroll") for (int j = 0; j < 8; ++j) { if (DBG_LEVEL >= 3) na[j] = ar[64 * j]; else nx[j] = xr[64 * j]; } \
        ninv = (with_moe && lane < NEXP) ? INV[(size_t)(m_) * NEXP + lane] : -1; } while (0)
    int m = gw;
    if (m < NTOK) FN_LOAD(m);
    for (; m < NTOK; m += NGW) {
        f32x4 v[8]; const int myinv = ninv;
#pragma unroll
        for (int j = 0; j < 8; ++j) { if (DBG_LEVEL >= 3) { const u32x2 w = na[j]; v[j].x = __uint_as_float(w.x << 16); v[j].y = __uint_as_float(w.x & 0xffff0000u); v[j].z = __uint_as_float(w.y << 16); v[j].w = __uint_as_float(w.y & 0xffff0000u); } else v[j] = nx[j]; }
        unsigned long long mask = __ballot(myinv >= 0);
        u32x2 y0[8]; const bool has0 = mask != 0ull;
        if (has0) { const int e = __builtin_ctzll(mask); mask &= mask - 1; const int slot = __builtin_amdgcn_readlane(myinv, e); const GAS u32x2* yr = (const GAS u32x2*)(Y + (size_t)slot * DM) + lane;
#pragma unroll
            for (int j = 0; j < 8; ++j) y0[j] = yr[64 * j]; }
        { const int nm = m + NGW; if (nm < NTOK) FN_LOAD(nm); }
        if (has0) {
#pragma unroll
            for (int j = 0; j < 8; ++j) { const u32x2 w = y0[j]; v[j].x += __uint_as_float(w.x << 16); v[j].y += __uint_as_float(w.x & 0xffff0000u); v[j].z += __uint_as_float(w.y << 16); v[j].w += __uint_as_float(w.y & 0xffff0000u); } }
        while (mask) { const int e = __builtin_ctzll(mask); mask &= mask - 1; const int slot = __builtin_amdgcn_readlane(myinv, e);
            const GAS u32x2* yr = (const GAS u32x2*)(Y + (size_t)slot * DM) + lane;
#pragma unroll
            for (int j = 0; j < 8; ++j) { const u32x2 w = yr[64 * j]; v[j].x += __uint_as_float(w.x << 16); v[j].y += __uint_as_float(w.x & 0xffff0000u); v[j].z += __uint_as_float(w.y << 16); v[j].w += __uint_as_float(w.y & 0xffff0000u); } }
        float s = 0.f;
#pragma unroll
        for (int j = 0; j < 8; ++j) s += (v[j].x * v[j].x + v[j].y * v[j].y) + (v[j].z * v[j].z + v[j].w * v[j].w);
        const float rinv = 1.0f / sqrtf(wave_sum(s) * (1.f / DM) + EPS);
        GAS f32x4* orow = (GAS f32x4*)(OUT + (size_t)m * DM) + lane;
#pragma unroll
        for (int j = 0; j < 8; ++j) { const f32x4 gv = ((const GAS f32x4*)g + lane)[64 * j]; orow[64 * j] = v[j] * rinv * gv; }
    }
#undef FN_LOAD
}
__device__ __forceinline__ void p_copy_x(const Frame& F, const Args& a) {
    const f32x4* src = (const f32x4*)a.in[0]; f32x4* dst = (f32x4*)a.out;
    for (size_t i = (size_t)blockIdx.x * 512 + F.tid; i < (size_t)NTOK * DM / 4; i += (size_t)F.G * 512) dst[i] = src[i];
}

constexpr int NPHASE = 10;
__global__ void __launch_bounds__(NWAVES * 64, 2) fwd_kernel(Args args) {
    extern __shared__ __attribute__((aligned(16))) unsigned char lds[];
    Frame F;
    F.lds = (LAS unsigned char*)lds;
    F.tid = threadIdx.x; F.lane = F.tid & 63; F.wave = __builtin_amdgcn_readfirstlane(F.tid >> 6);
    F.G = gridDim.x; { const int bx = blockIdx.x; F.vcu = (F.G % 8 == 0) ? (bx % 8) * (F.G / 8) + bx / 8 : bx; }
    unsigned char* ws = args.ws;
    gu32* ctl = (gu32*)(ws + WS_CTL);
    for (int u = F.tid; u < (LDS_BYTES - LDSCTL_OFF) / 4; u += NWAVES * 64) ((LAS unsigned*)(F.lds + LDSCTL_OFF))[u] = 0u;
    __syncthreads();
    XcdBarrier bar; bar.bar = (unsigned*)(ctl + CW_BAR); bar.x = 0; bar.st = nullptr;
    if (MK_N_LAUNCHES == 1) bar = xcd_barrier_post((unsigned*)(ctl + CW_BAR), (volatile LAS unsigned*)(F.lds + LDSCTL_OFF + 64));
    const int lo = args.ph_lo, hi = args.ph_hi;
#define IN(k) (lo <= (k) && (k) < hi)
#define SEAM(k) do { if (IN(k) && IN((k) + 1)) xcd_barrier(bar); } while (0)

    if (IN(0)) { for (int rep = 0; rep < REPS(0); ++rep) p0_prologue(F, args); }
    SEAM(0);
    if (IN(1)) {
#if DBG_LEVEL >= 3
        pg8::DenseProb<DM> P; P.A = (const bf16_t*)(ws + WS_H); P.Bt = (const bf16_t*)(ws + WS_WIN); P.S.init(NTOK, INW, F.G, (int)blockIdx.x);
        pg8::EpiInProj E{(bf16_t*)(ws + WS_QA), (bf16_t*)(ws + WS_KA), (bf16_t*)(ws + WS_VA), (bf16_t*)(ws + WS_QB), (bf16_t*)(ws + WS_KB), (bf16_t*)(ws + WS_VB), (bf16_t*)(ws + WS_GA), (bf16_t*)(ws + WS_GB), args.in[3]};
        for (int rep = 0; rep < REPS(1); ++rep) pg8::gemm_phase<pg8::EpiInProj, pg8::DenseProb<DM>, true>(F.lds, P, E);
#endif
    }
    SEAM(1);
    if (IN(2)) {
#if DBG_LEVEL >= 4
        p2_qkprep(F, args);
#endif
    }
    SEAM(2);
    if (IN(3)) {
#if DBG_LEVEL >= 4
        for (int rep = 0; rep < REPS(3); ++rep) p3_attention<0>(F, args, (char*)lds);
#endif
#if DBG_LEVEL >= 3
        __syncthreads();
        for (int rep = 0; rep < REPS(13); ++rep) p3_attention<1>(F, args, (char*)lds);
        __syncthreads();
#endif
    }
    SEAM(3);
    if (IN(4)) {
#if DBG_LEVEL >= 4
        { pg8::DenseProb<QW> P; P.A = (const bf16_t*)(ws + WS_OA); P.Bt = (const bf16_t*)(ws + WS_WPA); P.S.init(NTOK, DM, F.G, (int)blockIdx.x);
          pg8::EpiGated<0> E{(bf16_t*)(ws + WS_GA), nullptr};
          pg8::gemm_phase<pg8::EpiGated<0>, pg8::DenseProb<QW>, true>(F.lds, P, E); }
        { pg8::DenseProb<QW> P; P.A = (const bf16_t*)(ws + WS_OB); P.Bt = (const bf16_t*)(ws + WS_WPB); P.S.init(NTOK, DM, F.G, (int)blockIdx.x);
          pg8::EpiGated<1> E{(bf16_t*)(ws + WS_GA), (const bf16_t*)(ws + WS_GB)};
          pg8::gemm_phase<pg8::EpiGated<1>, pg8::DenseProb<QW>, true>(F.lds, P, E); }
#elif DBG_LEVEL >= 3
        { pg8::DenseProb<QW> P; P.A = (const bf16_t*)(ws + WS_OB); P.Bt = (const bf16_t*)(ws + WS_WPB); P.S.init(NTOK, DM, F.G, (int)blockIdx.x);
          pg8::EpiGated<2> E{(bf16_t*)(ws + WS_GA), (const bf16_t*)(ws + WS_GB)};
          pg8::gemm_phase<pg8::EpiGated<2>, pg8::DenseProb<QW>, true>(F.lds, P, E); }
#endif
    }
    SEAM(4);
    if (IN(5)) {
#if DBG_LEVEL >= 3
        pg8::DenseProb<DM> P; P.A = (const bf16_t*)(ws + WS_GA); P.Bt = (const bf16_t*)(ws + WS_WO); P.S.init(NTOK, DM, F.G, (int)blockIdx.x);
        pg8::EpiAtt E{(bf16_t*)(ws + WS_ATT)};
        for (int rep = 0; rep < REPS(5); ++rep) pg8::gemm_phase<pg8::EpiAtt, pg8::DenseProb<DM>, true>(F.lds, P, E);
#endif
    }
    SEAM(5);
    if (IN(6)) {
#if DBG_LEVEL >= 2
        for (int rep = 0; rep < REPS(6); ++rep) p7_router(F, args);
#endif
    }
    SEAM(6);
    if (IN(7)) {
#if DBG_LEVEL >= 2
        for (int rep = 0; rep < REPS(7); ++rep) p8_topk(F, args);
        __syncthreads();
        p_moe_weights(F, args);
#endif
    }
    SEAM(7);
    if (IN(8)) {
#if DBG_LEVEL >= 2
        LAS unsigned* rowoff = (LAS unsigned*)(F.lds + pg8::STAGE_BYTES);
        const int* IDX = (const int*)(ws + WS_IDX);
        for (int i = 0; i < 8; ++i) { pg8::Unit u; int e, b; if (!pg8::moe_unit(i, F.G, F.vcu, u, e, b)) break;
            if (F.tid < 256) rowoff[i * 256 + F.tid] = (unsigned)IDX[u.pm * 256 + F.tid] * (unsigned)(DM * 2); }
        __syncthreads();
        pg8::GuProb P; P.H2 = (const bf16_t*)(ws + WS_H); P.W = (const bf16_t*)(ws + WS_WGU); P.rowoff = rowoff; P.G = F.G; P.vcu = F.vcu;
        pg8::EpiSwiglu E{(bf16_t*)(ws + WS_GA)};
        for (int rep = 0; rep < REPS(8); ++rep) pg8::gemm_phase<pg8::EpiSwiglu, pg8::GuProb, true>(F.lds, P, E);
#endif
    }
    SEAM(8);
    if (IN(9)) {
#if DBG_LEVEL >= 2
        pg8::DownProb P; P.HID = (const bf16_t*)(ws + WS_GA); P.W = (const bf16_t*)(ws + WS_WD); P.G = F.G; P.vcu = F.vcu;
        pg8::EpiDown E{(bf16_t*)(ws + WS_Y), (const float*)(ws + WS_GATEV)};
        for (int rep = 0; rep < REPS(9); ++rep) pg8::gemm_phase<pg8::EpiDown, pg8::DownProb, true>(F.lds, P, E);
#endif
    }
    SEAM(9);
    if (IN(10)) { p11_final(F, args, DBG_LEVEL >= 2); }
#undef IN
#undef SEAM
}

extern "C" void kernel_launch(void* const* d_in, const int* in_sizes, int n_in, void* d_out, int out_size, void* d_ws, size_t ws_size, hipStream_t stream) {
    static int grid = 0;
    if (grid == 0) {
        if (n_in != 17 || in_sizes[0] != NTOK * DM || out_size != NTOK * DM || ws_size < WS_END) { fprintf(stderr, "kernel_launch: unexpected shapes (n_in %d, in0 %d, out %d, ws %zu); nothing launched\n", n_in, n_in > 0 ? in_sizes[0] : -1, out_size, ws_size); grid = -1; return; }
        int dev = 0, cus = 0, per_cu = 0;
        if (hipGetDevice(&dev) != hipSuccess || hipDeviceGetAttribute(&cus, hipDeviceAttributeMultiprocessorCount, dev) != hipSuccess) { grid = -1; return; }
        if (hipFuncSetAttribute((const void*)fwd_kernel, hipFuncAttributeMaxDynamicSharedMemorySize, LDS_BYTES) != hipSuccess) { fprintf(stderr, "kernel_launch: hipFuncSetAttribute failed\n"); grid = -1; return; }
        if (hipOccupancyMaxActiveBlocksPerMultiprocessor(&per_cu, (const void*)fwd_kernel, NWAVES * 64, LDS_BYTES) != hipSuccess || per_cu < 1)
            fprintf(stderr, "kernel_launch: note: occupancy query reports %d workgroups per CU\n", per_cu);
        (void)hipGetLastError();
        grid = cus;
    }
    if (grid < 0) return;
    (void)hipMemsetAsync((char*)d_ws + WS_CTL, 0, CTL_ZERO_BYTES, stream);
    Args a{};
    for (int i = 0; i < 17; ++i) a.in[i] = (const float*)d_in[i];
    a.out = (float*)d_out; a.ws = (unsigned char*)d_ws;
#if MK_N_LAUNCHES == 1
    a.ph_lo = 0; a.ph_hi = NPHASE + 1; a.li = 0;
    hipLaunchKernelGGL(fwd_kernel, dim3(grid), dim3(NWAVES * 64), LDS_BYTES, stream, a);
#else
    for (int li = 0; li <= NPHASE; ++li) { a.ph_lo = li; a.ph_hi = li + 1; a.li = li;
        hipLaunchKernelGGL(fwd_kernel, dim3(grid), dim3(NWAVES * 64), LDS_BYTES, stream, a); }
#endif
    const hipError_t le = hipPeekAtLastError();
    if (le != hipSuccess) fprintf(stderr, "kernel_launch: launch failed: %s\n", hipGetErrorName(le));
}
```

```cpp
#include <hip/hip_runtime.h>
#include <cstdio>
#include <cstdint>

#ifndef MK_N_LAUNCHES
#define MK_N_LAUNCHES 1
#endif
#ifndef DBG_LEVEL
#define DBG_LEVEL 4
#endif

#ifndef REP_PHASE
#define REP_PHASE -1
#endif
#define REPS(k) ((REP_PHASE == (k)) ? 2 : 1)
#define GAS __attribute__((address_space(1)))
#define LAS __attribute__((address_space(3)))
typedef unsigned short bf16_t;
typedef short bf16x8 __attribute__((ext_vector_type(8)));
typedef short s16x4 __attribute__((ext_vector_type(4)));
typedef float f32x2 __attribute__((ext_vector_type(2)));
typedef float f32x4 __attribute__((ext_vector_type(4)));
typedef float f32x8 __attribute__((ext_vector_type(8)));
typedef float f32x16 __attribute__((ext_vector_type(16)));
typedef unsigned u32x2 __attribute__((ext_vector_type(2)));
typedef unsigned u32x4 __attribute__((ext_vector_type(4)));
typedef GAS unsigned gu32;

constexpr int BATCH = 4, SEQ = 8192, DM = 2048, NTOK = BATCH * SEQ, HD = 128;
constexpr int NHA = 8, NHB = 8;
constexpr int QW = 1024, KVW = 256, INW = 7168;
constexpr int NEXP = 16, CAP = 1024, DFF = 1024, NLIST = BATCH * NEXP, NSLOT = NLIST * CAP;
constexpr float EPS = 1e-6f, LOG2E = 1.4426950408889634f;

constexpr size_t MiB = 1u << 20;
constexpr size_t WS_CTL = 0, CTL_ZERO_BYTES = 1 * MiB;
constexpr size_t WS_ROPE = 1 * MiB;
constexpr size_t WS_AFF = 2 * MiB;
constexpr size_t WS_IDX = 4 * MiB;
constexpr size_t WS_GATEV = 4 * MiB + 256 * 1024;
constexpr size_t WS_INV = 5 * MiB;
constexpr size_t WS_WIN = 8 * MiB;
constexpr size_t WS_WPA = 36 * MiB;
constexpr size_t WS_WPB = 40 * MiB;
constexpr size_t WS_WO = 44 * MiB;
constexpr size_t WS_WGU = 52 * MiB;
constexpr size_t WS_WD = 180 * MiB;
constexpr size_t WS_H = 244 * MiB;
constexpr size_t WS_GA = 372 * MiB;
constexpr size_t WS_GB = 500 * MiB;
constexpr size_t WS_QA = 628 * MiB, WS_KA = 692 * MiB, WS_VA = 708 * MiB, WS_QB = 724 * MiB, WS_KB = 788 * MiB, WS_VB = 804 * MiB;
constexpr size_t WS_Y = 500 * MiB;
constexpr size_t WS_OA = 820 * MiB, WS_OB = 884 * MiB;
constexpr size_t WS_ATT = 820 * MiB;
constexpr size_t WS_K8 = 948 * MiB;
constexpr size_t WS_V8T = 956 * MiB;
constexpr size_t WS_H8 = 820 * MiB;
constexpr size_t WS_WIN8 = 964 * MiB;
constexpr size_t WS_WPA8 = 978 * MiB;
constexpr size_t WS_END = 980 * MiB;
constexpr float W8S = 32.f, OA8S = 64.f;
constexpr int CW_TMO = 0;
constexpr int CW_BAR = 4096;

constexpr int LDS_SCRATCH = 155648;
constexpr int LDSCTL_OFF = LDS_SCRATCH;
constexpr int LDS_BYTES = LDS_SCRATCH + 512;

__device__ __forceinline__ unsigned cvt_pk_bf16(float lo, float hi) { unsigned r; asm volatile("v_cvt_pk_bf16_f32 %0, %1, %2" : "=v"(r) : "v"(lo), "v"(hi)); return r; }
__device__ __forceinline__ float bf2f(unsigned short v) { return __uint_as_float(((unsigned)v) << 16); }
__device__ __forceinline__ unsigned short f2bf(float f) { return (unsigned short)(cvt_pk_bf16(f, 0.f) & 0xffffu); }
__device__ __forceinline__ float wave_sum(float v) {
#pragma unroll
    for (int o = 1; o < 64; o <<= 1) v += __shfl_xor(v, o);
    return v;
}
__device__ __forceinline__ float sigmoidf_fast(float z) { return __builtin_amdgcn_rcpf(1.f + __builtin_amdgcn_exp2f(-z * LOG2E)); }
#define LDS_WAIT() asm volatile("s_waitcnt lgkmcnt(0)" ::: "memory")
#define VM_WAIT() asm volatile("s_waitcnt vmcnt(0)" ::: "memory")

namespace pg8 {
constexpr int BM = 256, BK = 64, HALF = 128, HTB = HALF * BK * 2, STAGE_BYTES = 8 * HTB;
__host__ __device__ __forceinline__ int lds_byte(int r, int c) { const int st = (r >> 4) * 2 + (c >> 5), rr = r & 15, cc = c & 31, ob = rr * 64 + cc * 2; return st * 1024 + (ob ^ (((ob >> 9) & 1) << 5)); }
__host__ __device__ __forceinline__ void stage_rc(int b, int& R, int& C) { const int st = b / 1024, sb = b % 1024, swz = sb ^ (((sb >> 9) & 1) << 5); R = (st >> 1) * 16 + swz / 64; C = (st & 1) * 32 + (swz % 64) / 2; }
__host__ __device__ __forceinline__ int perm32(int rho) { const int n = rho >> 4, i = rho & 15; return 8 * (i >> 2) + 4 * n + (i & 3); }

struct Unit { int pm, pn, ord; };

struct StaticOrder {
    int nM, nN, nwg, G, c;
    __device__ void init(int M, int N, int G_, int c_) { nM = M / BM; nN = N / BM; nwg = nM * nN; G = G_; c = c_; }
    __device__ bool next(int i, Unit& u) const {
        const long L = (long)i * G + c; if (L >= nwg) return false;
        int wgid = (int)L; { const int q = nwg / 8, r = nwg % 8, xcd = wgid % 8, off = wgid / 8; wgid = (xcd < r ? xcd * (q + 1) : r * (q + 1) + (xcd - r) * q) + off; }
        const int nig = 8 * nN, gid = wgid / nig, fm = gid * 8, gsz = (nM - fm) < 8 ? (nM - fm) : 8;
        u.pm = fm + ((wgid % nig) % gsz); u.pn = (wgid % nig) / gsz; u.ord = i; return true;
    }
};

template <class Epi, class Prob, bool ALIGN_EPI>
__device__ __forceinline__ void gemm_phase(LAS unsigned char* lds, const Prob& P, const Epi& E) {
    int tid = threadIdx.x; asm volatile("" : "+v"(tid));
    const int wid = __builtin_amdgcn_readfirstlane(tid >> 6), lane = tid & 63, wr = wid >> 2, wc = wid & 3, fr = lane & 15, fq = lane >> 4;
    constexpr int K = Prob::K, nt = K / BK;
    int Rs[2], Cs[2]; unsigned voffB[2];
#pragma unroll
    for (int i = 0; i < 2; ++i) { int R, C; stage_rc(tid * 16 + i * 8192, R, C); const int Rb = Epi::PERM ? ((R & ~31) + perm32(R & 31)) : R;
        Rs[i] = R; Cs[i] = C; voffB[i] = (unsigned)(Rb * K + C) * 2u; }
    constexpr size_t kstep = (size_t)(BK * 2);
    constexpr size_t hstepB = (size_t)HALF * K * 2;
    const unsigned ldsw = (unsigned)wid * 1024u;
    const int aoff = lds_byte(wr * 64 + fr, fq * 8), boff = lds_byte(wc * 32 + fr, fq * 8);
#define PG8_SA(b, h) (((b) * 2 + (h)) * HTB)
#define PG8_SB(b, h) ((4 + (b) * 2 + (h)) * HTB)
#define PG8_STAGE(bufoff, gbase, voff) do { _Pragma("unroll") for (int _i = 0; _i < 2; ++_i) \
        __builtin_amdgcn_global_load_lds((const unsigned*)((const char*)(gbase) + (voff)[_i]), (LAS unsigned*)(lds + (bufoff) + ldsw + _i * 8192), 16, 0, 0); } while (0)
#define PG8_LDA(dst, b, h) do { _Pragma("unroll") for (int m = 0; m < 4; ++m) _Pragma("unroll") for (int k = 0; k < 2; ++k) dst[m][k] = *(const LAS bf16x8*)(lds + PG8_SA(b, h) + aoff + m * 2048 + k * 1024); } while (0)
#define PG8_LDB(dst, b, h) do { _Pragma("unroll") for (int n = 0; n < 2; ++n) _Pragma("unroll") for (int k = 0; k < 2; ++k) dst[n][k] = *(const LAS bf16x8*)(lds + PG8_SB(b, h) + boff + n * 2048 + k * 1024); } while (0)
#define PG8_MMA(ai, bj, At, Bt) do { __builtin_amdgcn_s_setprio(1); _Pragma("unroll") for (int m = 0; m < 4; ++m) _Pragma("unroll") for (int n = 0; n < 2; ++n) _Pragma("unroll") for (int k = 0; k < 2; ++k) \
        acc[ai][bj][m][n] = __builtin_amdgcn_mfma_f32_16x16x32_bf16(Bt[n][k], At[m][k], acc[ai][bj][m][n], 0, 0, 0); __builtin_amdgcn_s_setprio(0); } while (0)
#define PG8_WAIT_V(n) asm volatile("s_waitcnt vmcnt(" #n ")" ::: "memory")
#define PG8_WAIT_L(n) asm volatile("s_waitcnt lgkmcnt(" #n ")" ::: "memory")
#define PG8_BAR __builtin_amdgcn_s_barrier()
#define PG8_SCHED __builtin_amdgcn_sched_barrier(0)
    Unit cur, nxt; int ui = 0;
    if (!P.next(0, cur)) return;
    unsigned vAc[2][2], vAn[2][2];
    P.a_voff(cur, Rs, Cs, vAc);
    f32x4 acc[2][2][4][2];
#pragma unroll
    for (int a = 0; a < 2; ++a)
#pragma unroll
        for (int b = 0; b < 2; ++b)
#pragma unroll
            for (int m = 0; m < 4; ++m)
#pragma unroll
                for (int n = 0; n < 2; ++n) acc[a][b][m][n] = (f32x4){0.f, 0.f, 0.f, 0.f};
    bf16x8 At[4][2], B0[2][2], B1[2][2];
    const char* cA = P.a_base(cur); const char* cB = P.b_base(cur);
    PG8_STAGE(PG8_SB(0, 0), cB, voffB); PG8_STAGE(PG8_SB(0, 1), cB + hstepB, voffB); PG8_STAGE(PG8_SA(0, 0), cA, vAc[0]); PG8_STAGE(PG8_SA(0, 1), cA, vAc[1]);
    if (wr == 1) PG8_BAR;
    PG8_WAIT_V(2); PG8_BAR;
    PG8_STAGE(PG8_SB(1, 0), cB + kstep, voffB); PG8_STAGE(PG8_SA(1, 0), cA + kstep, vAc[0]); PG8_STAGE(PG8_SB(1, 1), cB + hstepB + kstep, voffB);
    PG8_WAIT_V(6); PG8_BAR;
    for (;;) {
        const bool has_next = P.next(ui + 1, nxt);
        const char* nA = has_next ? P.a_base(nxt) : cA; const char* nB = has_next ? P.b_base(nxt) : cB;
        if constexpr (Prob::GATHER) { if (has_next) P.a_voff(nxt, Rs, Cs, vAn);
          else { vAn[0][0] = vAc[0][0]; vAn[0][1] = vAc[0][1]; vAn[1][0] = vAc[1][0]; vAn[1][1] = vAc[1][1]; } }
        for (int t = 0; t < nt; t += 2) {
            const bool last = (t == nt - 2);
            const char* a1 = cA + (size_t)(t + 1) * kstep;
            const char* a2 = last ? nA : cA + (size_t)(t + 2) * kstep; const char* b2 = last ? nB : cB + (size_t)(t + 2) * kstep;
            const char* a3 = a2 + kstep; const char* b3 = b2 + kstep;
            unsigned va2[2][2];
            if constexpr (Prob::GATHER) { va2[0][0] = last ? vAn[0][0] : vAc[0][0]; va2[0][1] = last ? vAn[0][1] : vAc[0][1]; va2[1][0] = last ? vAn[1][0] : vAc[1][0]; va2[1][1] = last ? vAn[1][1] : vAc[1][1]; }
            else { va2[0][0] = vAc[0][0]; va2[0][1] = vAc[0][1]; va2[1][0] = vAc[1][0]; va2[1][1] = vAc[1][1]; }
            PG8_LDB(B0, 0, 0); PG8_LDB(B1, 0, 1); PG8_SCHED; PG8_LDA(At, 0, 0); PG8_STAGE(PG8_SA(1, 1), a1, vAc[1]);
            PG8_WAIT_V(8); PG8_WAIT_L(0); PG8_BAR; PG8_MMA(0, 0, At, B0); PG8_MMA(0, 1, At, B1); PG8_BAR; PG8_SCHED;
            PG8_LDA(At, 0, 1); PG8_STAGE(PG8_SB(0, 0), b2, voffB); PG8_STAGE(PG8_SB(0, 1), b2 + hstepB, voffB); PG8_STAGE(PG8_SA(0, 0), a2, va2[0]);
            PG8_WAIT_V(8); PG8_WAIT_L(0); PG8_BAR; PG8_MMA(1, 0, At, B0); PG8_MMA(1, 1, At, B1); PG8_BAR; PG8_SCHED;
            PG8_LDB(B0, 1, 0); PG8_LDB(B1, 1, 1); PG8_SCHED; PG8_LDA(At, 1, 0); PG8_STAGE(PG8_SA(0, 1), a2, va2[1]);
            PG8_WAIT_V(8); PG8_WAIT_L(0); PG8_BAR; PG8_MMA(0, 0, At, B0); PG8_MMA(0, 1, At, B1); PG8_BAR; PG8_SCHED;
            PG8_LDA(At, 1, 1); PG8_STAGE(PG8_SB(1, 0), b3, voffB); PG8_STAGE(PG8_SB(1, 1), b3 + hstepB, voffB); PG8_STAGE(PG8_SA(1, 0), a3, va2[0]);
            PG8_WAIT_V(8); PG8_WAIT_L(0); PG8_BAR; PG8_MMA(1, 0, At, B0); PG8_MMA(1, 1, At, B1); PG8_BAR; PG8_SCHED;
        }
        if constexpr (ALIGN_EPI) { if (wr == 0) PG8_BAR; }
        E(acc, cur, wr, wc, fr, fq);
        if (!has_next) break;
#pragma unroll
        for (int a = 0; a < 2; ++a)
#pragma unroll
            for (int b = 0; b < 2; ++b)
#pragma unroll
                for (int m = 0; m < 4; ++m)
#pragma unroll
                    for (int n = 0; n < 2; ++n) acc[a][b][m][n] = (f32x4){0.f, 0.f, 0.f, 0.f};
        cur = nxt; cA = nA; cB = nB; ++ui;
        if constexpr (Prob::GATHER) { vAc[0][0] = vAn[0][0]; vAc[0][1] = vAn[0][1]; vAc[1][0] = vAn[1][0]; vAc[1][1] = vAn[1][1]; }
        if constexpr (ALIGN_EPI) { if (wr == 1) PG8_BAR; }
    }
    PG8_WAIT_V(0);
    if constexpr (!ALIGN_EPI) { if (wr == 0) PG8_BAR; }
    PG8_BAR;
#undef PG8_SA
#undef PG8_SB
#undef PG8_STAGE
#undef PG8_LDA
#undef PG8_LDB
#undef PG8_MMA
#undef PG8_WAIT_V
#undef PG8_WAIT_L
#undef PG8_BAR
#undef PG8_SCHED
}
typedef int v8i_g __attribute__((ext_vector_type(8)));
__device__ __forceinline__ void glds_saddr(const void* sbase, unsigned voff, unsigned lds_dst) { unsigned keep;
    asm volatile("s_mov_b32 %0, m0\n\ts_mov_b32 m0, %3\n\ts_nop 0\n\tglobal_load_lds_dwordx4 %2, %1\n\ts_mov_b32 m0, %0" : "=&s"(keep) : "s"(sbase), "v"(voff), "s"(lds_dst) : "memory"); }
template <class Epi, class Prob, bool ALIGN_EPI>
__device__ __forceinline__ void gemm_phase8(LAS unsigned char* lds, const Prob& P, const Epi& E) {
    int tid = threadIdx.x; asm volatile("" : "+v"(tid));
    const int wid = __builtin_amdgcn_readfirstlane(tid >> 6), lane = tid & 63, wr = wid >> 2, wc = wid & 3, fr = lane & 15, fq = lane >> 4;
    constexpr int K = Prob::K, nt = K / 128;
    int Rs[2], Cs[2]; unsigned voffB[2];
#pragma unroll
    for (int i = 0; i < 2; ++i) { int R, C; stage_rc(tid * 16 + i * 8192, R, C); const int Rb = Epi::PERM ? ((R & ~31) + perm32(R & 31)) : R;
        Rs[i] = R; Cs[i] = C; voffB[i] = (unsigned)(Rb * K + C * 2); }
    constexpr size_t kstep = (size_t)128;
    constexpr size_t hstepB = (size_t)HALF * K, hstepA = (size_t)HALF * K;
    const unsigned ldsw = (unsigned)wid * 1024u; const unsigned lds0 = (unsigned)__builtin_amdgcn_readfirstlane((int)(uintptr_t)lds);
    const int aoff = lds_byte(wr * 64 + fr, fq * 16), boff = lds_byte(wc * 32 + fr, fq * 16);
#define PG8_SA(b, h) (((b) * 2 + (h)) * HTB)
#define PG8_SB(b, h) ((4 + (b) * 2 + (h)) * HTB)
#define PG8_STAGE(bufoff, gbase, voff) do { _Pragma("unroll") for (int _i = 0; _i < 2; ++_i) glds_saddr((const void*)(gbase), (voff)[_i], lds0 + (unsigned)((bufoff) + _i * 8192) + ldsw); } while (0)
#define PG8_LDA(dst, b, h) do { _Pragma("unroll") for (int m = 0; m < 4; ++m) dst[m] = *(const LAS v8i_g*)(lds + PG8_SA(b, h) + aoff + m * 2048); } while (0)
#define PG8_LDB(dst, b, h) do { _Pragma("unroll") for (int n = 0; n < 2; ++n) dst[n] = *(const LAS v8i_g*)(lds + PG8_SB(b, h) + boff + n * 2048); } while (0)
#define PG8_MMA(ai, bj, At, Bt) do { __builtin_amdgcn_s_setprio(1); _Pragma("unroll") for (int m = 0; m < 4; ++m) _Pragma("unroll") for (int n = 0; n < 2; ++n) \
        acc[ai][bj][m][n] = __builtin_amdgcn_mfma_scale_f32_16x16x128_f8f6f4(Bt[n], At[m], acc[ai][bj][m][n], 0, 0, 0, 0, 0, 0); __builtin_amdgcn_s_setprio(0); } while (0)
#define PG8_WAIT_V(n) asm volatile("s_waitcnt vmcnt(" #n ")" ::: "memory")
#define PG8_WAIT_L(n) asm volatile("s_waitcnt lgkmcnt(" #n ")" ::: "memory")
#define PG8_BAR __builtin_amdgcn_s_barrier()
#define PG8_SCHED __builtin_amdgcn_sched_barrier(0)
    Unit cur, nxt; int ui = 0;
    if (!P.next(0, cur)) return;
    unsigned vAc[2][2], vAn[2][2];
    P.a_voff(cur, Rs, Cs, vAc);
    f32x4 acc[2][2][4][2];
#pragma unroll
    for (int a = 0; a < 2; ++a)
#pragma unroll
        for (int b = 0; b < 2; ++b)
#pragma unroll
            for (int m = 0; m < 4; ++m)
#pragma unroll
                for (int n = 0; n < 2; ++n) acc[a][b][m][n] = (f32x4){0.f, 0.f, 0.f, 0.f};
    v8i_g At[4], B0[2], B1[2];
    const char* cA = P.a_base(cur); const char* cB = P.b_base(cur);
    PG8_STAGE(PG8_SB(0, 0), cB, voffB); PG8_STAGE(PG8_SB(0, 1), cB + hstepB, voffB); PG8_STAGE(PG8_SA(0, 0), cA, vAc[0]); PG8_STAGE(PG8_SA(0, 1), cA + hstepA, vAc[0]);
    if (wr == 1) PG8_BAR;
    PG8_WAIT_V(2); PG8_BAR;
    PG8_STAGE(PG8_SB(1, 0), cB + kstep, voffB); PG8_STAGE(PG8_SA(1, 0), cA + kstep, vAc[0]); PG8_STAGE(PG8_SB(1, 1), cB + hstepB + kstep, voffB);
    PG8_WAIT_V(6); PG8_BAR;
    for (;;) {
        const bool has_next = P.next(ui + 1, nxt);
        const char* nA = has_next ? P.a_base(nxt) : cA; const char* nB = has_next ? P.b_base(nxt) : cB;
        if constexpr (Prob::GATHER) { if (has_next) P.a_voff(nxt, Rs, Cs, vAn);
          else { vAn[0][0] = vAc[0][0]; vAn[0][1] = vAc[0][1]; vAn[1][0] = vAc[1][0]; vAn[1][1] = vAc[1][1]; } }
        for (int t = 0; t < nt; t += 2) {
            const bool last = (t == nt - 2);
            const char* a1 = cA + (size_t)(t + 1) * kstep;
            const char* a2 = last ? nA : cA + (size_t)(t + 2) * kstep; const char* b2 = last ? nB : cB + (size_t)(t + 2) * kstep;
            const char* a3 = a2 + kstep; const char* b3 = b2 + kstep;
            unsigned va2[2][2];
            if constexpr (Prob::GATHER) { va2[0][0] = last ? vAn[0][0] : vAc[0][0]; va2[0][1] = last ? vAn[0][1] : vAc[0][1]; va2[1][0] = last ? vAn[1][0] : vAc[1][0]; va2[1][1] = last ? vAn[1][1] : vAc[1][1]; }
            else { va2[0][0] = vAc[0][0]; va2[0][1] = vAc[0][1]; va2[1][0] = vAc[1][0]; va2[1][1] = vAc[1][1]; }
            PG8_LDB(B0, 0, 0); PG8_LDB(B1, 0, 1); PG8_SCHED; PG8_LDA(At, 0, 0); PG8_STAGE(PG8_SA(1, 1), a1 + hstepA, vAc[0]);
            PG8_WAIT_V(8); PG8_WAIT_L(0); PG8_BAR; PG8_MMA(0, 0, At, B0); PG8_MMA(0, 1, At, B1); PG8_BAR; PG8_SCHED;
            PG8_LDA(At, 0, 1); PG8_STAGE(PG8_SB(0, 0), b2, voffB); PG8_STAGE(PG8_SB(0, 1), b2 + hstepB, voffB); PG8_STAGE(PG8_SA(0, 0), a2, va2[0]);
            PG8_WAIT_V(8); PG8_WAIT_L(0); PG8_BAR; PG8_MMA(1, 0, At, B0); PG8_MMA(1, 1, At, B1); PG8_BAR; PG8_SCHED;
            PG8_LDB(B0, 1, 0); PG8_LDB(B1, 1, 1); PG8_SCHED; PG8_LDA(At, 1, 0); PG8_STAGE(PG8_SA(0, 1), a2 + hstepA, va2[0]);
            PG8_WAIT_V(8); PG8_WAIT_L(0); PG8_BAR; PG8_MMA(0, 0, At, B0); PG8_MMA(0, 1, At, B1); PG8_BAR; PG8_SCHED;
            PG8_LDA(At, 1, 1); PG8_STAGE(PG8_SB(1, 0), b3, voffB); PG8_STAGE(PG8_SB(1, 1), b3 + hstepB, voffB); PG8_STAGE(PG8_SA(1, 0), a3, va2[0]);
            PG8_WAIT_V(8); PG8_WAIT_L(0); PG8_BAR; PG8_MMA(1, 0, At, B0); PG8_MMA(1, 1, At, B1); PG8_BAR; PG8_SCHED;
        }
        if constexpr (ALIGN_EPI) { if (wr == 0) PG8_BAR; }
        E(acc, cur, wr, wc, fr, fq);
        if (!has_next) break;
#pragma unroll
        for (int a = 0; a < 2; ++a)
#pragma unroll
            for (int b = 0; b < 2; ++b)
#pragma unroll
                for (int m = 0; m < 4; ++m)
#pragma unroll
                    for (int n = 0; n < 2; ++n) acc[a][b][m][n] = (f32x4){0.f, 0.f, 0.f, 0.f};
        cur = nxt; cA = nA; cB = nB; ++ui;
        if constexpr (Prob::GATHER) { vAc[0][0] = vAn[0][0]; vAc[0][1] = vAn[0][1]; vAc[1][0] = vAn[1][0]; vAc[1][1] = vAn[1][1]; }
        if constexpr (ALIGN_EPI) { if (wr == 1) PG8_BAR; }
    }
    PG8_WAIT_V(0);
    if constexpr (!ALIGN_EPI) { if (wr == 0) PG8_BAR; }
    PG8_BAR;
#undef PG8_SA
#undef PG8_SB
#undef PG8_STAGE
#undef PG8_LDA
#undef PG8_LDB
#undef PG8_MMA
#undef PG8_WAIT_V
#undef PG8_WAIT_L
#undef PG8_BAR
#undef PG8_SCHED
}

template <int K_> struct DenseProb {
    static constexpr int K = K_; static constexpr bool GATHER = false;
    const bf16_t* A; const bf16_t* Bt; StaticOrder S;
    __device__ __forceinline__ bool next(int i, Unit& u) const { return S.next(i, u); }
    __device__ __forceinline__ const char* a_base(const Unit& u) const { return (const char*)(A + (size_t)u.pm * BM * K); }
    __device__ __forceinline__ const char* b_base(const Unit& u) const { return (const char*)(Bt + (size_t)u.pn * BM * K); }
    __device__ __forceinline__ void a_voff(const Unit&, const int (&Rs)[2], const int (&Cs)[2], unsigned (&vo)[2][2]) const {
#pragma unroll
        for (int h = 0; h < 2; ++h)
#pragma unroll
            for (int i = 0; i < 2; ++i) vo[h][i] = (unsigned)((h * HALF + Rs[i]) * K + Cs[i]) * 2u;
    }
};
template <int K_, int PMAP, int EB> struct MapProb {
    static constexpr int K = K_; static constexpr bool GATHER = false;
    const unsigned char* A; const unsigned char* Bt; StaticOrder S;
    __device__ __forceinline__ bool next(int i, Unit& u) const { const bool ok = S.next(i, u); if (PMAP == 1) u.pn = u.pn < 6 ? u.pn : u.pn + 6; if (PMAP == 2) u.pn += 6; return ok; }
    __device__ __forceinline__ const char* a_base(const Unit& u) const { return (const char*)(A + (size_t)u.pm * BM * K * EB); }
    __device__ __forceinline__ const char* b_base(const Unit& u) const { return (const char*)(Bt + (size_t)u.pn * BM * K * EB); }
    __device__ __forceinline__ void a_voff(const Unit&, const int (&Rs)[2], const int (&Cs)[2], unsigned (&vo)[2][2]) const {
#pragma unroll
        for (int h = 0; h < 2; ++h)
#pragma unroll
            for (int i = 0; i < 2; ++i) vo[h][i] = (unsigned)((h * HALF + Rs[i]) * K * EB + Cs[i] * 2);
    }
};
__device__ __forceinline__ bool moe_unit(int i, int G, int vcu, Unit& u, int& e, int& b) {
    const int L = i * G + vcu; if (L >= 2048) return false;
    const int x = (L & 255) >> 5, w = L & 31, r = L >> 8;
    e = 2 * x + (r >> 2); b = r & 3; u.pm = (b * NEXP + e) * 4 + (w >> 3); u.pn = w & 7; u.ord = i; return true;
}
struct GuProb {
    static constexpr int K = DM; static constexpr bool GATHER = true;
    const bf16_t* H2; const bf16_t* W; const LAS unsigned* rowoff; int G, vcu;
    __device__ __forceinline__ bool next(int i, Unit& u) const { int e, b; return moe_unit(i, G, vcu, u, e, b); }
    __device__ __forceinline__ const char* a_base(const Unit& u) const { const int b = (u.pm >> 2) / NEXP; return (const char*)(H2 + (size_t)b * SEQ * DM); }
    __device__ __forceinline__ const char* b_base(const Unit& u) const { const int e = (u.pm >> 2) % NEXP; return (const char*)(W + ((size_t)e * 2048 + (size_t)u.pn * BM) * DM); }
    __device__ __forceinline__ void a_voff(const Unit& u, const int (&Rs)[2], const int (&Cs)[2], unsigned (&vo)[2][2]) const {
#pragma unroll
        for (int h = 0; h < 2; ++h)
#pragma unroll
            for (int i = 0; i < 2; ++i) vo[h][i] = rowoff[u.ord * 256 + h * HALF + Rs[i]] + (unsigned)Cs[i] * 2u;
    }
};
struct DownProb {
    static constexpr int K = DFF; static constexpr bool GATHER = false;
    const bf16_t* HID; const bf16_t* W; int G, vcu;
    __device__ __forceinline__ bool next(int i, Unit& u) const { int e, b; return moe_unit(i, G, vcu, u, e, b); }
    __device__ __forceinline__ const char* a_base(const Unit& u) const { return (const char*)(HID + (size_t)u.pm * BM * DFF); }
    __device__ __forceinline__ const char* b_base(const Unit& u) const { const int e = (u.pm >> 2) % NEXP; return (const char*)(W + ((size_t)e * 2048 + (size_t)u.pn * BM) * DFF); }
    __device__ __forceinline__ void a_voff(const Unit&, const int (&Rs)[2], const int (&Cs)[2], unsigned (&vo)[2][2]) const {
#pragma unroll
        for (int h = 0; h < 2; ++h)
#pragma unroll
            for (int i = 0; i < 2; ++i) vo[h][i] = (unsigned)((h * HALF + Rs[i]) * DFF + Cs[i]) * 2u;
    }
};

typedef const f32x4 (&AccRef)[2][2][4][2];
struct EpiInProj {
    static constexpr bool PERM = true;
    bf16_t *QA, *KA, *VA, *QB, *KB, *VB, *GA, *GB; const float* bgate; float oscale;
    __device__ __forceinline__ void operator()(AccRef acc, const Unit& u, int wr, int wc, int fr, int fq) const {
        const int pn = u.pn; bf16_t* base; int ldc, colt; bool gate = false;
        if (pn < 4) { base = QA; ldc = QW; colt = pn * 256; }
        else if (pn == 4) { base = KA; ldc = KVW; colt = 0; }
        else if (pn == 5) { base = VA; ldc = KVW; colt = 0; }
        else if (pn < 10) { base = QB; ldc = QW; colt = (pn - 6) * 256; }
        else if (pn == 10) { base = KB; ldc = KVW; colt = 0; }
        else if (pn == 11) { base = VB; ldc = KVW; colt = 0; }
        else if (pn < 20) { base = GA; ldc = DM; colt = (pn - 12) * 256; gate = true; }
        else { base = GB; ldc = DM; colt = (pn - 20) * 256; gate = true; }
        const int row0 = u.pm * BM + wr * 64 + fr, col0 = colt + wc * 32 + 8 * fq;
        f32x4 bv[2][2];
#pragma unroll
        for (int bj = 0; bj < 2; ++bj)
#pragma unroll
            for (int n = 0; n < 2; ++n) bv[bj][n] = gate ? *(const f32x4*)(bgate + (pn - 12) * 256 + wc * 32 + 8 * fq + bj * HALF + 4 * n) : (f32x4){0.f, 0.f, 0.f, 0.f};
#pragma unroll
        for (int ai = 0; ai < 2; ++ai)
#pragma unroll
            for (int m = 0; m < 4; ++m) { bf16_t* rowp = base + (size_t)(row0 + ai * HALF + m * 16) * ldc + col0;
#pragma unroll
                for (int bj = 0; bj < 2; ++bj) { f32x4 v0 = acc[ai][bj][m][0] * oscale + bv[bj][0], v1 = acc[ai][bj][m][1] * oscale + bv[bj][1];
                    if (gate) {
#pragma unroll
                        for (int j = 0; j < 4; ++j) { v0[j] = sigmoidf_fast(v0[j]); v1[j] = sigmoidf_fast(v1[j]); } }
                    u32x4 w; w.x = cvt_pk_bf16(v0[0], v0[1]); w.y = cvt_pk_bf16(v0[2], v0[3]); w.z = cvt_pk_bf16(v1[0], v1[1]); w.w = cvt_pk_bf16(v1[2], v1[3]);
                    *(u32x4*)(rowp + bj * HALF) = w; } }
    }
};
template <int MODE> struct EpiGated {
    static constexpr bool PERM = true;
    bf16_t* G1; const bf16_t* G2; float oscale;
    __device__ __forceinline__ void operator()(AccRef acc, const Unit& u, int wr, int wc, int fr, int fq) const {
        const int row0 = u.pm * BM + wr * 64 + fr, col0 = u.pn * BM + wc * 32 + 8 * fq;
#pragma unroll
        for (int ai = 0; ai < 2; ++ai)
#pragma unroll
            for (int m = 0; m < 4; ++m) { const size_t off = (size_t)(row0 + ai * HALF + m * 16) * DM + col0;
#pragma unroll
                for (int bj = 0; bj < 2; ++bj) {
                    const bf16x8 g1 = (MODE == 2) ? (bf16x8){0, 0, 0, 0, 0, 0, 0, 0} : *(const bf16x8*)(G1 + off + bj * HALF);
                    bf16x8 g2 = g1; if (MODE >= 1) g2 = *(const bf16x8*)(G2 + off + bj * HALF);
                    float o[8];
#pragma unroll
                    for (int j = 0; j < 8; ++j) { const float a = acc[ai][bj][m][j >> 2][j & 3] * oscale;
                        if (MODE == 0) o[j] = bf2f((unsigned short)g1[j]) * a;
                        else if (MODE == 1) o[j] = bf2f((unsigned short)g1[j]) + bf2f((unsigned short)g2[j]) * a;
                        else o[j] = bf2f((unsigned short)g2[j]) * a; }
                    u32x4 w; w.x = cvt_pk_bf16(o[0], o[1]); w.y = cvt_pk_bf16(o[2], o[3]); w.z = cvt_pk_bf16(o[4], o[5]); w.w = cvt_pk_bf16(o[6], o[7]);
                    *(u32x4*)(G1 + off + bj * HALF) = w; } }
    }
};
struct EpiAtt {
    static constexpr bool PERM = true;
    bf16_t* O;
    __device__ __forceinline__ void operator()(AccRef acc, const Unit& u, int wr, int wc, int fr, int fq) const {
        const int row0 = u.pm * BM + wr * 64 + fr, col0 = u.pn * BM + wc * 32 + 8 * fq;
#pragma unroll
        for (int ai = 0; ai < 2; ++ai)
#pragma unroll
            for (int m = 0; m < 4; ++m) { bf16_t* rowp = O + (size_t)(row0 + ai * HALF + m * 16) * DM + col0;
#pragma unroll
                for (int bj = 0; bj < 2; ++bj) { const f32x4 v0 = acc[ai][bj][m][0], v1 = acc[ai][bj][m][1];
                    u32x4 w; w.x = cvt_pk_bf16(v0[0], v0[1]); w.y = cvt_pk_bf16(v0[2], v0[3]); w.z = cvt_pk_bf16(v1[0], v1[1]); w.w = cvt_pk_bf16(v1[2], v1[3]);
                    *(u32x4*)(rowp + bj * HALF) = w; } }
    }
};
struct EpiSwiglu {
    static constexpr bool PERM = true;
    bf16_t* HID;
    __device__ __forceinline__ void operator()(AccRef acc, const Unit& u, int wr, int wc, int fr, int fq) const {
        const int row0 = u.pm * BM + wr * 64 + fr, col0 = u.pn * HALF + wc * 32 + 8 * fq;
#pragma unroll
        for (int ai = 0; ai < 2; ++ai)
#pragma unroll
            for (int m = 0; m < 4; ++m) { float o[8];
#pragma unroll
                for (int j = 0; j < 8; ++j) { const float a = acc[ai][0][m][j >> 2][j & 3], up = acc[ai][1][m][j >> 2][j & 3]; o[j] = a * sigmoidf_fast(a) * up; }
                u32x4 w; w.x = cvt_pk_bf16(o[0], o[1]); w.y = cvt_pk_bf16(o[2], o[3]); w.z = cvt_pk_bf16(o[4], o[5]); w.w = cvt_pk_bf16(o[6], o[7]);
                *(u32x4*)(HID + (size_t)(row0 + ai * HALF + m * 16) * DFF + col0) = w; }
    }
};
struct EpiDown {
    static constexpr bool PERM = true;
    bf16_t* Y; const float* gatev;
    __device__ __forceinline__ void operator()(AccRef acc, const Unit& u, int wr, int wc, int fr, int fq) const {
        const int row0 = u.pm * BM + wr * 64 + fr, col0 = u.pn * BM + wc * 32 + 8 * fq;
#pragma unroll
        for (int ai = 0; ai < 2; ++ai)
#pragma unroll
            for (int m = 0; m < 4; ++m) { const int row = row0 + ai * HALF + m * 16; const float g = gatev[row];
#pragma unroll
                for (int bj = 0; bj < 2; ++bj) { const f32x4 v0 = acc[ai][bj][m][0] * g, v1 = acc[ai][bj][m][1] * g;
                    u32x4 w; w.x = cvt_pk_bf16(v0[0], v0[1]); w.y = cvt_pk_bf16(v0[2], v0[3]); w.z = cvt_pk_bf16(v1[0], v1[1]); w.w = cvt_pk_bf16(v1[2], v1[3]);
                    *(u32x4*)(Y + (size_t)row * DM + col0 + bj * HALF) = w; } }
    }
};
}

namespace att {
constexpr int D = 128, NW = 8, QBLK = 32, KVBLK = 64;
constexpr float SCALE = 0.088388347648318440f, C = SCALE * LOG2E;
constexpr float THR = 8.f;
constexpr int LDQ = QW, LDK = KVW;
constexpr int SHM_V = KVBLK * D * 2, SHM_K = KVBLK * D * 2;
constexpr int BUFB = SHM_V + SHM_K, NBUF = 4;
constexpr int OFF_WS = NBUF * BUFB, OFF_TAB = OFF_WS + NW * 64 * 4, LDS_END = OFF_TAB + 4 * 768 * 4, OFF_OST = 0;
static_assert(LDS_END <= LDS_SCRATCH, "attention LDS");
#define KSWZ(row, colB) ((row) * 256 + ((colB) ^ (((row) & 7) << 4)))
#define SBAR() __builtin_amdgcn_sched_barrier(0)
__device__ __forceinline__ int crow(int r, int hi) { return (r & 3) + 8 * (r >> 2) + 4 * hi; }
__device__ __forceinline__ unsigned cvtpk(float lo, float hi) { unsigned r; asm volatile("v_cvt_pk_bf16_f32 %0, %1, %2" : "=v"(r) : "v"(lo), "v"(hi)); return r; }

__device__ __forceinline__ void partialSM(f32x16& p0, f32x16& p1, float& m_reg, float& mn, float& alpha) {
  float pmax = p0[0];
#pragma unroll
  for (int r = 1; r < 16; ++r) pmax = fmaxf(pmax, p0[r]);
#pragma unroll
  for (int r = 0; r < 16; ++r) pmax = fmaxf(pmax, p1[r]);
  { auto rr = __builtin_amdgcn_permlane32_swap(__float_as_uint(pmax), __float_as_uint(pmax), false, false);
    pmax = fmaxf(__uint_as_float(rr[0]), __uint_as_float(rr[1])); }
  if (__builtin_expect(__all(pmax - m_reg <= THR / SCALE), 1)) { mn = m_reg; alpha = 1.f; }
  else { mn = fmaxf(m_reg, pmax); alpha = __builtin_amdgcn_exp2f((m_reg - mn) * C); m_reg = mn; }
  float mnC = -mn * C;
#pragma unroll
  for (int r = 0; r < 16; ++r) p0[r] = fmaf(p0[r], C, mnC);
#pragma unroll
  for (int r = 0; r < 16; ++r) p1[r] = fmaf(p1[r], C, mnC);
#pragma unroll
  for (int r = 0; r < 16; ++r) p0[r] = __builtin_amdgcn_exp2f(p0[r]);
}
__device__ __forceinline__ void partialSM_B(f32x16& p0, f32x16& p1, float& m_reg, float& mn, float& alpha, const float* tb) {
#pragma unroll
  for (int r = 0; r < 16; ++r) { const int o = (r & 3) + 8 * (r >> 2); p0[r] = fmaf(p0[r], C, tb[o]); p1[r] = fmaf(p1[r], C, tb[32 + o]); }
  float pmax = p0[0];
#pragma unroll
  for (int r = 1; r < 16; ++r) pmax = fmaxf(pmax, p0[r]);
#pragma unroll
  for (int r = 0; r < 16; ++r) pmax = fmaxf(pmax, p1[r]);
  { auto rr = __builtin_amdgcn_permlane32_swap(__float_as_uint(pmax), __float_as_uint(pmax), false, false);
    pmax = fmaxf(__uint_as_float(rr[0]), __uint_as_float(rr[1])); }
  if (__builtin_expect(__all(pmax - m_reg <= THR * LOG2E), 1)) { mn = m_reg; alpha = 1.f; }
  else { mn = fmaxf(m_reg, pmax); alpha = __builtin_amdgcn_exp2f(m_reg - mn); m_reg = mn; }
#pragma unroll
  for (int r = 0; r < 16; ++r) p0[r] = p0[r] - mn;
#pragma unroll
  for (int r = 0; r < 16; ++r) p1[r] = p1[r] - mn;
#pragma unroll
  for (int r = 0; r < 16; ++r) p0[r] = __builtin_amdgcn_exp2f(p0[r]);
}
__device__ __forceinline__ void finishSM(f32x16& p0, f32x16& p1, float alpha, float& l_reg, bf16x8& pa0, bf16x8& pa1, bf16x8& pa2, bf16x8& pa3) {
#pragma unroll
  for (int r = 0; r < 16; ++r) p1[r] = __builtin_amdgcn_exp2f(p1[r]);
  float ps = 0;
#pragma unroll
  for (int r = 0; r < 16; ++r) ps += p0[r];
#pragma unroll
  for (int r = 0; r < 16; ++r) ps += p1[r];
  { auto rr = __builtin_amdgcn_permlane32_swap(__float_as_uint(ps), __float_as_uint(ps), false, false);
    ps = __uint_as_float(rr[0]) + __uint_as_float(rr[1]); }
  l_reg = l_reg * alpha + ps;
#define PK4(P, BASE, OUT) do { unsigned a0 = cvtpk(P[BASE + 0], P[BASE + 1]), a1 = cvtpk(P[BASE + 2], P[BASE + 3]);   \
    unsigned b0 = cvtpk(P[BASE + 4], P[BASE + 5]), b1 = cvtpk(P[BASE + 6], P[BASE + 7]);                              \
    auto r0 = __builtin_amdgcn_permlane32_swap(a0, b0, false, false); auto r1 = __builtin_amdgcn_permlane32_swap(a1, b1, false, false); \
    u32x4 w = {r0[0], r1[0], r0[1], r1[1]}; OUT = *reinterpret_cast<bf16x8*>(&w); } while (0)
  PK4(p0, 0, pa0); PK4(p0, 8, pa1); PK4(p1, 0, pa2); PK4(p1, 8, pa3);
#undef PK4
}
__device__ __forceinline__ void qkt(f32x16& p0, f32x16& p1, const bf16_t* Ks, const bf16x8* qr, int r32, int hi, float init = 0.f) {
#pragma unroll
  for (int r = 0; r < 16; ++r) { p0[r] = init; p1[r] = init; }
#pragma unroll
  for (int d0 = 0; d0 < 8; ++d0) { int cb = (d0 * 16 + hi * 8) * 2;
    bf16x8 b0 = *reinterpret_cast<const bf16x8*>((const char*)Ks + KSWZ(r32, cb));
    bf16x8 b1 = *reinterpret_cast<const bf16x8*>((const char*)Ks + KSWZ(32 + r32, cb));
    p0 = __builtin_amdgcn_mfma_f32_32x32x16_bf16(b0, qr[d0], p0, 0, 0, 0);
    p1 = __builtin_amdgcn_mfma_f32_32x32x16_bf16(b1, qr[d0], p1, 0, 0, 0); }
}
__device__ __forceinline__ int v_st(int k, int c) { const int kk = (k & ~0xC) | ((k & 4) << 1) | ((k & 8) >> 1); return ((kk >> 3) * 4 + (c >> 5)) * 512 + ((kk & 7) * 32 + (c & 31)) * 2; }
__device__ __forceinline__ int v_rd_base(int lane) { return ((lane & 3) << 3) | (((lane >> 2) & 3) << 6) | (((lane >> 4) & 1) << 5) | (((lane >> 5) & 1) << 8); }
constexpr int v_rd_off(int d0, int ks, int half) { return d0 * 512 + ks * 4096 + half * 2048; }
template <int OFF> __device__ __forceinline__ s16x4 tr_read(int vb) {
  s16x4 r; asm volatile("ds_read_b64_tr_b16 %0, %1 offset:%2" : "=&v"(r) : "v"(vb), "i"(OFF) : "memory"); return r;
}
template <int D0> __device__ __forceinline__ void pv_one(f32x16& od, int vb, bf16x8 pa0, bf16x8 pa1, bf16x8 pa2, bf16x8 pa3) {
  const s16x4 l0 = tr_read<v_rd_off(D0, 0, 0)>(vb), h0 = tr_read<v_rd_off(D0, 0, 1)>(vb), l1 = tr_read<v_rd_off(D0, 1, 0)>(vb), h1 = tr_read<v_rd_off(D0, 1, 1)>(vb);
  const s16x4 l2 = tr_read<v_rd_off(D0, 2, 0)>(vb), h2 = tr_read<v_rd_off(D0, 2, 1)>(vb), l3 = tr_read<v_rd_off(D0, 3, 0)>(vb), h3 = tr_read<v_rd_off(D0, 3, 1)>(vb);
  asm volatile("s_waitcnt lgkmcnt(0)" ::: "memory"); SBAR();
#define PK(L, H) (bf16x8){L[0], L[1], L[2], L[3], H[0], H[1], H[2], H[3]}
  od = __builtin_amdgcn_mfma_f32_32x32x16_bf16(pa0, PK(l0, h0), od, 0, 0, 0);
  od = __builtin_amdgcn_mfma_f32_32x32x16_bf16(pa1, PK(l1, h1), od, 0, 0, 0);
  od = __builtin_amdgcn_mfma_f32_32x32x16_bf16(pa2, PK(l2, h2), od, 0, 0, 0);
  od = __builtin_amdgcn_mfma_f32_32x32x16_bf16(pa3, PK(l3, h3), od, 0, 0, 0);
#undef PK
}
__device__ __forceinline__ void pv_d0(f32x16* o, int vb, bf16x8 pa0, bf16x8 pa1, bf16x8 pa2, bf16x8 pa3) {
  pv_one<0>(o[0], vb, pa0, pa1, pa2, pa3); pv_one<1>(o[1], vb, pa0, pa1, pa2, pa3); pv_one<2>(o[2], vb, pa0, pa1, pa2, pa3); pv_one<3>(o[3], vb, pa0, pa1, pa2, pa3);
}
template <int MODE>
__device__ __forceinline__ void pv_psm(f32x16* o, int vb, bf16x8 pa0, bf16x8 pa1, bf16x8 pa2, bf16x8 pa3, f32x16& p0, f32x16& p1, float& m_reg, float& mn, float& alpha, const float* tb) {
  pv_one<0>(o[0], vb, pa0, pa1, pa2, pa3);
  if constexpr (MODE == 1) {
#pragma unroll
    for (int r = 0; r < 16; ++r) { const int of = (r & 3) + 8 * (r >> 2); p0[r] = fmaf(p0[r], C, tb[of]); p1[r] = fmaf(p1[r], C, tb[32 + of]); }
  }
  float pmax = p0[0];
#pragma unroll
  for (int r = 1; r < 16; ++r) pmax = fmaxf(pmax, p0[r]);
#pragma unroll
  for (int r = 0; r < 16; ++r) pmax = fmaxf(pmax, p1[r]);
  { auto rr = __builtin_amdgcn_permlane32_swap(__float_as_uint(pmax), __float_as_uint(pmax), false, false);
    pmax = fmaxf(__uint_as_float(rr[0]), __uint_as_float(rr[1])); }
  SBAR();
  pv_one<1>(o[1], vb, pa0, pa1, pa2, pa3);
  float sub;
  if constexpr (MODE == 0) {
    if (__builtin_expect(__all(pmax - m_reg <= THR / SCALE), 1)) { mn = m_reg; alpha = 1.f; }
    else { mn = fmaxf(m_reg, pmax); alpha = __builtin_amdgcn_exp2f((m_reg - mn) * C); m_reg = mn; }
    sub = -mn * C;
#pragma unroll
    for (int r = 0; r < 16; ++r) p0[r] = fmaf(p0[r], C, sub);
  } else {
    if (__builtin_expect(__all(pmax - m_reg <= THR * LOG2E), 1)) { mn = m_reg; alpha = 1.f; }
    else { mn = fmaxf(m_reg, pmax); alpha = __builtin_amdgcn_exp2f(m_reg - mn); m_reg = mn; }
    sub = -mn;
#pragma unroll
    for (int r = 0; r < 16; ++r) p0[r] = p0[r] + sub;
  }
  SBAR();
  pv_one<2>(o[2], vb, pa0, pa1, pa2, pa3);
#pragma unroll
  for (int r = 0; r < 16; ++r) { if constexpr (MODE == 0) p1[r] = fmaf(p1[r], C, sub); else p1[r] = p1[r] + sub; }
#pragma unroll
  for (int r = 0; r < 6; ++r) p0[r] = __builtin_amdgcn_exp2f(p0[r]);
  SBAR();
  pv_one<3>(o[3], vb, pa0, pa1, pa2, pa3);
#pragma unroll
  for (int r = 6; r < 16; ++r) p0[r] = __builtin_amdgcn_exp2f(p0[r]);
}
__device__ __forceinline__ f32x8 bf8_to_f32(bf16x8 v) { f32x8 r;
#pragma unroll
  for (int j = 0; j < 8; ++j) r[j] = bf2f((unsigned short)v[j]);
  return r; }
__device__ __forceinline__ bf16x8 f32_to_bf8(f32x8 x) { u32x4 w = {cvtpk(x[0], x[1]), cvtpk(x[2], x[3]), cvtpk(x[4], x[5]), cvtpk(x[6], x[7])}; return *reinterpret_cast<bf16x8*>(&w); }
__device__ __forceinline__ int t5_bucket(int rel) {
  const int n = rel < 0 ? -rel : rel; int bk;
  if (n < 8) bk = n; else if (n < 12) bk = 8; else if (n < 16) bk = 9; else if (n < 23) bk = 10; else if (n < 32) bk = 11; else if (n < 46) bk = 12; else if (n < 64) bk = 13; else if (n < 91) bk = 14; else bk = 15;
  return bk + (rel > 0 ? 16 : 0);
}
struct Aux { const float* cosT; const float* sinT; const float* qn; const float* kn; const float* relb; const float* sink; };

template <int MODE>
__device__ __forceinline__ void attn_unit(const bf16_t* Qb, const bf16_t* __restrict__ Kh, const bf16_t* __restrict__ Vh, bf16_t* Ob, int kbeg, int kend, int q0, int head, char* lds, const Aux& aux) {
  int tid = threadIdx.x; asm volatile("" : "+v"(tid));
  const int wid = tid >> 6, lane = tid & 63, r32 = lane & 31, hi = lane >> 5;
  char* V_lds = lds; char* K_lds = lds + SHM_V;
  float* ws = (float*)(lds + OFF_WS) + wid * 64; float* li_l = ws; float* al_l = ws + 32;
  float* tab = (float*)(lds + OFF_TAB);
  float m_reg = -1e30f, l_reg = 0; f32x16 o[4] = {}; bf16x8 qr[8];
  const bf16_t* Qw = Qb + (long)(wid * QBLK + r32) * LDQ + hi * 8;
#pragma unroll
  for (int d0 = 0; d0 < 8; ++d0) qr[d0] = *reinterpret_cast<const bf16x8*>(Qw + d0 * 16);
  if constexpr (MODE == 1) {
    for (int i = tid; i < 768; i += 512) { const int rel = i - 383, n = rel < 0 ? -rel : rel; float v = -1e30f; if (n <= 128) v = aux.relb[t5_bucket(rel) * NHB + head] * LOG2E; tab[i] = v; }
    m_reg = aux.sink[head] * LOG2E; l_reg = 1.0f;
  }
  const int tbase = kbeg - q0 - wid * QBLK - r32 + 383 + 4 * hi;
  const int sr = tid >> 4, sc = (tid & 15) * 8, vst0 = v_st(sr, sc), vst1 = v_st(32 + sr, sc);
  const int vb0 = (int)(uintptr_t)V_lds + v_rd_base(lane);
  struct { bf16x8 vs0, vs1, ks0, ks1; } sr_[2];
#define SLOAD(i, k0) do { sr_[i].vs0 = *reinterpret_cast<const bf16x8*>(&Vh[(long)(kbeg + (k0) + sr) * LDK + sc]); sr_[i].vs1 = *reinterpret_cast<const bf16x8*>(&Vh[(long)(kbeg + (k0) + 32 + sr) * LDK + sc]); \
    sr_[i].ks0 = *reinterpret_cast<const bf16x8*>(&Kh[(long)(kbeg + (k0) + sr) * LDK + sc]); sr_[i].ks1 = *reinterpret_cast<const bf16x8*>(&Kh[(long)(kbeg + (k0) + 32 + sr) * LDK + sc]); } while (0)
#define SWRITE(bo, i) do { *(bf16x8*)(V_lds + (bo) + vst0) = sr_[i].vs0;          \
    *(bf16x8*)(V_lds + (bo) + vst1) = sr_[i].vs1; int kc = sc * 2;               \
    *(bf16x8*)(K_lds + (bo) + KSWZ(sr, kc)) = sr_[i].ks0;                       \
    *(bf16x8*)(K_lds + (bo) + KSWZ(32 + sr, kc)) = sr_[i].ks1; } while (0)
#define SWAIT() asm volatile("s_waitcnt vmcnt(4)" ::: "memory")
#define RESC(a) do { if (__any((a) < 1.f)) { if (hi == 0) al_l[r32] = (a); asm volatile("s_waitcnt lgkmcnt(0)" ::: "memory"); \
    _Pragma("unroll") for (int d = 0; d < 4; ++d) _Pragma("unroll") for (int r = 0; r < 16; ++r) o[d][r] *= al_l[crow(r, hi)]; } } while (0)
#define PSM(P0, P1, MN, AL, j) do { if constexpr (MODE == 0) partialSM(P0, P1, m_reg, MN, AL); else partialSM_B(P0, P1, m_reg, MN, AL, tab + tbase + (j) * KVBLK); } while (0)
#define ROT() do { const int t_ = o_prev; o_prev = o_cur; o_cur = o_next; o_next = t_; } while (0)
  f32x16 pA0, pA1, pB0, pB1; float mnA, mnB, alA, alB; bf16x8 pa0, pa1, pa2, pa3; const int NT = (kend - kbeg) / KVBLK;
  constexpr int SE = 0, SO = 1;
  int o_prev = 2 * BUFB, o_cur = 0, o_next = BUFB;
  SLOAD(SE, 0); asm volatile("s_waitcnt vmcnt(0)" ::: "memory"); SWRITE(0, SE);
  SLOAD(SO, KVBLK); SLOAD(SE, 2 * KVBLK);
  __syncthreads();
  qkt(pA0, pA1, (const bf16_t*)(K_lds + o_cur), qr, r32, hi); PSM(pA0, pA1, mnA, alA, 0);
  SWAIT(); SWRITE(o_next, SO); RESC(alA); __syncthreads();
  ROT();
  for (int j = 1; j + 1 < NT; j += 2) {
    SBAR(); qkt(pB0, pB1, (const bf16_t*)(K_lds + o_cur), qr, r32, hi);
    finishSM(pA0, pA1, alA, l_reg, pa0, pa1, pa2, pa3); SBAR();
    SLOAD(SO, (j + 2) * KVBLK); SBAR();
    pv_psm<MODE>(o, vb0 + o_prev, pa0, pa1, pa2, pa3, pB0, pB1, m_reg, mnB, alB, tab + tbase + j * KVBLK);
    SWAIT(); SWRITE(o_next, SE);
    RESC(alB); __syncthreads(); ROT();
    SBAR(); qkt(pA0, pA1, (const bf16_t*)(K_lds + o_cur), qr, r32, hi);
    finishSM(pB0, pB1, alB, l_reg, pa0, pa1, pa2, pa3); SBAR();
    SLOAD(SE, (j + 3 < NT ? j + 3 : NT - 1) * KVBLK); SBAR();
    pv_psm<MODE>(o, vb0 + o_prev, pa0, pa1, pa2, pa3, pA0, pA1, m_reg, mnA, alA, tab + tbase + (j + 1) * KVBLK);
    SWAIT(); SWRITE(o_next, SO);
    RESC(alA); __syncthreads(); ROT();
  }
  SBAR(); qkt(pB0, pB1, (const bf16_t*)(K_lds + o_cur), qr, r32, hi);
  finishSM(pA0, pA1, alA, l_reg, pa0, pa1, pa2, pa3); SBAR();
  pv_psm<MODE>(o, vb0 + o_prev, pa0, pa1, pa2, pa3, pB0, pB1, m_reg, mnB, alB, tab + tbase + (NT - 1) * KVBLK);
  RESC(alB);
  finishSM(pB0, pB1, alB, l_reg, pa0, pa1, pa2, pa3); SBAR();
  pv_d0(o, vb0 + o_cur, pa0, pa1, pa2, pa3);
  if (hi == 0) li_l[r32] = l_reg; asm volatile("s_waitcnt lgkmcnt(0)" ::: "memory");
  float rli[16];
#pragma unroll
  for (int r = 0; r < 16; ++r) rli[r] = __builtin_amdgcn_rcpf(li_l[crow(r, hi)]);
  asm volatile("s_waitcnt vmcnt(0)" ::: "memory");
  __syncthreads();
  char* ost = lds + OFF_OST + wid * 8192;
#pragma unroll
  for (int r = 0; r < 16; ++r) { const int orow = crow(r, hi);
#pragma unroll
    for (int d0 = 0; d0 < 4; ++d0) *(unsigned short*)(ost + orow * 256 + (d0 * 32 + r32) * 2) = f2bf(o[d0][r] * rli[r]); }
  asm volatile("s_waitcnt lgkmcnt(0)" ::: "memory");
  bf16_t* Ow = Ob + (long)(wid * QBLK) * LDQ;
#pragma unroll
  for (int i = 0; i < 8; ++i) { const int ch = i * 64 + lane, row = ch >> 4, c16 = ch & 15;
    const u32x4 v = *(const u32x4*)(ost + row * 256 + c16 * 16); *(u32x4*)(Ow + (long)row * LDQ + c16 * 8) = v; }
  asm volatile("s_waitcnt lgkmcnt(0)" ::: "memory");
  __syncthreads();
#undef ROT
#undef SLOAD
#undef SWRITE
#undef SWAIT
#undef RESC
#undef PSM
}

template <int MODE>
__device__ __forceinline__ void softmax_tile(f32x16& p0, f32x16& p1, float& m_reg, float& l_reg, float& alpha, bf16x8& pa0, bf16x8& pa1, bf16x8& pa2, bf16x8& pa3, const float* tb) {
  if constexpr (MODE == 0) {
    alpha = 1.f;
    if (__builtin_expect(m_reg != 0.f, 0)) {
#pragma unroll
      for (int r = 0; r < 16; ++r) { p0[r] -= m_reg; p1[r] -= m_reg; } }
#pragma unroll
    for (int r = 0; r < 16; ++r) { p0[r] = __builtin_amdgcn_exp2f(p0[r]); p1[r] = __builtin_amdgcn_exp2f(p1[r]); }
  } else {
  if constexpr (MODE == 1) {
#pragma unroll
    for (int r = 0; r < 16; ++r) { const int of = (r & 3) + 8 * (r >> 2); p0[r] = fmaf(p0[r], C, tb[of]); p1[r] = fmaf(p1[r], C, tb[32 + of]); }
  }
  float pmax = p0[0];
#pragma unroll
  for (int r = 1; r < 16; ++r) pmax = fmaxf(pmax, p0[r]);
#pragma unroll
  for (int r = 0; r < 16; ++r) pmax = fmaxf(pmax, p1[r]);
  { auto rr = __builtin_amdgcn_permlane32_swap(__float_as_uint(pmax), __float_as_uint(pmax), false, false);
    pmax = fmaxf(__uint_as_float(rr[0]), __uint_as_float(rr[1])); }
  float mn, sub;
  if constexpr (MODE == 0) {
    if (__builtin_expect(__all(pmax - m_reg <= THR / SCALE), 1)) { mn = m_reg; alpha = 1.f; }
    else { mn = fmaxf(m_reg, pmax); alpha = __builtin_amdgcn_exp2f((m_reg - mn) * C); m_reg = mn; }
    sub = -mn * C;
#pragma unroll
    for (int r = 0; r < 16; ++r) { p0[r] = __builtin_amdgcn_exp2f(fmaf(p0[r], C, sub)); p1[r] = __builtin_amdgcn_exp2f(fmaf(p1[r], C, sub)); }
  } else {
    if (__builtin_expect(__all(pmax - m_reg <= THR * LOG2E), 1)) { mn = m_reg; alpha = 1.f; }
    else { mn = fmaxf(m_reg, pmax); alpha = __builtin_amdgcn_exp2f(m_reg - mn); m_reg = mn; }
    sub = -mn;
#pragma unroll
    for (int r = 0; r < 16; ++r) { p0[r] = __builtin_amdgcn_exp2f(p0[r] + sub); p1[r] = __builtin_amdgcn_exp2f(p1[r] + sub); }
  }
  }
  float ps = 0;
#pragma unroll
  for (int r = 0; r < 16; ++r) ps += p0[r];
#pragma unroll
  for (int r = 0; r < 16; ++r) ps += p1[r];
  { auto rr = __builtin_amdgcn_permlane32_swap(__float_as_uint(ps), __float_as_uint(ps), false, false);
    ps = __uint_as_float(rr[0]) + __uint_as_float(rr[1]); }
  l_reg = l_reg * alpha + ps;
#define PK4(P, BASE, OUT) do { unsigned a0 = cvtpk(P[BASE + 0], P[BASE + 1]), a1 = cvtpk(P[BASE + 2], P[BASE + 3]);   \
    unsigned b0 = cvtpk(P[BASE + 4], P[BASE + 5]), b1 = cvtpk(P[BASE + 6], P[BASE + 7]);                              \
    auto r0 = __builtin_amdgcn_permlane32_swap(a0, b0, false, false); auto r1 = __builtin_amdgcn_permlane32_swap(a1, b1, false, false); \
    u32x4 w = {r0[0], r1[0], r0[1], r1[1]}; OUT = *reinterpret_cast<bf16x8*>(&w); } while (0)
  PK4(p0, 0, pa0); PK4(p0, 8, pa1); PK4(p1, 0, pa2); PK4(p1, 8, pa3);
#undef PK4
}
typedef short v4i16_t __attribute__((ext_vector_type(4)));
__device__ __forceinline__ bf16x8 ld_frag2(int sp, const LAS char* kb, const int (&kx)[4], const LAS char* vb) {
  if (sp >= 16) { const int s = sp - 16, d0 = s >> 1; return *(const LAS bf16x8*)(kb + kx[d0 & 3] + (d0 >> 2) * 128 + (s & 1) * 8192); }
  const int D0 = sp >> 2, ks = sp & 3;
  const s16x4 lo = __builtin_bit_cast(s16x4, __builtin_amdgcn_ds_read_tr16_b64_v4i16((LAS v4i16_t*)(vb + v_rd_off(D0, ks, 0))));
  const s16x4 hi = __builtin_bit_cast(s16x4, __builtin_amdgcn_ds_read_tr16_b64_v4i16((LAS v4i16_t*)(vb + v_rd_off(D0, ks, 1))));
  return (bf16x8){lo[0], lo[1], lo[2], lo[3], hi[0], hi[1], hi[2], hi[3]};
}
template <int SB, int SE, bool PRE>
__device__ __forceinline__ void mrun(bf16x8 (&f)[8], f32x16& p0, f32x16& p1, f32x16* o, const bf16x8* qr, bf16x8 pa0, bf16x8 pa1, bf16x8 pa2, bf16x8 pa3, const LAS char* kb, const int (&kx)[4], const LAS char* vb, float init) {
  if (SE > 16) { p0 = f32x16{}; p1 = f32x16{}; }
  SBAR();
  if (!PRE) {
#pragma unroll
    for (int s = SB; s < SB + 8; ++s) f[s & 7] = ld_frag2(s, kb, kx, vb);
    SBAR(); }
#pragma unroll
  for (int sp = SB; sp < SE; ++sp) {
    if (sp >= 16) { const int s = sp - 16; if (s & 1) p1 = __builtin_amdgcn_mfma_f32_32x32x16_bf16(f[sp & 7], qr[s >> 1], p1, 0, 0, 0); else p0 = __builtin_amdgcn_mfma_f32_32x32x16_bf16(f[sp & 7], qr[s >> 1], p0, 0, 0, 0); }
    else { const int D0 = sp >> 2, ks = sp & 3; const bf16x8 pa = ks == 0 ? pa0 : ks == 1 ? pa1 : ks == 2 ? pa2 : pa3;
      o[D0] = __builtin_amdgcn_mfma_f32_32x32x16_bf16(pa, f[sp & 7], o[D0], 0, 0, 0); }
    if (sp + 8 < SE) f[sp & 7] = ld_frag2(sp + 8, kb, kx, vb);
    SBAR();
  }
}
template <int MODE>
__device__ __forceinline__ void attn_unit_pp(const bf16_t* Qb, const bf16_t* __restrict__ Kh, const bf16_t* __restrict__ Vh, bf16_t* Ob, int kbeg, int kend, int q0, int head, char* lds, const Aux& aux) {
  int tid = threadIdx.x; asm volatile("" : "+v"(tid));
  const int wid = tid >> 6, lane = tid & 63, r32 = lane & 31, hi = lane >> 5;
  const int widu = __builtin_amdgcn_readfirstlane(wid), half = widu >> 2;
  const int hsub = widu >> 1, rsub = (widu & 1) * QBLK;
  const int rw0 = q0 + rsub;
#define NEED(j) (MODE == 0 || ((kbeg + (j) * KVBLK + KVBLK - 1 >= rw0 - 128) && (kbeg + (j) * KVBLK <= rw0 + QBLK - 1 + 128)))
  char* V_lds = lds; char* K_lds = lds + SHM_V;
  float* ws = (float*)(lds + OFF_WS) + wid * 64; float* li_l = ws; float* al_l = ws + 32;
  float* tab = (float*)(lds + OFF_TAB) + hsub * 768;
  float m_reg = -1e30f, l_reg = 0; f32x16 o[4] = {}; bf16x8 qr[8];
  const bf16_t* Qw = Qb + (long)(rsub + r32) * LDQ + hsub * HD + hi * 8;
#pragma unroll
  for (int d0 = 0; d0 < 8; ++d0) qr[d0] = *reinterpret_cast<const bf16x8*>(Qw + d0 * 16);
  if constexpr (MODE == 1) {
    m_reg = aux.sink[head + hsub] * LOG2E; l_reg = 1.0f;
  }
  const int tbase = kbeg - q0 - rsub - r32 + 383 + 4 * hi;
  float qk_init = 0.f;
  if constexpr (MODE == 0) {
    float mq = fmaxf(fabsf(aux.qn[lane]), fabsf(aux.qn[64 + lane])), mk = fmaxf(fabsf(aux.kn[lane]), fabsf(aux.kn[64 + lane]));
#pragma unroll
    for (int of = 1; of < 64; of <<= 1) { mq = fmaxf(mq, __shfl_xor(mq, of)); mk = fmaxf(mk, __shfl_xor(mk, of)); }
    const float bound = C * 128.0f * mq * mk * 1.01f + 0.5f;
    m_reg = __builtin_amdgcn_readfirstlane(__float_as_int(bound > 64.f ? bound - 64.f : 0.f)) ? (bound - 64.f) : 0.f; (void)qk_init; }
  const int sr = tid >> 4, sc = (tid & 15) * 8, vst0 = v_st(sr, sc), vst1 = v_st(32 + sr, sc);
  const int vb0 = (int)(uintptr_t)V_lds + v_rd_base(lane);
  int kx[4];
#pragma unroll
  for (int d = 0; d < 4; ++d) kx[d] = r32 * 256 + ((d * 32 + hi * 16) ^ ((r32 & 7) << 4));
  const LAS char* k3 = (const LAS char*)K_lds; const LAS char* v3 = (const LAS char*)V_lds + v_rd_base(lane);
  bf16x8 fr_[8];
  bf16x8 s_v0, s_v1, s_k0, s_k1;
#define SLOAD(k0) do { s_v0 = *reinterpret_cast<const bf16x8*>(&Vh[(long)(kbeg + (k0) + sr) * LDK + sc]); s_v1 = *reinterpret_cast<const bf16x8*>(&Vh[(long)(kbeg + (k0) + 32 + sr) * LDK + sc]); \
    s_k0 = *reinterpret_cast<const bf16x8*>(&Kh[(long)(kbeg + (k0) + sr) * LDK + sc]); s_k1 = *reinterpret_cast<const bf16x8*>(&Kh[(long)(kbeg + (k0) + 32 + sr) * LDK + sc]); } while (0)
#define SWRITE(bo) do { *(bf16x8*)(V_lds + (bo) + vst0) = s_v0; *(bf16x8*)(V_lds + (bo) + vst1) = s_v1; const int kc = sc * 2;  \
    *(bf16x8*)(K_lds + (bo) + KSWZ(sr, kc)) = s_k0; *(bf16x8*)(K_lds + (bo) + KSWZ(32 + sr, kc)) = s_k1; } while (0)
#define VMW0() asm volatile("s_waitcnt vmcnt(0)" ::: "memory")
#define BAR() asm volatile("s_waitcnt lgkmcnt(0)\n\ts_barrier" ::: "memory")
#define RESC(a) do { if (__any((a) < 1.f)) { if (hi == 0) al_l[r32] = (a); asm volatile("s_waitcnt lgkmcnt(0)" ::: "memory"); \
    _Pragma("unroll") for (int d = 0; d < 4; ++d) _Pragma("unroll") for (int r = 0; r < 16; ++r) o[d][r] *= al_l[crow(r, hi)]; } } while (0)
#define ROT() do { const int t_ = o_prev; o_prev = o_cur; o_cur = o_next; o_next = t_; } while (0)
#define VSEG(j) do { VMW0(); SWRITE(o_next); { const int nx_ = (j) + 2 + half; SLOAD((nx_ < NT ? nx_ : NT - 1) * KVBLK); } SBAR(); \
    if (NEED(j)) { softmax_tile<MODE>(p0, p1, m_reg, l_reg, alpha, pa0, pa1, pa2, pa3, tab + tbase + (j) * KVBLK); if constexpr (MODE == 1) { RESC(alpha); } } SBAR(); } while (0)
#define PVPRE() do { if constexpr (MODE == 0) { _Pragma("unroll") for (int s_ = 0; s_ < 8; ++s_) fr_[s_] = ld_frag2(s_, k3, kx, v3 + o_cur); SBAR(); } } while (0)
  f32x16 p0, p1; float alpha; bf16x8 pa0, pa1, pa2, pa3; const int NT = (kend - kbeg) / KVBLK;
  int o_prev = 2 * BUFB, o_cur = 0, o_next = BUFB;
  { bf16x8 t_v0, t_v1, t_k0, t_k1;
    t_v0 = *reinterpret_cast<const bf16x8*>(&Vh[(long)(kbeg + sr) * LDK + sc]); t_v1 = *reinterpret_cast<const bf16x8*>(&Vh[(long)(kbeg + 32 + sr) * LDK + sc]);
    t_k0 = *reinterpret_cast<const bf16x8*>(&Kh[(long)(kbeg + sr) * LDK + sc]); t_k1 = *reinterpret_cast<const bf16x8*>(&Kh[(long)(kbeg + 32 + sr) * LDK + sc]);
    SLOAD(KVBLK); VMW0();
    *(bf16x8*)(V_lds + vst0) = t_v0; *(bf16x8*)(V_lds + vst1) = t_v1; { const int kc = sc * 2; *(bf16x8*)(K_lds + KSWZ(sr, kc)) = t_k0; *(bf16x8*)(K_lds + KSWZ(32 + sr, kc)) = t_k1; }
    if (half) { SWRITE(BUFB); SLOAD(2 * KVBLK); } }
  BAR();
#define MSEG_QK(j) do { SBAR(); if (NEED(j)) qkt(p0, p1, (const bf16_t*)(K_lds + o_cur), qr, r32, hi, qk_init); SBAR(); } while (0)
#define MSEG(j) do { SBAR(); if (NEED(j)) qkt(p0, p1, (const bf16_t*)(K_lds + o_cur), qr, r32, hi, qk_init); if (NEED((j) - 1)) pv_d0(o, vb0 + o_prev, pa0, pa1, pa2, pa3); SBAR(); } while (0)
#define MSEG_PV() do { SBAR(); if (NEED(NT - 1)) pv_d0(o, vb0 + o_prev, pa0, pa1, pa2, pa3); SBAR(); } while (0)
  if (half == 0) {
    MSEG_QK(0); VSEG(0);
    BAR(); ROT();
    for (int j = 1; j < NT; ++j) { MSEG(j); VSEG(j); BAR(); ROT(); }
    MSEG_PV();
  } else {
    MSEG_QK(0);
    BAR(); ROT();
    for (int j = 1; j < NT; ++j) { VSEG(j - 1); MSEG(j); BAR(); ROT(); }
    VSEG(NT - 1); MSEG_PV();
  }
#undef MSEG_QK
#undef MSEG
#undef MSEG_PV
  if (hi == 0) li_l[r32] = l_reg; asm volatile("s_waitcnt lgkmcnt(0)" ::: "memory");
  float rli[16];
#pragma unroll
  for (int r = 0; r < 16; ++r) rli[r] = __builtin_amdgcn_rcpf(li_l[crow(r, hi)]);
  VMW0();
  __syncthreads();
  char* ost = lds + OFF_OST + wid * 8192;
#pragma unroll
  for (int r = 0; r < 16; ++r) { const int orow = crow(r, hi);
#pragma unroll
    for (int d0 = 0; d0 < 4; ++d0) *(unsigned short*)(ost + orow * 256 + (d0 * 32 + r32) * 2) = f2bf(o[d0][r] * rli[r]); }
  asm volatile("s_waitcnt lgkmcnt(0)" ::: "memory");
  bf16_t* Ow = Ob + (long)rsub * LDQ + hsub * HD;
#pragma unroll
  for (int i = 0; i < 8; ++i) { const int ch = i * 64 + lane, row = ch >> 4, c16 = ch & 15;
    const u32x4 v = *(const u32x4*)(ost + row * 256 + c16 * 16); *(u32x4*)(Ow + (long)row * LDQ + c16 * 8) = v; }
  asm volatile("s_waitcnt lgkmcnt(0)" ::: "memory");
  __syncthreads();
#undef SLOAD
#undef SWRITE
#undef VMW0
#undef BAR
#undef RESC
#undef ROT
#undef VSEG
#undef PVPRE
#undef NEED
}

__device__ __forceinline__ int offK16(int row, int ch) { return row * 256 + 16 * (ch ^ (row & 15)); }
__device__ __forceinline__ int offV16(int row, int ch) { return row * 256 + 16 * (ch ^ ((row & 7) << 1)); }
__device__ __forceinline__ bf16x8 ld_frag16(int sp, const LAS char* kb, const int (&ka)[4], const LAS char* vb, const int (&va)[8]) {
  if (sp >= 16) { const int s = sp - 16, kblk = s >> 2, ks = s & 3; return *(const LAS bf16x8*)(kb + ka[ks] + kblk * 4096); }
  const int db = sp >> 1, s = sp & 1;
  const s16x4 lo = __builtin_bit_cast(s16x4, __builtin_amdgcn_ds_read_tr16_b64_v4i16((LAS v4i16_t*)(vb + va[db] + s * 8192)));
  const s16x4 hi = __builtin_bit_cast(s16x4, __builtin_amdgcn_ds_read_tr16_b64_v4i16((LAS v4i16_t*)(vb + va[db] + s * 8192 + 4096)));
  return (bf16x8){lo[0], lo[1], lo[2], lo[3], hi[0], hi[1], hi[2], hi[3]};
}
template <int SB, int SE, bool PRE>
__device__ __forceinline__ void mrun16(bf16x8 (&f)[8], f32x4 (&S)[4][2], f32x4 (&O)[8][2], const bf16x8 (&qf)[2][4], const bf16x8 (&pf)[2][2], const LAS char* kb, const int (&ka)[4], const LAS char* vb, const int (&va)[8]) {
  if (SE > 16) {
#pragma unroll
    for (int i = 0; i < 4; ++i) { S[i][0] = (f32x4){0.f, 0.f, 0.f, 0.f}; S[i][1] = (f32x4){0.f, 0.f, 0.f, 0.f}; } }
  SBAR();
  if (!PRE) {
#pragma unroll
    for (int s = SB; s < SB + 8; ++s) f[s & 7] = ld_frag16(s, kb, ka, vb, va);
    SBAR(); }
#pragma unroll
  for (int sp = SB; sp < SE; ++sp) {
    if (sp >= 16) { const int s = sp - 16, kblk = s >> 2, ks = s & 3;
      S[kblk][0] = __builtin_amdgcn_mfma_f32_16x16x32_bf16(f[sp & 7], qf[0][ks], S[kblk][0], 0, 0, 0); S[kblk][1] = __builtin_amdgcn_mfma_f32_16x16x32_bf16(f[sp & 7], qf[1][ks], S[kblk][1], 0, 0, 0); }
    else { const int db = sp >> 1, s = sp & 1;
      O[db][0] = __builtin_amdgcn_mfma_f32_16x16x32_bf16(f[sp & 7], pf[0][s], O[db][0], 0, 0, 0); O[db][1] = __builtin_amdgcn_mfma_f32_16x16x32_bf16(f[sp & 7], pf[1][s], O[db][1], 0, 0, 0); }
    if (sp + 8 < SE) f[sp & 7] = ld_frag16(sp + 8, kb, ka, vb, va);
    SBAR();
  }
}
__device__ __forceinline__ void attn_unit16(const bf16_t* Qb, const bf16_t* __restrict__ Kh, const bf16_t* __restrict__ Vh, bf16_t* Ob, int nkeys, int q0, char* lds, const Aux& aux) {
  int tid = threadIdx.x; asm volatile("" : "+v"(tid));
  const int wid = tid >> 6, lane = tid & 63, fr = lane & 15, fq = lane >> 4;
  const int half = __builtin_amdgcn_readfirstlane(wid >> 2);
  char* V_lds = lds; char* K_lds = lds + SHM_V;
  float shift;
  { float mq = fmaxf(fabsf(aux.qn[lane]), fabsf(aux.qn[64 + lane])), mk = fmaxf(fabsf(aux.kn[lane]), fabsf(aux.kn[64 + lane]));
#pragma unroll
    for (int of = 1; of < 64; of <<= 1) { mq = fmaxf(mq, __shfl_xor(mq, of)); mk = fmaxf(mk, __shfl_xor(mk, of)); }
    const float bound = C * 128.0f * mq * mk * 1.01f + 0.5f; shift = bound > 64.f ? bound - 64.f : 0.f; }
  bf16x8 qf[2][4];
#pragma unroll
  for (int qb = 0; qb < 2; ++qb)
#pragma unroll
    for (int ks = 0; ks < 4; ++ks) qf[qb][ks] = *reinterpret_cast<const bf16x8*>(Qb + (long)(wid * QBLK + 16 * qb + fr) * LDQ + 32 * ks + 8 * fq);
#pragma unroll
  for (int qb = 0; qb < 2; ++qb) {
    float ss = 0.f;
#pragma unroll
    for (int ks = 0; ks < 4; ++ks) { const f32x8 x = bf8_to_f32(qf[qb][ks]);
#pragma unroll
      for (int e = 0; e < 8; ++e) ss += x[e] * x[e]; }
    ss += __shfl_xor(ss, 16); ss += __shfl_xor(ss, 32);
    const float rinv = C / sqrtf(ss * (1.0f / 128.0f) + EPS);
    const int t = q0 + wid * QBLK + 16 * qb + fr;
#pragma unroll
    for (int hf = 0; hf < 2; ++hf) { const int posx = hf ? (t & 63) : (t >> 6);
      const f32x8 cs = *reinterpret_cast<const f32x8*>(aux.cosT + posx * 32 + 8 * fq), sn = *reinterpret_cast<const f32x8*>(aux.sinT + posx * 32 + 8 * fq);
      const f32x8 g1 = *reinterpret_cast<const f32x8*>(aux.qn + hf * 64 + 8 * fq), g2 = *reinterpret_cast<const f32x8*>(aux.qn + hf * 64 + 32 + 8 * fq);
      const f32x8 x1 = bf8_to_f32(qf[qb][2 * hf]) * rinv * g1, x2 = bf8_to_f32(qf[qb][2 * hf + 1]) * rinv * g2;
      qf[qb][2 * hf] = f32_to_bf8(x1 * cs - x2 * sn); qf[qb][2 * hf + 1] = f32_to_bf8(x2 * cs + x1 * sn); } }
  f32x4 O[8][2], S[4][2]; bf16x8 pf[2][2]; float lsum[2] = {0.f, 0.f};
#pragma unroll
  for (int i = 0; i < 8; ++i) { O[i][0] = (f32x4){0.f, 0.f, 0.f, 0.f}; O[i][1] = (f32x4){0.f, 0.f, 0.f, 0.f}; }
  int ka[4], va[8];
#pragma unroll
  for (int ks = 0; ks < 4; ++ks) ka[ks] = offK16(fr, 4 * ks + fq);
  { const int q = (lane & 15) >> 2, p = lane & 3;
#pragma unroll
    for (int c = 0; c < 8; ++c) va[c] = offV16(4 * fq + q, 2 * c + (p >> 1)) + 8 * (p & 1); }
  const LAS char* k3 = (const LAS char*)K_lds; const LAS char* v3 = (const LAS char*)V_lds;
  bf16x8 fr_[8];
  const int sr = tid >> 4, scc = tid & 15, kst = offK16(sr, scc), vst = offV16(sr, scc);
  bf16x8 s_v0, s_v1, s_k0, s_k1;
#define SLOAD(k0) do { s_v0 = *reinterpret_cast<const bf16x8*>(&Vh[(long)((k0) + sr) * LDK + scc * 8]); s_v1 = *reinterpret_cast<const bf16x8*>(&Vh[(long)((k0) + 32 + sr) * LDK + scc * 8]); \
    s_k0 = *reinterpret_cast<const bf16x8*>(&Kh[(long)((k0) + sr) * LDK + scc * 8]); s_k1 = *reinterpret_cast<const bf16x8*>(&Kh[(long)((k0) + 32 + sr) * LDK + scc * 8]); } while (0)
#define SWRITE(bo) do { *(bf16x8*)(V_lds + (bo) + vst) = s_v0; *(bf16x8*)(V_lds + (bo) + vst + 8192) = s_v1; *(bf16x8*)(K_lds + (bo) + kst) = s_k0; *(bf16x8*)(K_lds + (bo) + kst + 8192) = s_k1; } while (0)
#define VMW0() asm volatile("s_waitcnt vmcnt(0)" ::: "memory")
#define BAR() asm volatile("s_waitcnt lgkmcnt(0)\n\ts_barrier" ::: "memory")
#define ROT() do { const int t_ = o_prev; o_prev = o_cur; o_cur = o_next; o_next = t_; } while (0)
#define VSEG(j, wbuf_, pbuf_) do { VMW0(); SWRITE(wbuf_); { const int nx_ = (j) + 2 + half; SLOAD((nx_ < NT ? nx_ : NT - 1) * KVBLK); } SBAR(); \
    if (__builtin_expect(shift != 0.f, 0)) { _Pragma("unroll") for (int i_ = 0; i_ < 4; ++i_) { S[i_][0] -= shift; S[i_][1] -= shift; } } \
    _Pragma("unroll") for (int qb_ = 0; qb_ < 2; ++qb_) { \
      _Pragma("unroll") for (int i_ = 0; i_ < 4; ++i_) _Pragma("unroll") for (int r_ = 0; r_ < 4; ++r_) S[i_][qb_][r_] = __builtin_amdgcn_exp2f(S[i_][qb_][r_]); \
      float a_ = 0.f; _Pragma("unroll") for (int i_ = 0; i_ < 4; ++i_) a_ += (S[i_][qb_][0] + S[i_][qb_][1]) + (S[i_][qb_][2] + S[i_][qb_][3]); lsum[qb_] += a_; \
      _Pragma("unroll") for (int s_ = 0; s_ < 2; ++s_) { u32x4 w_ = {cvtpk(S[2 * s_][qb_][0], S[2 * s_][qb_][1]), cvtpk(S[2 * s_][qb_][2], S[2 * s_][qb_][3]), cvtpk(S[2 * s_ + 1][qb_][0], S[2 * s_ + 1][qb_][1]), cvtpk(S[2 * s_ + 1][qb_][2], S[2 * s_ + 1][qb_][3])}; \
        pf[qb_][s_] = *reinterpret_cast<bf16x8*>(&w_); } } \
    SBAR(); _Pragma("unroll") for (int s_ = 0; s_ < 8; ++s_) fr_[s_] = ld_frag16(s_, k3, ka, v3 + (pbuf_), va); SBAR(); } while (0)
  const int NT = nkeys / KVBLK;
  int o_prev = 2 * BUFB, o_cur = 0, o_next = BUFB;
  SLOAD(0); VMW0(); SWRITE(0);
  if (half) { SLOAD(KVBLK); VMW0(); SWRITE(BUFB); SLOAD(2 * KVBLK); } else { SLOAD(KVBLK); }
  BAR();
  if (half == 0) {
    mrun16<16, 32, false>(fr_, S, O, qf, pf, k3 + o_cur, ka, v3 + o_prev, va);
    VSEG(0, o_next, o_cur);
    BAR(); ROT();
    for (int j = 1; j < NT; ++j) {
      mrun16<0, 32, true>(fr_, S, O, qf, pf, k3 + o_cur, ka, v3 + o_prev, va);
      VSEG(j, o_next, o_cur);
      BAR(); ROT();
    }
    mrun16<0, 16, true>(fr_, S, O, qf, pf, k3 + o_cur, ka, v3 + o_prev, va);
  } else {
    mrun16<16, 32, false>(fr_, S, O, qf, pf, k3 + o_cur, ka, v3 + o_prev, va);
    BAR(); ROT();
    for (int j = 1; j < NT; ++j) {
      VSEG(j - 1, o_next, o_prev);
      mrun16<0, 32, true>(fr_, S, O, qf, pf, k3 + o_cur, ka, v3 + o_prev, va);
      BAR(); ROT();
    }
    VSEG(NT - 1, o_next, o_prev);
    mrun16<0, 16, true>(fr_, S, O, qf, pf, k3 + o_cur, ka, v3 + o_prev, va);
  }
  float rl[2];
#pragma unroll
  for (int qb = 0; qb < 2; ++qb) { float l = lsum[qb]; l += __shfl_xor(l, 16); l += __shfl_xor(l, 32); rl[qb] = __builtin_amdgcn_rcpf(l); }
  VMW0();
  __syncthreads();
  char* ost = lds + OFF_OST + wid * 8192;
#pragma unroll
  for (int db = 0; db < 8; ++db)
#pragma unroll
    for (int qb = 0; qb < 2; ++qb) { const f32x4 v = O[db][qb] * rl[qb]; u32x2 w; w.x = cvtpk(v[0], v[1]); w.y = cvtpk(v[2], v[3]);
      *(u32x2*)(ost + (16 * qb + fr) * 256 + (16 * db + 4 * fq) * 2) = w; }
  asm volatile("s_waitcnt lgkmcnt(0)" ::: "memory");
  bf16_t* Ow = Ob + (long)(wid * QBLK) * LDQ;
#pragma unroll
  for (int i = 0; i < 8; ++i) { const int ch = i * 64 + lane, row = ch >> 4, c16 = ch & 15;
    const u32x4 v = *(const u32x4*)(ost + row * 256 + c16 * 16); *(u32x4*)(Ow + (long)row * LDQ + c16 * 8) = v; }
  asm volatile("s_waitcnt lgkmcnt(0)" ::: "memory");
  __syncthreads();
#undef SLOAD
#undef SWRITE
#undef VMW0
#undef BAR
#undef ROT
#undef VSEG
}

typedef int v8i_t __attribute__((ext_vector_type(8)));
typedef short v2s_t __attribute__((ext_vector_type(2)));
__device__ __forceinline__ int off8(int row, int c16) { return row * 128 + 16 * (c16 ^ (((row >> 1) & 1) | (((row >> 2) & 1) << 2))); }
__device__ __forceinline__ v8i_t ld_frag8(const LAS char* img, int a0, int a1, int blk) {
  const u32x4 lo = *(const LAS u32x4*)(img + blk * 2048 + a0), hi = *(const LAS u32x4*)(img + blk * 2048 + a1);
  return (v8i_t){(int)lo.x, (int)lo.y, (int)lo.z, (int)lo.w, (int)hi.x, (int)hi.y, (int)hi.z, (int)hi.w};
}
__device__ __forceinline__ void exp_pack8(f32x4 (&S)[4][2], v8i_t (&pf)[2], float (&lsum)[2], float pscale, int h) {
#pragma unroll
  for (int qb = 0; qb < 2; ++qb) { float a = 0.f;
#pragma unroll
    for (int i = 0; i < 4; ++i) { f32x4 e;
#pragma unroll
      for (int r = 0; r < 4; ++r) e[r] = __builtin_amdgcn_exp2f(S[i][qb][r]);
      a += (e[0] + e[1]) + (e[2] + e[3]);
      v2s_t p = {0, 0}; p = __builtin_amdgcn_cvt_scalef32_pk_bf8_f32(p, e[0], e[1], pscale, false); p = __builtin_amdgcn_cvt_scalef32_pk_bf8_f32(p, e[2], e[3], pscale, true);
      const int w = __builtin_bit_cast(int, p);
      if (h == 0) { if (i == 0) pf[qb][0] = w; else if (i == 1) pf[qb][1] = w; else if (i == 2) pf[qb][2] = w; else pf[qb][3] = w; }
      else { if (i == 0) pf[qb][4] = w; else if (i == 1) pf[qb][5] = w; else if (i == 2) pf[qb][6] = w; else pf[qb][7] = w; } }
    lsum[qb] += a; }
}
template <bool DO_PV, bool DO_QK, bool PRE>
__device__ __forceinline__ void mrun8(v8i_t (&f)[2], f32x4 (&S)[4][2], f32x4 (&O)[8][2], const v8i_t (&qf)[2], v8i_t (&pf)[2], float (&lsum)[2], float pscale, const LAS char* kimg, const LAS char* vimg, int a0, int a1) {
  constexpr int SB = DO_PV ? 0 : 8, SE = DO_QK ? 16 : 8;
  SBAR();
  if (!PRE) {
#pragma unroll
    for (int s = SB; s < SB + 2; ++s) f[s & 1] = (s >= 8) ? ld_frag8(kimg, a0, a1, s - 8) : ld_frag8(vimg, a0, a1, s);
    SBAR(); }
#pragma unroll
  for (int sp = SB; sp < SE; ++sp) {
    if (sp >= 8) { const int kb = sp - 8; const f32x4 z = {0.f, 0.f, 0.f, 0.f};
      S[kb & 3][0] = __builtin_amdgcn_mfma_scale_f32_16x16x128_f8f6f4(f[sp & 1], qf[0], z, 0, 0, 0, 0, 0, 0); S[kb & 3][1] = __builtin_amdgcn_mfma_scale_f32_16x16x128_f8f6f4(f[sp & 1], qf[1], z, 0, 0, 0, 0, 0, 0); }
    else { O[sp][0] = __builtin_amdgcn_mfma_scale_f32_16x16x128_f8f6f4(f[sp & 1], pf[0], O[sp][0], 0, 1, 0, 0, 0, 0); O[sp][1] = __builtin_amdgcn_mfma_scale_f32_16x16x128_f8f6f4(f[sp & 1], pf[1], O[sp][1], 0, 1, 0, 0, 0, 0); }
    if (sp + 2 < SE) f[sp & 1] = (sp + 2 >= 8) ? ld_frag8(kimg, a0, a1, sp + 2 - 8) : ld_frag8(vimg, a0, a1, sp + 2);
    SBAR();
    if (sp == 11) { exp_pack8(S, pf, lsum, pscale, 0); SBAR(); }
  }
}
__device__ __forceinline__ float xsum16(float x) { auto r = __builtin_amdgcn_permlane16_swap(__float_as_uint(x), __float_as_uint(x), false, false); return __uint_as_float(r[0]) + __uint_as_float(r[1]); }
__device__ __forceinline__ float xsum32(float x) { auto r = __builtin_amdgcn_permlane32_swap(__float_as_uint(x), __float_as_uint(x), false, false); return __uint_as_float(r[0]) + __uint_as_float(r[1]); }
__device__ __forceinline__ float xchg16(float x, bool odd) { auto r = __builtin_amdgcn_permlane16_swap(__float_as_uint(x), __float_as_uint(x), false, false); return __uint_as_float(odd ? r[0] : r[1]); }
__device__ __forceinline__ void attn_unit8(const bf16_t* Qb, const unsigned char* __restrict__ K8, const unsigned char* __restrict__ V8T, bf16_t* Ob, int q0, char* lds, const Aux& aux, float pscale) {
  int tid = threadIdx.x; asm volatile("" : "+v"(tid));
  const int wid = tid >> 6, lane = tid & 63, fr = lane & 15, g = lane >> 4;
  const int half = __builtin_amdgcn_readfirstlane(wid >> 2);
  v8i_t qf[2];
  { char* qs = lds + 3 * BUFB + wid * 4096;
#pragma unroll
    for (int qb = 0; qb < 2; ++qb) {
      bf16x8 q16[4]; float ss = 0.f;
#pragma unroll
      for (int ks = 0; ks < 4; ++ks) { q16[ks] = *reinterpret_cast<const bf16x8*>(Qb + (long)(wid * QBLK + 16 * qb + fr) * LDQ + 32 * ks + 8 * g); const f32x8 x = bf8_to_f32(q16[ks]);
#pragma unroll
        for (int e = 0; e < 8; ++e) ss += x[e] * x[e]; }
      ss = xsum32(xsum16(ss));
      const float rinv = C / sqrtf(ss * (1.0f / 128.0f) + EPS);
      const int t = q0 + wid * QBLK + 16 * qb + fr;
#pragma unroll
      for (int hf = 0; hf < 2; ++hf) { const int posx = hf ? (t & 63) : (t >> 6);
        const f32x8 cs = *reinterpret_cast<const f32x8*>(aux.cosT + posx * 32 + 8 * g), sn = *reinterpret_cast<const f32x8*>(aux.sinT + posx * 32 + 8 * g);
        const f32x8 g1 = *reinterpret_cast<const f32x8*>(aux.qn + hf * 64 + 8 * g), g2 = *reinterpret_cast<const f32x8*>(aux.qn + hf * 64 + 32 + 8 * g);
        const f32x8 x1 = bf8_to_f32(q16[2 * hf]) * rinv * g1, x2 = bf8_to_f32(q16[2 * hf + 1]) * rinv * g2;
        const f32x8 y1 = x1 * cs - x2 * sn, y2 = x2 * cs + x1 * sn;
        int a0_ = 0, a1_ = 0, b0_ = 0, b1_ = 0;
        a0_ = __builtin_amdgcn_cvt_pk_fp8_f32(y1[0], y1[1], a0_, false); a0_ = __builtin_amdgcn_cvt_pk_fp8_f32(y1[2], y1[3], a0_, true); a1_ = __builtin_amdgcn_cvt_pk_fp8_f32(y1[4], y1[5], a1_, false); a1_ = __builtin_amdgcn_cvt_pk_fp8_f32(y1[6], y1[7], a1_, true);
        b0_ = __builtin_amdgcn_cvt_pk_fp8_f32(y2[0], y2[1], b0_, false); b0_ = __builtin_amdgcn_cvt_pk_fp8_f32(y2[2], y2[3], b0_, true); b1_ = __builtin_amdgcn_cvt_pk_fp8_f32(y2[4], y2[5], b1_, false); b1_ = __builtin_amdgcn_cvt_pk_fp8_f32(y2[6], y2[7], b1_, true);
        *(u32x2*)(qs + (16 * qb + fr) * 128 + 32 * (2 * hf) + 8 * g) = (u32x2){(unsigned)a0_, (unsigned)a1_}; *(u32x2*)(qs + (16 * qb + fr) * 128 + 32 * (2 * hf + 1) + 8 * g) = (u32x2){(unsigned)b0_, (unsigned)b1_}; }
    }
    asm volatile("s_waitcnt lgkmcnt(0)" ::: "memory");
#pragma unroll
    for (int qb = 0; qb < 2; ++qb) { const u32x4 lo = *(const u32x4*)(qs + (16 * qb + fr) * 128 + 32 * g), hi = *(const u32x4*)(qs + (16 * qb + fr) * 128 + 32 * g + 16);
      qf[qb] = (v8i_t){(int)lo.x, (int)lo.y, (int)lo.z, (int)lo.w, (int)hi.x, (int)hi.y, (int)hi.z, (int)hi.w}; }
    asm volatile("s_waitcnt lgkmcnt(0)" ::: "memory"); }
  f32x4 O[8][2], S[4][2]; v8i_t pf[2]; float lsum[2] = {0.f, 0.f};
#pragma unroll
  for (int i = 0; i < 8; ++i) { O[i][0] = (f32x4){0.f, 0.f, 0.f, 0.f}; O[i][1] = (f32x4){0.f, 0.f, 0.f, 0.f}; }
  const int a0 = off8(fr, 2 * g), a1 = off8(fr, 2 * g + 1);
  char* V_lds = lds; char* K_lds = lds + SHM_V;
  const LAS char* k3 = (const LAS char*)K_lds; const LAS char* v3 = (const LAS char*)V_lds;
  v8i_t fr_[2];
  const int widu = __builtin_amdgcn_readfirstlane(wid);
  unsigned dso[2];
#pragma unroll
  for (int i = 0; i < 2; ++i) { const int c = (wid * 2 + i) * 64 + lane, row = c >> 3, p = c & 7; dso[i] = (unsigned)(row * 128 + ((p ^ (((row >> 1) & 1) | (((row >> 2) & 1) << 2))) << 4)); }
  const unsigned ldsw = (unsigned)widu * 2048u; LAS unsigned char* l3 = (LAS unsigned char*)lds;
#define DMA_TILE(t_) do { const unsigned char* kg_ = K8 + (size_t)(t_) * 16384; const unsigned char* vg_ = V8T + (size_t)(t_) * 16384; const unsigned bo_ = (unsigned)(((t_) & 3) * BUFB); \
    _Pragma("unroll") for (int i_ = 0; i_ < 2; ++i_) { \
      __builtin_amdgcn_global_load_lds((const unsigned*)(vg_ + dso[i_]), (LAS unsigned*)(l3 + bo_ + ldsw + i_ * 1024), 16, 0, 0); \
      __builtin_amdgcn_global_load_lds((const unsigned*)(kg_ + dso[i_]), (LAS unsigned*)(l3 + bo_ + SHM_V + ldsw + i_ * 1024), 16, 0, 0); } } while (0)
#define VMW0() asm volatile("s_waitcnt vmcnt(0)" ::: "memory")
#define BAR() asm volatile("s_waitcnt lgkmcnt(0)\n\ts_barrier" ::: "memory")
#define VSEG(j, pbuf_) do { VMW0(); { const int nx_ = (j) + 2 + half; if (nx_ < NT) DMA_TILE(nx_); } SBAR(); \
    exp_pack8(S, pf, lsum, pscale, 1); \
    SBAR(); _Pragma("unroll") for (int s_ = 0; s_ < 2; ++s_) fr_[s_] = ld_frag8(v3 + (pbuf_), a0, a1, s_); SBAR(); } while (0)
  constexpr int NT = SEQ / 128;
  DMA_TILE(0); DMA_TILE(1); if (half) DMA_TILE(2);
  VMW0(); BAR();
  if (half) BAR();
  mrun8<false, true, false>(fr_, S, O, qf, pf, lsum, pscale, k3, v3, a0, a1);
  BAR();
  VSEG(0, 0);
  BAR();
  for (int j = 1; j < NT; ++j) {
    mrun8<true, true, true>(fr_, S, O, qf, pf, lsum, pscale, k3 + (j & 3) * BUFB, v3 + ((j - 1) & 3) * BUFB, a0, a1);
    BAR();
    VSEG(j, (j & 3) * BUFB);
    BAR();
  }
  mrun8<true, false, true>(fr_, S, O, qf, pf, lsum, pscale, k3, v3 + ((NT - 1) & 3) * BUFB, a0, a1);
  if (!half) BAR();
  float rl[2];
#pragma unroll
  for (int qb = 0; qb < 2; ++qb) { const float l = xsum32(xsum16(lsum[qb])); rl[qb] = pscale * __builtin_amdgcn_rcpf(l); }
  VMW0();
  __syncthreads();
  char* ost = lds + OFF_OST + wid * 8192;
#pragma unroll
  for (int db = 0; db < 8; ++db)
#pragma unroll
    for (int qb = 0; qb < 2; ++qb) { const f32x4 v = O[db][qb] * rl[qb]; u32x2 w; w.x = cvtpk(v[0], v[1]); w.y = cvtpk(v[2], v[3]);
      *(u32x2*)(ost + (16 * qb + fr) * 256 + (16 * db + 4 * g) * 2) = w; }
  asm volatile("s_waitcnt lgkmcnt(0)" ::: "memory");
  bf16_t* Ow = Ob + (long)(wid * QBLK) * LDQ;
#pragma unroll
  for (int i = 0; i < 8; ++i) { const int ch = i * 64 + lane, row = ch >> 4, c16 = ch & 15;
    const u32x4 v = *(const u32x4*)(ost + row * 256 + c16 * 16); *(u32x4*)(Ow + (long)row * LDQ + c16 * 8) = v; }
  asm volatile("s_waitcnt lgkmcnt(0)" ::: "memory");
  __syncthreads();
#undef DMA_TILE
#undef VMW0
#undef BAR
#undef VSEG
}
}

#define XB_TMO      128
#define XB_XCNT(j)  (256  + 64 * (j))
#define XB_XSUB(j)  (1280 + 64 * (j))
#define XB_XGEN(j)  (2304 + 64 * (j))
#define XB_TOP      3328
#define XB_TOPGEN   3392
#define XCD_BAR_WORDS 3456
#define XB_SPIN_CAP (1u << 18)
__device__ __forceinline__ unsigned xb_ld(unsigned* p)              { return __hip_atomic_load(p, __ATOMIC_RELAXED, __HIP_MEMORY_SCOPE_AGENT); }
__device__ __forceinline__ unsigned xb_add(unsigned* p, unsigned v) { return __hip_atomic_fetch_add(p, v, __ATOMIC_RELAXED, __HIP_MEMORY_SCOPE_AGENT); }
__device__ __forceinline__ unsigned xb_xcc_id() { return (unsigned)__builtin_amdgcn_s_getreg((3 << 11) | 20) & 0xFu; }
#define XB_SPIN(cond, bar) do { unsigned _sp = 0; while (cond) { __builtin_amdgcn_s_sleep(1); \
    if ((++_sp & 255u) == 0u) { if (xb_ld(&(bar)[XB_TMO])) break; if (_sp > XB_SPIN_CAP) { atomicAdd(&(bar)[XB_TMO], 1u); break; } } } } while (0)
struct XcdBarrier { unsigned* bar; unsigned x; volatile LAS unsigned* st; };
__device__ __forceinline__ XcdBarrier xcd_barrier_post(unsigned* bar, volatile LAS unsigned* st) {
    XcdBarrier b; b.bar = bar; b.x = xb_xcc_id(); b.st = st;
    if (threadIdx.x == 0) (void)xb_add(&bar[XB_XCNT(b.x)], 1u);
    return b;
}
__device__ __forceinline__ void xcd_barrier_complete(unsigned* bar, unsigned x, unsigned& nloc, unsigned& nx) {
    const unsigned G = gridDim.x * gridDim.y * gridDim.z;
    unsigned sum, cnt, mine, sp = 0u;
    for (;;) {
        sum = 0u; cnt = 0u; mine = 0u;
#pragma unroll
        for (unsigned j = 0; j < 16; ++j) { const unsigned c = xb_ld(&bar[XB_XCNT(j)]); sum += c; cnt += (c > 0u) ? 1u : 0u; mine = (j == x) ? c : mine; }
        if (sum == G) break;
        __builtin_amdgcn_s_sleep(1);
        if ((++sp & 255u) == 0u) { if (xb_ld(&bar[XB_TMO])) break; if (sp > XB_SPIN_CAP) { atomicAdd(&bar[XB_TMO], 1u); break; } }
    }
    nloc = mine > 0u ? mine : 1u; nx = cnt > 0u ? cnt : 1u;
}
__device__ __forceinline__ void xcd_barrier(const XcdBarrier& b) {
    asm volatile("s_waitcnt vmcnt(0)" ::: "memory");
    __syncthreads();
    if (threadIdx.x == 0) {
        unsigned* bar = b.bar;
        __builtin_amdgcn_s_waitcnt(0);
        unsigned nloc = b.st[0], nx = b.st[1];
        if (nloc == 0u) { xcd_barrier_complete(bar, b.x, nloc, nx); b.st[0] = nloc; b.st[1] = nx; }
        const unsigned old = xb_add(&bar[XB_XSUB(b.x)], 1u);
        const unsigned gen = old / nloc;
        if (old + 1u == (gen + 1u) * nloc) {
            __builtin_amdgcn_fence(__ATOMIC_RELEASE, "agent");
            asm volatile("s_waitcnt vmcnt(0)" ::: "memory");
            const unsigned og = xb_add(&bar[XB_TOP], 1u);
            const unsigned tg = og / nx;
            if (og + 1u == (tg + 1u) * nx) xb_add(&bar[XB_TOPGEN], 1u);
            else XB_SPIN(xb_ld(&bar[XB_TOPGEN]) == tg, bar);
            __builtin_amdgcn_fence(__ATOMIC_ACQUIRE, "agent");
            xb_add(&bar[XB_XGEN(b.x)], 1u);
            asm volatile("s_waitcnt vmcnt(0)" ::: "memory");
        } else {
            XB_SPIN(xb_ld(&bar[XB_XGEN(b.x)]) == gen, bar);
            __builtin_amdgcn_fence(__ATOMIC_ACQUIRE, "agent");
            asm volatile("s_waitcnt vmcnt(0)" ::: "memory");
        }
    }
    __syncthreads();
}

struct Args { const float* in[17]; float* out; unsigned char* ws; int ph_lo, ph_hi, li, pad; };
struct Frame { LAS unsigned char* lds; int tid, lane, wave, vcu, G; };
constexpr int NWAVES = 8;

__device__ __forceinline__ void tr_item(const float* W, int N, int k0, int n0, bf16_t* WT, int Kd, int drow0, LAS float* scr, int lane, unsigned char* WT8 = nullptr, bool wr16 = true) {
    float tv[32];
#pragma unroll
    for (int i = 0; i < 32; ++i) { const int kk = 2 * i + (lane >> 5); tv[i] = W[(size_t)(k0 + kk) * N + n0 + (lane & 31)]; }
#pragma unroll
    for (int i = 0; i < 32; ++i) { const int kk = 2 * i + (lane >> 5); scr[kk * 33 + (lane & 31)] = tv[i]; }
    LDS_WAIT(); asm volatile("" ::: "memory");
    const int c = lane & 7;
#pragma unroll
    for (int j = 0; j < 4; ++j) { const int n = (lane >> 3) + 8 * j; const LAS float* s = scr + (8 * c) * 33 + n;
        if (wr16) { u32x4 o; o.x = cvt_pk_bf16(s[0 * 33], s[1 * 33]); o.y = cvt_pk_bf16(s[2 * 33], s[3 * 33]); o.z = cvt_pk_bf16(s[4 * 33], s[5 * 33]); o.w = cvt_pk_bf16(s[6 * 33], s[7 * 33]);
            *(GAS u32x4*)(WT + (size_t)(drow0 + n) * Kd + k0 + 8 * c) = o; }
        if (WT8) { int w0 = 0, w1 = 0; w0 = __builtin_amdgcn_cvt_pk_fp8_f32(s[0 * 33] * W8S, s[1 * 33] * W8S, w0, false); w0 = __builtin_amdgcn_cvt_pk_fp8_f32(s[2 * 33] * W8S, s[3 * 33] * W8S, w0, true);
            w1 = __builtin_amdgcn_cvt_pk_fp8_f32(s[4 * 33] * W8S, s[5 * 33] * W8S, w1, false); w1 = __builtin_amdgcn_cvt_pk_fp8_f32(s[6 * 33] * W8S, s[7 * 33] * W8S, w1, true);
            *(GAS u32x2*)(WT8 + (size_t)(drow0 + n) * Kd + k0 + 8 * c) = (u32x2){(unsigned)w0, (unsigned)w1}; } }
    LDS_WAIT(); asm volatile("" ::: "memory");
}
__device__ __forceinline__ void rms_row_to_bf16(const float* xrow, const float* g, bf16_t* orow, int lane) {
    const GAS f32x4* xr = (const GAS f32x4*)xrow + lane; const GAS f32x4* gr = (const GAS f32x4*)g + lane;
    f32x4 v[8]; float s = 0.f;
#pragma unroll
    for (int j = 0; j < 8; ++j) { v[j] = xr[64 * j]; s += (v[j].x * v[j].x + v[j].y * v[j].y) + (v[j].z * v[j].z + v[j].w * v[j].w); }
    const float rinv = 1.0f / sqrtf(wave_sum(s) * (1.f / DM) + EPS);
    GAS u32x2* o8 = (GAS u32x2*)orow + lane;
#pragma unroll
    for (int j = 0; j < 8; ++j) { const f32x4 gv = gr[64 * j]; u32x2 w; w.x = cvt_pk_bf16(v[j].x * rinv * gv.x, v[j].y * rinv * gv.y); w.y = cvt_pk_bf16(v[j].z * rinv * gv.z, v[j].w * rinv * gv.w); o8[64 * j] = w; }
}

__device__ __forceinline__ void p0_prologue(const Frame& F, const Args& a) {
    unsigned char* ws = a.ws;
    LAS float* scr = (LAS float*)(F.lds + F.wave * 16384);
    const int gw = F.vcu * NWAVES + F.wave, NGW = F.G * NWAVES;
    constexpr int I_IN = (DM / 64) * (INW / 32), I_P = (QW / 64) * (DM / 32), I_O = (DM / 64) * (DM / 32);
    constexpr int NITEMS = I_IN + 2 * I_P + I_O;
    for (int it = gw; it < NITEMS; it += NGW) {
        int r = it;
        if (r < I_IN) { const int nb = INW / 32, kb = r / nb, n0 = (r % nb) * 32; tr_item(a.in[2], INW, kb * 64, n0, (bf16_t*)(ws + WS_WIN), DM, n0, scr, F.lane, ws + WS_WIN8, true); continue; } r -= I_IN;
        if (r < I_P) { const int nb = DM / 32, kb = r / nb, n0 = (r % nb) * 32; tr_item(a.in[6], DM, kb * 64, n0, (bf16_t*)(ws + WS_WPA), QW, n0, scr, F.lane); continue; } r -= I_P;
        if (r < I_P) { const int nb = DM / 32, kb = r / nb, n0 = (r % nb) * 32; tr_item(a.in[9], DM, kb * 64, n0, (bf16_t*)(ws + WS_WPB), QW, n0, scr, F.lane); continue; } r -= I_P;
        { const int nb = DM / 32, kb = r / nb, n0 = (r % nb) * 32; tr_item(a.in[10], DM, kb * 64, n0, (bf16_t*)(ws + WS_WO), DM, n0, scr, F.lane); }
    }
    float* cosT = (float*)(ws + WS_ROPE); float* sinT = cosT + 128 * 32;
    for (int i = blockIdx.x * 512 + F.tid; i < 128 * 32; i += F.G * 512) { const int pos = i >> 5, p = i & 31;
        const float inv = 1.0f / powf(10000.0f, (float)(2 * p) / 64.0f); const float ang = (float)pos * inv; cosT[i] = cosf(ang); sinT[i] = sinf(ang); }
    { const float* X = a.in[0]; const float* gm = a.in[1]; bf16_t* H = (bf16_t*)(ws + WS_H); const int lane = F.lane;
      f32x4 nx[8]; int m = gw;
      if (m < NTOK) { const GAS f32x4* xr = (const GAS f32x4*)(X + (size_t)m * DM) + lane;
#pragma unroll
          for (int j = 0; j < 8; ++j) nx[j] = xr[64 * j]; }
      for (; m < NTOK; m += NGW) { f32x4 v[8]; float s = 0.f;
#pragma unroll
          for (int j = 0; j < 8; ++j) { v[j] = nx[j]; s += (v[j].x * v[j].x + v[j].y * v[j].y) + (v[j].z * v[j].z + v[j].w * v[j].w); }
          { const int nm = m + NGW; if (nm < NTOK) { const GAS f32x4* xr = (const GAS f32x4*)(X + (size_t)nm * DM) + lane;
#pragma unroll
              for (int j = 0; j < 8; ++j) nx[j] = xr[64 * j]; } }
          const float rinv = 1.0f / sqrtf(wave_sum(s) * (1.f / DM) + EPS);
          GAS u32x2* o8 = (GAS u32x2*)(H + (size_t)m * DM) + lane;
#pragma unroll
          for (int j = 0; j < 8; ++j) { const f32x4 gv = ((const GAS f32x4*)gm + lane)[64 * j]; const f32x4 hv = v[j] * rinv * gv; u32x2 w; w.x = cvt_pk_bf16(hv.x, hv.y); w.y = cvt_pk_bf16(hv.z, hv.w); o8[64 * j] = w;
              int w8 = 0; w8 = __builtin_amdgcn_cvt_pk_fp8_f32(hv.x, hv.y, w8, false); w8 = __builtin_amdgcn_cvt_pk_fp8_f32(hv.z, hv.w, w8, true); ((GAS int*)(ws + WS_H8 + (size_t)m * DM) + lane)[64 * j] = w8; } } }
}

constexpr int CW_WCTR = 8192;
__device__ __forceinline__ void p_moe_weights(const Frame& F, const Args& a) {
    unsigned char* ws = a.ws; LAS float* scr = (LAS float*)(F.lds + F.wave * 16384);
    constexpr int I_GU = NEXP * (DM / 64) * (DFF / 32), I_D = NEXP * (DFF / 64) * (DM / 32), NIT = 2 * I_GU + I_D;
    unsigned* ctr = (unsigned*)(ws + WS_CTL) + CW_WCTR;
    for (;;) {
        unsigned it0 = 0; if (F.lane == 0) it0 = __hip_atomic_fetch_add(ctr, 4u, __ATOMIC_RELAXED, __HIP_MEMORY_SCOPE_AGENT);
        it0 = (unsigned)__builtin_amdgcn_readfirstlane((int)it0);
        if (it0 >= (unsigned)NIT) break;
        for (int k4 = 0; k4 < 4; ++k4) { int r = (int)it0 + k4; if (r >= NIT) break;
            if (r < 2 * I_GU) { const int up = r >= I_GU; if (up) r -= I_GU; constexpr int per = (DM / 64) * (DFF / 32); const int e = r / per, q = r % per, nb = DFF / 32, kb = q / nb, n0 = (q % nb) * 32;
                tr_item(a.in[up ? 14 : 13] + (size_t)e * DM * DFF, DFF, kb * 64, n0, (bf16_t*)(ws + WS_WGU) + (size_t)e * 2048 * DM, DM, (n0 >> 7) * 256 + (n0 & 127) + (up ? 128 : 0), scr, F.lane); continue; }
            r -= 2 * I_GU;
            { constexpr int per = (DFF / 64) * (DM / 32); const int e = r / per, q = r % per, nb = DM / 32, kb = q / nb, n0 = (q % nb) * 32;
                tr_item(a.in[15] + (size_t)e * DFF * DM, DM, kb * 64, n0, (bf16_t*)(ws + WS_WD) + (size_t)e * 2048 * DFF, DFF, n0, scr, F.lane); } }
    }
}

__device__ __forceinline__ void prep_vecs(const Frame& F, bf16_t* T, int ld, int nh_log2, const float* gain, const float* cosT, const float* sinT, float oscale, unsigned char* out8) {
    const int gw = F.vcu * NWAVES + F.wave, NGW = F.G * NWAVES;
    const int sub = F.lane & 15, half = sub >> 3, q = sub & 7;
    const int nvec = NTOK << nh_log2;
    const f32x4 g1 = *(const f32x4*)(gain + half * 64 + 4 * q), g2 = *(const f32x4*)(gain + half * 64 + 32 + 4 * q);
    for (int it = gw; it < nvec / 16; it += NGW) {
        bf16_t* base[4]; u32x2 w1[4], w2[4]; int posx[4];
#pragma unroll
        for (int u = 0; u < 4; ++u) { const int vec = it * 16 + u * 4 + (F.lane >> 4);
            const int tok = vec >> nh_log2, hd = vec & ((1 << nh_log2) - 1), pos = tok & (SEQ - 1); posx[u] = half ? (pos & 63) : (pos >> 6);
            base[u] = T + (size_t)tok * ld + hd * HD + half * 64 + 4 * q; w1[u] = *(const u32x2*)base[u]; w2[u] = *(const u32x2*)(base[u] + 32); }
#pragma unroll
        for (int u = 0; u < 4; ++u) {
            float x1[4] = {bf2f(w1[u].x & 0xffff), bf2f(w1[u].x >> 16), bf2f(w1[u].y & 0xffff), bf2f(w1[u].y >> 16)}, x2[4] = {bf2f(w2[u].x & 0xffff), bf2f(w2[u].x >> 16), bf2f(w2[u].y & 0xffff), bf2f(w2[u].y >> 16)};
            float ss = 0.f;
#pragma unroll
            for (int j = 0; j < 4; ++j) ss += x1[j] * x1[j] + x2[j] * x2[j];
            ss += __shfl_xor(ss, 1); ss += __shfl_xor(ss, 2); ss += __shfl_xor(ss, 4); ss += __shfl_xor(ss, 8);
            const float rinv = 1.0f / sqrtf(ss * (1.0f / 128.0f) + EPS);
            const f32x4 cs = *(const f32x4*)(cosT + posx[u] * 32 + 4 * q), sn = *(const f32x4*)(sinT + posx[u] * 32 + 4 * q);
            float y1[4], y2[4];
#pragma unroll
            for (int j = 0; j < 4; ++j) { const float a1 = x1[j] * rinv * g1[j], a2 = x2[j] * rinv * g2[j]; y1[j] = (a1 * cs[j] - a2 * sn[j]) * oscale; y2[j] = (a2 * cs[j] + a1 * sn[j]) * oscale; }
            if (out8) {
                const int vec = it * 16 + u * 4 + (F.lane >> 4), tok = vec >> nh_log2, hd = vec & ((1 << nh_log2) - 1);
                unsigned char* o8 = out8 + ((size_t)(((tok >> 13) << nh_log2) + hd) * SEQ + (tok & (SEQ - 1))) * HD + half * 64 + 4 * q;
                int w1 = 0, w2 = 0; w1 = __builtin_amdgcn_cvt_pk_fp8_f32(y1[0], y1[1], w1, false); w1 = __builtin_amdgcn_cvt_pk_fp8_f32(y1[2], y1[3], w1, true);
                w2 = __builtin_amdgcn_cvt_pk_fp8_f32(y2[0], y2[1], w2, false); w2 = __builtin_amdgcn_cvt_pk_fp8_f32(y2[2], y2[3], w2, true);
                *(int*)o8 = w1; *(int*)(o8 + 32) = w2;
            } else {
            u32x2 o1, o2; o1.x = cvt_pk_bf16(y1[0], y1[1]); o1.y = cvt_pk_bf16(y1[2], y1[3]); o2.x = cvt_pk_bf16(y2[0], y2[1]); o2.y = cvt_pk_bf16(y2[2], y2[3]);
            *(u32x2*)base[u] = o1; *(u32x2*)(base[u] + 32) = o2; } }
    }
}
__device__ __forceinline__ void p2_qkprep(const Frame& F, const Args& a) {
    const float* cosT = (const float*)(a.ws + WS_ROPE); const float* sinT = cosT + 128 * 32;
    prep_vecs(F, (bf16_t*)(a.ws + WS_KA), KVW, 1, a.in[5], cosT, sinT, 1.0f, a.ws + WS_K8);
    { const bf16_t* VA = (const bf16_t*)(a.ws + WS_VA); unsigned char* V8T = a.ws + WS_V8T; LAS bf16_t* tl = (LAS bf16_t*)F.lds; constexpr int TP = 132;
      for (int T = F.vcu; T < BATCH * 2 * 64; T += F.G) { const int bk = T >> 6, t = T & 63, b = bk >> 1, kvh = bk & 1;
        { const int r = F.tid >> 2, qd = F.tid & 3; const bf16_t* src = VA + ((size_t)b * SEQ + 128 * t + r) * KVW + kvh * HD + qd * 32;
#pragma unroll
          for (int i = 0; i < 4; ++i) { const u32x4 v = *(const u32x4*)(src + 8 * i); LAS unsigned* d = (LAS unsigned*)(tl + r * TP + qd * 32 + 8 * i); d[0] = v.x; d[1] = v.y; d[2] = v.z; d[3] = v.w; } }
        __syncthreads();
        { const int d = F.tid >> 2, g = F.tid & 3; int w[8];
#pragma unroll
          for (int kb = 0; kb < 8; ++kb) { float x[4];
#pragma unroll
            for (int r = 0; r < 4; ++r) x[r] = bf2f(tl[(16 * kb + 4 * g + r) * TP + d]);
            int ww = 0; ww = __builtin_amdgcn_cvt_pk_fp8_f32(x[0], x[1], ww, false); ww = __builtin_amdgcn_cvt_pk_fp8_f32(x[2], x[3], ww, true); w[kb] = ww; }
          unsigned char* dst = V8T + ((size_t)T * HD + d) * 128 + 32 * g;
          *(u32x4*)dst = (u32x4){(unsigned)w[0], (unsigned)w[1], (unsigned)w[2], (unsigned)w[3]}; *(u32x4*)(dst + 16) = (u32x4){(unsigned)w[4], (unsigned)w[5], (unsigned)w[6], (unsigned)w[7]}; }
        __syncthreads(); } }
}

template <int MODE> __device__ __forceinline__ void p3_attention(const Frame& F, const Args& a, char* lds) {
    unsigned char* ws = a.ws;
    const bf16_t* Q = (const bf16_t*)(ws + (MODE == 0 ? WS_QA : WS_QB)); const bf16_t* K = (const bf16_t*)(ws + (MODE == 0 ? WS_KA : WS_KB)); const bf16_t* V = (const bf16_t*)(ws + (MODE == 0 ? WS_VA : WS_VB));
    att::Aux aux; aux.cosT = (const float*)(ws + WS_ROPE); aux.sinT = aux.cosT + 128 * 32; aux.qn = a.in[4]; aux.kn = a.in[5]; aux.relb = a.in[8]; aux.sink = a.in[7];
#define BUILD_TABS(kvh_) do { float* tabs_ = (float*)(lds + att::OFF_TAB); for (int i_ = F.tid; i_ < 4 * 768; i_ += 512) { const int hh_ = i_ / 768, ii_ = i_ - hh_ * 768, rel_ = ii_ - 383, n_ = rel_ < 0 ? -rel_ : rel_; float v_ = -1e30f; \
        if (n_ <= 128) v_ = aux.relb[att::t5_bucket(rel_) * NHB + (kvh_) * 4 + hh_] * LOG2E; tabs_[i_] = v_; } } while (0)
    float pscale = 1.f;
    if (MODE == 0) { float mq = fmaxf(fabsf(aux.qn[F.lane]), fabsf(aux.qn[64 + F.lane])), mk = fmaxf(fabsf(aux.kn[F.lane]), fabsf(aux.kn[64 + F.lane]));
#pragma unroll
        for (int of = 1; of < 64; of <<= 1) { mq = fmaxf(mq, __shfl_xor(mq, of)); mk = fmaxf(mk, __shfl_xor(mk, of)); }
        const float bound = att::C * 128.0f * mq * mk * 1.13f + 0.5f; pscale = __builtin_amdgcn_exp2f(fmaxf(ceilf(bound) - 15.f, 0.f));
        pscale = __uint_as_float(__builtin_amdgcn_readfirstlane(__float_as_uint(pscale))); }
    const bool shared_tabs = (F.G == 256);
    if (MODE == 1 && shared_tabs) { BUILD_TABS((F.vcu >> 5) & 1); __syncthreads(); }
    for (int i = 0;; ++i) {
        const int L = i * F.G + F.vcu; if (L >= 1024) break;
        const int x = (L & 255) >> 5, b = x >> 1, kvh = x & 1;
        const int qb = (MODE == 0) ? (L & 31) : ((L >> 8) * 32 + (L & 31));
        const int head = (MODE == 0) ? kvh * 4 + (L >> 8) : kvh * 4, q0 = qb * ((MODE == 0) ? 256 : 64);
        const bf16_t* Qb = Q + ((size_t)b * SEQ + q0) * QW + head * HD;
        const bf16_t* Kh = K + (size_t)b * SEQ * KVW + kvh * HD; const bf16_t* Vh = V + (size_t)b * SEQ * KVW + kvh * HD;
        int kbeg = 0, kend = SEQ;
        if (MODE == 1) { kbeg = q0 - 128 < 0 ? 0 : q0 - 128; kend = q0 + 192 > SEQ ? SEQ : q0 + 192; }
        if (MODE == 1 && !shared_tabs) { __syncthreads(); BUILD_TABS(kvh); __syncthreads(); }
        bf16_t* Ob = (bf16_t*)(ws + (MODE == 0 ? WS_OA : WS_OB)) + ((size_t)b * SEQ + q0) * QW + head * HD;
        if constexpr (MODE == 0) att::attn_unit8(Qb, a.ws + WS_K8 + (size_t)(b * 2 + kvh) * SEQ * HD, a.ws + WS_V8T + (size_t)(b * 2 + kvh) * 64 * 16384, Ob, q0, lds, aux, pscale);
        else att::attn_unit_pp<MODE>(Qb, Kh, Vh, Ob, kbeg, kend, q0, head, lds, aux);
    }
#undef BUILD_TABS
}

__device__ __forceinline__ void p7_router(const Frame& F, const Args& a) {
    LAS float* wl = (LAS float*)F.lds;
    const float* wr = a.in[12];
    for (int i = F.tid; i < DM * NEXP / 4; i += 512) { const f32x4 v = *(const f32x4*)(wr + 4 * i); const int k = i >> 2, e0 = (i & 3) * 4;
        wl[(e0 + 0) * DM + k] = v.x; wl[(e0 + 1) * DM + k] = v.y; wl[(e0 + 2) * DM + k] = v.z; wl[(e0 + 3) * DM + k] = v.w; }
    __syncthreads();
    const float* X = a.in[0]; const bf16_t* ATT = (const bf16_t*)(a.ws + WS_ATT); bf16_t* H2 = (bf16_t*)(a.ws + WS_H); float* AFF = (float*)(a.ws + WS_AFF); const float* g = a.in[11];
    const int gw = F.vcu * NWAVES + F.wave, NGW = F.G * NWAVES, lane = F.lane;
    f32x4 nx[2][8]; u32x2 na[2][8];
#define RT_LOAD(rp_) do { _Pragma("unroll") for (int rr = 0; rr < 2; ++rr) { const size_t row_ = (size_t)(2 * (rp_) + rr); const GAS f32x4* xr = (const GAS f32x4*)(X + row_ * DM) + lane; const GAS u32x2* ar = (const GAS u32x2*)(ATT + row_ * DM) + lane; \
        _Pragma("unroll") for (int j = 0; j < 8; ++j) { nx[rr][j] = xr[64 * j]; if (DBG_LEVEL >= 3) na[rr][j] = ar[64 * j]; else na[rr][j] = (u32x2){0u, 0u}; } } } while (0)
    int rp = gw;
    if (rp < NTOK / 2) RT_LOAD(rp);
    for (; rp < NTOK / 2; rp += NGW) {
        f32x4 h[2][8]; float rinv[2];
#pragma unroll
        for (int rr = 0; rr < 2; ++rr) { float s = 0.f;
#pragma unroll
            for (int j = 0; j < 8; ++j) { f32x4 v = nx[rr][j]; const u32x2 w = na[rr][j]; v.x += __uint_as_float(w.x << 16); v.y += __uint_as_float(w.x & 0xffff0000u); v.z += __uint_as_float(w.y << 16); v.w += __uint_as_float(w.y & 0xffff0000u);
                h[rr][j] = v; s += (v.x * v.x + v.y * v.y) + (v.z * v.z + v.w * v.w); }
            rinv[rr] = s; }
#if DBG_LEVEL >= 3
#pragma unroll
        for (int rr = 0; rr < 2; ++rr) { GAS u32x2* x8 = (GAS u32x2*)((bf16_t*)(a.ws + WS_ATT) + (size_t)(2 * rp + rr) * DM) + lane;
#pragma unroll
            for (int j = 0; j < 8; ++j) { u32x2 w; w.x = cvt_pk_bf16(h[rr][j].x, h[rr][j].y); w.y = cvt_pk_bf16(h[rr][j].z, h[rr][j].w); x8[64 * j] = w; } }
#endif
        { const int nrp = rp + NGW; if (nrp < NTOK / 2) RT_LOAD(nrp); }
#pragma unroll
        for (int rr = 0; rr < 2; ++rr) { rinv[rr] = 1.0f / sqrtf(wave_sum(rinv[rr]) * (1.f / DM) + EPS);
            GAS u32x2* o8 = (GAS u32x2*)(H2 + (size_t)(2 * rp + rr) * DM) + lane;
#pragma unroll
            for (int j = 0; j < 8; ++j) { const f32x4 gv = ((const GAS f32x4*)g + lane)[64 * j]; h[rr][j] = h[rr][j] * rinv[rr] * gv;
                u32x2 w; w.x = cvt_pk_bf16(h[rr][j].x, h[rr][j].y); w.y = cvt_pk_bf16(h[rr][j].z, h[rr][j].w); o8[64 * j] = w; } }
        float v[32];
#pragma unroll
        for (int e = 0; e < NEXP; ++e) { float s0 = 0.f, s1 = 0.f;
#pragma unroll
            for (int j = 0; j < 8; ++j) { const f32x4 w = *(const LAS f32x4*)(wl + e * DM + 4 * lane + 256 * j);
                s0 += (h[0][j].x * w.x + h[0][j].y * w.y) + (h[0][j].z * w.z + h[0][j].w * w.w); s1 += (h[1][j].x * w.x + h[1][j].y * w.y) + (h[1][j].z * w.z + h[1][j].w * w.w); }
            v[e] = s0; v[16 + e] = s1; }
#pragma unroll
        for (int off = 16; off >= 1; off >>= 1) { const bool up = (lane & off) != 0;
#pragma unroll
            for (int i = 0; i < off; ++i) { const float lo = v[i], hi = v[i + off]; const float keep = up ? hi : lo, send = up ? lo : hi; v[i] = keep + __shfl_xor(send, off); } }
        const float mine = v[0] + __shfl_xor(v[0], 32);
        float mx = mine; mx = fmaxf(mx, __shfl_xor(mx, 1)); mx = fmaxf(mx, __shfl_xor(mx, 2)); mx = fmaxf(mx, __shfl_xor(mx, 4)); mx = fmaxf(mx, __shfl_xor(mx, 8));
        const float ex = expf(mine - mx); float sm = ex; sm += __shfl_xor(sm, 1); sm += __shfl_xor(sm, 2); sm += __shfl_xor(sm, 4); sm += __shfl_xor(sm, 8);
        if (lane < 32) { const int row = 2 * rp + (lane >> 4), e = lane & 15, b = row >> 13, s = row & (SEQ - 1); AFF[((size_t)(b * NEXP + e)) * SEQ + s] = ex / sm; }
    }
#undef RT_LOAD
    __syncthreads();
}

__device__ __forceinline__ int block_excl_scan(int v, LAS int* sc, int tid, int& total) {
    const int lane = tid & 63, w = tid >> 6; int x = v;
#pragma unroll
    for (int o = 1; o < 64; o <<= 1) { const int y = __shfl_up(x, o); if (lane >= o) x += y; }
    __syncthreads();
    if (lane == 63) sc[w] = x;
    __syncthreads();
    int pre = 0, tot = 0;
#pragma unroll
    for (int j = 0; j < 8; ++j) { const int s = sc[j]; if (j < w) pre += s; tot += s; }
    total = tot; return pre + x - v;
}
__device__ __forceinline__ void p8_topk(const Frame& F, const Args& a) {
    const float* AFF = (const float*)(a.ws + WS_AFF); int* IDX = (int*)(a.ws + WS_IDX); float* GATEV = (float*)(a.ws + WS_GATEV); int* INV = (int*)(a.ws + WS_INV);
    LAS int* hist = (LAS int*)F.lds; LAS int* sc = hist + 256; LAS int* res = sc + 16;
    const int tid = F.tid, lane = F.lane;
    for (int list = F.vcu; list < NLIST; list += F.G) {
        const int b = list / NEXP, e = list % NEXP;
        unsigned key[16];
        { const u32x4* src = (const u32x4*)(AFF + (size_t)list * SEQ + tid * 16);
#pragma unroll
            for (int j = 0; j < 4; ++j) { const u32x4 v = src[j]; key[4 * j] = v.x; key[4 * j + 1] = v.y; key[4 * j + 2] = v.z; key[4 * j + 3] = v.w; } }
        unsigned prefix = 0u, pmask = 0u; int krem = CAP;
#pragma unroll 1
        for (int pass = 0; pass < 4; ++pass) { const int shift = 24 - 8 * pass;
            __syncthreads();
            if (tid < 256) hist[tid] = 0;
            __syncthreads();
#pragma unroll
            for (int j = 0; j < 16; ++j) if ((key[j] & pmask) == prefix) __hip_atomic_fetch_add(&hist[(key[j] >> shift) & 255u], 1, __ATOMIC_RELAXED, __HIP_MEMORY_SCOPE_WORKGROUP);
            __syncthreads();
            if (tid < 64) {
                int c[4]; int s = 0;
#pragma unroll
                for (int j = 0; j < 4; ++j) { c[j] = hist[4 * lane + j]; s += c[j]; }
                int suf = s;
#pragma unroll
                for (int o = 1; o < 64; o <<= 1) { const int y = __shfl_down(suf, o); if (lane + o < 64) suf += y; }
                const int excl = suf - s;
                if (suf >= krem && excl < krem) { int cum = excl, bin = 4 * lane, kn = krem;
#pragma unroll
                    for (int j = 3; j >= 0; --j) { if (cum < krem && cum + c[j] >= krem) { bin = 4 * lane + j; kn = krem - cum; } cum += c[j]; }
                    res[0] = bin; res[1] = kn; }
            }
            __syncthreads();
            const int bin = res[0]; krem = res[1];
            prefix |= ((unsigned)bin) << shift; pmask |= 255u << shift;
        }
        const unsigned T = prefix;
        int ceq = 0;
#pragma unroll
        for (int j = 0; j < 16; ++j) ceq += (key[j] == T) ? 1 : 0;
        int toteq; const int eqb = block_excl_scan(ceq, sc, tid, toteq);
        int csel = 0, er = eqb; unsigned selmask = 0u;
#pragma unroll
        for (int j = 0; j < 16; ++j) { bool s = key[j] > T; if (key[j] == T) { s = er < krem; ++er; } if (s) { selmask |= 1u << j; ++csel; } }
        int totsel; int pos = block_excl_scan(csel, sc, tid, totsel);
#pragma unroll
        for (int j = 0; j < 16; ++j) { const int tokpos = tid * 16 + j; int slot = -1;
            if (selmask & (1u << j)) { slot = list * CAP + pos; IDX[slot] = tokpos; GATEV[slot] = __uint_as_float(key[j]); ++pos; }
            INV[((size_t)b * SEQ + tokpos) * NEXP + e] = slot; }
        __syncthreads();
    }
}

__device__ __forceinline__ void p11_final(const Frame& F, const Args& a, bool with_moe) {
    const float* X = a.in[0]; float* OUT = a.out; const bf16_t* ATT = (const bf16_t*)(a.ws + WS_ATT); const bf16_t* Y = (const bf16_t*)(a.ws + WS_Y); const int* INV = (const int*)(a.ws + WS_INV); const float* g = a.in[16];
    const int gw = F.vcu * NWAVES + F.wave, NGW = F.G * NWAVES, lane = F.lane;
    f32x4 nx[8]; u32x2 na[8]; int ninv = -1;
#define FN_LOAD(m_) do { const GAS f32x4* xr = (const GAS f32x4*)(X + (size_t)(m_) * DM) + lane; const GAS u32x2* ar = (const GAS u32x2*)(ATT + (size_t)(m_) * DM) + lane; \
        _Pragma("unroll") for (int j = 0; j < 8; ++j) { if (DBG_LEVEL >= 3) na[j] = ar[64 * j]; else nx[j] = xr[64 * j]; } \
        ninv = (with_moe && lane < NEXP) ? INV[(size_t)(m_) * NEXP + lane] : -1; } while (0)
    int m = gw;
    if (m < NTOK) FN_LOAD(m);
    for (; m < NTOK; m += NGW) {
        f32x4 v[8]; const int myinv = ninv;
#pragma unroll
        for (int j = 0; j < 8; ++j) { if (DBG_LEVEL >= 3) { const u32x2 w = na[j]; v[j].x = __uint_as_float(w.x << 16); v[j].y = __uint_as_float(w.x & 0xffff0000u); v[j].z = __uint_as_float(w.y << 16); v[j].w = __uint_as_float(w.y & 0xffff0000u); } else v[j] = nx[j]; }
        unsigned long long mask = __ballot(myinv >= 0);
        u32x2 y0[8]; const bool has0 = mask != 0ull;
        if (has0) { const int e = __builtin_ctzll(mask); mask &= mask - 1; const int slot = __builtin_amdgcn_readlane(myinv, e); const GAS u32x2* yr = (const GAS u32x2*)(Y + (size_t)slot * DM) + lane;
#pragma unroll
            for (int j = 0; j < 8; ++j) y0[j] = yr[64 * j]; }
        { const int nm = m + NGW; if (nm < NTOK) FN_LOAD(nm); }
        if (has0) {
#pragma unroll
            for (int j = 0; j < 8; ++j) { const u32x2 w = y0[j]; v[j].x += __uint_as_float(w.x << 16); v[j].y += __uint_as_float(w.x & 0xffff0000u); v[j].z += __uint_as_float(w.y << 16); v[j].w += __uint_as_float(w.y & 0xffff0000u); } }
        while (mask) { const int e = __builtin_ctzll(mask); mask &= mask - 1; const int slot = __builtin_amdgcn_readlane(myinv, e);
            const GAS u32x2* yr = (const GAS u32x2*)(Y + (size_t)slot * DM) + lane;
#pragma unroll
            for (int j = 0; j < 8; ++j) { const u32x2 w = yr[64 * j]; v[j].x += __uint_as_float(w.x << 16); v[j].y += __uint_as_float(w.x & 0xffff0000u); v[j].z += __uint_as_float(w.y << 16); v[j].w += __uint_as_float(w.y & 0xffff0000u); } }
        float s = 0.f;
#pragma unroll
        for (int j = 0; j < 8; ++j) s += (v[j].x * v[j].x + v[j].y * v[j].y) + (v[j].z * v[j].z + v[j].w * v[j].w);
        const float rinv = 1.0f / sqrtf(wave_sum(s) * (1.f / DM) + EPS);
        GAS f32x4* orow = (GAS f32x4*)(OUT + (size_t)m * DM) + lane;
#pragma unroll
        for (int j = 0; j < 8; ++j) { const f32x4 gv = ((const GAS f32x4*)g + lane)[64 * j]; orow[64 * j] = v[j] * rinv * gv; }
    }
#undef FN_LOAD
}
__device__ __forceinline__ void p_copy_x(const Frame& F, const Args& a) {
    const f32x4* src = (const f32x4*)a.in[0]; f32x4* dst = (f32x4*)a.out;
    for (size_t i = (size_t)blockIdx.x * 512 + F.tid; i < (size_t)NTOK * DM / 4; i += (size_t)F.G * 512) dst[i] = src[i];
}

constexpr int NPHASE = 10;
__global__ void __launch_bounds__(NWAVES * 64, 2) fwd_kernel(Args args) {
    extern __shared__ __attribute__((aligned(16))) unsigned char lds[];
    Frame F;
    F.lds = (LAS unsigned char*)lds;
    F.tid = threadIdx.x; F.lane = F.tid & 63; F.wave = __builtin_amdgcn_readfirstlane(F.tid >> 6);
    F.G = gridDim.x; { const int bx = blockIdx.x; F.vcu = (F.G % 8 == 0) ? (bx % 8) * (F.G / 8) + bx / 8 : bx; }
    unsigned char* ws = args.ws;
    gu32* ctl = (gu32*)(ws + WS_CTL);
    for (int u = F.tid; u < (LDS_BYTES - LDSCTL_OFF) / 4; u += NWAVES * 64) ((LAS unsigned*)(F.lds + LDSCTL_OFF))[u] = 0u;
    __syncthreads();
    XcdBarrier bar; bar.bar = (unsigned*)(ctl + CW_BAR); bar.x = 0; bar.st = nullptr;
    if (MK_N_LAUNCHES == 1) bar = xcd_barrier_post((unsigned*)(ctl + CW_BAR), (volatile LAS unsigned*)(F.lds + LDSCTL_OFF + 64));
    const int lo = args.ph_lo, hi = args.ph_hi;
#define IN(k) (lo <= (k) && (k) < hi)
#define SEAM(k) do { if (IN(k) && IN((k) + 1)) xcd_barrier(bar); } while (0)
#define REFRAME() do { int t_ = threadIdx.x; asm volatile("" : "+v"(t_)); F.tid = t_; F.lane = t_ & 63; F.wave = __builtin_amdgcn_readfirstlane(t_ >> 6); } while (0)

    if (IN(0)) { REFRAME(); for (int rep = 0; rep < REPS(0); ++rep) p0_prologue(F, args); }
    SEAM(0);
    if (IN(1)) { REFRAME();
#if DBG_LEVEL >= 3
        { pg8::MapProb<DM, 1, 1> P; P.A = ws + WS_H8; P.Bt = ws + WS_WIN8; P.S.init(NTOK, 22 * 256, F.G, (int)blockIdx.x);
          pg8::EpiInProj E{(bf16_t*)(ws + WS_QA), (bf16_t*)(ws + WS_KA), (bf16_t*)(ws + WS_VA), (bf16_t*)(ws + WS_QB), (bf16_t*)(ws + WS_KB), (bf16_t*)(ws + WS_VB), (bf16_t*)(ws + WS_GA), (bf16_t*)(ws + WS_GB), args.in[3], 1.0f / W8S};
          pg8::gemm_phase8<pg8::EpiInProj, pg8::MapProb<DM, 1, 1>, true>(F.lds, P, E); }
        { int gg_ = F.G; asm volatile("" : "+s"(gg_)); unsigned char* ws2_ = ws; asm volatile("" : "+s"(ws2_));
          pg8::MapProb<DM, 2, 2> P; P.A = ws2_ + WS_H; P.Bt = ws2_ + WS_WIN; P.S.init(NTOK, 6 * 256, gg_, (int)blockIdx.x);
          pg8::EpiInProj E{(bf16_t*)(ws2_ + WS_QA), (bf16_t*)(ws2_ + WS_KA), (bf16_t*)(ws2_ + WS_VA), (bf16_t*)(ws2_ + WS_QB), (bf16_t*)(ws2_ + WS_KB), (bf16_t*)(ws2_ + WS_VB), (bf16_t*)(ws2_ + WS_GA), (bf16_t*)(ws2_ + WS_GB), args.in[3], 1.0f};
          pg8::gemm_phase<pg8::EpiInProj, pg8::MapProb<DM, 2, 2>, true>(F.lds, P, E); }
#endif
    }
    SEAM(1);
    if (IN(2)) { REFRAME();
#if DBG_LEVEL >= 4
        p2_qkprep(F, args);
#endif
    }
    SEAM(2);
    if (IN(3)) { REFRAME();
#if DBG_LEVEL >= 4
        for (int rep = 0; rep < REPS(3); ++rep) p3_attention<0>(F, args, (char*)lds);
#endif
#if DBG_LEVEL >= 3
        __syncthreads();
        for (int rep = 0; rep < REPS(13); ++rep) p3_attention<1>(F, args, (char*)lds);
        __syncthreads();
#endif
    }
    SEAM(3);
    if (IN(4)) { REFRAME();
#if DBG_LEVEL >= 4
        { pg8::DenseProb<QW> P; P.A = (const bf16_t*)(ws + WS_OA); P.Bt = (const bf16_t*)(ws + WS_WPA); P.S.init(NTOK, DM, F.G, (int)blockIdx.x);
          pg8::EpiGated<0> E{(bf16_t*)(ws + WS_GA), nullptr, 1.0f};
          pg8::gemm_phase<pg8::EpiGated<0>, pg8::DenseProb<QW>, true>(F.lds, P, E); }
        { int gg_ = F.G; asm volatile("" : "+s"(gg_));
          unsigned char* ws2_ = ws; asm volatile("" : "+s"(ws2_));
          pg8::DenseProb<QW> P; P.A = (const bf16_t*)(ws2_ + WS_OB); P.Bt = (const bf16_t*)(ws2_ + WS_WPB); P.S.init(NTOK, DM, gg_, (int)blockIdx.x);
          pg8::EpiGated<1> E{(bf16_t*)(ws2_ + WS_GA), (const bf16_t*)(ws2_ + WS_GB), 1.0f};
          pg8::gemm_phase<pg8::EpiGated<1>, pg8::DenseProb<QW>, true>(F.lds, P, E); }
#elif DBG_LEVEL >= 3
        { pg8::DenseProb<QW> P; P.A = (const bf16_t*)(ws + WS_OB); P.Bt = (const bf16_t*)(ws + WS_WPB); P.S.init(NTOK, DM, F.G, (int)blockIdx.x);
          pg8::EpiGated<2> E{(bf16_t*)(ws + WS_GA), (const bf16_t*)(ws + WS_GB)};
          pg8::gemm_phase<pg8::EpiGated<2>, pg8::DenseProb<QW>, true>(F.lds, P, E); }
#endif
    }
    SEAM(4);
    if (IN(5)) { REFRAME();
#if DBG_LEVEL >= 3
        pg8::DenseProb<DM> P; P.A = (const bf16_t*)(ws + WS_GA); P.Bt = (const bf16_t*)(ws + WS_WO); P.S.init(NTOK, DM, F.G, (int)blockIdx.x);
        pg8::EpiAtt E{(bf16_t*)(ws + WS_ATT)};
        for (int rep = 0; rep < REPS(5); ++rep) pg8::gemm_phase<pg8::EpiAtt, pg8::DenseProb<DM>, true>(F.lds, P, E);
#endif
    }
    SEAM(5);
    if (IN(6)) { REFRAME();
#if DBG_LEVEL >= 2
        for (int rep = 0; rep < REPS(6); ++rep) p7_router(F, args);
#endif
    }
    SEAM(6);
    if (IN(7)) { REFRAME();
#if DBG_LEVEL >= 2
        for (int rep = 0; rep < REPS(7); ++rep) p8_topk(F, args);
        __syncthreads();
        p_moe_weights(F, args);
#endif
    }
    SEAM(7);
    if (IN(8)) { REFRAME();
#if DBG_LEVEL >= 2
        LAS unsigned* rowoff = (LAS unsigned*)(F.lds + pg8::STAGE_BYTES);
        const int* IDX = (const int*)(ws + WS_IDX);
        for (int i = 0; i < 8; ++i) { pg8::Unit u; int e, b; if (!pg8::moe_unit(i, F.G, F.vcu, u, e, b)) break;
            if (F.tid < 256) rowoff[i * 256 + F.tid] = (unsigned)IDX[u.pm * 256 + F.tid] * (unsigned)(DM * 2); }
        __syncthreads();
        pg8::GuProb P; P.H2 = (const bf16_t*)(ws + WS_H); P.W = (const bf16_t*)(ws + WS_WGU); P.rowoff = rowoff; P.G = F.G; P.vcu = F.vcu;
        pg8::EpiSwiglu E{(bf16_t*)(ws + WS_GA)};
        for (int rep = 0; rep < REPS(8); ++rep) pg8::gemm_phase<pg8::EpiSwiglu, pg8::GuProb, true>(F.lds, P, E);
#endif
    }
    SEAM(8);
    if (IN(9)) { REFRAME();
#if DBG_LEVEL >= 2
        pg8::DownProb P; P.HID = (const bf16_t*)(ws + WS_GA); P.W = (const bf16_t*)(ws + WS_WD); P.G = F.G; P.vcu = F.vcu;
        pg8::EpiDown E{(bf16_t*)(ws + WS_Y), (const float*)(ws + WS_GATEV)};
        for (int rep = 0; rep < REPS(9); ++rep) pg8::gemm_phase<pg8::EpiDown, pg8::DownProb, true>(F.lds, P, E);
#endif
    }
    SEAM(9);
    if (IN(10)) { REFRAME(); p11_final(F, args, DBG_LEVEL >= 2); }
#undef IN
#undef SEAM
}

extern "C" void kernel_launch(void* const* d_in, const int* in_sizes, int n_in, void* d_out, int out_size, void* d_ws, size_t ws_size, hipStream_t stream) {
    static int grid = 0;
    if (grid == 0) {
        if (n_in != 17 || in_sizes[0] != NTOK * DM || out_size != NTOK * DM || ws_size < WS_END) { fprintf(stderr, "kernel_launch: unexpected shapes (n_in %d, in0 %d, out %d, ws %zu); nothing launched\n", n_in, n_in > 0 ? in_sizes[0] : -1, out_size, ws_size); grid = -1; return; }
        int dev = 0, cus = 0, per_cu = 0;
        if (hipGetDevice(&dev) != hipSuccess || hipDeviceGetAttribute(&cus, hipDeviceAttributeMultiprocessorCount, dev) != hipSuccess) { grid = -1; return; }
        if (hipFuncSetAttribute((const void*)fwd_kernel, hipFuncAttributeMaxDynamicSharedMemorySize, LDS_BYTES) != hipSuccess) { fprintf(stderr, "kernel_launch: hipFuncSetAttribute failed\n"); grid = -1; return; }
        if (hipOccupancyMaxActiveBlocksPerMultiprocessor(&per_cu, (const void*)fwd_kernel, NWAVES * 64, LDS_BYTES) != hipSuccess || per_cu < 1)
            fprintf(stderr, "kernel_launch: note: occupancy query reports %d workgroups per CU\n", per_cu);
        (void)hipGetLastError();
        grid = cus;
    }
    if (grid < 0) return;
    (void)hipMemsetAsync((char*)d_ws + WS_CTL, 0, CTL_ZERO_BYTES, stream);
    Args a{};
    for (int i = 0; i < 17; ++i) a.in[i] = (const float*)d_in[i];
    a.out = (float*)d_out; a.ws = (unsigned char*)d_ws;
#if MK_N_LAUNCHES == 1
    a.ph_lo = 0; a.ph_hi = NPHASE + 1; a.li = 0;
    hipLaunchKernelGGL(fwd_kernel, dim3(grid), dim3(NWAVES * 64), LDS_BYTES, stream, a);
#else
    for (int li = 0; li <= NPHASE; ++li) { a.ph_lo = li; a.ph_hi = li + 1; a.li = li;
        hipLaunchKernelGGL(fwd_kernel, dim3(grid), dim3(NWAVES * 64), LDS_BYTES, stream, a); }
#endif
    const hipError_t le = hipPeekAtLastError();
    if (le != hipSuccess) fprintf(stderr, "kernel_launch: launch failed: %s\n", hipGetErrorName(le));
}
```

```cpp
#include <hip/hip_runtime.h>
#include <cstdio>
#include <cstdint>

#ifndef MK_N_LAUNCHES
#define MK_N_LAUNCHES 1
#endif
#ifndef DBG_LEVEL
#define DBG_LEVEL 4
#endif

#ifndef REP_PHASE
#define REP_PHASE -1
#endif
#define REPS(k) ((REP_PHASE == (k)) ? 2 : 1)
#define GAS __attribute__((address_space(1)))
#define LAS __attribute__((address_space(3)))
typedef unsigned short bf16_t;
typedef short bf16x8 __attribute__((ext_vector_type(8)));
typedef short s16x4 __attribute__((ext_vector_type(4)));
typedef float f32x2 __attribute__((ext_vector_type(2)));
typedef float f32x4 __attribute__((ext_vector_type(4)));
typedef float f32x8 __attribute__((ext_vector_type(8)));
typedef float f32x16 __attribute__((ext_vector_type(16)));
typedef unsigned u32x2 __attribute__((ext_vector_type(2)));
typedef unsigned u32x4 __attribute__((ext_vector_type(4)));
typedef GAS unsigned gu32;

constexpr int BATCH = 4, SEQ = 8192, DM = 2048, NTOK = BATCH * SEQ, HD = 128;
constexpr int NHA = 8, NHB = 8;
constexpr int QW = 1024, KVW = 256, INW = 7168;
constexpr int NEXP = 16, CAP = 1024, DFF = 1024, NLIST = BATCH * NEXP, NSLOT = NLIST * CAP;
constexpr float EPS = 1e-6f, LOG2E = 1.4426950408889634f;

constexpr size_t MiB = 1u << 20;
constexpr size_t WS_CTL = 0, CTL_ZERO_BYTES = 1 * MiB;
constexpr size_t WS_ROPE = 1 * MiB;
constexpr size_t WS_AFF = 2 * MiB;
constexpr size_t WS_IDX = 4 * MiB;
constexpr size_t WS_GATEV = 4 * MiB + 256 * 1024;
constexpr size_t WS_INV = 5 * MiB;
constexpr size_t WS_WIN = 8 * MiB;
constexpr size_t WS_WPA = 36 * MiB;
constexpr size_t WS_WPB = 40 * MiB;
constexpr size_t WS_WO = 44 * MiB;
constexpr size_t WS_WGU = 52 * MiB;
constexpr size_t WS_WD = 180 * MiB;
constexpr size_t WS_H = 244 * MiB;
constexpr size_t WS_GA = 372 * MiB;
constexpr size_t WS_GB = 500 * MiB;
constexpr size_t WS_QA = 628 * MiB, WS_KA = 692 * MiB, WS_VA = 708 * MiB, WS_QB = 724 * MiB, WS_KB = 788 * MiB, WS_VB = 804 * MiB;
constexpr size_t WS_Y = 500 * MiB;
constexpr size_t WS_OA = 820 * MiB, WS_OB = 884 * MiB;
constexpr size_t WS_ATT = 820 * MiB;
constexpr size_t WS_K8 = 948 * MiB;
constexpr size_t WS_V8T = 956 * MiB;
constexpr size_t WS_H8 = 820 * MiB;
constexpr size_t WS_WIN8 = 964 * MiB;
constexpr size_t WS_WPA8 = 978 * MiB, WS_WPB8 = 980 * MiB;
constexpr size_t WS_WO8 = 982 * MiB;
constexpr size_t WS_END = 986 * MiB;
constexpr size_t WS_OA8 = 820 * MiB, WS_OB8 = 884 * MiB;
constexpr size_t WS_M8 = 244 * MiB;
constexpr float OB8S = 8.f, M8S = 16.f;
constexpr float W8S = 32.f, OA8S = 64.f;
constexpr int CW_TMO = 0;
constexpr int CW_BAR = 4096;

constexpr int LDS_SCRATCH = 155648;
constexpr int LDSCTL_OFF = LDS_SCRATCH;
constexpr int LDS_BYTES = LDS_SCRATCH + 512;

__device__ __forceinline__ unsigned cvt_pk_bf16(float lo, float hi) { unsigned r; asm volatile("v_cvt_pk_bf16_f32 %0, %1, %2" : "=v"(r) : "v"(lo), "v"(hi)); return r; }
__device__ __forceinline__ float bf2f(unsigned short v) { return __uint_as_float(((unsigned)v) << 16); }
__device__ __forceinline__ unsigned short f2bf(float f) { return (unsigned short)(cvt_pk_bf16(f, 0.f) & 0xffffu); }
__device__ __forceinline__ float wave_sum(float v) {
#pragma unroll
    for (int o = 1; o < 64; o <<= 1) v += __shfl_xor(v, o);
    return v;
}
__device__ __forceinline__ float sigmoidf_fast(float z) { return __builtin_amdgcn_rcpf(1.f + __builtin_amdgcn_exp2f(-z * LOG2E)); }
#define LDS_WAIT() asm volatile("s_waitcnt lgkmcnt(0)" ::: "memory")
#define VM_WAIT() asm volatile("s_waitcnt vmcnt(0)" ::: "memory")

namespace pg8 {
constexpr int BM = 256, BK = 64, HALF = 128, HTB = HALF * BK * 2, STAGE_BYTES = 8 * HTB;
__host__ __device__ __forceinline__ int lds_byte(int r, int c) { const int st = (r >> 4) * 2 + (c >> 5), rr = r & 15, cc = c & 31, ob = rr * 64 + cc * 2; return st * 1024 + (ob ^ (((ob >> 9) & 1) << 5)); }
__host__ __device__ __forceinline__ void stage_rc(int b, int& R, int& C) { const int st = b / 1024, sb = b % 1024, swz = sb ^ (((sb >> 9) & 1) << 5); R = (st >> 1) * 16 + swz / 64; C = (st & 1) * 32 + (swz % 64) / 2; }
__host__ __device__ __forceinline__ int perm32(int rho) { const int n = rho >> 4, i = rho & 15; return 8 * (i >> 2) + 4 * n + (i & 3); }

struct Unit { int pm, pn, ord; };

struct StaticOrder {
    int nM, nN, nwg, G, c;
    __device__ void init(int M, int N, int G_, int c_) { nM = M / BM; nN = N / BM; nwg = nM * nN; G = G_; c = c_; }
    __device__ bool next(int i, Unit& u) const {
        const long L = (long)i * G + c; if (L >= nwg) return false;
        int wgid = (int)L; { const int q = nwg / 8, r = nwg % 8, xcd = wgid % 8, off = wgid / 8; wgid = (xcd < r ? xcd * (q + 1) : r * (q + 1) + (xcd - r) * q) + off; }
        const int nig = 8 * nN, gid = wgid / nig, fm = gid * 8, gsz = (nM - fm) < 8 ? (nM - fm) : 8;
        u.pm = fm + ((wgid % nig) % gsz); u.pn = (wgid % nig) / gsz; u.ord = i; return true;
    }
};

template <class Epi, class Prob, bool ALIGN_EPI>
__device__ __forceinline__ void gemm_phase(LAS unsigned char* lds, const Prob& P, const Epi& E) {
    int tid = threadIdx.x; asm volatile("" : "+v"(tid));
    const int wid = __builtin_amdgcn_readfirstlane(tid >> 6), lane = tid & 63, wr = wid >> 2, wc = wid & 3, fr = lane & 15, fq = lane >> 4;
    constexpr int K = Prob::K, nt = K / BK;
    int Rs[2], Cs[2]; unsigned voffB[2];
#pragma unroll
    for (int i = 0; i < 2; ++i) { int R, C; stage_rc(tid * 16 + i * 8192, R, C); const int Rb = Epi::PERM ? ((R & ~31) + perm32(R & 31)) : R;
        Rs[i] = R; Cs[i] = C; voffB[i] = (unsigned)(Rb * K + C) * 2u; }
    constexpr size_t kstep = (size_t)(BK * 2);
    constexpr size_t hstepB = (size_t)HALF * K * 2;
    const unsigned ldsw = (unsigned)wid * 1024u;
    const int aoff = lds_byte(wr * 64 + fr, fq * 8), boff = lds_byte(wc * 32 + fr, fq * 8);
#define PG8_SA(b, h) (((b) * 2 + (h)) * HTB)
#define PG8_SB(b, h) ((4 + (b) * 2 + (h)) * HTB)
#define PG8_STAGE(bufoff, gbase, voff) do { _Pragma("unroll") for (int _i = 0; _i < 2; ++_i) \
        __builtin_amdgcn_global_load_lds((const unsigned*)((const char*)(gbase) + (voff)[_i]), (LAS unsigned*)(lds + (bufoff) + ldsw + _i * 8192), 16, 0, 0); } while (0)
#define PG8_LDA(dst, b, h) do { _Pragma("unroll") for (int m = 0; m < 4; ++m) _Pragma("unroll") for (int k = 0; k < 2; ++k) dst[m][k] = *(const LAS bf16x8*)(lds + PG8_SA(b, h) + aoff + m * 2048 + k * 1024); } while (0)
#define PG8_LDB(dst, b, h) do { _Pragma("unroll") for (int n = 0; n < 2; ++n) _Pragma("unroll") for (int k = 0; k < 2; ++k) dst[n][k] = *(const LAS bf16x8*)(lds + PG8_SB(b, h) + boff + n * 2048 + k * 1024); } while (0)
#define PG8_MMA(ai, bj, At, Bt) do { __builtin_amdgcn_s_setprio(1); _Pragma("unroll") for (int m = 0; m < 4; ++m) _Pragma("unroll") for (int n = 0; n < 2; ++n) _Pragma("unroll") for (int k = 0; k < 2; ++k) \
        acc[ai][bj][m][n] = __builtin_amdgcn_mfma_f32_16x16x32_bf16(Bt[n][k], At[m][k], acc[ai][bj][m][n], 0, 0, 0); __builtin_amdgcn_s_setprio(0); } while (0)
#define PG8_WAIT_V(n) asm volatile("s_waitcnt vmcnt(" #n ")" ::: "memory")
#define PG8_WAIT_L(n) asm volatile("s_waitcnt lgkmcnt(" #n ")" ::: "memory")
#define PG8_BAR __builtin_amdgcn_s_barrier()
#define PG8_SCHED __builtin_amdgcn_sched_barrier(0)
    Unit cur, nxt; int ui = 0;
    if (!P.next(0, cur)) return;
    unsigned vAc[2][2], vAn[2][2];
    P.a_voff(cur, Rs, Cs, vAc);
    f32x4 acc[2][2][4][2];
#pragma unroll
    for (int a = 0; a < 2; ++a)
#pragma unroll
        for (int b = 0; b < 2; ++b)
#pragma unroll
            for (int m = 0; m < 4; ++m)
#pragma unroll
                for (int n = 0; n < 2; ++n) acc[a][b][m][n] = (f32x4){0.f, 0.f, 0.f, 0.f};
    bf16x8 At[4][2], B0[2][2], B1[2][2];
    const char* cA = P.a_base(cur); const char* cB = P.b_base(cur);
    PG8_STAGE(PG8_SB(0, 0), cB, voffB); PG8_STAGE(PG8_SB(0, 1), cB + hstepB, voffB); PG8_STAGE(PG8_SA(0, 0), cA, vAc[0]); PG8_STAGE(PG8_SA(0, 1), cA, vAc[1]);
    if (wr == 1) PG8_BAR;
    PG8_WAIT_V(2); PG8_BAR;
    PG8_STAGE(PG8_SB(1, 0), cB + kstep, voffB); PG8_STAGE(PG8_SA(1, 0), cA + kstep, vAc[0]); PG8_STAGE(PG8_SB(1, 1), cB + hstepB + kstep, voffB);
    PG8_WAIT_V(6); PG8_BAR;
    for (;;) {
        const bool has_next = P.next(ui + 1, nxt);
        const char* nA = has_next ? P.a_base(nxt) : cA; const char* nB = has_next ? P.b_base(nxt) : cB;
        if constexpr (Prob::GATHER) { if (has_next) P.a_voff(nxt, Rs, Cs, vAn);
          else { vAn[0][0] = vAc[0][0]; vAn[0][1] = vAc[0][1]; vAn[1][0] = vAc[1][0]; vAn[1][1] = vAc[1][1]; } }
        for (int t = 0; t < nt; t += 2) {
            const bool last = (t == nt - 2);
            const char* a1 = cA + (size_t)(t + 1) * kstep;
            const char* a2 = last ? nA : cA + (size_t)(t + 2) * kstep; const char* b2 = last ? nB : cB + (size_t)(t + 2) * kstep;
            const char* a3 = a2 + kstep; const char* b3 = b2 + kstep;
            unsigned va2[2][2];
            if constexpr (Prob::GATHER) { va2[0][0] = last ? vAn[0][0] : vAc[0][0]; va2[0][1] = last ? vAn[0][1] : vAc[0][1]; va2[1][0] = last ? vAn[1][0] : vAc[1][0]; va2[1][1] = last ? vAn[1][1] : vAc[1][1]; }
            else { va2[0][0] = vAc[0][0]; va2[0][1] = vAc[0][1]; va2[1][0] = vAc[1][0]; va2[1][1] = vAc[1][1]; }
            PG8_LDB(B0, 0, 0); PG8_LDB(B1, 0, 1); PG8_SCHED; PG8_LDA(At, 0, 0); PG8_STAGE(PG8_SA(1, 1), a1, vAc[1]);
            PG8_WAIT_V(8); PG8_WAIT_L(0); PG8_BAR; PG8_MMA(0, 0, At, B0); PG8_MMA(0, 1, At, B1); PG8_BAR; PG8_SCHED;
            PG8_LDA(At, 0, 1); PG8_STAGE(PG8_SB(0, 0), b2, voffB); PG8_STAGE(PG8_SB(0, 1), b2 + hstepB, voffB); PG8_STAGE(PG8_SA(0, 0), a2, va2[0]);
            PG8_WAIT_V(8); PG8_WAIT_L(0); PG8_BAR; PG8_MMA(1, 0, At, B0); PG8_MMA(1, 1, At, B1); PG8_BAR; PG8_SCHED;
            PG8_LDB(B0, 1, 0); PG8_LDB(B1, 1, 1); PG8_SCHED; PG8_LDA(At, 1, 0); PG8_STAGE(PG8_SA(0, 1), a2, va2[1]);
            PG8_WAIT_V(8); PG8_WAIT_L(0); PG8_BAR; PG8_MMA(0, 0, At, B0); PG8_MMA(0, 1, At, B1); PG8_BAR; PG8_SCHED;
            PG8_LDA(At, 1, 1); PG8_STAGE(PG8_SB(1, 0), b3, voffB); PG8_STAGE(PG8_SB(1, 1), b3 + hstepB, voffB); PG8_STAGE(PG8_SA(1, 0), a3, va2[0]);
            PG8_WAIT_V(8); PG8_WAIT_L(0); PG8_BAR; PG8_MMA(1, 0, At, B0); PG8_MMA(1, 1, At, B1); PG8_BAR; PG8_SCHED;
        }
        if constexpr (ALIGN_EPI) { if (wr == 0) PG8_BAR; }
        E(acc, cur, wr, wc, fr, fq);
        if (!has_next) break;
#pragma unroll
        for (int a = 0; a < 2; ++a)
#pragma unroll
            for (int b = 0; b < 2; ++b)
#pragma unroll
                for (int m = 0; m < 4; ++m)
#pragma unroll
                    for (int n = 0; n < 2; ++n) acc[a][b][m][n] = (f32x4){0.f, 0.f, 0.f, 0.f};
        cur = nxt; cA = nA; cB = nB; ++ui;
        if constexpr (Prob::GATHER) { vAc[0][0] = vAn[0][0]; vAc[0][1] = vAn[0][1]; vAc[1][0] = vAn[1][0]; vAc[1][1] = vAn[1][1]; }
        if constexpr (ALIGN_EPI) { if (wr == 1) PG8_BAR; }
    }
    PG8_WAIT_V(0);
    if constexpr (!ALIGN_EPI) { if (wr == 0) PG8_BAR; }
    PG8_BAR;
#undef PG8_SA
#undef PG8_SB
#undef PG8_STAGE
#undef PG8_LDA
#undef PG8_LDB
#undef PG8_MMA
#undef PG8_WAIT_V
#undef PG8_WAIT_L
#undef PG8_BAR
#undef PG8_SCHED
}
typedef int v8i_g __attribute__((ext_vector_type(8)));
__device__ __forceinline__ void glds_saddr(const void* sbase, unsigned voff, unsigned lds_dst) { unsigned keep;
    asm volatile("s_mov_b32 %0, m0\n\ts_mov_b32 m0, %3\n\ts_nop 0\n\tglobal_load_lds_dwordx4 %2, %1\n\ts_mov_b32 m0, %0" : "=&s"(keep) : "s"(sbase), "v"(voff), "s"(lds_dst) : "memory"); }
template <class Epi, class Prob, bool ALIGN_EPI>
__device__ __forceinline__ void gemm_phase8(LAS unsigned char* lds, const Prob& P, const Epi& E) {
    int tid = threadIdx.x; asm volatile("" : "+v"(tid));
    const int wid = __builtin_amdgcn_readfirstlane(tid >> 6), lane = tid & 63, wr = wid >> 2, wc = wid & 3, fr = lane & 15, fq = lane >> 4;
    constexpr int K = Prob::K, nt = K / 128;
    int Rs[2], Cs[2]; unsigned voffB[2];
#pragma unroll
    for (int i = 0; i < 2; ++i) { int R, C; stage_rc(tid * 16 + i * 8192, R, C); const int Rb = Epi::PERM ? ((R & ~31) + perm32(R & 31)) : R;
        Rs[i] = R; Cs[i] = C; voffB[i] = (unsigned)(Rb * K + C * 2); }
    constexpr size_t kstep = (size_t)128;
    constexpr size_t hstepB = (size_t)HALF * K, hstepA = (size_t)HALF * K;
    const unsigned ldsw = (unsigned)wid * 1024u; const unsigned lds0 = (unsigned)__builtin_amdgcn_readfirstlane((int)(uintptr_t)lds);
    const int aoff = lds_byte(wr * 64 + fr, fq * 16), boff = lds_byte(wc * 32 + fr, fq * 16);
#define PG8_SA(b, h) (((b) * 2 + (h)) * HTB)
#define PG8_SB(b, h) ((4 + (b) * 2 + (h)) * HTB)
#define PG8_STAGE(bufoff, gbase, voff) do { _Pragma("unroll") for (int _i = 0; _i < 2; ++_i) glds_saddr((const void*)(gbase), (voff)[_i], lds0 + (unsigned)((bufoff) + _i * 8192) + ldsw); } while (0)
#define PG8_LDA(dst, b, h) do { _Pragma("unroll") for (int m = 0; m < 4; ++m) dst[m] = *(const LAS v8i_g*)(lds + PG8_SA(b, h) + aoff + m * 2048); } while (0)
#define PG8_LDB(dst, b, h) do { _Pragma("unroll") for (int n = 0; n < 2; ++n) dst[n] = *(const LAS v8i_g*)(lds + PG8_SB(b, h) + boff + n * 2048); } while (0)
#define PG8_MMA(ai, bj, At, Bt) do { __builtin_amdgcn_s_setprio(1); _Pragma("unroll") for (int m = 0; m < 4; ++m) _Pragma("unroll") for (int n = 0; n < 2; ++n) \
        acc[ai][bj][m][n] = __builtin_amdgcn_mfma_scale_f32_16x16x128_f8f6f4(Bt[n], At[m], acc[ai][bj][m][n], 0, 0, 0, 0, 0, 0); __builtin_amdgcn_s_setprio(0); } while (0)
#define PG8_WAIT_V(n) asm volatile("s_waitcnt vmcnt(" #n ")" ::: "memory")
#define PG8_WAIT_L(n) asm volatile("s_waitcnt lgkmcnt(" #n ")" ::: "memory")
#define PG8_BAR __builtin_amdgcn_s_barrier()
#define PG8_SCHED __builtin_amdgcn_sched_barrier(0)
    Unit cur, nxt; int ui = 0;
    if (!P.next(0, cur)) return;
    unsigned vAc[2][2], vAn[2][2];
    P.a_voff(cur, Rs, Cs, vAc);
    f32x4 acc[2][2][4][2];
#pragma unroll
    for (int a = 0; a < 2; ++a)
#pragma unroll
        for (int b = 0; b < 2; ++b)
#pragma unroll
            for (int m = 0; m < 4; ++m)
#pragma unroll
                for (int n = 0; n < 2; ++n) acc[a][b][m][n] = (f32x4){0.f, 0.f, 0.f, 0.f};
    v8i_g At[4], B0[2], B1[2];
    const char* cA = P.a_base(cur); const char* cB = P.b_base(cur);
    PG8_STAGE(PG8_SB(0, 0), cB, voffB); PG8_STAGE(PG8_SB(0, 1), cB + hstepB, voffB); PG8_STAGE(PG8_SA(0, 0), cA, vAc[0]); PG8_STAGE(PG8_SA(0, 1), cA + hstepA, vAc[0]);
    if (wr == 1) PG8_BAR;
    PG8_WAIT_V(2); PG8_BAR;
    PG8_STAGE(PG8_SB(1, 0), cB + kstep, voffB); PG8_STAGE(PG8_SA(1, 0), cA + kstep, vAc[0]); PG8_STAGE(PG8_SB(1, 1), cB + hstepB + kstep, voffB);
    PG8_WAIT_V(6); PG8_BAR;
    for (;;) {
        const bool has_next = P.next(ui + 1, nxt);
        const char* nA = has_next ? P.a_base(nxt) : cA; const char* nB = has_next ? P.b_base(nxt) : cB;
        if constexpr (Prob::GATHER) { if (has_next) P.a_voff(nxt, Rs, Cs, vAn);
          else { vAn[0][0] = vAc[0][0]; vAn[0][1] = vAc[0][1]; vAn[1][0] = vAc[1][0]; vAn[1][1] = vAc[1][1]; } }
#pragma nounroll
        for (int t = 0; t < nt; t += 2) {
            const bool last = (t == nt - 2);
            const char* a1 = cA + (size_t)(t + 1) * kstep;
            const char* a2 = last ? nA : cA + (size_t)(t + 2) * kstep; const char* b2 = last ? nB : cB + (size_t)(t + 2) * kstep;
            const char* a3 = a2 + kstep; const char* b3 = b2 + kstep;
            unsigned va2[2][2];
            if constexpr (Prob::GATHER) { va2[0][0] = last ? vAn[0][0] : vAc[0][0]; va2[0][1] = last ? vAn[0][1] : vAc[0][1]; va2[1][0] = last ? vAn[1][0] : vAc[1][0]; va2[1][1] = last ? vAn[1][1] : vAc[1][1]; }
            else { va2[0][0] = vAc[0][0]; va2[0][1] = vAc[0][1]; va2[1][0] = vAc[1][0]; va2[1][1] = vAc[1][1]; }
            PG8_LDB(B0, 0, 0); PG8_LDB(B1, 0, 1); PG8_SCHED; PG8_LDA(At, 0, 0); PG8_STAGE(PG8_SA(1, 1), a1 + hstepA, vAc[0]);
            PG8_WAIT_V(8); PG8_WAIT_L(0); PG8_BAR; PG8_MMA(0, 0, At, B0); PG8_MMA(0, 1, At, B1); PG8_BAR; PG8_SCHED;
            PG8_LDA(At, 0, 1); PG8_STAGE(PG8_SB(0, 0), b2, voffB); PG8_STAGE(PG8_SB(0, 1), b2 + hstepB, voffB); PG8_STAGE(PG8_SA(0, 0), a2, va2[0]);
            PG8_WAIT_V(8); PG8_WAIT_L(0); PG8_BAR; PG8_MMA(1, 0, At, B0); PG8_MMA(1, 1, At, B1); PG8_BAR; PG8_SCHED;
            PG8_LDB(B0, 1, 0); PG8_LDB(B1, 1, 1); PG8_SCHED; PG8_LDA(At, 1, 0); PG8_STAGE(PG8_SA(0, 1), a2 + hstepA, va2[0]);
            PG8_WAIT_V(8); PG8_WAIT_L(0); PG8_BAR; PG8_MMA(0, 0, At, B0); PG8_MMA(0, 1, At, B1); PG8_BAR; PG8_SCHED;
            PG8_LDA(At, 1, 1); PG8_STAGE(PG8_SB(1, 0), b3, voffB); PG8_STAGE(PG8_SB(1, 1), b3 + hstepB, voffB); PG8_STAGE(PG8_SA(1, 0), a3, va2[0]);
            PG8_WAIT_V(8); PG8_WAIT_L(0); PG8_BAR; PG8_MMA(1, 0, At, B0); PG8_MMA(1, 1, At, B1); PG8_BAR; PG8_SCHED;
        }
        if constexpr (ALIGN_EPI) { if (wr == 0) PG8_BAR; }
        E(acc, cur, wr, wc, fr, fq);
        if (!has_next) break;
#pragma unroll
        for (int a = 0; a < 2; ++a)
#pragma unroll
            for (int b = 0; b < 2; ++b)
#pragma unroll
                for (int m = 0; m < 4; ++m)
#pragma unroll
                    for (int n = 0; n < 2; ++n) acc[a][b][m][n] = (f32x4){0.f, 0.f, 0.f, 0.f};
        cur = nxt; cA = nA; cB = nB; ++ui;
        if constexpr (Prob::GATHER) { vAc[0][0] = vAn[0][0]; vAc[0][1] = vAn[0][1]; vAc[1][0] = vAn[1][0]; vAc[1][1] = vAn[1][1]; }
        if constexpr (ALIGN_EPI) { if (wr == 1) PG8_BAR; }
    }
    PG8_WAIT_V(0);
    if constexpr (!ALIGN_EPI) { if (wr == 0) PG8_BAR; }
    PG8_BAR;
#undef PG8_SA
#undef PG8_SB
#undef PG8_STAGE
#undef PG8_LDA
#undef PG8_LDB
#undef PG8_MMA
#undef PG8_WAIT_V
#undef PG8_WAIT_L
#undef PG8_BAR
#undef PG8_SCHED
}

template <int K_> struct DenseProb {
    static constexpr int K = K_; static constexpr bool GATHER = false;
    const bf16_t* A; const bf16_t* Bt; StaticOrder S;
    __device__ __forceinline__ bool next(int i, Unit& u) const { return S.next(i, u); }
    __device__ __forceinline__ const char* a_base(const Unit& u) const { return (const char*)(A + (size_t)u.pm * BM * K); }
    __device__ __forceinline__ const char* b_base(const Unit& u) const { return (const char*)(Bt + (size_t)u.pn * BM * K); }
    __device__ __forceinline__ void a_voff(const Unit&, const int (&Rs)[2], const int (&Cs)[2], unsigned (&vo)[2][2]) const {
#pragma unroll
        for (int h = 0; h < 2; ++h)
#pragma unroll
            for (int i = 0; i < 2; ++i) vo[h][i] = (unsigned)((h * HALF + Rs[i]) * K + Cs[i]) * 2u;
    }
};
template <int K_, int PMAP, int EB> struct MapProb {
    static constexpr int K = K_; static constexpr bool GATHER = false;
    const unsigned char* A; const unsigned char* Bt; StaticOrder S;
    __device__ __forceinline__ bool next(int i, Unit& u) const { const bool ok = S.next(i, u); if (PMAP == 1) u.pn = u.pn < 6 ? u.pn : u.pn + 6; if (PMAP == 2) u.pn += 6; return ok; }
    __device__ __forceinline__ const char* a_base(const Unit& u) const { return (const char*)(A + (size_t)u.pm * BM * K * EB); }
    __device__ __forceinline__ const char* b_base(const Unit& u) const { return (const char*)(Bt + (size_t)u.pn * BM * K * EB); }
    __device__ __forceinline__ void a_voff(const Unit&, const int (&Rs)[2], const int (&Cs)[2], unsigned (&vo)[2][2]) const {
#pragma unroll
        for (int h = 0; h < 2; ++h)
#pragma unroll
            for (int i = 0; i < 2; ++i) vo[h][i] = (unsigned)((h * HALF + Rs[i]) * K * EB + Cs[i] * 2);
    }
};
__device__ __forceinline__ bool moe_unit(int i, int G, int vcu, Unit& u, int& e, int& b) {
    const int L = i * G + vcu; if (L >= 2048) return false;
    const int x = (L & 255) >> 5, w = L & 31, r = L >> 8;
    e = 2 * x + (r >> 2); b = r & 3; u.pm = (b * NEXP + e) * 4 + (w >> 3); u.pn = w & 7; u.ord = i; return true;
}
struct GuProb {
    static constexpr int K = DM; static constexpr bool GATHER = true;
    const bf16_t* H2; const bf16_t* W; const LAS unsigned* rowoff; int G, vcu;
    __device__ __forceinline__ bool next(int i, Unit& u) const { int e, b; return moe_unit(i, G, vcu, u, e, b); }
    __device__ __forceinline__ const char* a_base(const Unit& u) const { const int b = (u.pm >> 2) / NEXP; return (const char*)(H2 + (size_t)b * SEQ * DM); }
    __device__ __forceinline__ const char* b_base(const Unit& u) const { const int e = (u.pm >> 2) % NEXP; return (const char*)(W + ((size_t)e * 2048 + (size_t)u.pn * BM) * DM); }
    __device__ __forceinline__ void a_voff(const Unit& u, const int (&Rs)[2], const int (&Cs)[2], unsigned (&vo)[2][2]) const {
#pragma unroll
        for (int h = 0; h < 2; ++h)
#pragma unroll
            for (int i = 0; i < 2; ++i) vo[h][i] = rowoff[u.ord * 256 + h * HALF + Rs[i]] + (unsigned)Cs[i] * 2u;
    }
};
struct DownProb {
    static constexpr int K = DFF; static constexpr bool GATHER = false;
    const bf16_t* HID; const bf16_t* W; int G, vcu;
    __device__ __forceinline__ bool next(int i, Unit& u) const { int e, b; return moe_unit(i, G, vcu, u, e, b); }
    __device__ __forceinline__ const char* a_base(const Unit& u) const { return (const char*)(HID + (size_t)u.pm * BM * DFF); }
    __device__ __forceinline__ const char* b_base(const Unit& u) const { const int e = (u.pm >> 2) % NEXP; return (const char*)(W + ((size_t)e * 2048 + (size_t)u.pn * BM) * DFF); }
    __device__ __forceinline__ void a_voff(const Unit&, const int (&Rs)[2], const int (&Cs)[2], unsigned (&vo)[2][2]) const {
#pragma unroll
        for (int h = 0; h < 2; ++h)
#pragma unroll
            for (int i = 0; i < 2; ++i) vo[h][i] = (unsigned)((h * HALF + Rs[i]) * DFF + Cs[i]) * 2u;
    }
};

typedef const f32x4 (&AccRef)[2][2][4][2];
struct EpiInProj {
    static constexpr bool PERM = true;
    bf16_t *QA, *KA, *VA, *QB, *KB, *VB, *GA, *GB; const float* bgate; float oscale;
    __device__ __forceinline__ void operator()(AccRef acc, const Unit& u, int wr, int wc, int fr, int fq) const {
        const int pn = u.pn; bf16_t* base; int ldc, colt; bool gate = false;
        if (pn < 4) { base = QA; ldc = QW; colt = pn * 256; }
        else if (pn == 4) { base = KA; ldc = KVW; colt = 0; }
        else if (pn == 5) { base = VA; ldc = KVW; colt = 0; }
        else if (pn < 10) { base = QB; ldc = QW; colt = (pn - 6) * 256; }
        else if (pn == 10) { base = KB; ldc = KVW; colt = 0; }
        else if (pn == 11) { base = VB; ldc = KVW; colt = 0; }
        else if (pn < 20) { base = GA; ldc = DM; colt = (pn - 12) * 256; gate = true; }
        else { base = GB; ldc = DM; colt = (pn - 20) * 256; gate = true; }
        const int row0 = u.pm * BM + wr * 64 + fr, col0 = colt + wc * 32 + 8 * fq;
        f32x4 bv[2][2];
#pragma unroll
        for (int bj = 0; bj < 2; ++bj)
#pragma unroll
            for (int n = 0; n < 2; ++n) bv[bj][n] = gate ? *(const f32x4*)(bgate + (pn - 12) * 256 + wc * 32 + 8 * fq + bj * HALF + 4 * n) : (f32x4){0.f, 0.f, 0.f, 0.f};
#pragma unroll
        for (int ai = 0; ai < 2; ++ai)
#pragma unroll
            for (int m = 0; m < 4; ++m) { bf16_t* rowp = base + (size_t)(row0 + ai * HALF + m * 16) * ldc + col0;
#pragma unroll
                for (int bj = 0; bj < 2; ++bj) { f32x4 v0 = acc[ai][bj][m][0] * oscale + bv[bj][0], v1 = acc[ai][bj][m][1] * oscale + bv[bj][1];
                    if (gate) {
#pragma unroll
                        for (int j = 0; j < 4; ++j) { v0[j] = sigmoidf_fast(v0[j]); v1[j] = sigmoidf_fast(v1[j]); } }
                    u32x4 w; w.x = cvt_pk_bf16(v0[0], v0[1]); w.y = cvt_pk_bf16(v0[2], v0[3]); w.z = cvt_pk_bf16(v1[0], v1[1]); w.w = cvt_pk_bf16(v1[2], v1[3]);
                    *(u32x4*)(rowp + bj * HALF) = w; } }
    }
};
template <int MODE> struct EpiGated {
    static constexpr bool PERM = true;
    bf16_t* G1; const bf16_t* G2; float oscale;
    __device__ __forceinline__ void operator()(AccRef acc, const Unit& u, int wr, int wc, int fr, int fq) const {
        const int row0 = u.pm * BM + wr * 64 + fr, col0 = u.pn * BM + wc * 32 + 8 * fq;
#pragma unroll
        for (int ai = 0; ai < 2; ++ai)
#pragma unroll
            for (int m = 0; m < 4; ++m) { const size_t off = (size_t)(row0 + ai * HALF + m * 16) * DM + col0;
#pragma unroll
                for (int bj = 0; bj < 2; ++bj) {
                    const bf16x8 g1 = (MODE == 2) ? (bf16x8){0, 0, 0, 0, 0, 0, 0, 0} : *(const bf16x8*)(G1 + off + bj * HALF);
                    bf16x8 g2 = g1; if (MODE >= 1) g2 = *(const bf16x8*)(G2 + off + bj * HALF);
                    float o[8];
#pragma unroll
                    for (int j = 0; j < 8; ++j) { const float a = acc[ai][bj][m][j >> 2][j & 3] * oscale;
                        if (MODE == 0) o[j] = bf2f((unsigned short)g1[j]) * a;
                        else if (MODE == 1) o[j] = bf2f((unsigned short)g1[j]) + bf2f((unsigned short)g2[j]) * a;
                        else o[j] = bf2f((unsigned short)g2[j]) * a; }
                    u32x4 w; w.x = cvt_pk_bf16(o[0], o[1]); w.y = cvt_pk_bf16(o[2], o[3]); w.z = cvt_pk_bf16(o[4], o[5]); w.w = cvt_pk_bf16(o[6], o[7]);
                    *(u32x4*)(G1 + off + bj * HALF) = w; } }
    }
};
template <int MODE> struct EpiGated8 {
    static constexpr bool PERM = true;
    bf16_t* G1; const bf16_t* G2; unsigned char* M8; float oscale;
    __device__ __forceinline__ void operator()(AccRef acc, const Unit& u, int wr, int wc, int fr, int fq) const {
        const int row0 = u.pm * BM + wr * 64 + fr, col0 = u.pn * BM + wc * 32 + 8 * fq;
#pragma unroll
        for (int ai = 0; ai < 2; ++ai)
#pragma unroll
            for (int m = 0; m < 4; ++m) { const unsigned off = (unsigned)((row0 + ai * HALF + m * 16) * DM + col0);
#pragma unroll
                for (int bj = 0; bj < 2; ++bj) {
                    const bf16x8 g1 = *(const bf16x8*)(G1 + off + bj * HALF);
                    bf16x8 g2 = g1; if (MODE == 1) g2 = *(const bf16x8*)(G2 + off + bj * HALF);
                    float o[8];
#pragma unroll
                    for (int j = 0; j < 8; ++j) { const float a = acc[ai][bj][m][j >> 2][j & 3] * oscale;
                        if (MODE == 0) o[j] = bf2f((unsigned short)g1[j]) * a; else o[j] = (bf2f((unsigned short)g1[j]) + bf2f((unsigned short)g2[j]) * a) * M8S; }
                    if (MODE == 0) { u32x4 w; w.x = cvt_pk_bf16(o[0], o[1]); w.y = cvt_pk_bf16(o[2], o[3]); w.z = cvt_pk_bf16(o[4], o[5]); w.w = cvt_pk_bf16(o[6], o[7]); *(u32x4*)(G1 + off + bj * HALF) = w; }
                    else { int w0 = 0, w1 = 0; w0 = __builtin_amdgcn_cvt_pk_fp8_f32(o[0], o[1], w0, false); w0 = __builtin_amdgcn_cvt_pk_fp8_f32(o[2], o[3], w0, true);
                        w1 = __builtin_amdgcn_cvt_pk_fp8_f32(o[4], o[5], w1, false); w1 = __builtin_amdgcn_cvt_pk_fp8_f32(o[6], o[7], w1, true);
                        *(u32x2*)(M8 + off + bj * HALF) = (u32x2){(unsigned)w0, (unsigned)w1}; } }
                asm volatile("" ::: "memory"); }
    }
};
struct EpiAtt {
    static constexpr bool PERM = true;
    bf16_t* O; float oscale;
    __device__ __forceinline__ void operator()(AccRef acc, const Unit& u, int wr, int wc, int fr, int fq) const {
        const int row0 = u.pm * BM + wr * 64 + fr, col0 = u.pn * BM + wc * 32 + 8 * fq;
#pragma unroll
        for (int ai = 0; ai < 2; ++ai)
#pragma unroll
            for (int m = 0; m < 4; ++m) { bf16_t* rowp = O + (size_t)(row0 + ai * HALF + m * 16) * DM + col0;
#pragma unroll
                for (int bj = 0; bj < 2; ++bj) { const f32x4 v0 = acc[ai][bj][m][0] * oscale, v1 = acc[ai][bj][m][1] * oscale;
                    u32x4 w; w.x = cvt_pk_bf16(v0[0], v0[1]); w.y = cvt_pk_bf16(v0[2], v0[3]); w.z = cvt_pk_bf16(v1[0], v1[1]); w.w = cvt_pk_bf16(v1[2], v1[3]);
                    *(u32x4*)(rowp + bj * HALF) = w; } }
    }
};
struct EpiSwiglu {
    static constexpr bool PERM = true;
    bf16_t* HID;
    __device__ __forceinline__ void operator()(AccRef acc, const Unit& u, int wr, int wc, int fr, int fq) const {
        const int row0 = u.pm * BM + wr * 64 + fr, col0 = u.pn * HALF + wc * 32 + 8 * fq;
#pragma unroll
        for (int ai = 0; ai < 2; ++ai)
#pragma unroll
            for (int m = 0; m < 4; ++m) { float o[8];
#pragma unroll
                for (int j = 0; j < 8; ++j) { const float a = acc[ai][0][m][j >> 2][j & 3], up = acc[ai][1][m][j >> 2][j & 3]; o[j] = a * sigmoidf_fast(a) * up; }
                u32x4 w; w.x = cvt_pk_bf16(o[0], o[1]); w.y = cvt_pk_bf16(o[2], o[3]); w.z = cvt_pk_bf16(o[4], o[5]); w.w = cvt_pk_bf16(o[6], o[7]);
                *(u32x4*)(HID + (size_t)(row0 + ai * HALF + m * 16) * DFF + col0) = w; }
    }
};
struct EpiDown {
    static constexpr bool PERM = true;
    bf16_t* Y; const float* gatev;
    __device__ __forceinline__ void operator()(AccRef acc, const Unit& u, int wr, int wc, int fr, int fq) const {
        const int row0 = u.pm * BM + wr * 64 + fr, col0 = u.pn * BM + wc * 32 + 8 * fq;
#pragma unroll
        for (int ai = 0; ai < 2; ++ai)
#pragma unroll
            for (int m = 0; m < 4; ++m) { const int row = row0 + ai * HALF + m * 16; const float g = gatev[row];
#pragma unroll
                for (int bj = 0; bj < 2; ++bj) { const f32x4 v0 = acc[ai][bj][m][0] * g, v1 = acc[ai][bj][m][1] * g;
                    u32x4 w; w.x = cvt_pk_bf16(v0[0], v0[1]); w.y = cvt_pk_bf16(v0[2], v0[3]); w.z = cvt_pk_bf16(v1[0], v1[1]); w.w = cvt_pk_bf16(v1[2], v1[3]);
                    *(u32x4*)(Y + (size_t)row * DM + col0 + bj * HALF) = w; } }
    }
};
}

namespace att {
constexpr int D = 128, NW = 8, QBLK = 32, KVBLK = 64;
constexpr float SCALE = 0.088388347648318440f, C = SCALE * LOG2E;
constexpr float THR = 8.f;
constexpr int LDQ = QW, LDK = KVW;
constexpr int SHM_V = KVBLK * D * 2, SHM_K = KVBLK * D * 2;
constexpr int BUFB = SHM_V + SHM_K, NBUF = 4;
constexpr int OFF_WS = NBUF * BUFB, OFF_TAB = OFF_WS + NW * 64 * 4, LDS_END = OFF_TAB + 4 * 768 * 4, OFF_OST = 0;
static_assert(LDS_END <= LDS_SCRATCH, "attention LDS");
#define KSWZ(row, colB) ((row) * 256 + ((colB) ^ (((row) & 7) << 4)))
#define SBAR() __builtin_amdgcn_sched_barrier(0)
__device__ __forceinline__ int crow(int r, int hi) { return (r & 3) + 8 * (r >> 2) + 4 * hi; }
__device__ __forceinline__ unsigned cvtpk(float lo, float hi) { unsigned r; asm volatile("v_cvt_pk_bf16_f32 %0, %1, %2" : "=v"(r) : "v"(lo), "v"(hi)); return r; }

__device__ __forceinline__ void partialSM(f32x16& p0, f32x16& p1, float& m_reg, float& mn, float& alpha) {
  float pmax = p0[0];
#pragma unroll
  for (int r = 1; r < 16; ++r) pmax = fmaxf(pmax, p0[r]);
#pragma unroll
  for (int r = 0; r < 16; ++r) pmax = fmaxf(pmax, p1[r]);
  { auto rr = __builtin_amdgcn_permlane32_swap(__float_as_uint(pmax), __float_as_uint(pmax), false, false);
    pmax = fmaxf(__uint_as_float(rr[0]), __uint_as_float(rr[1])); }
  if (__builtin_expect(__all(pmax - m_reg <= THR / SCALE), 1)) { mn = m_reg; alpha = 1.f; }
  else { mn = fmaxf(m_reg, pmax); alpha = __builtin_amdgcn_exp2f((m_reg - mn) * C); m_reg = mn; }
  float mnC = -mn * C;
#pragma unroll
  for (int r = 0; r < 16; ++r) p0[r] = fmaf(p0[r], C, mnC);
#pragma unroll
  for (int r = 0; r < 16; ++r) p1[r] = fmaf(p1[r], C, mnC);
#pragma unroll
  for (int r = 0; r < 16; ++r) p0[r] = __builtin_amdgcn_exp2f(p0[r]);
}
__device__ __forceinline__ void partialSM_B(f32x16& p0, f32x16& p1, float& m_reg, float& mn, float& alpha, const float* tb) {
#pragma unroll
  for (int r = 0; r < 16; ++r) { const int o = (r & 3) + 8 * (r >> 2); p0[r] = fmaf(p0[r], C, tb[o]); p1[r] = fmaf(p1[r], C, tb[32 + o]); }
  float pmax = p0[0];
#pragma unroll
  for (int r = 1; r < 16; ++r) pmax = fmaxf(pmax, p0[r]);
#pragma unroll
  for (int r = 0; r < 16; ++r) pmax = fmaxf(pmax, p1[r]);
  { auto rr = __builtin_amdgcn_permlane32_swap(__float_as_uint(pmax), __float_as_uint(pmax), false, false);
    pmax = fmaxf(__uint_as_float(rr[0]), __uint_as_float(rr[1])); }
  if (__builtin_expect(__all(pmax - m_reg <= THR * LOG2E), 1)) { mn = m_reg; alpha = 1.f; }
  else { mn = fmaxf(m_reg, pmax); alpha = __builtin_amdgcn_exp2f(m_reg - mn); m_reg = mn; }
#pragma unroll
  for (int r = 0; r < 16; ++r) p0[r] = p0[r] - mn;
#pragma unroll
  for (int r = 0; r < 16; ++r) p1[r] = p1[r] - mn;
#pragma unroll
  for (int r = 0; r < 16; ++r) p0[r] = __builtin_amdgcn_exp2f(p0[r]);
}
__device__ __forceinline__ void finishSM(f32x16& p0, f32x16& p1, float alpha, float& l_reg, bf16x8& pa0, bf16x8& pa1, bf16x8& pa2, bf16x8& pa3) {
#pragma unroll
  for (int r = 0; r < 16; ++r) p1[r] = __builtin_amdgcn_exp2f(p1[r]);
  float ps = 0;
#pragma unroll
  for (int r = 0; r < 16; ++r) ps += p0[r];
#pragma unroll
  for (int r = 0; r < 16; ++r) ps += p1[r];
  { auto rr = __builtin_amdgcn_permlane32_swap(__float_as_uint(ps), __float_as_uint(ps), false, false);
    ps = __uint_as_float(rr[0]) + __uint_as_float(rr[1]); }
  l_reg = l_reg * alpha + ps;
#define PK4(P, BASE, OUT) do { unsigned a0 = cvtpk(P[BASE + 0], P[BASE + 1]), a1 = cvtpk(P[BASE + 2], P[BASE + 3]);   \
    unsigned b0 = cvtpk(P[BASE + 4], P[BASE + 5]), b1 = cvtpk(P[BASE + 6], P[BASE + 7]);                              \
    auto r0 = __builtin_amdgcn_permlane32_swap(a0, b0, false, false); auto r1 = __builtin_amdgcn_permlane32_swap(a1, b1, false, false); \
    u32x4 w = {r0[0], r1[0], r0[1], r1[1]}; OUT = *reinterpret_cast<bf16x8*>(&w); } while (0)
  PK4(p0, 0, pa0); PK4(p0, 8, pa1); PK4(p1, 0, pa2); PK4(p1, 8, pa3);
#undef PK4
}
__device__ __forceinline__ void qkt(f32x16& p0, f32x16& p1, const bf16_t* Ks, const bf16x8* qr, int r32, int hi, float init = 0.f) {
#pragma unroll
  for (int r = 0; r < 16; ++r) { p0[r] = init; p1[r] = init; }
#pragma unroll
  for (int d0 = 0; d0 < 8; ++d0) { int cb = (d0 * 16 + hi * 8) * 2;
    bf16x8 b0 = *reinterpret_cast<const bf16x8*>((const char*)Ks + KSWZ(r32, cb));
    bf16x8 b1 = *reinterpret_cast<const bf16x8*>((const char*)Ks + KSWZ(32 + r32, cb));
    p0 = __builtin_amdgcn_mfma_f32_32x32x16_bf16(b0, qr[d0], p0, 0, 0, 0);
    p1 = __builtin_amdgcn_mfma_f32_32x32x16_bf16(b1, qr[d0], p1, 0, 0, 0); }
}
__device__ __forceinline__ int v_st(int k, int c) { const int kk = (k & ~0xC) | ((k & 4) << 1) | ((k & 8) >> 1); return ((kk >> 3) * 4 + (c >> 5)) * 512 + ((kk & 7) * 32 + (c & 31)) * 2; }
__device__ __forceinline__ int v_rd_base(int lane) { return ((lane & 3) << 3) | (((lane >> 2) & 3) << 6) | (((lane >> 4) & 1) << 5) | (((lane >> 5) & 1) << 8); }
constexpr int v_rd_off(int d0, int ks, int half) { return d0 * 512 + ks * 4096 + half * 2048; }
template <int OFF> __device__ __forceinline__ s16x4 tr_read(int vb) {
  s16x4 r; asm volatile("ds_read_b64_tr_b16 %0, %1 offset:%2" : "=&v"(r) : "v"(vb), "i"(OFF) : "memory"); return r;
}
template <int D0> __device__ __forceinline__ void pv_one(f32x16& od, int vb, bf16x8 pa0, bf16x8 pa1, bf16x8 pa2, bf16x8 pa3) {
  const s16x4 l0 = tr_read<v_rd_off(D0, 0, 0)>(vb), h0 = tr_read<v_rd_off(D0, 0, 1)>(vb), l1 = tr_read<v_rd_off(D0, 1, 0)>(vb), h1 = tr_read<v_rd_off(D0, 1, 1)>(vb);
  const s16x4 l2 = tr_read<v_rd_off(D0, 2, 0)>(vb), h2 = tr_read<v_rd_off(D0, 2, 1)>(vb), l3 = tr_read<v_rd_off(D0, 3, 0)>(vb), h3 = tr_read<v_rd_off(D0, 3, 1)>(vb);
  asm volatile("s_waitcnt lgkmcnt(0)" ::: "memory"); SBAR();
#define PK(L, H) (bf16x8){L[0], L[1], L[2], L[3], H[0], H[1], H[2], H[3]}
  od = __builtin_amdgcn_mfma_f32_32x32x16_bf16(pa0, PK(l0, h0), od, 0, 0, 0);
  od = __builtin_amdgcn_mfma_f32_32x32x16_bf16(pa1, PK(l1, h1), od, 0, 0, 0);
  od = __builtin_amdgcn_mfma_f32_32x32x16_bf16(pa2, PK(l2, h2), od, 0, 0, 0);
  od = __builtin_amdgcn_mfma_f32_32x32x16_bf16(pa3, PK(l3, h3), od, 0, 0, 0);
#undef PK
}
__device__ __forceinline__ void pv_d0(f32x16* o, int vb, bf16x8 pa0, bf16x8 pa1, bf16x8 pa2, bf16x8 pa3) {
  pv_one<0>(o[0], vb, pa0, pa1, pa2, pa3); pv_one<1>(o[1], vb, pa0, pa1, pa2, pa3); pv_one<2>(o[2], vb, pa0, pa1, pa2, pa3); pv_one<3>(o[3], vb, pa0, pa1, pa2, pa3);
}
template <int MODE>
__device__ __forceinline__ void pv_psm(f32x16* o, int vb, bf16x8 pa0, bf16x8 pa1, bf16x8 pa2, bf16x8 pa3, f32x16& p0, f32x16& p1, float& m_reg, float& mn, float& alpha, const float* tb) {
  pv_one<0>(o[0], vb, pa0, pa1, pa2, pa3);
  if constexpr (MODE == 1) {
#pragma unroll
    for (int r = 0; r < 16; ++r) { const int of = (r & 3) + 8 * (r >> 2); p0[r] = fmaf(p0[r], C, tb[of]); p1[r] = fmaf(p1[r], C, tb[32 + of]); }
  }
  float pmax = p0[0];
#pragma unroll
  for (int r = 1; r < 16; ++r) pmax = fmaxf(pmax, p0[r]);
#pragma unroll
  for (int r = 0; r < 16; ++r) pmax = fmaxf(pmax, p1[r]);
  { auto rr = __builtin_amdgcn_permlane32_swap(__float_as_uint(pmax), __float_as_uint(pmax), false, false);
    pmax = fmaxf(__uint_as_float(rr[0]), __uint_as_float(rr[1])); }
  SBAR();
  pv_one<1>(o[1], vb, pa0, pa1, pa2, pa3);
  float sub;
  if constexpr (MODE == 0) {
    if (__builtin_expect(__all(pmax - m_reg <= THR / SCALE), 1)) { mn = m_reg; alpha = 1.f; }
    else { mn = fmaxf(m_reg, pmax); alpha = __builtin_amdgcn_exp2f((m_reg - mn) * C); m_reg = mn; }
    sub = -mn * C;
#pragma unroll
    for (int r = 0; r < 16; ++r) p0[r] = fmaf(p0[r], C, sub);
  } else {
    if (__builtin_expect(__all(pmax - m_reg <= THR * LOG2E), 1)) { mn = m_reg; alpha = 1.f; }
    else { mn = fmaxf(m_reg, pmax); alpha = __builtin_amdgcn_exp2f(m_reg - mn); m_reg = mn; }
    sub = -mn;
#pragma unroll
    for (int r = 0; r < 16; ++r) p0[r] = p0[r] + sub;
  }
  SBAR();
  pv_one<2>(o[2], vb, pa0, pa1, pa2, pa3);
#pragma unroll
  for (int r = 0; r < 16; ++r) { if constexpr (MODE == 0) p1[r] = fmaf(p1[r], C, sub); else p1[r] = p1[r] + sub; }
#pragma unroll
  for (int r = 0; r < 6; ++r) p0[r] = __builtin_amdgcn_exp2f(p0[r]);
  SBAR();
  pv_one<3>(o[3], vb, pa0, pa1, pa2, pa3);
#pragma unroll
  for (int r = 6; r < 16; ++r) p0[r] = __builtin_amdgcn_exp2f(p0[r]);
}
__device__ __forceinline__ f32x8 bf8_to_f32(bf16x8 v) { f32x8 r;
#pragma unroll
  for (int j = 0; j < 8; ++j) r[j] = bf2f((unsigned short)v[j]);
  return r; }
__device__ __forceinline__ bf16x8 f32_to_bf8(f32x8 x) { u32x4 w = {cvtpk(x[0], x[1]), cvtpk(x[2], x[3]), cvtpk(x[4], x[5]), cvtpk(x[6], x[7])}; return *reinterpret_cast<bf16x8*>(&w); }
__device__ __forceinline__ int t5_bucket(int rel) {
  const int n = rel < 0 ? -rel : rel; int bk;
  if (n < 8) bk = n; else if (n < 12) bk = 8; else if (n < 16) bk = 9; else if (n < 23) bk = 10; else if (n < 32) bk = 11; else if (n < 46) bk = 12; else if (n < 64) bk = 13; else if (n < 91) bk = 14; else bk = 15;
  return bk + (rel > 0 ? 16 : 0);
}
struct Aux { const float* cosT; const float* sinT; const float* qn; const float* kn; const float* relb; const float* sink; };

template <int MODE>
__device__ __forceinline__ void attn_unit(const bf16_t* Qb, const bf16_t* __restrict__ Kh, const bf16_t* __restrict__ Vh, bf16_t* Ob, int kbeg, int kend, int q0, int head, char* lds, const Aux& aux) {
  int tid = threadIdx.x; asm volatile("" : "+v"(tid));
  const int wid = tid >> 6, lane = tid & 63, r32 = lane & 31, hi = lane >> 5;
  char* V_lds = lds; char* K_lds = lds + SHM_V;
  float* ws = (float*)(lds + OFF_WS) + wid * 64; float* li_l = ws; float* al_l = ws + 32;
  float* tab = (float*)(lds + OFF_TAB);
  float m_reg = -1e30f, l_reg = 0; f32x16 o[4] = {}; bf16x8 qr[8];
  const bf16_t* Qw = Qb + (long)(wid * QBLK + r32) * LDQ + hi * 8;
#pragma unroll
  for (int d0 = 0; d0 < 8; ++d0) qr[d0] = *reinterpret_cast<const bf16x8*>(Qw + d0 * 16);
  if constexpr (MODE == 1) {
    for (int i = tid; i < 768; i += 512) { const int rel = i - 383, n = rel < 0 ? -rel : rel; float v = -1e30f; if (n <= 128) v = aux.relb[t5_bucket(rel) * NHB + head] * LOG2E; tab[i] = v; }
    m_reg = aux.sink[head] * LOG2E; l_reg = 1.0f;
  }
  const int tbase = kbeg - q0 - wid * QBLK - r32 + 383 + 4 * hi;
  const int sr = tid >> 4, sc = (tid & 15) * 8, vst0 = v_st(sr, sc), vst1 = v_st(32 + sr, sc);
  const int vb0 = (int)(uintptr_t)V_lds + v_rd_base(lane);
  struct { bf16x8 vs0, vs1, ks0, ks1; } sr_[2];
#define SLOAD(i, k0) do { sr_[i].vs0 = *reinterpret_cast<const bf16x8*>(&Vh[(long)(kbeg + (k0) + sr) * LDK + sc]); sr_[i].vs1 = *reinterpret_cast<const bf16x8*>(&Vh[(long)(kbeg + (k0) + 32 + sr) * LDK + sc]); \
    sr_[i].ks0 = *reinterpret_cast<const bf16x8*>(&Kh[(long)(kbeg + (k0) + sr) * LDK + sc]); sr_[i].ks1 = *reinterpret_cast<const bf16x8*>(&Kh[(long)(kbeg + (k0) + 32 + sr) * LDK + sc]); } while (0)
#define SWRITE(bo, i) do { *(bf16x8*)(V_lds + (bo) + vst0) = sr_[i].vs0;          \
    *(bf16x8*)(V_lds + (bo) + vst1) = sr_[i].vs1; int kc = sc * 2;               \
    *(bf16x8*)(K_lds + (bo) + KSWZ(sr, kc)) = sr_[i].ks0;                       \
    *(bf16x8*)(K_lds + (bo) + KSWZ(32 + sr, kc)) = sr_[i].ks1; } while (0)
#define SWAIT() asm volatile("s_waitcnt vmcnt(4)" ::: "memory")
#define RESC(a) do { if (__any((a) < 1.f)) { if (hi == 0) al_l[r32] = (a); asm volatile("s_waitcnt lgkmcnt(0)" ::: "memory"); \
    _Pragma("unroll") for (int d = 0; d < 4; ++d) _Pragma("unroll") for (int r = 0; r < 16; ++r) o[d][r] *= al_l[crow(r, hi)]; } } while (0)
#define PSM(P0, P1, MN, AL, j) do { if constexpr (MODE == 0) partialSM(P0, P1, m_reg, MN, AL); else partialSM_B(P0, P1, m_reg, MN, AL, tab + tbase + (j) * KVBLK); } while (0)
#define ROT() do { const int t_ = o_prev; o_prev = o_cur; o_cur = o_next; o_next = t_; } while (0)
  f32x16 pA0, pA1, pB0, pB1; float mnA, mnB, alA, alB; bf16x8 pa0, pa1, pa2, pa3; const int NT = (kend - kbeg) / KVBLK;
  constexpr int SE = 0, SO = 1;
  int o_prev = 2 * BUFB, o_cur = 0, o_next = BUFB;
  SLOAD(SE, 0); asm volatile("s_waitcnt vmcnt(0)" ::: "memory"); SWRITE(0, SE);
  SLOAD(SO, KVBLK); SLOAD(SE, 2 * KVBLK);
  __syncthreads();
  qkt(pA0, pA1, (const bf16_t*)(K_lds + o_cur), qr, r32, hi); PSM(pA0, pA1, mnA, alA, 0);
  SWAIT(); SWRITE(o_next, SO); RESC(alA); __syncthreads();
  ROT();
  for (int j = 1; j + 1 < NT; j += 2) {
    SBAR(); qkt(pB0, pB1, (const bf16_t*)(K_lds + o_cur), qr, r32, hi);
    finishSM(pA0, pA1, alA, l_reg, pa0, pa1, pa2, pa3); SBAR();
    SLOAD(SO, (j + 2) * KVBLK); SBAR();
    pv_psm<MODE>(o, vb0 + o_prev, pa0, pa1, pa2, pa3, pB0, pB1, m_reg, mnB, alB, tab + tbase + j * KVBLK);
    SWAIT(); SWRITE(o_next, SE);
    RESC(alB); __syncthreads(); ROT();
    SBAR(); qkt(pA0, pA1, (const bf16_t*)(K_lds + o_cur), qr, r32, hi);
    finishSM(pB0, pB1, alB, l_reg, pa0, pa1, pa2, pa3); SBAR();
    SLOAD(SE, (j + 3 < NT ? j + 3 : NT - 1) * KVBLK); SBAR();
    pv_psm<MODE>(o, vb0 + o_prev, pa0, pa1, pa2, pa3, pA0, pA1, m_reg, mnA, alA, tab + tbase + (j + 1) * KVBLK);
    SWAIT(); SWRITE(o_next, SO);
    RESC(alA); __syncthreads(); ROT();
  }
  SBAR(); qkt(pB0, pB1, (const bf16_t*)(K_lds + o_cur), qr, r32, hi);
  finishSM(pA0, pA1, alA, l_reg, pa0, pa1, pa2, pa3); SBAR();
  pv_psm<MODE>(o, vb0 + o_prev, pa0, pa1, pa2, pa3, pB0, pB1, m_reg, mnB, alB, tab + tbase + (NT - 1) * KVBLK);
  RESC(alB);
  finishSM(pB0, pB1, alB, l_reg, pa0, pa1, pa2, pa3); SBAR();
  pv_d0(o, vb0 + o_cur, pa0, pa1, pa2, pa3);
  if (hi == 0) li_l[r32] = l_reg; asm volatile("s_waitcnt lgkmcnt(0)" ::: "memory");
  float rli[16];
#pragma unroll
  for (int r = 0; r < 16; ++r) rli[r] = __builtin_amdgcn_rcpf(li_l[crow(r, hi)]);
  asm volatile("s_waitcnt vmcnt(0)" ::: "memory");
  __syncthreads();
  char* ost = lds + OFF_OST + wid * 8192;
#pragma unroll
  for (int r = 0; r < 16; ++r) { const int orow = crow(r, hi);
#pragma unroll
    for (int d0 = 0; d0 < 4; ++d0) *(unsigned short*)(ost + orow * 256 + (d0 * 32 + r32) * 2) = f2bf(o[d0][r] * rli[r]); }
  asm volatile("s_waitcnt lgkmcnt(0)" ::: "memory");
  bf16_t* Ow = Ob + (long)(wid * QBLK) * LDQ;
#pragma unroll
  for (int i = 0; i < 8; ++i) { const int ch = i * 64 + lane, row = ch >> 4, c16 = ch & 15;
    const u32x4 v = *(const u32x4*)(ost + row * 256 + c16 * 16); *(u32x4*)(Ow + (long)row * LDQ + c16 * 8) = v; }
  asm volatile("s_waitcnt lgkmcnt(0)" ::: "memory");
  __syncthreads();
#undef ROT
#undef SLOAD
#undef SWRITE
#undef SWAIT
#undef RESC
#undef PSM
}

template <int MODE>
__device__ __forceinline__ void softmax_tile(f32x16& p0, f32x16& p1, float& m_reg, float& l_reg, float& alpha, bf16x8& pa0, bf16x8& pa1, bf16x8& pa2, bf16x8& pa3, const float* tb) {
  if constexpr (MODE == 0) {
    alpha = 1.f;
    if (__builtin_expect(m_reg != 0.f, 0)) {
#pragma unroll
      for (int r = 0; r < 16; ++r) { p0[r] -= m_reg; p1[r] -= m_reg; } }
#pragma unroll
    for (int r = 0; r < 16; ++r) { p0[r] = __builtin_amdgcn_exp2f(p0[r]); p1[r] = __builtin_amdgcn_exp2f(p1[r]); }
  } else {
  if constexpr (MODE == 1) {
#pragma unroll
    for (int r = 0; r < 16; ++r) { const int of = (r & 3) + 8 * (r >> 2); p0[r] = fmaf(p0[r], C, tb[of]); p1[r] = fmaf(p1[r], C, tb[32 + of]); }
  }
  float pmax = p0[0];
#pragma unroll
  for (int r = 1; r < 16; ++r) pmax = fmaxf(pmax, p0[r]);
#pragma unroll
  for (int r = 0; r < 16; ++r) pmax = fmaxf(pmax, p1[r]);
  { auto rr = __builtin_amdgcn_permlane32_swap(__float_as_uint(pmax), __float_as_uint(pmax), false, false);
    pmax = fmaxf(__uint_as_float(rr[0]), __uint_as_float(rr[1])); }
  float mn, sub;
  if constexpr (MODE == 0) {
    if (__builtin_expect(__all(pmax - m_reg <= THR / SCALE), 1)) { mn = m_reg; alpha = 1.f; }
    else { mn = fmaxf(m_reg, pmax); alpha = __builtin_amdgcn_exp2f((m_reg - mn) * C); m_reg = mn; }
    sub = -mn * C;
#pragma unroll
    for (int r = 0; r < 16; ++r) { p0[r] = __builtin_amdgcn_exp2f(fmaf(p0[r], C, sub)); p1[r] = __builtin_amdgcn_exp2f(fmaf(p1[r], C, sub)); }
  } else {
    if (__builtin_expect(__all(pmax - m_reg <= THR * LOG2E), 1)) { mn = m_reg; alpha = 1.f; }
    else { mn = fmaxf(m_reg, pmax); alpha = __builtin_amdgcn_exp2f(m_reg - mn); m_reg = mn; }
    sub = -mn;
#pragma unroll
    for (int r = 0; r < 16; ++r) { p0[r] = __builtin_amdgcn_exp2f(p0[r] + sub); p1[r] = __builtin_amdgcn_exp2f(p1[r] + sub); }
  }
  }
  float ps = 0;
#pragma unroll
  for (int r = 0; r < 16; ++r) ps += p0[r];
#pragma unroll
  for (int r = 0; r < 16; ++r) ps += p1[r];
  { auto rr = __builtin_amdgcn_permlane32_swap(__float_as_uint(ps), __float_as_uint(ps), false, false);
    ps = __uint_as_float(rr[0]) + __uint_as_float(rr[1]); }
  l_reg = l_reg * alpha + ps;
#define PK4(P, BASE, OUT) do { unsigned a0 = cvtpk(P[BASE + 0], P[BASE + 1]), a1 = cvtpk(P[BASE + 2], P[BASE + 3]);   \
    unsigned b0 = cvtpk(P[BASE + 4], P[BASE + 5]), b1 = cvtpk(P[BASE + 6], P[BASE + 7]);                              \
    auto r0 = __builtin_amdgcn_permlane32_swap(a0, b0, false, false); auto r1 = __builtin_amdgcn_permlane32_swap(a1, b1, false, false); \
    u32x4 w = {r0[0], r1[0], r0[1], r1[1]}; OUT = *reinterpret_cast<bf16x8*>(&w); } while (0)
  PK4(p0, 0, pa0); PK4(p0, 8, pa1); PK4(p1, 0, pa2); PK4(p1, 8, pa3);
#undef PK4
}
typedef short v4i16_t __attribute__((ext_vector_type(4)));
__device__ __forceinline__ bf16x8 ld_frag2(int sp, const LAS char* kb, const int (&kx)[4], const LAS char* vb) {
  if (sp >= 16) { const int s = sp - 16, d0 = s >> 1; return *(const LAS bf16x8*)(kb + kx[d0 & 3] + (d0 >> 2) * 128 + (s & 1) * 8192); }
  const int D0 = sp >> 2, ks = sp & 3;
  const s16x4 lo = __builtin_bit_cast(s16x4, __builtin_amdgcn_ds_read_tr16_b64_v4i16((LAS v4i16_t*)(vb + v_rd_off(D0, ks, 0))));
  const s16x4 hi = __builtin_bit_cast(s16x4, __builtin_amdgcn_ds_read_tr16_b64_v4i16((LAS v4i16_t*)(vb + v_rd_off(D0, ks, 1))));
  return (bf16x8){lo[0], lo[1], lo[2], lo[3], hi[0], hi[1], hi[2], hi[3]};
}
template <int SB, int SE, bool PRE>
__device__ __forceinline__ void mrun(bf16x8 (&f)[8], f32x16& p0, f32x16& p1, f32x16* o, const bf16x8* qr, bf16x8 pa0, bf16x8 pa1, bf16x8 pa2, bf16x8 pa3, const LAS char* kb, const int (&kx)[4], const LAS char* vb, float init) {
  if (SE > 16) { p0 = f32x16{}; p1 = f32x16{}; }
  SBAR();
  if (!PRE) {
#pragma unroll
    for (int s = SB; s < SB + 8; ++s) f[s & 7] = ld_frag2(s, kb, kx, vb);
    SBAR(); }
#pragma unroll
  for (int sp = SB; sp < SE; ++sp) {
    if (sp >= 16) { const int s = sp - 16; if (s & 1) p1 = __builtin_amdgcn_mfma_f32_32x32x16_bf16(f[sp & 7], qr[s >> 1], p1, 0, 0, 0); else p0 = __builtin_amdgcn_mfma_f32_32x32x16_bf16(f[sp & 7], qr[s >> 1], p0, 0, 0, 0); }
    else { const int D0 = sp >> 2, ks = sp & 3; const bf16x8 pa = ks == 0 ? pa0 : ks == 1 ? pa1 : ks == 2 ? pa2 : pa3;
      o[D0] = __builtin_amdgcn_mfma_f32_32x32x16_bf16(pa, f[sp & 7], o[D0], 0, 0, 0); }
    if (sp + 8 < SE) f[sp & 7] = ld_frag2(sp + 8, kb, kx, vb);
    SBAR();
  }
}
template <int MODE>
__device__ __forceinline__ void attn_unit_pp(const bf16_t* Qb, const bf16_t* __restrict__ Kh, const bf16_t* __restrict__ Vh, unsigned char* Ob8, int kbeg, int kend, int q0, int head, char* lds, const Aux& aux) {
  int tid = threadIdx.x; asm volatile("" : "+v"(tid));
  const int wid = tid >> 6, lane = tid & 63, r32 = lane & 31, hi = lane >> 5;
  const int widu = __builtin_amdgcn_readfirstlane(wid), half = widu >> 2;
  const int hsub = widu >> 1, rsub = (widu & 1) * QBLK;
  const int rw0 = q0 + rsub;
#define NEED(j) (MODE == 0 || ((kbeg + (j) * KVBLK + KVBLK - 1 >= rw0 - 128) && (kbeg + (j) * KVBLK <= rw0 + QBLK - 1 + 128)))
  char* V_lds = lds; char* K_lds = lds + SHM_V;
  float* ws = (float*)(lds + OFF_WS) + wid * 64; float* li_l = ws; float* al_l = ws + 32;
  float* tab = (float*)(lds + OFF_TAB) + hsub * 768;
  float m_reg = -1e30f, l_reg = 0; f32x16 o[4] = {}; bf16x8 qr[8];
  const bf16_t* Qw = Qb + (long)(rsub + r32) * LDQ + hsub * HD + hi * 8;
#pragma unroll
  for (int d0 = 0; d0 < 8; ++d0) qr[d0] = *reinterpret_cast<const bf16x8*>(Qw + d0 * 16);
  if constexpr (MODE == 1) {
    m_reg = aux.sink[head + hsub] * LOG2E; l_reg = 1.0f;
  }
  const int tbase = kbeg - q0 - rsub - r32 + 383 + 4 * hi;
  float qk_init = 0.f;
  if constexpr (MODE == 0) {
    float mq = fmaxf(fabsf(aux.qn[lane]), fabsf(aux.qn[64 + lane])), mk = fmaxf(fabsf(aux.kn[lane]), fabsf(aux.kn[64 + lane]));
#pragma unroll
    for (int of = 1; of < 64; of <<= 1) { mq = fmaxf(mq, __shfl_xor(mq, of)); mk = fmaxf(mk, __shfl_xor(mk, of)); }
    const float bound = C * 128.0f * mq * mk * 1.01f + 0.5f;
    m_reg = __builtin_amdgcn_readfirstlane(__float_as_int(bound > 64.f ? bound - 64.f : 0.f)) ? (bound - 64.f) : 0.f; (void)qk_init; }
  const int sr = tid >> 4, sc = (tid & 15) * 8, vst0 = v_st(sr, sc), vst1 = v_st(32 + sr, sc);
  const int vb0 = (int)(uintptr_t)V_lds + v_rd_base(lane);
  int kx[4];
#pragma unroll
  for (int d = 0; d < 4; ++d) kx[d] = r32 * 256 + ((d * 32 + hi * 16) ^ ((r32 & 7) << 4));
  const LAS char* k3 = (const LAS char*)K_lds; const LAS char* v3 = (const LAS char*)V_lds + v_rd_base(lane);
  bf16x8 fr_[8];
  bf16x8 s_v0, s_v1, s_k0, s_k1;
#define SLOAD(k0) do { s_v0 = *reinterpret_cast<const bf16x8*>(&Vh[(long)(kbeg + (k0) + sr) * LDK + sc]); s_v1 = *reinterpret_cast<const bf16x8*>(&Vh[(long)(kbeg + (k0) + 32 + sr) * LDK + sc]); \
    s_k0 = *reinterpret_cast<const bf16x8*>(&Kh[(long)(kbeg + (k0) + sr) * LDK + sc]); s_k1 = *reinterpret_cast<const bf16x8*>(&Kh[(long)(kbeg + (k0) + 32 + sr) * LDK + sc]); } while (0)
#define SWRITE(bo) do { *(bf16x8*)(V_lds + (bo) + vst0) = s_v0; *(bf16x8*)(V_lds + (bo) + vst1) = s_v1; const int kc = sc * 2;  \
    *(bf16x8*)(K_lds + (bo) + KSWZ(sr, kc)) = s_k0; *(bf16x8*)(K_lds + (bo) + KSWZ(32 + sr, kc)) = s_k1; } while (0)
#define VMW0() asm volatile("s_waitcnt vmcnt(0)" ::: "memory")
#define BAR() asm volatile("s_waitcnt lgkmcnt(0)\n\ts_barrier" ::: "memory")
#define RESC(a) do { if (__any((a) < 1.f)) { if (hi == 0) al_l[r32] = (a); asm volatile("s_waitcnt lgkmcnt(0)" ::: "memory"); \
    _Pragma("unroll") for (int d = 0; d < 4; ++d) _Pragma("unroll") for (int r = 0; r < 16; ++r) o[d][r] *= al_l[crow(r, hi)]; } } while (0)
#define ROT() do { const int t_ = o_prev; o_prev = o_cur; o_cur = o_next; o_next = t_; } while (0)
#define VSEG(j) do { VMW0(); SWRITE(o_next); { const int nx_ = (j) + 2 + half; SLOAD((nx_ < NT ? nx_ : NT - 1) * KVBLK); } SBAR(); \
    if (NEED(j)) { softmax_tile<MODE>(p0, p1, m_reg, l_reg, alpha, pa0, pa1, pa2, pa3, tab + tbase + (j) * KVBLK); if constexpr (MODE == 1) { RESC(alpha); } } SBAR(); } while (0)
#define PVPRE() do { if constexpr (MODE == 0) { _Pragma("unroll") for (int s_ = 0; s_ < 8; ++s_) fr_[s_] = ld_frag2(s_, k3, kx, v3 + o_cur); SBAR(); } } while (0)
  f32x16 p0, p1; float alpha; bf16x8 pa0, pa1, pa2, pa3; const int NT = (kend - kbeg) / KVBLK;
  int o_prev = 2 * BUFB, o_cur = 0, o_next = BUFB;
  { bf16x8 t_v0, t_v1, t_k0, t_k1;
    t_v0 = *reinterpret_cast<const bf16x8*>(&Vh[(long)(kbeg + sr) * LDK + sc]); t_v1 = *reinterpret_cast<const bf16x8*>(&Vh[(long)(kbeg + 32 + sr) * LDK + sc]);
    t_k0 = *reinterpret_cast<const bf16x8*>(&Kh[(long)(kbeg + sr) * LDK + sc]); t_k1 = *reinterpret_cast<const bf16x8*>(&Kh[(long)(kbeg + 32 + sr) * LDK + sc]);
    SLOAD(KVBLK); VMW0();
    *(bf16x8*)(V_lds + vst0) = t_v0; *(bf16x8*)(V_lds + vst1) = t_v1; { const int kc = sc * 2; *(bf16x8*)(K_lds + KSWZ(sr, kc)) = t_k0; *(bf16x8*)(K_lds + KSWZ(32 + sr, kc)) = t_k1; }
    if (half) { SWRITE(BUFB); SLOAD(2 * KVBLK); } }
  BAR();
#define MSEG_QK(j) do { SBAR(); if (NEED(j)) qkt(p0, p1, (const bf16_t*)(K_lds + o_cur), qr, r32, hi, qk_init); SBAR(); } while (0)
#define MSEG(j) do { SBAR(); if (NEED(j)) qkt(p0, p1, (const bf16_t*)(K_lds + o_cur), qr, r32, hi, qk_init); if (NEED((j) - 1)) pv_d0(o, vb0 + o_prev, pa0, pa1, pa2, pa3); SBAR(); } while (0)
#define MSEG_PV() do { SBAR(); if (NEED(NT - 1)) pv_d0(o, vb0 + o_prev, pa0, pa1, pa2, pa3); SBAR(); } while (0)
  if (half == 0) {
    MSEG_QK(0); VSEG(0);
    BAR(); ROT();
    for (int j = 1; j < NT; ++j) { MSEG(j); VSEG(j); BAR(); ROT(); }
    MSEG_PV();
  } else {
    MSEG_QK(0);
    BAR(); ROT();
    for (int j = 1; j < NT; ++j) { VSEG(j - 1); MSEG(j); BAR(); ROT(); }
    VSEG(NT - 1); MSEG_PV();
  }
#undef MSEG_QK
#undef MSEG
#undef MSEG_PV
  if (hi == 0) li_l[r32] = l_reg; asm volatile("s_waitcnt lgkmcnt(0)" ::: "memory");
  float rli[16];
#pragma unroll
  for (int r = 0; r < 16; ++r) rli[r] = __builtin_amdgcn_rcpf(li_l[crow(r, hi)]);
  VMW0();
  __syncthreads();
  char* ost = lds + OFF_OST + wid * 4096;
#pragma unroll
  for (int r = 0; r < 16; ++r) { const int orow = crow(r, hi);
#pragma unroll
    for (int d0 = 0; d0 < 4; ++d0) { const float xo = o[d0][r] * rli[r] * OB8S; *(unsigned char*)(ost + orow * 128 + d0 * 32 + r32) = (unsigned char)(__builtin_amdgcn_cvt_pk_fp8_f32(xo, xo, 0, false) & 0xff); } }
  asm volatile("s_waitcnt lgkmcnt(0)" ::: "memory");
  unsigned char* Ow = Ob8 + (long)rsub * QW + hsub * HD;
#pragma unroll
  for (int i = 0; i < 4; ++i) { const int ch = i * 64 + lane, row = ch >> 3, c16 = ch & 7;
    const u32x4 v = *(const u32x4*)(ost + row * 128 + c16 * 16); *(u32x4*)(Ow + (long)row * QW + c16 * 16) = v; }
  asm volatile("s_waitcnt lgkmcnt(0)" ::: "memory");
  __syncthreads();
#undef SLOAD
#undef SWRITE
#undef VMW0
#undef BAR
#undef RESC
#undef ROT
#undef VSEG
#undef PVPRE
#undef NEED
}

__device__ __forceinline__ int offK16(int row, int ch) { return row * 256 + 16 * (ch ^ (row & 15)); }
__device__ __forceinline__ int offV16(int row, int ch) { return row * 256 + 16 * (ch ^ ((row & 7) << 1)); }
__device__ __forceinline__ bf16x8 ld_frag16(int sp, const LAS char* kb, const int (&ka)[4], const LAS char* vb, const int (&va)[8]) {
  if (sp >= 16) { const int s = sp - 16, kblk = s >> 2, ks = s & 3; return *(const LAS bf16x8*)(kb + ka[ks] + kblk * 4096); }
  const int db = sp >> 1, s = sp & 1;
  const s16x4 lo = __builtin_bit_cast(s16x4, __builtin_amdgcn_ds_read_tr16_b64_v4i16((LAS v4i16_t*)(vb + va[db] + s * 8192)));
  const s16x4 hi = __builtin_bit_cast(s16x4, __builtin_amdgcn_ds_read_tr16_b64_v4i16((LAS v4i16_t*)(vb + va[db] + s * 8192 + 4096)));
  return (bf16x8){lo[0], lo[1], lo[2], lo[3], hi[0], hi[1], hi[2], hi[3]};
}
template <int SB, int SE, bool PRE>
__device__ __forceinline__ void mrun16(bf16x8 (&f)[8], f32x4 (&S)[4][2], f32x4 (&O)[8][2], const bf16x8 (&qf)[2][4], const bf16x8 (&pf)[2][2], const LAS char* kb, const int (&ka)[4], const LAS char* vb, const int (&va)[8]) {
  if (SE > 16) {
#pragma unroll
    for (int i = 0; i < 4; ++i) { S[i][0] = (f32x4){0.f, 0.f, 0.f, 0.f}; S[i][1] = (f32x4){0.f, 0.f, 0.f, 0.f}; } }
  SBAR();
  if (!PRE) {
#pragma unroll
    for (int s = SB; s < SB + 8; ++s) f[s & 7] = ld_frag16(s, kb, ka, vb, va);
    SBAR(); }
#pragma unroll
  for (int sp = SB; sp < SE; ++sp) {
    if (sp >= 16) { const int s = sp - 16, kblk = s >> 2, ks = s & 3;
      S[kblk][0] = __builtin_amdgcn_mfma_f32_16x16x32_bf16(f[sp & 7], qf[0][ks], S[kblk][0], 0, 0, 0); S[kblk][1] = __builtin_amdgcn_mfma_f32_16x16x32_bf16(f[sp & 7], qf[1][ks], S[kblk][1], 0, 0, 0); }
    else { const int db = sp >> 1, s = sp & 1;
      O[db][0] = __builtin_amdgcn_mfma_f32_16x16x32_bf16(f[sp & 7], pf[0][s], O[db][0], 0, 0, 0); O[db][1] = __builtin_amdgcn_mfma_f32_16x16x32_bf16(f[sp & 7], pf[1][s], O[db][1], 0, 0, 0); }
    if (sp + 8 < SE) f[sp & 7] = ld_frag16(sp + 8, kb, ka, vb, va);
    SBAR();
  }
}
__device__ __forceinline__ void attn_unit16(const bf16_t* Qb, const bf16_t* __restrict__ Kh, const bf16_t* __restrict__ Vh, bf16_t* Ob, int nkeys, int q0, char* lds, const Aux& aux) {
  int tid = threadIdx.x; asm volatile("" : "+v"(tid));
  const int wid = tid >> 6, lane = tid & 63, fr = lane & 15, fq = lane >> 4;
  const int half = __builtin_amdgcn_readfirstlane(wid >> 2);
  char* V_lds = lds; char* K_lds = lds + SHM_V;
  float shift;
  { float mq = fmaxf(fabsf(aux.qn[lane]), fabsf(aux.qn[64 + lane])), mk = fmaxf(fabsf(aux.kn[lane]), fabsf(aux.kn[64 + lane]));
#pragma unroll
    for (int of = 1; of < 64; of <<= 1) { mq = fmaxf(mq, __shfl_xor(mq, of)); mk = fmaxf(mk, __shfl_xor(mk, of)); }
    const float bound = C * 128.0f * mq * mk * 1.01f + 0.5f; shift = bound > 64.f ? bound - 64.f : 0.f; }
  bf16x8 qf[2][4];
#pragma unroll
  for (int qb = 0; qb < 2; ++qb)
#pragma unroll
    for (int ks = 0; ks < 4; ++ks) qf[qb][ks] = *reinterpret_cast<const bf16x8*>(Qb + (long)(wid * QBLK + 16 * qb + fr) * LDQ + 32 * ks + 8 * fq);
#pragma unroll
  for (int qb = 0; qb < 2; ++qb) {
    float ss = 0.f;
#pragma unroll
    for (int ks = 0; ks < 4; ++ks) { const f32x8 x = bf8_to_f32(qf[qb][ks]);
#pragma unroll
      for (int e = 0; e < 8; ++e) ss += x[e] * x[e]; }
    ss += __shfl_xor(ss, 16); ss += __shfl_xor(ss, 32);
    const float rinv = C / sqrtf(ss * (1.0f / 128.0f) + EPS);
    const int t = q0 + wid * QBLK + 16 * qb + fr;
#pragma unroll
    for (int hf = 0; hf < 2; ++hf) { const int posx = hf ? (t & 63) : (t >> 6);
      const f32x8 cs = *reinterpret_cast<const f32x8*>(aux.cosT + posx * 32 + 8 * fq), sn = *reinterpret_cast<const f32x8*>(aux.sinT + posx * 32 + 8 * fq);
      const f32x8 g1 = *reinterpret_cast<const f32x8*>(aux.qn + hf * 64 + 8 * fq), g2 = *reinterpret_cast<const f32x8*>(aux.qn + hf * 64 + 32 + 8 * fq);
      const f32x8 x1 = bf8_to_f32(qf[qb][2 * hf]) * rinv * g1, x2 = bf8_to_f32(qf[qb][2 * hf + 1]) * rinv * g2;
      qf[qb][2 * hf] = f32_to_bf8(x1 * cs - x2 * sn); qf[qb][2 * hf + 1] = f32_to_bf8(x2 * cs + x1 * sn); } }
  f32x4 O[8][2], S[4][2]; bf16x8 pf[2][2]; float lsum[2] = {0.f, 0.f};
#pragma unroll
  for (int i = 0; i < 8; ++i) { O[i][0] = (f32x4){0.f, 0.f, 0.f, 0.f}; O[i][1] = (f32x4){0.f, 0.f, 0.f, 0.f}; }
  int ka[4], va[8];
#pragma unroll
  for (int ks = 0; ks < 4; ++ks) ka[ks] = offK16(fr, 4 * ks + fq);
  { const int q = (lane & 15) >> 2, p = lane & 3;
#pragma unroll
    for (int c = 0; c < 8; ++c) va[c] = offV16(4 * fq + q, 2 * c + (p >> 1)) + 8 * (p & 1); }
  const LAS char* k3 = (const LAS char*)K_lds; const LAS char* v3 = (const LAS char*)V_lds;
  bf16x8 fr_[8];
  const int sr = tid >> 4, scc = tid & 15, kst = offK16(sr, scc), vst = offV16(sr, scc);
  bf16x8 s_v0, s_v1, s_k0, s_k1;
#define SLOAD(k0) do { s_v0 = *reinterpret_cast<const bf16x8*>(&Vh[(long)((k0) + sr) * LDK + scc * 8]); s_v1 = *reinterpret_cast<const bf16x8*>(&Vh[(long)((k0) + 32 + sr) * LDK + scc * 8]); \
    s_k0 = *reinterpret_cast<const bf16x8*>(&Kh[(long)((k0) + sr) * LDK + scc * 8]); s_k1 = *reinterpret_cast<const bf16x8*>(&Kh[(long)((k0) + 32 + sr) * LDK + scc * 8]); } while (0)
#define SWRITE(bo) do { *(bf16x8*)(V_lds + (bo) + vst) = s_v0; *(bf16x8*)(V_lds + (bo) + vst + 8192) = s_v1; *(bf16x8*)(K_lds + (bo) + kst) = s_k0; *(bf16x8*)(K_lds + (bo) + kst + 8192) = s_k1; } while (0)
#define VMW0() asm volatile("s_waitcnt vmcnt(0)" ::: "memory")
#define BAR() asm volatile("s_waitcnt lgkmcnt(0)\n\ts_barrier" ::: "memory")
#define ROT() do { const int t_ = o_prev; o_prev = o_cur; o_cur = o_next; o_next = t_; } while (0)
#define VSEG(j, wbuf_, pbuf_) do { VMW0(); SWRITE(wbuf_); { const int nx_ = (j) + 2 + half; SLOAD((nx_ < NT ? nx_ : NT - 1) * KVBLK); } SBAR(); \
    if (__builtin_expect(shift != 0.f, 0)) { _Pragma("unroll") for (int i_ = 0; i_ < 4; ++i_) { S[i_][0] -= shift; S[i_][1] -= shift; } } \
    _Pragma("unroll") for (int qb_ = 0; qb_ < 2; ++qb_) { \
      _Pragma("unroll") for (int i_ = 0; i_ < 4; ++i_) _Pragma("unroll") for (int r_ = 0; r_ < 4; ++r_) S[i_][qb_][r_] = __builtin_amdgcn_exp2f(S[i_][qb_][r_]); \
      float a_ = 0.f; _Pragma("unroll") for (int i_ = 0; i_ < 4; ++i_) a_ += (S[i_][qb_][0] + S[i_][qb_][1]) + (S[i_][qb_][2] + S[i_][qb_][3]); lsum[qb_] += a_; \
      _Pragma("unroll") for (int s_ = 0; s_ < 2; ++s_) { u32x4 w_ = {cvtpk(S[2 * s_][qb_][0], S[2 * s_][qb_][1]), cvtpk(S[2 * s_][qb_][2], S[2 * s_][qb_][3]), cvtpk(S[2 * s_ + 1][qb_][0], S[2 * s_ + 1][qb_][1]), cvtpk(S[2 * s_ + 1][qb_][2], S[2 * s_ + 1][qb_][3])}; \
        pf[qb_][s_] = *reinterpret_cast<bf16x8*>(&w_); } } \
    SBAR(); _Pragma("unroll") for (int s_ = 0; s_ < 8; ++s_) fr_[s_] = ld_frag16(s_, k3, ka, v3 + (pbuf_), va); SBAR(); } while (0)
  const int NT = nkeys / KVBLK;
  int o_prev = 2 * BUFB, o_cur = 0, o_next = BUFB;
  SLOAD(0); VMW0(); SWRITE(0);
  if (half) { SLOAD(KVBLK); VMW0(); SWRITE(BUFB); SLOAD(2 * KVBLK); } else { SLOAD(KVBLK); }
  BAR();
  if (half == 0) {
    mrun16<16, 32, false>(fr_, S, O, qf, pf, k3 + o_cur, ka, v3 + o_prev, va);
    VSEG(0, o_next, o_cur);
    BAR(); ROT();
    for (int j = 1; j < NT; ++j) {
      mrun16<0, 32, true>(fr_, S, O, qf, pf, k3 + o_cur, ka, v3 + o_prev, va);
      VSEG(j, o_next, o_cur);
      BAR(); ROT();
    }
    mrun16<0, 16, true>(fr_, S, O, qf, pf, k3 + o_cur, ka, v3 + o_prev, va);
  } else {
    mrun16<16, 32, false>(fr_, S, O, qf, pf, k3 + o_cur, ka, v3 + o_prev, va);
    BAR(); ROT();
    for (int j = 1; j < NT; ++j) {
      VSEG(j - 1, o_next, o_prev);
      mrun16<0, 32, true>(fr_, S, O, qf, pf, k3 + o_cur, ka, v3 + o_prev, va);
      BAR(); ROT();
    }
    VSEG(NT - 1, o_next, o_prev);
    mrun16<0, 16, true>(fr_, S, O, qf, pf, k3 + o_cur, ka, v3 + o_prev, va);
  }
  float rl[2];
#pragma unroll
  for (int qb = 0; qb < 2; ++qb) { float l = lsum[qb]; l += __shfl_xor(l, 16); l += __shfl_xor(l, 32); rl[qb] = __builtin_amdgcn_rcpf(l); }
  VMW0();
  __syncthreads();
  char* ost = lds + OFF_OST + wid * 8192;
#pragma unroll
  for (int db = 0; db < 8; ++db)
#pragma unroll
    for (int qb = 0; qb < 2; ++qb) { const f32x4 v = O[db][qb] * rl[qb]; u32x2 w; w.x = cvtpk(v[0], v[1]); w.y = cvtpk(v[2], v[3]);
      *(u32x2*)(ost + (16 * qb + fr) * 256 + (16 * db + 4 * fq) * 2) = w; }
  asm volatile("s_waitcnt lgkmcnt(0)" ::: "memory");
  bf16_t* Ow = Ob + (long)(wid * QBLK) * LDQ;
#pragma unroll
  for (int i = 0; i < 8; ++i) { const int ch = i * 64 + lane, row = ch >> 4, c16 = ch & 15;
    const u32x4 v = *(const u32x4*)(ost + row * 256 + c16 * 16); *(u32x4*)(Ow + (long)row * LDQ + c16 * 8) = v; }
  asm volatile("s_waitcnt lgkmcnt(0)" ::: "memory");
  __syncthreads();
#undef SLOAD
#undef SWRITE
#undef VMW0
#undef BAR
#undef ROT
#undef VSEG
}

typedef int v8i_t __attribute__((ext_vector_type(8)));
typedef short v2s_t __attribute__((ext_vector_type(2)));
__device__ __forceinline__ int off8(int row, int c16) { return row * 128 + 16 * (c16 ^ (((row >> 1) & 1) | (((row >> 2) & 1) << 2))); }
__device__ __forceinline__ v8i_t ld_frag8(const LAS char* img, int a0, int a1, int blk) {
  const u32x4 lo = *(const LAS u32x4*)(img + blk * 2048 + a0), hi = *(const LAS u32x4*)(img + blk * 2048 + a1);
  return (v8i_t){(int)lo.x, (int)lo.y, (int)lo.z, (int)lo.w, (int)hi.x, (int)hi.y, (int)hi.z, (int)hi.w};
}
__device__ __forceinline__ void exp_pack8(f32x4 (&S)[4][2], v8i_t (&pf)[2], float (&lsum)[2], float pscale, int h) {
#pragma unroll
  for (int qb = 0; qb < 2; ++qb) { float a = 0.f;
#pragma unroll
    for (int i = 0; i < 4; ++i) { f32x4 e;
#pragma unroll
      for (int r = 0; r < 4; ++r) e[r] = __builtin_amdgcn_exp2f(S[i][qb][r]);
      a += (e[0] + e[1]) + (e[2] + e[3]);
      v2s_t p = {0, 0}; p = __builtin_amdgcn_cvt_scalef32_pk_bf8_f32(p, e[0], e[1], pscale, false); p = __builtin_amdgcn_cvt_scalef32_pk_bf8_f32(p, e[2], e[3], pscale, true);
      const int w = __builtin_bit_cast(int, p);
      if (h == 0) { if (i == 0) pf[qb][0] = w; else if (i == 1) pf[qb][1] = w; else if (i == 2) pf[qb][2] = w; else pf[qb][3] = w; }
      else { if (i == 0) pf[qb][4] = w; else if (i == 1) pf[qb][5] = w; else if (i == 2) pf[qb][6] = w; else pf[qb][7] = w; } }
    lsum[qb] += a; }
}
template <bool DO_PV, bool DO_QK, bool PRE>
__device__ __forceinline__ void mrun8(v8i_t (&f)[2], f32x4 (&S)[4][2], f32x4 (&O)[8][2], const v8i_t (&qf)[2], v8i_t (&pf)[2], float (&lsum)[2], float pscale, const LAS char* kimg, const LAS char* vimg, int a0, int a1) {
  constexpr int SB = DO_PV ? 0 : 8, SE = DO_QK ? 16 : 8;
  SBAR();
  if (!PRE) {
#pragma unroll
    for (int s = SB; s < SB + 2; ++s) f[s & 1] = (s >= 8) ? ld_frag8(kimg, a0, a1, s - 8) : ld_frag8(vimg, a0, a1, s);
    SBAR(); }
#pragma unroll
  for (int sp = SB; sp < SE; ++sp) {
    if (sp >= 8) { const int kb = sp - 8; const f32x4 z = {0.f, 0.f, 0.f, 0.f};
      S[kb & 3][0] = __builtin_amdgcn_mfma_scale_f32_16x16x128_f8f6f4(f[sp & 1], qf[0], z, 0, 0, 0, 0, 0, 0); S[kb & 3][1] = __builtin_amdgcn_mfma_scale_f32_16x16x128_f8f6f4(f[sp & 1], qf[1], z, 0, 0, 0, 0, 0, 0); }
    else { O[sp][0] = __builtin_amdgcn_mfma_scale_f32_16x16x128_f8f6f4(f[sp & 1], pf[0], O[sp][0], 0, 1, 0, 0, 0, 0); O[sp][1] = __builtin_amdgcn_mfma_scale_f32_16x16x128_f8f6f4(f[sp & 1], pf[1], O[sp][1], 0, 1, 0, 0, 0, 0); }
    if (sp + 2 < SE) f[sp & 1] = (sp + 2 >= 8) ? ld_frag8(kimg, a0, a1, sp + 2 - 8) : ld_frag8(vimg, a0, a1, sp + 2);
    SBAR();
    if (sp == 11) { exp_pack8(S, pf, lsum, pscale, 0); SBAR(); }
  }
}
__device__ __forceinline__ float xsum16(float x) { auto r = __builtin_amdgcn_permlane16_swap(__float_as_uint(x), __float_as_uint(x), false, false); return __uint_as_float(r[0]) + __uint_as_float(r[1]); }
__device__ __forceinline__ float xsum32(float x) { auto r = __builtin_amdgcn_permlane32_swap(__float_as_uint(x), __float_as_uint(x), false, false); return __uint_as_float(r[0]) + __uint_as_float(r[1]); }
__device__ __forceinline__ float xchg16(float x, bool odd) { auto r = __builtin_amdgcn_permlane16_swap(__float_as_uint(x), __float_as_uint(x), false, false); return __uint_as_float(odd ? r[0] : r[1]); }
__device__ __forceinline__ void attn_unit8(const bf16_t* Qb, const unsigned char* __restrict__ K8, const unsigned char* __restrict__ V8T, unsigned char* Ob8, int q0, char* lds, const Aux& aux, float pscale) {
  int tid = threadIdx.x; asm volatile("" : "+v"(tid));
  const int wid = tid >> 6, lane = tid & 63, fr = lane & 15, g = lane >> 4;
  const int half = __builtin_amdgcn_readfirstlane(wid >> 2);
  v8i_t qf[2];
  { char* qs = lds + 3 * BUFB + wid * 4096;
#pragma unroll
    for (int qb = 0; qb < 2; ++qb) {
      bf16x8 q16[4]; float ss = 0.f;
#pragma unroll
      for (int ks = 0; ks < 4; ++ks) { q16[ks] = *reinterpret_cast<const bf16x8*>(Qb + (long)(wid * QBLK + 16 * qb + fr) * LDQ + 32 * ks + 8 * g); const f32x8 x = bf8_to_f32(q16[ks]);
#pragma unroll
        for (int e = 0; e < 8; ++e) ss += x[e] * x[e]; }
      ss = xsum32(xsum16(ss));
      const float rinv = C / sqrtf(ss * (1.0f / 128.0f) + EPS);
      const int t = q0 + wid * QBLK + 16 * qb + fr;
#pragma unroll
      for (int hf = 0; hf < 2; ++hf) { const int posx = hf ? (t & 63) : (t >> 6);
        const f32x8 cs = *reinterpret_cast<const f32x8*>(aux.cosT + posx * 32 + 8 * g), sn = *reinterpret_cast<const f32x8*>(aux.sinT + posx * 32 + 8 * g);
        const f32x8 g1 = *reinterpret_cast<const f32x8*>(aux.qn + hf * 64 + 8 * g), g2 = *reinterpret_cast<const f32x8*>(aux.qn + hf * 64 + 32 + 8 * g);
        const f32x8 x1 = bf8_to_f32(q16[2 * hf]) * rinv * g1, x2 = bf8_to_f32(q16[2 * hf + 1]) * rinv * g2;
        const f32x8 y1 = x1 * cs - x2 * sn, y2 = x2 * cs + x1 * sn;
        int a0_ = 0, a1_ = 0, b0_ = 0, b1_ = 0;
        a0_ = __builtin_amdgcn_cvt_pk_fp8_f32(y1[0], y1[1], a0_, false); a0_ = __builtin_amdgcn_cvt_pk_fp8_f32(y1[2], y1[3], a0_, true); a1_ = __builtin_amdgcn_cvt_pk_fp8_f32(y1[4], y1[5], a1_, false); a1_ = __builtin_amdgcn_cvt_pk_fp8_f32(y1[6], y1[7], a1_, true);
        b0_ = __builtin_amdgcn_cvt_pk_fp8_f32(y2[0], y2[1], b0_, false); b0_ = __builtin_amdgcn_cvt_pk_fp8_f32(y2[2], y2[3], b0_, true); b1_ = __builtin_amdgcn_cvt_pk_fp8_f32(y2[4], y2[5], b1_, false); b1_ = __builtin_amdgcn_cvt_pk_fp8_f32(y2[6], y2[7], b1_, true);
        *(u32x2*)(qs + (16 * qb + fr) * 128 + 32 * (2 * hf) + 8 * g) = (u32x2){(unsigned)a0_, (unsigned)a1_}; *(u32x2*)(qs + (16 * qb + fr) * 128 + 32 * (2 * hf + 1) + 8 * g) = (u32x2){(unsigned)b0_, (unsigned)b1_}; }
    }
    asm volatile("s_waitcnt lgkmcnt(0)" ::: "memory");
#pragma unroll
    for (int qb = 0; qb < 2; ++qb) { const u32x4 lo = *(const u32x4*)(qs + (16 * qb + fr) * 128 + 32 * g), hi = *(const u32x4*)(qs + (16 * qb + fr) * 128 + 32 * g + 16);
      qf[qb] = (v8i_t){(int)lo.x, (int)lo.y, (int)lo.z, (int)lo.w, (int)hi.x, (int)hi.y, (int)hi.z, (int)hi.w}; }
    asm volatile("s_waitcnt lgkmcnt(0)" ::: "memory"); }
  f32x4 O[8][2], S[4][2]; v8i_t pf[2]; float lsum[2] = {0.f, 0.f};
#pragma unroll
  for (int i = 0; i < 8; ++i) { O[i][0] = (f32x4){0.f, 0.f, 0.f, 0.f}; O[i][1] = (f32x4){0.f, 0.f, 0.f, 0.f}; }
  const int a0 = off8(fr, 2 * g), a1 = off8(fr, 2 * g + 1);
  char* V_lds = lds; char* K_lds = lds + SHM_V;
  const LAS char* k3 = (const LAS char*)K_lds; const LAS char* v3 = (const LAS char*)V_lds;
  v8i_t fr_[2];
  const int widu = __builtin_amdgcn_readfirstlane(wid);
  unsigned dso[2];
#pragma unroll
  for (int i = 0; i < 2; ++i) { const int c = (wid * 2 + i) * 64 + lane, row = c >> 3, p = c & 7; dso[i] = (unsigned)(row * 128 + ((p ^ (((row >> 1) & 1) | (((row >> 2) & 1) << 2))) << 4)); }
  const unsigned ldsw = (unsigned)widu * 2048u; LAS unsigned char* l3 = (LAS unsigned char*)lds;
#define DMA_TILE(t_) do { const unsigned char* kg_ = K8 + (size_t)(t_) * 16384; const unsigned char* vg_ = V8T + (size_t)(t_) * 16384; const unsigned bo_ = (unsigned)(((t_) & 3) * BUFB); \
    _Pragma("unroll") for (int i_ = 0; i_ < 2; ++i_) { \
      __builtin_amdgcn_global_load_lds((const unsigned*)(vg_ + dso[i_]), (LAS unsigned*)(l3 + bo_ + ldsw + i_ * 1024), 16, 0, 0); \
      __builtin_amdgcn_global_load_lds((const unsigned*)(kg_ + dso[i_]), (LAS unsigned*)(l3 + bo_ + SHM_V + ldsw + i_ * 1024), 16, 0, 0); } } while (0)
#define VMW0() asm volatile("s_waitcnt vmcnt(0)" ::: "memory")
#define BAR() asm volatile("s_waitcnt lgkmcnt(0)\n\ts_barrier" ::: "memory")
#define VSEG(j, pbuf_) do { VMW0(); { const int nx_ = (j) + 2 + half; if (nx_ < NT) DMA_TILE(nx_); } SBAR(); \
    exp_pack8(S, pf, lsum, pscale, 1); \
    SBAR(); _Pragma("unroll") for (int s_ = 0; s_ < 2; ++s_) fr_[s_] = ld_frag8(v3 + (pbuf_), a0, a1, s_); SBAR(); } while (0)
  constexpr int NT = SEQ / 128;
  DMA_TILE(0); DMA_TILE(1); if (half) DMA_TILE(2);
  VMW0(); BAR();
  if (half) BAR();
  mrun8<false, true, false>(fr_, S, O, qf, pf, lsum, pscale, k3, v3, a0, a1);
  BAR();
  VSEG(0, 0);
  BAR();
  for (int j = 1; j < NT; ++j) {
    mrun8<true, true, true>(fr_, S, O, qf, pf, lsum, pscale, k3 + (j & 3) * BUFB, v3 + ((j - 1) & 3) * BUFB, a0, a1);
    BAR();
    VSEG(j, (j & 3) * BUFB);
    BAR();
  }
  mrun8<true, false, true>(fr_, S, O, qf, pf, lsum, pscale, k3, v3 + ((NT - 1) & 3) * BUFB, a0, a1);
  if (!half) BAR();
  float rl[2];
#pragma unroll
  for (int qb = 0; qb < 2; ++qb) { const float l = xsum32(xsum16(lsum[qb])); rl[qb] = pscale * __builtin_amdgcn_rcpf(l); }
  VMW0();
  __syncthreads();
  char* ost = lds + OFF_OST + wid * 4096;
#pragma unroll
  for (int db = 0; db < 8; ++db)
#pragma unroll
    for (int qb = 0; qb < 2; ++qb) { const f32x4 v = O[db][qb] * (rl[qb] * OA8S); int w = 0; w = __builtin_amdgcn_cvt_pk_fp8_f32(v[0], v[1], w, false); w = __builtin_amdgcn_cvt_pk_fp8_f32(v[2], v[3], w, true);
      *(int*)(ost + (16 * qb + fr) * 128 + 16 * db + 4 * g) = w; }
  asm volatile("s_waitcnt lgkmcnt(0)" ::: "memory");
  unsigned char* Ow = Ob8 + (long)(wid * QBLK) * QW;
#pragma unroll
  for (int i = 0; i < 4; ++i) { const int ch = i * 64 + lane, row = ch >> 3, c16 = ch & 7;
    const u32x4 v = *(const u32x4*)(ost + row * 128 + c16 * 16); *(u32x4*)(Ow + (long)row * QW + c16 * 16) = v; }
  asm volatile("s_waitcnt lgkmcnt(0)" ::: "memory");
  __syncthreads();
#undef DMA_TILE
#undef VMW0
#undef BAR
#undef VSEG
}
}

#define XB_TMO      128
#define XB_XCNT(j)  (256  + 64 * (j))
#define XB_XSUB(j)  (1280 + 64 * (j))
#define XB_XGEN(j)  (2304 + 64 * (j))
#define XB_TOP      3328
#define XB_TOPGEN   3392
#define XCD_BAR_WORDS 3456
#define XB_SPIN_CAP (1u << 18)
__device__ __forceinline__ unsigned xb_ld(unsigned* p)              { return __hip_atomic_load(p, __ATOMIC_RELAXED, __HIP_MEMORY_SCOPE_AGENT); }
__device__ __forceinline__ unsigned xb_add(unsigned* p, unsigned v) { return __hip_atomic_fetch_add(p, v, __ATOMIC_RELAXED, __HIP_MEMORY_SCOPE_AGENT); }
__device__ __forceinline__ unsigned xb_xcc_id() { return (unsigned)__builtin_amdgcn_s_getreg((3 << 11) | 20) & 0xFu; }
#define XB_SPIN(cond, bar) do { unsigned _sp = 0; while (cond) { __builtin_amdgcn_s_sleep(1); \
    if ((++_sp & 255u) == 0u) { if (xb_ld(&(bar)[XB_TMO])) break; if (_sp > XB_SPIN_CAP) { atomicAdd(&(bar)[XB_TMO], 1u); break; } } } } while (0)
struct XcdBarrier { unsigned* bar; unsigned x; volatile LAS unsigned* st; };
__device__ __forceinline__ XcdBarrier xcd_barrier_post(unsigned* bar, volatile LAS unsigned* st) {
    XcdBarrier b; b.bar = bar; b.x = xb_xcc_id(); b.st = st;
    if (threadIdx.x == 0) (void)xb_add(&bar[XB_XCNT(b.x)], 1u);
    return b;
}
__device__ __forceinline__ void xcd_barrier_complete(unsigned* bar, unsigned x, unsigned& nloc, unsigned& nx) {
    const unsigned G = gridDim.x * gridDim.y * gridDim.z;
    unsigned sum, cnt, mine, sp = 0u;
    for (;;) {
        sum = 0u; cnt = 0u; mine = 0u;
#pragma unroll
        for (unsigned j = 0; j < 16; ++j) { const unsigned c = xb_ld(&bar[XB_XCNT(j)]); sum += c; cnt += (c > 0u) ? 1u : 0u; mine = (j == x) ? c : mine; }
        if (sum == G) break;
        __builtin_amdgcn_s_sleep(1);
        if ((++sp & 255u) == 0u) { if (xb_ld(&bar[XB_TMO])) break; if (sp > XB_SPIN_CAP) { atomicAdd(&bar[XB_TMO], 1u); break; } }
    }
    nloc = mine > 0u ? mine : 1u; nx = cnt > 0u ? cnt : 1u;
}
__device__ __forceinline__ void xcd_barrier(const XcdBarrier& b) {
    asm volatile("s_waitcnt vmcnt(0)" ::: "memory");
    __syncthreads();
    if (threadIdx.x == 0) {
        unsigned* bar = b.bar;
        __builtin_amdgcn_s_waitcnt(0);
        unsigned nloc = b.st[0], nx = b.st[1];
        if (nloc == 0u) { xcd_barrier_complete(bar, b.x, nloc, nx); b.st[0] = nloc; b.st[1] = nx; }
        const unsigned old = xb_add(&bar[XB_XSUB(b.x)], 1u);
        const unsigned gen = old / nloc;
        if (old + 1u == (gen + 1u) * nloc) {
            __builtin_amdgcn_fence(__ATOMIC_RELEASE, "agent");
            asm volatile("s_waitcnt vmcnt(0)" ::: "memory");
            const unsigned og = xb_add(&bar[XB_TOP], 1u);
            const unsigned tg = og / nx;
            if (og + 1u == (tg + 1u) * nx) xb_add(&bar[XB_TOPGEN], 1u);
            else XB_SPIN(xb_ld(&bar[XB_TOPGEN]) == tg, bar);
            __builtin_amdgcn_fence(__ATOMIC_ACQUIRE, "agent");
            xb_add(&bar[XB_XGEN(b.x)], 1u);
            asm volatile("s_waitcnt vmcnt(0)" ::: "memory");
        } else {
            XB_SPIN(xb_ld(&bar[XB_XGEN(b.x)]) == gen, bar);
            __builtin_amdgcn_fence(__ATOMIC_ACQUIRE, "agent");
            asm volatile("s_waitcnt vmcnt(0)" ::: "memory");
        }
    }
    __syncthreads();
}

struct Args { const float* in[17]; float* out; unsigned char* ws; int ph_lo, ph_hi, li, pad; };
struct Frame { LAS unsigned char* lds; int tid, lane, wave, vcu, G; };
constexpr int NWAVES = 8;

__device__ __forceinline__ void tr_item(const float* W, int N, int k0, int n0, bf16_t* WT, int Kd, int drow0, LAS float* scr, int lane, unsigned char* WT8 = nullptr, bool wr16 = true) {
    float tv[32];
#pragma unroll
    for (int i = 0; i < 32; ++i) { const int kk = 2 * i + (lane >> 5); tv[i] = W[(size_t)(k0 + kk) * N + n0 + (lane & 31)]; }
#pragma unroll
    for (int i = 0; i < 32; ++i) { const int kk = 2 * i + (lane >> 5); scr[kk * 33 + (lane & 31)] = tv[i]; }
    LDS_WAIT(); asm volatile("" ::: "memory");
    const int c = lane & 7;
#pragma unroll
    for (int j = 0; j < 4; ++j) { const int n = (lane >> 3) + 8 * j; const LAS float* s = scr + (8 * c) * 33 + n;
        if (wr16) { u32x4 o; o.x = cvt_pk_bf16(s[0 * 33], s[1 * 33]); o.y = cvt_pk_bf16(s[2 * 33], s[3 * 33]); o.z = cvt_pk_bf16(s[4 * 33], s[5 * 33]); o.w = cvt_pk_bf16(s[6 * 33], s[7 * 33]);
            *(GAS u32x4*)(WT + (size_t)(drow0 + n) * Kd + k0 + 8 * c) = o; }
        if (WT8) { int w0 = 0, w1 = 0; w0 = __builtin_amdgcn_cvt_pk_fp8_f32(s[0 * 33] * W8S, s[1 * 33] * W8S, w0, false); w0 = __builtin_amdgcn_cvt_pk_fp8_f32(s[2 * 33] * W8S, s[3 * 33] * W8S, w0, true);
            w1 = __builtin_amdgcn_cvt_pk_fp8_f32(s[4 * 33] * W8S, s[5 * 33] * W8S, w1, false); w1 = __builtin_amdgcn_cvt_pk_fp8_f32(s[6 * 33] * W8S, s[7 * 33] * W8S, w1, true);
            *(GAS u32x2*)(WT8 + (size_t)(drow0 + n) * Kd + k0 + 8 * c) = (u32x2){(unsigned)w0, (unsigned)w1}; } }
    LDS_WAIT(); asm volatile("" ::: "memory");
}
__device__ __forceinline__ void rms_row_to_bf16(const float* xrow, const float* g, bf16_t* orow, int lane) {
    const GAS f32x4* xr = (const GAS f32x4*)xrow + lane; const GAS f32x4* gr = (const GAS f32x4*)g + lane;
    f32x4 v[8]; float s = 0.f;
#pragma unroll
    for (int j = 0; j < 8; ++j) { v[j] = xr[64 * j]; s += (v[j].x * v[j].x + v[j].y * v[j].y) + (v[j].z * v[j].z + v[j].w * v[j].w); }
    const float rinv = 1.0f / sqrtf(wave_sum(s) * (1.f / DM) + EPS);
    GAS u32x2* o8 = (GAS u32x2*)orow + lane;
#pragma unroll
    for (int j = 0; j < 8; ++j) { const f32x4 gv = gr[64 * j]; u32x2 w; w.x = cvt_pk_bf16(v[j].x * rinv * gv.x, v[j].y * rinv * gv.y); w.y = cvt_pk_bf16(v[j].z * rinv * gv.z, v[j].w * rinv * gv.w); o8[64 * j] = w; }
}

__device__ __forceinline__ void p0_prologue(const Frame& F, const Args& a) {
    unsigned char* ws = a.ws;
    LAS float* scr = (LAS float*)(F.lds + F.wave * 16384);
    const int gw = F.vcu * NWAVES + F.wave, NGW = F.G * NWAVES;
    constexpr int I_IN = (DM / 64) * (INW / 32), I_P = (QW / 64) * (DM / 32), I_O = (DM / 64) * (DM / 32);
    constexpr int NITEMS = I_IN + 2 * I_P + I_O;
    for (int it = gw; it < NITEMS; it += NGW) {
        int r = it;
        if (r < I_IN) { const int nb = INW / 32, kb = r / nb, n0 = (r % nb) * 32; tr_item(a.in[2], INW, kb * 64, n0, (bf16_t*)(ws + WS_WIN), DM, n0, scr, F.lane, ws + WS_WIN8, false); continue; } r -= I_IN;
        if (r < I_P) { const int nb = DM / 32, kb = r / nb, n0 = (r % nb) * 32; tr_item(a.in[6], DM, kb * 64, n0, (bf16_t*)(ws + WS_WPA), QW, n0, scr, F.lane, ws + WS_WPA8, false); continue; } r -= I_P;
        if (r < I_P) { const int nb = DM / 32, kb = r / nb, n0 = (r % nb) * 32; tr_item(a.in[9], DM, kb * 64, n0, (bf16_t*)(ws + WS_WPB), QW, n0, scr, F.lane, ws + WS_WPB8, false); continue; } r -= I_P;
        { const int nb = DM / 32, kb = r / nb, n0 = (r % nb) * 32; tr_item(a.in[10], DM, kb * 64, n0, (bf16_t*)(ws + WS_WO), DM, n0, scr, F.lane, ws + WS_WO8, false); }
    }
    float* cosT = (float*)(ws + WS_ROPE); float* sinT = cosT + 128 * 32;
    for (int i = blockIdx.x * 512 + F.tid; i < 128 * 32; i += F.G * 512) { const int pos = i >> 5, p = i & 31;
        const float inv = 1.0f / powf(10000.0f, (float)(2 * p) / 64.0f); const float ang = (float)pos * inv; cosT[i] = cosf(ang); sinT[i] = sinf(ang); }
    { const float* X = a.in[0]; const float* gm = a.in[1]; bf16_t* H = (bf16_t*)(ws + WS_H); const int lane = F.lane;
      f32x4 nx[8]; int m = gw;
      if (m < NTOK) { const GAS f32x4* xr = (const GAS f32x4*)(X + (size_t)m * DM) + lane;
#pragma unroll
          for (int j = 0; j < 8; ++j) nx[j] = xr[64 * j]; }
      for (; m < NTOK; m += NGW) { f32x4 v[8]; float s = 0.f;
#pragma unroll
          for (int j = 0; j < 8; ++j) { v[j] = nx[j]; s += (v[j].x * v[j].x + v[j].y * v[j].y) + (v[j].z * v[j].z + v[j].w * v[j].w); }
          { const int nm = m + NGW; if (nm < NTOK) { const GAS f32x4* xr = (const GAS f32x4*)(X + (size_t)nm * DM) + lane;
#pragma unroll
              for (int j = 0; j < 8; ++j) nx[j] = xr[64 * j]; } }
          const float rinv = 1.0f / sqrtf(wave_sum(s) * (1.f / DM) + EPS);
          GAS u32x2* o8 = (GAS u32x2*)(H + (size_t)m * DM) + lane;
#pragma unroll
          for (int j = 0; j < 8; ++j) { const f32x4 gv = ((const GAS f32x4*)gm + lane)[64 * j]; const f32x4 hv = v[j] * rinv * gv; (void)o8;
              int w8 = 0; w8 = __builtin_amdgcn_cvt_pk_fp8_f32(hv.x, hv.y, w8, false); w8 = __builtin_amdgcn_cvt_pk_fp8_f32(hv.z, hv.w, w8, true); ((GAS int*)(ws + WS_H8 + (size_t)m * DM) + lane)[64 * j] = w8; } } }
}

constexpr int CW_WCTR = 8192;
__device__ __forceinline__ void p_moe_weights(const Frame& F, const Args& a) {
    unsigned char* ws = a.ws; LAS float* scr = (LAS float*)(F.lds + F.wave * 16384);
    constexpr int I_GU = NEXP * (DM / 64) * (DFF / 32), I_D = NEXP * (DFF / 64) * (DM / 32), NIT = 2 * I_GU + I_D;
    unsigned* ctr = (unsigned*)(ws + WS_CTL) + CW_WCTR;
    for (;;) {
        unsigned it0 = 0; if (F.lane == 0) it0 = __hip_atomic_fetch_add(ctr, 4u, __ATOMIC_RELAXED, __HIP_MEMORY_SCOPE_AGENT);
        it0 = (unsigned)__builtin_amdgcn_readfirstlane((int)it0);
        if (it0 >= (unsigned)NIT) break;
        for (int k4 = 0; k4 < 4; ++k4) { int r = (int)it0 + k4; if (r >= NIT) break;
            if (r < 2 * I_GU) { const int up = r >= I_GU; if (up) r -= I_GU; constexpr int per = (DM / 64) * (DFF / 32); const int e = r / per, q = r % per, nb = DFF / 32, kb = q / nb, n0 = (q % nb) * 32;
                tr_item(a.in[up ? 14 : 13] + (size_t)e * DM * DFF, DFF, kb * 64, n0, (bf16_t*)(ws + WS_WGU) + (size_t)e * 2048 * DM, DM, (n0 >> 7) * 256 + (n0 & 127) + (up ? 128 : 0), scr, F.lane); continue; }
            r -= 2 * I_GU;
            { constexpr int per = (DFF / 64) * (DM / 32); const int e = r / per, q = r % per, nb = DM / 32, kb = q / nb, n0 = (q % nb) * 32;
                tr_item(a.in[15] + (size_t)e * DFF * DM, DM, kb * 64, n0, (bf16_t*)(ws + WS_WD) + (size_t)e * 2048 * DFF, DFF, n0, scr, F.lane); } }
    }
}

__device__ __forceinline__ void prep_vecs(const Frame& F, bf16_t* T, int ld, int nh_log2, const float* gain, const float* cosT, const float* sinT, float oscale, unsigned char* out8) {
    const int gw = F.vcu * NWAVES + F.wave, NGW = F.G * NWAVES;
    const int sub = F.lane & 15, half = sub >> 3, q = sub & 7;
    const int nvec = NTOK << nh_log2;
    const f32x4 g1 = *(const f32x4*)(gain + half * 64 + 4 * q), g2 = *(const f32x4*)(gain + half * 64 + 32 + 4 * q);
    for (int it = gw; it < nvec / 16; it += NGW) {
        bf16_t* base[4]; u32x2 w1[4], w2[4]; int posx[4];
#pragma unroll
        for (int u = 0; u < 4; ++u) { const int vec = it * 16 + u * 4 + (F.lane >> 4);
            const int tok = vec >> nh_log2, hd = vec & ((1 << nh_log2) - 1), pos = tok & (SEQ - 1); posx[u] = half ? (pos & 63) : (pos >> 6);
            base[u] = T + (size_t)tok * ld + hd * HD + half * 64 + 4 * q; w1[u] = *(const u32x2*)base[u]; w2[u] = *(const u32x2*)(base[u] + 32); }
#pragma unroll
        for (int u = 0; u < 4; ++u) {
            float x1[4] = {bf2f(w1[u].x & 0xffff), bf2f(w1[u].x >> 16), bf2f(w1[u].y & 0xffff), bf2f(w1[u].y >> 16)}, x2[4] = {bf2f(w2[u].x & 0xffff), bf2f(w2[u].x >> 16), bf2f(w2[u].y & 0xffff), bf2f(w2[u].y >> 16)};
            float ss = 0.f;
#pragma unroll
            for (int j = 0; j < 4; ++j) ss += x1[j] * x1[j] + x2[j] * x2[j];
            ss += __shfl_xor(ss, 1); ss += __shfl_xor(ss, 2); ss += __shfl_xor(ss, 4); ss += __shfl_xor(ss, 8);
            const float rinv = 1.0f / sqrtf(ss * (1.0f / 128.0f) + EPS);
            const f32x4 cs = *(const f32x4*)(cosT + posx[u] * 32 + 4 * q), sn = *(const f32x4*)(sinT + posx[u] * 32 + 4 * q);
            float y1[4], y2[4];
#pragma unroll
            for (int j = 0; j < 4; ++j) { const float a1 = x1[j] * rinv * g1[j], a2 = x2[j] * rinv * g2[j]; y1[j] = (a1 * cs[j] - a2 * sn[j]) * oscale; y2[j] = (a2 * cs[j] + a1 * sn[j]) * oscale; }
            if (out8) {
                const int vec = it * 16 + u * 4 + (F.lane >> 4), tok = vec >> nh_log2, hd = vec & ((1 << nh_log2) - 1);
                unsigned char* o8 = out8 + ((size_t)(((tok >> 13) << nh_log2) + hd) * SEQ + (tok & (SEQ - 1))) * HD + half * 64 + 4 * q;
                int w1 = 0, w2 = 0; w1 = __builtin_amdgcn_cvt_pk_fp8_f32(y1[0], y1[1], w1, false); w1 = __builtin_amdgcn_cvt_pk_fp8_f32(y1[2], y1[3], w1, true);
                w2 = __builtin_amdgcn_cvt_pk_fp8_f32(y2[0], y2[1], w2, false); w2 = __builtin_amdgcn_cvt_pk_fp8_f32(y2[2], y2[3], w2, true);
                *(int*)o8 = w1; *(int*)(o8 + 32) = w2;
            } else {
            u32x2 o1, o2; o1.x = cvt_pk_bf16(y1[0], y1[1]); o1.y = cvt_pk_bf16(y1[2], y1[3]); o2.x = cvt_pk_bf16(y2[0], y2[1]); o2.y = cvt_pk_bf16(y2[2], y2[3]);
            *(u32x2*)base[u] = o1; *(u32x2*)(base[u] + 32) = o2; } }
    }
}
__device__ __forceinline__ void p2_qkprep(const Frame& F, const Args& a) {
    const float* cosT = (const float*)(a.ws + WS_ROPE); const float* sinT = cosT + 128 * 32;
    prep_vecs(F, (bf16_t*)(a.ws + WS_KA), KVW, 1, a.in[5], cosT, sinT, 1.0f, a.ws + WS_K8);
    { const bf16_t* VA = (const bf16_t*)(a.ws + WS_VA); unsigned char* V8T = a.ws + WS_V8T; LAS bf16_t* tl = (LAS bf16_t*)F.lds; constexpr int TP = 132;
      for (int T = F.vcu; T < BATCH * 2 * 64; T += F.G) { const int bk = T >> 6, t = T & 63, b = bk >> 1, kvh = bk & 1;
        { const int r = F.tid >> 2, qd = F.tid & 3; const bf16_t* src = VA + ((size_t)b * SEQ + 128 * t + r) * KVW + kvh * HD + qd * 32;
#pragma unroll
          for (int i = 0; i < 4; ++i) { const u32x4 v = *(const u32x4*)(src + 8 * i); LAS unsigned* d = (LAS unsigned*)(tl + r * TP + qd * 32 + 8 * i); d[0] = v.x; d[1] = v.y; d[2] = v.z; d[3] = v.w; } }
        __syncthreads();
        { const int d = F.tid >> 2, g = F.tid & 3; int w[8];
#pragma unroll
          for (int kb = 0; kb < 8; ++kb) { float x[4];
#pragma unroll
            for (int r = 0; r < 4; ++r) x[r] = bf2f(tl[(16 * kb + 4 * g + r) * TP + d]);
            int ww = 0; ww = __builtin_amdgcn_cvt_pk_fp8_f32(x[0], x[1], ww, false); ww = __builtin_amdgcn_cvt_pk_fp8_f32(x[2], x[3], ww, true); w[kb] = ww; }
          unsigned char* dst = V8T + ((size_t)T * HD + d) * 128 + 32 * g;
          *(u32x4*)dst = (u32x4){(unsigned)w[0], (unsigned)w[1], (unsigned)w[2], (unsigned)w[3]}; *(u32x4*)(dst + 16) = (u32x4){(unsigned)w[4], (unsigned)w[5], (unsigned)w[6], (unsigned)w[7]}; }
        __syncthreads(); } }
}

template <int MODE> __device__ __forceinline__ void p3_attention(const Frame& F, const Args& a, char* lds) {
    unsigned char* ws = a.ws;
    const bf16_t* Q = (const bf16_t*)(ws + (MODE == 0 ? WS_QA : WS_QB)); const bf16_t* K = (const bf16_t*)(ws + (MODE == 0 ? WS_KA : WS_KB)); const bf16_t* V = (const bf16_t*)(ws + (MODE == 0 ? WS_VA : WS_VB));
    att::Aux aux; aux.cosT = (const float*)(ws + WS_ROPE); aux.sinT = aux.cosT + 128 * 32; aux.qn = a.in[4]; aux.kn = a.in[5]; aux.relb = a.in[8]; aux.sink = a.in[7];
#define BUILD_TABS(kvh_) do { float* tabs_ = (float*)(lds + att::OFF_TAB); for (int i_ = F.tid; i_ < 4 * 768; i_ += 512) { const int hh_ = i_ / 768, ii_ = i_ - hh_ * 768, rel_ = ii_ - 383, n_ = rel_ < 0 ? -rel_ : rel_; float v_ = -1e30f; \
        if (n_ <= 128) v_ = aux.relb[att::t5_bucket(rel_) * NHB + (kvh_) * 4 + hh_] * LOG2E; tabs_[i_] = v_; } } while (0)
    float pscale = 1.f;
    if (MODE == 0) { float mq = fmaxf(fabsf(aux.qn[F.lane]), fabsf(aux.qn[64 + F.lane])), mk = fmaxf(fabsf(aux.kn[F.lane]), fabsf(aux.kn[64 + F.lane]));
#pragma unroll
        for (int of = 1; of < 64; of <<= 1) { mq = fmaxf(mq, __shfl_xor(mq, of)); mk = fmaxf(mk, __shfl_xor(mk, of)); }
        const float bound = att::C * 128.0f * mq * mk * 1.13f + 0.5f; pscale = __builtin_amdgcn_exp2f(fmaxf(ceilf(bound) - 15.f, 0.f));
        pscale = __uint_as_float(__builtin_amdgcn_readfirstlane(__float_as_uint(pscale))); }
    const bool shared_tabs = (F.G == 256);
    if (MODE == 1 && shared_tabs) { BUILD_TABS((F.vcu >> 5) & 1); __syncthreads(); }
    for (int i = 0;; ++i) {
        const int L = i * F.G + F.vcu; if (L >= 1024) break;
        const int x = (L & 255) >> 5, b = x >> 1, kvh = x & 1;
        const int qb = (MODE == 0) ? (L & 31) : ((L >> 8) * 32 + (L & 31));
        const int head = (MODE == 0) ? kvh * 4 + (L >> 8) : kvh * 4, q0 = qb * ((MODE == 0) ? 256 : 64);
        const bf16_t* Qb = Q + ((size_t)b * SEQ + q0) * QW + head * HD;
        const bf16_t* Kh = K + (size_t)b * SEQ * KVW + kvh * HD; const bf16_t* Vh = V + (size_t)b * SEQ * KVW + kvh * HD;
        int kbeg = 0, kend = SEQ;
        if (MODE == 1) { kbeg = q0 - 128 < 0 ? 0 : q0 - 128; kend = q0 + 192 > SEQ ? SEQ : q0 + 192; }
        if (MODE == 1 && !shared_tabs) { __syncthreads(); BUILD_TABS(kvh); __syncthreads(); }
        unsigned char* Ob8 = ws + (MODE == 0 ? WS_OA8 : WS_OB8) + ((size_t)b * SEQ + q0) * QW + head * HD;
        if constexpr (MODE == 0) att::attn_unit8(Qb, a.ws + WS_K8 + (size_t)(b * 2 + kvh) * SEQ * HD, a.ws + WS_V8T + (size_t)(b * 2 + kvh) * 64 * 16384, Ob8, q0, lds, aux, pscale);
        else att::attn_unit_pp<MODE>(Qb, Kh, Vh, Ob8, kbeg, kend, q0, head, lds, aux);
    }
#undef BUILD_TABS
}

__device__ __forceinline__ void p7_router(const Frame& F, const Args& a) {
    LAS float* wl = (LAS float*)F.lds;
    const float* wr = a.in[12];
    for (int i = F.tid; i < DM * NEXP / 4; i += 512) { const f32x4 v = *(const f32x4*)(wr + 4 * i); const int k = i >> 2, e0 = (i & 3) * 4;
        wl[(e0 + 0) * DM + k] = v.x; wl[(e0 + 1) * DM + k] = v.y; wl[(e0 + 2) * DM + k] = v.z; wl[(e0 + 3) * DM + k] = v.w; }
    __syncthreads();
    const float* X = a.in[0]; const bf16_t* ATT = (const bf16_t*)(a.ws + WS_ATT); bf16_t* H2 = (bf16_t*)(a.ws + WS_H); float* AFF = (float*)(a.ws + WS_AFF); const float* g = a.in[11];
    const int gw = F.vcu * NWAVES + F.wave, NGW = F.G * NWAVES, lane = F.lane;
    f32x4 nx[2][8]; u32x2 na[2][8];
#define RT_LOAD(rp_) do { _Pragma("unroll") for (int rr = 0; rr < 2; ++rr) { const size_t row_ = (size_t)(2 * (rp_) + rr); const GAS f32x4* xr = (const GAS f32x4*)(X + row_ * DM) + lane; const GAS u32x2* ar = (const GAS u32x2*)(ATT + row_ * DM) + lane; \
        _Pragma("unroll") for (int j = 0; j < 8; ++j) { nx[rr][j] = xr[64 * j]; if (DBG_LEVEL >= 3) na[rr][j] = ar[64 * j]; else na[rr][j] = (u32x2){0u, 0u}; } } } while (0)
    int rp = gw;
    if (rp < NTOK / 2) RT_LOAD(rp);
    for (; rp < NTOK / 2; rp += NGW) {
        f32x4 h[2][8]; float rinv[2];
#pragma unroll
        for (int rr = 0; rr < 2; ++rr) { float s = 0.f;
#pragma unroll
            for (int j = 0; j < 8; ++j) { f32x4 v = nx[rr][j]; const u32x2 w = na[rr][j]; v.x += __uint_as_float(w.x << 16); v.y += __uint_as_float(w.x & 0xffff0000u); v.z += __uint_as_float(w.y << 16); v.w += __uint_as_float(w.y & 0xffff0000u);
                h[rr][j] = v; s += (v.x * v.x + v.y * v.y) + (v.z * v.z + v.w * v.w); }
            rinv[rr] = s; }
#if DBG_LEVEL >= 3
#pragma unroll
        for (int rr = 0; rr < 2; ++rr) { GAS u32x2* x8 = (GAS u32x2*)((bf16_t*)(a.ws + WS_ATT) + (size_t)(2 * rp + rr) * DM) + lane;
#pragma unroll
            for (int j = 0; j < 8; ++j) { u32x2 w; w.x = cvt_pk_bf16(h[rr][j].x, h[rr][j].y); w.y = cvt_pk_bf16(h[rr][j].z, h[rr][j].w); x8[64 * j] = w; } }
#endif
        { const int nrp = rp + NGW; if (nrp < NTOK / 2) RT_LOAD(nrp); }
#pragma unroll
        for (int rr = 0; rr < 2; ++rr) { rinv[rr] = 1.0f / sqrtf(wave_sum(rinv[rr]) * (1.f / DM) + EPS);
            GAS u32x2* o8 = (GAS u32x2*)(H2 + (size_t)(2 * rp + rr) * DM) + lane;
#pragma unroll
            for (int j = 0; j < 8; ++j) { const f32x4 gv = ((const GAS f32x4*)g + lane)[64 * j]; h[rr][j] = h[rr][j] * rinv[rr] * gv;
                u32x2 w; w.x = cvt_pk_bf16(h[rr][j].x, h[rr][j].y); w.y = cvt_pk_bf16(h[rr][j].z, h[rr][j].w); o8[64 * j] = w; } }
        float v[32];
#pragma unroll
        for (int e = 0; e < NEXP; ++e) { float s0 = 0.f, s1 = 0.f;
#pragma unroll
            for (int j = 0; j < 8; ++j) { const f32x4 w = *(const LAS f32x4*)(wl + e * DM + 4 * lane + 256 * j);
                s0 += (h[0][j].x * w.x + h[0][j].y * w.y) + (h[0][j].z * w.z + h[0][j].w * w.w); s1 += (h[1][j].x * w.x + h[1][j].y * w.y) + (h[1][j].z * w.z + h[1][j].w * w.w); }
            v[e] = s0; v[16 + e] = s1; }
#pragma unroll
        for (int off = 16; off >= 1; off >>= 1) { const bool up = (lane & off) != 0;
#pragma unroll
            for (int i = 0; i < off; ++i) { const float lo = v[i], hi = v[i + off]; const float keep = up ? hi : lo, send = up ? lo : hi; v[i] = keep + __shfl_xor(send, off); } }
        const float mine = v[0] + __shfl_xor(v[0], 32);
        float mx = mine; mx = fmaxf(mx, __shfl_xor(mx, 1)); mx = fmaxf(mx, __shfl_xor(mx, 2)); mx = fmaxf(mx, __shfl_xor(mx, 4)); mx = fmaxf(mx, __shfl_xor(mx, 8));
        const float ex = expf(mine - mx); float sm = ex; sm += __shfl_xor(sm, 1); sm += __shfl_xor(sm, 2); sm += __shfl_xor(sm, 4); sm += __shfl_xor(sm, 8);
        if (lane < 32) { const int row = 2 * rp + (lane >> 4), e = lane & 15, b = row >> 13, s = row & (SEQ - 1); AFF[((size_t)(b * NEXP + e)) * SEQ + s] = ex / sm; }
    }
#undef RT_LOAD
    __syncthreads();
}

__device__ __forceinline__ int block_excl_scan(int v, LAS int* sc, int tid, int& total) {
    const int lane = tid & 63, w = tid >> 6; int x = v;
#pragma unroll
    for (int o = 1; o < 64; o <<= 1) { const int y = __shfl_up(x, o); if (lane >= o) x += y; }
    __syncthreads();
    if (lane == 63) sc[w] = x;
    __syncthreads();
    int pre = 0, tot = 0;
#pragma unroll
    for (int j = 0; j < 8; ++j) { const int s = sc[j]; if (j < w) pre += s; tot += s; }
    total = tot; return pre + x - v;
}
__device__ __forceinline__ void p8_topk(const Frame& F, const Args& a) {
    const float* AFF = (const float*)(a.ws + WS_AFF); int* IDX = (int*)(a.ws + WS_IDX); float* GATEV = (float*)(a.ws + WS_GATEV); int* INV = (int*)(a.ws + WS_INV);
    LAS int* hist = (LAS int*)F.lds; LAS int* sc = hist + 256; LAS int* res = sc + 16;
    const int tid = F.tid, lane = F.lane;
    for (int list = F.vcu; list < NLIST; list += F.G) {
        const int b = list / NEXP, e = list % NEXP;
        unsigned key[16];
        { const u32x4* src = (const u32x4*)(AFF + (size_t)list * SEQ + tid * 16);
#pragma unroll
            for (int j = 0; j < 4; ++j) { const u32x4 v = src[j]; key[4 * j] = v.x; key[4 * j + 1] = v.y; key[4 * j + 2] = v.z; key[4 * j + 3] = v.w; } }
        unsigned prefix = 0u, pmask = 0u; int krem = CAP;
#pragma unroll 1
        for (int pass = 0; pass < 4; ++pass) { const int shift = 24 - 8 * pass;
            __syncthreads();
            if (tid < 256) hist[tid] = 0;
            __syncthreads();
#pragma unroll
            for (int j = 0; j < 16; ++j) if ((key[j] & pmask) == prefix) __hip_atomic_fetch_add(&hist[(key[j] >> shift) & 255u], 1, __ATOMIC_RELAXED, __HIP_MEMORY_SCOPE_WORKGROUP);
            __syncthreads();
            if (tid < 64) {
                int c[4]; int s = 0;
#pragma unroll
                for (int j = 0; j < 4; ++j) { c[j] = hist[4 * lane + j]; s += c[j]; }
                int suf = s;
#pragma unroll
                for (int o = 1; o < 64; o <<= 1) { const int y = __shfl_down(suf, o); if (lane + o < 64) suf += y; }
                const int excl = suf - s;
                if (suf >= krem && excl < krem) { int cum = excl, bin = 4 * lane, kn = krem;
#pragma unroll
                    for (int j = 3; j >= 0; --j) { if (cum < krem && cum + c[j] >= krem) { bin = 4 * lane + j; kn = krem - cum; } cum += c[j]; }
                    res[0] = bin; res[1] = kn; }
            }
            __syncthreads();
            const int bin = res[0]; krem = res[1];
            prefix |= ((unsigned)bin) << shift; pmask |= 255u << shift;
        }
        const unsigned T = prefix;
        int ceq = 0;
#pragma unroll
        for (int j = 0; j < 16; ++j) ceq += (key[j] == T) ? 1 : 0;
        int toteq; const int eqb = block_excl_scan(ceq, sc, tid, toteq);
        int csel = 0, er = eqb; unsigned selmask = 0u;
#pragma unroll
        for (int j = 0; j < 16; ++j) { bool s = key[j] > T; if (key[j] == T) { s = er < krem; ++er; } if (s) { selmask |= 1u << j; ++csel; } }
        int totsel; int pos = block_excl_scan(csel, sc, tid, totsel);
#pragma unroll
        for (int j = 0; j < 16; ++j) { const int tokpos = tid * 16 + j; int slot = -1;
            if (selmask & (1u << j)) { slot = list * CAP + pos; IDX[slot] = tokpos; GATEV[slot] = __uint_as_float(key[j]); ++pos; }
            INV[((size_t)b * SEQ + tokpos) * NEXP + e] = slot; }
        __syncthreads();
    }
}

__device__ __forceinline__ void p11_final(const Frame& F, const Args& a, bool with_moe) {
    const float* X = a.in[0]; float* OUT = a.out; const bf16_t* ATT = (const bf16_t*)(a.ws + WS_ATT); const bf16_t* Y = (const bf16_t*)(a.ws + WS_Y); const int* INV = (const int*)(a.ws + WS_INV); const float* g = a.in[16];
    const int gw = F.vcu * NWAVES + F.wave, NGW = F.G * NWAVES, lane = F.lane;
    f32x4 nx[8]; u32x2 na[8]; int ninv = -1;
#define FN_LOAD(m_) do { const GAS f32x4* xr = (const GAS f32x4*)(X + (size_t)(m_) * DM) + lane; const GAS u32x2* ar = (const GAS u32x2*)(ATT + (size_t)(m_) * DM) + lane; \
        _Pragma("unroll") for (int j = 0; j < 8; ++j) { if (DBG_LEVEL >= 3) na[j] = ar[64 * j]; else nx[j] = xr[64 * j]; } \
        ninv = (with_moe && lane < NEXP) ? INV[(size_t)(m_) * NEXP + lane] : -1; } while (0)
    int m = gw;
    if (m < NTOK) FN_LOAD(m);
    for (; m < NTOK; m += NGW) {
        f32x4 v[8]; const int myinv = ninv;
#pragma unroll
        for (int j = 0; j < 8; ++j) { if (DBG_LEVEL >= 3) { const u32x2 w = na[j]; v[j].x = __uint_as_float(w.x << 16); v[j].y = __uint_as_float(w.x & 0xffff0000u); v[j].z = __uint_as_float(w.y << 16); v[j].w = __uint_as_float(w.y & 0xffff0000u); } else v[j] = nx[j]; }
        unsigned long long mask = __ballot(myinv >= 0);
        u32x2 y0[8]; const bool has0 = mask != 0ull;
        if (has0) { const int e = __builtin_ctzll(mask); mask &= mask - 1; const int slot = __builtin_amdgcn_readlane(myinv, e); const GAS u32x2* yr = (const GAS u32x2*)(Y + (size_t)slot * DM) + lane;
#pragma unroll
            for (int j = 0; j < 8; ++j) y0[j] = yr[64 * j]; }
        { const int nm = m + NGW; if (nm < NTOK) FN_LOAD(nm); }
        if (has0) {
#pragma unroll
            for (int j = 0; j < 8; ++j) { const u32x2 w = y0[j]; v[j].x += __uint_as_float(w.x << 16); v[j].y += __uint_as_float(w.x & 0xffff0000u); v[j].z += __uint_as_float(w.y << 16); v[j].w += __uint_as_float(w.y & 0xffff0000u); } }
        while (mask) { const int e = __builtin_ctzll(mask); mask &= mask - 1; const int slot = __builtin_amdgcn_readlane(myinv, e);
            const GAS u32x2* yr = (const GAS u32x2*)(Y + (size_t)slot * DM) + lane;
#pragma unroll
            for (int j = 0; j < 8; ++j) { const u32x2 w = yr[64 * j]; v[j].x += __uint_as_float(w.x << 16); v[j].y += __uint_as_float(w.x & 0xffff0000u); v[j].z += __uint_as_float(w.y << 16); v[j].w += __uint_as_float(w.y & 0xffff0000u); } }
        float s = 0.f;
#pragma unroll
        for (int j = 0; j < 8; ++j) s += (v[j].x * v[j].x + v[j].y * v[j].y) + (v[j].z * v[j].z + v[j].w * v[j].w);
        const float rinv = 1.0f / sqrtf(wave_sum(s) * (1.f / DM) + EPS);
        GAS f32x4* orow = (GAS f32x4*)(OUT + (size_t)m * DM) + lane;
#pragma unroll
        for (int j = 0; j < 8; ++j) { const f32x4 gv = ((const GAS f32x4*)g + lane)[64 * j]; orow[64 * j] = v[j] * rinv * gv; }
    }
#undef FN_LOAD
}
__device__ __forceinline__ void p_copy_x(const Frame& F, const Args& a) {
    const f32x4* src = (const f32x4*)a.in[0]; f32x4* dst = (f32x4*)a.out;
    for (size_t i = (size_t)blockIdx.x * 512 + F.tid; i < (size_t)NTOK * DM / 4; i += (size_t)F.G * 512) dst[i] = src[i];
}

constexpr int NPHASE = 10;
__global__ void __launch_bounds__(NWAVES * 64, 2) fwd_kernel(Args args) {
    extern __shared__ __attribute__((aligned(16))) unsigned char lds[];
    Frame F;
    F.lds = (LAS unsigned char*)lds;
    F.tid = threadIdx.x; F.lane = F.tid & 63; F.wave = __builtin_amdgcn_readfirstlane(F.tid >> 6);
    F.G = gridDim.x; { const int bx = blockIdx.x; F.vcu = (F.G % 8 == 0) ? (bx % 8) * (F.G / 8) + bx / 8 : bx; }
    unsigned char* ws = args.ws;
    gu32* ctl = (gu32*)(ws + WS_CTL);
    for (int u = F.tid; u < (LDS_BYTES - LDSCTL_OFF) / 4; u += NWAVES * 64) ((LAS unsigned*)(F.lds + LDSCTL_OFF))[u] = 0u;
    __syncthreads();
    XcdBarrier bar; bar.bar = (unsigned*)(ctl + CW_BAR); bar.x = 0; bar.st = nullptr;
    if (MK_N_LAUNCHES == 1) bar = xcd_barrier_post((unsigned*)(ctl + CW_BAR), (volatile LAS unsigned*)(F.lds + LDSCTL_OFF + 64));
    const int lo = args.ph_lo, hi = args.ph_hi;
#define IN(k) (lo <= (k) && (k) < hi)
#define SEAM(k) do { if (IN(k) && IN((k) + 1)) xcd_barrier(bar); } while (0)
#define REFRAME() do { int t_ = threadIdx.x; asm volatile("" : "+v"(t_)); F.tid = t_; F.lane = t_ & 63; F.wave = __builtin_amdgcn_readfirstlane(t_ >> 6); } while (0)

    if (IN(0)) { REFRAME(); for (int rep = 0; rep < REPS(0); ++rep) p0_prologue(F, args); }
    SEAM(0);
    if (IN(1)) { REFRAME();
#if DBG_LEVEL >= 3
        { pg8::MapProb<DM, 0, 1> P; P.A = ws + WS_H8; P.Bt = ws + WS_WIN8; P.S.init(NTOK, INW, F.G, (int)blockIdx.x);
          pg8::EpiInProj E{(bf16_t*)(ws + WS_QA), (bf16_t*)(ws + WS_KA), (bf16_t*)(ws + WS_VA), (bf16_t*)(ws + WS_QB), (bf16_t*)(ws + WS_KB), (bf16_t*)(ws + WS_VB), (bf16_t*)(ws + WS_GA), (bf16_t*)(ws + WS_GB), args.in[3], 1.0f / W8S};
          pg8::gemm_phase8<pg8::EpiInProj, pg8::MapProb<DM, 0, 1>, true>(F.lds, P, E); }
#endif
    }
    SEAM(1);
    if (IN(2)) { REFRAME();
#if DBG_LEVEL >= 4
        p2_qkprep(F, args);
#endif
    }
    SEAM(2);
    if (IN(3)) { REFRAME();
#if DBG_LEVEL >= 4
        for (int rep = 0; rep < REPS(3); ++rep) p3_attention<0>(F, args, (char*)lds);
#endif
#if DBG_LEVEL >= 3
        __syncthreads();
        for (int rep = 0; rep < REPS(13); ++rep) p3_attention<1>(F, args, (char*)lds);
        __syncthreads();
#endif
    }
    SEAM(3);
    if (IN(4)) { REFRAME();
#if DBG_LEVEL >= 4
        { pg8::MapProb<QW, 0, 1> P; P.A = ws + WS_OA8; P.Bt = ws + WS_WPA8; P.S.init(NTOK, DM, F.G, (int)blockIdx.x);
          pg8::EpiGated8<0> E{(bf16_t*)(ws + WS_GA), nullptr, nullptr, 1.0f / (OA8S * W8S)};
          pg8::gemm_phase8<pg8::EpiGated8<0>, pg8::MapProb<QW, 0, 1>, true>(F.lds, P, E); }
        { int gg_ = F.G; asm volatile("" : "+s"(gg_)); unsigned char* ws2_ = ws; asm volatile("" : "+s"(ws2_));
          pg8::MapProb<QW, 0, 1> P; P.A = ws2_ + WS_OB8; P.Bt = ws2_ + WS_WPB8; P.S.init(NTOK, DM, gg_, (int)blockIdx.x);
          pg8::EpiGated8<1> E{(bf16_t*)(ws2_ + WS_GA), (const bf16_t*)(ws2_ + WS_GB), ws2_ + WS_M8, 1.0f / (OB8S * W8S)};
          pg8::gemm_phase8<pg8::EpiGated8<1>, pg8::MapProb<QW, 0, 1>, true>(F.lds, P, E); }
#endif
    }
    SEAM(4);
    if (IN(5)) { REFRAME();
#if DBG_LEVEL >= 3
        pg8::MapProb<DM, 0, 1> P; P.A = ws + WS_M8; P.Bt = ws + WS_WO8; P.S.init(NTOK, DM, F.G, (int)blockIdx.x);
        pg8::EpiAtt E{(bf16_t*)(ws + WS_ATT), 1.0f / (M8S * W8S)};
        for (int rep = 0; rep < REPS(5); ++rep) pg8::gemm_phase8<pg8::EpiAtt, pg8::MapProb<DM, 0, 1>, true>(F.lds, P, E);
#endif
    }
    SEAM(5);
    if (IN(6)) { REFRAME();
#if DBG_LEVEL >= 2
        for (int rep = 0; rep < REPS(6); ++rep) p7_router(F, args);
#endif
    }
    SEAM(6);
    if (IN(7)) { REFRAME();
#if DBG_LEVEL >= 2
        for (int rep = 0; rep < REPS(7); ++rep) p8_topk(F, args);
        __syncthreads();
        p_moe_weights(F, args);
#endif
    }
    SEAM(7);
    if (IN(8)) { REFRAME();
#if DBG_LEVEL >= 2
        LAS unsigned* rowoff = (LAS unsigned*)(F.lds + pg8::STAGE_BYTES);
        const int* IDX = (const int*)(ws + WS_IDX);
        for (int i = 0; i < 8; ++i) { pg8::Unit u; int e, b; if (!pg8::moe_unit(i, F.G, F.vcu, u, e, b)) break;
            if (F.tid < 256) rowoff[i * 256 + F.tid] = (unsigned)IDX[u.pm * 256 + F.tid] * (unsigned)(DM * 2); }
        __syncthreads();
        pg8::GuProb P; P.H2 = (const bf16_t*)(ws + WS_H); P.W = (const bf16_t*)(ws + WS_WGU); P.rowoff = rowoff; P.G = F.G; P.vcu = F.vcu;
        pg8::EpiSwiglu E{(bf16_t*)(ws + WS_GA)};
        for (int rep = 0; rep < REPS(8); ++rep) pg8::gemm_phase<pg8::EpiSwiglu, pg8::GuProb, true>(F.lds, P, E);
#endif
    }
    SEAM(8);
    if (IN(9)) { REFRAME();
#if DBG_LEVEL >= 2
        pg8::DownProb P; P.HID = (const bf16_t*)(ws + WS_GA); P.W = (const bf16_t*)(ws + WS_WD); P.G = F.G; P.vcu = F.vcu;
        pg8::EpiDown E{(bf16_t*)(ws + WS_Y), (const float*)(ws + WS_GATEV)};
        for (int rep = 0; rep < REPS(9); ++rep) pg8::gemm_phase<pg8::EpiDown, pg8::DownProb, true>(F.lds, P, E);
#endif
    }
    SEAM(9);
    if (IN(10)) { REFRAME(); p11_final(F, args, DBG_LEVEL >= 2); }
#undef IN
#undef SEAM
}

extern "C" void kernel_launch(void* const* d_in, const int* in_sizes, int n_in, void* d_out, int out_size, void* d_ws, size_t ws_size, hipStream_t stream) {
    static int grid = 0;
    if (grid == 0) {
        if (n_in != 17 || in_sizes[0] != NTOK * DM || out_size != NTOK * DM || ws_size < WS_END) { fprintf(stderr, "kernel_launch: unexpected shapes (n_in %d, in0 %d, out %d, ws %zu); nothing launched\n", n_in, n_in > 0 ? in_sizes[0] : -1, out_size, ws_size); grid = -1; return; }
        int dev = 0, cus = 0, per_cu = 0;
        if (hipGetDevice(&dev) != hipSuccess || hipDeviceGetAttribute(&cus, hipDeviceAttributeMultiprocessorCount, dev) != hipSuccess) { grid = -1; return; }
        if (hipFuncSetAttribute((const void*)fwd_kernel, hipFuncAttributeMaxDynamicSharedMemorySize, LDS_BYTES) != hipSuccess) { fprintf(stderr, "kernel_launch: hipFuncSetAttribute failed\n"); grid = -1; return; }
        if (hipOccupancyMaxActiveBlocksPerMultiprocessor(&per_cu, (const void*)fwd_kernel, NWAVES * 64, LDS_BYTES) != hipSuccess || per_cu < 1)
            fprintf(stderr, "kernel_launch: note: occupancy query reports %d workgroups per CU\n", per_cu);
        (void)hipGetLastError();
        grid = cus;
    }
    if (grid < 0) return;
    (void)hipMemsetAsync((char*)d_ws + WS_CTL, 0, CTL_ZERO_BYTES, stream);
    Args a{};
    for (int i = 0; i < 17; ++i) a.in[i] = (const float*)d_in[i];
    a.out = (float*)d_out; a.ws = (unsigned char*)d_ws;
#if MK_N_LAUNCHES == 1
    a.ph_lo = 0; a.ph_hi = NPHASE + 1; a.li = 0;
    hipLaunchKernelGGL(fwd_kernel, dim3(grid), dim3(NWAVES * 64), LDS_BYTES, stream, a);
#else
    for (int li = 0; li <= NPHASE; ++li) { a.ph_lo = li; a.ph_hi = li + 1; a.li = li;
        hipLaunchKernelGGL(fwd_kernel, dim3(grid), dim3(NWAVES * 64), LDS_BYTES, stream, a); }
#endif
    const hipError_t le = hipPeekAtLastError();
    if (le != hipSuccess) fprintf(stderr, "kernel_launch: launch failed: %s\n", hipGetErrorName(le));
}
```

```cpp
#include <hip/hip_runtime.h>
#include <cstdio>
#include <cstdint>

#ifndef MK_N_LAUNCHES
#define MK_N_LAUNCHES 1
#endif
#ifndef DBG_LEVEL
#define DBG_LEVEL 4
#endif

#ifndef REP_PHASE
#define REP_PHASE -1
#endif
#define REPS(k) ((REP_PHASE == (k)) ? 2 : 1)
#define GAS __attribute__((address_space(1)))
#define LAS __attribute__((address_space(3)))
typedef unsigned short bf16_t;
typedef short bf16x8 __attribute__((ext_vector_type(8)));
typedef short s16x4 __attribute__((ext_vector_type(4)));
typedef float f32x2 __attribute__((ext_vector_type(2)));
typedef float f32x4 __attribute__((ext_vector_type(4)));
typedef float f32x8 __attribute__((ext_vector_type(8)));
typedef float f32x16 __attribute__((ext_vector_type(16)));
typedef unsigned u32x2 __attribute__((ext_vector_type(2)));
typedef unsigned u32x4 __attribute__((ext_vector_type(4)));
typedef GAS unsigned gu32;

constexpr int BATCH = 4, SEQ = 8192, DM = 2048, NTOK = BATCH * SEQ, HD = 128;
constexpr int NHA = 8, NHB = 8;
constexpr int QW = 1024, KVW = 256, INW = 7168;
constexpr int NEXP = 16, CAP = 1024, DFF = 1024, NLIST = BATCH * NEXP, NSLOT = NLIST * CAP;
constexpr float EPS = 1e-6f, LOG2E = 1.4426950408889634f;

constexpr size_t MiB = 1u << 20;
constexpr size_t WS_CTL = 0, CTL_ZERO_BYTES = 1 * MiB;
constexpr size_t WS_ROPE = 1 * MiB;
constexpr size_t WS_AFF = 2 * MiB;
constexpr size_t WS_IDX = 4 * MiB;
constexpr size_t WS_GATEV = 4 * MiB + 256 * 1024;
constexpr size_t WS_INV = 5 * MiB;
constexpr size_t WS_WIN = 8 * MiB;
constexpr size_t WS_WPA = 36 * MiB;
constexpr size_t WS_WPB = 40 * MiB;
constexpr size_t WS_WO = 44 * MiB;
constexpr size_t WS_WGU = 52 * MiB;
constexpr size_t WS_WD = 180 * MiB;
constexpr size_t WS_H = 244 * MiB;
constexpr size_t WS_GA = 372 * MiB;
constexpr size_t WS_GB = 500 * MiB;
constexpr size_t WS_QA = 628 * MiB, WS_KA = 692 * MiB, WS_VA = 708 * MiB, WS_QB = 724 * MiB, WS_KB = 788 * MiB, WS_VB = 804 * MiB;
constexpr size_t WS_Y = 500 * MiB;
constexpr size_t WS_OA = 820 * MiB, WS_OB = 884 * MiB;
constexpr size_t WS_ATT = 820 * MiB;
constexpr size_t WS_K8 = 948 * MiB;
constexpr size_t WS_V8T = 956 * MiB;
constexpr size_t WS_H8 = 820 * MiB;
constexpr size_t WS_WIN8 = 964 * MiB;
constexpr size_t WS_WPA8 = 978 * MiB, WS_WPB8 = 980 * MiB;
constexpr size_t WS_WO8 = 982 * MiB;
constexpr size_t WS_WD8 = 986 * MiB;
constexpr size_t WS_END = 1018 * MiB;
constexpr size_t WS_OA8 = 820 * MiB, WS_OB8 = 884 * MiB;
constexpr size_t WS_M8 = 244 * MiB;
constexpr float OB8S = 8.f, M8S = 16.f;
constexpr float W8S = 32.f, OA8S = 64.f;
constexpr int CW_TMO = 0;
constexpr int CW_BAR = 4096;

constexpr int LDS_SCRATCH = 155648;
constexpr int LDSCTL_OFF = LDS_SCRATCH;
constexpr int LDS_BYTES = LDS_SCRATCH + 512;

__device__ __forceinline__ unsigned cvt_pk_bf16(float lo, float hi) { unsigned r; asm volatile("v_cvt_pk_bf16_f32 %0, %1, %2" : "=v"(r) : "v"(lo), "v"(hi)); return r; }
__device__ __forceinline__ float bf2f(unsigned short v) { return __uint_as_float(((unsigned)v) << 16); }
__device__ __forceinline__ unsigned short f2bf(float f) { return (unsigned short)(cvt_pk_bf16(f, 0.f) & 0xffffu); }
__device__ __forceinline__ float wave_sum(float v) {
#pragma unroll
    for (int o = 1; o < 64; o <<= 1) v += __shfl_xor(v, o);
    return v;
}
__device__ __forceinline__ float sigmoidf_fast(float z) { return __builtin_amdgcn_rcpf(1.f + __builtin_amdgcn_exp2f(-z * LOG2E)); }
#define LDS_WAIT() asm volatile("s_waitcnt lgkmcnt(0)" ::: "memory")
#define VM_WAIT() asm volatile("s_waitcnt vmcnt(0)" ::: "memory")

namespace pg8 {
constexpr int BM = 256, BK = 64, HALF = 128, HTB = HALF * BK * 2, STAGE_BYTES = 8 * HTB;
__host__ __device__ __forceinline__ int lds_byte(int r, int c) { const int st = (r >> 4) * 2 + (c >> 5), rr = r & 15, cc = c & 31, ob = rr * 64 + cc * 2; return st * 1024 + (ob ^ (((ob >> 9) & 1) << 5)); }
__host__ __device__ __forceinline__ void stage_rc(int b, int& R, int& C) { const int st = b / 1024, sb = b % 1024, swz = sb ^ (((sb >> 9) & 1) << 5); R = (st >> 1) * 16 + swz / 64; C = (st & 1) * 32 + (swz % 64) / 2; }
__host__ __device__ __forceinline__ int perm32(int rho) { const int n = rho >> 4, i = rho & 15; return 8 * (i >> 2) + 4 * n + (i & 3); }

struct Unit { int pm, pn, ord; };

struct StaticOrder {
    int nM, nN, nwg, G, c;
    __device__ void init(int M, int N, int G_, int c_) { nM = M / BM; nN = N / BM; nwg = nM * nN; G = G_; c = c_; }
    __device__ bool next(int i, Unit& u) const {
        const long L = (long)i * G + c; if (L >= nwg) return false;
        int wgid = (int)L; { const int q = nwg / 8, r = nwg % 8, xcd = wgid % 8, off = wgid / 8; wgid = (xcd < r ? xcd * (q + 1) : r * (q + 1) + (xcd - r) * q) + off; }
        const int nig = 8 * nN, gid = wgid / nig, fm = gid * 8, gsz = (nM - fm) < 8 ? (nM - fm) : 8;
        u.pm = fm + ((wgid % nig) % gsz); u.pn = (wgid % nig) / gsz; u.ord = i; return true;
    }
};

template <class Epi, class Prob, bool ALIGN_EPI>
__device__ __forceinline__ void gemm_phase(LAS unsigned char* lds, const Prob& P, const Epi& E) {
    int tid = threadIdx.x; asm volatile("" : "+v"(tid));
    const int wid = __builtin_amdgcn_readfirstlane(tid >> 6), lane = tid & 63, wr = wid >> 2, wc = wid & 3, fr = lane & 15, fq = lane >> 4;
    constexpr int K = Prob::K, nt = K / BK;
    int Rs[2], Cs[2]; unsigned voffB[2];
#pragma unroll
    for (int i = 0; i < 2; ++i) { int R, C; stage_rc(tid * 16 + i * 8192, R, C); const int Rb = Epi::PERM ? ((R & ~31) + perm32(R & 31)) : R;
        Rs[i] = R; Cs[i] = C; voffB[i] = (unsigned)(Rb * K + C) * 2u; }
    constexpr size_t kstep = (size_t)(BK * 2);
    constexpr size_t hstepB = (size_t)HALF * K * 2;
    const unsigned ldsw = (unsigned)wid * 1024u;
    const int aoff = lds_byte(wr * 64 + fr, fq * 8), boff = lds_byte(wc * 32 + fr, fq * 8);
#define PG8_SA(b, h) (((b) * 2 + (h)) * HTB)
#define PG8_SB(b, h) ((4 + (b) * 2 + (h)) * HTB)
#define PG8_STAGE(bufoff, gbase, voff) do { _Pragma("unroll") for (int _i = 0; _i < 2; ++_i) \
        __builtin_amdgcn_global_load_lds((const unsigned*)((const char*)(gbase) + (voff)[_i]), (LAS unsigned*)(lds + (bufoff) + ldsw + _i * 8192), 16, 0, 0); } while (0)
#define PG8_LDA(dst, b, h) do { _Pragma("unroll") for (int m = 0; m < 4; ++m) _Pragma("unroll") for (int k = 0; k < 2; ++k) dst[m][k] = *(const LAS bf16x8*)(lds + PG8_SA(b, h) + aoff + m * 2048 + k * 1024); } while (0)
#define PG8_LDB(dst, b, h) do { _Pragma("unroll") for (int n = 0; n < 2; ++n) _Pragma("unroll") for (int k = 0; k < 2; ++k) dst[n][k] = *(const LAS bf16x8*)(lds + PG8_SB(b, h) + boff + n * 2048 + k * 1024); } while (0)
#define PG8_MMA(ai, bj, At, Bt) do { __builtin_amdgcn_s_setprio(1); _Pragma("unroll") for (int m = 0; m < 4; ++m) _Pragma("unroll") for (int n = 0; n < 2; ++n) _Pragma("unroll") for (int k = 0; k < 2; ++k) \
        acc[ai][bj][m][n] = __builtin_amdgcn_mfma_f32_16x16x32_bf16(Bt[n][k], At[m][k], acc[ai][bj][m][n], 0, 0, 0); __builtin_amdgcn_s_setprio(0); } while (0)
#define PG8_WAIT_V(n) asm volatile("s_waitcnt vmcnt(" #n ")" ::: "memory")
#define PG8_WAIT_L(n) asm volatile("s_waitcnt lgkmcnt(" #n ")" ::: "memory")
#define PG8_BAR __builtin_amdgcn_s_barrier()
#define PG8_SCHED __builtin_amdgcn_sched_barrier(0)
    Unit cur, nxt; int ui = 0;
    if (!P.next(0, cur)) return;
    unsigned vAc[2][2], vAn[2][2];
    P.a_voff(cur, Rs, Cs, vAc);
    f32x4 acc[2][2][4][2];
#pragma unroll
    for (int a = 0; a < 2; ++a)
#pragma unroll
        for (int b = 0; b < 2; ++b)
#pragma unroll
            for (int m = 0; m < 4; ++m)
#pragma unroll
                for (int n = 0; n < 2; ++n) acc[a][b][m][n] = (f32x4){0.f, 0.f, 0.f, 0.f};
    bf16x8 At[4][2], B0[2][2], B1[2][2];
    const char* cA = P.a_base(cur); const char* cB = P.b_base(cur);
    PG8_STAGE(PG8_SB(0, 0), cB, voffB); PG8_STAGE(PG8_SB(0, 1), cB + hstepB, voffB); PG8_STAGE(PG8_SA(0, 0), cA, vAc[0]); PG8_STAGE(PG8_SA(0, 1), cA, vAc[1]);
    if (wr == 1) PG8_BAR;
    PG8_WAIT_V(2); PG8_BAR;
    PG8_STAGE(PG8_SB(1, 0), cB + kstep, voffB); PG8_STAGE(PG8_SA(1, 0), cA + kstep, vAc[0]); PG8_STAGE(PG8_SB(1, 1), cB + hstepB + kstep, voffB);
    PG8_WAIT_V(6); PG8_BAR;
    for (;;) {
        const bool has_next = P.next(ui + 1, nxt);
        const char* nA = has_next ? P.a_base(nxt) : cA; const char* nB = has_next ? P.b_base(nxt) : cB;
        if constexpr (Prob::GATHER) { if (has_next) P.a_voff(nxt, Rs, Cs, vAn);
          else { vAn[0][0] = vAc[0][0]; vAn[0][1] = vAc[0][1]; vAn[1][0] = vAc[1][0]; vAn[1][1] = vAc[1][1]; } }
        for (int t = 0; t < nt; t += 2) {
            const bool last = (t == nt - 2);
            const char* a1 = cA + (size_t)(t + 1) * kstep;
            const char* a2 = last ? nA : cA + (size_t)(t + 2) * kstep; const char* b2 = last ? nB : cB + (size_t)(t + 2) * kstep;
            const char* a3 = a2 + kstep; const char* b3 = b2 + kstep;
            unsigned va2[2][2];
            if constexpr (Prob::GATHER) { va2[0][0] = last ? vAn[0][0] : vAc[0][0]; va2[0][1] = last ? vAn[0][1] : vAc[0][1]; va2[1][0] = last ? vAn[1][0] : vAc[1][0]; va2[1][1] = last ? vAn[1][1] : vAc[1][1]; }
            else { va2[0][0] = vAc[0][0]; va2[0][1] = vAc[0][1]; va2[1][0] = vAc[1][0]; va2[1][1] = vAc[1][1]; }
            PG8_LDB(B0, 0, 0); PG8_LDB(B1, 0, 1); PG8_SCHED; PG8_LDA(At, 0, 0); PG8_STAGE(PG8_SA(1, 1), a1, vAc[1]);
            PG8_WAIT_V(8); PG8_WAIT_L(0); PG8_BAR; PG8_MMA(0, 0, At, B0); PG8_MMA(0, 1, At, B1); PG8_BAR; PG8_SCHED;
            PG8_LDA(At, 0, 1); PG8_STAGE(PG8_SB(0, 0), b2, voffB); PG8_STAGE(PG8_SB(0, 1), b2 + hstepB, voffB); PG8_STAGE(PG8_SA(0, 0), a2, va2[0]);
            PG8_WAIT_V(8); PG8_WAIT_L(0); PG8_BAR; PG8_MMA(1, 0, At, B0); PG8_MMA(1, 1, At, B1); PG8_BAR; PG8_SCHED;
            PG8_LDB(B0, 1, 0); PG8_LDB(B1, 1, 1); PG8_SCHED; PG8_LDA(At, 1, 0); PG8_STAGE(PG8_SA(0, 1), a2, va2[1]);
            PG8_WAIT_V(8); PG8_WAIT_L(0); PG8_BAR; PG8_MMA(0, 0, At, B0); PG8_MMA(0, 1, At, B1); PG8_BAR; PG8_SCHED;
            PG8_LDA(At, 1, 1); PG8_STAGE(PG8_SB(1, 0), b3, voffB); PG8_STAGE(PG8_SB(1, 1), b3 + hstepB, voffB); PG8_STAGE(PG8_SA(1, 0), a3, va2[0]);
            PG8_WAIT_V(8); PG8_WAIT_L(0); PG8_BAR; PG8_MMA(1, 0, At, B0); PG8_MMA(1, 1, At, B1); PG8_BAR; PG8_SCHED;
        }
        if constexpr (ALIGN_EPI) { if (wr == 0) PG8_BAR; }
        E(acc, cur, wr, wc, fr, fq);
        if (!has_next) break;
#pragma unroll
        for (int a = 0; a < 2; ++a)
#pragma unroll
            for (int b = 0; b < 2; ++b)
#pragma unroll
                for (int m = 0; m < 4; ++m)
#pragma unroll
                    for (int n = 0; n < 2; ++n) acc[a][b][m][n] = (f32x4){0.f, 0.f, 0.f, 0.f};
        cur = nxt; cA = nA; cB = nB; ++ui;
        if constexpr (Prob::GATHER) { vAc[0][0] = vAn[0][0]; vAc[0][1] = vAn[0][1]; vAc[1][0] = vAn[1][0]; vAc[1][1] = vAn[1][1]; }
        if constexpr (ALIGN_EPI) { if (wr == 1) PG8_BAR; }
    }
    PG8_WAIT_V(0);
    if constexpr (!ALIGN_EPI) { if (wr == 0) PG8_BAR; }
    PG8_BAR;
#undef PG8_SA
#undef PG8_SB
#undef PG8_STAGE
#undef PG8_LDA
#undef PG8_LDB
#undef PG8_MMA
#undef PG8_WAIT_V
#undef PG8_WAIT_L
#undef PG8_BAR
#undef PG8_SCHED
}
typedef int v8i_g __attribute__((ext_vector_type(8)));
__device__ __forceinline__ void glds_saddr(const void* sbase, unsigned voff, unsigned lds_dst) { unsigned keep;
    asm volatile("s_mov_b32 %0, m0\n\ts_mov_b32 m0, %3\n\ts_nop 0\n\tglobal_load_lds_dwordx4 %2, %1\n\ts_mov_b32 m0, %0" : "=&s"(keep) : "s"(sbase), "v"(voff), "s"(lds_dst) : "memory"); }
template <class Epi, class Prob, bool ALIGN_EPI>
__device__ __forceinline__ void gemm_phase8(LAS unsigned char* lds, const Prob& P, const Epi& E) {
    int tid = threadIdx.x; asm volatile("" : "+v"(tid));
    const int wid = __builtin_amdgcn_readfirstlane(tid >> 6), lane = tid & 63, wr = wid >> 2, wc = wid & 3, fr = lane & 15, fq = lane >> 4;
    constexpr int K = Prob::K, nt = K / 128;
    int Rs[2], Cs[2]; unsigned voffB[2];
#pragma unroll
    for (int i = 0; i < 2; ++i) { int R, C; stage_rc(tid * 16 + i * 8192, R, C); const int Rb = Epi::PERM ? ((R & ~31) + perm32(R & 31)) : R;
        Rs[i] = R; Cs[i] = C; voffB[i] = (unsigned)(Rb * K + C * 2); }
    constexpr size_t kstep = (size_t)128;
    constexpr size_t hstepB = (size_t)HALF * K, hstepA = (size_t)HALF * K;
    const unsigned ldsw = (unsigned)wid * 1024u; const unsigned lds0 = (unsigned)__builtin_amdgcn_readfirstlane((int)(uintptr_t)lds);
    const int aoff = lds_byte(wr * 64 + fr, fq * 16), boff = lds_byte(wc * 32 + fr, fq * 16);
#define PG8_SA(b, h) (((b) * 2 + (h)) * HTB)
#define PG8_SB(b, h) ((4 + (b) * 2 + (h)) * HTB)
#define PG8_STAGE(bufoff, gbase, voff) do { _Pragma("unroll") for (int _i = 0; _i < 2; ++_i) glds_saddr((const void*)(gbase), (voff)[_i], lds0 + (unsigned)((bufoff) + _i * 8192) + ldsw); } while (0)
#define PG8_STAGE_A1(bufoff, gbase, vo) do { if constexpr (Prob::GATHER) { PG8_STAGE(bufoff, gbase, (vo)[1]); } else { PG8_STAGE(bufoff, (gbase) + hstepA, (vo)[0]); } } while (0)
#define PG8_LDA(dst, b, h) do { _Pragma("unroll") for (int m = 0; m < 4; ++m) dst[m] = *(const LAS v8i_g*)(lds + PG8_SA(b, h) + aoff + m * 2048); } while (0)
#define PG8_LDB(dst, b, h) do { _Pragma("unroll") for (int n = 0; n < 2; ++n) dst[n] = *(const LAS v8i_g*)(lds + PG8_SB(b, h) + boff + n * 2048); } while (0)
#define PG8_MMA(ai, bj, At, Bt) do { __builtin_amdgcn_s_setprio(1); _Pragma("unroll") for (int m = 0; m < 4; ++m) _Pragma("unroll") for (int n = 0; n < 2; ++n) \
        acc[ai][bj][m][n] = __builtin_amdgcn_mfma_scale_f32_16x16x128_f8f6f4(Bt[n], At[m], acc[ai][bj][m][n], 0, 0, 0, 0, 0, 0); __builtin_amdgcn_s_setprio(0); } while (0)
#define PG8_WAIT_V(n) asm volatile("s_waitcnt vmcnt(" #n ")" ::: "memory")
#define PG8_WAIT_L(n) asm volatile("s_waitcnt lgkmcnt(" #n ")" ::: "memory")
#define PG8_BAR __builtin_amdgcn_s_barrier()
#define PG8_SCHED __builtin_amdgcn_sched_barrier(0)
    Unit cur, nxt; int ui = 0;
    if (!P.next(0, cur)) return;
    unsigned vAc[2][2];
    P.a_voff(cur, Rs, Cs, vAc);
    f32x4 acc[2][2][4][2];
#pragma unroll
    for (int a = 0; a < 2; ++a)
#pragma unroll
        for (int b = 0; b < 2; ++b)
#pragma unroll
            for (int m = 0; m < 4; ++m)
#pragma unroll
                for (int n = 0; n < 2; ++n) acc[a][b][m][n] = (f32x4){0.f, 0.f, 0.f, 0.f};
    v8i_g At[4], B0[2], B1[2];
    const char* cA = P.a_base(cur); const char* cB = P.b_base(cur);
    PG8_STAGE(PG8_SB(0, 0), cB, voffB); PG8_STAGE(PG8_SB(0, 1), cB + hstepB, voffB); PG8_STAGE(PG8_SA(0, 0), cA, vAc[0]); PG8_STAGE_A1(PG8_SA(0, 1), cA, vAc);
    if (wr == 1) PG8_BAR;
    PG8_WAIT_V(2); PG8_BAR;
    PG8_STAGE(PG8_SB(1, 0), cB + kstep, voffB); PG8_STAGE(PG8_SA(1, 0), cA + kstep, vAc[0]); PG8_STAGE(PG8_SB(1, 1), cB + hstepB + kstep, voffB);
    PG8_WAIT_V(6); PG8_BAR;
    for (;;) {
        const bool has_next = P.next(ui + 1, nxt);
        const char* nA = has_next ? P.a_base(nxt) : cA; const char* nB = has_next ? P.b_base(nxt) : cB;
        unsigned va2[2][2];
#pragma nounroll
        for (int t = 0; t < nt; t += 2) {
            const bool last = (t == nt - 2);
            const char* a1 = cA + (size_t)(t + 1) * kstep;
            const char* a2 = last ? nA : cA + (size_t)(t + 2) * kstep; const char* b2 = last ? nB : cB + (size_t)(t + 2) * kstep;
            const char* a3 = a2 + kstep; const char* b3 = b2 + kstep;
            va2[0][0] = vAc[0][0]; va2[0][1] = vAc[0][1]; va2[1][0] = vAc[1][0]; va2[1][1] = vAc[1][1];
            if constexpr (Prob::GATHER) { if (last && has_next) { int Rn[2], Cn[2];
                int t2_ = tid; asm volatile("" : "+v"(t2_));
#pragma unroll
                for (int i = 0; i < 2; ++i) stage_rc(t2_ * 16 + i * 8192, Rn[i], Cn[i]);
                P.a_voff(nxt, Rn, Cn, va2); } }
            PG8_LDB(B0, 0, 0); PG8_LDB(B1, 0, 1); PG8_SCHED; PG8_LDA(At, 0, 0); PG8_STAGE_A1(PG8_SA(1, 1), a1, vAc);
            PG8_WAIT_V(8); PG8_WAIT_L(0); PG8_BAR; PG8_MMA(0, 0, At, B0); PG8_MMA(0, 1, At, B1); PG8_BAR; PG8_SCHED;
            PG8_LDA(At, 0, 1); PG8_STAGE(PG8_SB(0, 0), b2, voffB); PG8_STAGE(PG8_SB(0, 1), b2 + hstepB, voffB); PG8_STAGE(PG8_SA(0, 0), a2, va2[0]);
            PG8_WAIT_V(8); PG8_WAIT_L(0); PG8_BAR; PG8_MMA(1, 0, At, B0); PG8_MMA(1, 1, At, B1); PG8_BAR; PG8_SCHED;
            PG8_LDB(B0, 1, 0); PG8_LDB(B1, 1, 1); PG8_SCHED; PG8_LDA(At, 1, 0); PG8_STAGE_A1(PG8_SA(0, 1), a2, va2);
            PG8_WAIT_V(8); PG8_WAIT_L(0); PG8_BAR; PG8_MMA(0, 0, At, B0); PG8_MMA(0, 1, At, B1); PG8_BAR; PG8_SCHED;
            PG8_LDA(At, 1, 1); PG8_STAGE(PG8_SB(1, 0), b3, voffB); PG8_STAGE(PG8_SB(1, 1), b3 + hstepB, voffB); PG8_STAGE(PG8_SA(1, 0), a3, va2[0]);
            PG8_WAIT_V(8); PG8_WAIT_L(0); PG8_BAR; PG8_MMA(1, 0, At, B0); PG8_MMA(1, 1, At, B1); PG8_BAR; PG8_SCHED;
        }
        if constexpr (ALIGN_EPI) { if (wr == 0) PG8_BAR; }
        { int t3_ = tid; asm volatile("" : "+v"(t3_)); const int l3_ = t3_ & 63;
          E(acc, cur, wr, wc, l3_ & 15, l3_ >> 4); }
        if (!has_next) break;
#pragma unroll
        for (int a = 0; a < 2; ++a)
#pragma unroll
            for (int b = 0; b < 2; ++b)
#pragma unroll
                for (int m = 0; m < 4; ++m)
#pragma unroll
                    for (int n = 0; n < 2; ++n) acc[a][b][m][n] = (f32x4){0.f, 0.f, 0.f, 0.f};
        cur = nxt; cA = nA; cB = nB; ++ui;
        if constexpr (Prob::GATHER) { vAc[0][0] = va2[0][0]; vAc[0][1] = va2[0][1]; vAc[1][0] = va2[1][0]; vAc[1][1] = va2[1][1]; }
        if constexpr (ALIGN_EPI) { if (wr == 1) PG8_BAR; }
    }
    PG8_WAIT_V(0);
    if constexpr (!ALIGN_EPI) { if (wr == 0) PG8_BAR; }
    PG8_BAR;
#undef PG8_SA
#undef PG8_SB
#undef PG8_STAGE
#undef PG8_STAGE_A1
#undef PG8_LDA
#undef PG8_LDB
#undef PG8_MMA
#undef PG8_WAIT_V
#undef PG8_WAIT_L
#undef PG8_BAR
#undef PG8_SCHED
}

template <int K_> struct DenseProb {
    static constexpr int K = K_; static constexpr bool GATHER = false;
    const bf16_t* A; const bf16_t* Bt; StaticOrder S;
    __device__ __forceinline__ bool next(int i, Unit& u) const { return S.next(i, u); }
    __device__ __forceinline__ const char* a_base(const Unit& u) const { return (const char*)(A + (size_t)u.pm * BM * K); }
    __device__ __forceinline__ const char* b_base(const Unit& u) const { return (const char*)(Bt + (size_t)u.pn * BM * K); }
    __device__ __forceinline__ void a_voff(const Unit&, const int (&Rs)[2], const int (&Cs)[2], unsigned (&vo)[2][2]) const {
#pragma unroll
        for (int h = 0; h < 2; ++h)
#pragma unroll
            for (int i = 0; i < 2; ++i) vo[h][i] = (unsigned)((h * HALF + Rs[i]) * K + Cs[i]) * 2u;
    }
};
template <int K_, int PMAP, int EB> struct MapProb {
    static constexpr int K = K_; static constexpr bool GATHER = false;
    const unsigned char* A; const unsigned char* Bt; StaticOrder S;
    __device__ __forceinline__ bool next(int i, Unit& u) const { const bool ok = S.next(i, u); if (PMAP == 1) u.pn = u.pn < 6 ? u.pn : u.pn + 6; if (PMAP == 2) u.pn += 6; return ok; }
    __device__ __forceinline__ const char* a_base(const Unit& u) const { return (const char*)(A + (size_t)u.pm * BM * K * EB); }
    __device__ __forceinline__ const char* b_base(const Unit& u) const { return (const char*)(Bt + (size_t)u.pn * BM * K * EB); }
    __device__ __forceinline__ void a_voff(const Unit&, const int (&Rs)[2], const int (&Cs)[2], unsigned (&vo)[2][2]) const {
#pragma unroll
        for (int h = 0; h < 2; ++h)
#pragma unroll
            for (int i = 0; i < 2; ++i) vo[h][i] = (unsigned)((h * HALF + Rs[i]) * K * EB + Cs[i] * 2);
    }
};
__device__ __forceinline__ bool moe_unit(int i, int G, int vcu, Unit& u, int& e, int& b) {
    const int L = i * G + vcu; if (L >= 2048) return false;
    const int x = (L & 255) >> 5, w = L & 31, r = L >> 8;
    e = 2 * x + (r >> 2); b = r & 3; u.pm = (b * NEXP + e) * 4 + (w >> 3); u.pn = w & 7; u.ord = i; return true;
}
struct GuProb {
    static constexpr int K = DM; static constexpr bool GATHER = true;
    const bf16_t* H2; const bf16_t* W; const LAS unsigned* rowoff; int G, vcu;
    __device__ __forceinline__ bool next(int i, Unit& u) const { int e, b; return moe_unit(i, G, vcu, u, e, b); }
    __device__ __forceinline__ const char* a_base(const Unit& u) const { const int b = (u.pm >> 2) / NEXP; return (const char*)(H2 + (size_t)b * SEQ * DM); }
    __device__ __forceinline__ const char* b_base(const Unit& u) const { const int e = (u.pm >> 2) % NEXP; return (const char*)(W + ((size_t)e * 2048 + (size_t)u.pn * BM) * DM); }
    __device__ __forceinline__ void a_voff(const Unit& u, const int (&Rs)[2], const int (&Cs)[2], unsigned (&vo)[2][2]) const {
#pragma unroll
        for (int h = 0; h < 2; ++h)
#pragma unroll
            for (int i = 0; i < 2; ++i) vo[h][i] = rowoff[u.ord * 256 + h * HALF + Rs[i]] + (unsigned)Cs[i] * 2u;
    }
};
struct DownProb {
    static constexpr int K = DFF; static constexpr bool GATHER = false;
    const bf16_t* HID; const bf16_t* W; int G, vcu;
    __device__ __forceinline__ bool next(int i, Unit& u) const { int e, b; return moe_unit(i, G, vcu, u, e, b); }
    __device__ __forceinline__ const char* a_base(const Unit& u) const { return (const char*)(HID + (size_t)u.pm * BM * DFF); }
    __device__ __forceinline__ const char* b_base(const Unit& u) const { const int e = (u.pm >> 2) % NEXP; return (const char*)(W + ((size_t)e * 2048 + (size_t)u.pn * BM) * DFF); }
    __device__ __forceinline__ void a_voff(const Unit&, const int (&Rs)[2], const int (&Cs)[2], unsigned (&vo)[2][2]) const {
#pragma unroll
        for (int h = 0; h < 2; ++h)
#pragma unroll
            for (int i = 0; i < 2; ++i) vo[h][i] = (unsigned)((h * HALF + Rs[i]) * DFF + Cs[i]) * 2u;
    }
};

struct GuProb8 {
    static constexpr int K = DM; static constexpr bool GATHER = true;
    const unsigned char* H2; const unsigned char* W; const LAS unsigned* rowoff; int G, vcu;
    __device__ __forceinline__ bool next(int i, Unit& u) const { int e, b; return moe_unit(i, G, vcu, u, e, b); }
    __device__ __forceinline__ const char* a_base(const Unit& u) const { const int b = (u.pm >> 2) / NEXP; return (const char*)(H2 + (size_t)b * SEQ * DM); }
    __device__ __forceinline__ const char* b_base(const Unit& u) const { const int e = (u.pm >> 2) % NEXP; return (const char*)(W + ((size_t)e * 2048 + (size_t)u.pn * BM) * DM); }
    __device__ __forceinline__ void a_voff(const Unit& u, const int (&Rs)[2], const int (&Cs)[2], unsigned (&vo)[2][2]) const {
#pragma unroll
        for (int h = 0; h < 2; ++h)
#pragma unroll
            for (int i = 0; i < 2; ++i) vo[h][i] = rowoff[u.ord * 256 + h * HALF + Rs[i]] + (unsigned)Cs[i] * 2u;
    }
};
struct DownProb8 {
    static constexpr int K = DFF; static constexpr bool GATHER = false;
    const unsigned char* HID; const unsigned char* W; int G, vcu;
    __device__ __forceinline__ bool next(int i, Unit& u) const { int e, b; return moe_unit(i, G, vcu, u, e, b); }
    __device__ __forceinline__ const char* a_base(const Unit& u) const { return (const char*)(HID + (size_t)u.pm * BM * DFF); }
    __device__ __forceinline__ const char* b_base(const Unit& u) const { const int e = (u.pm >> 2) % NEXP; return (const char*)(W + ((size_t)e * 2048 + (size_t)u.pn * BM) * DFF); }
    __device__ __forceinline__ void a_voff(const Unit&, const int (&Rs)[2], const int (&Cs)[2], unsigned (&vo)[2][2]) const {
#pragma unroll
        for (int h = 0; h < 2; ++h)
#pragma unroll
            for (int i = 0; i < 2; ++i) vo[h][i] = (unsigned)((h * HALF + Rs[i]) * DFF + Cs[i] * 2);
    }
};
typedef const f32x4 (&AccRef)[2][2][4][2];
struct EpiInProj {
    static constexpr bool PERM = true;
    bf16_t *QA, *KA, *VA, *QB, *KB, *VB, *GA, *GB; const float* bgate; float oscale;
    __device__ __forceinline__ void operator()(AccRef acc, const Unit& u, int wr, int wc, int fr, int fq) const {
        const int pn = u.pn; bf16_t* base; int ldc, colt; bool gate = false;
        if (pn < 4) { base = QA; ldc = QW; colt = pn * 256; }
        else if (pn == 4) { base = KA; ldc = KVW; colt = 0; }
        else if (pn == 5) { base = VA; ldc = KVW; colt = 0; }
        else if (pn < 10) { base = QB; ldc = QW; colt = (pn - 6) * 256; }
        else if (pn == 10) { base = KB; ldc = KVW; colt = 0; }
        else if (pn == 11) { base = VB; ldc = KVW; colt = 0; }
        else if (pn < 20) { base = GA; ldc = DM; colt = (pn - 12) * 256; gate = true; }
        else { base = GB; ldc = DM; colt = (pn - 20) * 256; gate = true; }
        const int row0 = u.pm * BM + wr * 64 + fr, col0 = colt + wc * 32 + 8 * fq;
        f32x4 bv[2][2];
#pragma unroll
        for (int bj = 0; bj < 2; ++bj)
#pragma unroll
            for (int n = 0; n < 2; ++n) bv[bj][n] = gate ? *(const f32x4*)(bgate + (pn - 12) * 256 + wc * 32 + 8 * fq + bj * HALF + 4 * n) : (f32x4){0.f, 0.f, 0.f, 0.f};
#pragma unroll
        for (int ai = 0; ai < 2; ++ai)
#pragma unroll
            for (int m = 0; m < 4; ++m) { bf16_t* rowp = base + (size_t)(row0 + ai * HALF + m * 16) * ldc + col0;
#pragma unroll
                for (int bj = 0; bj < 2; ++bj) { f32x4 v0 = acc[ai][bj][m][0] * oscale + bv[bj][0], v1 = acc[ai][bj][m][1] * oscale + bv[bj][1];
                    if (gate) {
#pragma unroll
                        for (int j = 0; j < 4; ++j) { v0[j] = sigmoidf_fast(v0[j]); v1[j] = sigmoidf_fast(v1[j]); } }
                    u32x4 w; w.x = cvt_pk_bf16(v0[0], v0[1]); w.y = cvt_pk_bf16(v0[2], v0[3]); w.z = cvt_pk_bf16(v1[0], v1[1]); w.w = cvt_pk_bf16(v1[2], v1[3]);
                    *(u32x4*)(rowp + bj * HALF) = w; } }
    }
};
template <int MODE> struct EpiGated {
    static constexpr bool PERM = true;
    bf16_t* G1; const bf16_t* G2; float oscale;
    __device__ __forceinline__ void operator()(AccRef acc, const Unit& u, int wr, int wc, int fr, int fq) const {
        const int row0 = u.pm * BM + wr * 64 + fr, col0 = u.pn * BM + wc * 32 + 8 * fq;
#pragma unroll
        for (int ai = 0; ai < 2; ++ai)
#pragma unroll
            for (int m = 0; m < 4; ++m) { const size_t off = (size_t)(row0 + ai * HALF + m * 16) * DM + col0;
#pragma unroll
                for (int bj = 0; bj < 2; ++bj) {
                    const bf16x8 g1 = (MODE == 2) ? (bf16x8){0, 0, 0, 0, 0, 0, 0, 0} : *(const bf16x8*)(G1 + off + bj * HALF);
                    bf16x8 g2 = g1; if (MODE >= 1) g2 = *(const bf16x8*)(G2 + off + bj * HALF);
                    float o[8];
#pragma unroll
                    for (int j = 0; j < 8; ++j) { const float a = acc[ai][bj][m][j >> 2][j & 3] * oscale;
                        if (MODE == 0) o[j] = bf2f((unsigned short)g1[j]) * a;
                        else if (MODE == 1) o[j] = bf2f((unsigned short)g1[j]) + bf2f((unsigned short)g2[j]) * a;
                        else o[j] = bf2f((unsigned short)g2[j]) * a; }
                    u32x4 w; w.x = cvt_pk_bf16(o[0], o[1]); w.y = cvt_pk_bf16(o[2], o[3]); w.z = cvt_pk_bf16(o[4], o[5]); w.w = cvt_pk_bf16(o[6], o[7]);
                    *(u32x4*)(G1 + off + bj * HALF) = w; } }
    }
};
template <int MODE> struct EpiGated8 {
    static constexpr bool PERM = true;
    bf16_t* G1; const bf16_t* G2; unsigned char* M8; float oscale;
    __device__ __forceinline__ void operator()(AccRef acc, const Unit& u, int wr, int wc, int fr, int fq) const {
        const int row0 = u.pm * BM + wr * 64 + fr, col0 = u.pn * BM + wc * 32 + 8 * fq;
#pragma unroll
        for (int ai = 0; ai < 2; ++ai)
#pragma unroll
            for (int m = 0; m < 4; ++m) { const unsigned off = (unsigned)((row0 + ai * HALF + m * 16) * DM + col0);
#pragma unroll
                for (int bj = 0; bj < 2; ++bj) {
                    const bf16x8 g1 = *(const bf16x8*)(G1 + off + bj * HALF);
                    bf16x8 g2 = g1; if (MODE == 1) g2 = *(const bf16x8*)(G2 + off + bj * HALF);
                    float o[8];
#pragma unroll
                    for (int j = 0; j < 8; ++j) { const float a = acc[ai][bj][m][j >> 2][j & 3] * oscale;
                        if (MODE == 0) o[j] = bf2f((unsigned short)g1[j]) * a; else o[j] = (bf2f((unsigned short)g1[j]) + bf2f((unsigned short)g2[j]) * a) * M8S; }
                    if (MODE == 0) { u32x4 w; w.x = cvt_pk_bf16(o[0], o[1]); w.y = cvt_pk_bf16(o[2], o[3]); w.z = cvt_pk_bf16(o[4], o[5]); w.w = cvt_pk_bf16(o[6], o[7]); *(u32x4*)(G1 + off + bj * HALF) = w; }
                    else { int w0 = 0, w1 = 0; w0 = __builtin_amdgcn_cvt_pk_fp8_f32(o[0], o[1], w0, false); w0 = __builtin_amdgcn_cvt_pk_fp8_f32(o[2], o[3], w0, true);
                        w1 = __builtin_amdgcn_cvt_pk_fp8_f32(o[4], o[5], w1, false); w1 = __builtin_amdgcn_cvt_pk_fp8_f32(o[6], o[7], w1, true);
                        *(u32x2*)(M8 + off + bj * HALF) = (u32x2){(unsigned)w0, (unsigned)w1}; } }
                asm volatile("" ::: "memory"); }
    }
};
struct EpiAtt {
    static constexpr bool PERM = true;
    bf16_t* O; float oscale;
    __device__ __forceinline__ void operator()(AccRef acc, const Unit& u, int wr, int wc, int fr, int fq) const {
        const int row0 = u.pm * BM + wr * 64 + fr, col0 = u.pn * BM + wc * 32 + 8 * fq;
#pragma unroll
        for (int ai = 0; ai < 2; ++ai)
#pragma unroll
            for (int m = 0; m < 4; ++m) { bf16_t* rowp = O + (size_t)(row0 + ai * HALF + m * 16) * DM + col0;
#pragma unroll
                for (int bj = 0; bj < 2; ++bj) { const f32x4 v0 = acc[ai][bj][m][0] * oscale, v1 = acc[ai][bj][m][1] * oscale;
                    u32x4 w; w.x = cvt_pk_bf16(v0[0], v0[1]); w.y = cvt_pk_bf16(v0[2], v0[3]); w.z = cvt_pk_bf16(v1[0], v1[1]); w.w = cvt_pk_bf16(v1[2], v1[3]);
                    *(u32x4*)(rowp + bj * HALF) = w; } }
    }
};
struct EpiSwiglu {
    static constexpr bool PERM = true;
    unsigned char* HID; float oscale;
    __device__ __forceinline__ void operator()(AccRef acc, const Unit& u, int wr, int wc, int fr, int fq) const {
        const int row0 = u.pm * BM + wr * 64 + fr, col0 = u.pn * HALF + wc * 32 + 8 * fq;
#pragma unroll
        for (int ai = 0; ai < 2; ++ai)
#pragma unroll
            for (int m = 0; m < 4; ++m) { float o[8];
#pragma unroll
                for (int j = 0; j < 8; ++j) { const float a = acc[ai][0][m][j >> 2][j & 3] * oscale, up = acc[ai][1][m][j >> 2][j & 3] * oscale; o[j] = a * sigmoidf_fast(a) * up; }
                int w0 = 0, w1 = 0; w0 = __builtin_amdgcn_cvt_pk_fp8_f32(o[0], o[1], w0, false); w0 = __builtin_amdgcn_cvt_pk_fp8_f32(o[2], o[3], w0, true);
                w1 = __builtin_amdgcn_cvt_pk_fp8_f32(o[4], o[5], w1, false); w1 = __builtin_amdgcn_cvt_pk_fp8_f32(o[6], o[7], w1, true);
                *(u32x2*)(HID + (size_t)(row0 + ai * HALF + m * 16) * DFF + col0) = (u32x2){(unsigned)w0, (unsigned)w1}; }
    }
};
struct EpiDown {
    static constexpr bool PERM = true;
    bf16_t* Y; const float* gatev; float oscale;
    __device__ __forceinline__ void operator()(AccRef acc, const Unit& u, int wr, int wc, int fr, int fq) const {
        const int row0 = u.pm * BM + wr * 64 + fr, col0 = u.pn * BM + wc * 32 + 8 * fq;
#pragma unroll
        for (int ai = 0; ai < 2; ++ai)
#pragma unroll
            for (int m = 0; m < 4; ++m) { const int row = row0 + ai * HALF + m * 16; const float g = gatev[row] * oscale;
#pragma unroll
                for (int bj = 0; bj < 2; ++bj) { const f32x4 v0 = acc[ai][bj][m][0] * g, v1 = acc[ai][bj][m][1] * g;
                    u32x4 w; w.x = cvt_pk_bf16(v0[0], v0[1]); w.y = cvt_pk_bf16(v0[2], v0[3]); w.z = cvt_pk_bf16(v1[0], v1[1]); w.w = cvt_pk_bf16(v1[2], v1[3]);
                    *(u32x4*)(Y + (size_t)row * DM + col0 + bj * HALF) = w; } }
    }
};
}

namespace att {
constexpr int D = 128, NW = 8, QBLK = 32, KVBLK = 64;
constexpr float SCALE = 0.088388347648318440f, C = SCALE * LOG2E;
constexpr float THR = 8.f;
constexpr int LDQ = QW, LDK = KVW;
constexpr int SHM_V = KVBLK * D * 2, SHM_K = KVBLK * D * 2;
constexpr int BUFB = SHM_V + SHM_K, NBUF = 4;
constexpr int OFF_WS = NBUF * BUFB, OFF_TAB = OFF_WS + NW * 64 * 4, LDS_END = OFF_TAB + 4 * 768 * 4, OFF_OST = 0;
static_assert(LDS_END <= LDS_SCRATCH, "attention LDS");
#define KSWZ(row, colB) ((row) * 256 + ((colB) ^ (((row) & 7) << 4)))
#define SBAR() __builtin_amdgcn_sched_barrier(0)
__device__ __forceinline__ int crow(int r, int hi) { return (r & 3) + 8 * (r >> 2) + 4 * hi; }
__device__ __forceinline__ unsigned cvtpk(float lo, float hi) { unsigned r; asm volatile("v_cvt_pk_bf16_f32 %0, %1, %2" : "=v"(r) : "v"(lo), "v"(hi)); return r; }

__device__ __forceinline__ void partialSM(f32x16& p0, f32x16& p1, float& m_reg, float& mn, float& alpha) {
  float pmax = p0[0];
#pragma unroll
  for (int r = 1; r < 16; ++r) pmax = fmaxf(pmax, p0[r]);
#pragma unroll
  for (int r = 0; r < 16; ++r) pmax = fmaxf(pmax, p1[r]);
  { auto rr = __builtin_amdgcn_permlane32_swap(__float_as_uint(pmax), __float_as_uint(pmax), false, false);
    pmax = fmaxf(__uint_as_float(rr[0]), __uint_as_float(rr[1])); }
  if (__builtin_expect(__all(pmax - m_reg <= THR / SCALE), 1)) { mn = m_reg; alpha = 1.f; }
  else { mn = fmaxf(m_reg, pmax); alpha = __builtin_amdgcn_exp2f((m_reg - mn) * C); m_reg = mn; }
  float mnC = -mn * C;
#pragma unroll
  for (int r = 0; r < 16; ++r) p0[r] = fmaf(p0[r], C, mnC);
#pragma unroll
  for (int r = 0; r < 16; ++r) p1[r] = fmaf(p1[r], C, mnC);
#pragma unroll
  for (int r = 0; r < 16; ++r) p0[r] = __builtin_amdgcn_exp2f(p0[r]);
}
__device__ __forceinline__ void partialSM_B(f32x16& p0, f32x16& p1, float& m_reg, float& mn, float& alpha, const float* tb) {
#pragma unroll
  for (int r = 0; r < 16; ++r) { const int o = (r & 3) + 8 * (r >> 2); p0[r] = fmaf(p0[r], C, tb[o]); p1[r] = fmaf(p1[r], C, tb[32 + o]); }
  float pmax = p0[0];
#pragma unroll
  for (int r = 1; r < 16; ++r) pmax = fmaxf(pmax, p0[r]);
#pragma unroll
  for (int r = 0; r < 16; ++r) pmax = fmaxf(pmax, p1[r]);
  { auto rr = __builtin_amdgcn_permlane32_swap(__float_as_uint(pmax), __float_as_uint(pmax), false, false);
    pmax = fmaxf(__uint_as_float(rr[0]), __uint_as_float(rr[1])); }
  if (__builtin_expect(__all(pmax - m_reg <= THR * LOG2E), 1)) { mn = m_reg; alpha = 1.f; }
  else { mn = fmaxf(m_reg, pmax); alpha = __builtin_amdgcn_exp2f(m_reg - mn); m_reg = mn; }
#pragma unroll
  for (int r = 0; r < 16; ++r) p0[r] = p0[r] - mn;
#pragma unroll
  for (int r = 0; r < 16; ++r) p1[r] = p1[r] - mn;
#pragma unroll
  for (int r = 0; r < 16; ++r) p0[r] = __builtin_amdgcn_exp2f(p0[r]);
}
__device__ __forceinline__ void finishSM(f32x16& p0, f32x16& p1, float alpha, float& l_reg, bf16x8& pa0, bf16x8& pa1, bf16x8& pa2, bf16x8& pa3) {
#pragma unroll
  for (int r = 0; r < 16; ++r) p1[r] = __builtin_amdgcn_exp2f(p1[r]);
  float ps = 0;
#pragma unroll
  for (int r = 0; r < 16; ++r) ps += p0[r];
#pragma unroll
  for (int r = 0; r < 16; ++r) ps += p1[r];
  { auto rr = __builtin_amdgcn_permlane32_swap(__float_as_uint(ps), __float_as_uint(ps), false, false);
    ps = __uint_as_float(rr[0]) + __uint_as_float(rr[1]); }
  l_reg = l_reg * alpha + ps;
#define PK4(P, BASE, OUT) do { unsigned a0 = cvtpk(P[BASE + 0], P[BASE + 1]), a1 = cvtpk(P[BASE + 2], P[BASE + 3]);   \
    unsigned b0 = cvtpk(P[BASE + 4], P[BASE + 5]), b1 = cvtpk(P[BASE + 6], P[BASE + 7]);                              \
    auto r0 = __builtin_amdgcn_permlane32_swap(a0, b0, false, false); auto r1 = __builtin_amdgcn_permlane32_swap(a1, b1, false, false); \
    u32x4 w = {r0[0], r1[0], r0[1], r1[1]}; OUT = *reinterpret_cast<bf16x8*>(&w); } while (0)
  PK4(p0, 0, pa0); PK4(p0, 8, pa1); PK4(p1, 0, pa2); PK4(p1, 8, pa3);
#undef PK4
}
__device__ __forceinline__ void qkt(f32x16& p0, f32x16& p1, const bf16_t* Ks, const bf16x8* qr, int r32, int hi, float init = 0.f) {
#pragma unroll
  for (int r = 0; r < 16; ++r) { p0[r] = init; p1[r] = init; }
#pragma unroll
  for (int d0 = 0; d0 < 8; ++d0) { int cb = (d0 * 16 + hi * 8) * 2;
    bf16x8 b0 = *reinterpret_cast<const bf16x8*>((const char*)Ks + KSWZ(r32, cb));
    bf16x8 b1 = *reinterpret_cast<const bf16x8*>((const char*)Ks + KSWZ(32 + r32, cb));
    p0 = __builtin_amdgcn_mfma_f32_32x32x16_bf16(b0, qr[d0], p0, 0, 0, 0);
    p1 = __builtin_amdgcn_mfma_f32_32x32x16_bf16(b1, qr[d0], p1, 0, 0, 0); }
}
__device__ __forceinline__ int v_st(int k, int c) { const int kk = (k & ~0xC) | ((k & 4) << 1) | ((k & 8) >> 1); return ((kk >> 3) * 4 + (c >> 5)) * 512 + ((kk & 7) * 32 + (c & 31)) * 2; }
__device__ __forceinline__ int v_rd_base(int lane) { return ((lane & 3) << 3) | (((lane >> 2) & 3) << 6) | (((lane >> 4) & 1) << 5) | (((lane >> 5) & 1) << 8); }
constexpr int v_rd_off(int d0, int ks, int half) { return d0 * 512 + ks * 4096 + half * 2048; }
template <int OFF> __device__ __forceinline__ s16x4 tr_read(int vb) {
  s16x4 r; asm volatile("ds_read_b64_tr_b16 %0, %1 offset:%2" : "=&v"(r) : "v"(vb), "i"(OFF) : "memory"); return r;
}
template <int D0> __device__ __forceinline__ void pv_one(f32x16& od, int vb, bf16x8 pa0, bf16x8 pa1, bf16x8 pa2, bf16x8 pa3) {
  const s16x4 l0 = tr_read<v_rd_off(D0, 0, 0)>(vb), h0 = tr_read<v_rd_off(D0, 0, 1)>(vb), l1 = tr_read<v_rd_off(D0, 1, 0)>(vb), h1 = tr_read<v_rd_off(D0, 1, 1)>(vb);
  const s16x4 l2 = tr_read<v_rd_off(D0, 2, 0)>(vb), h2 = tr_read<v_rd_off(D0, 2, 1)>(vb), l3 = tr_read<v_rd_off(D0, 3, 0)>(vb), h3 = tr_read<v_rd_off(D0, 3, 1)>(vb);
  asm volatile("s_waitcnt lgkmcnt(0)" ::: "memory"); SBAR();
#define PK(L, H) (bf16x8){L[0], L[1], L[2], L[3], H[0], H[1], H[2], H[3]}
  od = __builtin_amdgcn_mfma_f32_32x32x16_bf16(pa0, PK(l0, h0), od, 0, 0, 0);
  od = __builtin_amdgcn_mfma_f32_32x32x16_bf16(pa1, PK(l1, h1), od, 0, 0, 0);
  od = __builtin_amdgcn_mfma_f32_32x32x16_bf16(pa2, PK(l2, h2), od, 0, 0, 0);
  od = __builtin_amdgcn_mfma_f32_32x32x16_bf16(pa3, PK(l3, h3), od, 0, 0, 0);
#undef PK
}
__device__ __forceinline__ void pv_d0(f32x16* o, int vb, bf16x8 pa0, bf16x8 pa1, bf16x8 pa2, bf16x8 pa3) {
  pv_one<0>(o[0], vb, pa0, pa1, pa2, pa3); pv_one<1>(o[1], vb, pa0, pa1, pa2, pa3); pv_one<2>(o[2], vb, pa0, pa1, pa2, pa3); pv_one<3>(o[3], vb, pa0, pa1, pa2, pa3);
}
template <int MODE>
__device__ __forceinline__ void pv_psm(f32x16* o, int vb, bf16x8 pa0, bf16x8 pa1, bf16x8 pa2, bf16x8 pa3, f32x16& p0, f32x16& p1, float& m_reg, float& mn, float& alpha, const float* tb) {
  pv_one<0>(o[0], vb, pa0, pa1, pa2, pa3);
  if constexpr (MODE == 1) {
#pragma unroll
    for (int r = 0; r < 16; ++r) { const int of = (r & 3) + 8 * (r >> 2); p0[r] = fmaf(p0[r], C, tb[of]); p1[r] = fmaf(p1[r], C, tb[32 + of]); }
  }
  float pmax = p0[0];
#pragma unroll
  for (int r = 1; r < 16; ++r) pmax = fmaxf(pmax, p0[r]);
#pragma unroll
  for (int r = 0; r < 16; ++r) pmax = fmaxf(pmax, p1[r]);
  { auto rr = __builtin_amdgcn_permlane32_swap(__float_as_uint(pmax), __float_as_uint(pmax), false, false);
    pmax = fmaxf(__uint_as_float(rr[0]), __uint_as_float(rr[1])); }
  SBAR();
  pv_one<1>(o[1], vb, pa0, pa1, pa2, pa3);
  float sub;
  if constexpr (MODE == 0) {
    if (__builtin_expect(__all(pmax - m_reg <= THR / SCALE), 1)) { mn = m_reg; alpha = 1.f; }
    else { mn = fmaxf(m_reg, pmax); alpha = __builtin_amdgcn_exp2f((m_reg - mn) * C); m_reg = mn; }
    sub = -mn * C;
#pragma unroll
    for (int r = 0; r < 16; ++r) p0[r] = fmaf(p0[r], C, sub);
  } else {
    if (__builtin_expect(__all(pmax - m_reg <= THR * LOG2E), 1)) { mn = m_reg; alpha = 1.f; }
    else { mn = fmaxf(m_reg, pmax); alpha = __builtin_amdgcn_exp2f(m_reg - mn); m_reg = mn; }
    sub = -mn;
#pragma unroll
    for (int r = 0; r < 16; ++r) p0[r] = p0[r] + sub;
  }
  SBAR();
  pv_one<2>(o[2], vb, pa0, pa1, pa2, pa3);
#pragma unroll
  for (int r = 0; r < 16; ++r) { if constexpr (MODE == 0) p1[r] = fmaf(p1[r], C, sub); else p1[r] = p1[r] + sub; }
#pragma unroll
  for (int r = 0; r < 6; ++r) p0[r] = __builtin_amdgcn_exp2f(p0[r]);
  SBAR();
  pv_one<3>(o[3], vb, pa0, pa1, pa2, pa3);
#pragma unroll
  for (int r = 6; r < 16; ++r) p0[r] = __builtin_amdgcn_exp2f(p0[r]);
}
__device__ __forceinline__ f32x8 bf8_to_f32(bf16x8 v) { f32x8 r;
#pragma unroll
  for (int j = 0; j < 8; ++j) r[j] = bf2f((unsigned short)v[j]);
  return r; }
__device__ __forceinline__ bf16x8 f32_to_bf8(f32x8 x) { u32x4 w = {cvtpk(x[0], x[1]), cvtpk(x[2], x[3]), cvtpk(x[4], x[5]), cvtpk(x[6], x[7])}; return *reinterpret_cast<bf16x8*>(&w); }
__device__ __forceinline__ int t5_bucket(int rel) {
  const int n = rel < 0 ? -rel : rel; int bk;
  if (n < 8) bk = n; else if (n < 12) bk = 8; else if (n < 16) bk = 9; else if (n < 23) bk = 10; else if (n < 32) bk = 11; else if (n < 46) bk = 12; else if (n < 64) bk = 13; else if (n < 91) bk = 14; else bk = 15;
  return bk + (rel > 0 ? 16 : 0);
}
struct Aux { const float* cosT; const float* sinT; const float* qn; const float* kn; const float* relb; const float* sink; };

template <int MODE>
__device__ __forceinline__ void attn_unit(const bf16_t* Qb, const bf16_t* __restrict__ Kh, const bf16_t* __restrict__ Vh, bf16_t* Ob, int kbeg, int kend, int q0, int head, char* lds, const Aux& aux) {
  int tid = threadIdx.x; asm volatile("" : "+v"(tid));
  const int wid = tid >> 6, lane = tid & 63, r32 = lane & 31, hi = lane >> 5;
  char* V_lds = lds; char* K_lds = lds + SHM_V;
  float* ws = (float*)(lds + OFF_WS) + wid * 64; float* li_l = ws; float* al_l = ws + 32;
  float* tab = (float*)(lds + OFF_TAB);
  float m_reg = -1e30f, l_reg = 0; f32x16 o[4] = {}; bf16x8 qr[8];
  const bf16_t* Qw = Qb + (long)(wid * QBLK + r32) * LDQ + hi * 8;
#pragma unroll
  for (int d0 = 0; d0 < 8; ++d0) qr[d0] = *reinterpret_cast<const bf16x8*>(Qw + d0 * 16);
  if constexpr (MODE == 1) {
    for (int i = tid; i < 768; i += 512) { const int rel = i - 383, n = rel < 0 ? -rel : rel; float v = -1e30f; if (n <= 128) v = aux.relb[t5_bucket(rel) * NHB + head] * LOG2E; tab[i] = v; }
    m_reg = aux.sink[head] * LOG2E; l_reg = 1.0f;
  }
  const int tbase = kbeg - q0 - wid * QBLK - r32 + 383 + 4 * hi;
  const int sr = tid >> 4, sc = (tid & 15) * 8, vst0 = v_st(sr, sc), vst1 = v_st(32 + sr, sc);
  const int vb0 = (int)(uintptr_t)V_lds + v_rd_base(lane);
  struct { bf16x8 vs0, vs1, ks0, ks1; } sr_[2];
#define SLOAD(i, k0) do { sr_[i].vs0 = *reinterpret_cast<const bf16x8*>(&Vh[(long)(kbeg + (k0) + sr) * LDK + sc]); sr_[i].vs1 = *reinterpret_cast<const bf16x8*>(&Vh[(long)(kbeg + (k0) + 32 + sr) * LDK + sc]); \
    sr_[i].ks0 = *reinterpret_cast<const bf16x8*>(&Kh[(long)(kbeg + (k0) + sr) * LDK + sc]); sr_[i].ks1 = *reinterpret_cast<const bf16x8*>(&Kh[(long)(kbeg + (k0) + 32 + sr) * LDK + sc]); } while (0)
#define SWRITE(bo, i) do { *(bf16x8*)(V_lds + (bo) + vst0) = sr_[i].vs0;          \
    *(bf16x8*)(V_lds + (bo) + vst1) = sr_[i].vs1; int kc = sc * 2;               \
    *(bf16x8*)(K_lds + (bo) + KSWZ(sr, kc)) = sr_[i].ks0;                       \
    *(bf16x8*)(K_lds + (bo) + KSWZ(32 + sr, kc)) = sr_[i].ks1; } while (0)
#define SWAIT() asm volatile("s_waitcnt vmcnt(4)" ::: "memory")
#define RESC(a) do { if (__any((a) < 1.f)) { if (hi == 0) al_l[r32] = (a); asm volatile("s_waitcnt lgkmcnt(0)" ::: "memory"); \
    _Pragma("unroll") for (int d = 0; d < 4; ++d) _Pragma("unroll") for (int r = 0; r < 16; ++r) o[d][r] *= al_l[crow(r, hi)]; } } while (0)
#define PSM(P0, P1, MN, AL, j) do { if constexpr (MODE == 0) partialSM(P0, P1, m_reg, MN, AL); else partialSM_B(P0, P1, m_reg, MN, AL, tab + tbase + (j) * KVBLK); } while (0)
#define ROT() do { const int t_ = o_prev; o_prev = o_cur; o_cur = o_next; o_next = t_; } while (0)
  f32x16 pA0, pA1, pB0, pB1; float mnA, mnB, alA, alB; bf16x8 pa0, pa1, pa2, pa3; const int NT = (kend - kbeg) / KVBLK;
  constexpr int SE = 0, SO = 1;
  int o_prev = 2 * BUFB, o_cur = 0, o_next = BUFB;
  SLOAD(SE, 0); asm volatile("s_waitcnt vmcnt(0)" ::: "memory"); SWRITE(0, SE);
  SLOAD(SO, KVBLK); SLOAD(SE, 2 * KVBLK);
  __syncthreads();
  qkt(pA0, pA1, (const bf16_t*)(K_lds + o_cur), qr, r32, hi); PSM(pA0, pA1, mnA, alA, 0);
  SWAIT(); SWRITE(o_next, SO); RESC(alA); __syncthreads();
  ROT();
  for (int j = 1; j + 1 < NT; j += 2) {
    SBAR(); qkt(pB0, pB1, (const bf16_t*)(K_lds + o_cur), qr, r32, hi);
    finishSM(pA0, pA1, alA, l_reg, pa0, pa1, pa2, pa3); SBAR();
    SLOAD(SO, (j + 2) * KVBLK); SBAR();
    pv_psm<MODE>(o, vb0 + o_prev, pa0, pa1, pa2, pa3, pB0, pB1, m_reg, mnB, alB, tab + tbase + j * KVBLK);
    SWAIT(); SWRITE(o_next, SE);
    RESC(alB); __syncthreads(); ROT();
    SBAR(); qkt(pA0, pA1, (const bf16_t*)(K_lds + o_cur), qr, r32, hi);
    finishSM(pB0, pB1, alB, l_reg, pa0, pa1, pa2, pa3); SBAR();
    SLOAD(SE, (j + 3 < NT ? j + 3 : NT - 1) * KVBLK); SBAR();
    pv_psm<MODE>(o, vb0 + o_prev, pa0, pa1, pa2, pa3, pA0, pA1, m_reg, mnA, alA, tab + tbase + (j + 1) * KVBLK);
    SWAIT(); SWRITE(o_next, SO);
    RESC(alA); __syncthreads(); ROT();
  }
  SBAR(); qkt(pB0, pB1, (const bf16_t*)(K_lds + o_cur), qr, r32, hi);
  finishSM(pA0, pA1, alA, l_reg, pa0, pa1, pa2, pa3); SBAR();
  pv_psm<MODE>(o, vb0 + o_prev, pa0, pa1, pa2, pa3, pB0, pB1, m_reg, mnB, alB, tab + tbase + (NT - 1) * KVBLK);
  RESC(alB);
  finishSM(pB0, pB1, alB, l_reg, pa0, pa1, pa2, pa3); SBAR();
  pv_d0(o, vb0 + o_cur, pa0, pa1, pa2, pa3);
  if (hi == 0) li_l[r32] = l_reg; asm volatile("s_waitcnt lgkmcnt(0)" ::: "memory");
  float rli[16];
#pragma unroll
  for (int r = 0; r < 16; ++r) rli[r] = __builtin_amdgcn_rcpf(li_l[crow(r, hi)]);
  asm volatile("s_waitcnt vmcnt(0)" ::: "memory");
  __syncthreads();
  char* ost = lds + OFF_OST + wid * 8192;
#pragma unroll
  for (int r = 0; r < 16; ++r) { const int orow = crow(r, hi);
#pragma unroll
    for (int d0 = 0; d0 < 4; ++d0) *(unsigned short*)(ost + orow * 256 + (d0 * 32 + r32) * 2) = f2bf(o[d0][r] * rli[r]); }
  asm volatile("s_waitcnt lgkmcnt(0)" ::: "memory");
  bf16_t* Ow = Ob + (long)(wid * QBLK) * LDQ;
#pragma unroll
  for (int i = 0; i < 8; ++i) { const int ch = i * 64 + lane, row = ch >> 4, c16 = ch & 15;
    const u32x4 v = *(const u32x4*)(ost + row * 256 + c16 * 16); *(u32x4*)(Ow + (long)row * LDQ + c16 * 8) = v; }
  asm volatile("s_waitcnt lgkmcnt(0)" ::: "memory");
  __syncthreads();
#undef ROT
#undef SLOAD
#undef SWRITE
#undef SWAIT
#undef RESC
#undef PSM
}

template <int MODE>
__device__ __forceinline__ void softmax_tile(f32x16& p0, f32x16& p1, float& m_reg, float& l_reg, float& alpha, bf16x8& pa0, bf16x8& pa1, bf16x8& pa2, bf16x8& pa3, const float* tb) {
  if constexpr (MODE == 0) {
    alpha = 1.f;
    if (__builtin_expect(m_reg != 0.f, 0)) {
#pragma unroll
      for (int r = 0; r < 16; ++r) { p0[r] -= m_reg; p1[r] -= m_reg; } }
#pragma unroll
    for (int r = 0; r < 16; ++r) { p0[r] = __builtin_amdgcn_exp2f(p0[r]); p1[r] = __builtin_amdgcn_exp2f(p1[r]); }
  } else {
  if constexpr (MODE == 1) {
#pragma unroll
    for (int r = 0; r < 16; ++r) { const int of = (r & 3) + 8 * (r >> 2); p0[r] = fmaf(p0[r], C, tb[of]); p1[r] = fmaf(p1[r], C, tb[32 + of]); }
  }
  float pmax = p0[0];
#pragma unroll
  for (int r = 1; r < 16; ++r) pmax = fmaxf(pmax, p0[r]);
#pragma unroll
  for (int r = 0; r < 16; ++r) pmax = fmaxf(pmax, p1[r]);
  { auto rr = __builtin_amdgcn_permlane32_swap(__float_as_uint(pmax), __float_as_uint(pmax), false, false);
    pmax = fmaxf(__uint_as_float(rr[0]), __uint_as_float(rr[1])); }
  float mn, sub;
  if constexpr (MODE == 0) {
    if (__builtin_expect(__all(pmax - m_reg <= THR / SCALE), 1)) { mn = m_reg; alpha = 1.f; }
    else { mn = fmaxf(m_reg, pmax); alpha = __builtin_amdgcn_exp2f((m_reg - mn) * C); m_reg = mn; }
    sub = -mn * C;
#pragma unroll
    for (int r = 0; r < 16; ++r) { p0[r] = __builtin_amdgcn_exp2f(fmaf(p0[r], C, sub)); p1[r] = __builtin_amdgcn_exp2f(fmaf(p1[r], C, sub)); }
  } else {
    if (__builtin_expect(__all(pmax - m_reg <= THR * LOG2E), 1)) { mn = m_reg; alpha = 1.f; }
    else { mn = fmaxf(m_reg, pmax); alpha = __builtin_amdgcn_exp2f(m_reg - mn); m_reg = mn; }
    sub = -mn;
#pragma unroll
    for (int r = 0; r < 16; ++r) { p0[r] = __builtin_amdgcn_exp2f(p0[r] + sub); p1[r] = __builtin_amdgcn_exp2f(p1[r] + sub); }
  }
  }
  float ps = 0;
#pragma unroll
  for (int r = 0; r < 16; ++r) ps += p0[r];
#pragma unroll
  for (int r = 0; r < 16; ++r) ps += p1[r];
  { auto rr = __builtin_amdgcn_permlane32_swap(__float_as_uint(ps), __float_as_uint(ps), false, false);
    ps = __uint_as_float(rr[0]) + __uint_as_float(rr[1]); }
  l_reg = l_reg * alpha + ps;
#define PK4(P, BASE, OUT) do { unsigned a0 = cvtpk(P[BASE + 0], P[BASE + 1]), a1 = cvtpk(P[BASE + 2], P[BASE + 3]);   \
    unsigned b0 = cvtpk(P[BASE + 4], P[BASE + 5]), b1 = cvtpk(P[BASE + 6], P[BASE + 7]);                              \
    auto r0 = __builtin_amdgcn_permlane32_swap(a0, b0, false, false); auto r1 = __builtin_amdgcn_permlane32_swap(a1, b1, false, false); \
    u32x4 w = {r0[0], r1[0], r0[1], r1[1]}; OUT = *reinterpret_cast<bf16x8*>(&w); } while (0)
  PK4(p0, 0, pa0); PK4(p0, 8, pa1); PK4(p1, 0, pa2); PK4(p1, 8, pa3);
#undef PK4
}
typedef short v4i16_t __attribute__((ext_vector_type(4)));
__device__ __forceinline__ bf16x8 ld_frag2(int sp, const LAS char* kb, const int (&kx)[4], const LAS char* vb) {
  if (sp >= 16) { const int s = sp - 16, d0 = s >> 1; return *(const LAS bf16x8*)(kb + kx[d0 & 3] + (d0 >> 2) * 128 + (s & 1) * 8192); }
  const int D0 = sp >> 2, ks = sp & 3;
  const s16x4 lo = __builtin_bit_cast(s16x4, __builtin_amdgcn_ds_read_tr16_b64_v4i16((LAS v4i16_t*)(vb + v_rd_off(D0, ks, 0))));
  const s16x4 hi = __builtin_bit_cast(s16x4, __builtin_amdgcn_ds_read_tr16_b64_v4i16((LAS v4i16_t*)(vb + v_rd_off(D0, ks, 1))));
  return (bf16x8){lo[0], lo[1], lo[2], lo[3], hi[0], hi[1], hi[2], hi[3]};
}
template <int SB, int SE, bool PRE>
__device__ __forceinline__ void mrun(bf16x8 (&f)[8], f32x16& p0, f32x16& p1, f32x16* o, const bf16x8* qr, bf16x8 pa0, bf16x8 pa1, bf16x8 pa2, bf16x8 pa3, const LAS char* kb, const int (&kx)[4], const LAS char* vb, float init) {
  if (SE > 16) { p0 = f32x16{}; p1 = f32x16{}; }
  SBAR();
  if (!PRE) {
#pragma unroll
    for (int s = SB; s < SB + 8; ++s) f[s & 7] = ld_frag2(s, kb, kx, vb);
    SBAR(); }
#pragma unroll
  for (int sp = SB; sp < SE; ++sp) {
    if (sp >= 16) { const int s = sp - 16; if (s & 1) p1 = __builtin_amdgcn_mfma_f32_32x32x16_bf16(f[sp & 7], qr[s >> 1], p1, 0, 0, 0); else p0 = __builtin_amdgcn_mfma_f32_32x32x16_bf16(f[sp & 7], qr[s >> 1], p0, 0, 0, 0); }
    else { const int D0 = sp >> 2, ks = sp & 3; const bf16x8 pa = ks == 0 ? pa0 : ks == 1 ? pa1 : ks == 2 ? pa2 : pa3;
      o[D0] = __builtin_amdgcn_mfma_f32_32x32x16_bf16(pa, f[sp & 7], o[D0], 0, 0, 0); }
    if (sp + 8 < SE) f[sp & 7] = ld_frag2(sp + 8, kb, kx, vb);
    SBAR();
  }
}
template <int MODE>
__device__ __forceinline__ void attn_unit_pp(const bf16_t* Qb, const bf16_t* __restrict__ Kh, const bf16_t* __restrict__ Vh, unsigned char* Ob8, int kbeg, int kend, int q0, int head, char* lds, const Aux& aux) {
  int tid = threadIdx.x; asm volatile("" : "+v"(tid));
  const int wid = tid >> 6, lane = tid & 63, r32 = lane & 31, hi = lane >> 5;
  const int widu = __builtin_amdgcn_readfirstlane(wid), half = widu >> 2;
  const int hsub = widu >> 1, rsub = (widu & 1) * QBLK;
  const int rw0 = q0 + rsub;
#define NEED(j) (MODE == 0 || ((kbeg + (j) * KVBLK + KVBLK - 1 >= rw0 - 128) && (kbeg + (j) * KVBLK <= rw0 + QBLK - 1 + 128)))
  char* V_lds = lds; char* K_lds = lds + SHM_V;
  float* ws = (float*)(lds + OFF_WS) + wid * 64; float* li_l = ws; float* al_l = ws + 32;
  float* tab = (float*)(lds + OFF_TAB) + hsub * 768;
  float m_reg = -1e30f, l_reg = 0; f32x16 o[4] = {}; bf16x8 qr[8];
  const bf16_t* Qw = Qb + (long)(rsub + r32) * LDQ + hsub * HD + hi * 8;
#pragma unroll
  for (int d0 = 0; d0 < 8; ++d0) qr[d0] = *reinterpret_cast<const bf16x8*>(Qw + d0 * 16);
  if constexpr (MODE == 1) {
    m_reg = aux.sink[head + hsub] * LOG2E; l_reg = 1.0f;
  }
  const int tbase = kbeg - q0 - rsub - r32 + 383 + 4 * hi;
  float qk_init = 0.f;
  if constexpr (MODE == 0) {
    float mq = fmaxf(fabsf(aux.qn[lane]), fabsf(aux.qn[64 + lane])), mk = fmaxf(fabsf(aux.kn[lane]), fabsf(aux.kn[64 + lane]));
#pragma unroll
    for (int of = 1; of < 64; of <<= 1) { mq = fmaxf(mq, __shfl_xor(mq, of)); mk = fmaxf(mk, __shfl_xor(mk, of)); }
    const float bound = C * 128.0f * mq * mk * 1.01f + 0.5f;
    m_reg = __builtin_amdgcn_readfirstlane(__float_as_int(bound > 64.f ? bound - 64.f : 0.f)) ? (bound - 64.f) : 0.f; (void)qk_init; }
  const int sr = tid >> 4, sc = (tid & 15) * 8, vst0 = v_st(sr, sc), vst1 = v_st(32 + sr, sc);
  const int vb0 = (int)(uintptr_t)V_lds + v_rd_base(lane);
  int kx[4];
#pragma unroll
  for (int d = 0; d < 4; ++d) kx[d] = r32 * 256 + ((d * 32 + hi * 16) ^ ((r32 & 7) << 4));
  const LAS char* k3 = (const LAS char*)K_lds; const LAS char* v3 = (const LAS char*)V_lds + v_rd_base(lane);
  bf16x8 fr_[8];
  bf16x8 s_v0, s_v1, s_k0, s_k1;
#define SLOAD(k0) do { s_v0 = *reinterpret_cast<const bf16x8*>(&Vh[(long)(kbeg + (k0) + sr) * LDK + sc]); s_v1 = *reinterpret_cast<const bf16x8*>(&Vh[(long)(kbeg + (k0) + 32 + sr) * LDK + sc]); \
    s_k0 = *reinterpret_cast<const bf16x8*>(&Kh[(long)(kbeg + (k0) + sr) * LDK + sc]); s_k1 = *reinterpret_cast<const bf16x8*>(&Kh[(long)(kbeg + (k0) + 32 + sr) * LDK + sc]); } while (0)
#define SWRITE(bo) do { *(bf16x8*)(V_lds + (bo) + vst0) = s_v0; *(bf16x8*)(V_lds + (bo) + vst1) = s_v1; const int kc = sc * 2;  \
    *(bf16x8*)(K_lds + (bo) + KSWZ(sr, kc)) = s_k0; *(bf16x8*)(K_lds + (bo) + KSWZ(32 + sr, kc)) = s_k1; } while (0)
#define VMW0() asm volatile("s_waitcnt vmcnt(0)" ::: "memory")
#define BAR() asm volatile("s_waitcnt lgkmcnt(0)\n\ts_barrier" ::: "memory")
#define RESC(a) do { if (__any((a) < 1.f)) { if (hi == 0) al_l[r32] = (a); asm volatile("s_waitcnt lgkmcnt(0)" ::: "memory"); \
    _Pragma("unroll") for (int d = 0; d < 4; ++d) _Pragma("unroll") for (int r = 0; r < 16; ++r) o[d][r] *= al_l[crow(r, hi)]; } } while (0)
#define ROT() do { const int t_ = o_prev; o_prev = o_cur; o_cur = o_next; o_next = t_; } while (0)
#define VSEG(j) do { VMW0(); SWRITE(o_next); { const int nx_ = (j) + 2 + half; SLOAD((nx_ < NT ? nx_ : NT - 1) * KVBLK); } SBAR(); \
    if (NEED(j)) { softmax_tile<MODE>(p0, p1, m_reg, l_reg, alpha, pa0, pa1, pa2, pa3, tab + tbase + (j) * KVBLK); if constexpr (MODE == 1) { RESC(alpha); } } SBAR(); } while (0)
#define PVPRE() do { if constexpr (MODE == 0) { _Pragma("unroll") for (int s_ = 0; s_ < 8; ++s_) fr_[s_] = ld_frag2(s_, k3, kx, v3 + o_cur); SBAR(); } } while (0)
  f32x16 p0, p1; float alpha; bf16x8 pa0, pa1, pa2, pa3; const int NT = (kend - kbeg) / KVBLK;
  int o_prev = 2 * BUFB, o_cur = 0, o_next = BUFB;
  { bf16x8 t_v0, t_v1, t_k0, t_k1;
    t_v0 = *reinterpret_cast<const bf16x8*>(&Vh[(long)(kbeg + sr) * LDK + sc]); t_v1 = *reinterpret_cast<const bf16x8*>(&Vh[(long)(kbeg + 32 + sr) * LDK + sc]);
    t_k0 = *reinterpret_cast<const bf16x8*>(&Kh[(long)(kbeg + sr) * LDK + sc]); t_k1 = *reinterpret_cast<const bf16x8*>(&Kh[(long)(kbeg + 32 + sr) * LDK + sc]);
    SLOAD(KVBLK); VMW0();
    *(bf16x8*)(V_lds + vst0) = t_v0; *(bf16x8*)(V_lds + vst1) = t_v1; { const int kc = sc * 2; *(bf16x8*)(K_lds + KSWZ(sr, kc)) = t_k0; *(bf16x8*)(K_lds + KSWZ(32 + sr, kc)) = t_k1; }
    if (half) { SWRITE(BUFB); SLOAD(2 * KVBLK); } }
  BAR();
#define MSEG_QK(j) do { SBAR(); if (NEED(j)) qkt(p0, p1, (const bf16_t*)(K_lds + o_cur), qr, r32, hi, qk_init); SBAR(); } while (0)
#define MSEG(j) do { SBAR(); if (NEED(j)) qkt(p0, p1, (const bf16_t*)(K_lds + o_cur), qr, r32, hi, qk_init); if (NEED((j) - 1)) pv_d0(o, vb0 + o_prev, pa0, pa1, pa2, pa3); SBAR(); } while (0)
#define MSEG_PV() do { SBAR(); if (NEED(NT - 1)) pv_d0(o, vb0 + o_prev, pa0, pa1, pa2, pa3); SBAR(); } while (0)
  if (half == 0) {
    MSEG_QK(0); VSEG(0);
    BAR(); ROT();
    for (int j = 1; j < NT; ++j) { MSEG(j); VSEG(j); BAR(); ROT(); }
    MSEG_PV();
  } else {
    MSEG_QK(0);
    BAR(); ROT();
    for (int j = 1; j < NT; ++j) { VSEG(j - 1); MSEG(j); BAR(); ROT(); }
    VSEG(NT - 1); MSEG_PV();
  }
#undef MSEG_QK
#undef MSEG
#undef MSEG_PV
  if (hi == 0) li_l[r32] = l_reg; asm volatile("s_waitcnt lgkmcnt(0)" ::: "memory");
  float rli[16];
#pragma unroll
  for (int r = 0; r < 16; ++r) rli[r] = __builtin_amdgcn_rcpf(li_l[crow(r, hi)]);
  VMW0();
  __syncthreads();
  char* ost = lds + OFF_OST + wid * 4096;
#pragma unroll
  for (int r = 0; r < 16; ++r) { const int orow = crow(r, hi);
#pragma unroll
    for (int d0 = 0; d0 < 4; ++d0) { const float xo = o[d0][r] * rli[r] * OB8S; *(unsigned char*)(ost + orow * 128 + d0 * 32 + r32) = (unsigned char)(__builtin_amdgcn_cvt_pk_fp8_f32(xo, xo, 0, false) & 0xff); } }
  asm volatile("s_waitcnt lgkmcnt(0)" ::: "memory");
  unsigned char* Ow = Ob8 + (long)rsub * QW + hsub * HD;
#pragma unroll
  for (int i = 0; i < 4; ++i) { const int ch = i * 64 + lane, row = ch >> 3, c16 = ch & 7;
    const u32x4 v = *(const u32x4*)(ost + row * 128 + c16 * 16); *(u32x4*)(Ow + (long)row * QW + c16 * 16) = v; }
  asm volatile("s_waitcnt lgkmcnt(0)" ::: "memory");
  __syncthreads();
#undef SLOAD
#undef SWRITE
#undef VMW0
#undef BAR
#undef RESC
#undef ROT
#undef VSEG
#undef PVPRE
#undef NEED
}

__device__ __forceinline__ int offK16(int row, int ch) { return row * 256 + 16 * (ch ^ (row & 15)); }
__device__ __forceinline__ int offV16(int row, int ch) { return row * 256 + 16 * (ch ^ ((row & 7) << 1)); }
__device__ __forceinline__ bf16x8 ld_frag16(int sp, const LAS char* kb, const int (&ka)[4], const LAS char* vb, const int (&va)[8]) {
  if (sp >= 16) { const int s = sp - 16, kblk = s >> 2, ks = s & 3; return *(const LAS bf16x8*)(kb + ka[ks] + kblk * 4096); }
  const int db = sp >> 1, s = sp & 1;
  const s16x4 lo = __builtin_bit_cast(s16x4, __builtin_amdgcn_ds_read_tr16_b64_v4i16((LAS v4i16_t*)(vb + va[db] + s * 8192)));
  const s16x4 hi = __builtin_bit_cast(s16x4, __builtin_amdgcn_ds_read_tr16_b64_v4i16((LAS v4i16_t*)(vb + va[db] + s * 8192 + 4096)));
  return (bf16x8){lo[0], lo[1], lo[2], lo[3], hi[0], hi[1], hi[2], hi[3]};
}
template <int SB, int SE, bool PRE>
__device__ __forceinline__ void mrun16(bf16x8 (&f)[8], f32x4 (&S)[4][2], f32x4 (&O)[8][2], const bf16x8 (&qf)[2][4], const bf16x8 (&pf)[2][2], const LAS char* kb, const int (&ka)[4], const LAS char* vb, const int (&va)[8]) {
  if (SE > 16) {
#pragma unroll
    for (int i = 0; i < 4; ++i) { S[i][0] = (f32x4){0.f, 0.f, 0.f, 0.f}; S[i][1] = (f32x4){0.f, 0.f, 0.f, 0.f}; } }
  SBAR();
  if (!PRE) {
#pragma unroll
    for (int s = SB; s < SB + 8; ++s) f[s & 7] = ld_frag16(s, kb, ka, vb, va);
    SBAR(); }
#pragma unroll
  for (int sp = SB; sp < SE; ++sp) {
    if (sp >= 16) { const int s = sp - 16, kblk = s >> 2, ks = s & 3;
      S[kblk][0] = __builtin_amdgcn_mfma_f32_16x16x32_bf16(f[sp & 7], qf[0][ks], S[kblk][0], 0, 0, 0); S[kblk][1] = __builtin_amdgcn_mfma_f32_16x16x32_bf16(f[sp & 7], qf[1][ks], S[kblk][1], 0, 0, 0); }
    else { const int db = sp >> 1, s = sp & 1;
      O[db][0] = __builtin_amdgcn_mfma_f32_16x16x32_bf16(f[sp & 7], pf[0][s], O[db][0], 0, 0, 0); O[db][1] = __builtin_amdgcn_mfma_f32_16x16x32_bf16(f[sp & 7], pf[1][s], O[db][1], 0, 0, 0); }
    if (sp + 8 < SE) f[sp & 7] = ld_frag16(sp + 8, kb, ka, vb, va);
    SBAR();
  }
}
__device__ __forceinline__ void attn_unit16(const bf16_t* Qb, const bf16_t* __restrict__ Kh, const bf16_t* __restrict__ Vh, bf16_t* Ob, int nkeys, int q0, char* lds, const Aux& aux) {
  int tid = threadIdx.x; asm volatile("" : "+v"(tid));
  const int wid = tid >> 6, lane = tid & 63, fr = lane & 15, fq = lane >> 4;
  const int half = __builtin_amdgcn_readfirstlane(wid >> 2);
  char* V_lds = lds; char* K_lds = lds + SHM_V;
  float shift;
  { float mq = fmaxf(fabsf(aux.qn[lane]), fabsf(aux.qn[64 + lane])), mk = fmaxf(fabsf(aux.kn[lane]), fabsf(aux.kn[64 + lane]));
#pragma unroll
    for (int of = 1; of < 64; of <<= 1) { mq = fmaxf(mq, __shfl_xor(mq, of)); mk = fmaxf(mk, __shfl_xor(mk, of)); }
    const float bound = C * 128.0f * mq * mk * 1.01f + 0.5f; shift = bound > 64.f ? bound - 64.f : 0.f; }
  bf16x8 qf[2][4];
#pragma unroll
  for (int qb = 0; qb < 2; ++qb)
#pragma unroll
    for (int ks = 0; ks < 4; ++ks) qf[qb][ks] = *reinterpret_cast<const bf16x8*>(Qb + (long)(wid * QBLK + 16 * qb + fr) * LDQ + 32 * ks + 8 * fq);
#pragma unroll
  for (int qb = 0; qb < 2; ++qb) {
    float ss = 0.f;
#pragma unroll
    for (int ks = 0; ks < 4; ++ks) { const f32x8 x = bf8_to_f32(qf[qb][ks]);
#pragma unroll
      for (int e = 0; e < 8; ++e) ss += x[e] * x[e]; }
    ss += __shfl_xor(ss, 16); ss += __shfl_xor(ss, 32);
    const float rinv = C / sqrtf(ss * (1.0f / 128.0f) + EPS);
    const int t = q0 + wid * QBLK + 16 * qb + fr;
#pragma unroll
    for (int hf = 0; hf < 2; ++hf) { const int posx = hf ? (t & 63) : (t >> 6);
      const f32x8 cs = *reinterpret_cast<const f32x8*>(aux.cosT + posx * 32 + 8 * fq), sn = *reinterpret_cast<const f32x8*>(aux.sinT + posx * 32 + 8 * fq);
      const f32x8 g1 = *reinterpret_cast<const f32x8*>(aux.qn + hf * 64 + 8 * fq), g2 = *reinterpret_cast<const f32x8*>(aux.qn + hf * 64 + 32 + 8 * fq);
      const f32x8 x1 = bf8_to_f32(qf[qb][2 * hf]) * rinv * g1, x2 = bf8_to_f32(qf[qb][2 * hf + 1]) * rinv * g2;
      qf[qb][2 * hf] = f32_to_bf8(x1 * cs - x2 * sn); qf[qb][2 * hf + 1] = f32_to_bf8(x2 * cs + x1 * sn); } }
  f32x4 O[8][2], S[4][2]; bf16x8 pf[2][2]; float lsum[2] = {0.f, 0.f};
#pragma unroll
  for (int i = 0; i < 8; ++i) { O[i][0] = (f32x4){0.f, 0.f, 0.f, 0.f}; O[i][1] = (f32x4){0.f, 0.f, 0.f, 0.f}; }
  int ka[4], va[8];
#pragma unroll
  for (int ks = 0; ks < 4; ++ks) ka[ks] = offK16(fr, 4 * ks + fq);
  { const int q = (lane & 15) >> 2, p = lane & 3;
#pragma unroll
    for (int c = 0; c < 8; ++c) va[c] = offV16(4 * fq + q, 2 * c + (p >> 1)) + 8 * (p & 1); }
  const LAS char* k3 = (const LAS char*)K_lds; const LAS char* v3 = (const LAS char*)V_lds;
  bf16x8 fr_[8];
  const int sr = tid >> 4, scc = tid & 15, kst = offK16(sr, scc), vst = offV16(sr, scc);
  bf16x8 s_v0, s_v1, s_k0, s_k1;
#define SLOAD(k0) do { s_v0 = *reinterpret_cast<const bf16x8*>(&Vh[(long)((k0) + sr) * LDK + scc * 8]); s_v1 = *reinterpret_cast<const bf16x8*>(&Vh[(long)((k0) + 32 + sr) * LDK + scc * 8]); \
    s_k0 = *reinterpret_cast<const bf16x8*>(&Kh[(long)((k0) + sr) * LDK + scc * 8]); s_k1 = *reinterpret_cast<const bf16x8*>(&Kh[(long)((k0) + 32 + sr) * LDK + scc * 8]); } while (0)
#define SWRITE(bo) do { *(bf16x8*)(V_lds + (bo) + vst) = s_v0; *(bf16x8*)(V_lds + (bo) + vst + 8192) = s_v1; *(bf16x8*)(K_lds + (bo) + kst) = s_k0; *(bf16x8*)(K_lds + (bo) + kst + 8192) = s_k1; } while (0)
#define VMW0() asm volatile("s_waitcnt vmcnt(0)" ::: "memory")
#define BAR() asm volatile("s_waitcnt lgkmcnt(0)\n\ts_barrier" ::: "memory")
#define ROT() do { const int t_ = o_prev; o_prev = o_cur; o_cur = o_next; o_next = t_; } while (0)
#define VSEG(j, wbuf_, pbuf_) do { VMW0(); SWRITE(wbuf_); { const int nx_ = (j) + 2 + half; SLOAD((nx_ < NT ? nx_ : NT - 1) * KVBLK); } SBAR(); \
    if (__builtin_expect(shift != 0.f, 0)) { _Pragma("unroll") for (int i_ = 0; i_ < 4; ++i_) { S[i_][0] -= shift; S[i_][1] -= shift; } } \
    _Pragma("unroll") for (int qb_ = 0; qb_ < 2; ++qb_) { \
      _Pragma("unroll") for (int i_ = 0; i_ < 4; ++i_) _Pragma("unroll") for (int r_ = 0; r_ < 4; ++r_) S[i_][qb_][r_] = __builtin_amdgcn_exp2f(S[i_][qb_][r_]); \
      float a_ = 0.f; _Pragma("unroll") for (int i_ = 0; i_ < 4; ++i_) a_ += (S[i_][qb_][0] + S[i_][qb_][1]) + (S[i_][qb_][2] + S[i_][qb_][3]); lsum[qb_] += a_; \
      _Pragma("unroll") for (int s_ = 0; s_ < 2; ++s_) { u32x4 w_ = {cvtpk(S[2 * s_][qb_][0], S[2 * s_][qb_][1]), cvtpk(S[2 * s_][qb_][2], S[2 * s_][qb_][3]), cvtpk(S[2 * s_ + 1][qb_][0], S[2 * s_ + 1][qb_][1]), cvtpk(S[2 * s_ + 1][qb_][2], S[2 * s_ + 1][qb_][3])}; \
        pf[qb_][s_] = *reinterpret_cast<bf16x8*>(&w_); } } \
    SBAR(); _Pragma("unroll") for (int s_ = 0; s_ < 8; ++s_) fr_[s_] = ld_frag16(s_, k3, ka, v3 + (pbuf_), va); SBAR(); } while (0)
  const int NT = nkeys / KVBLK;
  int o_prev = 2 * BUFB, o_cur = 0, o_next = BUFB;
  SLOAD(0); VMW0(); SWRITE(0);
  if (half) { SLOAD(KVBLK); VMW0(); SWRITE(BUFB); SLOAD(2 * KVBLK); } else { SLOAD(KVBLK); }
  BAR();
  if (half == 0) {
    mrun16<16, 32, false>(fr_, S, O, qf, pf, k3 + o_cur, ka, v3 + o_prev, va);
    VSEG(0, o_next, o_cur);
    BAR(); ROT();
    for (int j = 1; j < NT; ++j) {
      mrun16<0, 32, true>(fr_, S, O, qf, pf, k3 + o_cur, ka, v3 + o_prev, va);
      VSEG(j, o_next, o_cur);
      BAR(); ROT();
    }
    mrun16<0, 16, true>(fr_, S, O, qf, pf, k3 + o_cur, ka, v3 + o_prev, va);
  } else {
    mrun16<16, 32, false>(fr_, S, O, qf, pf, k3 + o_cur, ka, v3 + o_prev, va);
    BAR(); ROT();
    for (int j = 1; j < NT; ++j) {
      VSEG(j - 1, o_next, o_prev);
      mrun16<0, 32, true>(fr_, S, O, qf, pf, k3 + o_cur, ka, v3 + o_prev, va);
      BAR(); ROT();
    }
    VSEG(NT - 1, o_next, o_prev);
    mrun16<0, 16, true>(fr_, S, O, qf, pf, k3 + o_cur, ka, v3 + o_prev, va);
  }
  float rl[2];
#pragma unroll
  for (int qb = 0; qb < 2; ++qb) { float l = lsum[qb]; l += __shfl_xor(l, 16); l += __shfl_xor(l, 32); rl[qb] = __builtin_amdgcn_rcpf(l); }
  VMW0();
  __syncthreads();
  char* ost = lds + OFF_OST + wid * 8192;
#pragma unroll
  for (int db = 0; db < 8; ++db)
#pragma unroll
    for (int qb = 0; qb < 2; ++qb) { const f32x4 v = O[db][qb] * rl[qb]; u32x2 w; w.x = cvtpk(v[0], v[1]); w.y = cvtpk(v[2], v[3]);
      *(u32x2*)(ost + (16 * qb + fr) * 256 + (16 * db + 4 * fq) * 2) = w; }
  asm volatile("s_waitcnt lgkmcnt(0)" ::: "memory");
  bf16_t* Ow = Ob + (long)(wid * QBLK) * LDQ;
#pragma unroll
  for (int i = 0; i < 8; ++i) { const int ch = i * 64 + lane, row = ch >> 4, c16 = ch & 15;
    const u32x4 v = *(const u32x4*)(ost + row * 256 + c16 * 16); *(u32x4*)(Ow + (long)row * LDQ + c16 * 8) = v; }
  asm volatile("s_waitcnt lgkmcnt(0)" ::: "memory");
  __syncthreads();
#undef SLOAD
#undef SWRITE
#undef VMW0
#undef BAR
#undef ROT
#undef VSEG
}

typedef int v8i_t __attribute__((ext_vector_type(8)));
typedef short v2s_t __attribute__((ext_vector_type(2)));
__device__ __forceinline__ int off8(int row, int c16) { return row * 128 + 16 * (c16 ^ (((row >> 1) & 1) | (((row >> 2) & 1) << 2))); }
__device__ __forceinline__ v8i_t ld_frag8(const LAS char* img, int a0, int a1, int blk) {
  const u32x4 lo = *(const LAS u32x4*)(img + blk * 2048 + a0), hi = *(const LAS u32x4*)(img + blk * 2048 + a1);
  return (v8i_t){(int)lo.x, (int)lo.y, (int)lo.z, (int)lo.w, (int)hi.x, (int)hi.y, (int)hi.z, (int)hi.w};
}
__device__ __forceinline__ void exp_pack8(f32x4 (&S)[4][2], v8i_t (&pf)[2], float (&lsum)[2], float pscale, int h) {
#pragma unroll
  for (int qb = 0; qb < 2; ++qb) { float a = 0.f;
#pragma unroll
    for (int i = 0; i < 4; ++i) { f32x4 e;
#pragma unroll
      for (int r = 0; r < 4; ++r) e[r] = __builtin_amdgcn_exp2f(S[i][qb][r]);
      a += (e[0] + e[1]) + (e[2] + e[3]);
      v2s_t p = {0, 0}; p = __builtin_amdgcn_cvt_scalef32_pk_bf8_f32(p, e[0], e[1], pscale, false); p = __builtin_amdgcn_cvt_scalef32_pk_bf8_f32(p, e[2], e[3], pscale, true);
      const int w = __builtin_bit_cast(int, p);
      if (h == 0) { if (i == 0) pf[qb][0] = w; else if (i == 1) pf[qb][1] = w; else if (i == 2) pf[qb][2] = w; else pf[qb][3] = w; }
      else { if (i == 0) pf[qb][4] = w; else if (i == 1) pf[qb][5] = w; else if (i == 2) pf[qb][6] = w; else pf[qb][7] = w; } }
    lsum[qb] += a; }
}
template <bool DO_PV, bool DO_QK, bool PRE>
__device__ __forceinline__ void mrun8(v8i_t (&f)[2], f32x4 (&S)[4][2], f32x4 (&O)[8][2], const v8i_t (&qf)[2], v8i_t (&pf)[2], float (&lsum)[2], float pscale, const LAS char* kimg, const LAS char* vimg, int a0, int a1) {
  constexpr int SB = DO_PV ? 0 : 8, SE = DO_QK ? 16 : 8;
  SBAR();
  if (!PRE) {
#pragma unroll
    for (int s = SB; s < SB + 2; ++s) f[s & 1] = (s >= 8) ? ld_frag8(kimg, a0, a1, s - 8) : ld_frag8(vimg, a0, a1, s);
    SBAR(); }
#pragma unroll
  for (int sp = SB; sp < SE; ++sp) {
    if (sp >= 8) { const int kb = sp - 8; const f32x4 z = {0.f, 0.f, 0.f, 0.f};
      S[kb & 3][0] = __builtin_amdgcn_mfma_scale_f32_16x16x128_f8f6f4(f[sp & 1], qf[0], z, 0, 0, 0, 0, 0, 0); S[kb & 3][1] = __builtin_amdgcn_mfma_scale_f32_16x16x128_f8f6f4(f[sp & 1], qf[1], z, 0, 0, 0, 0, 0, 0); }
    else { O[sp][0] = __builtin_amdgcn_mfma_scale_f32_16x16x128_f8f6f4(f[sp & 1], pf[0], O[sp][0], 0, 1, 0, 0, 0, 0); O[sp][1] = __builtin_amdgcn_mfma_scale_f32_16x16x128_f8f6f4(f[sp & 1], pf[1], O[sp][1], 0, 1, 0, 0, 0, 0); }
    if (sp + 2 < SE) f[sp & 1] = (sp + 2 >= 8) ? ld_frag8(kimg, a0, a1, sp + 2 - 8) : ld_frag8(vimg, a0, a1, sp + 2);
    SBAR();
    if (sp == 11) { exp_pack8(S, pf, lsum, pscale, 0); SBAR(); }
  }
}
__device__ __forceinline__ float xsum16(float x) { auto r = __builtin_amdgcn_permlane16_swap(__float_as_uint(x), __float_as_uint(x), false, false); return __uint_as_float(r[0]) + __uint_as_float(r[1]); }
__device__ __forceinline__ float xsum32(float x) { auto r = __builtin_amdgcn_permlane32_swap(__float_as_uint(x), __float_as_uint(x), false, false); return __uint_as_float(r[0]) + __uint_as_float(r[1]); }
__device__ __forceinline__ float xchg16(float x, bool odd) { auto r = __builtin_amdgcn_permlane16_swap(__float_as_uint(x), __float_as_uint(x), false, false); return __uint_as_float(odd ? r[0] : r[1]); }
__device__ __forceinline__ void attn_unit8(const bf16_t* Qb, const unsigned char* __restrict__ K8, const unsigned char* __restrict__ V8T, unsigned char* Ob8, int q0, char* lds, const Aux& aux, float pscale) {
  int tid = threadIdx.x; asm volatile("" : "+v"(tid));
  const int wid = tid >> 6, lane = tid & 63, fr = lane & 15, g = lane >> 4;
  const int half = __builtin_amdgcn_readfirstlane(wid >> 2);
  v8i_t qf[2];
  { char* qs = lds + 3 * BUFB + wid * 4096;
#pragma unroll
    for (int qb = 0; qb < 2; ++qb) {
      bf16x8 q16[4]; float ss = 0.f;
#pragma unroll
      for (int ks = 0; ks < 4; ++ks) { q16[ks] = *reinterpret_cast<const bf16x8*>(Qb + (long)(wid * QBLK + 16 * qb + fr) * LDQ + 32 * ks + 8 * g); const f32x8 x = bf8_to_f32(q16[ks]);
#pragma unroll
        for (int e = 0; e < 8; ++e) ss += x[e] * x[e]; }
      ss = xsum32(xsum16(ss));
      const float rinv = C / sqrtf(ss * (1.0f / 128.0f) + EPS);
      const int t = q0 + wid * QBLK + 16 * qb + fr;
#pragma unroll
      for (int hf = 0; hf < 2; ++hf) { const int posx = hf ? (t & 63) : (t >> 6);
        const f32x8 cs = *reinterpret_cast<const f32x8*>(aux.cosT + posx * 32 + 8 * g), sn = *reinterpret_cast<const f32x8*>(aux.sinT + posx * 32 + 8 * g);
        const f32x8 g1 = *reinterpret_cast<const f32x8*>(aux.qn + hf * 64 + 8 * g), g2 = *reinterpret_cast<const f32x8*>(aux.qn + hf * 64 + 32 + 8 * g);
        const f32x8 x1 = bf8_to_f32(q16[2 * hf]) * rinv * g1, x2 = bf8_to_f32(q16[2 * hf + 1]) * rinv * g2;
        const f32x8 y1 = x1 * cs - x2 * sn, y2 = x2 * cs + x1 * sn;
        int a0_ = 0, a1_ = 0, b0_ = 0, b1_ = 0;
        a0_ = __builtin_amdgcn_cvt_pk_fp8_f32(y1[0], y1[1], a0_, false); a0_ = __builtin_amdgcn_cvt_pk_fp8_f32(y1[2], y1[3], a0_, true); a1_ = __builtin_amdgcn_cvt_pk_fp8_f32(y1[4], y1[5], a1_, false); a1_ = __builtin_amdgcn_cvt_pk_fp8_f32(y1[6], y1[7], a1_, true);
        b0_ = __builtin_amdgcn_cvt_pk_fp8_f32(y2[0], y2[1], b0_, false); b0_ = __builtin_amdgcn_cvt_pk_fp8_f32(y2[2], y2[3], b0_, true); b1_ = __builtin_amdgcn_cvt_pk_fp8_f32(y2[4], y2[5], b1_, false); b1_ = __builtin_amdgcn_cvt_pk_fp8_f32(y2[6], y2[7], b1_, true);
        *(u32x2*)(qs + (16 * qb + fr) * 128 + 32 * (2 * hf) + 8 * g) = (u32x2){(unsigned)a0_, (unsigned)a1_}; *(u32x2*)(qs + (16 * qb + fr) * 128 + 32 * (2 * hf + 1) + 8 * g) = (u32x2){(unsigned)b0_, (unsigned)b1_}; }
    }
    asm volatile("s_waitcnt lgkmcnt(0)" ::: "memory");
#pragma unroll
    for (int qb = 0; qb < 2; ++qb) { const u32x4 lo = *(const u32x4*)(qs + (16 * qb + fr) * 128 + 32 * g), hi = *(const u32x4*)(qs + (16 * qb + fr) * 128 + 32 * g + 16);
      qf[qb] = (v8i_t){(int)lo.x, (int)lo.y, (int)lo.z, (int)lo.w, (int)hi.x, (int)hi.y, (int)hi.z, (int)hi.w}; }
    asm volatile("s_waitcnt lgkmcnt(0)" ::: "memory"); }
  f32x4 O[8][2], S[4][2]; v8i_t pf[2]; float lsum[2] = {0.f, 0.f};
#pragma unroll
  for (int i = 0; i < 8; ++i) { O[i][0] = (f32x4){0.f, 0.f, 0.f, 0.f}; O[i][1] = (f32x4){0.f, 0.f, 0.f, 0.f}; }
  const int a0 = off8(fr, 2 * g), a1 = off8(fr, 2 * g + 1);
  char* V_lds = lds; char* K_lds = lds + SHM_V;
  const LAS char* k3 = (const LAS char*)K_lds; const LAS char* v3 = (const LAS char*)V_lds;
  v8i_t fr_[2];
  const int widu = __builtin_amdgcn_readfirstlane(wid);
  unsigned dso[2];
#pragma unroll
  for (int i = 0; i < 2; ++i) { const int c = (wid * 2 + i) * 64 + lane, row = c >> 3, p = c & 7; dso[i] = (unsigned)(row * 128 + ((p ^ (((row >> 1) & 1) | (((row >> 2) & 1) << 2))) << 4)); }
  const unsigned ldsw = (unsigned)widu * 2048u; LAS unsigned char* l3 = (LAS unsigned char*)lds;
#define DMA_TILE(t_) do { const unsigned char* kg_ = K8 + (size_t)(t_) * 16384; const unsigned char* vg_ = V8T + (size_t)(t_) * 16384; const unsigned bo_ = (unsigned)(((t_) & 3) * BUFB); \
    _Pragma("unroll") for (int i_ = 0; i_ < 2; ++i_) { \
      __builtin_amdgcn_global_load_lds((const unsigned*)(vg_ + dso[i_]), (LAS unsigned*)(l3 + bo_ + ldsw + i_ * 1024), 16, 0, 0); \
      __builtin_amdgcn_global_load_lds((const unsigned*)(kg_ + dso[i_]), (LAS unsigned*)(l3 + bo_ + SHM_V + ldsw + i_ * 1024), 16, 0, 0); } } while (0)
#define VMW0() asm volatile("s_waitcnt vmcnt(0)" ::: "memory")
#define BAR() asm volatile("s_waitcnt lgkmcnt(0)\n\ts_barrier" ::: "memory")
#define VSEG(j, pbuf_) do { VMW0(); { const int nx_ = (j) + 2 + half; if (nx_ < NT) DMA_TILE(nx_); } SBAR(); \
    exp_pack8(S, pf, lsum, pscale, 1); \
    SBAR(); _Pragma("unroll") for (int s_ = 0; s_ < 2; ++s_) fr_[s_] = ld_frag8(v3 + (pbuf_), a0, a1, s_); SBAR(); } while (0)
  constexpr int NT = SEQ / 128;
  DMA_TILE(0); DMA_TILE(1); if (half) DMA_TILE(2);
  VMW0(); BAR();
  if (half) BAR();
  mrun8<false, true, false>(fr_, S, O, qf, pf, lsum, pscale, k3, v3, a0, a1);
  BAR();
  VSEG(0, 0);
  BAR();
  for (int j = 1; j < NT; ++j) {
    mrun8<true, true, true>(fr_, S, O, qf, pf, lsum, pscale, k3 + (j & 3) * BUFB, v3 + ((j - 1) & 3) * BUFB, a0, a1);
    BAR();
    VSEG(j, (j & 3) * BUFB);
    BAR();
  }
  mrun8<true, false, true>(fr_, S, O, qf, pf, lsum, pscale, k3, v3 + ((NT - 1) & 3) * BUFB, a0, a1);
  if (!half) BAR();
  float rl[2];
#pragma unroll
  for (int qb = 0; qb < 2; ++qb) { const float l = xsum32(xsum16(lsum[qb])); rl[qb] = pscale * __builtin_amdgcn_rcpf(l); }
  VMW0();
  __syncthreads();
  char* ost = lds + OFF_OST + wid * 4096;
#pragma unroll
  for (int db = 0; db < 8; ++db)
#pragma unroll
    for (int qb = 0; qb < 2; ++qb) { const f32x4 v = O[db][qb] * (rl[qb] * OA8S); int w = 0; w = __builtin_amdgcn_cvt_pk_fp8_f32(v[0], v[1], w, false); w = __builtin_amdgcn_cvt_pk_fp8_f32(v[2], v[3], w, true);
      *(int*)(ost + (16 * qb + fr) * 128 + 16 * db + 4 * g) = w; }
  asm volatile("s_waitcnt lgkmcnt(0)" ::: "memory");
  unsigned char* Ow = Ob8 + (long)(wid * QBLK) * QW;
#pragma unroll
  for (int i = 0; i < 4; ++i) { const int ch = i * 64 + lane, row = ch >> 3, c16 = ch & 7;
    const u32x4 v = *(const u32x4*)(ost + row * 128 + c16 * 16); *(u32x4*)(Ow + (long)row * QW + c16 * 16) = v; }
  asm volatile("s_waitcnt lgkmcnt(0)" ::: "memory");
  __syncthreads();
#undef DMA_TILE
#undef VMW0
#undef BAR
#undef VSEG
}
}

#define XB_TMO      128
#define XB_XCNT(j)  (256  + 64 * (j))
#define XB_XSUB(j)  (1280 + 64 * (j))
#define XB_XGEN(j)  (2304 + 64 * (j))
#define XB_TOP      3328
#define XB_TOPGEN   3392
#define XCD_BAR_WORDS 3456
#define XB_SPIN_CAP (1u << 18)
__device__ __forceinline__ unsigned xb_ld(unsigned* p)              { return __hip_atomic_load(p, __ATOMIC_RELAXED, __HIP_MEMORY_SCOPE_AGENT); }
__device__ __forceinline__ unsigned xb_add(unsigned* p, unsigned v) { return __hip_atomic_fetch_add(p, v, __ATOMIC_RELAXED, __HIP_MEMORY_SCOPE_AGENT); }
__device__ __forceinline__ unsigned xb_xcc_id() { return (unsigned)__builtin_amdgcn_s_getreg((3 << 11) | 20) & 0xFu; }
#define XB_SPIN(cond, bar) do { unsigned _sp = 0; while (cond) { __builtin_amdgcn_s_sleep(1); \
    if ((++_sp & 255u) == 0u) { if (xb_ld(&(bar)[XB_TMO])) break; if (_sp > XB_SPIN_CAP) { atomicAdd(&(bar)[XB_TMO], 1u); break; } } } } while (0)
struct XcdBarrier { unsigned* bar; unsigned x; volatile LAS unsigned* st; };
__device__ __forceinline__ XcdBarrier xcd_barrier_post(unsigned* bar, volatile LAS unsigned* st) {
    XcdBarrier b; b.bar = bar; b.x = xb_xcc_id(); b.st = st;
    if (threadIdx.x == 0) (void)xb_add(&bar[XB_XCNT(b.x)], 1u);
    return b;
}
__device__ __forceinline__ void xcd_barrier_complete(unsigned* bar, unsigned x, unsigned& nloc, unsigned& nx) {
    const unsigned G = gridDim.x * gridDim.y * gridDim.z;
    unsigned sum, cnt, mine, sp = 0u;
    for (;;) {
        sum = 0u; cnt = 0u; mine = 0u;
#pragma unroll
        for (unsigned j = 0; j < 16; ++j) { const unsigned c = xb_ld(&bar[XB_XCNT(j)]); sum += c; cnt += (c > 0u) ? 1u : 0u; mine = (j == x) ? c : mine; }
        if (sum == G) break;
        __builtin_amdgcn_s_sleep(1);
        if ((++sp & 255u) == 0u) { if (xb_ld(&bar[XB_TMO])) break; if (sp > XB_SPIN_CAP) { atomicAdd(&bar[XB_TMO], 1u); break; } }
    }
    nloc = mine > 0u ? mine : 1u; nx = cnt > 0u ? cnt : 1u;
}
__device__ __forceinline__ void xcd_barrier(const XcdBarrier& b) {
    asm volatile("s_waitcnt vmcnt(0)" ::: "memory");
    __syncthreads();
    if (threadIdx.x == 0) {
        unsigned* bar = b.bar;
        __builtin_amdgcn_s_waitcnt(0);
        unsigned nloc = b.st[0], nx = b.st[1];
        if (nloc == 0u) { xcd_barrier_complete(bar, b.x, nloc, nx); b.st[0] = nloc; b.st[1] = nx; }
        const unsigned old = xb_add(&bar[XB_XSUB(b.x)], 1u);
        const unsigned gen = old / nloc;
        if (old + 1u == (gen + 1u) * nloc) {
            __builtin_amdgcn_fence(__ATOMIC_RELEASE, "agent");
            asm volatile("s_waitcnt vmcnt(0)" ::: "memory");
            const unsigned og = xb_add(&bar[XB_TOP], 1u);
            const unsigned tg = og / nx;
            if (og + 1u == (tg + 1u) * nx) xb_add(&bar[XB_TOPGEN], 1u);
            else XB_SPIN(xb_ld(&bar[XB_TOPGEN]) == tg, bar);
            __builtin_amdgcn_fence(__ATOMIC_ACQUIRE, "agent");
            xb_add(&bar[XB_XGEN(b.x)], 1u);
            asm volatile("s_waitcnt vmcnt(0)" ::: "memory");
        } else {
            XB_SPIN(xb_ld(&bar[XB_XGEN(b.x)]) == gen, bar);
            __builtin_amdgcn_fence(__ATOMIC_ACQUIRE, "agent");
            asm volatile("s_waitcnt vmcnt(0)" ::: "memory");
        }
    }
    __syncthreads();
}

struct Args { const float* in[17]; float* out; unsigned char* ws; int ph_lo, ph_hi, li, pad; };
struct Frame { LAS unsigned char* lds; int tid, lane, wave, vcu, G; };
constexpr int NWAVES = 8;

__device__ __forceinline__ void tr_item(const float* W, int N, int k0, int n0, bf16_t* WT, int Kd, int drow0, LAS float* scr, int lane, unsigned char* WT8 = nullptr, bool wr16 = true) {
    float tv[32];
#pragma unroll
    for (int i = 0; i < 32; ++i) { const int kk = 2 * i + (lane >> 5); tv[i] = W[(size_t)(k0 + kk) * N + n0 + (lane & 31)]; }
#pragma unroll
    for (int i = 0; i < 32; ++i) { const int kk = 2 * i + (lane >> 5); scr[kk * 33 + (lane & 31)] = tv[i]; }
    LDS_WAIT(); asm volatile("" ::: "memory");
    const int c = lane & 7;
#pragma unroll
    for (int j = 0; j < 4; ++j) { const int n = (lane >> 3) + 8 * j; const LAS float* s = scr + (8 * c) * 33 + n;
        if (wr16) { u32x4 o; o.x = cvt_pk_bf16(s[0 * 33], s[1 * 33]); o.y = cvt_pk_bf16(s[2 * 33], s[3 * 33]); o.z = cvt_pk_bf16(s[4 * 33], s[5 * 33]); o.w = cvt_pk_bf16(s[6 * 33], s[7 * 33]);
            *(GAS u32x4*)(WT + (size_t)(drow0 + n) * Kd + k0 + 8 * c) = o; }
        if (WT8) { int w0 = 0, w1 = 0; w0 = __builtin_amdgcn_cvt_pk_fp8_f32(s[0 * 33] * W8S, s[1 * 33] * W8S, w0, false); w0 = __builtin_amdgcn_cvt_pk_fp8_f32(s[2 * 33] * W8S, s[3 * 33] * W8S, w0, true);
            w1 = __builtin_amdgcn_cvt_pk_fp8_f32(s[4 * 33] * W8S, s[5 * 33] * W8S, w1, false); w1 = __builtin_amdgcn_cvt_pk_fp8_f32(s[6 * 33] * W8S, s[7 * 33] * W8S, w1, true);
            *(GAS u32x2*)(WT8 + (size_t)(drow0 + n) * Kd + k0 + 8 * c) = (u32x2){(unsigned)w0, (unsigned)w1}; } }
    LDS_WAIT(); asm volatile("" ::: "memory");
}
__device__ __forceinline__ void rms_row_to_bf16(const float* xrow, const float* g, bf16_t* orow, int lane) {
    const GAS f32x4* xr = (const GAS f32x4*)xrow + lane; const GAS f32x4* gr = (const GAS f32x4*)g + lane;
    f32x4 v[8]; float s = 0.f;
#pragma unroll
    for (int j = 0; j < 8; ++j) { v[j] = xr[64 * j]; s += (v[j].x * v[j].x + v[j].y * v[j].y) + (v[j].z * v[j].z + v[j].w * v[j].w); }
    const float rinv = 1.0f / sqrtf(wave_sum(s) * (1.f / DM) + EPS);
    GAS u32x2* o8 = (GAS u32x2*)orow + lane;
#pragma unroll
    for (int j = 0; j < 8; ++j) { const f32x4 gv = gr[64 * j]; u32x2 w; w.x = cvt_pk_bf16(v[j].x * rinv * gv.x, v[j].y * rinv * gv.y); w.y = cvt_pk_bf16(v[j].z * rinv * gv.z, v[j].w * rinv * gv.w); o8[64 * j] = w; }
}

__device__ __forceinline__ void p0_prologue(const Frame& F, const Args& a) {
    unsigned char* ws = a.ws;
    LAS float* scr = (LAS float*)(F.lds + F.wave * 16384);
    const int gw = F.vcu * NWAVES + F.wave, NGW = F.G * NWAVES;
    constexpr int I_IN = (DM / 64) * (INW / 32), I_P = (QW / 64) * (DM / 32), I_O = (DM / 64) * (DM / 32);
    constexpr int NITEMS = I_IN + 2 * I_P + I_O;
    for (int it = gw; it < NITEMS; it += NGW) {
        int r = it;
        if (r < I_IN) { const int nb = INW / 32, kb = r / nb, n0 = (r % nb) * 32; tr_item(a.in[2], INW, kb * 64, n0, (bf16_t*)(ws + WS_WIN), DM, n0, scr, F.lane, ws + WS_WIN8, false); continue; } r -= I_IN;
        if (r < I_P) { const int nb = DM / 32, kb = r / nb, n0 = (r % nb) * 32; tr_item(a.in[6], DM, kb * 64, n0, (bf16_t*)(ws + WS_WPA), QW, n0, scr, F.lane, ws + WS_WPA8, false); continue; } r -= I_P;
        if (r < I_P) { const int nb = DM / 32, kb = r / nb, n0 = (r % nb) * 32; tr_item(a.in[9], DM, kb * 64, n0, (bf16_t*)(ws + WS_WPB), QW, n0, scr, F.lane, ws + WS_WPB8, false); continue; } r -= I_P;
        { const int nb = DM / 32, kb = r / nb, n0 = (r % nb) * 32; tr_item(a.in[10], DM, kb * 64, n0, (bf16_t*)(ws + WS_WO), DM, n0, scr, F.lane, ws + WS_WO8, false); }
    }
    float* cosT = (float*)(ws + WS_ROPE); float* sinT = cosT + 128 * 32;
    for (int i = blockIdx.x * 512 + F.tid; i < 128 * 32; i += F.G * 512) { const int pos = i >> 5, p = i & 31;
        const float inv = 1.0f / powf(10000.0f, (float)(2 * p) / 64.0f); const float ang = (float)pos * inv; cosT[i] = cosf(ang); sinT[i] = sinf(ang); }
    { const float* X = a.in[0]; const float* gm = a.in[1]; bf16_t* H = (bf16_t*)(ws + WS_H); const int lane = F.lane;
      f32x4 nx[8]; int m = gw;
      if (m < NTOK) { const GAS f32x4* xr = (const GAS f32x4*)(X + (size_t)m * DM) + lane;
#pragma unroll
          for (int j = 0; j < 8; ++j) nx[j] = xr[64 * j]; }
      for (; m < NTOK; m += NGW) { f32x4 v[8]; float s = 0.f;
#pragma unroll
          for (int j = 0; j < 8; ++j) { v[j] = nx[j]; s += (v[j].x * v[j].x + v[j].y * v[j].y) + (v[j].z * v[j].z + v[j].w * v[j].w); }
          { const int nm = m + NGW; if (nm < NTOK) { const GAS f32x4* xr = (const GAS f32x4*)(X + (size_t)nm * DM) + lane;
#pragma unroll
              for (int j = 0; j < 8; ++j) nx[j] = xr[64 * j]; } }
          const float rinv = 1.0f / sqrtf(wave_sum(s) * (1.f / DM) + EPS);
          GAS u32x2* o8 = (GAS u32x2*)(H + (size_t)m * DM) + lane;
#pragma unroll
          for (int j = 0; j < 8; ++j) { const f32x4 gv = ((const GAS f32x4*)gm + lane)[64 * j]; const f32x4 hv = v[j] * rinv * gv; (void)o8;
              int w8 = 0; w8 = __builtin_amdgcn_cvt_pk_fp8_f32(hv.x, hv.y, w8, false); w8 = __builtin_amdgcn_cvt_pk_fp8_f32(hv.z, hv.w, w8, true); ((GAS int*)(ws + WS_H8 + (size_t)m * DM) + lane)[64 * j] = w8; } } }
}

constexpr int CW_WCTR = 8192;
__device__ __forceinline__ void p_moe_weights(const Frame& F, const Args& a) {
    unsigned char* ws = a.ws; LAS float* scr = (LAS float*)(F.lds + F.wave * 16384);
    constexpr int I_GU = NEXP * (DM / 64) * (DFF / 32), I_D = NEXP * (DFF / 64) * (DM / 32), NIT = 2 * I_GU + I_D;
    unsigned* ctr = (unsigned*)(ws + WS_CTL) + CW_WCTR;
    for (;;) {
        unsigned it0 = 0; if (F.lane == 0) it0 = __hip_atomic_fetch_add(ctr, 4u, __ATOMIC_RELAXED, __HIP_MEMORY_SCOPE_AGENT);
        it0 = (unsigned)__builtin_amdgcn_readfirstlane((int)it0);
        if (it0 >= (unsigned)NIT) break;
        for (int k4 = 0; k4 < 4; ++k4) { int r = (int)it0 + k4; if (r >= NIT) break;
            if (r < 2 * I_GU) { const int up = r >= I_GU; if (up) r -= I_GU; constexpr int per = (DM / 64) * (DFF / 32); const int e = r / per, q = r % per, nb = DFF / 32, kb = q / nb, n0 = (q % nb) * 32;
                tr_item(a.in[up ? 14 : 13] + (size_t)e * DM * DFF, DFF, kb * 64, n0, (bf16_t*)(ws + WS_WGU), DM, (n0 >> 7) * 256 + (n0 & 127) + (up ? 128 : 0), scr, F.lane, ws + WS_WGU + (size_t)e * 2048 * DM, false); continue; }
            r -= 2 * I_GU;
            { constexpr int per = (DFF / 64) * (DM / 32); const int e = r / per, q = r % per, nb = DM / 32, kb = q / nb, n0 = (q % nb) * 32;
                tr_item(a.in[15] + (size_t)e * DFF * DM, DM, kb * 64, n0, (bf16_t*)(ws + WS_WD) + (size_t)e * 2048 * DFF, DFF, n0, scr, F.lane, ws + WS_WD8 + (size_t)e * 2048 * DFF, false); } }
    }
}

__device__ __forceinline__ void prep_vecs(const Frame& F, bf16_t* T, int ld, int nh_log2, const float* gain, const float* cosT, const float* sinT, float oscale, unsigned char* out8) {
    const int gw = F.vcu * NWAVES + F.wave, NGW = F.G * NWAVES;
    const int sub = F.lane & 15, half = sub >> 3, q = sub & 7;
    const int nvec = NTOK << nh_log2;
    const f32x4 g1 = *(const f32x4*)(gain + half * 64 + 4 * q), g2 = *(const f32x4*)(gain + half * 64 + 32 + 4 * q);
    for (int it = gw; it < nvec / 16; it += NGW) {
        bf16_t* base[4]; u32x2 w1[4], w2[4]; int posx[4];
#pragma unroll
        for (int u = 0; u < 4; ++u) { const int vec = it * 16 + u * 4 + (F.lane >> 4);
            const int tok = vec >> nh_log2, hd = vec & ((1 << nh_log2) - 1), pos = tok & (SEQ - 1); posx[u] = half ? (pos & 63) : (pos >> 6);
            base[u] = T + (size_t)tok * ld + hd * HD + half * 64 + 4 * q; w1[u] = *(const u32x2*)base[u]; w2[u] = *(const u32x2*)(base[u] + 32); }
#pragma unroll
        for (int u = 0; u < 4; ++u) {
            float x1[4] = {bf2f(w1[u].x & 0xffff), bf2f(w1[u].x >> 16), bf2f(w1[u].y & 0xffff), bf2f(w1[u].y >> 16)}, x2[4] = {bf2f(w2[u].x & 0xffff), bf2f(w2[u].x >> 16), bf2f(w2[u].y & 0xffff), bf2f(w2[u].y >> 16)};
            float ss = 0.f;
#pragma unroll
            for (int j = 0; j < 4; ++j) ss += x1[j] * x1[j] + x2[j] * x2[j];
            ss += __shfl_xor(ss, 1); ss += __shfl_xor(ss, 2); ss += __shfl_xor(ss, 4); ss += __shfl_xor(ss, 8);
            const float rinv = 1.0f / sqrtf(ss * (1.0f / 128.0f) + EPS);
            const f32x4 cs = *(const f32x4*)(cosT + posx[u] * 32 + 4 * q), sn = *(const f32x4*)(sinT + posx[u] * 32 + 4 * q);
            float y1[4], y2[4];
#pragma unroll
            for (int j = 0; j < 4; ++j) { const float a1 = x1[j] * rinv * g1[j], a2 = x2[j] * rinv * g2[j]; y1[j] = (a1 * cs[j] - a2 * sn[j]) * oscale; y2[j] = (a2 * cs[j] + a1 * sn[j]) * oscale; }
            if (out8) {
                const int vec = it * 16 + u * 4 + (F.lane >> 4), tok = vec >> nh_log2, hd = vec & ((1 << nh_log2) - 1);
                unsigned char* o8 = out8 + ((size_t)(((tok >> 13) << nh_log2) + hd) * SEQ + (tok & (SEQ - 1))) * HD + half * 64 + 4 * q;
                int w1 = 0, w2 = 0; w1 = __builtin_amdgcn_cvt_pk_fp8_f32(y1[0], y1[1], w1, false); w1 = __builtin_amdgcn_cvt_pk_fp8_f32(y1[2], y1[3], w1, true);
                w2 = __builtin_amdgcn_cvt_pk_fp8_f32(y2[0], y2[1], w2, false); w2 = __builtin_amdgcn_cvt_pk_fp8_f32(y2[2], y2[3], w2, true);
                *(int*)o8 = w1; *(int*)(o8 + 32) = w2;
            } else {
            u32x2 o1, o2; o1.x = cvt_pk_bf16(y1[0], y1[1]); o1.y = cvt_pk_bf16(y1[2], y1[3]); o2.x = cvt_pk_bf16(y2[0], y2[1]); o2.y = cvt_pk_bf16(y2[2], y2[3]);
            *(u32x2*)base[u] = o1; *(u32x2*)(base[u] + 32) = o2; } }
    }
}
__device__ __forceinline__ void p2_qkprep(const Frame& F, const Args& a) {
    const float* cosT = (const float*)(a.ws + WS_ROPE); const float* sinT = cosT + 128 * 32;
    prep_vecs(F, (bf16_t*)(a.ws + WS_KA), KVW, 1, a.in[5], cosT, sinT, 1.0f, a.ws + WS_K8);
    { const bf16_t* VA = (const bf16_t*)(a.ws + WS_VA); unsigned char* V8T = a.ws + WS_V8T; LAS bf16_t* tl = (LAS bf16_t*)F.lds; constexpr int TP = 132;
      for (int T = F.vcu; T < BATCH * 2 * 64; T += F.G) { const int bk = T >> 6, t = T & 63, b = bk >> 1, kvh = bk & 1;
        { const int r = F.tid >> 2, qd = F.tid & 3; const bf16_t* src = VA + ((size_t)b * SEQ + 128 * t + r) * KVW + kvh * HD + qd * 32;
#pragma unroll
          for (int i = 0; i < 4; ++i) { const u32x4 v = *(const u32x4*)(src + 8 * i); LAS unsigned* d = (LAS unsigned*)(tl + r * TP + qd * 32 + 8 * i); d[0] = v.x; d[1] = v.y; d[2] = v.z; d[3] = v.w; } }
        __syncthreads();
        { const int d = F.tid >> 2, g = F.tid & 3; int w[8];
#pragma unroll
          for (int kb = 0; kb < 8; ++kb) { float x[4];
#pragma unroll
            for (int r = 0; r < 4; ++r) x[r] = bf2f(tl[(16 * kb + 4 * g + r) * TP + d]);
            int ww = 0; ww = __builtin_amdgcn_cvt_pk_fp8_f32(x[0], x[1], ww, false); ww = __builtin_amdgcn_cvt_pk_fp8_f32(x[2], x[3], ww, true); w[kb] = ww; }
          unsigned char* dst = V8T + ((size_t)T * HD + d) * 128 + 32 * g;
          *(u32x4*)dst = (u32x4){(unsigned)w[0], (unsigned)w[1], (unsigned)w[2], (unsigned)w[3]}; *(u32x4*)(dst + 16) = (u32x4){(unsigned)w[4], (unsigned)w[5], (unsigned)w[6], (unsigned)w[7]}; }
        __syncthreads(); } }
}

template <int MODE> __device__ __forceinline__ void p3_attention(const Frame& F, const Args& a, char* lds) {
    unsigned char* ws = a.ws;
    const bf16_t* Q = (const bf16_t*)(ws + (MODE == 0 ? WS_QA : WS_QB)); const bf16_t* K = (const bf16_t*)(ws + (MODE == 0 ? WS_KA : WS_KB)); const bf16_t* V = (const bf16_t*)(ws + (MODE == 0 ? WS_VA : WS_VB));
    att::Aux aux; aux.cosT = (const float*)(ws + WS_ROPE); aux.sinT = aux.cosT + 128 * 32; aux.qn = a.in[4]; aux.kn = a.in[5]; aux.relb = a.in[8]; aux.sink = a.in[7];
#define BUILD_TABS(kvh_) do { float* tabs_ = (float*)(lds + att::OFF_TAB); for (int i_ = F.tid; i_ < 4 * 768; i_ += 512) { const int hh_ = i_ / 768, ii_ = i_ - hh_ * 768, rel_ = ii_ - 383, n_ = rel_ < 0 ? -rel_ : rel_; float v_ = -1e30f; \
        if (n_ <= 128) v_ = aux.relb[att::t5_bucket(rel_) * NHB + (kvh_) * 4 + hh_] * LOG2E; tabs_[i_] = v_; } } while (0)
    float pscale = 1.f;
    if (MODE == 0) { float mq = fmaxf(fabsf(aux.qn[F.lane]), fabsf(aux.qn[64 + F.lane])), mk = fmaxf(fabsf(aux.kn[F.lane]), fabsf(aux.kn[64 + F.lane]));
#pragma unroll
        for (int of = 1; of < 64; of <<= 1) { mq = fmaxf(mq, __shfl_xor(mq, of)); mk = fmaxf(mk, __shfl_xor(mk, of)); }
        const float bound = att::C * 128.0f * mq * mk * 1.13f + 0.5f; pscale = __builtin_amdgcn_exp2f(fmaxf(ceilf(bound) - 15.f, 0.f));
        pscale = __uint_as_float(__builtin_amdgcn_readfirstlane(__float_as_uint(pscale))); }
    const bool shared_tabs = (F.G == 256);
    if (MODE == 1 && shared_tabs) { BUILD_TABS((F.vcu >> 5) & 1); __syncthreads(); }
    for (int i = 0;; ++i) {
        const int L = i * F.G + F.vcu; if (L >= 1024) break;
        const int x = (L & 255) >> 5, b = x >> 1, kvh = x & 1;
        const int qb = (MODE == 0) ? (L & 31) : ((L >> 8) * 32 + (L & 31));
        const int head = (MODE == 0) ? kvh * 4 + (L >> 8) : kvh * 4, q0 = qb * ((MODE == 0) ? 256 : 64);
        const bf16_t* Qb = Q + ((size_t)b * SEQ + q0) * QW + head * HD;
        const bf16_t* Kh = K + (size_t)b * SEQ * KVW + kvh * HD; const bf16_t* Vh = V + (size_t)b * SEQ * KVW + kvh * HD;
        int kbeg = 0, kend = SEQ;
        if (MODE == 1) { kbeg = q0 - 128 < 0 ? 0 : q0 - 128; kend = q0 + 192 > SEQ ? SEQ : q0 + 192; }
        if (MODE == 1 && !shared_tabs) { __syncthreads(); BUILD_TABS(kvh); __syncthreads(); }
        unsigned char* Ob8 = ws + (MODE == 0 ? WS_OA8 : WS_OB8) + ((size_t)b * SEQ + q0) * QW + head * HD;
        if constexpr (MODE == 0) att::attn_unit8(Qb, a.ws + WS_K8 + (size_t)(b * 2 + kvh) * SEQ * HD, a.ws + WS_V8T + (size_t)(b * 2 + kvh) * 64 * 16384, Ob8, q0, lds, aux, pscale);
        else att::attn_unit_pp<MODE>(Qb, Kh, Vh, Ob8, kbeg, kend, q0, head, lds, aux);
    }
#undef BUILD_TABS
}

__device__ __forceinline__ void p7_router(const Frame& F, const Args& a) {
    LAS float* wl = (LAS float*)F.lds;
    const float* wr = a.in[12];
    for (int i = F.tid; i < DM * NEXP / 4; i += 512) { const f32x4 v = *(const f32x4*)(wr + 4 * i); const int k = i >> 2, e0 = (i & 3) * 4;
        wl[(e0 + 0) * DM + k] = v.x; wl[(e0 + 1) * DM + k] = v.y; wl[(e0 + 2) * DM + k] = v.z; wl[(e0 + 3) * DM + k] = v.w; }
    __syncthreads();
    const float* X = a.in[0]; const bf16_t* ATT = (const bf16_t*)(a.ws + WS_ATT); bf16_t* H2 = (bf16_t*)(a.ws + WS_H); float* AFF = (float*)(a.ws + WS_AFF); const float* g = a.in[11];
    const int gw = F.vcu * NWAVES + F.wave, NGW = F.G * NWAVES, lane = F.lane;
    f32x4 nx[2][8]; u32x2 na[2][8];
#define RT_LOAD(rp_) do { _Pragma("unroll") for (int rr = 0; rr < 2; ++rr) { const size_t row_ = (size_t)(2 * (rp_) + rr); const GAS f32x4* xr = (const GAS f32x4*)(X + row_ * DM) + lane; const GAS u32x2* ar = (const GAS u32x2*)(ATT + row_ * DM) + lane; \
        _Pragma("unroll") for (int j = 0; j < 8; ++j) { nx[rr][j] = xr[64 * j]; if (DBG_LEVEL >= 3) na[rr][j] = ar[64 * j]; else na[rr][j] = (u32x2){0u, 0u}; } } } while (0)
    int rp = gw;
    if (rp < NTOK / 2) RT_LOAD(rp);
    for (; rp < NTOK / 2; rp += NGW) {
        f32x4 h[2][8]; float rinv[2];
#pragma unroll
        for (int rr = 0; rr < 2; ++rr) { float s = 0.f;
#pragma unroll
            for (int j = 0; j < 8; ++j) { f32x4 v = nx[rr][j]; const u32x2 w = na[rr][j]; v.x += __uint_as_float(w.x << 16); v.y += __uint_as_float(w.x & 0xffff0000u); v.z += __uint_as_float(w.y << 16); v.w += __uint_as_float(w.y & 0xffff0000u);
                h[rr][j] = v; s += (v.x * v.x + v.y * v.y) + (v.z * v.z + v.w * v.w); }
            rinv[rr] = s; }
#if DBG_LEVEL >= 3
#pragma unroll
        for (int rr = 0; rr < 2; ++rr) { GAS u32x2* x8 = (GAS u32x2*)((bf16_t*)(a.ws + WS_ATT) + (size_t)(2 * rp + rr) * DM) + lane;
#pragma unroll
            for (int j = 0; j < 8; ++j) { u32x2 w; w.x = cvt_pk_bf16(h[rr][j].x, h[rr][j].y); w.y = cvt_pk_bf16(h[rr][j].z, h[rr][j].w); x8[64 * j] = w; } }
#endif
        { const int nrp = rp + NGW; if (nrp < NTOK / 2) RT_LOAD(nrp); }
#pragma unroll
        for (int rr = 0; rr < 2; ++rr) { rinv[rr] = 1.0f / sqrtf(wave_sum(rinv[rr]) * (1.f / DM) + EPS);
            GAS int* o8 = (GAS int*)((unsigned char*)H2 + (size_t)(2 * rp + rr) * DM) + lane;
#pragma unroll
            for (int j = 0; j < 8; ++j) { const f32x4 gv = ((const GAS f32x4*)g + lane)[64 * j]; h[rr][j] = h[rr][j] * rinv[rr] * gv;
                int w = 0; w = __builtin_amdgcn_cvt_pk_fp8_f32(h[rr][j].x, h[rr][j].y, w, false); w = __builtin_amdgcn_cvt_pk_fp8_f32(h[rr][j].z, h[rr][j].w, w, true); o8[64 * j] = w; } }
        float v[32];
#pragma unroll
        for (int e = 0; e < NEXP; ++e) { float s0 = 0.f, s1 = 0.f;
#pragma unroll
            for (int j = 0; j < 8; ++j) { const f32x4 w = *(const LAS f32x4*)(wl + e * DM + 4 * lane + 256 * j);
                s0 += (h[0][j].x * w.x + h[0][j].y * w.y) + (h[0][j].z * w.z + h[0][j].w * w.w); s1 += (h[1][j].x * w.x + h[1][j].y * w.y) + (h[1][j].z * w.z + h[1][j].w * w.w); }
            v[e] = s0; v[16 + e] = s1; }
#pragma unroll
        for (int off = 16; off >= 1; off >>= 1) { const bool up = (lane & off) != 0;
#pragma unroll
            for (int i = 0; i < off; ++i) { const float lo = v[i], hi = v[i + off]; const float keep = up ? hi : lo, send = up ? lo : hi; v[i] = keep + __shfl_xor(send, off); } }
        const float mine = v[0] + __shfl_xor(v[0], 32);
        float mx = mine; mx = fmaxf(mx, __shfl_xor(mx, 1)); mx = fmaxf(mx, __shfl_xor(mx, 2)); mx = fmaxf(mx, __shfl_xor(mx, 4)); mx = fmaxf(mx, __shfl_xor(mx, 8));
        const float ex = expf(mine - mx); float sm = ex; sm += __shfl_xor(sm, 1); sm += __shfl_xor(sm, 2); sm += __shfl_xor(sm, 4); sm += __shfl_xor(sm, 8);
        if (lane < 32) { const int row = 2 * rp + (lane >> 4), e = lane & 15, b = row >> 13, s = row & (SEQ - 1); AFF[((size_t)(b * NEXP + e)) * SEQ + s] = ex / sm; }
    }
#undef RT_LOAD
    __syncthreads();
}

__device__ __forceinline__ int block_excl_scan(int v, LAS int* sc, int tid, int& total) {
    const int lane = tid & 63, w = tid >> 6; int x = v;
#pragma unroll
    for (int o = 1; o < 64; o <<= 1) { const int y = __shfl_up(x, o); if (lane >= o) x += y; }
    __syncthreads();
    if (lane == 63) sc[w] = x;
    __syncthreads();
    int pre = 0, tot = 0;
#pragma unroll
    for (int j = 0; j < 8; ++j) { const int s = sc[j]; if (j < w) pre += s; tot += s; }
    total = tot; return pre + x - v;
}
__device__ __forceinline__ void p8_topk(const Frame& F, const Args& a) {
    const float* AFF = (const float*)(a.ws + WS_AFF); int* IDX = (int*)(a.ws + WS_IDX); float* GATEV = (float*)(a.ws + WS_GATEV); int* INV = (int*)(a.ws + WS_INV);
    LAS int* hist = (LAS int*)F.lds; LAS int* sc = hist + 256; LAS int* res = sc + 16;
    const int tid = F.tid, lane = F.lane;
    for (int list = F.vcu; list < NLIST; list += F.G) {
        const int b = list / NEXP, e = list % NEXP;
        unsigned key[16];
        { const u32x4* src = (const u32x4*)(AFF + (size_t)list * SEQ + tid * 16);
#pragma unroll
            for (int j = 0; j < 4; ++j) { const u32x4 v = src[j]; key[4 * j] = v.x; key[4 * j + 1] = v.y; key[4 * j + 2] = v.z; key[4 * j + 3] = v.w; } }
        unsigned prefix = 0u, pmask = 0u; int krem = CAP;
#pragma unroll 1
        for (int pass = 0; pass < 4; ++pass) { const int shift = 24 - 8 * pass;
            __syncthreads();
            if (tid < 256) hist[tid] = 0;
            __syncthreads();
#pragma unroll
            for (int j = 0; j < 16; ++j) if ((key[j] & pmask) == prefix) __hip_atomic_fetch_add(&hist[(key[j] >> shift) & 255u], 1, __ATOMIC_RELAXED, __HIP_MEMORY_SCOPE_WORKGROUP);
            __syncthreads();
            if (tid < 64) {
                int c[4]; int s = 0;
#pragma unroll
                for (int j = 0; j < 4; ++j) { c[j] = hist[4 * lane + j]; s += c[j]; }
                int suf = s;
#pragma unroll
                for (int o = 1; o < 64; o <<= 1) { const int y = __shfl_down(suf, o); if (lane + o < 64) suf += y; }
                const int excl = suf - s;
                if (suf >= krem && excl < krem) { int cum = excl, bin = 4 * lane, kn = krem;
#pragma unroll
                    for (int j = 3; j >= 0; --j) { if (cum < krem && cum + c[j] >= krem) { bin = 4 * lane + j; kn = krem - cum; } cum += c[j]; }
                    res[0] = bin; res[1] = kn; }
            }
            __syncthreads();
            const int bin = res[0]; krem = res[1];
            prefix |= ((unsigned)bin) << shift; pmask |= 255u << shift;
        }
        const unsigned T = prefix;
        int ceq = 0;
#pragma unroll
        for (int j = 0; j < 16; ++j) ceq += (key[j] == T) ? 1 : 0;
        int toteq; const int eqb = block_excl_scan(ceq, sc, tid, toteq);
        int csel = 0, er = eqb; unsigned selmask = 0u;
#pragma unroll
        for (int j = 0; j < 16; ++j) { bool s = key[j] > T; if (key[j] == T) { s = er < krem; ++er; } if (s) { selmask |= 1u << j; ++csel; } }
        int totsel; int pos = block_excl_scan(csel, sc, tid, totsel);
#pragma unroll
        for (int j = 0; j < 16; ++j) { const int tokpos = tid * 16 + j; int slot = -1;
            if (selmask & (1u << j)) { slot = list * CAP + pos; IDX[slot] = tokpos; GATEV[slot] = __uint_as_float(key[j]); ++pos; }
            INV[((size_t)b * SEQ + tokpos) * NEXP + e] = slot; }
        __syncthreads();
    }
}

__device__ __forceinline__ void p11_final(const Frame& F, const Args& a, bool with_moe) {
    const float* X = a.in[0]; float* OUT = a.out; const bf16_t* ATT = (const bf16_t*)(a.ws + WS_ATT); const bf16_t* Y = (const bf16_t*)(a.ws + WS_Y); const int* INV = (const int*)(a.ws + WS_INV); const float* g = a.in[16];
    const int gw = F.vcu * NWAVES + F.wave, NGW = F.G * NWAVES, lane = F.lane;
    f32x4 nx[8]; u32x2 na[8]; int ninv = -1;
#define FN_LOAD(m_) do { const GAS f32x4* xr = (const GAS f32x4*)(X + (size_t)(m_) * DM) + lane; const GAS u32x2* ar = (const GAS u32x2*)(ATT + (size_t)(m_) * DM) + lane; \
        _Pragma("unroll") for (int j = 0; j < 8; ++j) { if (DBG_LEVEL >= 3) na[j] = ar[64 * j]; else nx[j] = xr[64 * j]; } \
        ninv = (with_moe && lane < NEXP) ? INV[(size_t)(m_) * NEXP + lane] : -1; } while (0)
    int m = gw;
    if (m < NTOK) FN_LOAD(m);
    for (; m < NTOK; m += NGW) {
        f32x4 v[8]; const int myinv = ninv;
#pragma unroll
        for (int j = 0; j < 8; ++j) { if (DBG_LEVEL >= 3) { const u32x2 w = na[j]; v[j].x = __uint_as_float(w.x << 16); v[j].y = __uint_as_float(w.x & 0xffff0000u); v[j].z = __uint_as_float(w.y << 16); v[j].w = __uint_as_float(w.y & 0xffff0000u); } else v[j] = nx[j]; }
        unsigned long long mask = __ballot(myinv >= 0);
        u32x2 y0[8]; const bool has0 = mask != 0ull;
        if (has0) { const int e = __builtin_ctzll(mask); mask &= mask - 1; const int slot = __builtin_amdgcn_readlane(myinv, e); const GAS u32x2* yr = (const GAS u32x2*)(Y + (size_t)slot * DM) + lane;
#pragma unroll
            for (int j = 0; j < 8; ++j) y0[j] = yr[64 * j]; }
        { const int nm = m + NGW; if (nm < NTOK) FN_LOAD(nm); }
        if (has0) {
#pragma unroll
            for (int j = 0; j < 8; ++j) { const u32x2 w = y0[j]; v[j].x += __uint_as_float(w.x << 16); v[j].y += __uint_as_float(w.x & 0xffff0000u); v[j].z += __uint_as_float(w.y << 16); v[j].w += __uint_as_float(w.y & 0xffff0000u); } }
        while (mask) { const int e = __builtin_ctzll(mask); mask &= mask - 1; const int slot = __builtin_amdgcn_readlane(myinv, e);
            const GAS u32x2* yr = (const GAS u32x2*)(Y + (size_t)slot * DM) + lane;
#pragma unroll
            for (int j = 0; j < 8; ++j) { const u32x2 w = yr[64 * j]; v[j].x += __uint_as_float(w.x << 16); v[j].y += __uint_as_float(w.x & 0xffff0000u); v[j].z += __uint_as_float(w.y << 16); v[j].w += __uint_as_float(w.y & 0xffff0000u); } }
        float s = 0.f;
#pragma unroll
        for (int j = 0; j < 8; ++j) s += (v[j].x * v[j].x + v[j].y * v[j].y) + (v[j].z * v[j].z + v[j].w * v[j].w);
        const float rinv = 1.0f / sqrtf(wave_sum(s) * (1.f / DM) + EPS);
        GAS f32x4* orow = (GAS f32x4*)(OUT + (size_t)m * DM) + lane;
#pragma unroll
        for (int j = 0; j < 8; ++j) { const f32x4 gv = ((const GAS f32x4*)g + lane)[64 * j]; orow[64 * j] = v[j] * rinv * gv; }
    }
#undef FN_LOAD
}
__device__ __forceinline__ void p_copy_x(const Frame& F, const Args& a) {
    const f32x4* src = (const f32x4*)a.in[0]; f32x4* dst = (f32x4*)a.out;
    for (size_t i = (size_t)blockIdx.x * 512 + F.tid; i < (size_t)NTOK * DM / 4; i += (size_t)F.G * 512) dst[i] = src[i];
}

constexpr int NPHASE = 10;
__global__ void __launch_bounds__(NWAVES * 64, 2) fwd_kernel(Args args) {
    extern __shared__ __attribute__((aligned(16))) unsigned char lds[];
    Frame F;
    F.lds = (LAS unsigned char*)lds;
    F.tid = threadIdx.x; F.lane = F.tid & 63; F.wave = __builtin_amdgcn_readfirstlane(F.tid >> 6);
    F.G = gridDim.x; { const int bx = blockIdx.x; F.vcu = (F.G % 8 == 0) ? (bx % 8) * (F.G / 8) + bx / 8 : bx; }
    unsigned char* ws = args.ws;
    gu32* ctl = (gu32*)(ws + WS_CTL);
    for (int u = F.tid; u < (LDS_BYTES - LDSCTL_OFF) / 4; u += NWAVES * 64) ((LAS unsigned*)(F.lds + LDSCTL_OFF))[u] = 0u;
    __syncthreads();
    XcdBarrier bar; bar.bar = (unsigned*)(ctl + CW_BAR); bar.x = 0; bar.st = nullptr;
    if (MK_N_LAUNCHES == 1) bar = xcd_barrier_post((unsigned*)(ctl + CW_BAR), (volatile LAS unsigned*)(F.lds + LDSCTL_OFF + 64));
    const int lo = args.ph_lo, hi = args.ph_hi;
#define IN(k) (lo <= (k) && (k) < hi)
#define SEAM(k) do { if (IN(k) && IN((k) + 1)) xcd_barrier(bar); } while (0)
#define REFRAME() do { int t_ = threadIdx.x; asm volatile("" : "+v"(t_)); F.tid = t_; F.lane = t_ & 63; F.wave = __builtin_amdgcn_readfirstlane(t_ >> 6); } while (0)

    if (IN(0)) { REFRAME(); for (int rep = 0; rep < REPS(0); ++rep) p0_prologue(F, args); }
    SEAM(0);
    if (IN(1)) { REFRAME();
#if DBG_LEVEL >= 3
        { pg8::MapProb<DM, 0, 1> P; P.A = ws + WS_H8; P.Bt = ws + WS_WIN8; P.S.init(NTOK, INW, F.G, (int)blockIdx.x);
          pg8::EpiInProj E{(bf16_t*)(ws + WS_QA), (bf16_t*)(ws + WS_KA), (bf16_t*)(ws + WS_VA), (bf16_t*)(ws + WS_QB), (bf16_t*)(ws + WS_KB), (bf16_t*)(ws + WS_VB), (bf16_t*)(ws + WS_GA), (bf16_t*)(ws + WS_GB), args.in[3], 1.0f / W8S};
          pg8::gemm_phase8<pg8::EpiInProj, pg8::MapProb<DM, 0, 1>, true>(F.lds, P, E); }
#endif
    }
    SEAM(1);
    if (IN(2)) { REFRAME();
#if DBG_LEVEL >= 4
        p2_qkprep(F, args);
#endif
    }
    SEAM(2);
    if (IN(3)) { REFRAME();
#if DBG_LEVEL >= 4
        for (int rep = 0; rep < REPS(3); ++rep) p3_attention<0>(F, args, (char*)lds);
#endif
#if DBG_LEVEL >= 3
        __syncthreads();
        for (int rep = 0; rep < REPS(13); ++rep) p3_attention<1>(F, args, (char*)lds);
        __syncthreads();
#endif
    }
    SEAM(3);
    if (IN(4)) { REFRAME();
#if DBG_LEVEL >= 4
        { pg8::MapProb<QW, 0, 1> P; P.A = ws + WS_OA8; P.Bt = ws + WS_WPA8; P.S.init(NTOK, DM, F.G, (int)blockIdx.x);
          pg8::EpiGated8<0> E{(bf16_t*)(ws + WS_GA), nullptr, nullptr, 1.0f / (OA8S * W8S)};
          pg8::gemm_phase8<pg8::EpiGated8<0>, pg8::MapProb<QW, 0, 1>, true>(F.lds, P, E); }
        { int gg_ = F.G; asm volatile("" : "+s"(gg_)); unsigned char* ws2_ = ws; asm volatile("" : "+s"(ws2_));
          pg8::MapProb<QW, 0, 1> P; P.A = ws2_ + WS_OB8; P.Bt = ws2_ + WS_WPB8; P.S.init(NTOK, DM, gg_, (int)blockIdx.x);
          pg8::EpiGated8<1> E{(bf16_t*)(ws2_ + WS_GA), (const bf16_t*)(ws2_ + WS_GB), ws2_ + WS_M8, 1.0f / (OB8S * W8S)};
          pg8::gemm_phase8<pg8::EpiGated8<1>, pg8::MapProb<QW, 0, 1>, true>(F.lds, P, E); }
#endif
    }
    SEAM(4);
    if (IN(5)) { REFRAME();
#if DBG_LEVEL >= 3
        pg8::MapProb<DM, 0, 1> P; P.A = ws + WS_M8; P.Bt = ws + WS_WO8; P.S.init(NTOK, DM, F.G, (int)blockIdx.x);
        pg8::EpiAtt E{(bf16_t*)(ws + WS_ATT), 1.0f / (M8S * W8S)};
        for (int rep = 0; rep < REPS(5); ++rep) pg8::gemm_phase8<pg8::EpiAtt, pg8::MapProb<DM, 0, 1>, true>(F.lds, P, E);
#endif
    }
    SEAM(5);
    if (IN(6)) { REFRAME();
#if DBG_LEVEL >= 2
        for (int rep = 0; rep < REPS(6); ++rep) p7_router(F, args);
#endif
    }
    SEAM(6);
    if (IN(7)) { REFRAME();
#if DBG_LEVEL >= 2
        for (int rep = 0; rep < REPS(7); ++rep) p8_topk(F, args);
        __syncthreads();
        p_moe_weights(F, args);
#endif
    }
    SEAM(7);
    if (IN(8)) { REFRAME();
#if DBG_LEVEL >= 2
        LAS unsigned* rowoff = (LAS unsigned*)(F.lds + pg8::STAGE_BYTES);
        const int* IDX = (const int*)(ws + WS_IDX);
        for (int i = 0; i < 8; ++i) { pg8::Unit u; int e, b; if (!pg8::moe_unit(i, F.G, F.vcu, u, e, b)) break;
            if (F.tid < 256) rowoff[i * 256 + F.tid] = (unsigned)IDX[u.pm * 256 + F.tid] * (unsigned)DM; }
        __syncthreads();
        pg8::GuProb8 P; P.H2 = ws + WS_H; P.W = ws + WS_WGU; P.rowoff = rowoff; P.G = F.G; P.vcu = F.vcu;
        pg8::EpiSwiglu E{ws + WS_GA, 1.0f / W8S};
        for (int rep = 0; rep < REPS(8); ++rep) pg8::gemm_phase8<pg8::EpiSwiglu, pg8::GuProb8, true>(F.lds, P, E);
#endif
    }
    SEAM(8);
    if (IN(9)) { REFRAME();
#if DBG_LEVEL >= 2
        pg8::DownProb8 P; P.HID = ws + WS_GA; P.W = ws + WS_WD8; P.G = F.G; P.vcu = F.vcu;
        pg8::EpiDown E{(bf16_t*)(ws + WS_Y), (const float*)(ws + WS_GATEV), 1.0f / W8S};
        for (int rep = 0; rep < REPS(9); ++rep) pg8::gemm_phase8<pg8::EpiDown, pg8::DownProb8, true>(F.lds, P, E);
#endif
    }
    SEAM(9);
    if (IN(10)) { REFRAME(); p11_final(F, args, DBG_LEVEL >= 2); }
#undef IN
#undef SEAM
}

extern "C" void kernel_launch(void* const* d_in, const int* in_sizes, int n_in, void* d_out, int out_size, void* d_ws, size_t ws_size, hipStream_t stream) {
    static int grid = 0;
    if (grid == 0) {
        if (n_in != 17 || in_sizes[0] != NTOK * DM || out_size != NTOK * DM || ws_size < WS_END) { fprintf(stderr, "kernel_launch: unexpected shapes (n_in %d, in0 %d, out %d, ws %zu); nothing launched\n", n_in, n_in > 0 ? in_sizes[0] : -1, out_size, ws_size); grid = -1; return; }
        int dev = 0, cus = 0, per_cu = 0;
        if (hipGetDevice(&dev) != hipSuccess || hipDeviceGetAttribute(&cus, hipDeviceAttributeMultiprocessorCount, dev) != hipSuccess) { grid = -1; return; }
        if (hipFuncSetAttribute((const void*)fwd_kernel, hipFuncAttributeMaxDynamicSharedMemorySize, LDS_BYTES) != hipSuccess) { fprintf(stderr, "kernel_launch: hipFuncSetAttribute failed\n"); grid = -1; return; }
        if (hipOccupancyMaxActiveBlocksPerMultiprocessor(&per_cu, (const void*)fwd_kernel, NWAVES * 64, LDS_BYTES) != hipSuccess || per_cu < 1)
            fprintf(stderr, "kernel_launch: note: occupancy query reports %d workgroups per CU\n", per_cu);
        (void)hipGetLastError();
        grid = cus;
    }
    if (grid < 0) return;
    (void)hipMemsetAsync((char*)d_ws + WS_CTL, 0, CTL_ZERO_BYTES, stream);
    Args a{};
    for (int i = 0; i < 17; ++i) a.in[i] = (const float*)d_in[i];
    a.out = (float*)d_out; a.ws = (unsigned char*)d_ws;
#if MK_N_LAUNCHES == 1
    a.ph_lo = 0; a.ph_hi = NPHASE + 1; a.li = 0;
    hipLaunchKernelGGL(fwd_kernel, dim3(grid), dim3(NWAVES * 64), LDS_BYTES, stream, a);
#else
    for (int li = 0; li <= NPHASE; ++li) { a.ph_lo = li; a.ph_hi = li + 1; a.li = li;
        hipLaunchKernelGGL(fwd_kernel, dim3(grid), dim3(NWAVES * 64), LDS_BYTES, stream, a); }
#endif
    const hipError_t le = hipPeekAtLastError();
    if (le != hipSuccess) fprintf(stderr, "kernel_launch: launch failed: %s\n", hipGetErrorName(le));
}
```

```cpp
#include <hip/hip_runtime.h>
#include <cstdio>
#include <cstdint>

#ifndef MK_N_LAUNCHES
#define MK_N_LAUNCHES 1
#endif
#ifndef DBG_LEVEL
#define DBG_LEVEL 4
#endif

#ifndef REP_PHASE
#define REP_PHASE -1
#endif
#define REPS(k) ((REP_PHASE == (k)) ? 2 : 1)
#define GAS __attribute__((address_space(1)))
#define LAS __attribute__((address_space(3)))
typedef unsigned short bf16_t;
typedef short bf16x8 __attribute__((ext_vector_type(8)));
typedef short s16x4 __attribute__((ext_vector_type(4)));
typedef float f32x2 __attribute__((ext_vector_type(2)));
typedef float f32x4 __attribute__((ext_vector_type(4)));
typedef float f32x8 __attribute__((ext_vector_type(8)));
typedef float f32x16 __attribute__((ext_vector_type(16)));
typedef unsigned u32x2 __attribute__((ext_vector_type(2)));
typedef unsigned u32x4 __attribute__((ext_vector_type(4)));
typedef GAS unsigned gu32;

constexpr int BATCH = 4, SEQ = 8192, DM = 2048, NTOK = BATCH * SEQ, HD = 128;
constexpr int NHA = 8, NHB = 8;
constexpr int QW = 1024, KVW = 256, INW = 7168;
constexpr int NEXP = 16, CAP = 1024, DFF = 1024, NLIST = BATCH * NEXP, NSLOT = NLIST * CAP;
constexpr float EPS = 1e-6f, LOG2E = 1.4426950408889634f;

constexpr size_t MiB = 1u << 20;
constexpr size_t WS_CTL = 0, CTL_ZERO_BYTES = 1 * MiB;
constexpr size_t WS_ROPE = 1 * MiB;
constexpr size_t WS_AFF = 2 * MiB;
constexpr size_t WS_IDX = 4 * MiB;
constexpr size_t WS_GATEV = 4 * MiB + 256 * 1024;
constexpr size_t WS_INV = 5 * MiB;
constexpr size_t WS_WIN = 8 * MiB;
constexpr size_t WS_WPA = 36 * MiB;
constexpr size_t WS_WPB = 40 * MiB;
constexpr size_t WS_WO = 44 * MiB;
constexpr size_t WS_WGU = 52 * MiB;
constexpr size_t WS_WD = 180 * MiB;
constexpr size_t WS_H = 244 * MiB;
constexpr size_t WS_GA = 372 * MiB;
constexpr size_t WS_GB = 500 * MiB;
constexpr size_t WS_QA = 628 * MiB, WS_KA = 692 * MiB, WS_VA = 708 * MiB, WS_QB = 724 * MiB, WS_KB = 788 * MiB, WS_VB = 804 * MiB;
constexpr size_t WS_Y = 500 * MiB;
constexpr size_t WS_OA = 820 * MiB, WS_OB = 884 * MiB;
constexpr size_t WS_ATT = 820 * MiB;
constexpr size_t WS_K8 = 948 * MiB;
constexpr size_t WS_V8T = 956 * MiB;
constexpr size_t WS_H8 = 820 * MiB;
constexpr size_t WS_WIN8 = 964 * MiB;
constexpr size_t WS_WPA8 = 978 * MiB, WS_WPB8 = 980 * MiB;
constexpr size_t WS_WO8 = 982 * MiB;
constexpr size_t WS_WD8 = 986 * MiB;
constexpr size_t WS_END = 1018 * MiB;
constexpr size_t WS_OA8 = 820 * MiB, WS_OB8 = 884 * MiB;
constexpr size_t WS_M8 = 244 * MiB;
constexpr float OB8S = 8.f, M8S = 16.f;
constexpr float W8S = 32.f, OA8S = 64.f;
constexpr int CW_TMO = 0;
constexpr int CW_BAR = 4096;

constexpr int LDS_SCRATCH = 155648;
constexpr int LDSCTL_OFF = LDS_SCRATCH;
constexpr int LDS_BYTES = LDS_SCRATCH + 512;

__device__ __forceinline__ unsigned cvt_pk_bf16(float lo, float hi) { unsigned r; asm volatile("v_cvt_pk_bf16_f32 %0, %1, %2" : "=v"(r) : "v"(lo), "v"(hi)); return r; }
__device__ __forceinline__ float bf2f(unsigned short v) { return __uint_as_float(((unsigned)v) << 16); }
__device__ __forceinline__ unsigned short f2bf(float f) { return (unsigned short)(cvt_pk_bf16(f, 0.f) & 0xffffu); }
__device__ __forceinline__ float wave_sum(float v) {
#pragma unroll
    for (int o = 1; o < 64; o <<= 1) v += __shfl_xor(v, o);
    return v;
}
__device__ __forceinline__ float sigmoidf_fast(float z) { return __builtin_amdgcn_rcpf(1.f + __builtin_amdgcn_exp2f(-z * LOG2E)); }
#define LDS_WAIT() asm volatile("s_waitcnt lgkmcnt(0)" ::: "memory")
#define VM_WAIT() asm volatile("s_waitcnt vmcnt(0)" ::: "memory")

namespace pg8 {
constexpr int BM = 256, BK = 64, HALF = 128, HTB = HALF * BK * 2, STAGE_BYTES = 8 * HTB;
__host__ __device__ __forceinline__ int lds_byte(int r, int c) { const int st = (r >> 4) * 2 + (c >> 5), rr = r & 15, cc = c & 31, ob = rr * 64 + cc * 2; return st * 1024 + (ob ^ (((ob >> 9) & 1) << 5)); }
__host__ __device__ __forceinline__ void stage_rc(int b, int& R, int& C) { const int st = b / 1024, sb = b % 1024, swz = sb ^ (((sb >> 9) & 1) << 5); R = (st >> 1) * 16 + swz / 64; C = (st & 1) * 32 + (swz % 64) / 2; }
__host__ __device__ __forceinline__ int perm32(int rho) { const int n = rho >> 4, i = rho & 15; return 8 * (i >> 2) + 4 * n + (i & 3); }

struct Unit { int pm, pn, ord; };

struct StaticOrder {
    int nM, nN, nwg, G, c;
    __device__ void init(int M, int N, int G_, int c_) { nM = M / BM; nN = N / BM; nwg = nM * nN; G = G_; c = c_; }
    __device__ bool next(int i, Unit& u) const {
        const long L = (long)i * G + c; if (L >= nwg) return false;
        int wgid = (int)L; { const int q = nwg / 8, r = nwg % 8, xcd = wgid % 8, off = wgid / 8; wgid = (xcd < r ? xcd * (q + 1) : r * (q + 1) + (xcd - r) * q) + off; }
        const int nig = 8 * nN, gid = wgid / nig, fm = gid * 8, gsz = (nM - fm) < 8 ? (nM - fm) : 8;
        u.pm = fm + ((wgid % nig) % gsz); u.pn = (wgid % nig) / gsz; u.ord = i; return true;
    }
};

template <class Epi, class Prob, bool ALIGN_EPI>
__device__ __forceinline__ void gemm_phase(LAS unsigned char* lds, const Prob& P, const Epi& E) {
    int tid = threadIdx.x; asm volatile("" : "+v"(tid));
    const int wid = __builtin_amdgcn_readfirstlane(tid >> 6), lane = tid & 63, wr = wid >> 2, wc = wid & 3, fr = lane & 15, fq = lane >> 4;
    constexpr int K = Prob::K, nt = K / BK;
    int Rs[2], Cs[2]; unsigned voffB[2];
#pragma unroll
    for (int i = 0; i < 2; ++i) { int R, C; stage_rc(tid * 16 + i * 8192, R, C); const int Rb = Epi::PERM ? ((R & ~31) + perm32(R & 31)) : R;
        Rs[i] = R; Cs[i] = C; voffB[i] = (unsigned)(Rb * K + C) * 2u; }
    constexpr size_t kstep = (size_t)(BK * 2);
    constexpr size_t hstepB = (size_t)HALF * K * 2;
    const unsigned ldsw = (unsigned)wid * 1024u;
    const int aoff = lds_byte(wr * 64 + fr, fq * 8), boff = lds_byte(wc * 32 + fr, fq * 8);
#define PG8_SA(b, h) (((b) * 2 + (h)) * HTB)
#define PG8_SB(b, h) ((4 + (b) * 2 + (h)) * HTB)
#define PG8_STAGE(bufoff, gbase, voff) do { _Pragma("unroll") for (int _i = 0; _i < 2; ++_i) \
        __builtin_amdgcn_global_load_lds((const unsigned*)((const char*)(gbase) + (voff)[_i]), (LAS unsigned*)(lds + (bufoff) + ldsw + _i * 8192), 16, 0, 0); } while (0)
#define PG8_LDA(dst, b, h) do { _Pragma("unroll") for (int m = 0; m < 4; ++m) _Pragma("unroll") for (int k = 0; k < 2; ++k) dst[m][k] = *(const LAS bf16x8*)(lds + PG8_SA(b, h) + aoff + m * 2048 + k * 1024); } while (0)
#define PG8_LDB(dst, b, h) do { _Pragma("unroll") for (int n = 0; n < 2; ++n) _Pragma("unroll") for (int k = 0; k < 2; ++k) dst[n][k] = *(const LAS bf16x8*)(lds + PG8_SB(b, h) + boff + n * 2048 + k * 1024); } while (0)
#define PG8_MMA(ai, bj, At, Bt) do { __builtin_amdgcn_s_setprio(1); _Pragma("unroll") for (int m = 0; m < 4; ++m) _Pragma("unroll") for (int n = 0; n < 2; ++n) _Pragma("unroll") for (int k = 0; k < 2; ++k) \
        acc[ai][bj][m][n] = __builtin_amdgcn_mfma_f32_16x16x32_bf16(Bt[n][k], At[m][k], acc[ai][bj][m][n], 0, 0, 0); __builtin_amdgcn_s_setprio(0); } while (0)
#define PG8_WAIT_V(n) asm volatile("s_waitcnt vmcnt(" #n ")" ::: "memory")
#define PG8_WAIT_L(n) asm volatile("s_waitcnt lgkmcnt(" #n ")" ::: "memory")
#define PG8_BAR __builtin_amdgcn_s_barrier()
#define PG8_SCHED __builtin_amdgcn_sched_barrier(0)
    Unit cur, nxt; int ui = 0;
    if (!P.next(0, cur)) return;
    unsigned vAc[2][2], vAn[2][2];
    P.a_voff(cur, Rs, Cs, vAc);
    f32x4 acc[2][2][4][2];
#pragma unroll
    for (int a = 0; a < 2; ++a)
#pragma unroll
        for (int b = 0; b < 2; ++b)
#pragma unroll
            for (int m = 0; m < 4; ++m)
#pragma unroll
                for (int n = 0; n < 2; ++n) acc[a][b][m][n] = (f32x4){0.f, 0.f, 0.f, 0.f};
    bf16x8 At[4][2], B0[2][2], B1[2][2];
    const char* cA = P.a_base(cur); const char* cB = P.b_base(cur);
    PG8_STAGE(PG8_SB(0, 0), cB, voffB); PG8_STAGE(PG8_SB(0, 1), cB + hstepB, voffB); PG8_STAGE(PG8_SA(0, 0), cA, vAc[0]); PG8_STAGE(PG8_SA(0, 1), cA, vAc[1]);
    if (wr == 1) PG8_BAR;
    PG8_WAIT_V(2); PG8_BAR;
    PG8_STAGE(PG8_SB(1, 0), cB + kstep, voffB); PG8_STAGE(PG8_SA(1, 0), cA + kstep, vAc[0]); PG8_STAGE(PG8_SB(1, 1), cB + hstepB + kstep, voffB);
    PG8_WAIT_V(6); PG8_BAR;
    for (;;) {
        const bool has_next = P.next(ui + 1, nxt);
        const char* nA = has_next ? P.a_base(nxt) : cA; const char* nB = has_next ? P.b_base(nxt) : cB;
        if constexpr (Prob::GATHER) { if (has_next) P.a_voff(nxt, Rs, Cs, vAn);
          else { vAn[0][0] = vAc[0][0]; vAn[0][1] = vAc[0][1]; vAn[1][0] = vAc[1][0]; vAn[1][1] = vAc[1][1]; } }
        for (int t = 0; t < nt; t += 2) {
            const bool last = (t == nt - 2);
            const char* a1 = cA + (size_t)(t + 1) * kstep;
            const char* a2 = last ? nA : cA + (size_t)(t + 2) * kstep; const char* b2 = last ? nB : cB + (size_t)(t + 2) * kstep;
            const char* a3 = a2 + kstep; const char* b3 = b2 + kstep;
            unsigned va2[2][2];
            if constexpr (Prob::GATHER) { va2[0][0] = last ? vAn[0][0] : vAc[0][0]; va2[0][1] = last ? vAn[0][1] : vAc[0][1]; va2[1][0] = last ? vAn[1][0] : vAc[1][0]; va2[1][1] = last ? vAn[1][1] : vAc[1][1]; }
            else { va2[0][0] = vAc[0][0]; va2[0][1] = vAc[0][1]; va2[1][0] = vAc[1][0]; va2[1][1] = vAc[1][1]; }
            PG8_LDB(B0, 0, 0); PG8_LDB(B1, 0, 1); PG8_SCHED; PG8_LDA(At, 0, 0); PG8_STAGE(PG8_SA(1, 1), a1, vAc[1]);
            PG8_WAIT_V(8); PG8_WAIT_L(0); PG8_BAR; PG8_MMA(0, 0, At, B0); PG8_MMA(0, 1, At, B1); PG8_BAR; PG8_SCHED;
            PG8_LDA(At, 0, 1); PG8_STAGE(PG8_SB(0, 0), b2, voffB); PG8_STAGE(PG8_SB(0, 1), b2 + hstepB, voffB); PG8_STAGE(PG8_SA(0, 0), a2, va2[0]);
            PG8_WAIT_V(8); PG8_WAIT_L(0); PG8_BAR; PG8_MMA(1, 0, At, B0); PG8_MMA(1, 1, At, B1); PG8_BAR; PG8_SCHED;
            PG8_LDB(B0, 1, 0); PG8_LDB(B1, 1, 1); PG8_SCHED; PG8_LDA(At, 1, 0); PG8_STAGE(PG8_SA(0, 1), a2, va2[1]);
            PG8_WAIT_V(8); PG8_WAIT_L(0); PG8_BAR; PG8_MMA(0, 0, At, B0); PG8_MMA(0, 1, At, B1); PG8_BAR; PG8_SCHED;
            PG8_LDA(At, 1, 1); PG8_STAGE(PG8_SB(1, 0), b3, voffB); PG8_STAGE(PG8_SB(1, 1), b3 + hstepB, voffB); PG8_STAGE(PG8_SA(1, 0), a3, va2[0]);
            PG8_WAIT_V(8); PG8_WAIT_L(0); PG8_BAR; PG8_MMA(1, 0, At, B0); PG8_MMA(1, 1, At, B1); PG8_BAR; PG8_SCHED;
        }
        if constexpr (ALIGN_EPI) { if (wr == 0) PG8_BAR; }
        E(acc, cur, wr, wc, fr, fq);
        if (!has_next) break;
#pragma unroll
        for (int a = 0; a < 2; ++a)
#pragma unroll
            for (int b = 0; b < 2; ++b)
#pragma unroll
                for (int m = 0; m < 4; ++m)
#pragma unroll
                    for (int n = 0; n < 2; ++n) acc[a][b][m][n] = (f32x4){0.f, 0.f, 0.f, 0.f};
        cur = nxt; cA = nA; cB = nB; ++ui;
        if constexpr (Prob::GATHER) { vAc[0][0] = vAn[0][0]; vAc[0][1] = vAn[0][1]; vAc[1][0] = vAn[1][0]; vAc[1][1] = vAn[1][1]; }
        if constexpr (ALIGN_EPI) { if (wr == 1) PG8_BAR; }
    }
    PG8_WAIT_V(0);
    if constexpr (!ALIGN_EPI) { if (wr == 0) PG8_BAR; }
    PG8_BAR;
#undef PG8_SA
#undef PG8_SB
#undef PG8_STAGE
#undef PG8_LDA
#undef PG8_LDB
#undef PG8_MMA
#undef PG8_WAIT_V
#undef PG8_WAIT_L
#undef PG8_BAR
#undef PG8_SCHED
}
typedef int v8i_g __attribute__((ext_vector_type(8)));
__device__ __forceinline__ void glds_saddr(const void* sbase, unsigned voff, unsigned lds_dst) { unsigned keep;
    asm volatile("s_mov_b32 %0, m0\n\ts_mov_b32 m0, %3\n\ts_nop 0\n\tglobal_load_lds_dwordx4 %2, %1\n\ts_mov_b32 m0, %0" : "=&s"(keep) : "s"(sbase), "v"(voff), "s"(lds_dst) : "memory"); }
template <class Epi, class Prob, bool ALIGN_EPI>
__device__ __forceinline__ void gemm_phase8(LAS unsigned char* lds, const Prob& P, const Epi& E) {
    int tid = threadIdx.x; asm volatile("" : "+v"(tid));
    const int wid = __builtin_amdgcn_readfirstlane(tid >> 6), lane = tid & 63, wr = wid >> 2, wc = wid & 3, fr = lane & 15, fq = lane >> 4;
    constexpr int K = Prob::K, nt = K / 128;
    int Rs[2], Cs[2]; unsigned voffB[2];
#pragma unroll
    for (int i = 0; i < 2; ++i) { int R, C; stage_rc(tid * 16 + i * 8192, R, C); const int Rb = Epi::PERM ? ((R & ~31) + perm32(R & 31)) : R;
        Rs[i] = R; Cs[i] = C; voffB[i] = (unsigned)(Rb * K + C * 2); }
    constexpr size_t kstep = (size_t)128;
    constexpr size_t hstepB = (size_t)HALF * K, hstepA = (size_t)HALF * K;
    const unsigned ldsw = (unsigned)wid * 1024u; const unsigned lds0 = (unsigned)__builtin_amdgcn_readfirstlane((int)(uintptr_t)lds);
    const int aoff = lds_byte(wr * 64 + fr, fq * 16), boff = lds_byte(wc * 32 + fr, fq * 16);
#define PG8_SA(b, h) (((b) * 2 + (h)) * HTB)
#define PG8_SB(b, h) ((4 + (b) * 2 + (h)) * HTB)
#define PG8_STAGE(bufoff, gbase, voff) do { _Pragma("unroll") for (int _i = 0; _i < 2; ++_i) glds_saddr((const void*)(gbase), (voff)[_i], lds0 + (unsigned)((bufoff) + _i * 8192) + ldsw); } while (0)
#define PG8_STAGE_A1(bufoff, gbase, vo) do { if constexpr (Prob::GATHER) { PG8_STAGE(bufoff, gbase, (vo)[1]); } else { PG8_STAGE(bufoff, (gbase) + hstepA, (vo)[0]); } } while (0)
#define PG8_LDA(dst, b, h) do { _Pragma("unroll") for (int m = 0; m < 4; ++m) dst[m] = *(const LAS v8i_g*)(lds + PG8_SA(b, h) + aoff + m * 2048); } while (0)
#define PG8_LDB(dst, b, h) do { _Pragma("unroll") for (int n = 0; n < 2; ++n) dst[n] = *(const LAS v8i_g*)(lds + PG8_SB(b, h) + boff + n * 2048); } while (0)
#define PG8_MMA(ai, bj, At, Bt) do { __builtin_amdgcn_s_setprio(1); _Pragma("unroll") for (int m = 0; m < 4; ++m) _Pragma("unroll") for (int n = 0; n < 2; ++n) \
        acc[ai][bj][m][n] = __builtin_amdgcn_mfma_scale_f32_16x16x128_f8f6f4(Bt[n], At[m], acc[ai][bj][m][n], 0, 0, 0, 0, 0, 0); __builtin_amdgcn_s_setprio(0); } while (0)
#define PG8_WAIT_V(n) asm volatile("s_waitcnt vmcnt(" #n ")" ::: "memory")
#define PG8_WAIT_L(n) asm volatile("s_waitcnt lgkmcnt(" #n ")" ::: "memory")
#define PG8_BAR __builtin_amdgcn_s_barrier()
#define PG8_SCHED __builtin_amdgcn_sched_barrier(0)
    Unit cur, nxt; int ui = 0;
    if (!P.next(0, cur)) return;
    unsigned vAc[2][2];
    P.a_voff(cur, Rs, Cs, vAc);
    f32x4 acc[2][2][4][2];
#pragma unroll
    for (int a = 0; a < 2; ++a)
#pragma unroll
        for (int b = 0; b < 2; ++b)
#pragma unroll
            for (int m = 0; m < 4; ++m)
#pragma unroll
                for (int n = 0; n < 2; ++n) acc[a][b][m][n] = (f32x4){0.f, 0.f, 0.f, 0.f};
    v8i_g At[4], B0[2], B1[2];
    const char* cA = P.a_base(cur); const char* cB = P.b_base(cur);
    PG8_STAGE(PG8_SB(0, 0), cB, voffB); PG8_STAGE(PG8_SB(0, 1), cB + hstepB, voffB); PG8_STAGE(PG8_SA(0, 0), cA, vAc[0]); PG8_STAGE_A1(PG8_SA(0, 1), cA, vAc);
    if (wr == 1) PG8_BAR;
    PG8_WAIT_V(2); PG8_BAR;
    PG8_STAGE(PG8_SB(1, 0), cB + kstep, voffB); PG8_STAGE(PG8_SA(1, 0), cA + kstep, vAc[0]); PG8_STAGE(PG8_SB(1, 1), cB + hstepB + kstep, voffB);
    PG8_WAIT_V(6); PG8_BAR;
    for (;;) {
        const bool has_next = P.next(ui + 1, nxt);
        const char* nA = has_next ? P.a_base(nxt) : cA; const char* nB = has_next ? P.b_base(nxt) : cB;
        unsigned va2[2][2];
#pragma nounroll
        for (int t = 0; t < nt; t += 2) {
            const bool last = (t == nt - 2);
            const char* a1 = cA + (size_t)(t + 1) * kstep;
            const char* a2 = last ? nA : cA + (size_t)(t + 2) * kstep; const char* b2 = last ? nB : cB + (size_t)(t + 2) * kstep;
            const char* a3 = a2 + kstep; const char* b3 = b2 + kstep;
            va2[0][0] = vAc[0][0]; va2[0][1] = vAc[0][1]; va2[1][0] = vAc[1][0]; va2[1][1] = vAc[1][1];
            if constexpr (Prob::GATHER) { if (last && has_next) { int Rn[2], Cn[2];
                int t2_ = tid; asm volatile("" : "+v"(t2_));
#pragma unroll
                for (int i = 0; i < 2; ++i) stage_rc(t2_ * 16 + i * 8192, Rn[i], Cn[i]);
                P.a_voff(nxt, Rn, Cn, va2); } }
            PG8_LDB(B0, 0, 0); PG8_LDB(B1, 0, 1); PG8_SCHED; PG8_LDA(At, 0, 0); PG8_STAGE_A1(PG8_SA(1, 1), a1, vAc);
            PG8_WAIT_V(8); PG8_WAIT_L(0); PG8_BAR; PG8_MMA(0, 0, At, B0); PG8_MMA(0, 1, At, B1); PG8_BAR; PG8_SCHED;
            PG8_LDA(At, 0, 1); PG8_STAGE(PG8_SB(0, 0), b2, voffB); PG8_STAGE(PG8_SB(0, 1), b2 + hstepB, voffB); PG8_STAGE(PG8_SA(0, 0), a2, va2[0]);
            PG8_WAIT_V(8); PG8_WAIT_L(0); PG8_BAR; PG8_MMA(1, 0, At, B0); PG8_MMA(1, 1, At, B1); PG8_BAR; PG8_SCHED;
            PG8_LDB(B0, 1, 0); PG8_LDB(B1, 1, 1); PG8_SCHED; PG8_LDA(At, 1, 0); PG8_STAGE_A1(PG8_SA(0, 1), a2, va2);
            PG8_WAIT_V(8); PG8_WAIT_L(0); PG8_BAR; PG8_MMA(0, 0, At, B0); PG8_MMA(0, 1, At, B1); PG8_BAR; PG8_SCHED;
            PG8_LDA(At, 1, 1); PG8_STAGE(PG8_SB(1, 0), b3, voffB); PG8_STAGE(PG8_SB(1, 1), b3 + hstepB, voffB); PG8_STAGE(PG8_SA(1, 0), a3, va2[0]);
            PG8_WAIT_V(8); PG8_WAIT_L(0); PG8_BAR; PG8_MMA(1, 0, At, B0); PG8_MMA(1, 1, At, B1); PG8_BAR; PG8_SCHED;
        }
        if constexpr (ALIGN_EPI) { if (wr == 0) PG8_BAR; }
        { int t3_ = tid; asm volatile("" : "+v"(t3_)); const int l3_ = t3_ & 63;
          E(acc, cur, wr, wc, l3_ & 15, l3_ >> 4); }
        if (!has_next) break;
#pragma unroll
        for (int a = 0; a < 2; ++a)
#pragma unroll
            for (int b = 0; b < 2; ++b)
#pragma unroll
                for (int m = 0; m < 4; ++m)
#pragma unroll
                    for (int n = 0; n < 2; ++n) acc[a][b][m][n] = (f32x4){0.f, 0.f, 0.f, 0.f};
        cur = nxt; cA = nA; cB = nB; ++ui;
        if constexpr (Prob::GATHER) { vAc[0][0] = va2[0][0]; vAc[0][1] = va2[0][1]; vAc[1][0] = va2[1][0]; vAc[1][1] = va2[1][1]; }
        if constexpr (ALIGN_EPI) { if (wr == 1) PG8_BAR; }
    }
    PG8_WAIT_V(0);
    if constexpr (!ALIGN_EPI) { if (wr == 0) PG8_BAR; }
    PG8_BAR;
#undef PG8_SA
#undef PG8_SB
#undef PG8_STAGE
#undef PG8_STAGE_A1
#undef PG8_LDA
#undef PG8_LDB
#undef PG8_MMA
#undef PG8_WAIT_V
#undef PG8_WAIT_L
#undef PG8_BAR
#undef PG8_SCHED
}

template <int K_> struct DenseProb {
    static constexpr int K = K_; static constexpr bool GATHER = false;
    const bf16_t* A; const bf16_t* Bt; StaticOrder S;
    __device__ __forceinline__ bool next(int i, Unit& u) const { return S.next(i, u); }
    __device__ __forceinline__ const char* a_base(const Unit& u) const { return (const char*)(A + (size_t)u.pm * BM * K); }
    __device__ __forceinline__ const char* b_base(const Unit& u) const { return (const char*)(Bt + (size_t)u.pn * BM * K); }
    __device__ __forceinline__ void a_voff(const Unit&, const int (&Rs)[2], const int (&Cs)[2], unsigned (&vo)[2][2]) const {
#pragma unroll
        for (int h = 0; h < 2; ++h)
#pragma unroll
            for (int i = 0; i < 2; ++i) vo[h][i] = (unsigned)((h * HALF + Rs[i]) * K + Cs[i]) * 2u;
    }
};
template <int K_, int PMAP, int EB> struct MapProb {
    static constexpr int K = K_; static constexpr bool GATHER = false;
    const unsigned char* A; const unsigned char* Bt; StaticOrder S;
    __device__ __forceinline__ bool next(int i, Unit& u) const { const bool ok = S.next(i, u); if (PMAP == 1) u.pn = u.pn < 6 ? u.pn : u.pn + 6; if (PMAP == 2) u.pn += 6; return ok; }
    __device__ __forceinline__ const char* a_base(const Unit& u) const { return (const char*)(A + (size_t)u.pm * BM * K * EB); }
    __device__ __forceinline__ const char* b_base(const Unit& u) const { return (const char*)(Bt + (size_t)u.pn * BM * K * EB); }
    __device__ __forceinline__ void a_voff(const Unit&, const int (&Rs)[2], const int (&Cs)[2], unsigned (&vo)[2][2]) const {
#pragma unroll
        for (int h = 0; h < 2; ++h)
#pragma unroll
            for (int i = 0; i < 2; ++i) vo[h][i] = (unsigned)((h * HALF + Rs[i]) * K * EB + Cs[i] * 2);
    }
};
__device__ __forceinline__ bool moe_unit(int i, int G, int vcu, Unit& u, int& e, int& b) {
    const int L = i * G + vcu; if (L >= 2048) return false;
    const int x = (L & 255) >> 5, w = L & 31, r = L >> 8;
    e = 2 * x + (r >> 2); b = r & 3; u.pm = (b * NEXP + e) * 4 + (w >> 3); u.pn = w & 7; u.ord = i; return true;
}
struct GuProb {
    static constexpr int K = DM; static constexpr bool GATHER = true;
    const bf16_t* H2; const bf16_t* W; const LAS unsigned* rowoff; int G, vcu;
    __device__ __forceinline__ bool next(int i, Unit& u) const { int e, b; return moe_unit(i, G, vcu, u, e, b); }
    __device__ __forceinline__ const char* a_base(const Unit& u) const { const int b = (u.pm >> 2) / NEXP; return (const char*)(H2 + (size_t)b * SEQ * DM); }
    __device__ __forceinline__ const char* b_base(const Unit& u) const { const int e = (u.pm >> 2) % NEXP; return (const char*)(W + ((size_t)e * 2048 + (size_t)u.pn * BM) * DM); }
    __device__ __forceinline__ void a_voff(const Unit& u, const int (&Rs)[2], const int (&Cs)[2], unsigned (&vo)[2][2]) const {
#pragma unroll
        for (int h = 0; h < 2; ++h)
#pragma unroll
            for (int i = 0; i < 2; ++i) vo[h][i] = rowoff[u.ord * 256 + h * HALF + Rs[i]] + (unsigned)Cs[i] * 2u;
    }
};
struct DownProb {
    static constexpr int K = DFF; static constexpr bool GATHER = false;
    const bf16_t* HID; const bf16_t* W; int G, vcu;
    __device__ __forceinline__ bool next(int i, Unit& u) const { int e, b; return moe_unit(i, G, vcu, u, e, b); }
    __device__ __forceinline__ const char* a_base(const Unit& u) const { return (const char*)(HID + (size_t)u.pm * BM * DFF); }
    __device__ __forceinline__ const char* b_base(const Unit& u) const { const int e = (u.pm >> 2) % NEXP; return (const char*)(W + ((size_t)e * 2048 + (size_t)u.pn * BM) * DFF); }
    __device__ __forceinline__ void a_voff(const Unit&, const int (&Rs)[2], const int (&Cs)[2], unsigned (&vo)[2][2]) const {
#pragma unroll
        for (int h = 0; h < 2; ++h)
#pragma unroll
            for (int i = 0; i < 2; ++i) vo[h][i] = (unsigned)((h * HALF + Rs[i]) * DFF + Cs[i]) * 2u;
    }
};

struct GuProb8 {
    static constexpr int K = DM; static constexpr bool GATHER = true;
    const unsigned char* H2; const unsigned char* W; const LAS unsigned* rowoff; int G, vcu;
    __device__ __forceinline__ bool next(int i, Unit& u) const { int e, b; return moe_unit(i, G, vcu, u, e, b); }
    __device__ __forceinline__ const char* a_base(const Unit& u) const { const int b = (u.pm >> 2) / NEXP; return (const char*)(H2 + (size_t)b * SEQ * DM); }
    __device__ __forceinline__ const char* b_base(const Unit& u) const { const int e = (u.pm >> 2) % NEXP; return (const char*)(W + ((size_t)e * 2048 + (size_t)u.pn * BM) * DM); }
    __device__ __forceinline__ void a_voff(const Unit& u, const int (&Rs)[2], const int (&Cs)[2], unsigned (&vo)[2][2]) const {
#pragma unroll
        for (int h = 0; h < 2; ++h)
#pragma unroll
            for (int i = 0; i < 2; ++i) vo[h][i] = rowoff[u.ord * 256 + h * HALF + Rs[i]] + (unsigned)Cs[i] * 2u;
    }
};
struct DownProb8 {
    static constexpr int K = DFF; static constexpr bool GATHER = false;
    const unsigned char* HID; const unsigned char* W; int G, vcu;
    __device__ __forceinline__ bool next(int i, Unit& u) const { int e, b; return moe_unit(i, G, vcu, u, e, b); }
    __device__ __forceinline__ const char* a_base(const Unit& u) const { return (const char*)(HID + (size_t)u.pm * BM * DFF); }
    __device__ __forceinline__ const char* b_base(const Unit& u) const { const int e = (u.pm >> 2) % NEXP; return (const char*)(W + ((size_t)e * 2048 + (size_t)u.pn * BM) * DFF); }
    __device__ __forceinline__ void a_voff(const Unit&, const int (&Rs)[2], const int (&Cs)[2], unsigned (&vo)[2][2]) const {
#pragma unroll
        for (int h = 0; h < 2; ++h)
#pragma unroll
            for (int i = 0; i < 2; ++i) vo[h][i] = (unsigned)((h * HALF + Rs[i]) * DFF + Cs[i] * 2);
    }
};
typedef const f32x4 (&AccRef)[2][2][4][2];
struct EpiInProj {
    static constexpr bool PERM = true;
    bf16_t *QA, *KA, *VA, *QB, *KB, *VB, *GA, *GB; const float* bgate; float oscale;
    __device__ __forceinline__ void operator()(AccRef acc, const Unit& u, int wr, int wc, int fr, int fq) const {
        const int pn = u.pn; bf16_t* base; int ldc, colt; bool gate = false;
        if (pn < 4) { base = QA; ldc = QW; colt = pn * 256; }
        else if (pn == 4) { base = KA; ldc = KVW; colt = 0; }
        else if (pn == 5) { base = VA; ldc = KVW; colt = 0; }
        else if (pn < 10) { base = QB; ldc = QW; colt = (pn - 6) * 256; }
        else if (pn == 10) { base = KB; ldc = KVW; colt = 0; }
        else if (pn == 11) { base = VB; ldc = KVW; colt = 0; }
        else if (pn < 20) { base = GA; ldc = DM; colt = (pn - 12) * 256; gate = true; }
        else { base = GB; ldc = DM; colt = (pn - 20) * 256; gate = true; }
        const int row0 = u.pm * BM + wr * 64 + fr, col0 = colt + wc * 32 + 8 * fq;
        f32x4 bv[2][2];
#pragma unroll
        for (int bj = 0; bj < 2; ++bj)
#pragma unroll
            for (int n = 0; n < 2; ++n) bv[bj][n] = gate ? *(const f32x4*)(bgate + (pn - 12) * 256 + wc * 32 + 8 * fq + bj * HALF + 4 * n) : (f32x4){0.f, 0.f, 0.f, 0.f};
#pragma unroll
        for (int ai = 0; ai < 2; ++ai)
#pragma unroll
            for (int m = 0; m < 4; ++m) { bf16_t* rowp = base + (size_t)(row0 + ai * HALF + m * 16) * ldc + col0;
#pragma unroll
                for (int bj = 0; bj < 2; ++bj) { f32x4 v0 = acc[ai][bj][m][0] * oscale + bv[bj][0], v1 = acc[ai][bj][m][1] * oscale + bv[bj][1];
                    if (gate) {
#pragma unroll
                        for (int j = 0; j < 4; ++j) { v0[j] = sigmoidf_fast(v0[j]); v1[j] = sigmoidf_fast(v1[j]); } }
                    u32x4 w; w.x = cvt_pk_bf16(v0[0], v0[1]); w.y = cvt_pk_bf16(v0[2], v0[3]); w.z = cvt_pk_bf16(v1[0], v1[1]); w.w = cvt_pk_bf16(v1[2], v1[3]);
                    *(u32x4*)(rowp + bj * HALF) = w; } }
    }
};
template <int MODE> struct EpiGated {
    static constexpr bool PERM = true;
    bf16_t* G1; const bf16_t* G2; float oscale;
    __device__ __forceinline__ void operator()(AccRef acc, const Unit& u, int wr, int wc, int fr, int fq) const {
        const int row0 = u.pm * BM + wr * 64 + fr, col0 = u.pn * BM + wc * 32 + 8 * fq;
#pragma unroll
        for (int ai = 0; ai < 2; ++ai)
#pragma unroll
            for (int m = 0; m < 4; ++m) { const size_t off = (size_t)(row0 + ai * HALF + m * 16) * DM + col0;
#pragma unroll
                for (int bj = 0; bj < 2; ++bj) {
                    const bf16x8 g1 = (MODE == 2) ? (bf16x8){0, 0, 0, 0, 0, 0, 0, 0} : *(const bf16x8*)(G1 + off + bj * HALF);
                    bf16x8 g2 = g1; if (MODE >= 1) g2 = *(const bf16x8*)(G2 + off + bj * HALF);
                    float o[8];
#pragma unroll
                    for (int j = 0; j < 8; ++j) { const float a = acc[ai][bj][m][j >> 2][j & 3] * oscale;
                        if (MODE == 0) o[j] = bf2f((unsigned short)g1[j]) * a;
                        else if (MODE == 1) o[j] = bf2f((unsigned short)g1[j]) + bf2f((unsigned short)g2[j]) * a;
                        else o[j] = bf2f((unsigned short)g2[j]) * a; }
                    u32x4 w; w.x = cvt_pk_bf16(o[0], o[1]); w.y = cvt_pk_bf16(o[2], o[3]); w.z = cvt_pk_bf16(o[4], o[5]); w.w = cvt_pk_bf16(o[6], o[7]);
                    *(u32x4*)(G1 + off + bj * HALF) = w; } }
    }
};
template <int MODE> struct EpiGated8 {
    static constexpr bool PERM = true;
    bf16_t* G1; const bf16_t* G2; unsigned char* M8; float oscale;
    __device__ __forceinline__ void operator()(AccRef acc, const Unit& u, int wr, int wc, int fr, int fq) const {
        const int row0 = u.pm * BM + wr * 64 + fr, col0 = u.pn * BM + wc * 32 + 8 * fq;
#pragma unroll
        for (int ai = 0; ai < 2; ++ai)
#pragma unroll
            for (int m = 0; m < 4; ++m) { const unsigned off = (unsigned)((row0 + ai * HALF + m * 16) * DM + col0);
#pragma unroll
                for (int bj = 0; bj < 2; ++bj) {
                    const bf16x8 g1 = *(const bf16x8*)(G1 + off + bj * HALF);
                    bf16x8 g2 = g1; if (MODE == 1) g2 = *(const bf16x8*)(G2 + off + bj * HALF);
                    float o[8];
#pragma unroll
                    for (int j = 0; j < 8; ++j) { const float a = acc[ai][bj][m][j >> 2][j & 3] * oscale;
                        if (MODE == 0) o[j] = bf2f((unsigned short)g1[j]) * a; else o[j] = (bf2f((unsigned short)g1[j]) + bf2f((unsigned short)g2[j]) * a) * M8S; }
                    if (MODE == 0) { u32x4 w; w.x = cvt_pk_bf16(o[0], o[1]); w.y = cvt_pk_bf16(o[2], o[3]); w.z = cvt_pk_bf16(o[4], o[5]); w.w = cvt_pk_bf16(o[6], o[7]); *(u32x4*)(G1 + off + bj * HALF) = w; }
                    else { int w0 = 0, w1 = 0; w0 = __builtin_amdgcn_cvt_pk_fp8_f32(o[0], o[1], w0, false); w0 = __builtin_amdgcn_cvt_pk_fp8_f32(o[2], o[3], w0, true);
                        w1 = __builtin_amdgcn_cvt_pk_fp8_f32(o[4], o[5], w1, false); w1 = __builtin_amdgcn_cvt_pk_fp8_f32(o[6], o[7], w1, true);
                        *(u32x2*)(M8 + off + bj * HALF) = (u32x2){(unsigned)w0, (unsigned)w1}; } }
                asm volatile("" ::: "memory"); }
    }
};
struct EpiAtt {
    static constexpr bool PERM = true;
    bf16_t* O; float oscale;
    __device__ __forceinline__ void operator()(AccRef acc, const Unit& u, int wr, int wc, int fr, int fq) const {
        const int row0 = u.pm * BM + wr * 64 + fr, col0 = u.pn * BM + wc * 32 + 8 * fq;
#pragma unroll
        for (int ai = 0; ai < 2; ++ai)
#pragma unroll
            for (int m = 0; m < 4; ++m) { bf16_t* rowp = O + (size_t)(row0 + ai * HALF + m * 16) * DM + col0;
#pragma unroll
                for (int bj = 0; bj < 2; ++bj) { const f32x4 v0 = acc[ai][bj][m][0] * oscale, v1 = acc[ai][bj][m][1] * oscale;
                    u32x4 w; w.x = cvt_pk_bf16(v0[0], v0[1]); w.y = cvt_pk_bf16(v0[2], v0[3]); w.z = cvt_pk_bf16(v1[0], v1[1]); w.w = cvt_pk_bf16(v1[2], v1[3]);
                    *(u32x4*)(rowp + bj * HALF) = w; } }
    }
};
struct EpiSwiglu {
    static constexpr bool PERM = true;
    unsigned char* HID; float oscale;
    __device__ __forceinline__ void operator()(AccRef acc, const Unit& u, int wr, int wc, int fr, int fq) const {
        const int row0 = u.pm * BM + wr * 64 + fr, col0 = u.pn * HALF + wc * 32 + 8 * fq;
#pragma unroll
        for (int ai = 0; ai < 2; ++ai)
#pragma unroll
            for (int m = 0; m < 4; ++m) { float o[8];
#pragma unroll
                for (int j = 0; j < 8; ++j) { const float a = acc[ai][0][m][j >> 2][j & 3] * oscale, up = acc[ai][1][m][j >> 2][j & 3] * oscale; o[j] = a * sigmoidf_fast(a) * up; }
                int w0 = 0, w1 = 0; w0 = __builtin_amdgcn_cvt_pk_fp8_f32(o[0], o[1], w0, false); w0 = __builtin_amdgcn_cvt_pk_fp8_f32(o[2], o[3], w0, true);
                w1 = __builtin_amdgcn_cvt_pk_fp8_f32(o[4], o[5], w1, false); w1 = __builtin_amdgcn_cvt_pk_fp8_f32(o[6], o[7], w1, true);
                *(u32x2*)(HID + (size_t)(row0 + ai * HALF + m * 16) * DFF + col0) = (u32x2){(unsigned)w0, (unsigned)w1}; }
    }
};
struct EpiDown {
    static constexpr bool PERM = true;
    bf16_t* Y; const float* gatev; float oscale;
    __device__ __forceinline__ void operator()(AccRef acc, const Unit& u, int wr, int wc, int fr, int fq) const {
        const int row0 = u.pm * BM + wr * 64 + fr, col0 = u.pn * BM + wc * 32 + 8 * fq;
#pragma unroll
        for (int ai = 0; ai < 2; ++ai)
#pragma unroll
            for (int m = 0; m < 4; ++m) { const int row = row0 + ai * HALF + m * 16; const float g = gatev[row] * oscale;
#pragma unroll
                for (int bj = 0; bj < 2; ++bj) { const f32x4 v0 = acc[ai][bj][m][0] * g, v1 = acc[ai][bj][m][1] * g;
                    u32x4 w; w.x = cvt_pk_bf16(v0[0], v0[1]); w.y = cvt_pk_bf16(v0[2], v0[3]); w.z = cvt_pk_bf16(v1[0], v1[1]); w.w = cvt_pk_bf16(v1[2], v1[3]);
                    *(u32x4*)(Y + (size_t)row * DM + col0 + bj * HALF) = w; } }
    }
};
}

namespace att {
constexpr int D = 128, NW = 8, QBLK = 32, KVBLK = 64;
constexpr float SCALE = 0.088388347648318440f, C = SCALE * LOG2E;
constexpr float THR = 8.f;
constexpr int LDQ = QW, LDK = KVW;
constexpr int SHM_V = KVBLK * D * 2, SHM_K = KVBLK * D * 2;
constexpr int BUFB = SHM_V + SHM_K, NBUF = 4;
constexpr int OFF_WS = NBUF * BUFB, OFF_TAB = OFF_WS + NW * 64 * 4, LDS_END = OFF_TAB + 4 * 768 * 4, OFF_OST = 0;
static_assert(LDS_END <= LDS_SCRATCH, "attention LDS");
#define KSWZ(row, colB) ((row) * 256 + ((colB) ^ (((row) & 7) << 4)))
#define SBAR() __builtin_amdgcn_sched_barrier(0)
__device__ __forceinline__ int crow(int r, int hi) { return (r & 3) + 8 * (r >> 2) + 4 * hi; }
__device__ __forceinline__ unsigned cvtpk(float lo, float hi) { unsigned r; asm volatile("v_cvt_pk_bf16_f32 %0, %1, %2" : "=v"(r) : "v"(lo), "v"(hi)); return r; }

__device__ __forceinline__ void partialSM(f32x16& p0, f32x16& p1, float& m_reg, float& mn, float& alpha) {
  float pmax = p0[0];
#pragma unroll
  for (int r = 1; r < 16; ++r) pmax = fmaxf(pmax, p0[r]);
#pragma unroll
  for (int r = 0; r < 16; ++r) pmax = fmaxf(pmax, p1[r]);
  { auto rr = __builtin_amdgcn_permlane32_swap(__float_as_uint(pmax), __float_as_uint(pmax), false, false);
    pmax = fmaxf(__uint_as_float(rr[0]), __uint_as_float(rr[1])); }
  if (__builtin_expect(__all(pmax - m_reg <= THR / SCALE), 1)) { mn = m_reg; alpha = 1.f; }
  else { mn = fmaxf(m_reg, pmax); alpha = __builtin_amdgcn_exp2f((m_reg - mn) * C); m_reg = mn; }
  float mnC = -mn * C;
#pragma unroll
  for (int r = 0; r < 16; ++r) p0[r] = fmaf(p0[r], C, mnC);
#pragma unroll
  for (int r = 0; r < 16; ++r) p1[r] = fmaf(p1[r], C, mnC);
#pragma unroll
  for (int r = 0; r < 16; ++r) p0[r] = __builtin_amdgcn_exp2f(p0[r]);
}
__device__ __forceinline__ void partialSM_B(f32x16& p0, f32x16& p1, float& m_reg, float& mn, float& alpha, const float* tb) {
#pragma unroll
  for (int r = 0; r < 16; ++r) { const int o = (r & 3) + 8 * (r >> 2); p0[r] = fmaf(p0[r], C, tb[o]); p1[r] = fmaf(p1[r], C, tb[32 + o]); }
  float pmax = p0[0];
#pragma unroll
  for (int r = 1; r < 16; ++r) pmax = fmaxf(pmax, p0[r]);
#pragma unroll
  for (int r = 0; r < 16; ++r) pmax = fmaxf(pmax, p1[r]);
  { auto rr = __builtin_amdgcn_permlane32_swap(__float_as_uint(pmax), __float_as_uint(pmax), false, false);
    pmax = fmaxf(__uint_as_float(rr[0]), __uint_as_float(rr[1])); }
  if (__builtin_expect(__all(pmax - m_reg <= THR * LOG2E), 1)) { mn = m_reg; alpha = 1.f; }
  else { mn = fmaxf(m_reg, pmax); alpha = __builtin_amdgcn_exp2f(m_reg - mn); m_reg = mn; }
#pragma unroll
  for (int r = 0; r < 16; ++r) p0[r] = p0[r] - mn;
#pragma unroll
  for (int r = 0; r < 16; ++r) p1[r] = p1[r] - mn;
#pragma unroll
  for (int r = 0; r < 16; ++r) p0[r] = __builtin_amdgcn_exp2f(p0[r]);
}
__device__ __forceinline__ void finishSM(f32x16& p0, f32x16& p1, float alpha, float& l_reg, bf16x8& pa0, bf16x8& pa1, bf16x8& pa2, bf16x8& pa3) {
#pragma unroll
  for (int r = 0; r < 16; ++r) p1[r] = __builtin_amdgcn_exp2f(p1[r]);
  float ps = 0;
#pragma unroll
  for (int r = 0; r < 16; ++r) ps += p0[r];
#pragma unroll
  for (int r = 0; r < 16; ++r) ps += p1[r];
  { auto rr = __builtin_amdgcn_permlane32_swap(__float_as_uint(ps), __float_as_uint(ps), false, false);
    ps = __uint_as_float(rr[0]) + __uint_as_float(rr[1]); }
  l_reg = l_reg * alpha + ps;
#define PK4(P, BASE, OUT) do { unsigned a0 = cvtpk(P[BASE + 0], P[BASE + 1]), a1 = cvtpk(P[BASE + 2], P[BASE + 3]);   \
    unsigned b0 = cvtpk(P[BASE + 4], P[BASE + 5]), b1 = cvtpk(P[BASE + 6], P[BASE + 7]);                              \
    auto r0 = __builtin_amdgcn_permlane32_swap(a0, b0, false, false); auto r1 = __builtin_amdgcn_permlane32_swap(a1, b1, false, false); \
    u32x4 w = {r0[0], r1[0], r0[1], r1[1]}; OUT = *reinterpret_cast<bf16x8*>(&w); } while (0)
  PK4(p0, 0, pa0); PK4(p0, 8, pa1); PK4(p1, 0, pa2); PK4(p1, 8, pa3);
#undef PK4
}
__device__ __forceinline__ void qkt(f32x16& p0, f32x16& p1, const bf16_t* Ks, const bf16x8* qr, int r32, int hi, float init = 0.f) {
#pragma unroll
  for (int r = 0; r < 16; ++r) { p0[r] = init; p1[r] = init; }
#pragma unroll
  for (int d0 = 0; d0 < 8; ++d0) { int cb = (d0 * 16 + hi * 8) * 2;
    bf16x8 b0 = *reinterpret_cast<const bf16x8*>((const char*)Ks + KSWZ(r32, cb));
    bf16x8 b1 = *reinterpret_cast<const bf16x8*>((const char*)Ks + KSWZ(32 + r32, cb));
    p0 = __builtin_amdgcn_mfma_f32_32x32x16_bf16(b0, qr[d0], p0, 0, 0, 0);
    p1 = __builtin_amdgcn_mfma_f32_32x32x16_bf16(b1, qr[d0], p1, 0, 0, 0); }
}
__device__ __forceinline__ int v_st(int k, int c) { const int kk = (k & ~0xC) | ((k & 4) << 1) | ((k & 8) >> 1); return ((kk >> 3) * 4 + (c >> 5)) * 512 + ((kk & 7) * 32 + (c & 31)) * 2; }
__device__ __forceinline__ int v_rd_base(int lane) { return ((lane & 3) << 3) | (((lane >> 2) & 3) << 6) | (((lane >> 4) & 1) << 5) | (((lane >> 5) & 1) << 8); }
constexpr int v_rd_off(int d0, int ks, int half) { return d0 * 512 + ks * 4096 + half * 2048; }
template <int OFF> __device__ __forceinline__ s16x4 tr_read(int vb) {
  s16x4 r; asm volatile("ds_read_b64_tr_b16 %0, %1 offset:%2" : "=&v"(r) : "v"(vb), "i"(OFF) : "memory"); return r;
}
template <int D0> __device__ __forceinline__ void pv_one(f32x16& od, int vb, bf16x8 pa0, bf16x8 pa1, bf16x8 pa2, bf16x8 pa3) {
  const s16x4 l0 = tr_read<v_rd_off(D0, 0, 0)>(vb), h0 = tr_read<v_rd_off(D0, 0, 1)>(vb), l1 = tr_read<v_rd_off(D0, 1, 0)>(vb), h1 = tr_read<v_rd_off(D0, 1, 1)>(vb);
  const s16x4 l2 = tr_read<v_rd_off(D0, 2, 0)>(vb), h2 = tr_read<v_rd_off(D0, 2, 1)>(vb), l3 = tr_read<v_rd_off(D0, 3, 0)>(vb), h3 = tr_read<v_rd_off(D0, 3, 1)>(vb);
  asm volatile("s_waitcnt lgkmcnt(0)" ::: "memory"); SBAR();
#define PK(L, H) (bf16x8){L[0], L[1], L[2], L[3], H[0], H[1], H[2], H[3]}
  od = __builtin_amdgcn_mfma_f32_32x32x16_bf16(pa0, PK(l0, h0), od, 0, 0, 0);
  od = __builtin_amdgcn_mfma_f32_32x32x16_bf16(pa1, PK(l1, h1), od, 0, 0, 0);
  od = __builtin_amdgcn_mfma_f32_32x32x16_bf16(pa2, PK(l2, h2), od, 0, 0, 0);
  od = __builtin_amdgcn_mfma_f32_32x32x16_bf16(pa3, PK(l3, h3), od, 0, 0, 0);
#undef PK
}
__device__ __forceinline__ void pv_d0(f32x16* o, int vb, bf16x8 pa0, bf16x8 pa1, bf16x8 pa2, bf16x8 pa3) {
  pv_one<0>(o[0], vb, pa0, pa1, pa2, pa3); pv_one<1>(o[1], vb, pa0, pa1, pa2, pa3); pv_one<2>(o[2], vb, pa0, pa1, pa2, pa3); pv_one<3>(o[3], vb, pa0, pa1, pa2, pa3);
}
template <int MODE>
__device__ __forceinline__ void pv_psm(f32x16* o, int vb, bf16x8 pa0, bf16x8 pa1, bf16x8 pa2, bf16x8 pa3, f32x16& p0, f32x16& p1, float& m_reg, float& mn, float& alpha, const float* tb) {
  pv_one<0>(o[0], vb, pa0, pa1, pa2, pa3);
  if constexpr (MODE == 1) {
#pragma unroll
    for (int r = 0; r < 16; ++r) { const int of = (r & 3) + 8 * (r >> 2); p0[r] = fmaf(p0[r], C, tb[of]); p1[r] = fmaf(p1[r], C, tb[32 + of]); }
  }
  float pmax = p0[0];
#pragma unroll
  for (int r = 1; r < 16; ++r) pmax = fmaxf(pmax, p0[r]);
#pragma unroll
  for (int r = 0; r < 16; ++r) pmax = fmaxf(pmax, p1[r]);
  { auto rr = __builtin_amdgcn_permlane32_swap(__float_as_uint(pmax), __float_as_uint(pmax), false, false);
    pmax = fmaxf(__uint_as_float(rr[0]), __uint_as_float(rr[1])); }
  SBAR();
  pv_one<1>(o[1], vb, pa0, pa1, pa2, pa3);
  float sub;
  if constexpr (MODE == 0) {
    if (__builtin_expect(__all(pmax - m_reg <= THR / SCALE), 1)) { mn = m_reg; alpha = 1.f; }
    else { mn = fmaxf(m_reg, pmax); alpha = __builtin_amdgcn_exp2f((m_reg - mn) * C); m_reg = mn; }
    sub = -mn * C;
#pragma unroll
    for (int r = 0; r < 16; ++r) p0[r] = fmaf(p0[r], C, sub);
  } else {
    if (__builtin_expect(__all(pmax - m_reg <= THR * LOG2E), 1)) { mn = m_reg; alpha = 1.f; }
    else { mn = fmaxf(m_reg, pmax); alpha = __builtin_amdgcn_exp2f(m_reg - mn); m_reg = mn; }
    sub = -mn;
#pragma unroll
    for (int r = 0; r < 16; ++r) p0[r] = p0[r] + sub;
  }
  SBAR();
  pv_one<2>(o[2], vb, pa0, pa1, pa2, pa3);
#pragma unroll
  for (int r = 0; r < 16; ++r) { if constexpr (MODE == 0) p1[r] = fmaf(p1[r], C, sub); else p1[r] = p1[r] + sub; }
#pragma unroll
  for (int r = 0; r < 6; ++r) p0[r] = __builtin_amdgcn_exp2f(p0[r]);
  SBAR();
  pv_one<3>(o[3], vb, pa0, pa1, pa2, pa3);
#pragma unroll
  for (int r = 6; r < 16; ++r) p0[r] = __builtin_amdgcn_exp2f(p0[r]);
}
__device__ __forceinline__ f32x8 bf8_to_f32(bf16x8 v) { f32x8 r;
#pragma unroll
  for (int j = 0; j < 8; ++j) r[j] = bf2f((unsigned short)v[j]);
  return r; }
__device__ __forceinline__ bf16x8 f32_to_bf8(f32x8 x) { u32x4 w = {cvtpk(x[0], x[1]), cvtpk(x[2], x[3]), cvtpk(x[4], x[5]), cvtpk(x[6], x[7])}; return *reinterpret_cast<bf16x8*>(&w); }
__device__ __forceinline__ int t5_bucket(int rel) {
  const int n = rel < 0 ? -rel : rel; int bk;
  if (n < 8) bk = n; else if (n < 12) bk = 8; else if (n < 16) bk = 9; else if (n < 23) bk = 10; else if (n < 32) bk = 11; else if (n < 46) bk = 12; else if (n < 64) bk = 13; else if (n < 91) bk = 14; else bk = 15;
  return bk + (rel > 0 ? 16 : 0);
}
struct Aux { const float* cosT; const float* sinT; const float* qn; const float* kn; const float* relb; const float* sink; };

template <int MODE>
__device__ __forceinline__ void attn_unit(const bf16_t* Qb, const bf16_t* __restrict__ Kh, const bf16_t* __restrict__ Vh, bf16_t* Ob, int kbeg, int kend, int q0, int head, char* lds, const Aux& aux) {
  int tid = threadIdx.x; asm volatile("" : "+v"(tid));
  const int wid = tid >> 6, lane = tid & 63, r32 = lane & 31, hi = lane >> 5;
  char* V_lds = lds; char* K_lds = lds + SHM_V;
  float* ws = (float*)(lds + OFF_WS) + wid * 64; float* li_l = ws; float* al_l = ws + 32;
  float* tab = (float*)(lds + OFF_TAB);
  float m_reg = -1e30f, l_reg = 0; f32x16 o[4] = {}; bf16x8 qr[8];
  const bf16_t* Qw = Qb + (long)(wid * QBLK + r32) * LDQ + hi * 8;
#pragma unroll
  for (int d0 = 0; d0 < 8; ++d0) qr[d0] = *reinterpret_cast<const bf16x8*>(Qw + d0 * 16);
  if constexpr (MODE == 1) {
    for (int i = tid; i < 768; i += 512) { const int rel = i - 383, n = rel < 0 ? -rel : rel; float v = -1e30f; if (n <= 128) v = aux.relb[t5_bucket(rel) * NHB + head] * LOG2E; tab[i] = v; }
    m_reg = aux.sink[head] * LOG2E; l_reg = 1.0f;
  }
  const int tbase = kbeg - q0 - wid * QBLK - r32 + 383 + 4 * hi;
  const int sr = tid >> 4, sc = (tid & 15) * 8, vst0 = v_st(sr, sc), vst1 = v_st(32 + sr, sc);
  const int vb0 = (int)(uintptr_t)V_lds + v_rd_base(lane);
  struct { bf16x8 vs0, vs1, ks0, ks1; } sr_[2];
#define SLOAD(i, k0) do { sr_[i].vs0 = *reinterpret_cast<const bf16x8*>(&Vh[(long)(kbeg + (k0) + sr) * LDK + sc]); sr_[i].vs1 = *reinterpret_cast<const bf16x8*>(&Vh[(long)(kbeg + (k0) + 32 + sr) * LDK + sc]); \
    sr_[i].ks0 = *reinterpret_cast<const bf16x8*>(&Kh[(long)(kbeg + (k0) + sr) * LDK + sc]); sr_[i].ks1 = *reinterpret_cast<const bf16x8*>(&Kh[(long)(kbeg + (k0) + 32 + sr) * LDK + sc]); } while (0)
#define SWRITE(bo, i) do { *(bf16x8*)(V_lds + (bo) + vst0) = sr_[i].vs0;          \
    *(bf16x8*)(V_lds + (bo) + vst1) = sr_[i].vs1; int kc = sc * 2;               \
    *(bf16x8*)(K_lds + (bo) + KSWZ(sr, kc)) = sr_[i].ks0;                       \
    *(bf16x8*)(K_lds + (bo) + KSWZ(32 + sr, kc)) = sr_[i].ks1; } while (0)
#define SWAIT() asm volatile("s_waitcnt vmcnt(4)" ::: "memory")
#define RESC(a) do { if (__any((a) < 1.f)) { if (hi == 0) al_l[r32] = (a); asm volatile("s_waitcnt lgkmcnt(0)" ::: "memory"); \
    _Pragma("unroll") for (int d = 0; d < 4; ++d) _Pragma("unroll") for (int r = 0; r < 16; ++r) o[d][r] *= al_l[crow(r, hi)]; } } while (0)
#define PSM(P0, P1, MN, AL, j) do { if constexpr (MODE == 0) partialSM(P0, P1, m_reg, MN, AL); else partialSM_B(P0, P1, m_reg, MN, AL, tab + tbase + (j) * KVBLK); } while (0)
#define ROT() do { const int t_ = o_prev; o_prev = o_cur; o_cur = o_next; o_next = t_; } while (0)
  f32x16 pA0, pA1, pB0, pB1; float mnA, mnB, alA, alB; bf16x8 pa0, pa1, pa2, pa3; const int NT = (kend - kbeg) / KVBLK;
  constexpr int SE = 0, SO = 1;
  int o_prev = 2 * BUFB, o_cur = 0, o_next = BUFB;
  SLOAD(SE, 0); asm volatile("s_waitcnt vmcnt(0)" ::: "memory"); SWRITE(0, SE);
  SLOAD(SO, KVBLK); SLOAD(SE, 2 * KVBLK);
  __syncthreads();
  qkt(pA0, pA1, (const bf16_t*)(K_lds + o_cur), qr, r32, hi); PSM(pA0, pA1, mnA, alA, 0);
  SWAIT(); SWRITE(o_next, SO); RESC(alA); __syncthreads();
  ROT();
  for (int j = 1; j + 1 < NT; j += 2) {
    SBAR(); qkt(pB0, pB1, (const bf16_t*)(K_lds + o_cur), qr, r32, hi);
    finishSM(pA0, pA1, alA, l_reg, pa0, pa1, pa2, pa3); SBAR();
    SLOAD(SO, (j + 2) * KVBLK); SBAR();
    pv_psm<MODE>(o, vb0 + o_prev, pa0, pa1, pa2, pa3, pB0, pB1, m_reg, mnB, alB, tab + tbase + j * KVBLK);
    SWAIT(); SWRITE(o_next, SE);
    RESC(alB); __syncthreads(); ROT();
    SBAR(); qkt(pA0, pA1, (const bf16_t*)(K_lds + o_cur), qr, r32, hi);
    finishSM(pB0, pB1, alB, l_reg, pa0, pa1, pa2, pa3); SBAR();
    SLOAD(SE, (j + 3 < NT ? j + 3 : NT - 1) * KVBLK); SBAR();
    pv_psm<MODE>(o, vb0 + o_prev, pa0, pa1, pa2, pa3, pA0, pA1, m_reg, mnA, alA, tab + tbase + (j + 1) * KVBLK);
    SWAIT(); SWRITE(o_next, SO);
    RESC(alA); __syncthreads(); ROT();
  }
  SBAR(); qkt(pB0, pB1, (const bf16_t*)(K_lds + o_cur), qr, r32, hi);
  finishSM(pA0, pA1, alA, l_reg, pa0, pa1, pa2, pa3); SBAR();
  pv_psm<MODE>(o, vb0 + o_prev, pa0, pa1, pa2, pa3, pB0, pB1, m_reg, mnB, alB, tab + tbase + (NT - 1) * KVBLK);
  RESC(alB);
  finishSM(pB0, pB1, alB, l_reg, pa0, pa1, pa2, pa3); SBAR();
  pv_d0(o, vb0 + o_cur, pa0, pa1, pa2, pa3);
  if (hi == 0) li_l[r32] = l_reg; asm volatile("s_waitcnt lgkmcnt(0)" ::: "memory");
  float rli[16];
#pragma unroll
  for (int r = 0; r < 16; ++r) rli[r] = __builtin_amdgcn_rcpf(li_l[crow(r, hi)]);
  asm volatile("s_waitcnt vmcnt(0)" ::: "memory");
  __syncthreads();
  char* ost = lds + OFF_OST + wid * 8192;
#pragma unroll
  for (int r = 0; r < 16; ++r) { const int orow = crow(r, hi);
#pragma unroll
    for (int d0 = 0; d0 < 4; ++d0) *(unsigned short*)(ost + orow * 256 + (d0 * 32 + r32) * 2) = f2bf(o[d0][r] * rli[r]); }
  asm volatile("s_waitcnt lgkmcnt(0)" ::: "memory");
  bf16_t* Ow = Ob + (long)(wid * QBLK) * LDQ;
#pragma unroll
  for (int i = 0; i < 8; ++i) { const int ch = i * 64 + lane, row = ch >> 4, c16 = ch & 15;
    const u32x4 v = *(const u32x4*)(ost + row * 256 + c16 * 16); *(u32x4*)(Ow + (long)row * LDQ + c16 * 8) = v; }
  asm volatile("s_waitcnt lgkmcnt(0)" ::: "memory");
  __syncthreads();
#undef ROT
#undef SLOAD
#undef SWRITE
#undef SWAIT
#undef RESC
#undef PSM
}

template <int MODE>
__device__ __forceinline__ void softmax_tile(f32x16& p0, f32x16& p1, float& m_reg, float& l_reg, float& alpha, bf16x8& pa0, bf16x8& pa1, bf16x8& pa2, bf16x8& pa3, const float* tb) {
  if constexpr (MODE == 0) {
    alpha = 1.f;
    if (__builtin_expect(m_reg != 0.f, 0)) {
#pragma unroll
      for (int r = 0; r < 16; ++r) { p0[r] -= m_reg; p1[r] -= m_reg; } }
#pragma unroll
    for (int r = 0; r < 16; ++r) { p0[r] = __builtin_amdgcn_exp2f(p0[r]); p1[r] = __builtin_amdgcn_exp2f(p1[r]); }
  } else {
  if constexpr (MODE == 1) {
#pragma unroll
    for (int r = 0; r < 16; ++r) { const int of = (r & 3) + 8 * (r >> 2); p0[r] = fmaf(p0[r], C, tb[of]); p1[r] = fmaf(p1[r], C, tb[32 + of]); }
  }
  float pmax = p0[0];
#pragma unroll
  for (int r = 1; r < 16; ++r) pmax = fmaxf(pmax, p0[r]);
#pragma unroll
  for (int r = 0; r < 16; ++r) pmax = fmaxf(pmax, p1[r]);
  { auto rr = __builtin_amdgcn_permlane32_swap(__float_as_uint(pmax), __float_as_uint(pmax), false, false);
    pmax = fmaxf(__uint_as_float(rr[0]), __uint_as_float(rr[1])); }
  float mn, sub;
  if constexpr (MODE == 0) {
    if (__builtin_expect(__all(pmax - m_reg <= THR / SCALE), 1)) { mn = m_reg; alpha = 1.f; }
    else { mn = fmaxf(m_reg, pmax); alpha = __builtin_amdgcn_exp2f((m_reg - mn) * C); m_reg = mn; }
    sub = -mn * C;
#pragma unroll
    for (int r = 0; r < 16; ++r) { p0[r] = __builtin_amdgcn_exp2f(fmaf(p0[r], C, sub)); p1[r] = __builtin_amdgcn_exp2f(fmaf(p1[r], C, sub)); }
  } else {
    if (__builtin_expect(__all(pmax - m_reg <= THR * LOG2E), 1)) { mn = m_reg; alpha = 1.f; }
    else { mn = fmaxf(m_reg, pmax); alpha = __builtin_amdgcn_exp2f(m_reg - mn); m_reg = mn; }
    sub = -mn;
#pragma unroll
    for (int r = 0; r < 16; ++r) { p0[r] = __builtin_amdgcn_exp2f(p0[r] + sub); p1[r] = __builtin_amdgcn_exp2f(p1[r] + sub); }
  }
  }
  float ps = 0;
#pragma unroll
  for (int r = 0; r < 16; ++r) ps += p0[r];
#pragma unroll
  for (int r = 0; r < 16; ++r) ps += p1[r];
  { auto rr = __builtin_amdgcn_permlane32_swap(__float_as_uint(ps), __float_as_uint(ps), false, false);
    ps = __uint_as_float(rr[0]) + __uint_as_float(rr[1]); }
  l_reg = l_reg * alpha + ps;
#define PK4(P, BASE, OUT) do { unsigned a0 = cvtpk(P[BASE + 0], P[BASE + 1]), a1 = cvtpk(P[BASE + 2], P[BASE + 3]);   \
    unsigned b0 = cvtpk(P[BASE + 4], P[BASE + 5]), b1 = cvtpk(P[BASE + 6], P[BASE + 7]);                              \
    auto r0 = __builtin_amdgcn_permlane32_swap(a0, b0, false, false); auto r1 = __builtin_amdgcn_permlane32_swap(a1, b1, false, false); \
    u32x4 w = {r0[0], r1[0], r0[1], r1[1]}; OUT = *reinterpret_cast<bf16x8*>(&w); } while (0)
  PK4(p0, 0, pa0); PK4(p0, 8, pa1); PK4(p1, 0, pa2); PK4(p1, 8, pa3);
#undef PK4
}
typedef short v4i16_t __attribute__((ext_vector_type(4)));
__device__ __forceinline__ bf16x8 ld_frag2(int sp, const LAS char* kb, const int (&kx)[4], const LAS char* vb) {
  if (sp >= 16) { const int s = sp - 16, d0 = s >> 1; return *(const LAS bf16x8*)(kb + kx[d0 & 3] + (d0 >> 2) * 128 + (s & 1) * 8192); }
  const int D0 = sp >> 2, ks = sp & 3;
  const s16x4 lo = __builtin_bit_cast(s16x4, __builtin_amdgcn_ds_read_tr16_b64_v4i16((LAS v4i16_t*)(vb + v_rd_off(D0, ks, 0))));
  const s16x4 hi = __builtin_bit_cast(s16x4, __builtin_amdgcn_ds_read_tr16_b64_v4i16((LAS v4i16_t*)(vb + v_rd_off(D0, ks, 1))));
  return (bf16x8){lo[0], lo[1], lo[2], lo[3], hi[0], hi[1], hi[2], hi[3]};
}
template <int SB, int SE, bool PRE>
__device__ __forceinline__ void mrun(bf16x8 (&f)[8], f32x16& p0, f32x16& p1, f32x16* o, const bf16x8* qr, bf16x8 pa0, bf16x8 pa1, bf16x8 pa2, bf16x8 pa3, const LAS char* kb, const int (&kx)[4], const LAS char* vb, float init) {
  if (SE > 16) { p0 = f32x16{}; p1 = f32x16{}; }
  SBAR();
  if (!PRE) {
#pragma unroll
    for (int s = SB; s < SB + 8; ++s) f[s & 7] = ld_frag2(s, kb, kx, vb);
    SBAR(); }
#pragma unroll
  for (int sp = SB; sp < SE; ++sp) {
    if (sp >= 16) { const int s = sp - 16; if (s & 1) p1 = __builtin_amdgcn_mfma_f32_32x32x16_bf16(f[sp & 7], qr[s >> 1], p1, 0, 0, 0); else p0 = __builtin_amdgcn_mfma_f32_32x32x16_bf16(f[sp & 7], qr[s >> 1], p0, 0, 0, 0); }
    else { const int D0 = sp >> 2, ks = sp & 3; const bf16x8 pa = ks == 0 ? pa0 : ks == 1 ? pa1 : ks == 2 ? pa2 : pa3;
      o[D0] = __builtin_amdgcn_mfma_f32_32x32x16_bf16(pa, f[sp & 7], o[D0], 0, 0, 0); }
    if (sp + 8 < SE) f[sp & 7] = ld_frag2(sp + 8, kb, kx, vb);
    SBAR();
  }
}
template <int MODE>
__device__ __forceinline__ void attn_unit_pp(const bf16_t* Qb, const bf16_t* __restrict__ Kh, const bf16_t* __restrict__ Vh, unsigned char* Ob8, int kbeg, int kend, int q0, int head, char* lds, const Aux& aux) {
  int tid = threadIdx.x; asm volatile("" : "+v"(tid));
  const int wid = tid >> 6, lane = tid & 63, r32 = lane & 31, hi = lane >> 5;
  const int widu = __builtin_amdgcn_readfirstlane(wid), half = widu >> 2;
  const int hsub = widu >> 1, rsub = (widu & 1) * QBLK;
  const int rw0 = q0 + rsub;
#define NEED(j) (MODE == 0 || ((kbeg + (j) * KVBLK + KVBLK - 1 >= rw0 - 128) && (kbeg + (j) * KVBLK <= rw0 + QBLK - 1 + 128)))
  char* V_lds = lds; char* K_lds = lds + SHM_V;
  float* ws = (float*)(lds + OFF_WS) + wid * 64; float* li_l = ws; float* al_l = ws + 32;
  float* tab = (float*)(lds + OFF_TAB) + hsub * 768;
  float m_reg = -1e30f, l_reg = 0; f32x16 o[4] = {}; bf16x8 qr[8];
  const bf16_t* Qw = Qb + (long)(rsub + r32) * LDQ + hsub * HD + hi * 8;
#pragma unroll
  for (int d0 = 0; d0 < 8; ++d0) qr[d0] = *reinterpret_cast<const bf16x8*>(Qw + d0 * 16);
  if constexpr (MODE == 1) {
    m_reg = aux.sink[head + hsub] * LOG2E; l_reg = 1.0f;
  }
  const int tbase = kbeg - q0 - rsub - r32 + 383 + 4 * hi;
  float qk_init = 0.f;
  if constexpr (MODE == 0) {
    float mq = fmaxf(fabsf(aux.qn[lane]), fabsf(aux.qn[64 + lane])), mk = fmaxf(fabsf(aux.kn[lane]), fabsf(aux.kn[64 + lane]));
#pragma unroll
    for (int of = 1; of < 64; of <<= 1) { mq = fmaxf(mq, __shfl_xor(mq, of)); mk = fmaxf(mk, __shfl_xor(mk, of)); }
    const float bound = C * 128.0f * mq * mk * 1.01f + 0.5f;
    m_reg = __builtin_amdgcn_readfirstlane(__float_as_int(bound > 64.f ? bound - 64.f : 0.f)) ? (bound - 64.f) : 0.f; (void)qk_init; }
  const int sr = tid >> 4, sc = (tid & 15) * 8, vst0 = v_st(sr, sc), vst1 = v_st(32 + sr, sc);
  const int vb0 = (int)(uintptr_t)V_lds + v_rd_base(lane);
  int kx[4];
#pragma unroll
  for (int d = 0; d < 4; ++d) kx[d] = r32 * 256 + ((d * 32 + hi * 16) ^ ((r32 & 7) << 4));
  const LAS char* k3 = (const LAS char*)K_lds; const LAS char* v3 = (const LAS char*)V_lds + v_rd_base(lane);
  bf16x8 fr_[8];
  bf16x8 s_v0, s_v1, s_k0, s_k1;
#define SLOAD(k0) do { s_v0 = *reinterpret_cast<const bf16x8*>(&Vh[(long)(kbeg + (k0) + sr) * LDK + sc]); s_v1 = *reinterpret_cast<const bf16x8*>(&Vh[(long)(kbeg + (k0) + 32 + sr) * LDK + sc]); \
    s_k0 = *reinterpret_cast<const bf16x8*>(&Kh[(long)(kbeg + (k0) + sr) * LDK + sc]); s_k1 = *reinterpret_cast<const bf16x8*>(&Kh[(long)(kbeg + (k0) + 32 + sr) * LDK + sc]); } while (0)
#define SWRITE(bo) do { *(bf16x8*)(V_lds + (bo) + vst0) = s_v0; *(bf16x8*)(V_lds + (bo) + vst1) = s_v1; const int kc = sc * 2;  \
    *(bf16x8*)(K_lds + (bo) + KSWZ(sr, kc)) = s_k0; *(bf16x8*)(K_lds + (bo) + KSWZ(32 + sr, kc)) = s_k1; } while (0)
#define VMW0() asm volatile("s_waitcnt vmcnt(0)" ::: "memory")
#define BAR() asm volatile("s_waitcnt lgkmcnt(0)\n\ts_barrier" ::: "memory")
#define RESC(a) do { if (__any((a) < 1.f)) { if (hi == 0) al_l[r32] = (a); asm volatile("s_waitcnt lgkmcnt(0)" ::: "memory"); \
    _Pragma("unroll") for (int d = 0; d < 4; ++d) _Pragma("unroll") for (int r = 0; r < 16; ++r) o[d][r] *= al_l[crow(r, hi)]; } } while (0)
#define ROT() do { const int t_ = o_prev; o_prev = o_cur; o_cur = o_next; o_next = t_; } while (0)
#define VSEG(j) do { VMW0(); SWRITE(o_next); { const int nx_ = (j) + 2 + half; SLOAD((nx_ < NT ? nx_ : NT - 1) * KVBLK); } SBAR(); \
    if (NEED(j)) { softmax_tile<MODE>(p0, p1, m_reg, l_reg, alpha, pa0, pa1, pa2, pa3, tab + tbase + (j) * KVBLK); if constexpr (MODE == 1) { RESC(alpha); } } SBAR(); } while (0)
#define PVPRE() do { if constexpr (MODE == 0) { _Pragma("unroll") for (int s_ = 0; s_ < 8; ++s_) fr_[s_] = ld_frag2(s_, k3, kx, v3 + o_cur); SBAR(); } } while (0)
  f32x16 p0, p1; float alpha; bf16x8 pa0, pa1, pa2, pa3; const int NT = (kend - kbeg) / KVBLK;
  int o_prev = 2 * BUFB, o_cur = 0, o_next = BUFB;
  { bf16x8 t_v0, t_v1, t_k0, t_k1;
    t_v0 = *reinterpret_cast<const bf16x8*>(&Vh[(long)(kbeg + sr) * LDK + sc]); t_v1 = *reinterpret_cast<const bf16x8*>(&Vh[(long)(kbeg + 32 + sr) * LDK + sc]);
    t_k0 = *reinterpret_cast<const bf16x8*>(&Kh[(long)(kbeg + sr) * LDK + sc]); t_k1 = *reinterpret_cast<const bf16x8*>(&Kh[(long)(kbeg + 32 + sr) * LDK + sc]);
    SLOAD(KVBLK); VMW0();
    *(bf16x8*)(V_lds + vst0) = t_v0; *(bf16x8*)(V_lds + vst1) = t_v1; { const int kc = sc * 2; *(bf16x8*)(K_lds + KSWZ(sr, kc)) = t_k0; *(bf16x8*)(K_lds + KSWZ(32 + sr, kc)) = t_k1; }
    if (half) { SWRITE(BUFB); SLOAD(2 * KVBLK); } }
  BAR();
#define MSEG_QK(j) do { SBAR(); if (NEED(j)) qkt(p0, p1, (const bf16_t*)(K_lds + o_cur), qr, r32, hi, qk_init); SBAR(); } while (0)
#define MSEG(j) do { SBAR(); if (NEED(j)) qkt(p0, p1, (const bf16_t*)(K_lds + o_cur), qr, r32, hi, qk_init); if (NEED((j) - 1)) pv_d0(o, vb0 + o_prev, pa0, pa1, pa2, pa3); SBAR(); } while (0)
#define MSEG_PV() do { SBAR(); if (NEED(NT - 1)) pv_d0(o, vb0 + o_prev, pa0, pa1, pa2, pa3); SBAR(); } while (0)
  if (half == 0) {
    MSEG_QK(0); VSEG(0);
    BAR(); ROT();
    for (int j = 1; j < NT; ++j) { MSEG(j); VSEG(j); BAR(); ROT(); }
    MSEG_PV();
  } else {
    MSEG_QK(0);
    BAR(); ROT();
    for (int j = 1; j < NT; ++j) { VSEG(j - 1); MSEG(j); BAR(); ROT(); }
    VSEG(NT - 1); MSEG_PV();
  }
#undef MSEG_QK
#undef MSEG
#undef MSEG_PV
  if (hi == 0) li_l[r32] = l_reg; asm volatile("s_waitcnt lgkmcnt(0)" ::: "memory");
  float rli[16];
#pragma unroll
  for (int r = 0; r < 16; ++r) rli[r] = __builtin_amdgcn_rcpf(li_l[crow(r, hi)]);
  VMW0();
  __syncthreads();
  char* ost = lds + OFF_OST + wid * 4096;
#pragma unroll
  for (int r = 0; r < 16; ++r) { const int orow = crow(r, hi);
#pragma unroll
    for (int d0 = 0; d0 < 4; ++d0) { const float xo = o[d0][r] * rli[r] * OB8S; *(unsigned char*)(ost + orow * 128 + d0 * 32 + r32) = (unsigned char)(__builtin_amdgcn_cvt_pk_fp8_f32(xo, xo, 0, false) & 0xff); } }
  asm volatile("s_waitcnt lgkmcnt(0)" ::: "memory");
  unsigned char* Ow = Ob8 + (long)rsub * QW + hsub * HD;
#pragma unroll
  for (int i = 0; i < 4; ++i) { const int ch = i * 64 + lane, row = ch >> 3, c16 = ch & 7;
    const u32x4 v = *(const u32x4*)(ost + row * 128 + c16 * 16); *(u32x4*)(Ow + (long)row * QW + c16 * 16) = v; }
  asm volatile("s_waitcnt lgkmcnt(0)" ::: "memory");
  __syncthreads();
#undef SLOAD
#undef SWRITE
#undef VMW0
#undef BAR
#undef RESC
#undef ROT
#undef VSEG
#undef PVPRE
#undef NEED
}

__device__ __forceinline__ int offK16(int row, int ch) { return row * 256 + 16 * (ch ^ (row & 15)); }
__device__ __forceinline__ int offV16(int row, int ch) { return row * 256 + 16 * (ch ^ ((row & 7) << 1)); }
__device__ __forceinline__ bf16x8 ld_frag16(int sp, const LAS char* kb, const int (&ka)[4], const LAS char* vb, const int (&va)[8]) {
  if (sp >= 16) { const int s = sp - 16, kblk = s >> 2, ks = s & 3; return *(const LAS bf16x8*)(kb + ka[ks] + kblk * 4096); }
  const int db = sp >> 1, s = sp & 1;
  const s16x4 lo = __builtin_bit_cast(s16x4, __builtin_amdgcn_ds_read_tr16_b64_v4i16((LAS v4i16_t*)(vb + va[db] + s * 8192)));
  const s16x4 hi = __builtin_bit_cast(s16x4, __builtin_amdgcn_ds_read_tr16_b64_v4i16((LAS v4i16_t*)(vb + va[db] + s * 8192 + 4096)));
  return (bf16x8){lo[0], lo[1], lo[2], lo[3], hi[0], hi[1], hi[2], hi[3]};
}
template <int SB, int SE, bool PRE>
__device__ __forceinline__ void mrun16(bf16x8 (&f)[8], f32x4 (&S)[4][2], f32x4 (&O)[8][2], const bf16x8 (&qf)[2][4], const bf16x8 (&pf)[2][2], const LAS char* kb, const int (&ka)[4], const LAS char* vb, const int (&va)[8]) {
  if (SE > 16) {
#pragma unroll
    for (int i = 0; i < 4; ++i) { S[i][0] = (f32x4){0.f, 0.f, 0.f, 0.f}; S[i][1] = (f32x4){0.f, 0.f, 0.f, 0.f}; } }
  SBAR();
  if (!PRE) {
#pragma unroll
    for (int s = SB; s < SB + 8; ++s) f[s & 7] = ld_frag16(s, kb, ka, vb, va);
    SBAR(); }
#pragma unroll
  for (int sp = SB; sp < SE; ++sp) {
    if (sp >= 16) { const int s = sp - 16, kblk = s >> 2, ks = s & 3;
      S[kblk][0] = __builtin_amdgcn_mfma_f32_16x16x32_bf16(f[sp & 7], qf[0][ks], S[kblk][0], 0, 0, 0); S[kblk][1] = __builtin_amdgcn_mfma_f32_16x16x32_bf16(f[sp & 7], qf[1][ks], S[kblk][1], 0, 0, 0); }
    else { const int db = sp >> 1, s = sp & 1;
      O[db][0] = __builtin_amdgcn_mfma_f32_16x16x32_bf16(f[sp & 7], pf[0][s], O[db][0], 0, 0, 0); O[db][1] = __builtin_amdgcn_mfma_f32_16x16x32_bf16(f[sp & 7], pf[1][s], O[db][1], 0, 0, 0); }
    if (sp + 8 < SE) f[sp & 7] = ld_frag16(sp + 8, kb, ka, vb, va);
    SBAR();
  }
}
__device__ __forceinline__ void attn_unit16(const bf16_t* Qb, const bf16_t* __restrict__ Kh, const bf16_t* __restrict__ Vh, bf16_t* Ob, int nkeys, int q0, char* lds, const Aux& aux) {
  int tid = threadIdx.x; asm volatile("" : "+v"(tid));
  const int wid = tid >> 6, lane = tid & 63, fr = lane & 15, fq = lane >> 4;
  const int half = __builtin_amdgcn_readfirstlane(wid >> 2);
  char* V_lds = lds; char* K_lds = lds + SHM_V;
  float shift;
  { float mq = fmaxf(fabsf(aux.qn[lane]), fabsf(aux.qn[64 + lane])), mk = fmaxf(fabsf(aux.kn[lane]), fabsf(aux.kn[64 + lane]));
#pragma unroll
    for (int of = 1; of < 64; of <<= 1) { mq = fmaxf(mq, __shfl_xor(mq, of)); mk = fmaxf(mk, __shfl_xor(mk, of)); }
    const float bound = C * 128.0f * mq * mk * 1.01f + 0.5f; shift = bound > 64.f ? bound - 64.f : 0.f; }
  bf16x8 qf[2][4];
#pragma unroll
  for (int qb = 0; qb < 2; ++qb)
#pragma unroll
    for (int ks = 0; ks < 4; ++ks) qf[qb][ks] = *reinterpret_cast<const bf16x8*>(Qb + (long)(wid * QBLK + 16 * qb + fr) * LDQ + 32 * ks + 8 * fq);
#pragma unroll
  for (int qb = 0; qb < 2; ++qb) {
    float ss = 0.f;
#pragma unroll
    for (int ks = 0; ks < 4; ++ks) { const f32x8 x = bf8_to_f32(qf[qb][ks]);
#pragma unroll
      for (int e = 0; e < 8; ++e) ss += x[e] * x[e]; }
    ss += __shfl_xor(ss, 16); ss += __shfl_xor(ss, 32);
    const float rinv = C / sqrtf(ss * (1.0f / 128.0f) + EPS);
    const int t = q0 + wid * QBLK + 16 * qb + fr;
#pragma unroll
    for (int hf = 0; hf < 2; ++hf) { const int posx = hf ? (t & 63) : (t >> 6);
      const f32x8 cs = *reinterpret_cast<const f32x8*>(aux.cosT + posx * 32 + 8 * fq), sn = *reinterpret_cast<const f32x8*>(aux.sinT + posx * 32 + 8 * fq);
      const f32x8 g1 = *reinterpret_cast<const f32x8*>(aux.qn + hf * 64 + 8 * fq), g2 = *reinterpret_cast<const f32x8*>(aux.qn + hf * 64 + 32 + 8 * fq);
      const f32x8 x1 = bf8_to_f32(qf[qb][2 * hf]) * rinv * g1, x2 = bf8_to_f32(qf[qb][2 * hf + 1]) * rinv * g2;
      qf[qb][2 * hf] = f32_to_bf8(x1 * cs - x2 * sn); qf[qb][2 * hf + 1] = f32_to_bf8(x2 * cs + x1 * sn); } }
  f32x4 O[8][2], S[4][2]; bf16x8 pf[2][2]; float lsum[2] = {0.f, 0.f};
#pragma unroll
  for (int i = 0; i < 8; ++i) { O[i][0] = (f32x4){0.f, 0.f, 0.f, 0.f}; O[i][1] = (f32x4){0.f, 0.f, 0.f, 0.f}; }
  int ka[4], va[8];
#pragma unroll
  for (int ks = 0; ks < 4; ++ks) ka[ks] = offK16(fr, 4 * ks + fq);
  { const int q = (lane & 15) >> 2, p = lane & 3;
#pragma unroll
    for (int c = 0; c < 8; ++c) va[c] = offV16(4 * fq + q, 2 * c + (p >> 1)) + 8 * (p & 1); }
  const LAS char* k3 = (const LAS char*)K_lds; const LAS char* v3 = (const LAS char*)V_lds;
  bf16x8 fr_[8];
  const int sr = tid >> 4, scc = tid & 15, kst = offK16(sr, scc), vst = offV16(sr, scc);
  bf16x8 s_v0, s_v1, s_k0, s_k1;
#define SLOAD(k0) do { s_v0 = *reinterpret_cast<const bf16x8*>(&Vh[(long)((k0) + sr) * LDK + scc * 8]); s_v1 = *reinterpret_cast<const bf16x8*>(&Vh[(long)((k0) + 32 + sr) * LDK + scc * 8]); \
    s_k0 = *reinterpret_cast<const bf16x8*>(&Kh[(long)((k0) + sr) * LDK + scc * 8]); s_k1 = *reinterpret_cast<const bf16x8*>(&Kh[(long)((k0) + 32 + sr) * LDK + scc * 8]); } while (0)
#define SWRITE(bo) do { *(bf16x8*)(V_lds + (bo) + vst) = s_v0; *(bf16x8*)(V_lds + (bo) + vst + 8192) = s_v1; *(bf16x8*)(K_lds + (bo) + kst) = s_k0; *(bf16x8*)(K_lds + (bo) + kst + 8192) = s_k1; } while (0)
#define VMW0() asm volatile("s_waitcnt vmcnt(0)" ::: "memory")
#define BAR() asm volatile("s_waitcnt lgkmcnt(0)\n\ts_barrier" ::: "memory")
#define ROT() do { const int t_ = o_prev; o_prev = o_cur; o_cur = o_next; o_next = t_; } while (0)
#define VSEG(j, wbuf_, pbuf_) do { VMW0(); SWRITE(wbuf_); { const int nx_ = (j) + 2 + half; SLOAD((nx_ < NT ? nx_ : NT - 1) * KVBLK); } SBAR(); \
    if (__builtin_expect(shift != 0.f, 0)) { _Pragma("unroll") for (int i_ = 0; i_ < 4; ++i_) { S[i_][0] -= shift; S[i_][1] -= shift; } } \
    _Pragma("unroll") for (int qb_ = 0; qb_ < 2; ++qb_) { \
      _Pragma("unroll") for (int i_ = 0; i_ < 4; ++i_) _Pragma("unroll") for (int r_ = 0; r_ < 4; ++r_) S[i_][qb_][r_] = __builtin_amdgcn_exp2f(S[i_][qb_][r_]); \
      float a_ = 0.f; _Pragma("unroll") for (int i_ = 0; i_ < 4; ++i_) a_ += (S[i_][qb_][0] + S[i_][qb_][1]) + (S[i_][qb_][2] + S[i_][qb_][3]); lsum[qb_] += a_; \
      _Pragma("unroll") for (int s_ = 0; s_ < 2; ++s_) { u32x4 w_ = {cvtpk(S[2 * s_][qb_][0], S[2 * s_][qb_][1]), cvtpk(S[2 * s_][qb_][2], S[2 * s_][qb_][3]), cvtpk(S[2 * s_ + 1][qb_][0], S[2 * s_ + 1][qb_][1]), cvtpk(S[2 * s_ + 1][qb_][2], S[2 * s_ + 1][qb_][3])}; \
        pf[qb_][s_] = *reinterpret_cast<bf16x8*>(&w_); } } \
    SBAR(); _Pragma("unroll") for (int s_ = 0; s_ < 8; ++s_) fr_[s_] = ld_frag16(s_, k3, ka, v3 + (pbuf_), va); SBAR(); } while (0)
  const int NT = nkeys / KVBLK;
  int o_prev = 2 * BUFB, o_cur = 0, o_next = BUFB;
  SLOAD(0); VMW0(); SWRITE(0);
  if (half) { SLOAD(KVBLK); VMW0(); SWRITE(BUFB); SLOAD(2 * KVBLK); } else { SLOAD(KVBLK); }
  BAR();
  if (half == 0) {
    mrun16<16, 32, false>(fr_, S, O, qf, pf, k3 + o_cur, ka, v3 + o_prev, va);
    VSEG(0, o_next, o_cur);
    BAR(); ROT();
    for (int j = 1; j < NT; ++j) {
      mrun16<0, 32, true>(fr_, S, O, qf, pf, k3 + o_cur, ka, v3 + o_prev, va);
      VSEG(j, o_next, o_cur);
      BAR(); ROT();
    }
    mrun16<0, 16, true>(fr_, S, O, qf, pf, k3 + o_cur, ka, v3 + o_prev, va);
  } else {
    mrun16<16, 32, false>(fr_, S, O, qf, pf, k3 + o_cur, ka, v3 + o_prev, va);
    BAR(); ROT();
    for (int j = 1; j < NT; ++j) {
      VSEG(j - 1, o_next, o_prev);
      mrun16<0, 32, true>(fr_, S, O, qf, pf, k3 + o_cur, ka, v3 + o_prev, va);
      BAR(); ROT();
    }
    VSEG(NT - 1, o_next, o_prev);
    mrun16<0, 16, true>(fr_, S, O, qf, pf, k3 + o_cur, ka, v3 + o_prev, va);
  }
  float rl[2];
#pragma unroll
  for (int qb = 0; qb < 2; ++qb) { float l = lsum[qb]; l += __shfl_xor(l, 16); l += __shfl_xor(l, 32); rl[qb] = __builtin_amdgcn_rcpf(l); }
  VMW0();
  __syncthreads();
  char* ost = lds + OFF_OST + wid * 8192;
#pragma unroll
  for (int db = 0; db < 8; ++db)
#pragma unroll
    for (int qb = 0; qb < 2; ++qb) { const f32x4 v = O[db][qb] * rl[qb]; u32x2 w; w.x = cvtpk(v[0], v[1]); w.y = cvtpk(v[2], v[3]);
      *(u32x2*)(ost + (16 * qb + fr) * 256 + (16 * db + 4 * fq) * 2) = w; }
  asm volatile("s_waitcnt lgkmcnt(0)" ::: "memory");
  bf16_t* Ow = Ob + (long)(wid * QBLK) * LDQ;
#pragma unroll
  for (int i = 0; i < 8; ++i) { const int ch = i * 64 + lane, row = ch >> 4, c16 = ch & 15;
    const u32x4 v = *(const u32x4*)(ost + row * 256 + c16 * 16); *(u32x4*)(Ow + (long)row * LDQ + c16 * 8) = v; }
  asm volatile("s_waitcnt lgkmcnt(0)" ::: "memory");
  __syncthreads();
#undef SLOAD
#undef SWRITE
#undef VMW0
#undef BAR
#undef ROT
#undef VSEG
}

typedef int v8i_t __attribute__((ext_vector_type(8)));
typedef short v2s_t __attribute__((ext_vector_type(2)));
__device__ __forceinline__ int off8(int row, int c16) { return row * 128 + 16 * (c16 ^ (((row >> 1) & 1) | (((row >> 2) & 1) << 2))); }
__device__ __forceinline__ v8i_t ld_frag8(const LAS char* img, int a0, int a1, int blk) {
  const u32x4 lo = *(const LAS u32x4*)(img + blk * 2048 + a0), hi = *(const LAS u32x4*)(img + blk * 2048 + a1);
  return (v8i_t){(int)lo.x, (int)lo.y, (int)lo.z, (int)lo.w, (int)hi.x, (int)hi.y, (int)hi.z, (int)hi.w};
}
__device__ __forceinline__ void exp_pack8(f32x4 (&S)[4][2], v8i_t (&pf)[2], float (&lsum)[2], float pscale, int h) {
#pragma unroll
  for (int qb = 0; qb < 2; ++qb) { float a = 0.f;
#pragma unroll
    for (int i = 0; i < 4; ++i) { f32x4 e;
#pragma unroll
      for (int r = 0; r < 4; ++r) e[r] = __builtin_amdgcn_exp2f(S[i][qb][r]);
      a += (e[0] + e[1]) + (e[2] + e[3]);
      v2s_t p = {0, 0}; p = __builtin_amdgcn_cvt_scalef32_pk_bf8_f32(p, e[0], e[1], pscale, false); p = __builtin_amdgcn_cvt_scalef32_pk_bf8_f32(p, e[2], e[3], pscale, true);
      const int w = __builtin_bit_cast(int, p);
      if (h == 0) { if (i == 0) pf[qb][0] = w; else if (i == 1) pf[qb][1] = w; else if (i == 2) pf[qb][2] = w; else pf[qb][3] = w; }
      else { if (i == 0) pf[qb][4] = w; else if (i == 1) pf[qb][5] = w; else if (i == 2) pf[qb][6] = w; else pf[qb][7] = w; } }
    lsum[qb] += a; }
}
template <bool DO_PV, bool DO_QK, bool PRE>
__device__ __forceinline__ void mrun8(v8i_t (&f)[2], f32x4 (&S)[4][2], f32x4 (&O)[8][2], const v8i_t (&qf)[2], v8i_t (&pf)[2], float (&lsum)[2], float pscale, const LAS char* kimg, const LAS char* vimg, int a0, int a1) {
  constexpr int SB = DO_PV ? 0 : 8, SE = DO_QK ? 16 : 8;
  SBAR();
  if (!PRE) {
#pragma unroll
    for (int s = SB; s < SB + 2; ++s) f[s & 1] = (s >= 8) ? ld_frag8(kimg, a0, a1, s - 8) : ld_frag8(vimg, a0, a1, s);
    SBAR(); }
#pragma unroll
  for (int sp = SB; sp < SE; ++sp) {
    if (sp >= 8) { const int kb = sp - 8; const f32x4 z = {0.f, 0.f, 0.f, 0.f};
      S[kb & 3][0] = __builtin_amdgcn_mfma_scale_f32_16x16x128_f8f6f4(f[sp & 1], qf[0], z, 0, 0, 0, 0, 0, 0); S[kb & 3][1] = __builtin_amdgcn_mfma_scale_f32_16x16x128_f8f6f4(f[sp & 1], qf[1], z, 0, 0, 0, 0, 0, 0); }
    else { O[sp][0] = __builtin_amdgcn_mfma_scale_f32_16x16x128_f8f6f4(f[sp & 1], pf[0], O[sp][0], 0, 1, 0, 0, 0, 0); O[sp][1] = __builtin_amdgcn_mfma_scale_f32_16x16x128_f8f6f4(f[sp & 1], pf[1], O[sp][1], 0, 1, 0, 0, 0, 0); }
    if (sp + 2 < SE) f[sp & 1] = (sp + 2 >= 8) ? ld_frag8(kimg, a0, a1, sp + 2 - 8) : ld_frag8(vimg, a0, a1, sp + 2);
    SBAR();
    if (sp == 11) { exp_pack8(S, pf, lsum, pscale, 0); SBAR(); }
  }
}
__device__ __forceinline__ float xsum16(float x) { auto r = __builtin_amdgcn_permlane16_swap(__float_as_uint(x), __float_as_uint(x), false, false); return __uint_as_float(r[0]) + __uint_as_float(r[1]); }
__device__ __forceinline__ float xsum32(float x) { auto r = __builtin_amdgcn_permlane32_swap(__float_as_uint(x), __float_as_uint(x), false, false); return __uint_as_float(r[0]) + __uint_as_float(r[1]); }
__device__ __forceinline__ float xchg16(float x, bool odd) { auto r = __builtin_amdgcn_permlane16_swap(__float_as_uint(x), __float_as_uint(x), false, false); return __uint_as_float(odd ? r[0] : r[1]); }
__device__ __forceinline__ void attn_unit8(const bf16_t* Qb, const unsigned char* __restrict__ K8, const unsigned char* __restrict__ V8T, unsigned char* Ob8, int q0, char* lds, const Aux& aux, float pscale) {
  int tid = threadIdx.x; asm volatile("" : "+v"(tid));
  const int wid = tid >> 6, lane = tid & 63, fr = lane & 15, g = lane >> 4;
  const int half = __builtin_amdgcn_readfirstlane(wid >> 2);
  v8i_t qf[2];
  { char* qs = lds + 3 * BUFB + wid * 4096;
#pragma unroll
    for (int qb = 0; qb < 2; ++qb) {
      bf16x8 q16[4]; float ss = 0.f;
#pragma unroll
      for (int ks = 0; ks < 4; ++ks) { q16[ks] = *reinterpret_cast<const bf16x8*>(Qb + (long)(wid * QBLK + 16 * qb + fr) * LDQ + 32 * ks + 8 * g); const f32x8 x = bf8_to_f32(q16[ks]);
#pragma unroll
        for (int e = 0; e < 8; ++e) ss += x[e] * x[e]; }
      ss = xsum32(xsum16(ss));
      const float rinv = C / sqrtf(ss * (1.0f / 128.0f) + EPS);
      const int t = q0 + wid * QBLK + 16 * qb + fr;
#pragma unroll
      for (int hf = 0; hf < 2; ++hf) { const int posx = hf ? (t & 63) : (t >> 6);
        const f32x8 cs = *reinterpret_cast<const f32x8*>(aux.cosT + posx * 32 + 8 * g), sn = *reinterpret_cast<const f32x8*>(aux.sinT + posx * 32 + 8 * g);
        const f32x8 g1 = *reinterpret_cast<const f32x8*>(aux.qn + hf * 64 + 8 * g), g2 = *reinterpret_cast<const f32x8*>(aux.qn + hf * 64 + 32 + 8 * g);
        const f32x8 x1 = bf8_to_f32(q16[2 * hf]) * rinv * g1, x2 = bf8_to_f32(q16[2 * hf + 1]) * rinv * g2;
        const f32x8 y1 = x1 * cs - x2 * sn, y2 = x2 * cs + x1 * sn;
        int a0_ = 0, a1_ = 0, b0_ = 0, b1_ = 0;
        a0_ = __builtin_amdgcn_cvt_pk_fp8_f32(y1[0], y1[1], a0_, false); a0_ = __builtin_amdgcn_cvt_pk_fp8_f32(y1[2], y1[3], a0_, true); a1_ = __builtin_amdgcn_cvt_pk_fp8_f32(y1[4], y1[5], a1_, false); a1_ = __builtin_amdgcn_cvt_pk_fp8_f32(y1[6], y1[7], a1_, true);
        b0_ = __builtin_amdgcn_cvt_pk_fp8_f32(y2[0], y2[1], b0_, false); b0_ = __builtin_amdgcn_cvt_pk_fp8_f32(y2[2], y2[3], b0_, true); b1_ = __builtin_amdgcn_cvt_pk_fp8_f32(y2[4], y2[5], b1_, false); b1_ = __builtin_amdgcn_cvt_pk_fp8_f32(y2[6], y2[7], b1_, true);
        *(u32x2*)(qs + (16 * qb + fr) * 128 + 32 * (2 * hf) + 8 * g) = (u32x2){(unsigned)a0_, (unsigned)a1_}; *(u32x2*)(qs + (16 * qb + fr) * 128 + 32 * (2 * hf + 1) + 8 * g) = (u32x2){(unsigned)b0_, (unsigned)b1_}; }
    }
    asm volatile("s_waitcnt lgkmcnt(0)" ::: "memory");
#pragma unroll
    for (int qb = 0; qb < 2; ++qb) { const u32x4 lo = *(const u32x4*)(qs + (16 * qb + fr) * 128 + 32 * g), hi = *(const u32x4*)(qs + (16 * qb + fr) * 128 + 32 * g + 16);
      qf[qb] = (v8i_t){(int)lo.x, (int)lo.y, (int)lo.z, (int)lo.w, (int)hi.x, (int)hi.y, (int)hi.z, (int)hi.w}; }
    asm volatile("s_waitcnt lgkmcnt(0)" ::: "memory"); }
  f32x4 O[8][2], S[4][2]; v8i_t pf[2]; float lsum[2] = {0.f, 0.f};
#pragma unroll
  for (int i = 0; i < 8; ++i) { O[i][0] = (f32x4){0.f, 0.f, 0.f, 0.f}; O[i][1] = (f32x4){0.f, 0.f, 0.f, 0.f}; }
  const int a0 = off8(fr, 2 * g), a1 = off8(fr, 2 * g + 1);
  char* V_lds = lds; char* K_lds = lds + SHM_V;
  const LAS char* k3 = (const LAS char*)K_lds; const LAS char* v3 = (const LAS char*)V_lds;
  v8i_t fr_[2];
  const int widu = __builtin_amdgcn_readfirstlane(wid);
  unsigned dso[2];
#pragma unroll
  for (int i = 0; i < 2; ++i) { const int c = (wid * 2 + i) * 64 + lane, row = c >> 3, p = c & 7; dso[i] = (unsigned)(row * 128 + ((p ^ (((row >> 1) & 1) | (((row >> 2) & 1) << 2))) << 4)); }
  const unsigned ldsw = (unsigned)widu * 2048u; LAS unsigned char* l3 = (LAS unsigned char*)lds;
#define DMA_TILE(t_) do { const unsigned char* kg_ = K8 + (size_t)(t_) * 16384; const unsigned char* vg_ = V8T + (size_t)(t_) * 16384; const unsigned bo_ = (unsigned)(((t_) & 3) * BUFB); \
    _Pragma("unroll") for (int i_ = 0; i_ < 2; ++i_) { \
      __builtin_amdgcn_global_load_lds((const unsigned*)(vg_ + dso[i_]), (LAS unsigned*)(l3 + bo_ + ldsw + i_ * 1024), 16, 0, 0); \
      __builtin_amdgcn_global_load_lds((const unsigned*)(kg_ + dso[i_]), (LAS unsigned*)(l3 + bo_ + SHM_V + ldsw + i_ * 1024), 16, 0, 0); } } while (0)
#define VMW0() asm volatile("s_waitcnt vmcnt(0)" ::: "memory")
#define BAR() asm volatile("s_waitcnt lgkmcnt(0)\n\ts_barrier" ::: "memory")
#define VSEG(j, pbuf_) do { VMW0(); { const int nx_ = (j) + 2 + half; if (nx_ < NT) DMA_TILE(nx_); } SBAR(); \
    exp_pack8(S, pf, lsum, pscale, 1); \
    SBAR(); _Pragma("unroll") for (int s_ = 0; s_ < 2; ++s_) fr_[s_] = ld_frag8(v3 + (pbuf_), a0, a1, s_); SBAR(); } while (0)
  constexpr int NT = SEQ / 128;
  DMA_TILE(0); DMA_TILE(1); if (half) DMA_TILE(2);
  VMW0(); BAR();
  if (half == 0) {
    mrun8<false, true, false>(fr_, S, O, qf, pf, lsum, pscale, k3, v3, a0, a1);
    VSEG(0, 0);
    BAR();
    for (int j = 1; j < NT; ++j) {
      mrun8<true, true, true>(fr_, S, O, qf, pf, lsum, pscale, k3 + (j & 3) * BUFB, v3 + ((j - 1) & 3) * BUFB, a0, a1);
      VSEG(j, (j & 3) * BUFB);
      BAR();
    }
    mrun8<true, false, true>(fr_, S, O, qf, pf, lsum, pscale, k3, v3 + ((NT - 1) & 3) * BUFB, a0, a1);
  } else {
    mrun8<false, true, false>(fr_, S, O, qf, pf, lsum, pscale, k3, v3, a0, a1);
    BAR();
    for (int j = 1; j < NT; ++j) {
      VSEG(j - 1, ((j - 1) & 3) * BUFB);
      mrun8<true, true, true>(fr_, S, O, qf, pf, lsum, pscale, k3 + (j & 3) * BUFB, v3 + ((j - 1) & 3) * BUFB, a0, a1);
      BAR();
    }
    VSEG(NT - 1, ((NT - 1) & 3) * BUFB);
    mrun8<true, false, true>(fr_, S, O, qf, pf, lsum, pscale, k3, v3 + ((NT - 1) & 3) * BUFB, a0, a1);
  }
  float rl[2];
#pragma unroll
  for (int qb = 0; qb < 2; ++qb) { const float l = xsum32(xsum16(lsum[qb])); rl[qb] = pscale * __builtin_amdgcn_rcpf(l); }
  VMW0();
  __syncthreads();
  char* ost = lds + OFF_OST + wid * 4096;
#pragma unroll
  for (int db = 0; db < 8; ++db)
#pragma unroll
    for (int qb = 0; qb < 2; ++qb) { const f32x4 v = O[db][qb] * (rl[qb] * OA8S); int w = 0; w = __builtin_amdgcn_cvt_pk_fp8_f32(v[0], v[1], w, false); w = __builtin_amdgcn_cvt_pk_fp8_f32(v[2], v[3], w, true);
      *(int*)(ost + (16 * qb + fr) * 128 + 16 * db + 4 * g) = w; }
  asm volatile("s_waitcnt lgkmcnt(0)" ::: "memory");
  unsigned char* Ow = Ob8 + (long)(wid * QBLK) * QW;
#pragma unroll
  for (int i = 0; i < 4; ++i) { const int ch = i * 64 + lane, row = ch >> 3, c16 = ch & 7;
    const u32x4 v = *(const u32x4*)(ost + row * 128 + c16 * 16); *(u32x4*)(Ow + (long)row * QW + c16 * 16) = v; }
  asm volatile("s_waitcnt lgkmcnt(0)" ::: "memory");
  __syncthreads();
#undef DMA_TILE
#undef VMW0
#undef BAR
#undef VSEG
}
}

#define XB_TMO      128
#define XB_XCNT(j)  (256  + 64 * (j))
#define XB_XSUB(j)  (1280 + 64 * (j))
#define XB_XGEN(j)  (2304 + 64 * (j))
#define XB_TOP      3328
#define XB_TOPGEN   3392
#define XCD_BAR_WORDS 3456
#define XB_SPIN_CAP (1u << 18)
__device__ __forceinline__ unsigned xb_ld(unsigned* p)              { return __hip_atomic_load(p, __ATOMIC_RELAXED, __HIP_MEMORY_SCOPE_AGENT); }
__device__ __forceinline__ unsigned xb_add(unsigned* p, unsigned v) { return __hip_atomic_fetch_add(p, v, __ATOMIC_RELAXED, __HIP_MEMORY_SCOPE_AGENT); }
__device__ __forceinline__ unsigned xb_xcc_id() { return (unsigned)__builtin_amdgcn_s_getreg((3 << 11) | 20) & 0xFu; }
#define XB_SPIN(cond, bar) do { unsigned _sp = 0; while (cond) { __builtin_amdgcn_s_sleep(1); \
    if ((++_sp & 255u) == 0u) { if (xb_ld(&(bar)[XB_TMO])) break; if (_sp > XB_SPIN_CAP) { atomicAdd(&(bar)[XB_TMO], 1u); break; } } } } while (0)
struct XcdBarrier { unsigned* bar; unsigned x; volatile LAS unsigned* st; };
__device__ __forceinline__ XcdBarrier xcd_barrier_post(unsigned* bar, volatile LAS unsigned* st) {
    XcdBarrier b; b.bar = bar; b.x = xb_xcc_id(); b.st = st;
    if (threadIdx.x == 0) (void)xb_add(&bar[XB_XCNT(b.x)], 1u);
    return b;
}
__device__ __forceinline__ void xcd_barrier_complete(unsigned* bar, unsigned x, unsigned& nloc, unsigned& nx) {
    const unsigned G = gridDim.x * gridDim.y * gridDim.z;
    unsigned sum, cnt, mine, sp = 0u;
    for (;;) {
        sum = 0u; cnt = 0u; mine = 0u;
#pragma unroll
        for (unsigned j = 0; j < 16; ++j) { const unsigned c = xb_ld(&bar[XB_XCNT(j)]); sum += c; cnt += (c > 0u) ? 1u : 0u; mine = (j == x) ? c : mine; }
        if (sum == G) break;
        __builtin_amdgcn_s_sleep(1);
        if ((++sp & 255u) == 0u) { if (xb_ld(&bar[XB_TMO])) break; if (sp > XB_SPIN_CAP) { atomicAdd(&bar[XB_TMO], 1u); break; } }
    }
    nloc = mine > 0u ? mine : 1u; nx = cnt > 0u ? cnt : 1u;
}
__device__ __forceinline__ void xcd_barrier(const XcdBarrier& b) {
    asm volatile("s_waitcnt vmcnt(0)" ::: "memory");
    __syncthreads();
    if (threadIdx.x == 0) {
        unsigned* bar = b.bar;
        __builtin_amdgcn_s_waitcnt(0);
        unsigned nloc = b.st[0], nx = b.st[1];
        if (nloc == 0u) { xcd_barrier_complete(bar, b.x, nloc, nx); b.st[0] = nloc; b.st[1] = nx; }
        const unsigned old = xb_add(&bar[XB_XSUB(b.x)], 1u);
        const unsigned gen = old / nloc;
        if (old + 1u == (gen + 1u) * nloc) {
            __builtin_amdgcn_fence(__ATOMIC_RELEASE, "agent");
            asm volatile("s_waitcnt vmcnt(0)" ::: "memory");
            const unsigned og = xb_add(&bar[XB_TOP], 1u);
            const unsigned tg = og / nx;
            if (og + 1u == (tg + 1u) * nx) xb_add(&bar[XB_TOPGEN], 1u);
            else XB_SPIN(xb_ld(&bar[XB_TOPGEN]) == tg, bar);
            __builtin_amdgcn_fence(__ATOMIC_ACQUIRE, "agent");
            xb_add(&bar[XB_XGEN(b.x)], 1u);
            asm volatile("s_waitcnt vmcnt(0)" ::: "memory");
        } else {
            XB_SPIN(xb_ld(&bar[XB_XGEN(b.x)]) == gen, bar);
            __builtin_amdgcn_fence(__ATOMIC_ACQUIRE, "agent");
            asm volatile("s_waitcnt vmcnt(0)" ::: "memory");
        }
    }
    __syncthreads();
}

struct Args { const float* in[17]; float* out; unsigned char* ws; int ph_lo, ph_hi, li, pad; };
struct Frame { LAS unsigned char* lds; int tid, lane, wave, vcu, G; };
constexpr int NWAVES = 8;

__device__ __forceinline__ void tr_item(const float* W, int N, int k0, int n0, bf16_t* WT, int Kd, int drow0, LAS float* scr, int lane, unsigned char* WT8 = nullptr, bool wr16 = true) {
    float tv[32];
#pragma unroll
    for (int i = 0; i < 32; ++i) { const int kk = 2 * i + (lane >> 5); tv[i] = W[(size_t)(k0 + kk) * N + n0 + (lane & 31)]; }
#pragma unroll
    for (int i = 0; i < 32; ++i) { const int kk = 2 * i + (lane >> 5); scr[kk * 33 + (lane & 31)] = tv[i]; }
    LDS_WAIT(); asm volatile("" ::: "memory");
    const int c = lane & 7;
#pragma unroll
    for (int j = 0; j < 4; ++j) { const int n = (lane >> 3) + 8 * j; const LAS float* s = scr + (8 * c) * 33 + n;
        if (wr16) { u32x4 o; o.x = cvt_pk_bf16(s[0 * 33], s[1 * 33]); o.y = cvt_pk_bf16(s[2 * 33], s[3 * 33]); o.z = cvt_pk_bf16(s[4 * 33], s[5 * 33]); o.w = cvt_pk_bf16(s[6 * 33], s[7 * 33]);
            *(GAS u32x4*)(WT + (size_t)(drow0 + n) * Kd + k0 + 8 * c) = o; }
        if (WT8) { int w0 = 0, w1 = 0; w0 = __builtin_amdgcn_cvt_pk_fp8_f32(s[0 * 33] * W8S, s[1 * 33] * W8S, w0, false); w0 = __builtin_amdgcn_cvt_pk_fp8_f32(s[2 * 33] * W8S, s[3 * 33] * W8S, w0, true);
            w1 = __builtin_amdgcn_cvt_pk_fp8_f32(s[4 * 33] * W8S, s[5 * 33] * W8S, w1, false); w1 = __builtin_amdgcn_cvt_pk_fp8_f32(s[6 * 33] * W8S, s[7 * 33] * W8S, w1, true);
            *(GAS u32x2*)(WT8 + (size_t)(drow0 + n) * Kd + k0 + 8 * c) = (u32x2){(unsigned)w0, (unsigned)w1}; } }
    LDS_WAIT(); asm volatile("" ::: "memory");
}
__device__ __forceinline__ void rms_row_to_bf16(const float* xrow, const float* g, bf16_t* orow, int lane) {
    const GAS f32x4* xr = (const GAS f32x4*)xrow + lane; const GAS f32x4* gr = (const GAS f32x4*)g + lane;
    f32x4 v[8]; float s = 0.f;
#pragma unroll
    for (int j = 0; j < 8; ++j) { v[j] = xr[64 * j]; s += (v[j].x * v[j].x + v[j].y * v[j].y) + (v[j].z * v[j].z + v[j].w * v[j].w); }
    const float rinv = 1.0f / sqrtf(wave_sum(s) * (1.f / DM) + EPS);
    GAS u32x2* o8 = (GAS u32x2*)orow + lane;
#pragma unroll
    for (int j = 0; j < 8; ++j) { const f32x4 gv = gr[64 * j]; u32x2 w; w.x = cvt_pk_bf16(v[j].x * rinv * gv.x, v[j].y * rinv * gv.y); w.y = cvt_pk_bf16(v[j].z * rinv * gv.z, v[j].w * rinv * gv.w); o8[64 * j] = w; }
}

__device__ __forceinline__ void p0_prologue(const Frame& F, const Args& a) {
    unsigned char* ws = a.ws;
    LAS float* scr = (LAS float*)(F.lds + F.wave * 16384);
    const int gw = F.vcu * NWAVES + F.wave, NGW = F.G * NWAVES;
    constexpr int I_IN = (DM / 64) * (INW / 32), I_P = (QW / 64) * (DM / 32), I_O = (DM / 64) * (DM / 32);
    constexpr int NITEMS = I_IN + 2 * I_P + I_O;
    for (int it = gw; it < NITEMS; it += NGW) {
        int r = it;
        if (r < I_IN) { const int nb = INW / 32, kb = r / nb, n0 = (r % nb) * 32; tr_item(a.in[2], INW, kb * 64, n0, (bf16_t*)(ws + WS_WIN), DM, n0, scr, F.lane, ws + WS_WIN8, false); continue; } r -= I_IN;
        if (r < I_P) { const int nb = DM / 32, kb = r / nb, n0 = (r % nb) * 32; tr_item(a.in[6], DM, kb * 64, n0, (bf16_t*)(ws + WS_WPA), QW, n0, scr, F.lane, ws + WS_WPA8, false); continue; } r -= I_P;
        if (r < I_P) { const int nb = DM / 32, kb = r / nb, n0 = (r % nb) * 32; tr_item(a.in[9], DM, kb * 64, n0, (bf16_t*)(ws + WS_WPB), QW, n0, scr, F.lane, ws + WS_WPB8, false); continue; } r -= I_P;
        { const int nb = DM / 32, kb = r / nb, n0 = (r % nb) * 32; tr_item(a.in[10], DM, kb * 64, n0, (bf16_t*)(ws + WS_WO), DM, n0, scr, F.lane, ws + WS_WO8, false); }
    }
    float* cosT = (float*)(ws + WS_ROPE); float* sinT = cosT + 128 * 32;
    for (int i = blockIdx.x * 512 + F.tid; i < 128 * 32; i += F.G * 512) { const int pos = i >> 5, p = i & 31;
        const float inv = 1.0f / powf(10000.0f, (float)(2 * p) / 64.0f); const float ang = (float)pos * inv; cosT[i] = cosf(ang); sinT[i] = sinf(ang); }
    { const float* X = a.in[0]; const float* gm = a.in[1]; bf16_t* H = (bf16_t*)(ws + WS_H); const int lane = F.lane;
      f32x4 nx[8]; int m = gw;
      if (m < NTOK) { const GAS f32x4* xr = (const GAS f32x4*)(X + (size_t)m * DM) + lane;
#pragma unroll
          for (int j = 0; j < 8; ++j) nx[j] = xr[64 * j]; }
      for (; m < NTOK; m += NGW) { f32x4 v[8]; float s = 0.f;
#pragma unroll
          for (int j = 0; j < 8; ++j) { v[j] = nx[j]; s += (v[j].x * v[j].x + v[j].y * v[j].y) + (v[j].z * v[j].z + v[j].w * v[j].w); }
          { const int nm = m + NGW; if (nm < NTOK) { const GAS f32x4* xr = (const GAS f32x4*)(X + (size_t)nm * DM) + lane;
#pragma unroll
              for (int j = 0; j < 8; ++j) nx[j] = xr[64 * j]; } }
          const float rinv = 1.0f / sqrtf(wave_sum(s) * (1.f / DM) + EPS);
          GAS u32x2* o8 = (GAS u32x2*)(H + (size_t)m * DM) + lane;
#pragma unroll
          for (int j = 0; j < 8; ++j) { const f32x4 gv = ((const GAS f32x4*)gm + lane)[64 * j]; const f32x4 hv = v[j] * rinv * gv; (void)o8;
              int w8 = 0; w8 = __builtin_amdgcn_cvt_pk_fp8_f32(hv.x, hv.y, w8, false); w8 = __builtin_amdgcn_cvt_pk_fp8_f32(hv.z, hv.w, w8, true); ((GAS int*)(ws + WS_H8 + (size_t)m * DM) + lane)[64 * j] = w8; } } }
}

constexpr int CW_WCTR = 8192;
__device__ __forceinline__ void p_moe_weights(const Frame& F, const Args& a) {
    unsigned char* ws = a.ws; LAS float* scr = (LAS float*)(F.lds + F.wave * 16384);
    constexpr int I_GU = NEXP * (DM / 64) * (DFF / 32), I_D = NEXP * (DFF / 64) * (DM / 32), NIT = 2 * I_GU + I_D;
    unsigned* ctr = (unsigned*)(ws + WS_CTL) + CW_WCTR;
    for (;;) {
        unsigned it0 = 0; if (F.lane == 0) it0 = __hip_atomic_fetch_add(ctr, 4u, __ATOMIC_RELAXED, __HIP_MEMORY_SCOPE_AGENT);
        it0 = (unsigned)__builtin_amdgcn_readfirstlane((int)it0);
        if (it0 >= (unsigned)NIT) break;
        for (int k4 = 0; k4 < 4; ++k4) { int r = (int)it0 + k4; if (r >= NIT) break;
            if (r < 2 * I_GU) { const int up = r >= I_GU; if (up) r -= I_GU; constexpr int per = (DM / 64) * (DFF / 32); const int e = r / per, q = r % per, nb = DFF / 32, kb = q / nb, n0 = (q % nb) * 32;
                tr_item(a.in[up ? 14 : 13] + (size_t)e * DM * DFF, DFF, kb * 64, n0, (bf16_t*)(ws + WS_WGU), DM, (n0 >> 7) * 256 + (n0 & 127) + (up ? 128 : 0), scr, F.lane, ws + WS_WGU + (size_t)e * 2048 * DM, false); continue; }
            r -= 2 * I_GU;
            { constexpr int per = (DFF / 64) * (DM / 32); const int e = r / per, q = r % per, nb = DM / 32, kb = q / nb, n0 = (q % nb) * 32;
                tr_item(a.in[15] + (size_t)e * DFF * DM, DM, kb * 64, n0, (bf16_t*)(ws + WS_WD) + (size_t)e * 2048 * DFF, DFF, n0, scr, F.lane, ws + WS_WD8 + (size_t)e * 2048 * DFF, false); } }
    }
}

__device__ __forceinline__ void prep_vecs(const Frame& F, bf16_t* T, int ld, int nh_log2, const float* gain, const float* cosT, const float* sinT, float oscale, unsigned char* out8) {
    const int gw = F.vcu * NWAVES + F.wave, NGW = F.G * NWAVES;
    const int sub = F.lane & 15, half = sub >> 3, q = sub & 7;
    const int nvec = NTOK << nh_log2;
    const f32x4 g1 = *(const f32x4*)(gain + half * 64 + 4 * q), g2 = *(const f32x4*)(gain + half * 64 + 32 + 4 * q);
    for (int it = gw; it < nvec / 16; it += NGW) {
        bf16_t* base[4]; u32x2 w1[4], w2[4]; int posx[4];
#pragma unroll
        for (int u = 0; u < 4; ++u) { const int vec = it * 16 + u * 4 + (F.lane >> 4);
            const int tok = vec >> nh_log2, hd = vec & ((1 << nh_log2) - 1), pos = tok & (SEQ - 1); posx[u] = half ? (pos & 63) : (pos >> 6);
            base[u] = T + (size_t)tok * ld + hd * HD + half * 64 + 4 * q; w1[u] = *(const u32x2*)base[u]; w2[u] = *(const u32x2*)(base[u] + 32); }
#pragma unroll
        for (int u = 0; u < 4; ++u) {
            float x1[4] = {bf2f(w1[u].x & 0xffff), bf2f(w1[u].x >> 16), bf2f(w1[u].y & 0xffff), bf2f(w1[u].y >> 16)}, x2[4] = {bf2f(w2[u].x & 0xffff), bf2f(w2[u].x >> 16), bf2f(w2[u].y & 0xffff), bf2f(w2[u].y >> 16)};
            float ss = 0.f;
#pragma unroll
            for (int j = 0; j < 4; ++j) ss += x1[j] * x1[j] + x2[j] * x2[j];
            ss += __shfl_xor(ss, 1); ss += __shfl_xor(ss, 2); ss += __shfl_xor(ss, 4); ss += __shfl_xor(ss, 8);
            const float rinv = 1.0f / sqrtf(ss * (1.0f / 128.0f) + EPS);
            const f32x4 cs = *(const f32x4*)(cosT + posx[u] * 32 + 4 * q), sn = *(const f32x4*)(sinT + posx[u] * 32 + 4 * q);
            float y1[4], y2[4];
#pragma unroll
            for (int j = 0; j < 4; ++j) { const float a1 = x1[j] * rinv * g1[j], a2 = x2[j] * rinv * g2[j]; y1[j] = (a1 * cs[j] - a2 * sn[j]) * oscale; y2[j] = (a2 * cs[j] + a1 * sn[j]) * oscale; }
            if (out8) {
                const int vec = it * 16 + u * 4 + (F.lane >> 4), tok = vec >> nh_log2, hd = vec & ((1 << nh_log2) - 1);
                unsigned char* o8 = out8 + ((size_t)(((tok >> 13) << nh_log2) + hd) * SEQ + (tok & (SEQ - 1))) * HD + half * 64 + 4 * q;
                int w1 = 0, w2 = 0; w1 = __builtin_amdgcn_cvt_pk_fp8_f32(y1[0], y1[1], w1, false); w1 = __builtin_amdgcn_cvt_pk_fp8_f32(y1[2], y1[3], w1, true);
                w2 = __builtin_amdgcn_cvt_pk_fp8_f32(y2[0], y2[1], w2, false); w2 = __builtin_amdgcn_cvt_pk_fp8_f32(y2[2], y2[3], w2, true);
                *(int*)o8 = w1; *(int*)(o8 + 32) = w2;
            } else {
            u32x2 o1, o2; o1.x = cvt_pk_bf16(y1[0], y1[1]); o1.y = cvt_pk_bf16(y1[2], y1[3]); o2.x = cvt_pk_bf16(y2[0], y2[1]); o2.y = cvt_pk_bf16(y2[2], y2[3]);
            *(u32x2*)base[u] = o1; *(u32x2*)(base[u] + 32) = o2; } }
    }
}
__device__ __forceinline__ void p2_qkprep(const Frame& F, const Args& a) {
    const float* cosT = (const float*)(a.ws + WS_ROPE); const float* sinT = cosT + 128 * 32;
    prep_vecs(F, (bf16_t*)(a.ws + WS_KA), KVW, 1, a.in[5], cosT, sinT, 1.0f, a.ws + WS_K8);
    { const bf16_t* VA = (const bf16_t*)(a.ws + WS_VA); unsigned char* V8T = a.ws + WS_V8T; LAS bf16_t* tl = (LAS bf16_t*)F.lds; constexpr int TP = 132;
      for (int T = F.vcu; T < BATCH * 2 * 64; T += F.G) { const int bk = T >> 6, t = T & 63, b = bk >> 1, kvh = bk & 1;
        { const int r = F.tid >> 2, qd = F.tid & 3; const bf16_t* src = VA + ((size_t)b * SEQ + 128 * t + r) * KVW + kvh * HD + qd * 32;
#pragma unroll
          for (int i = 0; i < 4; ++i) { const u32x4 v = *(const u32x4*)(src + 8 * i); LAS unsigned* d = (LAS unsigned*)(tl + r * TP + qd * 32 + 8 * i); d[0] = v.x; d[1] = v.y; d[2] = v.z; d[3] = v.w; } }
        __syncthreads();
        { const int d = F.tid >> 2, g = F.tid & 3; int w[8];
#pragma unroll
          for (int kb = 0; kb < 8; ++kb) { float x[4];
#pragma unroll
            for (int r = 0; r < 4; ++r) x[r] = bf2f(tl[(16 * kb + 4 * g + r) * TP + d]);
            int ww = 0; ww = __builtin_amdgcn_cvt_pk_fp8_f32(x[0], x[1], ww, false); ww = __builtin_amdgcn_cvt_pk_fp8_f32(x[2], x[3], ww, true); w[kb] = ww; }
          unsigned char* dst = V8T + ((size_t)T * HD + d) * 128 + 32 * g;
          *(u32x4*)dst = (u32x4){(unsigned)w[0], (unsigned)w[1], (unsigned)w[2], (unsigned)w[3]}; *(u32x4*)(dst + 16) = (u32x4){(unsigned)w[4], (unsigned)w[5], (unsigned)w[6], (unsigned)w[7]}; }
        __syncthreads(); } }
}

template <int MODE> __device__ __forceinline__ void p3_attention(const Frame& F, const Args& a, char* lds) {
    unsigned char* ws = a.ws;
    const bf16_t* Q = (const bf16_t*)(ws + (MODE == 0 ? WS_QA : WS_QB)); const bf16_t* K = (const bf16_t*)(ws + (MODE == 0 ? WS_KA : WS_KB)); const bf16_t* V = (const bf16_t*)(ws + (MODE == 0 ? WS_VA : WS_VB));
    att::Aux aux; aux.cosT = (const float*)(ws + WS_ROPE); aux.sinT = aux.cosT + 128 * 32; aux.qn = a.in[4]; aux.kn = a.in[5]; aux.relb = a.in[8]; aux.sink = a.in[7];
#define BUILD_TABS(kvh_) do { float* tabs_ = (float*)(lds + att::OFF_TAB); for (int i_ = F.tid; i_ < 4 * 768; i_ += 512) { const int hh_ = i_ / 768, ii_ = i_ - hh_ * 768, rel_ = ii_ - 383, n_ = rel_ < 0 ? -rel_ : rel_; float v_ = -1e30f; \
        if (n_ <= 128) v_ = aux.relb[att::t5_bucket(rel_) * NHB + (kvh_) * 4 + hh_] * LOG2E; tabs_[i_] = v_; } } while (0)
    float pscale = 1.f;
    if (MODE == 0) { float mq = fmaxf(fabsf(aux.qn[F.lane]), fabsf(aux.qn[64 + F.lane])), mk = fmaxf(fabsf(aux.kn[F.lane]), fabsf(aux.kn[64 + F.lane]));
#pragma unroll
        for (int of = 1; of < 64; of <<= 1) { mq = fmaxf(mq, __shfl_xor(mq, of)); mk = fmaxf(mk, __shfl_xor(mk, of)); }
        const float bound = att::C * 128.0f * mq * mk * 1.13f + 0.5f; pscale = __builtin_amdgcn_exp2f(fmaxf(ceilf(bound) - 15.f, 0.f));
        pscale = __uint_as_float(__builtin_amdgcn_readfirstlane(__float_as_uint(pscale))); }
    const bool shared_tabs = (F.G == 256);
    if (MODE == 1 && shared_tabs) { BUILD_TABS((F.vcu >> 5) & 1); __syncthreads(); }
    for (int i = 0;; ++i) {
        const int L = i * F.G + F.vcu; if (L >= 1024) break;
        const int x = (L & 255) >> 5, b = x >> 1, kvh = x & 1;
        const int qb = (MODE == 0) ? (L & 31) : ((L >> 8) * 32 + (L & 31));
        const int head = (MODE == 0) ? kvh * 4 + (L >> 8) : kvh * 4, q0 = qb * ((MODE == 0) ? 256 : 64);
        const bf16_t* Qb = Q + ((size_t)b * SEQ + q0) * QW + head * HD;
        const bf16_t* Kh = K + (size_t)b * SEQ * KVW + kvh * HD; const bf16_t* Vh = V + (size_t)b * SEQ * KVW + kvh * HD;
        int kbeg = 0, kend = SEQ;
        if (MODE == 1) { kbeg = q0 - 128 < 0 ? 0 : q0 - 128; kend = q0 + 192 > SEQ ? SEQ : q0 + 192; }
        if (MODE == 1 && !shared_tabs) { __syncthreads(); BUILD_TABS(kvh); __syncthreads(); }
        unsigned char* Ob8 = ws + (MODE == 0 ? WS_OA8 : WS_OB8) + ((size_t)b * SEQ + q0) * QW + head * HD;
        if constexpr (MODE == 0) att::attn_unit8(Qb, a.ws + WS_K8 + (size_t)(b * 2 + kvh) * SEQ * HD, a.ws + WS_V8T + (size_t)(b * 2 + kvh) * 64 * 16384, Ob8, q0, lds, aux, pscale);
        else att::attn_unit_pp<MODE>(Qb, Kh, Vh, Ob8, kbeg, kend, q0, head, lds, aux);
    }
#undef BUILD_TABS
}

__device__ __forceinline__ void p7_router(const Frame& F, const Args& a) {
    LAS float* wl = (LAS float*)F.lds;
    const float* wr = a.in[12];
    for (int i = F.tid; i < DM * NEXP / 4; i += 512) { const f32x4 v = *(const f32x4*)(wr + 4 * i); const int k = i >> 2, e0 = (i & 3) * 4;
        wl[(e0 + 0) * DM + k] = v.x; wl[(e0 + 1) * DM + k] = v.y; wl[(e0 + 2) * DM + k] = v.z; wl[(e0 + 3) * DM + k] = v.w; }
    __syncthreads();
    const float* X = a.in[0]; const bf16_t* ATT = (const bf16_t*)(a.ws + WS_ATT); bf16_t* H2 = (bf16_t*)(a.ws + WS_H); float* AFF = (float*)(a.ws + WS_AFF); const float* g = a.in[11];
    const int gw = F.vcu * NWAVES + F.wave, NGW = F.G * NWAVES, lane = F.lane;
    f32x4 nx[2][8]; u32x2 na[2][8];
#define RT_LOAD(rp_) do { _Pragma("unroll") for (int rr = 0; rr < 2; ++rr) { const size_t row_ = (size_t)(2 * (rp_) + rr); const GAS f32x4* xr = (const GAS f32x4*)(X + row_ * DM) + lane; const GAS u32x2* ar = (const GAS u32x2*)(ATT + row_ * DM) + lane; \
        _Pragma("unroll") for (int j = 0; j < 8; ++j) { nx[rr][j] = xr[64 * j]; if (DBG_LEVEL >= 3) na[rr][j] = ar[64 * j]; else na[rr][j] = (u32x2){0u, 0u}; } } } while (0)
    int rp = gw;
    if (rp < NTOK / 2) RT_LOAD(rp);
    for (; rp < NTOK / 2; rp += NGW) {
        f32x4 h[2][8]; float rinv[2];
#pragma unroll
        for (int rr = 0; rr < 2; ++rr) { float s = 0.f;
#pragma unroll
            for (int j = 0; j < 8; ++j) { f32x4 v = nx[rr][j]; const u32x2 w = na[rr][j]; v.x += __uint_as_float(w.x << 16); v.y += __uint_as_float(w.x & 0xffff0000u); v.z += __uint_as_float(w.y << 16); v.w += __uint_as_float(w.y & 0xffff0000u);
                h[rr][j] = v; s += (v.x * v.x + v.y * v.y) + (v.z * v.z + v.w * v.w); }
            rinv[rr] = s; }
#if DBG_LEVEL >= 3
#pragma unroll
        for (int rr = 0; rr < 2; ++rr) { GAS u32x2* x8 = (GAS u32x2*)((bf16_t*)(a.ws + WS_ATT) + (size_t)(2 * rp + rr) * DM) + lane;
#pragma unroll
            for (int j = 0; j < 8; ++j) { u32x2 w; w.x = cvt_pk_bf16(h[rr][j].x, h[rr][j].y); w.y = cvt_pk_bf16(h[rr][j].z, h[rr][j].w); x8[64 * j] = w; } }
#endif
        { const int nrp = rp + NGW; if (nrp < NTOK / 2) RT_LOAD(nrp); }
#pragma unroll
        for (int rr = 0; rr < 2; ++rr) { rinv[rr] = 1.0f / sqrtf(wave_sum(rinv[rr]) * (1.f / DM) + EPS);
            GAS int* o8 = (GAS int*)((unsigned char*)H2 + (size_t)(2 * rp + rr) * DM) + lane;
#pragma unroll
            for (int j = 0; j < 8; ++j) { const f32x4 gv = ((const GAS f32x4*)g + lane)[64 * j]; h[rr][j] = h[rr][j] * rinv[rr] * gv;
                int w = 0; w = __builtin_amdgcn_cvt_pk_fp8_f32(h[rr][j].x, h[rr][j].y, w, false); w = __builtin_amdgcn_cvt_pk_fp8_f32(h[rr][j].z, h[rr][j].w, w, true); o8[64 * j] = w; } }
        float v[32];
#pragma unroll
        for (int e = 0; e < NEXP; ++e) { float s0 = 0.f, s1 = 0.f;
#pragma unroll
            for (int j = 0; j < 8; ++j) { const f32x4 w = *(const LAS f32x4*)(wl + e * DM + 4 * lane + 256 * j);
                s0 += (h[0][j].x * w.x + h[0][j].y * w.y) + (h[0][j].z * w.z + h[0][j].w * w.w); s1 += (h[1][j].x * w.x + h[1][j].y * w.y) + (h[1][j].z * w.z + h[1][j].w * w.w); }
            v[e] = s0; v[16 + e] = s1; }
#pragma unroll
        for (int off = 16; off >= 1; off >>= 1) { const bool up = (lane & off) != 0;
#pragma unroll
            for (int i = 0; i < off; ++i) { const float lo = v[i], hi = v[i + off]; const float keep = up ? hi : lo, send = up ? lo : hi; v[i] = keep + __shfl_xor(send, off); } }
        const float mine = v[0] + __shfl_xor(v[0], 32);
        float mx = mine; mx = fmaxf(mx, __shfl_xor(mx, 1)); mx = fmaxf(mx, __shfl_xor(mx, 2)); mx = fmaxf(mx, __shfl_xor(mx, 4)); mx = fmaxf(mx, __shfl_xor(mx, 8));
        const float ex = expf(mine - mx); float sm = ex; sm += __shfl_xor(sm, 1); sm += __shfl_xor(sm, 2); sm += __shfl_xor(sm, 4); sm += __shfl_xor(sm, 8);
        if (lane < 32) { const int row = 2 * rp + (lane >> 4), e = lane & 15, b = row >> 13, s = row & (SEQ - 1); AFF[((size_t)(b * NEXP + e)) * SEQ + s] = ex / sm; }
    }
#undef RT_LOAD
    __syncthreads();
}

__device__ __forceinline__ int block_excl_scan(int v, LAS int* sc, int tid, int& total) {
    const int lane = tid & 63, w = tid >> 6; int x = v;
#pragma unroll
    for (int o = 1; o < 64; o <<= 1) { const int y = __shfl_up(x, o); if (lane >= o) x += y; }
    __syncthreads();
    if (lane == 63) sc[w] = x;
    __syncthreads();
    int pre = 0, tot = 0;
#pragma unroll
    for (int j = 0; j < 8; ++j) { const int s = sc[j]; if (j < w) pre += s; tot += s; }
    total = tot; return pre + x - v;
}
__device__ __forceinline__ void p8_topk(const Frame& F, const Args& a) {
    const float* AFF = (const float*)(a.ws + WS_AFF); int* IDX = (int*)(a.ws + WS_IDX); float* GATEV = (float*)(a.ws + WS_GATEV); int* INV = (int*)(a.ws + WS_INV);
    LAS int* hist = (LAS int*)F.lds; LAS int* sc = hist + 256; LAS int* res = sc + 16;
    const int tid = F.tid, lane = F.lane;
    for (int list = F.vcu; list < NLIST; list += F.G) {
        const int b = list / NEXP, e = list % NEXP;
        unsigned key[16];
        { const u32x4* src = (const u32x4*)(AFF + (size_t)list * SEQ + tid * 16);
#pragma unroll
            for (int j = 0; j < 4; ++j) { const u32x4 v = src[j]; key[4 * j] = v.x; key[4 * j + 1] = v.y; key[4 * j + 2] = v.z; key[4 * j + 3] = v.w; } }
        unsigned prefix = 0u, pmask = 0u; int krem = CAP;
#pragma unroll 1
        for (int pass = 0; pass < 4; ++pass) { const int shift = 24 - 8 * pass;
            __syncthreads();
            if (tid < 256) hist[tid] = 0;
            __syncthreads();
#pragma unroll
            for (int j = 0; j < 16; ++j) if ((key[j] & pmask) == prefix) __hip_atomic_fetch_add(&hist[(key[j] >> shift) & 255u], 1, __ATOMIC_RELAXED, __HIP_MEMORY_SCOPE_WORKGROUP);
            __syncthreads();
            if (tid < 64) {
                int c[4]; int s = 0;
#pragma unroll
                for (int j = 0; j < 4; ++j) { c[j] = hist[4 * lane + j]; s += c[j]; }
                int suf = s;
#pragma unroll
                for (int o = 1; o < 64; o <<= 1) { const int y = __shfl_down(suf, o); if (lane + o < 64) suf += y; }
                const int excl = suf - s;
                if (suf >= krem && excl < krem) { int cum = excl, bin = 4 * lane, kn = krem;
#pragma unroll
                    for (int j = 3; j >= 0; --j) { if (cum < krem && cum + c[j] >= krem) { bin = 4 * lane + j; kn = krem - cum; } cum += c[j]; }
                    res[0] = bin; res[1] = kn; }
            }
            __syncthreads();
            const int bin = res[0]; krem = res[1];
            prefix |= ((unsigned)bin) << shift; pmask |= 255u << shift;
        }
        const unsigned T = prefix;
        int ceq = 0;
#pragma unroll
        for (int j = 0; j < 16; ++j) ceq += (key[j] == T) ? 1 : 0;
        int toteq; const int eqb = block_excl_scan(ceq, sc, tid, toteq);
        int csel = 0, er = eqb; unsigned selmask = 0u;
#pragma unroll
        for (int j = 0; j < 16; ++j) { bool s = key[j] > T; if (key[j] == T) { s = er < krem; ++er; } if (s) { selmask |= 1u << j; ++csel; } }
        int totsel; int pos = block_excl_scan(csel, sc, tid, totsel);
#pragma unroll
        for (int j = 0; j < 16; ++j) { const int tokpos = tid * 16 + j; int slot = -1;
            if (selmask & (1u << j)) { slot = list * CAP + pos; IDX[slot] = tokpos; GATEV[slot] = __uint_as_float(key[j]); ++pos; }
            INV[((size_t)b * SEQ + tokpos) * NEXP + e] = slot; }
        __syncthreads();
    }
}

__device__ __forceinline__ void p11_final(const Frame& F, const Args& a, bool with_moe) {
    const float* X = a.in[0]; float* OUT = a.out; const bf16_t* ATT = (const bf16_t*)(a.ws + WS_ATT); const bf16_t* Y = (const bf16_t*)(a.ws + WS_Y); const int* INV = (const int*)(a.ws + WS_INV); const float* g = a.in[16];
    const int gw = F.vcu * NWAVES + F.wave, NGW = F.G * NWAVES, lane = F.lane;
    f32x4 nx[8]; u32x2 na[8]; int ninv = -1;
#define FN_LOAD(m_) do { const GAS f32x4* xr = (const GAS f32x4*)(X + (size_t)(m_) * DM) + lane; const GAS u32x2* ar = (const GAS u32x2*)(ATT + (size_t)(m_) * DM) + lane; \
        _Pragma("unroll") for (int j = 0; j < 8; ++j) { if (DBG_LEVEL >= 3) na[j] = ar[64 * j]; else nx[j] = xr[64 * j]; } \
        ninv = (with_moe && lane < NEXP) ? INV[(size_t)(m_) * NEXP + lane] : -1; } while (0)
    int m = gw;
    if (m < NTOK) FN_LOAD(m);
    for (; m < NTOK; m += NGW) {
        f32x4 v[8]; const int myinv = ninv;
#pragma unroll
        for (int j = 0; j < 8; ++j) { if (DBG_LEVEL >= 3) { const u32x2 w = na[j]; v[j].x = __uint_as_float(w.x << 16); v[j].y = __uint_as_float(w.x & 0xffff0000u); v[j].z = __uint_as_float(w.y << 16); v[j].w = __uint_as_float(w.y & 0xffff0000u); } else v[j] = nx[j]; }
        unsigned long long mask = __ballot(myinv >= 0);
        u32x2 y0[8]; const bool has0 = mask != 0ull;
        if (has0) { const int e = __builtin_ctzll(mask); mask &= mask - 1; const int slot = __builtin_amdgcn_readlane(myinv, e); const GAS u32x2* yr = (const GAS u32x2*)(Y + (size_t)slot * DM) + lane;
#pragma unroll
            for (int j = 0; j < 8; ++j) y0[j] = yr[64 * j]; }
        { const int nm = m + NGW; if (nm < NTOK) FN_LOAD(nm); }
        if (has0) {
#pragma unroll
            for (int j = 0; j < 8; ++j) { const u32x2 w = y0[j]; v[j].x += __uint_as_float(w.x << 16); v[j].y += __uint_as_float(w.x & 0xffff0000u); v[j].z += __uint_as_float(w.y << 16); v[j].w += __uint_as_float(w.y & 0xffff0000u); } }
        while (mask) { const int e = __builtin_ctzll(mask); mask &= mask - 1; const int slot = __builtin_amdgcn_readlane(myinv, e);
            const GAS u32x2* yr = (const GAS u32x2*)(Y + (size_t)slot * DM) + lane;
#pragma unroll
            for (int j = 0; j < 8; ++j) { const u32x2 w = yr[64 * j]; v[j].x += __uint_as_float(w.x << 16); v[j].y += __uint_as_float(w.x & 0xffff0000u); v[j].z += __uint_as_float(w.y << 16); v[j].w += __uint_as_float(w.y & 0xffff0000u); } }
        float s = 0.f;
#pragma unroll
        for (int j = 0; j < 8; ++j) s += (v[j].x * v[j].x + v[j].y * v[j].y) + (v[j].z * v[j].z + v[j].w * v[j].w);
        const float rinv = 1.0f / sqrtf(wave_sum(s) * (1.f / DM) + EPS);
        GAS f32x4* orow = (GAS f32x4*)(OUT + (size_t)m * DM) + lane;
#pragma unroll
        for (int j = 0; j < 8; ++j) { const f32x4 gv = ((const GAS f32x4*)g + lane)[64 * j]; orow[64 * j] = v[j] * rinv * gv; }
    }
#undef FN_LOAD
}
__device__ __forceinline__ void p_copy_x(const Frame& F, const Args& a) {
    const f32x4* src = (const f32x4*)a.in[0]; f32x4* dst = (f32x4*)a.out;
    for (size_t i = (size_t)blockIdx.x * 512 + F.tid; i < (size_t)NTOK * DM / 4; i += (size_t)F.G * 512) dst[i] = src[i];
}

constexpr int NPHASE = 10;
__global__ void __launch_bounds__(NWAVES * 64, 2) fwd_kernel(Args args) {
    extern __shared__ __attribute__((aligned(16))) unsigned char lds[];
    Frame F;
    F.lds = (LAS unsigned char*)lds;
    F.tid = threadIdx.x; F.lane = F.tid & 63; F.wave = __builtin_amdgcn_readfirstlane(F.tid >> 6);
    F.G = gridDim.x; { const int bx = blockIdx.x; F.vcu = (F.G % 8 == 0) ? (bx % 8) * (F.G / 8) + bx / 8 : bx; }
    unsigned char* ws = args.ws;
    gu32* ctl = (gu32*)(ws + WS_CTL);
    for (int u = F.tid; u < (LDS_BYTES - LDSCTL_OFF) / 4; u += NWAVES * 64) ((LAS unsigned*)(F.lds + LDSCTL_OFF))[u] = 0u;
    __syncthreads();
    XcdBarrier bar; bar.bar = (unsigned*)(ctl + CW_BAR); bar.x = 0; bar.st = nullptr;
    if (MK_N_LAUNCHES == 1) bar = xcd_barrier_post((unsigned*)(ctl + CW_BAR), (volatile LAS unsigned*)(F.lds + LDSCTL_OFF + 64));
    const int lo = args.ph_lo, hi = args.ph_hi;
#define IN(k) (lo <= (k) && (k) < hi)
#define SEAM(k) do { if (IN(k) && IN((k) + 1)) xcd_barrier(bar); } while (0)
#define REFRAME() do { int t_ = threadIdx.x; asm volatile("" : "+v"(t_)); F.tid = t_; F.lane = t_ & 63; F.wave = __builtin_amdgcn_readfirstlane(t_ >> 6); } while (0)

    if (IN(0)) { REFRAME(); for (int rep = 0; rep < REPS(0); ++rep) p0_prologue(F, args); }
    SEAM(0);
    if (IN(1)) { REFRAME();
#if DBG_LEVEL >= 3
        { pg8::MapProb<DM, 0, 1> P; P.A = ws + WS_H8; P.Bt = ws + WS_WIN8; P.S.init(NTOK, INW, F.G, (int)blockIdx.x);
          pg8::EpiInProj E{(bf16_t*)(ws + WS_QA), (bf16_t*)(ws + WS_KA), (bf16_t*)(ws + WS_VA), (bf16_t*)(ws + WS_QB), (bf16_t*)(ws + WS_KB), (bf16_t*)(ws + WS_VB), (bf16_t*)(ws + WS_GA), (bf16_t*)(ws + WS_GB), args.in[3], 1.0f / W8S};
          pg8::gemm_phase8<pg8::EpiInProj, pg8::MapProb<DM, 0, 1>, true>(F.lds, P, E); }
#endif
    }
    SEAM(1);
    if (IN(2)) { REFRAME();
#if DBG_LEVEL >= 4
        p2_qkprep(F, args);
#endif
    }
    SEAM(2);
    if (IN(3)) { REFRAME();
#if DBG_LEVEL >= 4
        for (int rep = 0; rep < REPS(3); ++rep) p3_attention<0>(F, args, (char*)lds);
#endif
#if DBG_LEVEL >= 3
        __syncthreads();
        for (int rep = 0; rep < REPS(13); ++rep) p3_attention<1>(F, args, (char*)lds);
        __syncthreads();
#endif
    }
    SEAM(3);
    if (IN(4)) { REFRAME();
#if DBG_LEVEL >= 4
        { pg8::MapProb<QW, 0, 1> P; P.A = ws + WS_OA8; P.Bt = ws + WS_WPA8; P.S.init(NTOK, DM, F.G, (int)blockIdx.x);
          pg8::EpiGated8<0> E{(bf16_t*)(ws + WS_GA), nullptr, nullptr, 1.0f / (OA8S * W8S)};
          pg8::gemm_phase8<pg8::EpiGated8<0>, pg8::MapProb<QW, 0, 1>, true>(F.lds, P, E); }
        { int gg_ = F.G; asm volatile("" : "+s"(gg_)); unsigned char* ws2_ = ws; asm volatile("" : "+s"(ws2_));
          pg8::MapProb<QW, 0, 1> P; P.A = ws2_ + WS_OB8; P.Bt = ws2_ + WS_WPB8; P.S.init(NTOK, DM, gg_, (int)blockIdx.x);
          pg8::EpiGated8<1> E{(bf16_t*)(ws2_ + WS_GA), (const bf16_t*)(ws2_ + WS_GB), ws2_ + WS_M8, 1.0f / (OB8S * W8S)};
          pg8::gemm_phase8<pg8::EpiGated8<1>, pg8::MapProb<QW, 0, 1>, true>(F.lds, P, E); }
#endif
    }
    SEAM(4);
    if (IN(5)) { REFRAME();
#if DBG_LEVEL >= 3
        pg8::MapProb<DM, 0, 1> P; P.A = ws + WS_M8; P.Bt = ws + WS_WO8; P.S.init(NTOK, DM, F.G, (int)blockIdx.x);
        pg8::EpiAtt E{(bf16_t*)(ws + WS_ATT), 1.0f / (M8S * W8S)};
        for (int rep = 0; rep < REPS(5); ++rep) pg8::gemm_phase8<pg8::EpiAtt, pg8::MapProb<DM, 0, 1>, true>(F.lds, P, E);
#endif
    }
    SEAM(5);
    if (IN(6)) { REFRAME();
#if DBG_LEVEL >= 2
        for (int rep = 0; rep < REPS(6); ++rep) p7_router(F, args);
#endif
    }
    SEAM(6);
    if (IN(7)) { REFRAME();
#if DBG_LEVEL >= 2
        for (int rep = 0; rep < REPS(7); ++rep) p8_topk(F, args);
        __syncthreads();
        p_moe_weights(F, args);
#endif
    }
    SEAM(7);
    if (IN(8)) { REFRAME();
#if DBG_LEVEL >= 2
        LAS unsigned* rowoff = (LAS unsigned*)(F.lds + pg8::STAGE_BYTES);
        const int* IDX = (const int*)(ws + WS_IDX);
        for (int i = 0; i < 8; ++i) { pg8::Unit u; int e, b; if (!pg8::moe_unit(i, F.G, F.vcu, u, e, b)) break;
            if (F.tid < 256) rowoff[i * 256 + F.tid] = (unsigned)IDX[u.pm * 256 + F.tid] * (unsigned)DM; }
        __syncthreads();
        pg8::GuProb8 P; P.H2 = ws + WS_H; P.W = ws + WS_WGU; P.rowoff = rowoff; P.G = F.G; P.vcu = F.vcu;
        pg8::EpiSwiglu E{ws + WS_GA, 1.0f / W8S};
        for (int rep = 0; rep < REPS(8); ++rep) pg8::gemm_phase8<pg8::EpiSwiglu, pg8::GuProb8, true>(F.lds, P, E);
#endif
    }
    SEAM(8);
    if (IN(9)) { REFRAME();
#if DBG_LEVEL >= 2
        pg8::DownProb8 P; P.HID = ws + WS_GA; P.W = ws + WS_WD8; P.G = F.G; P.vcu = F.vcu;
        pg8::EpiDown E{(bf16_t*)(ws + WS_Y), (const float*)(ws + WS_GATEV), 1.0f / W8S};
        for (int rep = 0; rep < REPS(9); ++rep) pg8::gemm_phase8<pg8::EpiDown, pg8::DownProb8, true>(F.lds, P, E);
#endif
    }
    SEAM(9);
    if (IN(10)) { REFRAME(); p11_final(F, args, DBG_LEVEL >= 2); }
#undef IN
#undef SEAM
}

extern "C" void kernel_launch(void* const* d_in, const int* in_sizes, int n_in, void* d_out, int out_size, void* d_ws, size_t ws_size, hipStream_t stream) {
    static int grid = 0;
    if (grid == 0) {
        if (n_in != 17 || in_sizes[0] != NTOK * DM || out_size != NTOK * DM || ws_size < WS_END) { fprintf(stderr, "kernel_launch: unexpected shapes (n_in %d, in0 %d, out %d, ws %zu); nothing launched\n", n_in, n_in > 0 ? in_sizes[0] : -1, out_size, ws_size); grid = -1; return; }
        int dev = 0, cus = 0, per_cu = 0;
        if (hipGetDevice(&dev) != hipSuccess || hipDeviceGetAttribute(&cus, hipDeviceAttributeMultiprocessorCount, dev) != hipSuccess) { grid = -1; return; }
        if (hipFuncSetAttribute((const void*)fwd_kernel, hipFuncAttributeMaxDynamicSharedMemorySize, LDS_BYTES) != hipSuccess) { fprintf(stderr, "kernel_launch: hipFuncSetAttribute failed\n"); grid = -1; return; }
        if (hipOccupancyMaxActiveBlocksPerMultiprocessor(&per_cu, (const void*)fwd_kernel, NWAVES * 64, LDS_BYTES) != hipSuccess || per_cu < 1)
            fprintf(stderr, "kernel_launch: note: occupancy query reports %d workgroups per CU\n", per_cu);
        (void)hipGetLastError();
        grid = cus;
    }
    if (grid < 0) return;
    (void)hipMemsetAsync((char*)d_ws + WS_CTL, 0, CTL_ZERO_BYTES, stream);
    Args a{};
    for (int i = 0; i < 17; ++i) a.in[i] = (const float*)d_in[i];
    a.out = (float*)d_out; a.ws = (unsigned char*)d_ws;
#if MK_N_LAUNCHES == 1
    a.ph_lo = 0; a.ph_hi = NPHASE + 1; a.li = 0;
    hipLaunchKernelGGL(fwd_kernel, dim3(grid), dim3(NWAVES * 64), LDS_BYTES, stream, a);
#else
    for (int li = 0; li <= NPHASE; ++li) { a.ph_lo = li; a.ph_hi = li + 1; a.li = li;
        hipLaunchKernelGGL(fwd_kernel, dim3(grid), dim3(NWAVES * 64), LDS_BYTES, stream, a); }
#endif
    const hipError_t le = hipPeekAtLastError();
    if (le != hipSuccess) fprintf(stderr, "kernel_launch: launch failed: %s\n", hipGetErrorName(le));
}
```

```cpp
#include <hip/hip_runtime.h>
#include <cstdio>
#include <cstdint>

#ifndef MK_N_LAUNCHES
#define MK_N_LAUNCHES 1
#endif
#ifndef DBG_LEVEL
#define DBG_LEVEL 4
#endif

#ifndef REP_PHASE
#define REP_PHASE -1
#endif
#define REPS(k) ((REP_PHASE == (k)) ? 2 : 1)
#define GAS __attribute__((address_space(1)))
#define LAS __attribute__((address_space(3)))
typedef unsigned short bf16_t;
typedef short bf16x8 __attribute__((ext_vector_type(8)));
typedef short s16x4 __attribute__((ext_vector_type(4)));
typedef float f32x2 __attribute__((ext_vector_type(2)));
typedef float f32x4 __attribute__((ext_vector_type(4)));
typedef float f32x8 __attribute__((ext_vector_type(8)));
typedef float f32x16 __attribute__((ext_vector_type(16)));
typedef unsigned u32x2 __attribute__((ext_vector_type(2)));
typedef unsigned u32x4 __attribute__((ext_vector_type(4)));
typedef GAS unsigned gu32;

constexpr int BATCH = 4, SEQ = 8192, DM = 2048, NTOK = BATCH * SEQ, HD = 128;
constexpr int NHA = 8, NHB = 8;
constexpr int QW = 1024, KVW = 256, INW = 7168;
constexpr int NEXP = 16, CAP = 1024, DFF = 1024, NLIST = BATCH * NEXP, NSLOT = NLIST * CAP;
constexpr float EPS = 1e-6f, LOG2E = 1.4426950408889634f;

constexpr size_t MiB = 1u << 20;
constexpr size_t WS_CTL = 0, CTL_ZERO_BYTES = 1 * MiB;
constexpr size_t WS_ROPE = 1 * MiB;
constexpr size_t WS_AFF = 2 * MiB;
constexpr size_t WS_IDX = 4 * MiB;
constexpr size_t WS_GATEV = 4 * MiB + 256 * 1024;
constexpr size_t WS_INV = 5 * MiB;
constexpr size_t WS_WIN = 8 * MiB;
constexpr size_t WS_WPA = 36 * MiB;
constexpr size_t WS_WPB = 40 * MiB;
constexpr size_t WS_WO = 44 * MiB;
constexpr size_t WS_WGU = 52 * MiB;
constexpr size_t WS_WD = 180 * MiB;
constexpr size_t WS_H = 244 * MiB;
constexpr size_t WS_GA = 372 * MiB;
constexpr size_t WS_GB = 500 * MiB;
constexpr size_t WS_QA = 628 * MiB, WS_KA = 692 * MiB, WS_VA = 708 * MiB, WS_QB = 724 * MiB, WS_KB = 788 * MiB, WS_VB = 804 * MiB;
constexpr size_t WS_Y = 500 * MiB;
constexpr size_t WS_OA = 820 * MiB, WS_OB = 884 * MiB;
constexpr size_t WS_ATT = 820 * MiB;
constexpr size_t WS_K8 = 948 * MiB;
constexpr size_t WS_V8T = 956 * MiB;
constexpr size_t WS_H8 = 820 * MiB;
constexpr size_t WS_WIN8 = 964 * MiB;
constexpr size_t WS_WPA8 = 978 * MiB, WS_WPB8 = 980 * MiB;
constexpr size_t WS_WO8 = 982 * MiB;
constexpr size_t WS_WD8 = 986 * MiB;
constexpr size_t WS_END = 1018 * MiB;
constexpr size_t WS_OA8 = 820 * MiB, WS_OB8 = 884 * MiB;
constexpr size_t WS_GA8 = WS_GA, WS_M18 = WS_GA + 64 * MiB, WS_GB8 = WS_GB;
constexpr size_t WS_M8 = 244 * MiB;
constexpr float OB8S = 8.f, M8S = 16.f, GATE8S = 256.f;
constexpr size_t WS_X1B = 116 * MiB;
constexpr float ATT8S = 16.f;
constexpr float W8S = 32.f, OA8S = 64.f;
constexpr int CW_TMO = 0;
constexpr int CW_BAR = 4096;

constexpr int LDS_SCRATCH = 155648;
constexpr int LDSCTL_OFF = LDS_SCRATCH;
constexpr int LDS_BYTES = LDS_SCRATCH + 512;

__device__ __forceinline__ unsigned cvt_pk_bf16(float lo, float hi) { unsigned r; asm volatile("v_cvt_pk_bf16_f32 %0, %1, %2" : "=v"(r) : "v"(lo), "v"(hi)); return r; }
__device__ __forceinline__ float bf2f(unsigned short v) { return __uint_as_float(((unsigned)v) << 16); }
__device__ __forceinline__ unsigned short f2bf(float f) { return (unsigned short)(cvt_pk_bf16(f, 0.f) & 0xffffu); }
__device__ __forceinline__ float wave_sum(float v) {
#pragma unroll
    for (int o = 1; o < 64; o <<= 1) v += __shfl_xor(v, o);
    return v;
}
__device__ __forceinline__ float sigmoidf_fast(float z) { return __builtin_amdgcn_rcpf(1.f + __builtin_amdgcn_exp2f(-z * LOG2E)); }
#define LDS_WAIT() asm volatile("s_waitcnt lgkmcnt(0)" ::: "memory")
#define VM_WAIT() asm volatile("s_waitcnt vmcnt(0)" ::: "memory")

namespace pg8 {
constexpr int BM = 256, BK = 64, HALF = 128, HTB = HALF * BK * 2, STAGE_BYTES = 8 * HTB;
__host__ __device__ __forceinline__ int lds_byte(int r, int c) { const int st = (r >> 4) * 2 + (c >> 5), rr = r & 15, cc = c & 31, ob = rr * 64 + cc * 2; return st * 1024 + (ob ^ (((ob >> 9) & 1) << 5)); }
__host__ __device__ __forceinline__ void stage_rc(int b, int& R, int& C) { const int st = b / 1024, sb = b % 1024, swz = sb ^ (((sb >> 9) & 1) << 5); R = (st >> 1) * 16 + swz / 64; C = (st & 1) * 32 + (swz % 64) / 2; }
__host__ __device__ __forceinline__ int perm32(int rho) { const int n = rho >> 4, i = rho & 15; return 8 * (i >> 2) + 4 * n + (i & 3); }

struct Unit { int pm, pn, ord; };

struct StaticOrder {
    int nM, nN, nwg, G, c;
    __device__ void init(int M, int N, int G_, int c_) { nM = M / BM; nN = N / BM; nwg = nM * nN; G = G_; c = c_; }
    __device__ bool next(int i, Unit& u) const {
        const long L = (long)i * G + c; if (L >= nwg) return false;
        int wgid = (int)L; { const int q = nwg / 8, r = nwg % 8, xcd = wgid % 8, off = wgid / 8; wgid = (xcd < r ? xcd * (q + 1) : r * (q + 1) + (xcd - r) * q) + off; }
        const int nig = 8 * nN, gid = wgid / nig, fm = gid * 8, gsz = (nM - fm) < 8 ? (nM - fm) : 8;
        u.pm = fm + ((wgid % nig) % gsz); u.pn = (wgid % nig) / gsz; u.ord = i; return true;
    }
};

template <class Epi, class Prob, bool ALIGN_EPI>
__device__ __forceinline__ void gemm_phase(LAS unsigned char* lds, const Prob& P, const Epi& E) {
    int tid = threadIdx.x; asm volatile("" : "+v"(tid));
    const int wid = __builtin_amdgcn_readfirstlane(tid >> 6), lane = tid & 63, wr = wid >> 2, wc = wid & 3, fr = lane & 15, fq = lane >> 4;
    constexpr int K = Prob::K, nt = K / BK;
    int Rs[2], Cs[2]; unsigned voffB[2];
#pragma unroll
    for (int i = 0; i < 2; ++i) { int R, C; stage_rc(tid * 16 + i * 8192, R, C); const int Rb = Epi::PERM ? ((R & ~31) + perm32(R & 31)) : R;
        Rs[i] = R; Cs[i] = C; voffB[i] = (unsigned)(Rb * K + C) * 2u; }
    constexpr size_t kstep = (size_t)(BK * 2);
    constexpr size_t hstepB = (size_t)HALF * K * 2;
    const unsigned ldsw = (unsigned)wid * 1024u;
    const int aoff = lds_byte(wr * 64 + fr, fq * 8), boff = lds_byte(wc * 32 + fr, fq * 8);
#define PG8_SA(b, h) (((b) * 2 + (h)) * HTB)
#define PG8_SB(b, h) ((4 + (b) * 2 + (h)) * HTB)
#define PG8_STAGE(bufoff, gbase, voff) do { _Pragma("unroll") for (int _i = 0; _i < 2; ++_i) \
        __builtin_amdgcn_global_load_lds((const unsigned*)((const char*)(gbase) + (voff)[_i]), (LAS unsigned*)(lds + (bufoff) + ldsw + _i * 8192), 16, 0, 0); } while (0)
#define PG8_LDA(dst, b, h) do { _Pragma("unroll") for (int m = 0; m < 4; ++m) _Pragma("unroll") for (int k = 0; k < 2; ++k) dst[m][k] = *(const LAS bf16x8*)(lds + PG8_SA(b, h) + aoff + m * 2048 + k * 1024); } while (0)
#define PG8_LDB(dst, b, h) do { _Pragma("unroll") for (int n = 0; n < 2; ++n) _Pragma("unroll") for (int k = 0; k < 2; ++k) dst[n][k] = *(const LAS bf16x8*)(lds + PG8_SB(b, h) + boff + n * 2048 + k * 1024); } while (0)
#define PG8_MMA(ai, bj, At, Bt) do { __builtin_amdgcn_s_setprio(1); _Pragma("unroll") for (int m = 0; m < 4; ++m) _Pragma("unroll") for (int n = 0; n < 2; ++n) _Pragma("unroll") for (int k = 0; k < 2; ++k) \
        acc[ai][bj][m][n] = __builtin_amdgcn_mfma_f32_16x16x32_bf16(Bt[n][k], At[m][k], acc[ai][bj][m][n], 0, 0, 0); __builtin_amdgcn_s_setprio(0); } while (0)
#define PG8_WAIT_V(n) asm volatile("s_waitcnt vmcnt(" #n ")" ::: "memory")
#define PG8_WAIT_L(n) asm volatile("s_waitcnt lgkmcnt(" #n ")" ::: "memory")
#define PG8_BAR __builtin_amdgcn_s_barrier()
#define PG8_SCHED __builtin_amdgcn_sched_barrier(0)
    Unit cur, nxt; int ui = 0;
    if (!P.next(0, cur)) return;
    unsigned vAc[2][2], vAn[2][2];
    P.a_voff(cur, Rs, Cs, vAc);
    f32x4 acc[2][2][4][2];
#pragma unroll
    for (int a = 0; a < 2; ++a)
#pragma unroll
        for (int b = 0; b < 2; ++b)
#pragma unroll
            for (int m = 0; m < 4; ++m)
#pragma unroll
                for (int n = 0; n < 2; ++n) acc[a][b][m][n] = (f32x4){0.f, 0.f, 0.f, 0.f};
    bf16x8 At[4][2], B0[2][2], B1[2][2];
    const char* cA = P.a_base(cur); const char* cB = P.b_base(cur);
    PG8_STAGE(PG8_SB(0, 0), cB, voffB); PG8_STAGE(PG8_SB(0, 1), cB + hstepB, voffB); PG8_STAGE(PG8_SA(0, 0), cA, vAc[0]); PG8_STAGE(PG8_SA(0, 1), cA, vAc[1]);
    if (wr == 1) PG8_BAR;
    PG8_WAIT_V(2); PG8_BAR;
    PG8_STAGE(PG8_SB(1, 0), cB + kstep, voffB); PG8_STAGE(PG8_SA(1, 0), cA + kstep, vAc[0]); PG8_STAGE(PG8_SB(1, 1), cB + hstepB + kstep, voffB);
    PG8_WAIT_V(6); PG8_BAR;
    for (;;) {
        const bool has_next = P.next(ui + 1, nxt);
        const char* nA = has_next ? P.a_base(nxt) : cA; const char* nB = has_next ? P.b_base(nxt) : cB;
        if constexpr (Prob::GATHER) { if (has_next) P.a_voff(nxt, Rs, Cs, vAn);
          else { vAn[0][0] = vAc[0][0]; vAn[0][1] = vAc[0][1]; vAn[1][0] = vAc[1][0]; vAn[1][1] = vAc[1][1]; } }
        for (int t = 0; t < nt; t += 2) {
            const bool last = (t == nt - 2);
            const char* a1 = cA + (size_t)(t + 1) * kstep;
            const char* a2 = last ? nA : cA + (size_t)(t + 2) * kstep; const char* b2 = last ? nB : cB + (size_t)(t + 2) * kstep;
            const char* a3 = a2 + kstep; const char* b3 = b2 + kstep;
            unsigned va2[2][2];
            if constexpr (Prob::GATHER) { va2[0][0] = last ? vAn[0][0] : vAc[0][0]; va2[0][1] = last ? vAn[0][1] : vAc[0][1]; va2[1][0] = last ? vAn[1][0] : vAc[1][0]; va2[1][1] = last ? vAn[1][1] : vAc[1][1]; }
            else { va2[0][0] = vAc[0][0]; va2[0][1] = vAc[0][1]; va2[1][0] = vAc[1][0]; va2[1][1] = vAc[1][1]; }
            PG8_LDB(B0, 0, 0); PG8_LDB(B1, 0, 1); PG8_SCHED; PG8_LDA(At, 0, 0); PG8_STAGE(PG8_SA(1, 1), a1, vAc[1]);
            PG8_WAIT_V(8); PG8_WAIT_L(0); PG8_BAR; PG8_MMA(0, 0, At, B0); PG8_MMA(0, 1, At, B1); PG8_BAR; PG8_SCHED;
            PG8_LDA(At, 0, 1); PG8_STAGE(PG8_SB(0, 0), b2, voffB); PG8_STAGE(PG8_SB(0, 1), b2 + hstepB, voffB); PG8_STAGE(PG8_SA(0, 0), a2, va2[0]);
            PG8_WAIT_V(8); PG8_WAIT_L(0); PG8_BAR; PG8_MMA(1, 0, At, B0); PG8_MMA(1, 1, At, B1); PG8_BAR; PG8_SCHED;
            PG8_LDB(B0, 1, 0); PG8_LDB(B1, 1, 1); PG8_SCHED; PG8_LDA(At, 1, 0); PG8_STAGE(PG8_SA(0, 1), a2, va2[1]);
            PG8_WAIT_V(8); PG8_WAIT_L(0); PG8_BAR; PG8_MMA(0, 0, At, B0); PG8_MMA(0, 1, At, B1); PG8_BAR; PG8_SCHED;
            PG8_LDA(At, 1, 1); PG8_STAGE(PG8_SB(1, 0), b3, voffB); PG8_STAGE(PG8_SB(1, 1), b3 + hstepB, voffB); PG8_STAGE(PG8_SA(1, 0), a3, va2[0]);
            PG8_WAIT_V(8); PG8_WAIT_L(0); PG8_BAR; PG8_MMA(1, 0, At, B0); PG8_MMA(1, 1, At, B1); PG8_BAR; PG8_SCHED;
        }
        if constexpr (ALIGN_EPI) { if (wr == 0) PG8_BAR; }
        E(acc, cur, wr, wc, fr, fq);
        if (!has_next) break;
#pragma unroll
        for (int a = 0; a < 2; ++a)
#pragma unroll
            for (int b = 0; b < 2; ++b)
#pragma unroll
                for (int m = 0; m < 4; ++m)
#pragma unroll
                    for (int n = 0; n < 2; ++n) acc[a][b][m][n] = (f32x4){0.f, 0.f, 0.f, 0.f};
        cur = nxt; cA = nA; cB = nB; ++ui;
        if constexpr (Prob::GATHER) { vAc[0][0] = vAn[0][0]; vAc[0][1] = vAn[0][1]; vAc[1][0] = vAn[1][0]; vAc[1][1] = vAn[1][1]; }
        if constexpr (ALIGN_EPI) { if (wr == 1) PG8_BAR; }
    }
    PG8_WAIT_V(0);
    if constexpr (!ALIGN_EPI) { if (wr == 0) PG8_BAR; }
    PG8_BAR;
#undef PG8_SA
#undef PG8_SB
#undef PG8_STAGE
#undef PG8_LDA
#undef PG8_LDB
#undef PG8_MMA
#undef PG8_WAIT_V
#undef PG8_WAIT_L
#undef PG8_BAR
#undef PG8_SCHED
}
typedef int v8i_g __attribute__((ext_vector_type(8)));
__device__ __forceinline__ void glds_saddr(const void* sbase, unsigned voff, unsigned lds_dst) { unsigned keep;
    asm volatile("s_mov_b32 %0, m0\n\ts_mov_b32 m0, %3\n\ts_nop 0\n\tglobal_load_lds_dwordx4 %2, %1\n\ts_mov_b32 m0, %0" : "=&s"(keep) : "s"(sbase), "v"(voff), "s"(lds_dst) : "memory"); }
template <class Epi, class Prob, bool ALIGN_EPI>
__device__ __forceinline__ void gemm_phase8(LAS unsigned char* lds, const Prob& P, const Epi& E) {
    int tid = threadIdx.x; asm volatile("" : "+v"(tid));
    const int wid = __builtin_amdgcn_readfirstlane(tid >> 6), lane = tid & 63, wr = wid >> 2, wc = wid & 3, fr = lane & 15, fq = lane >> 4;
    constexpr int K = Prob::K, nt = K / 128;
    int Rs[2], Cs[2]; unsigned voffB[2];
#pragma unroll
    for (int i = 0; i < 2; ++i) { int R, C; stage_rc(tid * 16 + i * 8192, R, C); const int Rb = Epi::PERM ? ((R & ~31) + perm32(R & 31)) : R;
        Rs[i] = R; Cs[i] = C; voffB[i] = (unsigned)(Rb * K + C * 2); }
    constexpr size_t kstep = (size_t)128;
    constexpr size_t hstepB = (size_t)HALF * K, hstepA = (size_t)HALF * K;
    const unsigned ldsw = (unsigned)wid * 1024u; const unsigned lds0 = (unsigned)__builtin_amdgcn_readfirstlane((int)(uintptr_t)lds);
    const int aoff = lds_byte(wr * 64 + fr, fq * 16), boff = lds_byte(wc * 32 + fr, fq * 16);
#define PG8_SA(b, h) (((b) * 2 + (h)) * HTB)
#define PG8_SB(b, h) ((4 + (b) * 2 + (h)) * HTB)
#define PG8_STAGE(bufoff, gbase, voff) do { _Pragma("unroll") for (int _i = 0; _i < 2; ++_i) glds_saddr((const void*)(gbase), (voff)[_i], lds0 + (unsigned)((bufoff) + _i * 8192) + ldsw); } while (0)
#define PG8_STAGE_A1(bufoff, gbase, vo) do { if constexpr (Prob::GATHER) { PG8_STAGE(bufoff, gbase, (vo)[1]); } else { PG8_STAGE(bufoff, (gbase) + hstepA, (vo)[0]); } } while (0)
#define PG8_LDA(dst, b, h) do { _Pragma("unroll") for (int m = 0; m < 4; ++m) dst[m] = *(const LAS v8i_g*)(lds + PG8_SA(b, h) + aoff + m * 2048); } while (0)
#define PG8_LDB(dst, b, h) do { _Pragma("unroll") for (int n = 0; n < 2; ++n) dst[n] = *(const LAS v8i_g*)(lds + PG8_SB(b, h) + boff + n * 2048); } while (0)
#define PG8_MMA(ai, bj, At, Bt) do { __builtin_amdgcn_s_setprio(1); _Pragma("unroll") for (int m = 0; m < 4; ++m) _Pragma("unroll") for (int n = 0; n < 2; ++n) \
        acc[ai][bj][m][n] = __builtin_amdgcn_mfma_scale_f32_16x16x128_f8f6f4(Bt[n], At[m], acc[ai][bj][m][n], 0, 0, 0, 0, 0, 0); __builtin_amdgcn_s_setprio(0); } while (0)
#define PG8_WAIT_V(n) asm volatile("s_waitcnt vmcnt(" #n ")" ::: "memory")
#define PG8_WAIT_L(n) asm volatile("s_waitcnt lgkmcnt(" #n ")" ::: "memory")
#define PG8_BAR __builtin_amdgcn_s_barrier()
#define PG8_SCHED __builtin_amdgcn_sched_barrier(0)
    Unit cur, nxt; int ui = 0;
    if (!P.next(0, cur)) return;
    unsigned vAc[2][2];
    P.a_voff(cur, Rs, Cs, vAc);
    f32x4 acc[2][2][4][2];
#pragma unroll
    for (int a = 0; a < 2; ++a)
#pragma unroll
        for (int b = 0; b < 2; ++b)
#pragma unroll
            for (int m = 0; m < 4; ++m)
#pragma unroll
                for (int n = 0; n < 2; ++n) acc[a][b][m][n] = (f32x4){0.f, 0.f, 0.f, 0.f};
    v8i_g At[4], B0[2], B1[2];
    const char* cA = P.a_base(cur); const char* cB = P.b_base(cur);
    PG8_STAGE(PG8_SB(0, 0), cB, voffB); PG8_STAGE(PG8_SB(0, 1), cB + hstepB, voffB); PG8_STAGE(PG8_SA(0, 0), cA, vAc[0]); PG8_STAGE_A1(PG8_SA(0, 1), cA, vAc);
    if (wr == 1) PG8_BAR;
    PG8_WAIT_V(2); PG8_BAR;
    PG8_STAGE(PG8_SB(1, 0), cB + kstep, voffB); PG8_STAGE(PG8_SA(1, 0), cA + kstep, vAc[0]); PG8_STAGE(PG8_SB(1, 1), cB + hstepB + kstep, voffB);
    PG8_WAIT_V(6); PG8_BAR;
    for (;;) {
        const bool has_next = P.next(ui + 1, nxt);
        const char* nA = has_next ? P.a_base(nxt) : cA; const char* nB = has_next ? P.b_base(nxt) : cB;
        unsigned va2[2][2];
#pragma nounroll
        for (int t = 0; t < nt; t += 2) {
            const bool last = (t == nt - 2);
            const char* a1 = cA + (size_t)(t + 1) * kstep;
            const char* a2 = last ? nA : cA + (size_t)(t + 2) * kstep; const char* b2 = last ? nB : cB + (size_t)(t + 2) * kstep;
            const char* a3 = a2 + kstep; const char* b3 = b2 + kstep;
            va2[0][0] = vAc[0][0]; va2[0][1] = vAc[0][1]; va2[1][0] = vAc[1][0]; va2[1][1] = vAc[1][1];
            if constexpr (Prob::GATHER) { if (last && has_next) { int Rn[2], Cn[2];
                int t2_ = tid; asm volatile("" : "+v"(t2_));
#pragma unroll
                for (int i = 0; i < 2; ++i) stage_rc(t2_ * 16 + i * 8192, Rn[i], Cn[i]);
                P.a_voff(nxt, Rn, Cn, va2); } }
            PG8_LDB(B0, 0, 0); PG8_LDB(B1, 0, 1); PG8_SCHED; PG8_LDA(At, 0, 0); PG8_STAGE_A1(PG8_SA(1, 1), a1, vAc);
            PG8_WAIT_V(8); PG8_WAIT_L(0); PG8_BAR; PG8_MMA(0, 0, At, B0); PG8_MMA(0, 1, At, B1); PG8_BAR; PG8_SCHED;
            PG8_LDA(At, 0, 1); PG8_STAGE(PG8_SB(0, 0), b2, voffB); PG8_STAGE(PG8_SB(0, 1), b2 + hstepB, voffB); PG8_STAGE(PG8_SA(0, 0), a2, va2[0]);
            PG8_WAIT_V(8); PG8_WAIT_L(0); PG8_BAR; PG8_MMA(1, 0, At, B0); PG8_MMA(1, 1, At, B1); PG8_BAR; PG8_SCHED;
            PG8_LDB(B0, 1, 0); PG8_LDB(B1, 1, 1); PG8_SCHED; PG8_LDA(At, 1, 0); PG8_STAGE_A1(PG8_SA(0, 1), a2, va2);
            PG8_WAIT_V(8); PG8_WAIT_L(0); PG8_BAR; PG8_MMA(0, 0, At, B0); PG8_MMA(0, 1, At, B1); PG8_BAR; PG8_SCHED;
            PG8_LDA(At, 1, 1); PG8_STAGE(PG8_SB(1, 0), b3, voffB); PG8_STAGE(PG8_SB(1, 1), b3 + hstepB, voffB); PG8_STAGE(PG8_SA(1, 0), a3, va2[0]);
            PG8_WAIT_V(8); PG8_WAIT_L(0); PG8_BAR; PG8_MMA(1, 0, At, B0); PG8_MMA(1, 1, At, B1); PG8_BAR; PG8_SCHED;
        }
        if constexpr (ALIGN_EPI) { if (wr == 0) PG8_BAR; }
        { int t3_ = tid; asm volatile("" : "+v"(t3_)); const int l3_ = t3_ & 63;
          E(acc, cur, wr, wc, l3_ & 15, l3_ >> 4); }
        if (!has_next) break;
#pragma unroll
        for (int a = 0; a < 2; ++a)
#pragma unroll
            for (int b = 0; b < 2; ++b)
#pragma unroll
                for (int m = 0; m < 4; ++m)
#pragma unroll
                    for (int n = 0; n < 2; ++n) acc[a][b][m][n] = (f32x4){0.f, 0.f, 0.f, 0.f};
        cur = nxt; cA = nA; cB = nB; ++ui;
        if constexpr (Prob::GATHER) { vAc[0][0] = va2[0][0]; vAc[0][1] = va2[0][1]; vAc[1][0] = va2[1][0]; vAc[1][1] = va2[1][1]; }
        if constexpr (ALIGN_EPI) { if (wr == 1) PG8_BAR; }
    }
    PG8_WAIT_V(0);
    if constexpr (!ALIGN_EPI) { if (wr == 0) PG8_BAR; }
    PG8_BAR;
#undef PG8_SA
#undef PG8_SB
#undef PG8_STAGE
#undef PG8_STAGE_A1
#undef PG8_LDA
#undef PG8_LDB
#undef PG8_MMA
#undef PG8_WAIT_V
#undef PG8_WAIT_L
#undef PG8_BAR
#undef PG8_SCHED
}

template <int K_> struct DenseProb {
    static constexpr int K = K_; static constexpr bool GATHER = false;
    const bf16_t* A; const bf16_t* Bt; StaticOrder S;
    __device__ __forceinline__ bool next(int i, Unit& u) const { return S.next(i, u); }
    __device__ __forceinline__ const char* a_base(const Unit& u) const { return (const char*)(A + (size_t)u.pm * BM * K); }
    __device__ __forceinline__ const char* b_base(const Unit& u) const { return (const char*)(Bt + (size_t)u.pn * BM * K); }
    __device__ __forceinline__ void a_voff(const Unit&, const int (&Rs)[2], const int (&Cs)[2], unsigned (&vo)[2][2]) const {
#pragma unroll
        for (int h = 0; h < 2; ++h)
#pragma unroll
            for (int i = 0; i < 2; ++i) vo[h][i] = (unsigned)((h * HALF + Rs[i]) * K + Cs[i]) * 2u;
    }
};
template <int K_, int PMAP, int EB> struct MapProb {
    static constexpr int K = K_; static constexpr bool GATHER = false;
    const unsigned char* A; const unsigned char* Bt; StaticOrder S;
    __device__ __forceinline__ bool next(int i, Unit& u) const { const bool ok = S.next(i, u); if (PMAP == 1) u.pn = u.pn < 6 ? u.pn : u.pn + 6; if (PMAP == 2) u.pn += 6; return ok; }
    __device__ __forceinline__ const char* a_base(const Unit& u) const { return (const char*)(A + (size_t)u.pm * BM * K * EB); }
    __device__ __forceinline__ const char* b_base(const Unit& u) const { return (const char*)(Bt + (size_t)u.pn * BM * K * EB); }
    __device__ __forceinline__ void a_voff(const Unit&, const int (&Rs)[2], const int (&Cs)[2], unsigned (&vo)[2][2]) const {
#pragma unroll
        for (int h = 0; h < 2; ++h)
#pragma unroll
            for (int i = 0; i < 2; ++i) vo[h][i] = (unsigned)((h * HALF + Rs[i]) * K * EB + Cs[i] * 2);
    }
};
__device__ __forceinline__ bool moe_unit(int i, int G, int vcu, Unit& u, int& e, int& b) {
    const int L = i * G + vcu; if (L >= 2048) return false;
    const int x = (L & 255) >> 5, w = L & 31, r = L >> 8;
    e = 2 * x + (r >> 2); b = r & 3; u.pm = (b * NEXP + e) * 4 + (w >> 3); u.pn = w & 7; u.ord = i; return true;
}
struct GuProb {
    static constexpr int K = DM; static constexpr bool GATHER = true;
    const bf16_t* H2; const bf16_t* W; const LAS unsigned* rowoff; int G, vcu;
    __device__ __forceinline__ bool next(int i, Unit& u) const { int e, b; return moe_unit(i, G, vcu, u, e, b); }
    __device__ __forceinline__ const char* a_base(const Unit& u) const { const int b = (u.pm >> 2) / NEXP; return (const char*)(H2 + (size_t)b * SEQ * DM); }
    __device__ __forceinline__ const char* b_base(const Unit& u) const { const int e = (u.pm >> 2) % NEXP; return (const char*)(W + ((size_t)e * 2048 + (size_t)u.pn * BM) * DM); }
    __device__ __forceinline__ void a_voff(const Unit& u, const int (&Rs)[2], const int (&Cs)[2], unsigned (&vo)[2][2]) const {
#pragma unroll
        for (int h = 0; h < 2; ++h)
#pragma unroll
            for (int i = 0; i < 2; ++i) vo[h][i] = rowoff[u.ord * 256 + h * HALF + Rs[i]] + (unsigned)Cs[i] * 2u;
    }
};
struct DownProb {
    static constexpr int K = DFF; static constexpr bool GATHER = false;
    const bf16_t* HID; const bf16_t* W; int G, vcu;
    __device__ __forceinline__ bool next(int i, Unit& u) const { int e, b; return moe_unit(i, G, vcu, u, e, b); }
    __device__ __forceinline__ const char* a_base(const Unit& u) const { return (const char*)(HID + (size_t)u.pm * BM * DFF); }
    __device__ __forceinline__ const char* b_base(const Unit& u) const { const int e = (u.pm >> 2) % NEXP; return (const char*)(W + ((size_t)e * 2048 + (size_t)u.pn * BM) * DFF); }
    __device__ __forceinline__ void a_voff(const Unit&, const int (&Rs)[2], const int (&Cs)[2], unsigned (&vo)[2][2]) const {
#pragma unroll
        for (int h = 0; h < 2; ++h)
#pragma unroll
            for (int i = 0; i < 2; ++i) vo[h][i] = (unsigned)((h * HALF + Rs[i]) * DFF + Cs[i]) * 2u;
    }
};

struct GuProb8 {
    static constexpr int K = DM; static constexpr bool GATHER = true;
    const unsigned char* H2; const unsigned char* W; const LAS unsigned* rowoff; int G, vcu;
    __device__ __forceinline__ bool next(int i, Unit& u) const { int e, b; return moe_unit(i, G, vcu, u, e, b); }
    __device__ __forceinline__ const char* a_base(const Unit& u) const { const int b = (u.pm >> 2) / NEXP; return (const char*)(H2 + (size_t)b * SEQ * DM); }
    __device__ __forceinline__ const char* b_base(const Unit& u) const { const int e = (u.pm >> 2) % NEXP; return (const char*)(W + ((size_t)e * 2048 + (size_t)u.pn * BM) * DM); }
    __device__ __forceinline__ void a_voff(const Unit& u, const int (&Rs)[2], const int (&Cs)[2], unsigned (&vo)[2][2]) const {
#pragma unroll
        for (int h = 0; h < 2; ++h)
#pragma unroll
            for (int i = 0; i < 2; ++i) vo[h][i] = rowoff[u.ord * 256 + h * HALF + Rs[i]] + (unsigned)Cs[i] * 2u;
    }
};
struct DownProb8 {
    static constexpr int K = DFF; static constexpr bool GATHER = false;
    const unsigned char* HID; const unsigned char* W; int G, vcu;
    __device__ __forceinline__ bool next(int i, Unit& u) const { int e, b; return moe_unit(i, G, vcu, u, e, b); }
    __device__ __forceinline__ const char* a_base(const Unit& u) const { return (const char*)(HID + (size_t)u.pm * BM * DFF); }
    __device__ __forceinline__ const char* b_base(const Unit& u) const { const int e = (u.pm >> 2) % NEXP; return (const char*)(W + ((size_t)e * 2048 + (size_t)u.pn * BM) * DFF); }
    __device__ __forceinline__ void a_voff(const Unit&, const int (&Rs)[2], const int (&Cs)[2], unsigned (&vo)[2][2]) const {
#pragma unroll
        for (int h = 0; h < 2; ++h)
#pragma unroll
            for (int i = 0; i < 2; ++i) vo[h][i] = (unsigned)((h * HALF + Rs[i]) * DFF + Cs[i] * 2);
    }
};
typedef const f32x4 (&AccRef)[2][2][4][2];
struct EpiInProj {
    static constexpr bool PERM = true;
    bf16_t *QA, *KA, *VA, *QB, *KB, *VB, *GA, *GB; const float* bgate; float oscale;
    __device__ __forceinline__ void operator()(AccRef acc, const Unit& u, int wr, int wc, int fr, int fq) const {
        const int pn = u.pn; bf16_t* base; int ldc, colt; bool gate = false;
        if (pn < 4) { base = QA; ldc = QW; colt = pn * 256; }
        else if (pn == 4) { base = KA; ldc = KVW; colt = 0; }
        else if (pn == 5) { base = VA; ldc = KVW; colt = 0; }
        else if (pn < 10) { base = QB; ldc = QW; colt = (pn - 6) * 256; }
        else if (pn == 10) { base = KB; ldc = KVW; colt = 0; }
        else if (pn == 11) { base = VB; ldc = KVW; colt = 0; }
        else if (pn < 20) { base = GA; ldc = DM; colt = (pn - 12) * 256; gate = true; }
        else { base = GB; ldc = DM; colt = (pn - 20) * 256; gate = true; }
        const int row0 = u.pm * BM + wr * 64 + fr, col0 = colt + wc * 32 + 8 * fq;
        f32x4 bv[2][2];
#pragma unroll
        for (int bj = 0; bj < 2; ++bj)
#pragma unroll
            for (int n = 0; n < 2; ++n) bv[bj][n] = gate ? *(const f32x4*)(bgate + (pn - 12) * 256 + wc * 32 + 8 * fq + bj * HALF + 4 * n) : (f32x4){0.f, 0.f, 0.f, 0.f};
#pragma unroll
        for (int ai = 0; ai < 2; ++ai)
#pragma unroll
            for (int m = 0; m < 4; ++m) { bf16_t* rowp = base + (size_t)(row0 + ai * HALF + m * 16) * ldc + col0;
#pragma unroll
                for (int bj = 0; bj < 2; ++bj) { f32x4 v0 = acc[ai][bj][m][0] * oscale + bv[bj][0], v1 = acc[ai][bj][m][1] * oscale + bv[bj][1];
                    if (gate) {
#pragma unroll
                        for (int j = 0; j < 4; ++j) { v0[j] = sigmoidf_fast(v0[j]) * GATE8S; v1[j] = sigmoidf_fast(v1[j]) * GATE8S; }
                        int w0 = 0, w1 = 0; w0 = __builtin_amdgcn_cvt_pk_fp8_f32(v0[0], v0[1], w0, false); w0 = __builtin_amdgcn_cvt_pk_fp8_f32(v0[2], v0[3], w0, true);
                        w1 = __builtin_amdgcn_cvt_pk_fp8_f32(v1[0], v1[1], w1, false); w1 = __builtin_amdgcn_cvt_pk_fp8_f32(v1[2], v1[3], w1, true);
                        *(u32x2*)((unsigned char*)base + (size_t)(row0 + ai * HALF + m * 16) * DM + col0 + bj * HALF) = (u32x2){(unsigned)w0, (unsigned)w1};
                    } else {
                    u32x4 w; w.x = cvt_pk_bf16(v0[0], v0[1]); w.y = cvt_pk_bf16(v0[2], v0[3]); w.z = cvt_pk_bf16(v1[0], v1[1]); w.w = cvt_pk_bf16(v1[2], v1[3]);
                    *(u32x4*)(rowp + bj * HALF) = w; } } }
    }
};
template <int MODE> struct EpiGated {
    static constexpr bool PERM = true;
    bf16_t* G1; const bf16_t* G2; float oscale;
    __device__ __forceinline__ void operator()(AccRef acc, const Unit& u, int wr, int wc, int fr, int fq) const {
        const int row0 = u.pm * BM + wr * 64 + fr, col0 = u.pn * BM + wc * 32 + 8 * fq;
#pragma unroll
        for (int ai = 0; ai < 2; ++ai)
#pragma unroll
            for (int m = 0; m < 4; ++m) { const size_t off = (size_t)(row0 + ai * HALF + m * 16) * DM + col0;
#pragma unroll
                for (int bj = 0; bj < 2; ++bj) {
                    const bf16x8 g1 = (MODE == 2) ? (bf16x8){0, 0, 0, 0, 0, 0, 0, 0} : *(const bf16x8*)(G1 + off + bj * HALF);
                    bf16x8 g2 = g1; if (MODE >= 1) g2 = *(const bf16x8*)(G2 + off + bj * HALF);
                    float o[8];
#pragma unroll
                    for (int j = 0; j < 8; ++j) { const float a = acc[ai][bj][m][j >> 2][j & 3] * oscale;
                        if (MODE == 0) o[j] = bf2f((unsigned short)g1[j]) * a;
                        else if (MODE == 1) o[j] = bf2f((unsigned short)g1[j]) + bf2f((unsigned short)g2[j]) * a;
                        else o[j] = bf2f((unsigned short)g2[j]) * a; }
                    u32x4 w; w.x = cvt_pk_bf16(o[0], o[1]); w.y = cvt_pk_bf16(o[2], o[3]); w.z = cvt_pk_bf16(o[4], o[5]); w.w = cvt_pk_bf16(o[6], o[7]);
                    *(u32x4*)(G1 + off + bj * HALF) = w; } }
    }
};
template <int MODE> struct EpiGated8 {
    static constexpr bool PERM = true;
    const unsigned char* G8; const unsigned char* M1; unsigned char* OUT8; float oscale;
    __device__ __forceinline__ void operator()(AccRef acc, const Unit& u, int wr, int wc, int fr, int fq) const {
        const int row0 = u.pm * BM + wr * 64 + fr, col0 = u.pn * BM + wc * 32 + 8 * fq;
        u32x2 g[2][4][2], m1[2][4][2];
#pragma unroll
        for (int ai = 0; ai < 2; ++ai)
#pragma unroll
            for (int m = 0; m < 4; ++m)
#pragma unroll
                for (int bj = 0; bj < 2; ++bj) { const unsigned off = (unsigned)((row0 + ai * HALF + m * 16) * DM + col0) + bj * HALF; g[ai][m][bj] = *(const u32x2*)(G8 + off); if (MODE == 1) m1[ai][m][bj] = *(const u32x2*)(M1 + off); }
        const float gs = oscale * (M8S / GATE8S);
#pragma unroll
        for (int ai = 0; ai < 2; ++ai)
#pragma unroll
            for (int m = 0; m < 4; ++m)
#pragma unroll
                for (int bj = 0; bj < 2; ++bj) { const unsigned off = (unsigned)((row0 + ai * HALF + m * 16) * DM + col0) + bj * HALF; float o[8];
                    { const int gx = (int)g[ai][m][bj].x, gy = (int)g[ai][m][bj].y;
                      const auto g0 = __builtin_amdgcn_cvt_pk_f32_fp8(gx, false), g1 = __builtin_amdgcn_cvt_pk_f32_fp8(gx, true), g2 = __builtin_amdgcn_cvt_pk_f32_fp8(gy, false), g3 = __builtin_amdgcn_cvt_pk_f32_fp8(gy, true);
                      const f32x4 a0 = acc[ai][bj][m][0] * gs, a1 = acc[ai][bj][m][1] * gs;
                      o[0] = g0[0] * a0[0]; o[1] = g0[1] * a0[1]; o[2] = g1[0] * a0[2]; o[3] = g1[1] * a0[3]; o[4] = g2[0] * a1[0]; o[5] = g2[1] * a1[1]; o[6] = g3[0] * a1[2]; o[7] = g3[1] * a1[3];
                      if (MODE == 1) { const int mx = (int)m1[ai][m][bj].x, my = (int)m1[ai][m][bj].y;
                        const auto m0 = __builtin_amdgcn_cvt_pk_f32_fp8(mx, false), m1_ = __builtin_amdgcn_cvt_pk_f32_fp8(mx, true), m2 = __builtin_amdgcn_cvt_pk_f32_fp8(my, false), m3 = __builtin_amdgcn_cvt_pk_f32_fp8(my, true);
                        o[0] += m0[0]; o[1] += m0[1]; o[2] += m1_[0]; o[3] += m1_[1]; o[4] += m2[0]; o[5] += m2[1]; o[6] += m3[0]; o[7] += m3[1]; } }
                    int w0 = 0, w1 = 0; w0 = __builtin_amdgcn_cvt_pk_fp8_f32(o[0], o[1], w0, false); w0 = __builtin_amdgcn_cvt_pk_fp8_f32(o[2], o[3], w0, true);
                    w1 = __builtin_amdgcn_cvt_pk_fp8_f32(o[4], o[5], w1, false); w1 = __builtin_amdgcn_cvt_pk_fp8_f32(o[6], o[7], w1, true);
                    *(u32x2*)(OUT8 + off) = (u32x2){(unsigned)w0, (unsigned)w1}; }
    }
};
struct EpiAtt {
    static constexpr bool PERM = true;
    unsigned char* O; float oscale;
    __device__ __forceinline__ void operator()(AccRef acc, const Unit& u, int wr, int wc, int fr, int fq) const {
        const int row0 = u.pm * BM + wr * 64 + fr, col0 = u.pn * BM + wc * 32 + 8 * fq;
#pragma unroll
        for (int ai = 0; ai < 2; ++ai)
#pragma unroll
            for (int m = 0; m < 4; ++m) { unsigned char* rowp = O + (size_t)(row0 + ai * HALF + m * 16) * DM + col0;
#pragma unroll
                for (int bj = 0; bj < 2; ++bj) { const f32x4 v0 = acc[ai][bj][m][0] * oscale, v1 = acc[ai][bj][m][1] * oscale;
                    int w0 = 0, w1 = 0; w0 = __builtin_amdgcn_cvt_pk_fp8_f32(v0[0], v0[1], w0, false); w0 = __builtin_amdgcn_cvt_pk_fp8_f32(v0[2], v0[3], w0, true);
                    w1 = __builtin_amdgcn_cvt_pk_fp8_f32(v1[0], v1[1], w1, false); w1 = __builtin_amdgcn_cvt_pk_fp8_f32(v1[2], v1[3], w1, true);
                    *(u32x2*)(rowp + bj * HALF) = (u32x2){(unsigned)w0, (unsigned)w1}; } }
    }
};
struct EpiSwiglu {
    static constexpr bool PERM = true;
    unsigned char* HID; float oscale;
    __device__ __forceinline__ void operator()(AccRef acc, const Unit& u, int wr, int wc, int fr, int fq) const {
        const int row0 = u.pm * BM + wr * 64 + fr, col0 = u.pn * HALF + wc * 32 + 8 * fq;
#pragma unroll
        for (int ai = 0; ai < 2; ++ai)
#pragma unroll
            for (int m = 0; m < 4; ++m) { float o[8];
#pragma unroll
                for (int j = 0; j < 8; ++j) { const float a = acc[ai][0][m][j >> 2][j & 3] * oscale, up = acc[ai][1][m][j >> 2][j & 3] * oscale; o[j] = a * sigmoidf_fast(a) * up; }
                int w0 = 0, w1 = 0; w0 = __builtin_amdgcn_cvt_pk_fp8_f32(o[0], o[1], w0, false); w0 = __builtin_amdgcn_cvt_pk_fp8_f32(o[2], o[3], w0, true);
                w1 = __builtin_amdgcn_cvt_pk_fp8_f32(o[4], o[5], w1, false); w1 = __builtin_amdgcn_cvt_pk_fp8_f32(o[6], o[7], w1, true);
                *(u32x2*)(HID + (size_t)(row0 + ai * HALF + m * 16) * DFF + col0) = (u32x2){(unsigned)w0, (unsigned)w1}; }
    }
};
struct EpiDown {
    static constexpr bool PERM = true;
    bf16_t* Y; const float* gatev; float oscale;
    __device__ __forceinline__ void operator()(AccRef acc, const Unit& u, int wr, int wc, int fr, int fq) const {
        const int row0 = u.pm * BM + wr * 64 + fr, col0 = u.pn * BM + wc * 32 + 8 * fq;
#pragma unroll
        for (int ai = 0; ai < 2; ++ai)
#pragma unroll
            for (int m = 0; m < 4; ++m) { const int row = row0 + ai * HALF + m * 16; const float g = gatev[row] * oscale;
#pragma unroll
                for (int bj = 0; bj < 2; ++bj) { const f32x4 v0 = acc[ai][bj][m][0] * g, v1 = acc[ai][bj][m][1] * g;
                    u32x4 w; w.x = cvt_pk_bf16(v0[0], v0[1]); w.y = cvt_pk_bf16(v0[2], v0[3]); w.z = cvt_pk_bf16(v1[0], v1[1]); w.w = cvt_pk_bf16(v1[2], v1[3]);
                    *(u32x4*)(Y + (size_t)row * DM + col0 + bj * HALF) = w; } }
    }
};
}

namespace att {
constexpr int D = 128, NW = 8, QBLK = 32, KVBLK = 64;
constexpr float SCALE = 0.088388347648318440f, C = SCALE * LOG2E;
constexpr float THR = 8.f;
constexpr int LDQ = QW, LDK = KVW;
constexpr int SHM_V = KVBLK * D * 2, SHM_K = KVBLK * D * 2;
constexpr int BUFB = SHM_V + SHM_K, NBUF = 4;
constexpr int OFF_WS = NBUF * BUFB, OFF_TAB = OFF_WS + NW * 64 * 4, LDS_END = OFF_TAB + 4 * 768 * 4, OFF_OST = 0;
static_assert(LDS_END <= LDS_SCRATCH, "attention LDS");
#define KSWZ(row, colB) ((row) * 256 + ((colB) ^ (((row) & 7) << 4)))
#define SBAR() __builtin_amdgcn_sched_barrier(0)
__device__ __forceinline__ int crow(int r, int hi) { return (r & 3) + 8 * (r >> 2) + 4 * hi; }
__device__ __forceinline__ unsigned cvtpk(float lo, float hi) { unsigned r; asm volatile("v_cvt_pk_bf16_f32 %0, %1, %2" : "=v"(r) : "v"(lo), "v"(hi)); return r; }

__device__ __forceinline__ void partialSM(f32x16& p0, f32x16& p1, float& m_reg, float& mn, float& alpha) {
  float pmax = p0[0];
#pragma unroll
  for (int r = 1; r < 16; ++r) pmax = fmaxf(pmax, p0[r]);
#pragma unroll
  for (int r = 0; r < 16; ++r) pmax = fmaxf(pmax, p1[r]);
  { auto rr = __builtin_amdgcn_permlane32_swap(__float_as_uint(pmax), __float_as_uint(pmax), false, false);
    pmax = fmaxf(__uint_as_float(rr[0]), __uint_as_float(rr[1])); }
  if (__builtin_expect(__all(pmax - m_reg <= THR / SCALE), 1)) { mn = m_reg; alpha = 1.f; }
  else { mn = fmaxf(m_reg, pmax); alpha = __builtin_amdgcn_exp2f((m_reg - mn) * C); m_reg = mn; }
  float mnC = -mn * C;
#pragma unroll
  for (int r = 0; r < 16; ++r) p0[r] = fmaf(p0[r], C, mnC);
#pragma unroll
  for (int r = 0; r < 16; ++r) p1[r] = fmaf(p1[r], C, mnC);
#pragma unroll
  for (int r = 0; r < 16; ++r) p0[r] = __builtin_amdgcn_exp2f(p0[r]);
}
__device__ __forceinline__ void partialSM_B(f32x16& p0, f32x16& p1, float& m_reg, float& mn, float& alpha, const float* tb) {
#pragma unroll
  for (int r = 0; r < 16; ++r) { const int o = (r & 3) + 8 * (r >> 2); p0[r] = fmaf(p0[r], C, tb[o]); p1[r] = fmaf(p1[r], C, tb[32 + o]); }
  float pmax = p0[0];
#pragma unroll
  for (int r = 1; r < 16; ++r) pmax = fmaxf(pmax, p0[r]);
#pragma unroll
  for (int r = 0; r < 16; ++r) pmax = fmaxf(pmax, p1[r]);
  { auto rr = __builtin_amdgcn_permlane32_swap(__float_as_uint(pmax), __float_as_uint(pmax), false, false);
    pmax = fmaxf(__uint_as_float(rr[0]), __uint_as_float(rr[1])); }
  if (__builtin_expect(__all(pmax - m_reg <= THR * LOG2E), 1)) { mn = m_reg; alpha = 1.f; }
  else { mn = fmaxf(m_reg, pmax); alpha = __builtin_amdgcn_exp2f(m_reg - mn); m_reg = mn; }
#pragma unroll
  for (int r = 0; r < 16; ++r) p0[r] = p0[r] - mn;
#pragma unroll
  for (int r = 0; r < 16; ++r) p1[r] = p1[r] - mn;
#pragma unroll
  for (int r = 0; r < 16; ++r) p0[r] = __builtin_amdgcn_exp2f(p0[r]);
}
__device__ __forceinline__ void finishSM(f32x16& p0, f32x16& p1, float alpha, float& l_reg, bf16x8& pa0, bf16x8& pa1, bf16x8& pa2, bf16x8& pa3) {
#pragma unroll
  for (int r = 0; r < 16; ++r) p1[r] = __builtin_amdgcn_exp2f(p1[r]);
  float ps = 0;
#pragma unroll
  for (int r = 0; r < 16; ++r) ps += p0[r];
#pragma unroll
  for (int r = 0; r < 16; ++r) ps += p1[r];
  { auto rr = __builtin_amdgcn_permlane32_swap(__float_as_uint(ps), __float_as_uint(ps), false, false);
    ps = __uint_as_float(rr[0]) + __uint_as_float(rr[1]); }
  l_reg = l_reg * alpha + ps;
#define PK4(P, BASE, OUT) do { unsigned a0 = cvtpk(P[BASE + 0], P[BASE + 1]), a1 = cvtpk(P[BASE + 2], P[BASE + 3]);   \
    unsigned b0 = cvtpk(P[BASE + 4], P[BASE + 5]), b1 = cvtpk(P[BASE + 6], P[BASE + 7]);                              \
    auto r0 = __builtin_amdgcn_permlane32_swap(a0, b0, false, false); auto r1 = __builtin_amdgcn_permlane32_swap(a1, b1, false, false); \
    u32x4 w = {r0[0], r1[0], r0[1], r1[1]}; OUT = *reinterpret_cast<bf16x8*>(&w); } while (0)
  PK4(p0, 0, pa0); PK4(p0, 8, pa1); PK4(p1, 0, pa2); PK4(p1, 8, pa3);
#undef PK4
}
__device__ __forceinline__ void qkt(f32x16& p0, f32x16& p1, const bf16_t* Ks, const bf16x8* qr, int r32, int hi, float init = 0.f) {
#pragma unroll
  for (int r = 0; r < 16; ++r) { p0[r] = init; p1[r] = init; }
#pragma unroll
  for (int d0 = 0; d0 < 8; ++d0) { int cb = (d0 * 16 + hi * 8) * 2;
    bf16x8 b0 = *reinterpret_cast<const bf16x8*>((const char*)Ks + KSWZ(r32, cb));
    bf16x8 b1 = *reinterpret_cast<const bf16x8*>((const char*)Ks + KSWZ(32 + r32, cb));
    p0 = __builtin_amdgcn_mfma_f32_32x32x16_bf16(b0, qr[d0], p0, 0, 0, 0);
    p1 = __builtin_amdgcn_mfma_f32_32x32x16_bf16(b1, qr[d0], p1, 0, 0, 0); }
}
__device__ __forceinline__ int v_st(int k, int c) { const int kk = (k & ~0xC) | ((k & 4) << 1) | ((k & 8) >> 1); return ((kk >> 3) * 4 + (c >> 5)) * 512 + ((kk & 7) * 32 + (c & 31)) * 2; }
__device__ __forceinline__ int v_rd_base(int lane) { return ((lane & 3) << 3) | (((lane >> 2) & 3) << 6) | (((lane >> 4) & 1) << 5) | (((lane >> 5) & 1) << 8); }
constexpr int v_rd_off(int d0, int ks, int half) { return d0 * 512 + ks * 4096 + half * 2048; }
template <int OFF> __device__ __forceinline__ s16x4 tr_read(int vb) {
  s16x4 r; asm volatile("ds_read_b64_tr_b16 %0, %1 offset:%2" : "=&v"(r) : "v"(vb), "i"(OFF) : "memory"); return r;
}
template <int D0> __device__ __forceinline__ void pv_one(f32x16& od, int vb, bf16x8 pa0, bf16x8 pa1, bf16x8 pa2, bf16x8 pa3) {
  const s16x4 l0 = tr_read<v_rd_off(D0, 0, 0)>(vb), h0 = tr_read<v_rd_off(D0, 0, 1)>(vb), l1 = tr_read<v_rd_off(D0, 1, 0)>(vb), h1 = tr_read<v_rd_off(D0, 1, 1)>(vb);
  const s16x4 l2 = tr_read<v_rd_off(D0, 2, 0)>(vb), h2 = tr_read<v_rd_off(D0, 2, 1)>(vb), l3 = tr_read<v_rd_off(D0, 3, 0)>(vb), h3 = tr_read<v_rd_off(D0, 3, 1)>(vb);
  asm volatile("s_waitcnt lgkmcnt(0)" ::: "memory"); SBAR();
#define PK(L, H) (bf16x8){L[0], L[1], L[2], L[3], H[0], H[1], H[2], H[3]}
  od = __builtin_amdgcn_mfma_f32_32x32x16_bf16(pa0, PK(l0, h0), od, 0, 0, 0);
  od = __builtin_amdgcn_mfma_f32_32x32x16_bf16(pa1, PK(l1, h1), od, 0, 0, 0);
  od = __builtin_amdgcn_mfma_f32_32x32x16_bf16(pa2, PK(l2, h2), od, 0, 0, 0);
  od = __builtin_amdgcn_mfma_f32_32x32x16_bf16(pa3, PK(l3, h3), od, 0, 0, 0);
#undef PK
}
__device__ __forceinline__ void pv_d0(f32x16* o, int vb, bf16x8 pa0, bf16x8 pa1, bf16x8 pa2, bf16x8 pa3) {
  pv_one<0>(o[0], vb, pa0, pa1, pa2, pa3); pv_one<1>(o[1], vb, pa0, pa1, pa2, pa3); pv_one<2>(o[2], vb, pa0, pa1, pa2, pa3); pv_one<3>(o[3], vb, pa0, pa1, pa2, pa3);
}
template <int MODE>
__device__ __forceinline__ void pv_psm(f32x16* o, int vb, bf16x8 pa0, bf16x8 pa1, bf16x8 pa2, bf16x8 pa3, f32x16& p0, f32x16& p1, float& m_reg, float& mn, float& alpha, const float* tb) {
  pv_one<0>(o[0], vb, pa0, pa1, pa2, pa3);
  if constexpr (MODE == 1) {
#pragma unroll
    for (int r = 0; r < 16; ++r) { const int of = (r & 3) + 8 * (r >> 2); p0[r] = fmaf(p0[r], C, tb[of]); p1[r] = fmaf(p1[r], C, tb[32 + of]); }
  }
  float pmax = p0[0];
#pragma unroll
  for (int r = 1; r < 16; ++r) pmax = fmaxf(pmax, p0[r]);
#pragma unroll
  for (int r = 0; r < 16; ++r) pmax = fmaxf(pmax, p1[r]);
  { auto rr = __builtin_amdgcn_permlane32_swap(__float_as_uint(pmax), __float_as_uint(pmax), false, false);
    pmax = fmaxf(__uint_as_float(rr[0]), __uint_as_float(rr[1])); }
  SBAR();
  pv_one<1>(o[1], vb, pa0, pa1, pa2, pa3);
  float sub;
  if constexpr (MODE == 0) {
    if (__builtin_expect(__all(pmax - m_reg <= THR / SCALE), 1)) { mn = m_reg; alpha = 1.f; }
    else { mn = fmaxf(m_reg, pmax); alpha = __builtin_amdgcn_exp2f((m_reg - mn) * C); m_reg = mn; }
    sub = -mn * C;
#pragma unroll
    for (int r = 0; r < 16; ++r) p0[r] = fmaf(p0[r], C, sub);
  } else {
    if (__builtin_expect(__all(pmax - m_reg <= THR * LOG2E), 1)) { mn = m_reg; alpha = 1.f; }
    else { mn = fmaxf(m_reg, pmax); alpha = __builtin_amdgcn_exp2f(m_reg - mn); m_reg = mn; }
    sub = -mn;
#pragma unroll
    for (int r = 0; r < 16; ++r) p0[r] = p0[r] + sub;
  }
  SBAR();
  pv_one<2>(o[2], vb, pa0, pa1, pa2, pa3);
#pragma unroll
  for (int r = 0; r < 16; ++r) { if constexpr (MODE == 0) p1[r] = fmaf(p1[r], C, sub); else p1[r] = p1[r] + sub; }
#pragma unroll
  for (int r = 0; r < 6; ++r) p0[r] = __builtin_amdgcn_exp2f(p0[r]);
  SBAR();
  pv_one<3>(o[3], vb, pa0, pa1, pa2, pa3);
#pragma unroll
  for (int r = 6; r < 16; ++r) p0[r] = __builtin_amdgcn_exp2f(p0[r]);
}
__device__ __forceinline__ f32x8 bf8_to_f32(bf16x8 v) { f32x8 r;
#pragma unroll
  for (int j = 0; j < 8; ++j) r[j] = bf2f((unsigned short)v[j]);
  return r; }
__device__ __forceinline__ bf16x8 f32_to_bf8(f32x8 x) { u32x4 w = {cvtpk(x[0], x[1]), cvtpk(x[2], x[3]), cvtpk(x[4], x[5]), cvtpk(x[6], x[7])}; return *reinterpret_cast<bf16x8*>(&w); }
__device__ __forceinline__ int t5_bucket(int rel) {
  const int n = rel < 0 ? -rel : rel; int bk;
  if (n < 8) bk = n; else if (n < 12) bk = 8; else if (n < 16) bk = 9; else if (n < 23) bk = 10; else if (n < 32) bk = 11; else if (n < 46) bk = 12; else if (n < 64) bk = 13; else if (n < 91) bk = 14; else bk = 15;
  return bk + (rel > 0 ? 16 : 0);
}
struct Aux { const float* cosT; const float* sinT; const float* qn; const float* kn; const float* relb; const float* sink; };

template <int MODE>
__device__ __forceinline__ void attn_unit(const bf16_t* Qb, const bf16_t* __restrict__ Kh, const bf16_t* __restrict__ Vh, bf16_t* Ob, int kbeg, int kend, int q0, int head, char* lds, const Aux& aux) {
  int tid = threadIdx.x; asm volatile("" : "+v"(tid));
  const int wid = tid >> 6, lane = tid & 63, r32 = lane & 31, hi = lane >> 5;
  char* V_lds = lds; char* K_lds = lds + SHM_V;
  float* ws = (float*)(lds + OFF_WS) + wid * 64; float* li_l = ws; float* al_l = ws + 32;
  float* tab = (float*)(lds + OFF_TAB);
  float m_reg = -1e30f, l_reg = 0; f32x16 o[4] = {}; bf16x8 qr[8];
  const bf16_t* Qw = Qb + (long)(wid * QBLK + r32) * LDQ + hi * 8;
#pragma unroll
  for (int d0 = 0; d0 < 8; ++d0) qr[d0] = *reinterpret_cast<const bf16x8*>(Qw + d0 * 16);
  if constexpr (MODE == 1) {
    for (int i = tid; i < 768; i += 512) { const int rel = i - 383, n = rel < 0 ? -rel : rel; float v = -1e30f; if (n <= 128) v = aux.relb[t5_bucket(rel) * NHB + head] * LOG2E; tab[i] = v; }
    m_reg = aux.sink[head] * LOG2E; l_reg = 1.0f;
  }
  const int tbase = kbeg - q0 - wid * QBLK - r32 + 383 + 4 * hi;
  const int sr = tid >> 4, sc = (tid & 15) * 8, vst0 = v_st(sr, sc), vst1 = v_st(32 + sr, sc);
  const int vb0 = (int)(uintptr_t)V_lds + v_rd_base(lane);
  struct { bf16x8 vs0, vs1, ks0, ks1; } sr_[2];
#define SLOAD(i, k0) do { sr_[i].vs0 = *reinterpret_cast<const bf16x8*>(&Vh[(long)(kbeg + (k0) + sr) * LDK + sc]); sr_[i].vs1 = *reinterpret_cast<const bf16x8*>(&Vh[(long)(kbeg + (k0) + 32 + sr) * LDK + sc]); \
    sr_[i].ks0 = *reinterpret_cast<const bf16x8*>(&Kh[(long)(kbeg + (k0) + sr) * LDK + sc]); sr_[i].ks1 = *reinterpret_cast<const bf16x8*>(&Kh[(long)(kbeg + (k0) + 32 + sr) * LDK + sc]); } while (0)
#define SWRITE(bo, i) do { *(bf16x8*)(V_lds + (bo) + vst0) = sr_[i].vs0;          \
    *(bf16x8*)(V_lds + (bo) + vst1) = sr_[i].vs1; int kc = sc * 2;               \
    *(bf16x8*)(K_lds + (bo) + KSWZ(sr, kc)) = sr_[i].ks0;                       \
    *(bf16x8*)(K_lds + (bo) + KSWZ(32 + sr, kc)) = sr_[i].ks1; } while (0)
#define SWAIT() asm volatile("s_waitcnt vmcnt(4)" ::: "memory")
#define RESC(a) do { if (__any((a) < 1.f)) { if (hi == 0) al_l[r32] = (a); asm volatile("s_waitcnt lgkmcnt(0)" ::: "memory"); \
    _Pragma("unroll") for (int d = 0; d < 4; ++d) _Pragma("unroll") for (int r = 0; r < 16; ++r) o[d][r] *= al_l[crow(r, hi)]; } } while (0)
#define PSM(P0, P1, MN, AL, j) do { if constexpr (MODE == 0) partialSM(P0, P1, m_reg, MN, AL); else partialSM_B(P0, P1, m_reg, MN, AL, tab + tbase + (j) * KVBLK); } while (0)
#define ROT() do { const int t_ = o_prev; o_prev = o_cur; o_cur = o_next; o_next = t_; } while (0)
  f32x16 pA0, pA1, pB0, pB1; float mnA, mnB, alA, alB; bf16x8 pa0, pa1, pa2, pa3; const int NT = (kend - kbeg) / KVBLK;
  constexpr int SE = 0, SO = 1;
  int o_prev = 2 * BUFB, o_cur = 0, o_next = BUFB;
  SLOAD(SE, 0); asm volatile("s_waitcnt vmcnt(0)" ::: "memory"); SWRITE(0, SE);
  SLOAD(SO, KVBLK); SLOAD(SE, 2 * KVBLK);
  __syncthreads();
  qkt(pA0, pA1, (const bf16_t*)(K_lds + o_cur), qr, r32, hi); PSM(pA0, pA1, mnA, alA, 0);
  SWAIT(); SWRITE(o_next, SO); RESC(alA); __syncthreads();
  ROT();
  for (int j = 1; j + 1 < NT; j += 2) {
    SBAR(); qkt(pB0, pB1, (const bf16_t*)(K_lds + o_cur), qr, r32, hi);
    finishSM(pA0, pA1, alA, l_reg, pa0, pa1, pa2, pa3); SBAR();
    SLOAD(SO, (j + 2) * KVBLK); SBAR();
    pv_psm<MODE>(o, vb0 + o_prev, pa0, pa1, pa2, pa3, pB0, pB1, m_reg, mnB, alB, tab + tbase + j * KVBLK);
    SWAIT(); SWRITE(o_next, SE);
    RESC(alB); __syncthreads(); ROT();
    SBAR(); qkt(pA0, pA1, (const bf16_t*)(K_lds + o_cur), qr, r32, hi);
    finishSM(pB0, pB1, alB, l_reg, pa0, pa1, pa2, pa3); SBAR();
    SLOAD(SE, (j + 3 < NT ? j + 3 : NT - 1) * KVBLK); SBAR();
    pv_psm<MODE>(o, vb0 + o_prev, pa0, pa1, pa2, pa3, pA0, pA1, m_reg, mnA, alA, tab + tbase + (j + 1) * KVBLK);
    SWAIT(); SWRITE(o_next, SO);
    RESC(alA); __syncthreads(); ROT();
  }
  SBAR(); qkt(pB0, pB1, (const bf16_t*)(K_lds + o_cur), qr, r32, hi);
  finishSM(pA0, pA1, alA, l_reg, pa0, pa1, pa2, pa3); SBAR();
  pv_psm<MODE>(o, vb0 + o_prev, pa0, pa1, pa2, pa3, pB0, pB1, m_reg, mnB, alB, tab + tbase + (NT - 1) * KVBLK);
  RESC(alB);
  finishSM(pB0, pB1, alB, l_reg, pa0, pa1, pa2, pa3); SBAR();
  pv_d0(o, vb0 + o_cur, pa0, pa1, pa2, pa3);
  if (hi == 0) li_l[r32] = l_reg; asm volatile("s_waitcnt lgkmcnt(0)" ::: "memory");
  float rli[16];
#pragma unroll
  for (int r = 0; r < 16; ++r) rli[r] = __builtin_amdgcn_rcpf(li_l[crow(r, hi)]);
  asm volatile("s_waitcnt vmcnt(0)" ::: "memory");
  __syncthreads();
  char* ost = lds + OFF_OST + wid * 8192;
#pragma unroll
  for (int r = 0; r < 16; ++r) { const int orow = crow(r, hi);
#pragma unroll
    for (int d0 = 0; d0 < 4; ++d0) *(unsigned short*)(ost + orow * 256 + (d0 * 32 + r32) * 2) = f2bf(o[d0][r] * rli[r]); }
  asm volatile("s_waitcnt lgkmcnt(0)" ::: "memory");
  bf16_t* Ow = Ob + (long)(wid * QBLK) * LDQ;
#pragma unroll
  for (int i = 0; i < 8; ++i) { const int ch = i * 64 + lane, row = ch >> 4, c16 = ch & 15;
    const u32x4 v = *(const u32x4*)(ost + row * 256 + c16 * 16); *(u32x4*)(Ow + (long)row * LDQ + c16 * 8) = v; }
  asm volatile("s_waitcnt lgkmcnt(0)" ::: "memory");
  __syncthreads();
#undef ROT
#undef SLOAD
#undef SWRITE
#undef SWAIT
#undef RESC
#undef PSM
}

template <int MODE>
__device__ __forceinline__ void softmax_tile(f32x16& p0, f32x16& p1, float& m_reg, float& l_reg, float& alpha, bf16x8& pa0, bf16x8& pa1, bf16x8& pa2, bf16x8& pa3, const float* tb) {
  if constexpr (MODE == 0) {
    alpha = 1.f;
    if (__builtin_expect(m_reg != 0.f, 0)) {
#pragma unroll
      for (int r = 0; r < 16; ++r) { p0[r] -= m_reg; p1[r] -= m_reg; } }
#pragma unroll
    for (int r = 0; r < 16; ++r) { p0[r] = __builtin_amdgcn_exp2f(p0[r]); p1[r] = __builtin_amdgcn_exp2f(p1[r]); }
  } else {
  if constexpr (MODE == 1) {
#pragma unroll
    for (int r = 0; r < 16; ++r) { const int of = (r & 3) + 8 * (r >> 2); p0[r] = fmaf(p0[r], C, tb[of]); p1[r] = fmaf(p1[r], C, tb[32 + of]); }
  }
  float pmax = p0[0];
#pragma unroll
  for (int r = 1; r < 16; ++r) pmax = fmaxf(pmax, p0[r]);
#pragma unroll
  for (int r = 0; r < 16; ++r) pmax = fmaxf(pmax, p1[r]);
  { auto rr = __builtin_amdgcn_permlane32_swap(__float_as_uint(pmax), __float_as_uint(pmax), false, false);
    pmax = fmaxf(__uint_as_float(rr[0]), __uint_as_float(rr[1])); }
  float mn, sub;
  if constexpr (MODE == 0) {
    if (__builtin_expect(__all(pmax - m_reg <= THR / SCALE), 1)) { mn = m_reg; alpha = 1.f; }
    else { mn = fmaxf(m_reg, pmax); alpha = __builtin_amdgcn_exp2f((m_reg - mn) * C); m_reg = mn; }
    sub = -mn * C;
#pragma unroll
    for (int r = 0; r < 16; ++r) { p0[r] = __builtin_amdgcn_exp2f(fmaf(p0[r], C, sub)); p1[r] = __builtin_amdgcn_exp2f(fmaf(p1[r], C, sub)); }
  } else {
    if (__builtin_expect(__all(pmax - m_reg <= THR * LOG2E), 1)) { mn = m_reg; alpha = 1.f; }
    else { mn = fmaxf(m_reg, pmax); alpha = __builtin_amdgcn_exp2f(m_reg - mn); m_reg = mn; }
    sub = -mn;
#pragma unroll
    for (int r = 0; r < 16; ++r) { p0[r] = __builtin_amdgcn_exp2f(p0[r] + sub); p1[r] = __builtin_amdgcn_exp2f(p1[r] + sub); }
  }
  }
  float ps = 0;
#pragma unroll
  for (int r = 0; r < 16; ++r) ps += p0[r];
#pragma unroll
  for (int r = 0; r < 16; ++r) ps += p1[r];
  { auto rr = __builtin_amdgcn_permlane32_swap(__float_as_uint(ps), __float_as_uint(ps), false, false);
    ps = __uint_as_float(rr[0]) + __uint_as_float(rr[1]); }
  l_reg = l_reg * alpha + ps;
#define PK4(P, BASE, OUT) do { unsigned a0 = cvtpk(P[BASE + 0], P[BASE + 1]), a1 = cvtpk(P[BASE + 2], P[BASE + 3]);   \
    unsigned b0 = cvtpk(P[BASE + 4], P[BASE + 5]), b1 = cvtpk(P[BASE + 6], P[BASE + 7]);                              \
    auto r0 = __builtin_amdgcn_permlane32_swap(a0, b0, false, false); auto r1 = __builtin_amdgcn_permlane32_swap(a1, b1, false, false); \
    u32x4 w = {r0[0], r1[0], r0[1], r1[1]}; OUT = *reinterpret_cast<bf16x8*>(&w); } while (0)
  PK4(p0, 0, pa0); PK4(p0, 8, pa1); PK4(p1, 0, pa2); PK4(p1, 8, pa3);
#undef PK4
}
typedef short v4i16_t __attribute__((ext_vector_type(4)));
__device__ __forceinline__ bf16x8 ld_frag2(int sp, const LAS char* kb, const int (&kx)[4], const LAS char* vb) {
  if (sp >= 16) { const int s = sp - 16, d0 = s >> 1; return *(const LAS bf16x8*)(kb + kx[d0 & 3] + (d0 >> 2) * 128 + (s & 1) * 8192); }
  const int D0 = sp >> 2, ks = sp & 3;
  const s16x4 lo = __builtin_bit_cast(s16x4, __builtin_amdgcn_ds_read_tr16_b64_v4i16((LAS v4i16_t*)(vb + v_rd_off(D0, ks, 0))));
  const s16x4 hi = __builtin_bit_cast(s16x4, __builtin_amdgcn_ds_read_tr16_b64_v4i16((LAS v4i16_t*)(vb + v_rd_off(D0, ks, 1))));
  return (bf16x8){lo[0], lo[1], lo[2], lo[3], hi[0], hi[1], hi[2], hi[3]};
}
template <int SB, int SE, bool PRE>
__device__ __forceinline__ void mrun(bf16x8 (&f)[8], f32x16& p0, f32x16& p1, f32x16* o, const bf16x8* qr, bf16x8 pa0, bf16x8 pa1, bf16x8 pa2, bf16x8 pa3, const LAS char* kb, const int (&kx)[4], const LAS char* vb, float init) {
  if (SE > 16) { p0 = f32x16{}; p1 = f32x16{}; }
  SBAR();
  if (!PRE) {
#pragma unroll
    for (int s = SB; s < SB + 8; ++s) f[s & 7] = ld_frag2(s, kb, kx, vb);
    SBAR(); }
#pragma unroll
  for (int sp = SB; sp < SE; ++sp) {
    if (sp >= 16) { const int s = sp - 16; if (s & 1) p1 = __builtin_amdgcn_mfma_f32_32x32x16_bf16(f[sp & 7], qr[s >> 1], p1, 0, 0, 0); else p0 = __builtin_amdgcn_mfma_f32_32x32x16_bf16(f[sp & 7], qr[s >> 1], p0, 0, 0, 0); }
    else { const int D0 = sp >> 2, ks = sp & 3; const bf16x8 pa = ks == 0 ? pa0 : ks == 1 ? pa1 : ks == 2 ? pa2 : pa3;
      o[D0] = __builtin_amdgcn_mfma_f32_32x32x16_bf16(pa, f[sp & 7], o[D0], 0, 0, 0); }
    if (sp + 8 < SE) f[sp & 7] = ld_frag2(sp + 8, kb, kx, vb);
    SBAR();
  }
}
template <int MODE>
__device__ __forceinline__ void attn_unit_pp(const bf16_t* Qb, const bf16_t* __restrict__ Kh, const bf16_t* __restrict__ Vh, unsigned char* Ob8, int kbeg, int kend, int q0, int head, char* lds, const Aux& aux) {
  int tid = threadIdx.x; asm volatile("" : "+v"(tid));
  const int wid = tid >> 6, lane = tid & 63, r32 = lane & 31, hi = lane >> 5;
  const int widu = __builtin_amdgcn_readfirstlane(wid), half = widu >> 2;
  const int hsub = widu >> 1, rsub = (widu & 1) * QBLK;
  const int rw0 = q0 + rsub;
#define NEED(j) (MODE == 0 || ((kbeg + (j) * KVBLK + KVBLK - 1 >= rw0 - 128) && (kbeg + (j) * KVBLK <= rw0 + QBLK - 1 + 128)))
  char* V_lds = lds; char* K_lds = lds + SHM_V;
  float* ws = (float*)(lds + OFF_WS) + wid * 64; float* li_l = ws; float* al_l = ws + 32;
  float* tab = (float*)(lds + OFF_TAB) + hsub * 768;
  float m_reg = -1e30f, l_reg = 0; f32x16 o[4] = {}; bf16x8 qr[8];
  const bf16_t* Qw = Qb + (long)(rsub + r32) * LDQ + hsub * HD + hi * 8;
#pragma unroll
  for (int d0 = 0; d0 < 8; ++d0) qr[d0] = *reinterpret_cast<const bf16x8*>(Qw + d0 * 16);
  if constexpr (MODE == 1) {
    m_reg = aux.sink[head + hsub] * LOG2E; l_reg = 1.0f;
  }
  const int tbase = kbeg - q0 - rsub - r32 + 383 + 4 * hi;
  float qk_init = 0.f;
  if constexpr (MODE == 0) {
    float mq = fmaxf(fabsf(aux.qn[lane]), fabsf(aux.qn[64 + lane])), mk = fmaxf(fabsf(aux.kn[lane]), fabsf(aux.kn[64 + lane]));
#pragma unroll
    for (int of = 1; of < 64; of <<= 1) { mq = fmaxf(mq, __shfl_xor(mq, of)); mk = fmaxf(mk, __shfl_xor(mk, of)); }
    const float bound = C * 128.0f * mq * mk * 1.01f + 0.5f;
    m_reg = __builtin_amdgcn_readfirstlane(__float_as_int(bound > 64.f ? bound - 64.f : 0.f)) ? (bound - 64.f) : 0.f; (void)qk_init; }
  const int sr = tid >> 4, sc = (tid & 15) * 8, vst0 = v_st(sr, sc), vst1 = v_st(32 + sr, sc);
  const int vb0 = (int)(uintptr_t)V_lds + v_rd_base(lane);
  int kx[4];
#pragma unroll
  for (int d = 0; d < 4; ++d) kx[d] = r32 * 256 + ((d * 32 + hi * 16) ^ ((r32 & 7) << 4));
  const LAS char* k3 = (const LAS char*)K_lds; const LAS char* v3 = (const LAS char*)V_lds + v_rd_base(lane);
  bf16x8 fr_[8];
  bf16x8 s_v0, s_v1, s_k0, s_k1;
#define SLOAD(k0) do { s_v0 = *reinterpret_cast<const bf16x8*>(&Vh[(long)(kbeg + (k0) + sr) * LDK + sc]); s_v1 = *reinterpret_cast<const bf16x8*>(&Vh[(long)(kbeg + (k0) + 32 + sr) * LDK + sc]); \
    s_k0 = *reinterpret_cast<const bf16x8*>(&Kh[(long)(kbeg + (k0) + sr) * LDK + sc]); s_k1 = *reinterpret_cast<const bf16x8*>(&Kh[(long)(kbeg + (k0) + 32 + sr) * LDK + sc]); } while (0)
#define SWRITE(bo) do { *(bf16x8*)(V_lds + (bo) + vst0) = s_v0; *(bf16x8*)(V_lds + (bo) + vst1) = s_v1; const int kc = sc * 2;  \
    *(bf16x8*)(K_lds + (bo) + KSWZ(sr, kc)) = s_k0; *(bf16x8*)(K_lds + (bo) + KSWZ(32 + sr, kc)) = s_k1; } while (0)
#define VMW0() asm volatile("s_waitcnt vmcnt(0)" ::: "memory")
#define BAR() asm volatile("s_waitcnt lgkmcnt(0)\n\ts_barrier" ::: "memory")
#define RESC(a) do { if (__any((a) < 1.f)) { if (hi == 0) al_l[r32] = (a); asm volatile("s_waitcnt lgkmcnt(0)" ::: "memory"); \
    _Pragma("unroll") for (int d = 0; d < 4; ++d) _Pragma("unroll") for (int r = 0; r < 16; ++r) o[d][r] *= al_l[crow(r, hi)]; } } while (0)
#define ROT() do { const int t_ = o_prev; o_prev = o_cur; o_cur = o_next; o_next = t_; } while (0)
#define VSEG(j) do { VMW0(); SWRITE(o_next); { const int nx_ = (j) + 2 + half; SLOAD((nx_ < NT ? nx_ : NT - 1) * KVBLK); } SBAR(); \
    if (NEED(j)) { softmax_tile<MODE>(p0, p1, m_reg, l_reg, alpha, pa0, pa1, pa2, pa3, tab + tbase + (j) * KVBLK); if constexpr (MODE == 1) { RESC(alpha); } } SBAR(); } while (0)
#define PVPRE() do { if constexpr (MODE == 0) { _Pragma("unroll") for (int s_ = 0; s_ < 8; ++s_) fr_[s_] = ld_frag2(s_, k3, kx, v3 + o_cur); SBAR(); } } while (0)
  f32x16 p0, p1; float alpha; bf16x8 pa0, pa1, pa2, pa3; const int NT = (kend - kbeg) / KVBLK;
  int o_prev = 2 * BUFB, o_cur = 0, o_next = BUFB;
  { bf16x8 t_v0, t_v1, t_k0, t_k1;
    t_v0 = *reinterpret_cast<const bf16x8*>(&Vh[(long)(kbeg + sr) * LDK + sc]); t_v1 = *reinterpret_cast<const bf16x8*>(&Vh[(long)(kbeg + 32 + sr) * LDK + sc]);
    t_k0 = *reinterpret_cast<const bf16x8*>(&Kh[(long)(kbeg + sr) * LDK + sc]); t_k1 = *reinterpret_cast<const bf16x8*>(&Kh[(long)(kbeg + 32 + sr) * LDK + sc]);
    SLOAD(KVBLK); VMW0();
    *(bf16x8*)(V_lds + vst0) = t_v0; *(bf16x8*)(V_lds + vst1) = t_v1; { const int kc = sc * 2; *(bf16x8*)(K_lds + KSWZ(sr, kc)) = t_k0; *(bf16x8*)(K_lds + KSWZ(32 + sr, kc)) = t_k1; }
    if (half) { SWRITE(BUFB); SLOAD(2 * KVBLK); } }
  BAR();
#define MSEG_QK(j) do { SBAR(); if (NEED(j)) qkt(p0, p1, (const bf16_t*)(K_lds + o_cur), qr, r32, hi, qk_init); SBAR(); } while (0)
#define MSEG(j) do { SBAR(); if (NEED(j)) qkt(p0, p1, (const bf16_t*)(K_lds + o_cur), qr, r32, hi, qk_init); if (NEED((j) - 1)) pv_d0(o, vb0 + o_prev, pa0, pa1, pa2, pa3); SBAR(); } while (0)
#define MSEG_PV() do { SBAR(); if (NEED(NT - 1)) pv_d0(o, vb0 + o_prev, pa0, pa1, pa2, pa3); SBAR(); } while (0)
  if (half == 0) {
    MSEG_QK(0); VSEG(0);
    BAR(); ROT();
    for (int j = 1; j < NT; ++j) { MSEG(j); VSEG(j); BAR(); ROT(); }
    MSEG_PV();
  } else {
    MSEG_QK(0);
    BAR(); ROT();
    for (int j = 1; j < NT; ++j) { VSEG(j - 1); MSEG(j); BAR(); ROT(); }
    VSEG(NT - 1); MSEG_PV();
  }
#undef MSEG_QK
#undef MSEG
#undef MSEG_PV
  if (hi == 0) li_l[r32] = l_reg; asm volatile("s_waitcnt lgkmcnt(0)" ::: "memory");
  float rli[16];
#pragma unroll
  for (int r = 0; r < 16; ++r) rli[r] = __builtin_amdgcn_rcpf(li_l[crow(r, hi)]);
  VMW0();
  __syncthreads();
  char* ost = lds + OFF_OST + wid * 4096;
#pragma unroll
  for (int r = 0; r < 16; ++r) { const int orow = crow(r, hi);
#pragma unroll
    for (int d0 = 0; d0 < 4; ++d0) { const float xo = o[d0][r] * rli[r] * OB8S; *(unsigned char*)(ost + orow * 128 + d0 * 32 + r32) = (unsigned char)(__builtin_amdgcn_cvt_pk_fp8_f32(xo, xo, 0, false) & 0xff); } }
  asm volatile("s_waitcnt lgkmcnt(0)" ::: "memory");
  unsigned char* Ow = Ob8 + (long)rsub * QW + hsub * HD;
#pragma unroll
  for (int i = 0; i < 4; ++i) { const int ch = i * 64 + lane, row = ch >> 3, c16 = ch & 7;
    const u32x4 v = *(const u32x4*)(ost + row * 128 + c16 * 16); *(u32x4*)(Ow + (long)row * QW + c16 * 16) = v; }
  asm volatile("s_waitcnt lgkmcnt(0)" ::: "memory");
  __syncthreads();
#undef SLOAD
#undef SWRITE
#undef VMW0
#undef BAR
#undef RESC
#undef ROT
#undef VSEG
#undef PVPRE
#undef NEED
}

__device__ __forceinline__ int offK16(int row, int ch) { return row * 256 + 16 * (ch ^ (row & 15)); }
__device__ __forceinline__ int offV16(int row, int ch) { return row * 256 + 16 * (ch ^ ((row & 7) << 1)); }
__device__ __forceinline__ bf16x8 ld_frag16(int sp, const LAS char* kb, const int (&ka)[4], const LAS char* vb, const int (&va)[8]) {
  if (sp >= 16) { const int s = sp - 16, kblk = s >> 2, ks = s & 3; return *(const LAS bf16x8*)(kb + ka[ks] + kblk * 4096); }
  const int db = sp >> 1, s = sp & 1;
  const s16x4 lo = __builtin_bit_cast(s16x4, __builtin_amdgcn_ds_read_tr16_b64_v4i16((LAS v4i16_t*)(vb + va[db] + s * 8192)));
  const s16x4 hi = __builtin_bit_cast(s16x4, __builtin_amdgcn_ds_read_tr16_b64_v4i16((LAS v4i16_t*)(vb + va[db] + s * 8192 + 4096)));
  return (bf16x8){lo[0], lo[1], lo[2], lo[3], hi[0], hi[1], hi[2], hi[3]};
}
template <int SB, int SE, bool PRE>
__device__ __forceinline__ void mrun16(bf16x8 (&f)[8], f32x4 (&S)[4][2], f32x4 (&O)[8][2], const bf16x8 (&qf)[2][4], const bf16x8 (&pf)[2][2], const LAS char* kb, const int (&ka)[4], const LAS char* vb, const int (&va)[8]) {
  if (SE > 16) {
#pragma unroll
    for (int i = 0; i < 4; ++i) { S[i][0] = (f32x4){0.f, 0.f, 0.f, 0.f}; S[i][1] = (f32x4){0.f, 0.f, 0.f, 0.f}; } }
  SBAR();
  if (!PRE) {
#pragma unroll
    for (int s = SB; s < SB + 8; ++s) f[s & 7] = ld_frag16(s, kb, ka, vb, va);
    SBAR(); }
#pragma unroll
  for (int sp = SB; sp < SE; ++sp) {
    if (sp >= 16) { const int s = sp - 16, kblk = s >> 2, ks = s & 3;
      S[kblk][0] = __builtin_amdgcn_mfma_f32_16x16x32_bf16(f[sp & 7], qf[0][ks], S[kblk][0], 0, 0, 0); S[kblk][1] = __builtin_amdgcn_mfma_f32_16x16x32_bf16(f[sp & 7], qf[1][ks], S[kblk][1], 0, 0, 0); }
    else { const int db = sp >> 1, s = sp & 1;
      O[db][0] = __builtin_amdgcn_mfma_f32_16x16x32_bf16(f[sp & 7], pf[0][s], O[db][0], 0, 0, 0); O[db][1] = __builtin_amdgcn_mfma_f32_16x16x32_bf16(f[sp & 7], pf[1][s], O[db][1], 0, 0, 0); }
    if (sp + 8 < SE) f[sp & 7] = ld_frag16(sp + 8, kb, ka, vb, va);
    SBAR();
  }
}
__device__ __forceinline__ void attn_unit16(const bf16_t* Qb, const bf16_t* __restrict__ Kh, const bf16_t* __restrict__ Vh, bf16_t* Ob, int nkeys, int q0, char* lds, const Aux& aux) {
  int tid = threadIdx.x; asm volatile("" : "+v"(tid));
  const int wid = tid >> 6, lane = tid & 63, fr = lane & 15, fq = lane >> 4;
  const int half = __builtin_amdgcn_readfirstlane(wid >> 2);
  char* V_lds = lds; char* K_lds = lds + SHM_V;
  float shift;
  { float mq = fmaxf(fabsf(aux.qn[lane]), fabsf(aux.qn[64 + lane])), mk = fmaxf(fabsf(aux.kn[lane]), fabsf(aux.kn[64 + lane]));
#pragma unroll
    for (int of = 1; of < 64; of <<= 1) { mq = fmaxf(mq, __shfl_xor(mq, of)); mk = fmaxf(mk, __shfl_xor(mk, of)); }
    const float bound = C * 128.0f * mq * mk * 1.01f + 0.5f; shift = bound > 64.f ? bound - 64.f : 0.f; }
  bf16x8 qf[2][4];
#pragma unroll
  for (int qb = 0; qb < 2; ++qb)
#pragma unroll
    for (int ks = 0; ks < 4; ++ks) qf[qb][ks] = *reinterpret_cast<const bf16x8*>(Qb + (long)(wid * QBLK + 16 * qb + fr) * LDQ + 32 * ks + 8 * fq);
#pragma unroll
  for (int qb = 0; qb < 2; ++qb) {
    float ss = 0.f;
#pragma unroll
    for (int ks = 0; ks < 4; ++ks) { const f32x8 x = bf8_to_f32(qf[qb][ks]);
#pragma unroll
      for (int e = 0; e < 8; ++e) ss += x[e] * x[e]; }
    ss += __shfl_xor(ss, 16); ss += __shfl_xor(ss, 32);
    const float rinv = C / sqrtf(ss * (1.0f / 128.0f) + EPS);
    const int t = q0 + wid * QBLK + 16 * qb + fr;
#pragma unroll
    for (int hf = 0; hf < 2; ++hf) { const int posx = hf ? (t & 63) : (t >> 6);
      const f32x8 cs = *reinterpret_cast<const f32x8*>(aux.cosT + posx * 32 + 8 * fq), sn = *reinterpret_cast<const f32x8*>(aux.sinT + posx * 32 + 8 * fq);
      const f32x8 g1 = *reinterpret_cast<const f32x8*>(aux.qn + hf * 64 + 8 * fq), g2 = *reinterpret_cast<const f32x8*>(aux.qn + hf * 64 + 32 + 8 * fq);
      const f32x8 x1 = bf8_to_f32(qf[qb][2 * hf]) * rinv * g1, x2 = bf8_to_f32(qf[qb][2 * hf + 1]) * rinv * g2;
      qf[qb][2 * hf] = f32_to_bf8(x1 * cs - x2 * sn); qf[qb][2 * hf + 1] = f32_to_bf8(x2 * cs + x1 * sn); } }
  f32x4 O[8][2], S[4][2]; bf16x8 pf[2][2]; float lsum[2] = {0.f, 0.f};
#pragma unroll
  for (int i = 0; i < 8; ++i) { O[i][0] = (f32x4){0.f, 0.f, 0.f, 0.f}; O[i][1] = (f32x4){0.f, 0.f, 0.f, 0.f}; }
  int ka[4], va[8];
#pragma unroll
  for (int ks = 0; ks < 4; ++ks) ka[ks] = offK16(fr, 4 * ks + fq);
  { const int q = (lane & 15) >> 2, p = lane & 3;
#pragma unroll
    for (int c = 0; c < 8; ++c) va[c] = offV16(4 * fq + q, 2 * c + (p >> 1)) + 8 * (p & 1); }
  const LAS char* k3 = (const LAS char*)K_lds; const LAS char* v3 = (const LAS char*)V_lds;
  bf16x8 fr_[8];
  const int sr = tid >> 4, scc = tid & 15, kst = offK16(sr, scc), vst = offV16(sr, scc);
  bf16x8 s_v0, s_v1, s_k0, s_k1;
#define SLOAD(k0) do { s_v0 = *reinterpret_cast<const bf16x8*>(&Vh[(long)((k0) + sr) * LDK + scc * 8]); s_v1 = *reinterpret_cast<const bf16x8*>(&Vh[(long)((k0) + 32 + sr) * LDK + scc * 8]); \
    s_k0 = *reinterpret_cast<const bf16x8*>(&Kh[(long)((k0) + sr) * LDK + scc * 8]); s_k1 = *reinterpret_cast<const bf16x8*>(&Kh[(long)((k0) + 32 + sr) * LDK + scc * 8]); } while (0)
#define SWRITE(bo) do { *(bf16x8*)(V_lds + (bo) + vst) = s_v0; *(bf16x8*)(V_lds + (bo) + vst + 8192) = s_v1; *(bf16x8*)(K_lds + (bo) + kst) = s_k0; *(bf16x8*)(K_lds + (bo) + kst + 8192) = s_k1; } while (0)
#define VMW0() asm volatile("s_waitcnt vmcnt(0)" ::: "memory")
#define BAR() asm volatile("s_waitcnt lgkmcnt(0)\n\ts_barrier" ::: "memory")
#define ROT() do { const int t_ = o_prev; o_prev = o_cur; o_cur = o_next; o_next = t_; } while (0)
#define VSEG(j, wbuf_, pbuf_) do { VMW0(); SWRITE(wbuf_); { const int nx_ = (j) + 2 + half; SLOAD((nx_ < NT ? nx_ : NT - 1) * KVBLK); } SBAR(); \
    if (__builtin_expect(shift != 0.f, 0)) { _Pragma("unroll") for (int i_ = 0; i_ < 4; ++i_) { S[i_][0] -= shift; S[i_][1] -= shift; } } \
    _Pragma("unroll") for (int qb_ = 0; qb_ < 2; ++qb_) { \
      _Pragma("unroll") for (int i_ = 0; i_ < 4; ++i_) _Pragma("unroll") for (int r_ = 0; r_ < 4; ++r_) S[i_][qb_][r_] = __builtin_amdgcn_exp2f(S[i_][qb_][r_]); \
      float a_ = 0.f; _Pragma("unroll") for (int i_ = 0; i_ < 4; ++i_) a_ += (S[i_][qb_][0] + S[i_][qb_][1]) + (S[i_][qb_][2] + S[i_][qb_][3]); lsum[qb_] += a_; \
      _Pragma("unroll") for (int s_ = 0; s_ < 2; ++s_) { u32x4 w_ = {cvtpk(S[2 * s_][qb_][0], S[2 * s_][qb_][1]), cvtpk(S[2 * s_][qb_][2], S[2 * s_][qb_][3]), cvtpk(S[2 * s_ + 1][qb_][0], S[2 * s_ + 1][qb_][1]), cvtpk(S[2 * s_ + 1][qb_][2], S[2 * s_ + 1][qb_][3])}; \
        pf[qb_][s_] = *reinterpret_cast<bf16x8*>(&w_); } } \
    SBAR(); _Pragma("unroll") for (int s_ = 0; s_ < 8; ++s_) fr_[s_] = ld_frag16(s_, k3, ka, v3 + (pbuf_), va); SBAR(); } while (0)
  const int NT = nkeys / KVBLK;
  int o_prev = 2 * BUFB, o_cur = 0, o_next = BUFB;
  SLOAD(0); VMW0(); SWRITE(0);
  if (half) { SLOAD(KVBLK); VMW0(); SWRITE(BUFB); SLOAD(2 * KVBLK); } else { SLOAD(KVBLK); }
  BAR();
  if (half == 0) {
    mrun16<16, 32, false>(fr_, S, O, qf, pf, k3 + o_cur, ka, v3 + o_prev, va);
    VSEG(0, o_next, o_cur);
    BAR(); ROT();
    for (int j = 1; j < NT; ++j) {
      mrun16<0, 32, true>(fr_, S, O, qf, pf, k3 + o_cur, ka, v3 + o_prev, va);
      VSEG(j, o_next, o_cur);
      BAR(); ROT();
    }
    mrun16<0, 16, true>(fr_, S, O, qf, pf, k3 + o_cur, ka, v3 + o_prev, va);
  } else {
    mrun16<16, 32, false>(fr_, S, O, qf, pf, k3 + o_cur, ka, v3 + o_prev, va);
    BAR(); ROT();
    for (int j = 1; j < NT; ++j) {
      VSEG(j - 1, o_next, o_prev);
      mrun16<0, 32, true>(fr_, S, O, qf, pf, k3 + o_cur, ka, v3 + o_prev, va);
      BAR(); ROT();
    }
    VSEG(NT - 1, o_next, o_prev);
    mrun16<0, 16, true>(fr_, S, O, qf, pf, k3 + o_cur, ka, v3 + o_prev, va);
  }
  float rl[2];
#pragma unroll
  for (int qb = 0; qb < 2; ++qb) { float l = lsum[qb]; l += __shfl_xor(l, 16); l += __shfl_xor(l, 32); rl[qb] = __builtin_amdgcn_rcpf(l); }
  VMW0();
  __syncthreads();
  char* ost = lds + OFF_OST + wid * 8192;
#pragma unroll
  for (int db = 0; db < 8; ++db)
#pragma unroll
    for (int qb = 0; qb < 2; ++qb) { const f32x4 v = O[db][qb] * rl[qb]; u32x2 w; w.x = cvtpk(v[0], v[1]); w.y = cvtpk(v[2], v[3]);
      *(u32x2*)(ost + (16 * qb + fr) * 256 + (16 * db + 4 * fq) * 2) = w; }
  asm volatile("s_waitcnt lgkmcnt(0)" ::: "memory");
  bf16_t* Ow = Ob + (long)(wid * QBLK) * LDQ;
#pragma unroll
  for (int i = 0; i < 8; ++i) { const int ch = i * 64 + lane, row = ch >> 4, c16 = ch & 15;
    const u32x4 v = *(const u32x4*)(ost + row * 256 + c16 * 16); *(u32x4*)(Ow + (long)row * LDQ + c16 * 8) = v; }
  asm volatile("s_waitcnt lgkmcnt(0)" ::: "memory");
  __syncthreads();
#undef SLOAD
#undef SWRITE
#undef VMW0
#undef BAR
#undef ROT
#undef VSEG
}

typedef int v8i_t __attribute__((ext_vector_type(8)));
typedef short v2s_t __attribute__((ext_vector_type(2)));
__device__ __forceinline__ int off8(int row, int c16) { return row * 128 + 16 * (c16 ^ (((row >> 1) & 1) | (((row >> 2) & 1) << 2))); }
__device__ __forceinline__ v8i_t ld_frag8(const LAS char* img, int a0, int a1, int blk) {
  const u32x4 lo = *(const LAS u32x4*)(img + blk * 2048 + a0), hi = *(const LAS u32x4*)(img + blk * 2048 + a1);
  return (v8i_t){(int)lo.x, (int)lo.y, (int)lo.z, (int)lo.w, (int)hi.x, (int)hi.y, (int)hi.z, (int)hi.w};
}
__device__ __forceinline__ void exp_pack8(f32x4 (&S)[4][2], v8i_t (&pf)[2], int h) {
#pragma unroll
  for (int qb = 0; qb < 2; ++qb) {
#pragma unroll
    for (int i = 0; i < 4; ++i) { f32x4 e;
#pragma unroll
      for (int r = 0; r < 4; ++r) e[r] = __builtin_amdgcn_exp2f(S[i][qb][r]);
      int w = __builtin_amdgcn_cvt_pk_bf8_f32(e[0], e[1], __builtin_bit_cast(int, e[0]), false); w = __builtin_amdgcn_cvt_pk_bf8_f32(e[2], e[3], w, true);
      if (h == 0) { if (i == 0) pf[qb][0] = w; else if (i == 1) pf[qb][1] = w; else if (i == 2) pf[qb][2] = w; else pf[qb][3] = w; }
      else { if (i == 0) pf[qb][4] = w; else if (i == 1) pf[qb][5] = w; else if (i == 2) pf[qb][6] = w; else pf[qb][7] = w; } } }
}
struct FRing { u32x4 l[4], h[4]; };
template <int OFF> __device__ __forceinline__ void ldf8(u32x4& lo, u32x4& hi, unsigned ad0, unsigned ad1) {
  asm volatile("ds_read_b128 %0, %1 offset:%2" : "=&v"(lo) : "v"(ad0), "n"(OFF));
  asm volatile("ds_read_b128 %0, %1 offset:%2" : "=&v"(hi) : "v"(ad1), "n"(OFF));
}
template <int N> __device__ __forceinline__ v8i_t wtf8(u32x4& lo, u32x4& hi) {
  asm volatile("s_waitcnt lgkmcnt(%2)" : "+v"(lo), "+v"(hi) : "n"(N));
  return (v8i_t){(int)lo.x, (int)lo.y, (int)lo.z, (int)lo.w, (int)hi.x, (int)hi.y, (int)hi.z, (int)hi.w};
}
template <int T> __device__ __forceinline__ void ldstep8(FRing& R, unsigned k0, unsigned k1, unsigned v0, unsigned v1) {
  if constexpr (T >= 8) ldf8<(T - 8) * 2048>(R.l[T & 3], R.h[T & 3], k0, k1); else ldf8<T * 2048>(R.l[T & 3], R.h[T & 3], v0, v1);
}
template <int SP, int SE>
__device__ __forceinline__ void mstep8(FRing& R, f32x4 (&S)[4][2], f32x4 (&O)[8][2], const v8i_t (&qf)[2], v8i_t (&pf)[2], f32x4 (&L)[2], float nE, unsigned k0, unsigned k1, unsigned v0, unsigned v1) {
  if constexpr (SP < SE) {
    constexpr int NA = (SE - 1 - SP) < 2 ? (SE - 1 - SP) : 2;
    const v8i_t f = wtf8<2 * NA>(R.l[SP & 3], R.h[SP & 3]);
    if constexpr (SP >= 8) { const f32x4 z = {nE, nE, nE, nE}; S[(SP - 8) & 3][0] = __builtin_amdgcn_mfma_scale_f32_16x16x128_f8f6f4(f, qf[0], z, 0, 0, 0, 0, 0, 0); }
    else O[SP][0] = __builtin_amdgcn_mfma_scale_f32_16x16x128_f8f6f4(f, pf[0], O[SP][0], 0, 1, 0, 0, 0, 0);
    if constexpr (SP + 3 < SE) ldstep8<SP + 3>(R, k0, k1, v0, v1);
    if constexpr (SP >= 8) { const f32x4 z = {nE, nE, nE, nE}; S[(SP - 8) & 3][1] = __builtin_amdgcn_mfma_scale_f32_16x16x128_f8f6f4(f, qf[1], z, 0, 0, 0, 0, 0, 0); }
    else O[SP][1] = __builtin_amdgcn_mfma_scale_f32_16x16x128_f8f6f4(f, pf[1], O[SP][1], 0, 1, 0, 0, 0, 0);
    if constexpr (SP == 0) { const int o1 = 0x38383838; const v8i_t ones = {o1, o1, o1, o1, o1, o1, o1, o1};
      L[0] = __builtin_amdgcn_mfma_scale_f32_16x16x128_f8f6f4(ones, pf[0], L[0], 0, 1, 0, 0, 0, 0); L[1] = __builtin_amdgcn_mfma_scale_f32_16x16x128_f8f6f4(ones, pf[1], L[1], 0, 1, 0, 0, 0, 0); }
    SBAR();
    if constexpr (SP == 11) { exp_pack8(S, pf, 0); SBAR(); }
  }
}
template <bool DO_PV, bool DO_QK, bool PRE>
__device__ __forceinline__ void mrun8(FRing& R, f32x4 (&S)[4][2], f32x4 (&O)[8][2], const v8i_t (&qf)[2], v8i_t (&pf)[2], f32x4 (&L)[2], float nE, const LAS char* kimg, const LAS char* vimg, int a0, int a1) {
  constexpr int SB = DO_PV ? 0 : 8, SE = DO_QK ? 16 : 8;
  const unsigned k0 = (unsigned)(size_t)kimg + (unsigned)a0, k1 = (unsigned)(size_t)kimg + (unsigned)a1, v0 = (unsigned)(size_t)vimg + (unsigned)a0, v1 = (unsigned)(size_t)vimg + (unsigned)a1;
  SBAR();
  if (!PRE) { ldstep8<SB>(R, k0, k1, v0, v1); ldstep8<SB + 1>(R, k0, k1, v0, v1); ldstep8<SB + 2>(R, k0, k1, v0, v1); SBAR(); }
#define MS8(sp_) mstep8<(SB + sp_ < SE ? SB + sp_ : SE), SE>(R, S, O, qf, pf, L, nE, k0, k1, v0, v1)
  MS8(0); MS8(1); MS8(2); MS8(3); MS8(4); MS8(5); MS8(6); MS8(7); MS8(8); MS8(9); MS8(10); MS8(11); MS8(12); MS8(13); MS8(14); MS8(15);
#undef MS8
}
__device__ __forceinline__ float xsum16(float x) { auto r = __builtin_amdgcn_permlane16_swap(__float_as_uint(x), __float_as_uint(x), false, false); return __uint_as_float(r[0]) + __uint_as_float(r[1]); }
__device__ __forceinline__ float xsum32(float x) { auto r = __builtin_amdgcn_permlane32_swap(__float_as_uint(x), __float_as_uint(x), false, false); return __uint_as_float(r[0]) + __uint_as_float(r[1]); }
__device__ __forceinline__ float xchg16(float x, bool odd) { auto r = __builtin_amdgcn_permlane16_swap(__float_as_uint(x), __float_as_uint(x), false, false); return __uint_as_float(odd ? r[0] : r[1]); }
__device__ __forceinline__ void attn_unit8(const bf16_t* Qb, const unsigned char* __restrict__ K8, const unsigned char* __restrict__ V8T, unsigned char* Ob8, int q0, char* lds, const Aux& aux, float nE) {
  int tid = threadIdx.x; asm volatile("" : "+v"(tid));
  const int wid = tid >> 6, lane = tid & 63, fr = lane & 15, g = lane >> 4;
  const int half = __builtin_amdgcn_readfirstlane(wid >> 2);
  v8i_t qf[2];
  { char* qs = lds + 3 * BUFB + wid * 4096;
#pragma unroll
    for (int qb = 0; qb < 2; ++qb) {
      bf16x8 q16[4]; float ss = 0.f;
#pragma unroll
      for (int ks = 0; ks < 4; ++ks) { q16[ks] = *reinterpret_cast<const bf16x8*>(Qb + (long)(wid * QBLK + 16 * qb + fr) * LDQ + 32 * ks + 8 * g); const f32x8 x = bf8_to_f32(q16[ks]);
#pragma unroll
        for (int e = 0; e < 8; ++e) ss += x[e] * x[e]; }
      ss = xsum32(xsum16(ss));
      const float rinv = C / sqrtf(ss * (1.0f / 128.0f) + EPS);
      const int t = q0 + wid * QBLK + 16 * qb + fr;
#pragma unroll
      for (int hf = 0; hf < 2; ++hf) { const int posx = hf ? (t & 63) : (t >> 6);
        const f32x8 cs = *reinterpret_cast<const f32x8*>(aux.cosT + posx * 32 + 8 * g), sn = *reinterpret_cast<const f32x8*>(aux.sinT + posx * 32 + 8 * g);
        const f32x8 g1 = *reinterpret_cast<const f32x8*>(aux.qn + hf * 64 + 8 * g), g2 = *reinterpret_cast<const f32x8*>(aux.qn + hf * 64 + 32 + 8 * g);
        const f32x8 x1 = bf8_to_f32(q16[2 * hf]) * rinv * g1, x2 = bf8_to_f32(q16[2 * hf + 1]) * rinv * g2;
        const f32x8 y1 = x1 * cs - x2 * sn, y2 = x2 * cs + x1 * sn;
        int a0_ = 0, a1_ = 0, b0_ = 0, b1_ = 0;
        a0_ = __builtin_amdgcn_cvt_pk_fp8_f32(y1[0], y1[1], a0_, false); a0_ = __builtin_amdgcn_cvt_pk_fp8_f32(y1[2], y1[3], a0_, true); a1_ = __builtin_amdgcn_cvt_pk_fp8_f32(y1[4], y1[5], a1_, false); a1_ = __builtin_amdgcn_cvt_pk_fp8_f32(y1[6], y1[7], a1_, true);
        b0_ = __builtin_amdgcn_cvt_pk_fp8_f32(y2[0], y2[1], b0_, false); b0_ = __builtin_amdgcn_cvt_pk_fp8_f32(y2[2], y2[3], b0_, true); b1_ = __builtin_amdgcn_cvt_pk_fp8_f32(y2[4], y2[5], b1_, false); b1_ = __builtin_amdgcn_cvt_pk_fp8_f32(y2[6], y2[7], b1_, true);
        *(u32x2*)(qs + (16 * qb + fr) * 128 + 32 * (2 * hf) + 8 * g) = (u32x2){(unsigned)a0_, (unsigned)a1_}; *(u32x2*)(qs + (16 * qb + fr) * 128 + 32 * (2 * hf + 1) + 8 * g) = (u32x2){(unsigned)b0_, (unsigned)b1_}; }
    }
    asm volatile("s_waitcnt lgkmcnt(0)" ::: "memory");
#pragma unroll
    for (int qb = 0; qb < 2; ++qb) { const u32x4 lo = *(const u32x4*)(qs + (16 * qb + fr) * 128 + 32 * g), hi = *(const u32x4*)(qs + (16 * qb + fr) * 128 + 32 * g + 16);
      qf[qb] = (v8i_t){(int)lo.x, (int)lo.y, (int)lo.z, (int)lo.w, (int)hi.x, (int)hi.y, (int)hi.z, (int)hi.w}; }
    asm volatile("s_waitcnt lgkmcnt(0)" ::: "memory"); }
  f32x4 O[8][2], S[4][2]; v8i_t pf[2]; f32x4 L[2] = {{0.f, 0.f, 0.f, 0.f}, {0.f, 0.f, 0.f, 0.f}};
#pragma unroll
  for (int i = 0; i < 8; ++i) { O[i][0] = (f32x4){0.f, 0.f, 0.f, 0.f}; O[i][1] = (f32x4){0.f, 0.f, 0.f, 0.f}; }
  const int a0 = off8(fr, 2 * g), a1 = off8(fr, 2 * g + 1);
  char* V_lds = lds; char* K_lds = lds + SHM_V;
  const LAS char* k3 = (const LAS char*)K_lds; const LAS char* v3 = (const LAS char*)V_lds;
  FRing fr_;
  const int widu = __builtin_amdgcn_readfirstlane(wid);
  unsigned dso[2];
#pragma unroll
  for (int i = 0; i < 2; ++i) { const int c = (wid * 2 + i) * 64 + lane, row = c >> 3, p = c & 7; dso[i] = (unsigned)(row * 128 + ((p ^ (((row >> 1) & 1) | (((row >> 2) & 1) << 2))) << 4)); }
  const unsigned ldsw = (unsigned)widu * 2048u; LAS unsigned char* l3 = (LAS unsigned char*)lds;
#define DMA_TILE(t_) do { const unsigned char* kg_ = K8 + (size_t)(t_) * 16384; const unsigned char* vg_ = V8T + (size_t)(t_) * 16384; const unsigned bo_ = (unsigned)(((t_) & 3) * BUFB); \
    _Pragma("unroll") for (int i_ = 0; i_ < 2; ++i_) { \
      __builtin_amdgcn_global_load_lds((const unsigned*)(vg_ + dso[i_]), (LAS unsigned*)(l3 + bo_ + ldsw + i_ * 1024), 16, 0, 0); \
      __builtin_amdgcn_global_load_lds((const unsigned*)(kg_ + dso[i_]), (LAS unsigned*)(l3 + bo_ + SHM_V + ldsw + i_ * 1024), 16, 0, 0); } } while (0)
#define VMW0() asm volatile("s_waitcnt vmcnt(0)" ::: "memory")
#define BAR() asm volatile("s_waitcnt lgkmcnt(0)\n\ts_barrier" ::: "memory")
#define VSEG(j, pbuf_) do { VMW0(); { const int nx_ = (j) + 2 + half; if (nx_ < NT) DMA_TILE(nx_); } SBAR(); \
    exp_pack8(S, pf, 1); \
    SBAR(); { const unsigned pv0_ = (unsigned)(size_t)(v3 + (pbuf_)) + (unsigned)a0, pv1_ = (unsigned)(size_t)(v3 + (pbuf_)) + (unsigned)a1; ldstep8<0>(fr_, 0u, 0u, pv0_, pv1_); ldstep8<1>(fr_, 0u, 0u, pv0_, pv1_); ldstep8<2>(fr_, 0u, 0u, pv0_, pv1_); } SBAR(); } while (0)
  constexpr int NT = SEQ / 128;
  DMA_TILE(0); DMA_TILE(1); if (half) DMA_TILE(2);
  VMW0(); BAR();
#define BARN() asm volatile("s_barrier" ::: "memory")
  if (half == 0) {
    mrun8<false, true, false>(fr_, S, O, qf, pf, L, nE, k3, v3, a0, a1);
    VSEG(0, 0);
    BARN();
    for (int j = 1; j < NT; ++j) {
      mrun8<true, true, true>(fr_, S, O, qf, pf, L, nE, k3 + (j & 3) * BUFB, v3 + ((j - 1) & 3) * BUFB, a0, a1);
      VSEG(j, (j & 3) * BUFB);
      BARN();
    }
    mrun8<true, false, true>(fr_, S, O, qf, pf, L, nE, k3, v3 + ((NT - 1) & 3) * BUFB, a0, a1);
  } else {
    mrun8<false, true, false>(fr_, S, O, qf, pf, L, nE, k3, v3, a0, a1);
    BARN();
    for (int j = 1; j < NT; ++j) {
      VSEG(j - 1, ((j - 1) & 3) * BUFB);
      mrun8<true, true, true>(fr_, S, O, qf, pf, L, nE, k3 + (j & 3) * BUFB, v3 + ((j - 1) & 3) * BUFB, a0, a1);
      BARN();
    }
    VSEG(NT - 1, ((NT - 1) & 3) * BUFB);
    mrun8<true, false, true>(fr_, S, O, qf, pf, L, nE, k3, v3 + ((NT - 1) & 3) * BUFB, a0, a1);
  }
#undef BARN
  float rl[2];
#pragma unroll
  for (int qb = 0; qb < 2; ++qb) rl[qb] = __builtin_amdgcn_rcpf(L[qb][0]);
  VMW0();
  __syncthreads();
  char* ost = lds + OFF_OST + wid * 4096;
#pragma unroll
  for (int db = 0; db < 8; ++db)
#pragma unroll
    for (int qb = 0; qb < 2; ++qb) { const f32x4 v = O[db][qb] * (rl[qb] * OA8S); int w = 0; w = __builtin_amdgcn_cvt_pk_fp8_f32(v[0], v[1], w, false); w = __builtin_amdgcn_cvt_pk_fp8_f32(v[2], v[3], w, true);
      *(int*)(ost + (16 * qb + fr) * 128 + 16 * db + 4 * g) = w; }
  asm volatile("s_waitcnt lgkmcnt(0)" ::: "memory");
  unsigned char* Ow = Ob8 + (long)(wid * QBLK) * QW;
#pragma unroll
  for (int i = 0; i < 4; ++i) { const int ch = i * 64 + lane, row = ch >> 3, c16 = ch & 7;
    const u32x4 v = *(const u32x4*)(ost + row * 128 + c16 * 16); *(u32x4*)(Ow + (long)row * QW + c16 * 16) = v; }
  asm volatile("s_waitcnt lgkmcnt(0)" ::: "memory");
  __syncthreads();
#undef DMA_TILE
#undef VMW0
#undef BAR
#undef VSEG
}
}

#define XB_TMO      128
#define XB_XCNT(j)  (256  + 64 * (j))
#define XB_XSUB(j)  (1280 + 64 * (j))
#define XB_XGEN(j)  (2304 + 64 * (j))
#define XB_TOP      3328
#define XB_TOPGEN   3392
#define XCD_BAR_WORDS 3456
#define XB_SPIN_CAP (1u << 18)
__device__ __forceinline__ unsigned xb_ld(unsigned* p)              { return __hip_atomic_load(p, __ATOMIC_RELAXED, __HIP_MEMORY_SCOPE_AGENT); }
__device__ __forceinline__ unsigned xb_add(unsigned* p, unsigned v) { return __hip_atomic_fetch_add(p, v, __ATOMIC_RELAXED, __HIP_MEMORY_SCOPE_AGENT); }
__device__ __forceinline__ unsigned xb_xcc_id() { return (unsigned)__builtin_amdgcn_s_getreg((3 << 11) | 20) & 0xFu; }
#define XB_SPIN(cond, bar) do { unsigned _sp = 0; while (cond) { __builtin_amdgcn_s_sleep(1); \
    if ((++_sp & 255u) == 0u) { if (xb_ld(&(bar)[XB_TMO])) break; if (_sp > XB_SPIN_CAP) { atomicAdd(&(bar)[XB_TMO], 1u); break; } } } } while (0)
struct XcdBarrier { unsigned* bar; unsigned x; volatile LAS unsigned* st; };
__device__ __forceinline__ XcdBarrier xcd_barrier_post(unsigned* bar, volatile LAS unsigned* st) {
    XcdBarrier b; b.bar = bar; b.x = xb_xcc_id(); b.st = st;
    if (threadIdx.x == 0) (void)xb_add(&bar[XB_XCNT(b.x)], 1u);
    return b;
}
__device__ __forceinline__ void xcd_barrier_complete(unsigned* bar, unsigned x, unsigned& nloc, unsigned& nx) {
    const unsigned G = gridDim.x * gridDim.y * gridDim.z;
    unsigned sum, cnt, mine, sp = 0u;
    for (;;) {
        sum = 0u; cnt = 0u; mine = 0u;
#pragma unroll
        for (unsigned j = 0; j < 16; ++j) { const unsigned c = xb_ld(&bar[XB_XCNT(j)]); sum += c; cnt += (c > 0u) ? 1u : 0u; mine = (j == x) ? c : mine; }
        if (sum == G) break;
        __builtin_amdgcn_s_sleep(1);
        if ((++sp & 255u) == 0u) { if (xb_ld(&bar[XB_TMO])) break; if (sp > XB_SPIN_CAP) { atomicAdd(&bar[XB_TMO], 1u); break; } }
    }
    nloc = mine > 0u ? mine : 1u; nx = cnt > 0u ? cnt : 1u;
}
__device__ __forceinline__ void xcd_barrier(const XcdBarrier& b) {
    asm volatile("s_waitcnt vmcnt(0)" ::: "memory");
    __syncthreads();
    if (threadIdx.x == 0) {
        unsigned* bar = b.bar;
        __builtin_amdgcn_s_waitcnt(0);
        unsigned nloc = b.st[0], nx = b.st[1];
        if (nloc == 0u) { xcd_barrier_complete(bar, b.x, nloc, nx); b.st[0] = nloc; b.st[1] = nx; }
        const unsigned old = xb_add(&bar[XB_XSUB(b.x)], 1u);
        const unsigned gen = old / nloc;
        if (old + 1u == (gen + 1u) * nloc) {
            __builtin_amdgcn_fence(__ATOMIC_RELEASE, "agent");
            asm volatile("s_waitcnt vmcnt(0)" ::: "memory");
            const unsigned og = xb_add(&bar[XB_TOP], 1u);
            const unsigned tg = og / nx;
            if (og + 1u == (tg + 1u) * nx) xb_add(&bar[XB_TOPGEN], 1u);
            else XB_SPIN(xb_ld(&bar[XB_TOPGEN]) == tg, bar);
            __builtin_amdgcn_fence(__ATOMIC_ACQUIRE, "agent");
            xb_add(&bar[XB_XGEN(b.x)], 1u);
            asm volatile("s_waitcnt vmcnt(0)" ::: "memory");
        } else {
            XB_SPIN(xb_ld(&bar[XB_XGEN(b.x)]) == gen, bar);
            __builtin_amdgcn_fence(__ATOMIC_ACQUIRE, "agent");
            asm volatile("s_waitcnt vmcnt(0)" ::: "memory");
        }
    }
    __syncthreads();
}

struct Args { const float* in[17]; float* out; unsigned char* ws; int ph_lo, ph_hi, li, pad; };
struct Frame { LAS unsigned char* lds; int tid, lane, wave, vcu, G; };
constexpr int NWAVES = 8;

__device__ __forceinline__ void tr_item(const float* W, int N, int k0, int n0, bf16_t* WT, int Kd, int drow0, LAS float* scr, int lane, unsigned char* WT8 = nullptr, bool wr16 = true) {
    float tv[32];
#pragma unroll
    for (int i = 0; i < 32; ++i) { const int kk = 2 * i + (lane >> 5); tv[i] = W[(size_t)(k0 + kk) * N + n0 + (lane & 31)]; }
#pragma unroll
    for (int i = 0; i < 32; ++i) { const int kk = 2 * i + (lane >> 5); scr[kk * 33 + (lane & 31)] = tv[i]; }
    LDS_WAIT(); asm volatile("" ::: "memory");
    const int c = lane & 7;
#pragma unroll
    for (int j = 0; j < 4; ++j) { const int n = (lane >> 3) + 8 * j; const LAS float* s = scr + (8 * c) * 33 + n;
        if (wr16) { u32x4 o; o.x = cvt_pk_bf16(s[0 * 33], s[1 * 33]); o.y = cvt_pk_bf16(s[2 * 33], s[3 * 33]); o.z = cvt_pk_bf16(s[4 * 33], s[5 * 33]); o.w = cvt_pk_bf16(s[6 * 33], s[7 * 33]);
            *(GAS u32x4*)(WT + (size_t)(drow0 + n) * Kd + k0 + 8 * c) = o; }
        if (WT8) { int w0 = 0, w1 = 0; w0 = __builtin_amdgcn_cvt_pk_fp8_f32(s[0 * 33] * W8S, s[1 * 33] * W8S, w0, false); w0 = __builtin_amdgcn_cvt_pk_fp8_f32(s[2 * 33] * W8S, s[3 * 33] * W8S, w0, true);
            w1 = __builtin_amdgcn_cvt_pk_fp8_f32(s[4 * 33] * W8S, s[5 * 33] * W8S, w1, false); w1 = __builtin_amdgcn_cvt_pk_fp8_f32(s[6 * 33] * W8S, s[7 * 33] * W8S, w1, true);
            *(GAS u32x2*)(WT8 + (size_t)(drow0 + n) * Kd + k0 + 8 * c) = (u32x2){(unsigned)w0, (unsigned)w1}; } }
    LDS_WAIT(); asm volatile("" ::: "memory");
}
__device__ __forceinline__ void rms_row_to_bf16(const float* xrow, const float* g, bf16_t* orow, int lane) {
    const GAS f32x4* xr = (const GAS f32x4*)xrow + lane; const GAS f32x4* gr = (const GAS f32x4*)g + lane;
    f32x4 v[8]; float s = 0.f;
#pragma unroll
    for (int j = 0; j < 8; ++j) { v[j] = xr[64 * j]; s += (v[j].x * v[j].x + v[j].y * v[j].y) + (v[j].z * v[j].z + v[j].w * v[j].w); }
    const float rinv = 1.0f / sqrtf(wave_sum(s) * (1.f / DM) + EPS);
    GAS u32x2* o8 = (GAS u32x2*)orow + lane;
#pragma unroll
    for (int j = 0; j < 8; ++j) { const f32x4 gv = gr[64 * j]; u32x2 w; w.x = cvt_pk_bf16(v[j].x * rinv * gv.x, v[j].y * rinv * gv.y); w.y = cvt_pk_bf16(v[j].z * rinv * gv.z, v[j].w * rinv * gv.w); o8[64 * j] = w; }
}

__device__ __forceinline__ void p0_prologue(const Frame& F, const Args& a) {
    unsigned char* ws = a.ws;
    LAS float* scr = (LAS float*)(F.lds + F.wave * 16384);
    const int gw = F.vcu * NWAVES + F.wave, NGW = F.G * NWAVES;
    constexpr int I_IN = (DM / 64) * (INW / 32), I_P = (QW / 64) * (DM / 32), I_O = (DM / 64) * (DM / 32);
    constexpr int NITEMS = I_IN + 2 * I_P + I_O;
    for (int it = gw; it < NITEMS; it += NGW) {
        int r = it;
        if (r < I_IN) { const int nb = INW / 32, kb = r / nb, n0 = (r % nb) * 32; tr_item(a.in[2], INW, kb * 64, n0, (bf16_t*)(ws + WS_WIN), DM, n0, scr, F.lane, ws + WS_WIN8, false); continue; } r -= I_IN;
        if (r < I_P) { const int nb = DM / 32, kb = r / nb, n0 = (r % nb) * 32; tr_item(a.in[6], DM, kb * 64, n0, (bf16_t*)(ws + WS_WPA), QW, n0, scr, F.lane, ws + WS_WPA8, false); continue; } r -= I_P;
        if (r < I_P) { const int nb = DM / 32, kb = r / nb, n0 = (r % nb) * 32; tr_item(a.in[9], DM, kb * 64, n0, (bf16_t*)(ws + WS_WPB), QW, n0, scr, F.lane, ws + WS_WPB8, false); continue; } r -= I_P;
        { const int nb = DM / 32, kb = r / nb, n0 = (r % nb) * 32; tr_item(a.in[10], DM, kb * 64, n0, (bf16_t*)(ws + WS_WO), DM, n0, scr, F.lane, ws + WS_WO8, false); }
    }
    float* cosT = (float*)(ws + WS_ROPE); float* sinT = cosT + 128 * 32;
    for (int i = blockIdx.x * 512 + F.tid; i < 128 * 32; i += F.G * 512) { const int pos = i >> 5, p = i & 31;
        const float inv = 1.0f / powf(10000.0f, (float)(2 * p) / 64.0f); const float ang = (float)pos * inv; cosT[i] = cosf(ang); sinT[i] = sinf(ang); }
    { const float* X = a.in[0]; const float* gm = a.in[1]; bf16_t* H = (bf16_t*)(ws + WS_H); const int lane = F.lane;
      f32x4 nx[8]; int m = gw;
      if (m < NTOK) { const GAS f32x4* xr = (const GAS f32x4*)(X + (size_t)m * DM) + lane;
#pragma unroll
          for (int j = 0; j < 8; ++j) nx[j] = xr[64 * j]; }
      for (; m < NTOK; m += NGW) { f32x4 v[8]; float s = 0.f;
#pragma unroll
          for (int j = 0; j < 8; ++j) { v[j] = nx[j]; s += (v[j].x * v[j].x + v[j].y * v[j].y) + (v[j].z * v[j].z + v[j].w * v[j].w); }
          { const int nm = m + NGW; if (nm < NTOK) { const GAS f32x4* xr = (const GAS f32x4*)(X + (size_t)nm * DM) + lane;
#pragma unroll
              for (int j = 0; j < 8; ++j) nx[j] = xr[64 * j]; } }
          const float rinv = 1.0f / sqrtf(wave_sum(s) * (1.f / DM) + EPS);
          GAS u32x2* o8 = (GAS u32x2*)(H + (size_t)m * DM) + lane;
#pragma unroll
          for (int j = 0; j < 8; ++j) { const f32x4 gv = ((const GAS f32x4*)gm + lane)[64 * j]; const f32x4 hv = v[j] * rinv * gv; (void)o8;
              int w8 = 0; w8 = __builtin_amdgcn_cvt_pk_fp8_f32(hv.x, hv.y, w8, false); w8 = __builtin_amdgcn_cvt_pk_fp8_f32(hv.z, hv.w, w8, true); ((GAS int*)(ws + WS_H8 + (size_t)m * DM) + lane)[64 * j] = w8; } } }
}

constexpr int CW_WCTR = 8192;
__device__ __forceinline__ void p_moe_weights(const Frame& F, const Args& a) {
    unsigned char* ws = a.ws; LAS float* scr = (LAS float*)(F.lds + F.wave * 16384);
    constexpr int I_GU = NEXP * (DM / 64) * (DFF / 32), I_D = NEXP * (DFF / 64) * (DM / 32), NIT = 2 * I_GU + I_D;
    unsigned* ctr = (unsigned*)(ws + WS_CTL) + CW_WCTR;
    for (;;) {
        unsigned it0 = 0; if (F.lane == 0) it0 = __hip_atomic_fetch_add(ctr, 4u, __ATOMIC_RELAXED, __HIP_MEMORY_SCOPE_AGENT);
        it0 = (unsigned)__builtin_amdgcn_readfirstlane((int)it0);
        if (it0 >= (unsigned)NIT) break;
        for (int k4 = 0; k4 < 4; ++k4) { int r = (int)it0 + k4; if (r >= NIT) break;
            if (r < 2 * I_GU) { const int up = r >= I_GU; if (up) r -= I_GU; constexpr int per = (DM / 64) * (DFF / 32); const int e = r / per, q = r % per, nb = DFF / 32, kb = q / nb, n0 = (q % nb) * 32;
                tr_item(a.in[up ? 14 : 13] + (size_t)e * DM * DFF, DFF, kb * 64, n0, (bf16_t*)(ws + WS_WGU), DM, (n0 >> 7) * 256 + (n0 & 127) + (up ? 128 : 0), scr, F.lane, ws + WS_WGU + (size_t)e * 2048 * DM, false); continue; }
            r -= 2 * I_GU;
            { constexpr int per = (DFF / 64) * (DM / 32); const int e = r / per, q = r % per, nb = DM / 32, kb = q / nb, n0 = (q % nb) * 32;
                tr_item(a.in[15] + (size_t)e * DFF * DM, DM, kb * 64, n0, (bf16_t*)(ws + WS_WD) + (size_t)e * 2048 * DFF, DFF, n0, scr, F.lane, ws + WS_WD8 + (size_t)e * 2048 * DFF, false); } }
    }
}

__device__ __forceinline__ void prep_vecs(const Frame& F, bf16_t* T, int ld, int nh_log2, const float* gain, const float* cosT, const float* sinT, float oscale, unsigned char* out8) {
    const int gw = F.vcu * NWAVES + F.wave, NGW = F.G * NWAVES;
    const int sub = F.lane & 15, half = sub >> 3, q = sub & 7;
    const int nvec = NTOK << nh_log2;
    const f32x4 g1 = *(const f32x4*)(gain + half * 64 + 4 * q), g2 = *(const f32x4*)(gain + half * 64 + 32 + 4 * q);
    for (int it = gw; it < nvec / 16; it += NGW) {
        bf16_t* base[4]; u32x2 w1[4], w2[4]; int posx[4];
#pragma unroll
        for (int u = 0; u < 4; ++u) { const int vec = it * 16 + u * 4 + (F.lane >> 4);
            const int tok = vec >> nh_log2, hd = vec & ((1 << nh_log2) - 1), pos = tok & (SEQ - 1); posx[u] = half ? (pos & 63) : (pos >> 6);
            base[u] = T + (size_t)tok * ld + hd * HD + half * 64 + 4 * q; w1[u] = *(const u32x2*)base[u]; w2[u] = *(const u32x2*)(base[u] + 32); }
#pragma unroll
        for (int u = 0; u < 4; ++u) {
            float x1[4] = {bf2f(w1[u].x & 0xffff), bf2f(w1[u].x >> 16), bf2f(w1[u].y & 0xffff), bf2f(w1[u].y >> 16)}, x2[4] = {bf2f(w2[u].x & 0xffff), bf2f(w2[u].x >> 16), bf2f(w2[u].y & 0xffff), bf2f(w2[u].y >> 16)};
            float ss = 0.f;
#pragma unroll
            for (int j = 0; j < 4; ++j) ss += x1[j] * x1[j] + x2[j] * x2[j];
            ss += __shfl_xor(ss, 1); ss += __shfl_xor(ss, 2); ss += __shfl_xor(ss, 4); ss += __shfl_xor(ss, 8);
            const float rinv = 1.0f / sqrtf(ss * (1.0f / 128.0f) + EPS);
            const f32x4 cs = *(const f32x4*)(cosT + posx[u] * 32 + 4 * q), sn = *(const f32x4*)(sinT + posx[u] * 32 + 4 * q);
            float y1[4], y2[4];
#pragma unroll
            for (int j = 0; j < 4; ++j) { const float a1 = x1[j] * rinv * g1[j], a2 = x2[j] * rinv * g2[j]; y1[j] = (a1 * cs[j] - a2 * sn[j]) * oscale; y2[j] = (a2 * cs[j] + a1 * sn[j]) * oscale; }
            if (out8) {
                const int vec = it * 16 + u * 4 + (F.lane >> 4), tok = vec >> nh_log2, hd = vec & ((1 << nh_log2) - 1);
                unsigned char* o8 = out8 + ((size_t)(((tok >> 13) << nh_log2) + hd) * SEQ + (tok & (SEQ - 1))) * HD + half * 64 + 4 * q;
                int w1 = 0, w2 = 0; w1 = __builtin_amdgcn_cvt_pk_fp8_f32(y1[0], y1[1], w1, false); w1 = __builtin_amdgcn_cvt_pk_fp8_f32(y1[2], y1[3], w1, true);
                w2 = __builtin_amdgcn_cvt_pk_fp8_f32(y2[0], y2[1], w2, false); w2 = __builtin_amdgcn_cvt_pk_fp8_f32(y2[2], y2[3], w2, true);
                *(int*)o8 = w1; *(int*)(o8 + 32) = w2;
            } else {
            u32x2 o1, o2; o1.x = cvt_pk_bf16(y1[0], y1[1]); o1.y = cvt_pk_bf16(y1[2], y1[3]); o2.x = cvt_pk_bf16(y2[0], y2[1]); o2.y = cvt_pk_bf16(y2[2], y2[3]);
            *(u32x2*)base[u] = o1; *(u32x2*)(base[u] + 32) = o2; } }
    }
}
__device__ __forceinline__ void p2_qkprep(const Frame& F, const Args& a) {
    const float* cosT = (const float*)(a.ws + WS_ROPE); const float* sinT = cosT + 128 * 32;
    prep_vecs(F, (bf16_t*)(a.ws + WS_KA), KVW, 1, a.in[5], cosT, sinT, 1.0f, a.ws + WS_K8);
    { const bf16_t* VA = (const bf16_t*)(a.ws + WS_VA); unsigned char* V8T = a.ws + WS_V8T; LAS bf16_t* tl = (LAS bf16_t*)F.lds; constexpr int TP = 132;
      for (int T = F.vcu; T < BATCH * 2 * 64; T += F.G) { const int bk = T >> 6, t = T & 63, b = bk >> 1, kvh = bk & 1;
        { const int r = F.tid >> 2, qd = F.tid & 3; const bf16_t* src = VA + ((size_t)b * SEQ + 128 * t + r) * KVW + kvh * HD + qd * 32;
#pragma unroll
          for (int i = 0; i < 4; ++i) { const u32x4 v = *(const u32x4*)(src + 8 * i); LAS unsigned* d = (LAS unsigned*)(tl + r * TP + qd * 32 + 8 * i); d[0] = v.x; d[1] = v.y; d[2] = v.z; d[3] = v.w; } }
        __syncthreads();
        { const int d = F.tid >> 2, g = F.tid & 3; int w[8];
#pragma unroll
          for (int kb = 0; kb < 8; ++kb) { float x[4];
#pragma unroll
            for (int r = 0; r < 4; ++r) x[r] = bf2f(tl[(16 * kb + 4 * g + r) * TP + d]);
            int ww = 0; ww = __builtin_amdgcn_cvt_pk_fp8_f32(x[0], x[1], ww, false); ww = __builtin_amdgcn_cvt_pk_fp8_f32(x[2], x[3], ww, true); w[kb] = ww; }
          unsigned char* dst = V8T + ((size_t)T * HD + d) * 128 + 32 * g;
          *(u32x4*)dst = (u32x4){(unsigned)w[0], (unsigned)w[1], (unsigned)w[2], (unsigned)w[3]}; *(u32x4*)(dst + 16) = (u32x4){(unsigned)w[4], (unsigned)w[5], (unsigned)w[6], (unsigned)w[7]}; }
        __syncthreads(); } }
}

template <int MODE> __device__ __forceinline__ void p3_attention(const Frame& F, const Args& a, char* lds) {
    unsigned char* ws = a.ws;
    const bf16_t* Q = (const bf16_t*)(ws + (MODE == 0 ? WS_QA : WS_QB)); const bf16_t* K = (const bf16_t*)(ws + (MODE == 0 ? WS_KA : WS_KB)); const bf16_t* V = (const bf16_t*)(ws + (MODE == 0 ? WS_VA : WS_VB));
    att::Aux aux; aux.cosT = (const float*)(ws + WS_ROPE); aux.sinT = aux.cosT + 128 * 32; aux.qn = a.in[4]; aux.kn = a.in[5]; aux.relb = a.in[8]; aux.sink = a.in[7];
#define BUILD_TABS(kvh_) do { float* tabs_ = (float*)(lds + att::OFF_TAB); for (int i_ = F.tid; i_ < 4 * 768; i_ += 512) { const int hh_ = i_ / 768, ii_ = i_ - hh_ * 768, rel_ = ii_ - 383, n_ = rel_ < 0 ? -rel_ : rel_; float v_ = -1e30f; \
        if (n_ <= 128) v_ = aux.relb[att::t5_bucket(rel_) * NHB + (kvh_) * 4 + hh_] * LOG2E; tabs_[i_] = v_; } } while (0)
    float pscale = 1.f;
    if (MODE == 0) { float mq = fmaxf(fabsf(aux.qn[F.lane]), fabsf(aux.qn[64 + F.lane])), mk = fmaxf(fabsf(aux.kn[F.lane]), fabsf(aux.kn[64 + F.lane]));
#pragma unroll
        for (int of = 1; of < 64; of <<= 1) { mq = fmaxf(mq, __shfl_xor(mq, of)); mk = fmaxf(mk, __shfl_xor(mk, of)); }
        const float bound = att::C * 128.0f * mq * mk * 1.13f + 0.5f; pscale = -fmaxf(ceilf(bound) - 15.f, 0.f);
        pscale = __uint_as_float(__builtin_amdgcn_readfirstlane(__float_as_uint(pscale))); }
    const bool shared_tabs = (F.G == 256);
    if (MODE == 1 && shared_tabs) { BUILD_TABS((F.vcu >> 5) & 1); __syncthreads(); }
    for (int i = 0;; ++i) {
        const int L = i * F.G + F.vcu; if (L >= 1024) break;
        const int x = (L & 255) >> 5, b = x >> 1, kvh = x & 1;
        const int qb = (MODE == 0) ? (L & 31) : ((L >> 8) * 32 + (L & 31));
        const int head = (MODE == 0) ? kvh * 4 + (L >> 8) : kvh * 4, q0 = qb * ((MODE == 0) ? 256 : 64);
        const bf16_t* Qb = Q + ((size_t)b * SEQ + q0) * QW + head * HD;
        const bf16_t* Kh = K + (size_t)b * SEQ * KVW + kvh * HD; const bf16_t* Vh = V + (size_t)b * SEQ * KVW + kvh * HD;
        int kbeg = 0, kend = SEQ;
        if (MODE == 1) { kbeg = q0 - 128 < 0 ? 0 : q0 - 128; kend = q0 + 192 > SEQ ? SEQ : q0 + 192; }
        if (MODE == 1 && !shared_tabs) { __syncthreads(); BUILD_TABS(kvh); __syncthreads(); }
        unsigned char* Ob8 = ws + (MODE == 0 ? WS_OA8 : WS_OB8) + ((size_t)b * SEQ + q0) * QW + head * HD;
        if constexpr (MODE == 0) att::attn_unit8(Qb, a.ws + WS_K8 + (size_t)(b * 2 + kvh) * SEQ * HD, a.ws + WS_V8T + (size_t)(b * 2 + kvh) * 64 * 16384, Ob8, q0, lds, aux, pscale);
        else att::attn_unit_pp<MODE>(Qb, Kh, Vh, Ob8, kbeg, kend, q0, head, lds, aux);
    }
#undef BUILD_TABS
}

__device__ __forceinline__ void p7_router(const Frame& F, const Args& a) {
    LAS float* wl = (LAS float*)F.lds;
    const float* wr = a.in[12];
    for (int i = F.tid; i < DM * NEXP / 4; i += 512) { const f32x4 v = *(const f32x4*)(wr + 4 * i); const int k = i >> 2, e0 = (i & 3) * 4;
        wl[(e0 + 0) * DM + k] = v.x; wl[(e0 + 1) * DM + k] = v.y; wl[(e0 + 2) * DM + k] = v.z; wl[(e0 + 3) * DM + k] = v.w; }
    __syncthreads();
    const float* X = a.in[0]; const unsigned char* ATT = a.ws + WS_ATT; bf16_t* H2 = (bf16_t*)(a.ws + WS_H); float* AFF = (float*)(a.ws + WS_AFF); const float* g = a.in[11];
    const int gw = F.vcu * NWAVES + F.wave, NGW = F.G * NWAVES, lane = F.lane;
    f32x4 nx[2][8]; unsigned na[2][8];
#define RT_LOAD(rp_) do { _Pragma("unroll") for (int rr = 0; rr < 2; ++rr) { const size_t row_ = (size_t)(2 * (rp_) + rr); const GAS f32x4* xr = (const GAS f32x4*)(X + row_ * DM) + lane; const GAS unsigned* ar = (const GAS unsigned*)(ATT + row_ * DM) + lane; \
        _Pragma("unroll") for (int j = 0; j < 8; ++j) { nx[rr][j] = xr[64 * j]; if (DBG_LEVEL >= 3) na[rr][j] = ar[64 * j]; else na[rr][j] = 0u; } } } while (0)
    int rp = gw;
    if (rp < NTOK / 2) RT_LOAD(rp);
    for (; rp < NTOK / 2; rp += NGW) {
        f32x4 h[2][8]; float rinv[2];
#pragma unroll
        for (int rr = 0; rr < 2; ++rr) { float s = 0.f;
#pragma unroll
            for (int j = 0; j < 8; ++j) { f32x4 v = nx[rr][j]; const int w = (int)na[rr][j]; const auto a01 = __builtin_amdgcn_cvt_pk_f32_fp8(w, false), a23 = __builtin_amdgcn_cvt_pk_f32_fp8(w, true);
                v.x += a01[0] * (1.0f / ATT8S); v.y += a01[1] * (1.0f / ATT8S); v.z += a23[0] * (1.0f / ATT8S); v.w += a23[1] * (1.0f / ATT8S);
                h[rr][j] = v; s += (v.x * v.x + v.y * v.y) + (v.z * v.z + v.w * v.w); }
            rinv[rr] = s; }
#if DBG_LEVEL >= 3
#pragma unroll
        for (int rr = 0; rr < 2; ++rr) { GAS u32x2* x8 = (GAS u32x2*)((bf16_t*)(a.ws + WS_X1B) + (size_t)(2 * rp + rr) * DM) + lane;
#pragma unroll
            for (int j = 0; j < 8; ++j) { u32x2 w; w.x = cvt_pk_bf16(h[rr][j].x, h[rr][j].y); w.y = cvt_pk_bf16(h[rr][j].z, h[rr][j].w); x8[64 * j] = w; } }
#endif
        { const int nrp = rp + NGW; if (nrp < NTOK / 2) RT_LOAD(nrp); }
#pragma unroll
        for (int rr = 0; rr < 2; ++rr) { rinv[rr] = 1.0f / sqrtf(wave_sum(rinv[rr]) * (1.f / DM) + EPS);
            GAS int* o8 = (GAS int*)((unsigned char*)H2 + (size_t)(2 * rp + rr) * DM) + lane;
#pragma unroll
            for (int j = 0; j < 8; ++j) { const f32x4 gv = ((const GAS f32x4*)g + lane)[64 * j]; h[rr][j] = h[rr][j] * rinv[rr] * gv;
                int w = 0; w = __builtin_amdgcn_cvt_pk_fp8_f32(h[rr][j].x, h[rr][j].y, w, false); w = __builtin_amdgcn_cvt_pk_fp8_f32(h[rr][j].z, h[rr][j].w, w, true); o8[64 * j] = w; } }
        float v[32];
#pragma unroll
        for (int e = 0; e < NEXP; ++e) { float s0 = 0.f, s1 = 0.f;
#pragma unroll
            for (int j = 0; j < 8; ++j) { const f32x4 w = *(const LAS f32x4*)(wl + e * DM + 4 * lane + 256 * j);
                s0 += (h[0][j].x * w.x + h[0][j].y * w.y) + (h[0][j].z * w.z + h[0][j].w * w.w); s1 += (h[1][j].x * w.x + h[1][j].y * w.y) + (h[1][j].z * w.z + h[1][j].w * w.w); }
            v[e] = s0; v[16 + e] = s1; }
#pragma unroll
        for (int off = 16; off >= 1; off >>= 1) { const bool up = (lane & off) != 0;
#pragma unroll
            for (int i = 0; i < off; ++i) { const float lo = v[i], hi = v[i + off]; const float keep = up ? hi : lo, send = up ? lo : hi; v[i] = keep + __shfl_xor(send, off); } }
        const float mine = v[0] + __shfl_xor(v[0], 32);
        float mx = mine; mx = fmaxf(mx, __shfl_xor(mx, 1)); mx = fmaxf(mx, __shfl_xor(mx, 2)); mx = fmaxf(mx, __shfl_xor(mx, 4)); mx = fmaxf(mx, __shfl_xor(mx, 8));
        const float ex = expf(mine - mx); float sm = ex; sm += __shfl_xor(sm, 1); sm += __shfl_xor(sm, 2); sm += __shfl_xor(sm, 4); sm += __shfl_xor(sm, 8);
        if (lane < 32) { const int row = 2 * rp + (lane >> 4), e = lane & 15, b = row >> 13, s = row & (SEQ - 1); AFF[((size_t)(b * NEXP + e)) * SEQ + s] = ex / sm; }
    }
#undef RT_LOAD
    __syncthreads();
}

__device__ __forceinline__ int block_excl_scan(int v, LAS int* sc, int tid, int& total) {
    const int lane = tid & 63, w = tid >> 6; int x = v;
#pragma unroll
    for (int o = 1; o < 64; o <<= 1) { const int y = __shfl_up(x, o); if (lane >= o) x += y; }
    __syncthreads();
    if (lane == 63) sc[w] = x;
    __syncthreads();
    int pre = 0, tot = 0;
#pragma unroll
    for (int j = 0; j < 8; ++j) { const int s = sc[j]; if (j < w) pre += s; tot += s; }
    total = tot; return pre + x - v;
}
__device__ __forceinline__ void p8_topk(const Frame& F, const Args& a) {
    const float* AFF = (const float*)(a.ws + WS_AFF); int* IDX = (int*)(a.ws + WS_IDX); float* GATEV = (float*)(a.ws + WS_GATEV); int* INV = (int*)(a.ws + WS_INV);
    LAS int* hist = (LAS int*)F.lds; LAS int* sc = hist + 256; LAS int* res = sc + 16;
    const int tid = F.tid, lane = F.lane;
    for (int list = F.vcu; list < NLIST; list += F.G) {
        const int b = list / NEXP, e = list % NEXP;
        unsigned key[16];
        { const u32x4* src = (const u32x4*)(AFF + (size_t)list * SEQ + tid * 16);
#pragma unroll
            for (int j = 0; j < 4; ++j) { const u32x4 v = src[j]; key[4 * j] = v.x; key[4 * j + 1] = v.y; key[4 * j + 2] = v.z; key[4 * j + 3] = v.w; } }
        unsigned prefix = 0u, pmask = 0u; int krem = CAP;
#pragma unroll 1
        for (int pass = 0; pass < 4; ++pass) { const int shift = 24 - 8 * pass;
            __syncthreads();
            if (tid < 256) hist[tid] = 0;
            __syncthreads();
#pragma unroll
            for (int j = 0; j < 16; ++j) if ((key[j] & pmask) == prefix) __hip_atomic_fetch_add(&hist[(key[j] >> shift) & 255u], 1, __ATOMIC_RELAXED, __HIP_MEMORY_SCOPE_WORKGROUP);
            __syncthreads();
            if (tid < 64) {
                int c[4]; int s = 0;
#pragma unroll
                for (int j = 0; j < 4; ++j) { c[j] = hist[4 * lane + j]; s += c[j]; }
                int suf = s;
#pragma unroll
                for (int o = 1; o < 64; o <<= 1) { const int y = __shfl_down(suf, o); if (lane + o < 64) suf += y; }
                const int excl = suf - s;
                if (suf >= krem && excl < krem) { int cum = excl, bin = 4 * lane, kn = krem;
#pragma unroll
                    for (int j = 3; j >= 0; --j) { if (cum < krem && cum + c[j] >= krem) { bin = 4 * lane + j; kn = krem - cum; } cum += c[j]; }
                    res[0] = bin; res[1] = kn; }
            }
            __syncthreads();
            const int bin = res[0]; krem = res[1];
            prefix |= ((unsigned)bin) << shift; pmask |= 255u << shift;
        }
        const unsigned T = prefix;
        int ceq = 0;
#pragma unroll
        for (int j = 0; j < 16; ++j) ceq += (key[j] == T) ? 1 : 0;
        int toteq; const int eqb = block_excl_scan(ceq, sc, tid, toteq);
        int csel = 0, er = eqb; unsigned selmask = 0u;
#pragma unroll
        for (int j = 0; j < 16; ++j) { bool s = key[j] > T; if (key[j] == T) { s = er < krem; ++er; } if (s) { selmask |= 1u << j; ++csel; } }
        int totsel; int pos = block_excl_scan(csel, sc, tid, totsel);
#pragma unroll
        for (int j = 0; j < 16; ++j) { const int tokpos = tid * 16 + j; int slot = -1;
            if (selmask & (1u << j)) { slot = list * CAP + pos; IDX[slot] = tokpos; GATEV[slot] = __uint_as_float(key[j]); ++pos; }
            INV[((size_t)b * SEQ + tokpos) * NEXP + e] = slot; }
        __syncthreads();
    }
}

__device__ __forceinline__ void p11_final(const Frame& F, const Args& a, bool with_moe) {
    const float* X = a.in[0]; float* OUT = a.out; const bf16_t* ATT = (const bf16_t*)(a.ws + WS_X1B); const bf16_t* Y = (const bf16_t*)(a.ws + WS_Y); const int* INV = (const int*)(a.ws + WS_INV); const float* g = a.in[16];
    const int gw = F.vcu * NWAVES + F.wave, NGW = F.G * NWAVES, lane = F.lane;
    f32x4 nx[8]; u32x2 na[8]; int ninv = -1;
#define FN_LOAD(m_) do { const GAS f32x4* xr = (const GAS f32x4*)(X + (size_t)(m_) * DM) + lane; const GAS u32x2* ar = (const GAS u32x2*)(ATT + (size_t)(m_) * DM) + lane; \
        _Pragma("unroll") for (int j = 0; j < 8; ++j) { if (DBG_LEVEL >= 3) na[j] = ar[64 * j]; else nx[j] = xr[64 * j]; } \
        ninv = (with_moe && lane < NEXP) ? INV[(size_t)(m_) * NEXP + lane] : -1; } while (0)
    int m = gw;
    if (m < NTOK) FN_LOAD(m);
    for (; m < NTOK; m += NGW) {
        f32x4 v[8]; const int myinv = ninv;
#pragma unroll
        for (int j = 0; j < 8; ++j) { if (DBG_LEVEL >= 3) { const u32x2 w = na[j]; v[j].x = __uint_as_float(w.x << 16); v[j].y = __uint_as_float(w.x & 0xffff0000u); v[j].z = __uint_as_float(w.y << 16); v[j].w = __uint_as_float(w.y & 0xffff0000u); } else v[j] = nx[j]; }
        unsigned long long mask = __ballot(myinv >= 0);
        u32x2 y0[8]; const bool has0 = mask != 0ull;
        if (has0) { const int e = __builtin_ctzll(mask); mask &= mask - 1; const int slot = __builtin_amdgcn_readlane(myinv, e); const GAS u32x2* yr = (const GAS u32x2*)(Y + (size_t)slot * DM) + lane;
#pragma unroll
            for (int j = 0; j < 8; ++j) y0[j] = yr[64 * j]; }
        { const int nm = m + NGW; if (nm < NTOK) FN_LOAD(nm); }
        if (has0) {
#pragma unroll
            for (int j = 0; j < 8; ++j) { const u32x2 w = y0[j]; v[j].x += __uint_as_float(w.x << 16); v[j].y += __uint_as_float(w.x & 0xffff0000u); v[j].z += __uint_as_float(w.y << 16); v[j].w += __uint_as_float(w.y & 0xffff0000u); } }
        while (mask) { const int e = __builtin_ctzll(mask); mask &= mask - 1; const int slot = __builtin_amdgcn_readlane(myinv, e);
            const GAS u32x2* yr = (const GAS u32x2*)(Y + (size_t)slot * DM) + lane;
#pragma unroll
            for (int j = 0; j < 8; ++j) { const u32x2 w = yr[64 * j]; v[j].x += __uint_as_float(w.x << 16); v[j].y += __uint_as_float(w.x & 0xffff0000u); v[j].z += __uint_as_float(w.y << 16); v[j].w += __uint_as_float(w.y & 0xffff0000u); } }
        float s = 0.f;
#pragma unroll
        for (int j = 0; j < 8; ++j) s += (v[j].x * v[j].x + v[j].y * v[j].y) + (v[j].z * v[j].z + v[j].w * v[j].w);
        const float rinv = 1.0f / sqrtf(wave_sum(s) * (1.f / DM) + EPS);
        GAS f32x4* orow = (GAS f32x4*)(OUT + (size_t)m * DM) + lane;
#pragma unroll
        for (int j = 0; j < 8; ++j) { const f32x4 gv = ((const GAS f32x4*)g + lane)[64 * j]; orow[64 * j] = v[j] * rinv * gv; }
    }
#undef FN_LOAD
}
__device__ __forceinline__ void p_copy_x(const Frame& F, const Args& a) {
    const f32x4* src = (const f32x4*)a.in[0]; f32x4* dst = (f32x4*)a.out;
    for (size_t i = (size_t)blockIdx.x * 512 + F.tid; i < (size_t)NTOK * DM / 4; i += (size_t)F.G * 512) dst[i] = src[i];
}

constexpr int NPHASE = 10;
__global__ void __launch_bounds__(NWAVES * 64, 2) fwd_kernel(Args args) {
    extern __shared__ __attribute__((aligned(16))) unsigned char lds[];
    Frame F;
    F.lds = (LAS unsigned char*)lds;
    F.tid = threadIdx.x; F.lane = F.tid & 63; F.wave = __builtin_amdgcn_readfirstlane(F.tid >> 6);
    F.G = gridDim.x; { const int bx = blockIdx.x; F.vcu = (F.G % 8 == 0) ? (bx % 8) * (F.G / 8) + bx / 8 : bx; }
    unsigned char* ws = args.ws;
    gu32* ctl = (gu32*)(ws + WS_CTL);
    for (int u = F.tid; u < (LDS_BYTES - LDSCTL_OFF) / 4; u += NWAVES * 64) ((LAS unsigned*)(F.lds + LDSCTL_OFF))[u] = 0u;
    __syncthreads();
    XcdBarrier bar; bar.bar = (unsigned*)(ctl + CW_BAR); bar.x = 0; bar.st = nullptr;
    if (MK_N_LAUNCHES == 1) bar = xcd_barrier_post((unsigned*)(ctl + CW_BAR), (volatile LAS unsigned*)(F.lds + LDSCTL_OFF + 64));
    const int lo = args.ph_lo, hi = args.ph_hi;
#define IN(k) (lo <= (k) && (k) < hi)
#define SEAM(k) do { if (IN(k) && IN((k) + 1)) xcd_barrier(bar); } while (0)
#define REFRAME() do { int t_ = threadIdx.x; asm volatile("" : "+v"(t_)); F.tid = t_; F.lane = t_ & 63; F.wave = __builtin_amdgcn_readfirstlane(t_ >> 6); } while (0)

    if (IN(0)) { REFRAME(); for (int rep = 0; rep < REPS(0); ++rep) p0_prologue(F, args); }
    SEAM(0);
    if (IN(1)) { REFRAME();
#if DBG_LEVEL >= 3
        { pg8::MapProb<DM, 0, 1> P; P.A = ws + WS_H8; P.Bt = ws + WS_WIN8; P.S.init(NTOK, INW, F.G, (int)blockIdx.x);
          pg8::EpiInProj E{(bf16_t*)(ws + WS_QA), (bf16_t*)(ws + WS_KA), (bf16_t*)(ws + WS_VA), (bf16_t*)(ws + WS_QB), (bf16_t*)(ws + WS_KB), (bf16_t*)(ws + WS_VB), (bf16_t*)(ws + WS_GA), (bf16_t*)(ws + WS_GB), args.in[3], 1.0f / W8S};
          pg8::gemm_phase8<pg8::EpiInProj, pg8::MapProb<DM, 0, 1>, true>(F.lds, P, E); }
#endif
    }
    SEAM(1);
    if (IN(2)) { REFRAME();
#if DBG_LEVEL >= 4
        p2_qkprep(F, args);
#endif
    }
    SEAM(2);
    if (IN(3)) { REFRAME();
#if DBG_LEVEL >= 4
        for (int rep = 0; rep < REPS(3); ++rep) p3_attention<0>(F, args, (char*)lds);
#endif
#if DBG_LEVEL >= 3
        __syncthreads();
        for (int rep = 0; rep < REPS(13); ++rep) p3_attention<1>(F, args, (char*)lds);
        __syncthreads();
#endif
    }
    SEAM(3);
    if (IN(4)) { REFRAME();
#if DBG_LEVEL >= 4
        { pg8::MapProb<QW, 0, 1> P; P.A = ws + WS_OA8; P.Bt = ws + WS_WPA8; P.S.init(NTOK, DM, F.G, (int)blockIdx.x);
          pg8::EpiGated8<0> E{ws + WS_GA8, nullptr, ws + WS_M18, 1.0f / (OA8S * W8S)};
          pg8::gemm_phase8<pg8::EpiGated8<0>, pg8::MapProb<QW, 0, 1>, true>(F.lds, P, E); }
        { int gg_ = F.G; asm volatile("" : "+s"(gg_)); unsigned char* ws2_ = ws; asm volatile("" : "+s"(ws2_));
          pg8::MapProb<QW, 0, 1> P; P.A = ws2_ + WS_OB8; P.Bt = ws2_ + WS_WPB8; P.S.init(NTOK, DM, gg_, (int)blockIdx.x);
          pg8::EpiGated8<1> E{ws2_ + WS_GB8, ws2_ + WS_M18, ws2_ + WS_M8, 1.0f / (OB8S * W8S)};
          pg8::gemm_phase8<pg8::EpiGated8<1>, pg8::MapProb<QW, 0, 1>, true>(F.lds, P, E); }
#endif
    }
    SEAM(4);
    if (IN(5)) { REFRAME();
#if DBG_LEVEL >= 3
        pg8::MapProb<DM, 0, 1> P; P.A = ws + WS_M8; P.Bt = ws + WS_WO8; P.S.init(NTOK, DM, F.G, (int)blockIdx.x);
        pg8::EpiAtt E{ws + WS_ATT, ATT8S / (M8S * W8S)};
        for (int rep = 0; rep < REPS(5); ++rep) pg8::gemm_phase8<pg8::EpiAtt, pg8::MapProb<DM, 0, 1>, true>(F.lds, P, E);
#endif
    }
    SEAM(5);
    if (IN(6)) { REFRAME();
#if DBG_LEVEL >= 2
        for (int rep = 0; rep < REPS(6); ++rep) p7_router(F, args);
#endif
    }
    SEAM(6);
    if (IN(7)) { REFRAME();
#if DBG_LEVEL >= 2
        for (int rep = 0; rep < REPS(7); ++rep) p8_topk(F, args);
        __syncthreads();
        p_moe_weights(F, args);
#endif
    }
    SEAM(7);
    if (IN(8)) { REFRAME();
#if DBG_LEVEL >= 2
        LAS unsigned* rowoff = (LAS unsigned*)(F.lds + pg8::STAGE_BYTES);
        const int* IDX = (const int*)(ws + WS_IDX);
        for (int i = 0; i < 8; ++i) { pg8::Unit u; int e, b; if (!pg8::moe_unit(i, F.G, F.vcu, u, e, b)) break;
            if (F.tid < 256) rowoff[i * 256 + F.tid] = (unsigned)IDX[u.pm * 256 + F.tid] * (unsigned)DM; }
        __syncthreads();
        pg8::GuProb8 P; P.H2 = ws + WS_H; P.W = ws + WS_WGU; P.rowoff = rowoff; P.G = F.G; P.vcu = F.vcu;
        pg8::EpiSwiglu E{ws + WS_GA, 1.0f / W8S};
        for (int rep = 0; rep < REPS(8); ++rep) pg8::gemm_phase8<pg8::EpiSwiglu, pg8::GuProb8, true>(F.lds, P, E);
#endif
    }
    SEAM(8);
    if (IN(9)) { REFRAME();
#if DBG_LEVEL >= 2
        pg8::DownProb8 P; P.HID = ws + WS_GA; P.W = ws + WS_WD8; P.G = F.G; P.vcu = F.vcu;
        pg8::EpiDown E{(bf16_t*)(ws + WS_Y), (const float*)(ws + WS_GATEV), 1.0f / W8S};
        for (int rep = 0; rep < REPS(9); ++rep) pg8::gemm_phase8<pg8::EpiDown, pg8::DownProb8, true>(F.lds, P, E);
#endif
    }
    SEAM(9);
    if (IN(10)) { REFRAME(); p11_final(F, args, DBG_LEVEL >= 2); }
#undef IN
#undef SEAM
}

extern "C" void kernel_launch(void* const* d_in, const int* in_sizes, int n_in, void* d_out, int out_size, void* d_ws, size_t ws_size, hipStream_t stream) {
    static int grid = 0;
    if (grid == 0) {
        if (n_in != 17 || in_sizes[0] != NTOK * DM || out_size != NTOK * DM || ws_size < WS_END) { fprintf(stderr, "kernel_launch: unexpected shapes (n_in %d, in0 %d, out %d, ws %zu); nothing launched\n", n_in, n_in > 0 ? in_sizes[0] : -1, out_size, ws_size); grid = -1; return; }
        int dev = 0, cus = 0, per_cu = 0;
        if (hipGetDevice(&dev) != hipSuccess || hipDeviceGetAttribute(&cus, hipDeviceAttributeMultiprocessorCount, dev) != hipSuccess) { grid = -1; return; }
        if (hipFuncSetAttribute((const void*)fwd_kernel, hipFuncAttributeMaxDynamicSharedMemorySize, LDS_BYTES) != hipSuccess) { fprintf(stderr, "kernel_launch: hipFuncSetAttribute failed\n"); grid = -1; return; }
        if (hipOccupancyMaxActiveBlocksPerMultiprocessor(&per_cu, (const void*)fwd_kernel, NWAVES * 64, LDS_BYTES) != hipSuccess || per_cu < 1)
            fprintf(stderr, "kernel_launch: note: occupancy query reports %d workgroups per CU\n", per_cu);
        (void)hipGetLastError();
        grid = cus;
    }
    if (grid < 0) return;
    (void)hipMemsetAsync((char*)d_ws + WS_CTL, 0, CTL_ZERO_BYTES, stream);
    Args a{};
    for (int i = 0; i < 17; ++i) a.in[i] = (const float*)d_in[i];
    a.out = (float*)d_out; a.ws = (unsigned char*)d_ws;
#if MK_N_LAUNCHES == 1
    a.ph_lo = 0; a.ph_hi = NPHASE + 1; a.li = 0;
    hipLaunchKernelGGL(fwd_kernel, dim3(grid), dim3(NWAVES * 64), LDS_BYTES, stream, a);
#else
    for (int li = 0; li <= NPHASE; ++li) { a.ph_lo = li; a.ph_hi = li + 1; a.li = li;
        hipLaunchKernelGGL(fwd_kernel, dim3(grid), dim3(NWAVES * 64), LDS_BYTES, stream, a); }
#endif
    const hipError_t le = hipPeekAtLastError();
    if (le != hipSuccess) fprintf(stderr, "kernel_launch: launch failed: %s\n", hipGetErrorName(le));
}
```

```cpp
#include <hip/hip_runtime.h>
#include <cstdio>
#include <cstdint>

#ifndef MK_N_LAUNCHES
#define MK_N_LAUNCHES 1
#endif
#ifndef DBG_LEVEL
#define DBG_LEVEL 4
#endif

#ifndef REP_PHASE
#define REP_PHASE -1
#endif
#define REPS(k) ((REP_PHASE == (k)) ? 2 : 1)
#define GAS __attribute__((address_space(1)))
#define LAS __attribute__((address_space(3)))
typedef unsigned short bf16_t;
typedef short bf16x8 __attribute__((ext_vector_type(8)));
typedef short s16x4 __attribute__((ext_vector_type(4)));
typedef float f32x2 __attribute__((ext_vector_type(2)));
typedef float f32x4 __attribute__((ext_vector_type(4)));
typedef float f32x8 __attribute__((ext_vector_type(8)));
typedef float f32x16 __attribute__((ext_vector_type(16)));
typedef unsigned u32x2 __attribute__((ext_vector_type(2)));
typedef unsigned u32x4 __attribute__((ext_vector_type(4)));
typedef GAS unsigned gu32;

constexpr int BATCH = 4, SEQ = 8192, DM = 2048, NTOK = BATCH * SEQ, HD = 128;
constexpr int NHA = 8, NHB = 8;
constexpr int QW = 1024, KVW = 256, INW = 7168;
constexpr int NEXP = 16, CAP = 1024, DFF = 1024, NLIST = BATCH * NEXP, NSLOT = NLIST * CAP;
constexpr float EPS = 1e-6f, LOG2E = 1.4426950408889634f;

constexpr size_t MiB = 1u << 20;
constexpr size_t WS_CTL = 0, CTL_ZERO_BYTES = 1 * MiB;
constexpr size_t WS_ROPE = 1 * MiB;
constexpr size_t WS_AFF = 2 * MiB;
constexpr size_t WS_IDX = 4 * MiB;
constexpr size_t WS_GATEV = 4 * MiB + 256 * 1024;
constexpr size_t WS_INV = 5 * MiB;
constexpr size_t WS_WIN = 8 * MiB;
constexpr size_t WS_WPA = 36 * MiB;
constexpr size_t WS_WPB = 40 * MiB;
constexpr size_t WS_WO = 44 * MiB;
constexpr size_t WS_WGU = 52 * MiB;
constexpr size_t WS_WD = 180 * MiB;
constexpr size_t WS_H = 244 * MiB;
constexpr size_t WS_GA = 372 * MiB;
constexpr size_t WS_GB = 500 * MiB;
constexpr size_t WS_QA = 628 * MiB, WS_KA = 692 * MiB, WS_VA = 708 * MiB, WS_QB = 724 * MiB, WS_KB = 788 * MiB, WS_VB = 804 * MiB;
constexpr size_t WS_Y = 500 * MiB;
constexpr size_t WS_OA = 820 * MiB, WS_OB = 884 * MiB;
constexpr size_t WS_ATT = 820 * MiB;
constexpr size_t WS_K8 = 948 * MiB;
constexpr size_t WS_V8T = 956 * MiB;
constexpr size_t WS_H8 = 820 * MiB;
constexpr size_t WS_WIN8 = 964 * MiB;
constexpr size_t WS_WPA8 = 978 * MiB, WS_WPB8 = 980 * MiB;
constexpr size_t WS_WO8 = 982 * MiB;
constexpr size_t WS_WD8 = 986 * MiB;
constexpr size_t WS_END = 1018 * MiB;
constexpr size_t WS_OA8 = 820 * MiB, WS_OB8 = 884 * MiB;
constexpr size_t WS_GA8 = WS_GA, WS_M18 = WS_GA + 64 * MiB, WS_GB8 = WS_GB;
constexpr size_t WS_M8 = 244 * MiB;
constexpr float OB8S = 8.f, M8S = 16.f, GATE8S = 256.f;
constexpr size_t WS_X1B = 116 * MiB;
constexpr float ATT8S = 16.f;
constexpr float W8S = 32.f, OA8S = 64.f;
constexpr int CW_TMO = 0;
constexpr int CW_BAR = 4096;

constexpr int LDS_SCRATCH = 155648;
constexpr int LDSCTL_OFF = LDS_SCRATCH;
constexpr int LDS_BYTES = LDS_SCRATCH + 512;

typedef __bf16 v32bf_t __attribute__((ext_vector_type(32)));
typedef unsigned v6u_t __attribute__((ext_vector_type(6)));
__device__ __forceinline__ unsigned cvt_pk_bf16(float lo, float hi) { unsigned r; asm volatile("v_cvt_pk_bf16_f32 %0, %1, %2" : "=v"(r) : "v"(lo), "v"(hi)); return r; }
__device__ __forceinline__ float bf2f(unsigned short v) { return __uint_as_float(((unsigned)v) << 16); }
__device__ __forceinline__ unsigned short f2bf(float f) { return (unsigned short)(cvt_pk_bf16(f, 0.f) & 0xffffu); }
__device__ __forceinline__ float wave_sum(float v) {
#pragma unroll
    for (int o = 1; o < 64; o <<= 1) v += __shfl_xor(v, o);
    return v;
}
__device__ __forceinline__ float sigmoidf_fast(float z) { return __builtin_amdgcn_rcpf(1.f + __builtin_amdgcn_exp2f(-z * LOG2E)); }
#define LDS_WAIT() asm volatile("s_waitcnt lgkmcnt(0)" ::: "memory")
#define VM_WAIT() asm volatile("s_waitcnt vmcnt(0)" ::: "memory")

namespace pg8 {
constexpr int BM = 256, BK = 64, HALF = 128, HTB = HALF * BK * 2, STAGE_BYTES = 8 * HTB;
__host__ __device__ __forceinline__ int lds_byte(int r, int c) { const int st = (r >> 4) * 2 + (c >> 5), rr = r & 15, cc = c & 31, ob = rr * 64 + cc * 2; return st * 1024 + (ob ^ (((ob >> 9) & 1) << 5)); }
__host__ __device__ __forceinline__ void stage_rc(int b, int& R, int& C) { const int st = b / 1024, sb = b % 1024, swz = sb ^ (((sb >> 9) & 1) << 5); R = (st >> 1) * 16 + swz / 64; C = (st & 1) * 32 + (swz % 64) / 2; }
__host__ __device__ __forceinline__ int perm32(int rho) { const int n = rho >> 4, i = rho & 15; return 8 * (i >> 2) + 4 * n + (i & 3); }

struct Unit { int pm, pn, ord; };

struct StaticOrder {
    int nM, nN, nwg, G, c;
    __device__ void init(int M, int N, int G_, int c_) { nM = M / BM; nN = N / BM; nwg = nM * nN; G = G_; c = c_; }
    __device__ bool next(int i, Unit& u) const {
        const long L = (long)i * G + c; if (L >= nwg) return false;
        int wgid = (int)L; { const int q = nwg / 8, r = nwg % 8, xcd = wgid % 8, off = wgid / 8; wgid = (xcd < r ? xcd * (q + 1) : r * (q + 1) + (xcd - r) * q) + off; }
        const int nig = 8 * nN, gid = wgid / nig, fm = gid * 8, gsz = (nM - fm) < 8 ? (nM - fm) : 8;
        u.pm = fm + ((wgid % nig) % gsz); u.pn = (wgid % nig) / gsz; u.ord = i; return true;
    }
};

template <class Epi, class Prob, bool ALIGN_EPI>
__device__ __forceinline__ void gemm_phase(LAS unsigned char* lds, const Prob& P, const Epi& E) {
    int tid = threadIdx.x; asm volatile("" : "+v"(tid));
    const int wid = __builtin_amdgcn_readfirstlane(tid >> 6), lane = tid & 63, wr = wid >> 2, wc = wid & 3, fr = lane & 15, fq = lane >> 4;
    constexpr int K = Prob::K, nt = K / BK;
    int Rs[2], Cs[2]; unsigned voffB[2];
#pragma unroll
    for (int i = 0; i < 2; ++i) { int R, C; stage_rc(tid * 16 + i * 8192, R, C); const int Rb = Epi::PERM ? ((R & ~31) + perm32(R & 31)) : R;
        Rs[i] = R; Cs[i] = C; voffB[i] = (unsigned)(Rb * K + C) * 2u; }
    constexpr size_t kstep = (size_t)(BK * 2);
    constexpr size_t hstepB = (size_t)HALF * K * 2;
    const unsigned ldsw = (unsigned)wid * 1024u;
    const int aoff = lds_byte(wr * 64 + fr, fq * 8), boff = lds_byte(wc * 32 + fr, fq * 8);
#define PG8_SA(b, h) (((b) * 2 + (h)) * HTB)
#define PG8_SB(b, h) ((4 + (b) * 2 + (h)) * HTB)
#define PG8_STAGE(bufoff, gbase, voff) do { _Pragma("unroll") for (int _i = 0; _i < 2; ++_i) \
        __builtin_amdgcn_global_load_lds((const unsigned*)((const char*)(gbase) + (voff)[_i]), (LAS unsigned*)(lds + (bufoff) + ldsw + _i * 8192), 16, 0, 0); } while (0)
#define PG8_LDA(dst, b, h) do { _Pragma("unroll") for (int m = 0; m < 4; ++m) _Pragma("unroll") for (int k = 0; k < 2; ++k) dst[m][k] = *(const LAS bf16x8*)(lds + PG8_SA(b, h) + aoff + m * 2048 + k * 1024); } while (0)
#define PG8_LDB(dst, b, h) do { _Pragma("unroll") for (int n = 0; n < 2; ++n) _Pragma("unroll") for (int k = 0; k < 2; ++k) dst[n][k] = *(const LAS bf16x8*)(lds + PG8_SB(b, h) + boff + n * 2048 + k * 1024); } while (0)
#define PG8_MMA(ai, bj, At, Bt) do { __builtin_amdgcn_s_setprio(1); _Pragma("unroll") for (int m = 0; m < 4; ++m) _Pragma("unroll") for (int n = 0; n < 2; ++n) _Pragma("unroll") for (int k = 0; k < 2; ++k) \
        acc[ai][bj][m][n] = __builtin_amdgcn_mfma_f32_16x16x32_bf16(Bt[n][k], At[m][k], acc[ai][bj][m][n], 0, 0, 0); __builtin_amdgcn_s_setprio(0); } while (0)
#define PG8_WAIT_V(n) asm volatile("s_waitcnt vmcnt(" #n ")" ::: "memory")
#define PG8_WAIT_L(n) asm volatile("s_waitcnt lgkmcnt(" #n ")" ::: "memory")
#define PG8_BAR __builtin_amdgcn_s_barrier()
#define PG8_SCHED __builtin_amdgcn_sched_barrier(0)
    Unit cur, nxt; int ui = 0;
    if (!P.next(0, cur)) return;
    unsigned vAc[2][2], vAn[2][2];
    P.a_voff(cur, Rs, Cs, vAc);
    f32x4 acc[2][2][4][2];
#pragma unroll
    for (int a = 0; a < 2; ++a)
#pragma unroll
        for (int b = 0; b < 2; ++b)
#pragma unroll
            for (int m = 0; m < 4; ++m)
#pragma unroll
                for (int n = 0; n < 2; ++n) acc[a][b][m][n] = (f32x4){0.f, 0.f, 0.f, 0.f};
    bf16x8 At[4][2], B0[2][2], B1[2][2];
    const char* cA = P.a_base(cur); const char* cB = P.b_base(cur);
    PG8_STAGE(PG8_SB(0, 0), cB, voffB); PG8_STAGE(PG8_SB(0, 1), cB + hstepB, voffB); PG8_STAGE(PG8_SA(0, 0), cA, vAc[0]); PG8_STAGE(PG8_SA(0, 1), cA, vAc[1]);
    if (wr == 1) PG8_BAR;
    PG8_WAIT_V(2); PG8_BAR;
    PG8_STAGE(PG8_SB(1, 0), cB + kstep, voffB); PG8_STAGE(PG8_SA(1, 0), cA + kstep, vAc[0]); PG8_STAGE(PG8_SB(1, 1), cB + hstepB + kstep, voffB);
    PG8_WAIT_V(6); PG8_BAR;
    for (;;) {
        const bool has_next = P.next(ui + 1, nxt);
        const char* nA = has_next ? P.a_base(nxt) : cA; const char* nB = has_next ? P.b_base(nxt) : cB;
        if constexpr (Prob::GATHER) { if (has_next) P.a_voff(nxt, Rs, Cs, vAn);
          else { vAn[0][0] = vAc[0][0]; vAn[0][1] = vAc[0][1]; vAn[1][0] = vAc[1][0]; vAn[1][1] = vAc[1][1]; } }
        for (int t = 0; t < nt; t += 2) {
            const bool last = (t == nt - 2);
            const char* a1 = cA + (size_t)(t + 1) * kstep;
            const char* a2 = last ? nA : cA + (size_t)(t + 2) * kstep; const char* b2 = last ? nB : cB + (size_t)(t + 2) * kstep;
            const char* a3 = a2 + kstep; const char* b3 = b2 + kstep;
            unsigned va2[2][2];
            if constexpr (Prob::GATHER) { va2[0][0] = last ? vAn[0][0] : vAc[0][0]; va2[0][1] = last ? vAn[0][1] : vAc[0][1]; va2[1][0] = last ? vAn[1][0] : vAc[1][0]; va2[1][1] = last ? vAn[1][1] : vAc[1][1]; }
            else { va2[0][0] = vAc[0][0]; va2[0][1] = vAc[0][1]; va2[1][0] = vAc[1][0]; va2[1][1] = vAc[1][1]; }
            PG8_LDB(B0, 0, 0); PG8_LDB(B1, 0, 1); PG8_SCHED; PG8_LDA(At, 0, 0); PG8_STAGE(PG8_SA(1, 1), a1, vAc[1]);
            PG8_WAIT_V(8); PG8_WAIT_L(0); PG8_BAR; PG8_MMA(0, 0, At, B0); PG8_MMA(0, 1, At, B1); PG8_BAR; PG8_SCHED;
            PG8_LDA(At, 0, 1); PG8_STAGE(PG8_SB(0, 0), b2, voffB); PG8_STAGE(PG8_SB(0, 1), b2 + hstepB, voffB); PG8_STAGE(PG8_SA(0, 0), a2, va2[0]);
            PG8_WAIT_V(8); PG8_WAIT_L(0); PG8_BAR; PG8_MMA(1, 0, At, B0); PG8_MMA(1, 1, At, B1); PG8_BAR; PG8_SCHED;
            PG8_LDB(B0, 1, 0); PG8_LDB(B1, 1, 1); PG8_SCHED; PG8_LDA(At, 1, 0); PG8_STAGE(PG8_SA(0, 1), a2, va2[1]);
            PG8_WAIT_V(8); PG8_WAIT_L(0); PG8_BAR; PG8_MMA(0, 0, At, B0); PG8_MMA(0, 1, At, B1); PG8_BAR; PG8_SCHED;
            PG8_LDA(At, 1, 1); PG8_STAGE(PG8_SB(1, 0), b3, voffB); PG8_STAGE(PG8_SB(1, 1), b3 + hstepB, voffB); PG8_STAGE(PG8_SA(1, 0), a3, va2[0]);
            PG8_WAIT_V(8); PG8_WAIT_L(0); PG8_BAR; PG8_MMA(1, 0, At, B0); PG8_MMA(1, 1, At, B1); PG8_BAR; PG8_SCHED;
        }
        if constexpr (ALIGN_EPI) { if (wr == 0) PG8_BAR; }
        E(acc, cur, wr, wc, fr, fq);
        if (!has_next) break;
#pragma unroll
        for (int a = 0; a < 2; ++a)
#pragma unroll
            for (int b = 0; b < 2; ++b)
#pragma unroll
                for (int m = 0; m < 4; ++m)
#pragma unroll
                    for (int n = 0; n < 2; ++n) acc[a][b][m][n] = (f32x4){0.f, 0.f, 0.f, 0.f};
        cur = nxt; cA = nA; cB = nB; ++ui;
        if constexpr (Prob::GATHER) { vAc[0][0] = vAn[0][0]; vAc[0][1] = vAn[0][1]; vAc[1][0] = vAn[1][0]; vAc[1][1] = vAn[1][1]; }
        if constexpr (ALIGN_EPI) { if (wr == 1) PG8_BAR; }
    }
    PG8_WAIT_V(0);
    if constexpr (!ALIGN_EPI) { if (wr == 0) PG8_BAR; }
    PG8_BAR;
#undef PG8_SA
#undef PG8_SB
#undef PG8_STAGE
#undef PG8_LDA
#undef PG8_LDB
#undef PG8_MMA
#undef PG8_WAIT_V
#undef PG8_WAIT_L
#undef PG8_BAR
#undef PG8_SCHED
}
typedef int v8i_g __attribute__((ext_vector_type(8)));
__device__ __forceinline__ void glds_saddr(const void* sbase, unsigned voff, unsigned lds_dst) { unsigned keep;
    asm volatile("s_mov_b32 %0, m0\n\ts_mov_b32 m0, %3\n\ts_nop 0\n\tglobal_load_lds_dwordx4 %2, %1\n\ts_mov_b32 m0, %0" : "=&s"(keep) : "s"(sbase), "v"(voff), "s"(lds_dst) : "memory"); }
template <class Epi, class Prob, bool ALIGN_EPI>
__device__ __forceinline__ void gemm_phase8(LAS unsigned char* lds, const Prob& P, const Epi& E) {
    int tid = threadIdx.x; asm volatile("" : "+v"(tid));
    const int wid = __builtin_amdgcn_readfirstlane(tid >> 6), lane = tid & 63, wr = wid >> 2, wc = wid & 3, fr = lane & 15, fq = lane >> 4;
    constexpr int K = Prob::K, nt = K / 128;
    int Rs[2], Cs[2]; unsigned voffB[2];
#pragma unroll
    for (int i = 0; i < 2; ++i) { int R, C; stage_rc(tid * 16 + i * 8192, R, C); const int Rb = Epi::PERM ? ((R & ~31) + perm32(R & 31)) : R;
        Rs[i] = R; Cs[i] = C; voffB[i] = (unsigned)(Rb * K + C * 2); }
    constexpr size_t kstep = (size_t)128;
    constexpr size_t hstepB = (size_t)HALF * K, hstepA = (size_t)HALF * K;
    const unsigned ldsw = (unsigned)wid * 1024u; const unsigned lds0 = (unsigned)__builtin_amdgcn_readfirstlane((int)(uintptr_t)lds);
    const int aoff = lds_byte(wr * 64 + fr, fq * 16), boff = lds_byte(wc * 32 + fr, fq * 16);
#define PG8_SA(b, h) (((b) * 2 + (h)) * HTB)
#define PG8_SB(b, h) ((4 + (b) * 2 + (h)) * HTB)
#define PG8_STAGE(bufoff, gbase, voff) do { _Pragma("unroll") for (int _i = 0; _i < 2; ++_i) glds_saddr((const void*)(gbase), (voff)[_i], lds0 + (unsigned)((bufoff) + _i * 8192) + ldsw); } while (0)
#define PG8_STAGE_A1(bufoff, gbase, vo) do { if constexpr (Prob::GATHER) { PG8_STAGE(bufoff, gbase, (vo)[1]); } else { PG8_STAGE(bufoff, (gbase) + hstepA, (vo)[0]); } } while (0)
#define PG8_LDA(dst, b, h) do { _Pragma("unroll") for (int m = 0; m < 4; ++m) dst[m] = *(const LAS v8i_g*)(lds + PG8_SA(b, h) + aoff + m * 2048); } while (0)
#define PG8_LDB(dst, b, h) do { _Pragma("unroll") for (int n = 0; n < 2; ++n) dst[n] = *(const LAS v8i_g*)(lds + PG8_SB(b, h) + boff + n * 2048); } while (0)
#define PG8_MMA(ai, bj, At, Bt) do { __builtin_amdgcn_s_setprio(1); _Pragma("unroll") for (int m = 0; m < 4; ++m) _Pragma("unroll") for (int n = 0; n < 2; ++n) \
        acc[ai][bj][m][n] = __builtin_amdgcn_mfma_scale_f32_16x16x128_f8f6f4(Bt[n], At[m], acc[ai][bj][m][n], 0, 0, 0, 0, 0, 0); __builtin_amdgcn_s_setprio(0); } while (0)
#define PG8_WAIT_V(n) asm volatile("s_waitcnt vmcnt(" #n ")" ::: "memory")
#define PG8_WAIT_L(n) asm volatile("s_waitcnt lgkmcnt(" #n ")" ::: "memory")
#define PG8_BAR __builtin_amdgcn_s_barrier()
#define PG8_SCHED __builtin_amdgcn_sched_barrier(0)
    Unit cur, nxt; int ui = 0;
    if (!P.next(0, cur)) return;
    unsigned vAc[2][2];
    P.a_voff(cur, Rs, Cs, vAc);
    f32x4 acc[2][2][4][2];
#pragma unroll
    for (int a = 0; a < 2; ++a)
#pragma unroll
        for (int b = 0; b < 2; ++b)
#pragma unroll
            for (int m = 0; m < 4; ++m)
#pragma unroll
                for (int n = 0; n < 2; ++n) acc[a][b][m][n] = (f32x4){0.f, 0.f, 0.f, 0.f};
    v8i_g At[4], B0[2], B1[2];
    const char* cA = P.a_base(cur); const char* cB = P.b_base(cur);
    PG8_STAGE(PG8_SB(0, 0), cB, voffB); PG8_STAGE(PG8_SB(0, 1), cB + hstepB, voffB); PG8_STAGE(PG8_SA(0, 0), cA, vAc[0]); PG8_STAGE_A1(PG8_SA(0, 1), cA, vAc);
    if (wr == 1) PG8_BAR;
    PG8_WAIT_V(2); PG8_BAR;
    PG8_STAGE(PG8_SB(1, 0), cB + kstep, voffB); PG8_STAGE(PG8_SA(1, 0), cA + kstep, vAc[0]); PG8_STAGE(PG8_SB(1, 1), cB + hstepB + kstep, voffB);
    PG8_WAIT_V(6); PG8_BAR;
    for (;;) {
        const bool has_next = P.next(ui + 1, nxt);
        const char* nA = has_next ? P.a_base(nxt) : cA; const char* nB = has_next ? P.b_base(nxt) : cB;
        unsigned va2[2][2];
#pragma nounroll
        for (int t = 0; t < nt; t += 2) {
            const bool last = (t == nt - 2);
            const char* a1 = cA + (size_t)(t + 1) * kstep;
            const char* a2 = last ? nA : cA + (size_t)(t + 2) * kstep; const char* b2 = last ? nB : cB + (size_t)(t + 2) * kstep;
            const char* a3 = a2 + kstep; const char* b3 = b2 + kstep;
            va2[0][0] = vAc[0][0]; va2[0][1] = vAc[0][1]; va2[1][0] = vAc[1][0]; va2[1][1] = vAc[1][1];
            if constexpr (Prob::GATHER) { if (last && has_next) { int Rn[2], Cn[2];
                int t2_ = tid; asm volatile("" : "+v"(t2_));
#pragma unroll
                for (int i = 0; i < 2; ++i) stage_rc(t2_ * 16 + i * 8192, Rn[i], Cn[i]);
                P.a_voff(nxt, Rn, Cn, va2); } }
            PG8_LDB(B0, 0, 0); PG8_LDB(B1, 0, 1); PG8_SCHED; PG8_LDA(At, 0, 0); PG8_STAGE_A1(PG8_SA(1, 1), a1, vAc);
            PG8_WAIT_V(8); PG8_WAIT_L(0); PG8_BAR; PG8_MMA(0, 0, At, B0); PG8_MMA(0, 1, At, B1); PG8_BAR; PG8_SCHED;
            PG8_LDA(At, 0, 1); PG8_STAGE(PG8_SB(0, 0), b2, voffB); PG8_STAGE(PG8_SB(0, 1), b2 + hstepB, voffB); PG8_STAGE(PG8_SA(0, 0), a2, va2[0]);
            PG8_WAIT_V(8); PG8_WAIT_L(0); PG8_BAR; PG8_MMA(1, 0, At, B0); PG8_MMA(1, 1, At, B1); PG8_BAR; PG8_SCHED;
            PG8_LDB(B0, 1, 0); PG8_LDB(B1, 1, 1); PG8_SCHED; PG8_LDA(At, 1, 0); PG8_STAGE_A1(PG8_SA(0, 1), a2, va2);
            PG8_WAIT_V(8); PG8_WAIT_L(0); PG8_BAR; PG8_MMA(0, 0, At, B0); PG8_MMA(0, 1, At, B1); PG8_BAR; PG8_SCHED;
            PG8_LDA(At, 1, 1); PG8_STAGE(PG8_SB(1, 0), b3, voffB); PG8_STAGE(PG8_SB(1, 1), b3 + hstepB, voffB); PG8_STAGE(PG8_SA(1, 0), a3, va2[0]);
            PG8_WAIT_V(8); PG8_WAIT_L(0); PG8_BAR; PG8_MMA(1, 0, At, B0); PG8_MMA(1, 1, At, B1); PG8_BAR; PG8_SCHED;
        }
        if constexpr (ALIGN_EPI) { if (wr == 0) PG8_BAR; }
        { int t3_ = tid; asm volatile("" : "+v"(t3_)); const int l3_ = t3_ & 63;
          E(acc, cur, wr, wc, l3_ & 15, l3_ >> 4); }
        if (!has_next) break;
#pragma unroll
        for (int a = 0; a < 2; ++a)
#pragma unroll
            for (int b = 0; b < 2; ++b)
#pragma unroll
                for (int m = 0; m < 4; ++m)
#pragma unroll
                    for (int n = 0; n < 2; ++n) acc[a][b][m][n] = (f32x4){0.f, 0.f, 0.f, 0.f};
        cur = nxt; cA = nA; cB = nB; ++ui;
        if constexpr (Prob::GATHER) { vAc[0][0] = va2[0][0]; vAc[0][1] = va2[0][1]; vAc[1][0] = va2[1][0]; vAc[1][1] = va2[1][1]; }
        if constexpr (ALIGN_EPI) { if (wr == 1) PG8_BAR; }
    }
    PG8_WAIT_V(0);
    if constexpr (!ALIGN_EPI) { if (wr == 0) PG8_BAR; }
    PG8_BAR;
#undef PG8_SA
#undef PG8_SB
#undef PG8_STAGE
#undef PG8_STAGE_A1
#undef PG8_LDA
#undef PG8_LDB
#undef PG8_MMA
#undef PG8_WAIT_V
#undef PG8_WAIT_L
#undef PG8_BAR
#undef PG8_SCHED
}

template <int K_> struct DenseProb {
    static constexpr int K = K_; static constexpr bool GATHER = false;
    const bf16_t* A; const bf16_t* Bt; StaticOrder S;
    __device__ __forceinline__ bool next(int i, Unit& u) const { return S.next(i, u); }
    __device__ __forceinline__ const char* a_base(const Unit& u) const { return (const char*)(A + (size_t)u.pm * BM * K); }
    __device__ __forceinline__ const char* b_base(const Unit& u) const { return (const char*)(Bt + (size_t)u.pn * BM * K); }
    __device__ __forceinline__ void a_voff(const Unit&, const int (&Rs)[2], const int (&Cs)[2], unsigned (&vo)[2][2]) const {
#pragma unroll
        for (int h = 0; h < 2; ++h)
#pragma unroll
            for (int i = 0; i < 2; ++i) vo[h][i] = (unsigned)((h * HALF + Rs[i]) * K + Cs[i]) * 2u;
    }
};
template <int K_, int PMAP, int EB> struct MapProb {
    static constexpr int K = K_; static constexpr bool GATHER = false;
    const unsigned char* A; const unsigned char* Bt; StaticOrder S;
    __device__ __forceinline__ bool next(int i, Unit& u) const { const bool ok = S.next(i, u); if (PMAP == 1) u.pn = u.pn < 6 ? u.pn : u.pn + 6; if (PMAP == 2) u.pn += 6; return ok; }
    __device__ __forceinline__ const char* a_base(const Unit& u) const { return (const char*)(A + (size_t)u.pm * BM * K * EB); }
    __device__ __forceinline__ const char* b_base(const Unit& u) const { return (const char*)(Bt + (size_t)u.pn * BM * K * EB); }
    __device__ __forceinline__ void a_voff(const Unit&, const int (&Rs)[2], const int (&Cs)[2], unsigned (&vo)[2][2]) const {
#pragma unroll
        for (int h = 0; h < 2; ++h)
#pragma unroll
            for (int i = 0; i < 2; ++i) vo[h][i] = (unsigned)((h * HALF + Rs[i]) * K * EB + Cs[i] * 2);
    }
};
__device__ __forceinline__ bool moe_unit(int i, int G, int vcu, Unit& u, int& e, int& b) {
    const int L = i * G + vcu; if (L >= 2048) return false;
    const int x = (L & 255) >> 5, w = L & 31, r = L >> 8;
    e = 2 * x + (r >> 2); b = r & 3; u.pm = (b * NEXP + e) * 4 + (w >> 3); u.pn = w & 7; u.ord = i; return true;
}
struct GuProb {
    static constexpr int K = DM; static constexpr bool GATHER = true;
    const bf16_t* H2; const bf16_t* W; const LAS unsigned* rowoff; int G, vcu;
    __device__ __forceinline__ bool next(int i, Unit& u) const { int e, b; return moe_unit(i, G, vcu, u, e, b); }
    __device__ __forceinline__ const char* a_base(const Unit& u) const { const int b = (u.pm >> 2) / NEXP; return (const char*)(H2 + (size_t)b * SEQ * DM); }
    __device__ __forceinline__ const char* b_base(const Unit& u) const { const int e = (u.pm >> 2) % NEXP; return (const char*)(W + ((size_t)e * 2048 + (size_t)u.pn * BM) * DM); }
    __device__ __forceinline__ void a_voff(const Unit& u, const int (&Rs)[2], const int (&Cs)[2], unsigned (&vo)[2][2]) const {
#pragma unroll
        for (int h = 0; h < 2; ++h)
#pragma unroll
            for (int i = 0; i < 2; ++i) vo[h][i] = rowoff[u.ord * 256 + h * HALF + Rs[i]] + (unsigned)Cs[i] * 2u;
    }
};
struct DownProb {
    static constexpr int K = DFF; static constexpr bool GATHER = false;
    const bf16_t* HID; const bf16_t* W; int G, vcu;
    __device__ __forceinline__ bool next(int i, Unit& u) const { int e, b; return moe_unit(i, G, vcu, u, e, b); }
    __device__ __forceinline__ const char* a_base(const Unit& u) const { return (const char*)(HID + (size_t)u.pm * BM * DFF); }
    __device__ __forceinline__ const char* b_base(const Unit& u) const { const int e = (u.pm >> 2) % NEXP; return (const char*)(W + ((size_t)e * 2048 + (size_t)u.pn * BM) * DFF); }
    __device__ __forceinline__ void a_voff(const Unit&, const int (&Rs)[2], const int (&Cs)[2], unsigned (&vo)[2][2]) const {
#pragma unroll
        for (int h = 0; h < 2; ++h)
#pragma unroll
            for (int i = 0; i < 2; ++i) vo[h][i] = (unsigned)((h * HALF + Rs[i]) * DFF + Cs[i]) * 2u;
    }
};

struct GuProb8 {
    static constexpr int K = DM; static constexpr bool GATHER = true;
    const unsigned char* H2; const unsigned char* W; const LAS unsigned* rowoff; int G, vcu;
    __device__ __forceinline__ bool next(int i, Unit& u) const { int e, b; return moe_unit(i, G, vcu, u, e, b); }
    __device__ __forceinline__ const char* a_base(const Unit& u) const { const int b = (u.pm >> 2) / NEXP; return (const char*)(H2 + (size_t)b * SEQ * DM); }
    __device__ __forceinline__ const char* b_base(const Unit& u) const { const int e = (u.pm >> 2) % NEXP; return (const char*)(W + ((size_t)e * 2048 + (size_t)u.pn * BM) * DM); }
    __device__ __forceinline__ void a_voff(const Unit& u, const int (&Rs)[2], const int (&Cs)[2], unsigned (&vo)[2][2]) const {
#pragma unroll
        for (int h = 0; h < 2; ++h)
#pragma unroll
            for (int i = 0; i < 2; ++i) vo[h][i] = rowoff[u.ord * 256 + h * HALF + Rs[i]] + (unsigned)Cs[i] * 2u;
    }
};
struct DownProb8 {
    static constexpr int K = DFF; static constexpr bool GATHER = false;
    const unsigned char* HID; const unsigned char* W; int G, vcu;
    __device__ __forceinline__ bool next(int i, Unit& u) const { int e, b; return moe_unit(i, G, vcu, u, e, b); }
    __device__ __forceinline__ const char* a_base(const Unit& u) const { return (const char*)(HID + (size_t)u.pm * BM * DFF); }
    __device__ __forceinline__ const char* b_base(const Unit& u) const { const int e = (u.pm >> 2) % NEXP; return (const char*)(W + ((size_t)e * 2048 + (size_t)u.pn * BM) * DFF); }
    __device__ __forceinline__ void a_voff(const Unit&, const int (&Rs)[2], const int (&Cs)[2], unsigned (&vo)[2][2]) const {
#pragma unroll
        for (int h = 0; h < 2; ++h)
#pragma unroll
            for (int i = 0; i < 2; ++i) vo[h][i] = (unsigned)((h * HALF + Rs[i]) * DFF + Cs[i] * 2);
    }
};
typedef const f32x4 (&AccRef)[2][2][4][2];
struct EpiInProj {
    static constexpr bool PERM = true;
    bf16_t *QA, *KA, *VA, *QB, *KB, *VB, *GA, *GB; const float* bgate; float oscale;
    __device__ __forceinline__ void operator()(AccRef acc, const Unit& u, int wr, int wc, int fr, int fq) const {
        const int pn = u.pn; bf16_t* base; int ldc, colt; bool gate = false;
        if (pn < 4) { base = QA; ldc = QW; colt = pn * 256; }
        else if (pn == 4) { base = KA; ldc = KVW; colt = 0; }
        else if (pn == 5) { base = VA; ldc = KVW; colt = 0; }
        else if (pn < 10) { base = QB; ldc = QW; colt = (pn - 6) * 256; }
        else if (pn == 10) { base = KB; ldc = KVW; colt = 0; }
        else if (pn == 11) { base = VB; ldc = KVW; colt = 0; }
        else if (pn < 20) { base = GA; ldc = DM; colt = (pn - 12) * 256; gate = true; }
        else { base = GB; ldc = DM; colt = (pn - 20) * 256; gate = true; }
        const int row0 = u.pm * BM + wr * 64 + fr, col0 = colt + wc * 32 + 8 * fq;
        f32x4 bv[2][2];
#pragma unroll
        for (int bj = 0; bj < 2; ++bj)
#pragma unroll
            for (int n = 0; n < 2; ++n) bv[bj][n] = gate ? *(const f32x4*)(bgate + (pn - 12) * 256 + wc * 32 + 8 * fq + bj * HALF + 4 * n) : (f32x4){0.f, 0.f, 0.f, 0.f};
#pragma unroll
        for (int ai = 0; ai < 2; ++ai)
#pragma unroll
            for (int m = 0; m < 4; ++m) { bf16_t* rowp = base + (size_t)(row0 + ai * HALF + m * 16) * ldc + col0;
#pragma unroll
                for (int bj = 0; bj < 2; ++bj) { f32x4 v0 = acc[ai][bj][m][0] * oscale + bv[bj][0], v1 = acc[ai][bj][m][1] * oscale + bv[bj][1];
                    if (gate) {
#pragma unroll
                        for (int j = 0; j < 4; ++j) { v0[j] = sigmoidf_fast(v0[j]) * GATE8S; v1[j] = sigmoidf_fast(v1[j]) * GATE8S; }
                        int w0 = 0, w1 = 0; w0 = __builtin_amdgcn_cvt_pk_fp8_f32(v0[0], v0[1], w0, false); w0 = __builtin_amdgcn_cvt_pk_fp8_f32(v0[2], v0[3], w0, true);
                        w1 = __builtin_amdgcn_cvt_pk_fp8_f32(v1[0], v1[1], w1, false); w1 = __builtin_amdgcn_cvt_pk_fp8_f32(v1[2], v1[3], w1, true);
                        *(u32x2*)((unsigned char*)base + (size_t)(row0 + ai * HALF + m * 16) * DM + col0 + bj * HALF) = (u32x2){(unsigned)w0, (unsigned)w1};
                    } else {
                    u32x4 w; w.x = cvt_pk_bf16(v0[0], v0[1]); w.y = cvt_pk_bf16(v0[2], v0[3]); w.z = cvt_pk_bf16(v1[0], v1[1]); w.w = cvt_pk_bf16(v1[2], v1[3]);
                    *(u32x4*)(rowp + bj * HALF) = w; } } }
    }
};
template <int MODE> struct EpiGated {
    static constexpr bool PERM = true;
    bf16_t* G1; const bf16_t* G2; float oscale;
    __device__ __forceinline__ void operator()(AccRef acc, const Unit& u, int wr, int wc, int fr, int fq) const {
        const int row0 = u.pm * BM + wr * 64 + fr, col0 = u.pn * BM + wc * 32 + 8 * fq;
#pragma unroll
        for (int ai = 0; ai < 2; ++ai)
#pragma unroll
            for (int m = 0; m < 4; ++m) { const size_t off = (size_t)(row0 + ai * HALF + m * 16) * DM + col0;
#pragma unroll
                for (int bj = 0; bj < 2; ++bj) {
                    const bf16x8 g1 = (MODE == 2) ? (bf16x8){0, 0, 0, 0, 0, 0, 0, 0} : *(const bf16x8*)(G1 + off + bj * HALF);
                    bf16x8 g2 = g1; if (MODE >= 1) g2 = *(const bf16x8*)(G2 + off + bj * HALF);
                    float o[8];
#pragma unroll
                    for (int j = 0; j < 8; ++j) { const float a = acc[ai][bj][m][j >> 2][j & 3] * oscale;
                        if (MODE == 0) o[j] = bf2f((unsigned short)g1[j]) * a;
                        else if (MODE == 1) o[j] = bf2f((unsigned short)g1[j]) + bf2f((unsigned short)g2[j]) * a;
                        else o[j] = bf2f((unsigned short)g2[j]) * a; }
                    u32x4 w; w.x = cvt_pk_bf16(o[0], o[1]); w.y = cvt_pk_bf16(o[2], o[3]); w.z = cvt_pk_bf16(o[4], o[5]); w.w = cvt_pk_bf16(o[6], o[7]);
                    *(u32x4*)(G1 + off + bj * HALF) = w; } }
    }
};
template <int MODE> struct EpiGated8 {
    static constexpr bool PERM = true;
    const unsigned char* G8; const unsigned char* M1; unsigned char* OUT8; float oscale;
    __device__ __forceinline__ void operator()(AccRef acc, const Unit& u, int wr, int wc, int fr, int fq) const {
        const int row0 = u.pm * BM + wr * 64 + fr, col0 = u.pn * BM + wc * 32 + 8 * fq;
        u32x2 g[2][4][2], m1[2][4][2];
#pragma unroll
        for (int ai = 0; ai < 2; ++ai)
#pragma unroll
            for (int m = 0; m < 4; ++m)
#pragma unroll
                for (int bj = 0; bj < 2; ++bj) { const unsigned off = (unsigned)((row0 + ai * HALF + m * 16) * DM + col0) + bj * HALF; g[ai][m][bj] = *(const u32x2*)(G8 + off); if (MODE == 1) m1[ai][m][bj] = *(const u32x2*)(M1 + off); }
        const float gs = oscale * (M8S / GATE8S);
#pragma unroll
        for (int ai = 0; ai < 2; ++ai)
#pragma unroll
            for (int m = 0; m < 4; ++m)
#pragma unroll
                for (int bj = 0; bj < 2; ++bj) { const unsigned off = (unsigned)((row0 + ai * HALF + m * 16) * DM + col0) + bj * HALF; float o[8];
                    { const int gx = (int)g[ai][m][bj].x, gy = (int)g[ai][m][bj].y;
                      const auto g0 = __builtin_amdgcn_cvt_pk_f32_fp8(gx, false), g1 = __builtin_amdgcn_cvt_pk_f32_fp8(gx, true), g2 = __builtin_amdgcn_cvt_pk_f32_fp8(gy, false), g3 = __builtin_amdgcn_cvt_pk_f32_fp8(gy, true);
                      const f32x4 a0 = acc[ai][bj][m][0] * gs, a1 = acc[ai][bj][m][1] * gs;
                      o[0] = g0[0] * a0[0]; o[1] = g0[1] * a0[1]; o[2] = g1[0] * a0[2]; o[3] = g1[1] * a0[3]; o[4] = g2[0] * a1[0]; o[5] = g2[1] * a1[1]; o[6] = g3[0] * a1[2]; o[7] = g3[1] * a1[3];
                      if (MODE == 1) { const int mx = (int)m1[ai][m][bj].x, my = (int)m1[ai][m][bj].y;
                        const auto m0 = __builtin_amdgcn_cvt_pk_f32_fp8(mx, false), m1_ = __builtin_amdgcn_cvt_pk_f32_fp8(mx, true), m2 = __builtin_amdgcn_cvt_pk_f32_fp8(my, false), m3 = __builtin_amdgcn_cvt_pk_f32_fp8(my, true);
                        o[0] += m0[0]; o[1] += m0[1]; o[2] += m1_[0]; o[3] += m1_[1]; o[4] += m2[0]; o[5] += m2[1]; o[6] += m3[0]; o[7] += m3[1]; } }
                    int w0 = 0, w1 = 0; w0 = __builtin_amdgcn_cvt_pk_fp8_f32(o[0], o[1], w0, false); w0 = __builtin_amdgcn_cvt_pk_fp8_f32(o[2], o[3], w0, true);
                    w1 = __builtin_amdgcn_cvt_pk_fp8_f32(o[4], o[5], w1, false); w1 = __builtin_amdgcn_cvt_pk_fp8_f32(o[6], o[7], w1, true);
                    *(u32x2*)(OUT8 + off) = (u32x2){(unsigned)w0, (unsigned)w1}; }
    }
};
struct EpiAtt {
    static constexpr bool PERM = true;
    unsigned char* O; float oscale;
    __device__ __forceinline__ void operator()(AccRef acc, const Unit& u, int wr, int wc, int fr, int fq) const {
        const int row0 = u.pm * BM + wr * 64 + fr, col0 = u.pn * BM + wc * 32 + 8 * fq;
#pragma unroll
        for (int ai = 0; ai < 2; ++ai)
#pragma unroll
            for (int m = 0; m < 4; ++m) { unsigned char* rowp = O + (size_t)(row0 + ai * HALF + m * 16) * DM + col0;
#pragma unroll
                for (int bj = 0; bj < 2; ++bj) { const f32x4 v0 = acc[ai][bj][m][0] * oscale, v1 = acc[ai][bj][m][1] * oscale;
                    int w0 = 0, w1 = 0; w0 = __builtin_amdgcn_cvt_pk_fp8_f32(v0[0], v0[1], w0, false); w0 = __builtin_amdgcn_cvt_pk_fp8_f32(v0[2], v0[3], w0, true);
                    w1 = __builtin_amdgcn_cvt_pk_fp8_f32(v1[0], v1[1], w1, false); w1 = __builtin_amdgcn_cvt_pk_fp8_f32(v1[2], v1[3], w1, true);
                    *(u32x2*)(rowp + bj * HALF) = (u32x2){(unsigned)w0, (unsigned)w1}; } }
    }
};
struct EpiSwiglu {
    static constexpr bool PERM = true;
    unsigned char* HID; float oscale;
    __device__ __forceinline__ void operator()(AccRef acc, const Unit& u, int wr, int wc, int fr, int fq) const {
        const int row0 = u.pm * BM + wr * 64 + fr, col0 = u.pn * HALF + wc * 32 + 8 * fq;
#pragma unroll
        for (int ai = 0; ai < 2; ++ai)
#pragma unroll
            for (int m = 0; m < 4; ++m) { float o[8];
#pragma unroll
                for (int j = 0; j < 8; ++j) { const float a = acc[ai][0][m][j >> 2][j & 3] * oscale, up = acc[ai][1][m][j >> 2][j & 3] * oscale; o[j] = a * sigmoidf_fast(a) * up; }
                int w0 = 0, w1 = 0; w0 = __builtin_amdgcn_cvt_pk_fp8_f32(o[0], o[1], w0, false); w0 = __builtin_amdgcn_cvt_pk_fp8_f32(o[2], o[3], w0, true);
                w1 = __builtin_amdgcn_cvt_pk_fp8_f32(o[4], o[5], w1, false); w1 = __builtin_amdgcn_cvt_pk_fp8_f32(o[6], o[7], w1, true);
                *(u32x2*)(HID + (size_t)(row0 + ai * HALF + m * 16) * DFF + col0) = (u32x2){(unsigned)w0, (unsigned)w1}; }
    }
};
struct EpiDown {
    static constexpr bool PERM = true;
    bf16_t* Y; const float* gatev; float oscale;
    __device__ __forceinline__ void operator()(AccRef acc, const Unit& u, int wr, int wc, int fr, int fq) const {
        const int row0 = u.pm * BM + wr * 64 + fr, col0 = u.pn * BM + wc * 32 + 8 * fq;
#pragma unroll
        for (int ai = 0; ai < 2; ++ai)
#pragma unroll
            for (int m = 0; m < 4; ++m) { const int row = row0 + ai * HALF + m * 16; const float g = gatev[row] * oscale;
#pragma unroll
                for (int bj = 0; bj < 2; ++bj) { const f32x4 v0 = acc[ai][bj][m][0] * g, v1 = acc[ai][bj][m][1] * g;
                    u32x4 w; w.x = cvt_pk_bf16(v0[0], v0[1]); w.y = cvt_pk_bf16(v0[2], v0[3]); w.z = cvt_pk_bf16(v1[0], v1[1]); w.w = cvt_pk_bf16(v1[2], v1[3]);
                    *(u32x4*)(Y + (size_t)row * DM + col0 + bj * HALF) = w; } }
    }
};
}

namespace att {
constexpr int D = 128, NW = 8, QBLK = 32, KVBLK = 64;
constexpr float SCALE = 0.088388347648318440f, C = SCALE * LOG2E;
constexpr float THR = 8.f;
constexpr int LDQ = QW, LDK = KVW;
constexpr int SHM_V = KVBLK * D * 2, SHM_K = KVBLK * D * 2;
constexpr int BUFB = SHM_V + SHM_K, NBUF = 4;
constexpr int OFF_WS = NBUF * BUFB, OFF_TAB = OFF_WS + NW * 64 * 4, LDS_END = OFF_TAB + 4 * 768 * 4, OFF_OST = 0;
static_assert(LDS_END <= LDS_SCRATCH, "attention LDS");
#define KSWZ(row, colB) ((row) * 256 + ((colB) ^ (((row) & 7) << 4)))
#define SBAR() __builtin_amdgcn_sched_barrier(0)
__device__ __forceinline__ int crow(int r, int hi) { return (r & 3) + 8 * (r >> 2) + 4 * hi; }
__device__ __forceinline__ unsigned cvtpk(float lo, float hi) { unsigned r; asm volatile("v_cvt_pk_bf16_f32 %0, %1, %2" : "=v"(r) : "v"(lo), "v"(hi)); return r; }

__device__ __forceinline__ void partialSM(f32x16& p0, f32x16& p1, float& m_reg, float& mn, float& alpha) {
  float pmax = p0[0];
#pragma unroll
  for (int r = 1; r < 16; ++r) pmax = fmaxf(pmax, p0[r]);
#pragma unroll
  for (int r = 0; r < 16; ++r) pmax = fmaxf(pmax, p1[r]);
  { auto rr = __builtin_amdgcn_permlane32_swap(__float_as_uint(pmax), __float_as_uint(pmax), false, false);
    pmax = fmaxf(__uint_as_float(rr[0]), __uint_as_float(rr[1])); }
  if (__builtin_expect(__all(pmax - m_reg <= THR / SCALE), 1)) { mn = m_reg; alpha = 1.f; }
  else { mn = fmaxf(m_reg, pmax); alpha = __builtin_amdgcn_exp2f((m_reg - mn) * C); m_reg = mn; }
  float mnC = -mn * C;
#pragma unroll
  for (int r = 0; r < 16; ++r) p0[r] = fmaf(p0[r], C, mnC);
#pragma unroll
  for (int r = 0; r < 16; ++r) p1[r] = fmaf(p1[r], C, mnC);
#pragma unroll
  for (int r = 0; r < 16; ++r) p0[r] = __builtin_amdgcn_exp2f(p0[r]);
}
__device__ __forceinline__ void partialSM_B(f32x16& p0, f32x16& p1, float& m_reg, float& mn, float& alpha, const float* tb) {
#pragma unroll
  for (int r = 0; r < 16; ++r) { const int o = (r & 3) + 8 * (r >> 2); p0[r] = fmaf(p0[r], C, tb[o]); p1[r] = fmaf(p1[r], C, tb[32 + o]); }
  float pmax = p0[0];
#pragma unroll
  for (int r = 1; r < 16; ++r) pmax = fmaxf(pmax, p0[r]);
#pragma unroll
  for (int r = 0; r < 16; ++r) pmax = fmaxf(pmax, p1[r]);
  { auto rr = __builtin_amdgcn_permlane32_swap(__float_as_uint(pmax), __float_as_uint(pmax), false, false);
    pmax = fmaxf(__uint_as_float(rr[0]), __uint_as_float(rr[1])); }
  if (__builtin_expect(__all(pmax - m_reg <= THR * LOG2E), 1)) { mn = m_reg; alpha = 1.f; }
  else { mn = fmaxf(m_reg, pmax); alpha = __builtin_amdgcn_exp2f(m_reg - mn); m_reg = mn; }
#pragma unroll
  for (int r = 0; r < 16; ++r) p0[r] = p0[r] - mn;
#pragma unroll
  for (int r = 0; r < 16; ++r) p1[r] = p1[r] - mn;
#pragma unroll
  for (int r = 0; r < 16; ++r) p0[r] = __builtin_amdgcn_exp2f(p0[r]);
}
__device__ __forceinline__ void finishSM(f32x16& p0, f32x16& p1, float alpha, float& l_reg, bf16x8& pa0, bf16x8& pa1, bf16x8& pa2, bf16x8& pa3) {
#pragma unroll
  for (int r = 0; r < 16; ++r) p1[r] = __builtin_amdgcn_exp2f(p1[r]);
  float ps = 0;
#pragma unroll
  for (int r = 0; r < 16; ++r) ps += p0[r];
#pragma unroll
  for (int r = 0; r < 16; ++r) ps += p1[r];
  { auto rr = __builtin_amdgcn_permlane32_swap(__float_as_uint(ps), __float_as_uint(ps), false, false);
    ps = __uint_as_float(rr[0]) + __uint_as_float(rr[1]); }
  l_reg = l_reg * alpha + ps;
#define PK4(P, BASE, OUT) do { unsigned a0 = cvtpk(P[BASE + 0], P[BASE + 1]), a1 = cvtpk(P[BASE + 2], P[BASE + 3]);   \
    unsigned b0 = cvtpk(P[BASE + 4], P[BASE + 5]), b1 = cvtpk(P[BASE + 6], P[BASE + 7]);                              \
    auto r0 = __builtin_amdgcn_permlane32_swap(a0, b0, false, false); auto r1 = __builtin_amdgcn_permlane32_swap(a1, b1, false, false); \
    u32x4 w = {r0[0], r1[0], r0[1], r1[1]}; OUT = *reinterpret_cast<bf16x8*>(&w); } while (0)
  PK4(p0, 0, pa0); PK4(p0, 8, pa1); PK4(p1, 0, pa2); PK4(p1, 8, pa3);
#undef PK4
}
__device__ __forceinline__ void qkt(f32x16& p0, f32x16& p1, const bf16_t* Ks, const bf16x8* qr, int r32, int hi, float init = 0.f) {
#pragma unroll
  for (int r = 0; r < 16; ++r) { p0[r] = init; p1[r] = init; }
#pragma unroll
  for (int d0 = 0; d0 < 8; ++d0) { int cb = (d0 * 16 + hi * 8) * 2;
    bf16x8 b0 = *reinterpret_cast<const bf16x8*>((const char*)Ks + KSWZ(r32, cb));
    bf16x8 b1 = *reinterpret_cast<const bf16x8*>((const char*)Ks + KSWZ(32 + r32, cb));
    p0 = __builtin_amdgcn_mfma_f32_32x32x16_bf16(b0, qr[d0], p0, 0, 0, 0);
    p1 = __builtin_amdgcn_mfma_f32_32x32x16_bf16(b1, qr[d0], p1, 0, 0, 0); }
}
__device__ __forceinline__ int v_st(int k, int c) { const int kk = (k & ~0xC) | ((k & 4) << 1) | ((k & 8) >> 1); return ((kk >> 3) * 4 + (c >> 5)) * 512 + ((kk & 7) * 32 + (c & 31)) * 2; }
__device__ __forceinline__ int v_rd_base(int lane) { return ((lane & 3) << 3) | (((lane >> 2) & 3) << 6) | (((lane >> 4) & 1) << 5) | (((lane >> 5) & 1) << 8); }
constexpr int v_rd_off(int d0, int ks, int half) { return d0 * 512 + ks * 4096 + half * 2048; }
template <int OFF> __device__ __forceinline__ s16x4 tr_read(int vb) {
  s16x4 r; asm volatile("ds_read_b64_tr_b16 %0, %1 offset:%2" : "=&v"(r) : "v"(vb), "i"(OFF) : "memory"); return r;
}
template <int D0> __device__ __forceinline__ void pv_one(f32x16& od, int vb, bf16x8 pa0, bf16x8 pa1, bf16x8 pa2, bf16x8 pa3) {
  const s16x4 l0 = tr_read<v_rd_off(D0, 0, 0)>(vb), h0 = tr_read<v_rd_off(D0, 0, 1)>(vb), l1 = tr_read<v_rd_off(D0, 1, 0)>(vb), h1 = tr_read<v_rd_off(D0, 1, 1)>(vb);
  const s16x4 l2 = tr_read<v_rd_off(D0, 2, 0)>(vb), h2 = tr_read<v_rd_off(D0, 2, 1)>(vb), l3 = tr_read<v_rd_off(D0, 3, 0)>(vb), h3 = tr_read<v_rd_off(D0, 3, 1)>(vb);
  asm volatile("s_waitcnt lgkmcnt(0)" ::: "memory"); SBAR();
#define PK(L, H) (bf16x8){L[0], L[1], L[2], L[3], H[0], H[1], H[2], H[3]}
  od = __builtin_amdgcn_mfma_f32_32x32x16_bf16(pa0, PK(l0, h0), od, 0, 0, 0);
  od = __builtin_amdgcn_mfma_f32_32x32x16_bf16(pa1, PK(l1, h1), od, 0, 0, 0);
  od = __builtin_amdgcn_mfma_f32_32x32x16_bf16(pa2, PK(l2, h2), od, 0, 0, 0);
  od = __builtin_amdgcn_mfma_f32_32x32x16_bf16(pa3, PK(l3, h3), od, 0, 0, 0);
#undef PK
}
__device__ __forceinline__ void pv_d0(f32x16* o, int vb, bf16x8 pa0, bf16x8 pa1, bf16x8 pa2, bf16x8 pa3) {
  pv_one<0>(o[0], vb, pa0, pa1, pa2, pa3); pv_one<1>(o[1], vb, pa0, pa1, pa2, pa3); pv_one<2>(o[2], vb, pa0, pa1, pa2, pa3); pv_one<3>(o[3], vb, pa0, pa1, pa2, pa3);
}
template <int MODE>
__device__ __forceinline__ void pv_psm(f32x16* o, int vb, bf16x8 pa0, bf16x8 pa1, bf16x8 pa2, bf16x8 pa3, f32x16& p0, f32x16& p1, float& m_reg, float& mn, float& alpha, const float* tb) {
  pv_one<0>(o[0], vb, pa0, pa1, pa2, pa3);
  if constexpr (MODE == 1) {
#pragma unroll
    for (int r = 0; r < 16; ++r) { const int of = (r & 3) + 8 * (r >> 2); p0[r] = fmaf(p0[r], C, tb[of]); p1[r] = fmaf(p1[r], C, tb[32 + of]); }
  }
  float pmax = p0[0];
#pragma unroll
  for (int r = 1; r < 16; ++r) pmax = fmaxf(pmax, p0[r]);
#pragma unroll
  for (int r = 0; r < 16; ++r) pmax = fmaxf(pmax, p1[r]);
  { auto rr = __builtin_amdgcn_permlane32_swap(__float_as_uint(pmax), __float_as_uint(pmax), false, false);
    pmax = fmaxf(__uint_as_float(rr[0]), __uint_as_float(rr[1])); }
  SBAR();
  pv_one<1>(o[1], vb, pa0, pa1, pa2, pa3);
  float sub;
  if constexpr (MODE == 0) {
    if (__builtin_expect(__all(pmax - m_reg <= THR / SCALE), 1)) { mn = m_reg; alpha = 1.f; }
    else { mn = fmaxf(m_reg, pmax); alpha = __builtin_amdgcn_exp2f((m_reg - mn) * C); m_reg = mn; }
    sub = -mn * C;
#pragma unroll
    for (int r = 0; r < 16; ++r) p0[r] = fmaf(p0[r], C, sub);
  } else {
    if (__builtin_expect(__all(pmax - m_reg <= THR * LOG2E), 1)) { mn = m_reg; alpha = 1.f; }
    else { mn = fmaxf(m_reg, pmax); alpha = __builtin_amdgcn_exp2f(m_reg - mn); m_reg = mn; }
    sub = -mn;
#pragma unroll
    for (int r = 0; r < 16; ++r) p0[r] = p0[r] + sub;
  }
  SBAR();
  pv_one<2>(o[2], vb, pa0, pa1, pa2, pa3);
#pragma unroll
  for (int r = 0; r < 16; ++r) { if constexpr (MODE == 0) p1[r] = fmaf(p1[r], C, sub); else p1[r] = p1[r] + sub; }
#pragma unroll
  for (int r = 0; r < 6; ++r) p0[r] = __builtin_amdgcn_exp2f(p0[r]);
  SBAR();
  pv_one<3>(o[3], vb, pa0, pa1, pa2, pa3);
#pragma unroll
  for (int r = 6; r < 16; ++r) p0[r] = __builtin_amdgcn_exp2f(p0[r]);
}
__device__ __forceinline__ f32x8 bf8_to_f32(bf16x8 v) { f32x8 r;
#pragma unroll
  for (int j = 0; j < 8; ++j) r[j] = bf2f((unsigned short)v[j]);
  return r; }
__device__ __forceinline__ bf16x8 f32_to_bf8(f32x8 x) { u32x4 w = {cvtpk(x[0], x[1]), cvtpk(x[2], x[3]), cvtpk(x[4], x[5]), cvtpk(x[6], x[7])}; return *reinterpret_cast<bf16x8*>(&w); }
__device__ __forceinline__ int t5_bucket(int rel) {
  const int n = rel < 0 ? -rel : rel; int bk;
  if (n < 8) bk = n; else if (n < 12) bk = 8; else if (n < 16) bk = 9; else if (n < 23) bk = 10; else if (n < 32) bk = 11; else if (n < 46) bk = 12; else if (n < 64) bk = 13; else if (n < 91) bk = 14; else bk = 15;
  return bk + (rel > 0 ? 16 : 0);
}
struct Aux { const float* cosT; const float* sinT; const float* qn; const float* kn; const float* relb; const float* sink; };

template <int MODE>
__device__ __forceinline__ void attn_unit(const bf16_t* Qb, const bf16_t* __restrict__ Kh, const bf16_t* __restrict__ Vh, bf16_t* Ob, int kbeg, int kend, int q0, int head, char* lds, const Aux& aux) {
  int tid = threadIdx.x; asm volatile("" : "+v"(tid));
  const int wid = tid >> 6, lane = tid & 63, r32 = lane & 31, hi = lane >> 5;
  char* V_lds = lds; char* K_lds = lds + SHM_V;
  float* ws = (float*)(lds + OFF_WS) + wid * 64; float* li_l = ws; float* al_l = ws + 32;
  float* tab = (float*)(lds + OFF_TAB);
  float m_reg = -1e30f, l_reg = 0; f32x16 o[4] = {}; bf16x8 qr[8];
  const bf16_t* Qw = Qb + (long)(wid * QBLK + r32) * LDQ + hi * 8;
#pragma unroll
  for (int d0 = 0; d0 < 8; ++d0) qr[d0] = *reinterpret_cast<const bf16x8*>(Qw + d0 * 16);
  if constexpr (MODE == 1) {
    for (int i = tid; i < 768; i += 512) { const int rel = i - 383, n = rel < 0 ? -rel : rel; float v = -1e30f; if (n <= 128) v = aux.relb[t5_bucket(rel) * NHB + head] * LOG2E; tab[i] = v; }
    m_reg = aux.sink[head] * LOG2E; l_reg = 1.0f;
  }
  const int tbase = kbeg - q0 - wid * QBLK - r32 + 383 + 4 * hi;
  const int sr = tid >> 4, sc = (tid & 15) * 8, vst0 = v_st(sr, sc), vst1 = v_st(32 + sr, sc);
  const int vb0 = (int)(uintptr_t)V_lds + v_rd_base(lane);
  struct { bf16x8 vs0, vs1, ks0, ks1; } sr_[2];
#define SLOAD(i, k0) do { sr_[i].vs0 = *reinterpret_cast<const bf16x8*>(&Vh[(long)(kbeg + (k0) + sr) * LDK + sc]); sr_[i].vs1 = *reinterpret_cast<const bf16x8*>(&Vh[(long)(kbeg + (k0) + 32 + sr) * LDK + sc]); \
    sr_[i].ks0 = *reinterpret_cast<const bf16x8*>(&Kh[(long)(kbeg + (k0) + sr) * LDK + sc]); sr_[i].ks1 = *reinterpret_cast<const bf16x8*>(&Kh[(long)(kbeg + (k0) + 32 + sr) * LDK + sc]); } while (0)
#define SWRITE(bo, i) do { *(bf16x8*)(V_lds + (bo) + vst0) = sr_[i].vs0;          \
    *(bf16x8*)(V_lds + (bo) + vst1) = sr_[i].vs1; int kc = sc * 2;               \
    *(bf16x8*)(K_lds + (bo) + KSWZ(sr, kc)) = sr_[i].ks0;                       \
    *(bf16x8*)(K_lds + (bo) + KSWZ(32 + sr, kc)) = sr_[i].ks1; } while (0)
#define SWAIT() asm volatile("s_waitcnt vmcnt(4)" ::: "memory")
#define RESC(a) do { if (__any((a) < 1.f)) { if (hi == 0) al_l[r32] = (a); asm volatile("s_waitcnt lgkmcnt(0)" ::: "memory"); \
    _Pragma("unroll") for (int d = 0; d < 4; ++d) _Pragma("unroll") for (int r = 0; r < 16; ++r) o[d][r] *= al_l[crow(r, hi)]; } } while (0)
#define PSM(P0, P1, MN, AL, j) do { if constexpr (MODE == 0) partialSM(P0, P1, m_reg, MN, AL); else partialSM_B(P0, P1, m_reg, MN, AL, tab + tbase + (j) * KVBLK); } while (0)
#define ROT() do { const int t_ = o_prev; o_prev = o_cur; o_cur = o_next; o_next = t_; } while (0)
  f32x16 pA0, pA1, pB0, pB1; float mnA, mnB, alA, alB; bf16x8 pa0, pa1, pa2, pa3; const int NT = (kend - kbeg) / KVBLK;
  constexpr int SE = 0, SO = 1;
  int o_prev = 2 * BUFB, o_cur = 0, o_next = BUFB;
  SLOAD(SE, 0); asm volatile("s_waitcnt vmcnt(0)" ::: "memory"); SWRITE(0, SE);
  SLOAD(SO, KVBLK); SLOAD(SE, 2 * KVBLK);
  __syncthreads();
  qkt(pA0, pA1, (const bf16_t*)(K_lds + o_cur), qr, r32, hi); PSM(pA0, pA1, mnA, alA, 0);
  SWAIT(); SWRITE(o_next, SO); RESC(alA); __syncthreads();
  ROT();
  for (int j = 1; j + 1 < NT; j += 2) {
    SBAR(); qkt(pB0, pB1, (const bf16_t*)(K_lds + o_cur), qr, r32, hi);
    finishSM(pA0, pA1, alA, l_reg, pa0, pa1, pa2, pa3); SBAR();
    SLOAD(SO, (j + 2) * KVBLK); SBAR();
    pv_psm<MODE>(o, vb0 + o_prev, pa0, pa1, pa2, pa3, pB0, pB1, m_reg, mnB, alB, tab + tbase + j * KVBLK);
    SWAIT(); SWRITE(o_next, SE);
    RESC(alB); __syncthreads(); ROT();
    SBAR(); qkt(pA0, pA1, (const bf16_t*)(K_lds + o_cur), qr, r32, hi);
    finishSM(pB0, pB1, alB, l_reg, pa0, pa1, pa2, pa3); SBAR();
    SLOAD(SE, (j + 3 < NT ? j + 3 : NT - 1) * KVBLK); SBAR();
    pv_psm<MODE>(o, vb0 + o_prev, pa0, pa1, pa2, pa3, pA0, pA1, m_reg, mnA, alA, tab + tbase + (j + 1) * KVBLK);
    SWAIT(); SWRITE(o_next, SO);
    RESC(alA); __syncthreads(); ROT();
  }
  SBAR(); qkt(pB0, pB1, (const bf16_t*)(K_lds + o_cur), qr, r32, hi);
  finishSM(pA0, pA1, alA, l_reg, pa0, pa1, pa2, pa3); SBAR();
  pv_psm<MODE>(o, vb0 + o_prev, pa0, pa1, pa2, pa3, pB0, pB1, m_reg, mnB, alB, tab + tbase + (NT - 1) * KVBLK);
  RESC(alB);
  finishSM(pB0, pB1, alB, l_reg, pa0, pa1, pa2, pa3); SBAR();
  pv_d0(o, vb0 + o_cur, pa0, pa1, pa2, pa3);
  if (hi == 0) li_l[r32] = l_reg; asm volatile("s_waitcnt lgkmcnt(0)" ::: "memory");
  float rli[16];
#pragma unroll
  for (int r = 0; r < 16; ++r) rli[r] = __builtin_amdgcn_rcpf(li_l[crow(r, hi)]);
  asm volatile("s_waitcnt vmcnt(0)" ::: "memory");
  __syncthreads();
  char* ost = lds + OFF_OST + wid * 8192;
#pragma unroll
  for (int r = 0; r < 16; ++r) { const int orow = crow(r, hi);
#pragma unroll
    for (int d0 = 0; d0 < 4; ++d0) *(unsigned short*)(ost + orow * 256 + (d0 * 32 + r32) * 2) = f2bf(o[d0][r] * rli[r]); }
  asm volatile("s_waitcnt lgkmcnt(0)" ::: "memory");
  bf16_t* Ow = Ob + (long)(wid * QBLK) * LDQ;
#pragma unroll
  for (int i = 0; i < 8; ++i) { const int ch = i * 64 + lane, row = ch >> 4, c16 = ch & 15;
    const u32x4 v = *(const u32x4*)(ost + row * 256 + c16 * 16); *(u32x4*)(Ow + (long)row * LDQ + c16 * 8) = v; }
  asm volatile("s_waitcnt lgkmcnt(0)" ::: "memory");
  __syncthreads();
#undef ROT
#undef SLOAD
#undef SWRITE
#undef SWAIT
#undef RESC
#undef PSM
}

template <int MODE>
__device__ __forceinline__ void softmax_tile(f32x16& p0, f32x16& p1, float& m_reg, float& l_reg, float& alpha, bf16x8& pa0, bf16x8& pa1, bf16x8& pa2, bf16x8& pa3, const float* tb) {
  if constexpr (MODE == 0) {
    alpha = 1.f;
    if (__builtin_expect(m_reg != 0.f, 0)) {
#pragma unroll
      for (int r = 0; r < 16; ++r) { p0[r] -= m_reg; p1[r] -= m_reg; } }
#pragma unroll
    for (int r = 0; r < 16; ++r) { p0[r] = __builtin_amdgcn_exp2f(p0[r]); p1[r] = __builtin_amdgcn_exp2f(p1[r]); }
  } else {
  if constexpr (MODE == 1) {
#pragma unroll
    for (int r = 0; r < 16; ++r) { const int of = (r & 3) + 8 * (r >> 2); p0[r] = fmaf(p0[r], C, tb[of]); p1[r] = fmaf(p1[r], C, tb[32 + of]); }
  }
  float pmax = p0[0];
#pragma unroll
  for (int r = 1; r < 16; ++r) pmax = fmaxf(pmax, p0[r]);
#pragma unroll
  for (int r = 0; r < 16; ++r) pmax = fmaxf(pmax, p1[r]);
  { auto rr = __builtin_amdgcn_permlane32_swap(__float_as_uint(pmax), __float_as_uint(pmax), false, false);
    pmax = fmaxf(__uint_as_float(rr[0]), __uint_as_float(rr[1])); }
  float mn, sub;
  if constexpr (MODE == 0) {
    if (__builtin_expect(__all(pmax - m_reg <= THR / SCALE), 1)) { mn = m_reg; alpha = 1.f; }
    else { mn = fmaxf(m_reg, pmax); alpha = __builtin_amdgcn_exp2f((m_reg - mn) * C); m_reg = mn; }
    sub = -mn * C;
#pragma unroll
    for (int r = 0; r < 16; ++r) { p0[r] = __builtin_amdgcn_exp2f(fmaf(p0[r], C, sub)); p1[r] = __builtin_amdgcn_exp2f(fmaf(p1[r], C, sub)); }
  } else {
    if (__builtin_expect(__all(pmax - m_reg <= THR * LOG2E), 1)) { mn = m_reg; alpha = 1.f; }
    else { mn = fmaxf(m_reg, pmax); alpha = __builtin_amdgcn_exp2f(m_reg - mn); m_reg = mn; }
    sub = -mn;
#pragma unroll
    for (int r = 0; r < 16; ++r) { p0[r] = __builtin_amdgcn_exp2f(p0[r] + sub); p1[r] = __builtin_amdgcn_exp2f(p1[r] + sub); }
  }
  }
  float ps = 0;
#pragma unroll
  for (int r = 0; r < 16; ++r) ps += p0[r];
#pragma unroll
  for (int r = 0; r < 16; ++r) ps += p1[r];
  { auto rr = __builtin_amdgcn_permlane32_swap(__float_as_uint(ps), __float_as_uint(ps), false, false);
    ps = __uint_as_float(rr[0]) + __uint_as_float(rr[1]); }
  l_reg = l_reg * alpha + ps;
#define PK4(P, BASE, OUT) do { unsigned a0 = cvtpk(P[BASE + 0], P[BASE + 1]), a1 = cvtpk(P[BASE + 2], P[BASE + 3]);   \
    unsigned b0 = cvtpk(P[BASE + 4], P[BASE + 5]), b1 = cvtpk(P[BASE + 6], P[BASE + 7]);                              \
    auto r0 = __builtin_amdgcn_permlane32_swap(a0, b0, false, false); auto r1 = __builtin_amdgcn_permlane32_swap(a1, b1, false, false); \
    u32x4 w = {r0[0], r1[0], r0[1], r1[1]}; OUT = *reinterpret_cast<bf16x8*>(&w); } while (0)
  PK4(p0, 0, pa0); PK4(p0, 8, pa1); PK4(p1, 0, pa2); PK4(p1, 8, pa3);
#undef PK4
}
typedef short v4i16_t __attribute__((ext_vector_type(4)));
__device__ __forceinline__ bf16x8 ld_frag2(int sp, const LAS char* kb, const int (&kx)[4], const LAS char* vb) {
  if (sp >= 16) { const int s = sp - 16, d0 = s >> 1; return *(const LAS bf16x8*)(kb + kx[d0 & 3] + (d0 >> 2) * 128 + (s & 1) * 8192); }
  const int D0 = sp >> 2, ks = sp & 3;
  const s16x4 lo = __builtin_bit_cast(s16x4, __builtin_amdgcn_ds_read_tr16_b64_v4i16((LAS v4i16_t*)(vb + v_rd_off(D0, ks, 0))));
  const s16x4 hi = __builtin_bit_cast(s16x4, __builtin_amdgcn_ds_read_tr16_b64_v4i16((LAS v4i16_t*)(vb + v_rd_off(D0, ks, 1))));
  return (bf16x8){lo[0], lo[1], lo[2], lo[3], hi[0], hi[1], hi[2], hi[3]};
}
template <int SB, int SE, bool PRE>
__device__ __forceinline__ void mrun(bf16x8 (&f)[8], f32x16& p0, f32x16& p1, f32x16* o, const bf16x8* qr, bf16x8 pa0, bf16x8 pa1, bf16x8 pa2, bf16x8 pa3, const LAS char* kb, const int (&kx)[4], const LAS char* vb, float init) {
  if (SE > 16) { p0 = f32x16{}; p1 = f32x16{}; }
  SBAR();
  if (!PRE) {
#pragma unroll
    for (int s = SB; s < SB + 8; ++s) f[s & 7] = ld_frag2(s, kb, kx, vb);
    SBAR(); }
#pragma unroll
  for (int sp = SB; sp < SE; ++sp) {
    if (sp >= 16) { const int s = sp - 16; if (s & 1) p1 = __builtin_amdgcn_mfma_f32_32x32x16_bf16(f[sp & 7], qr[s >> 1], p1, 0, 0, 0); else p0 = __builtin_amdgcn_mfma_f32_32x32x16_bf16(f[sp & 7], qr[s >> 1], p0, 0, 0, 0); }
    else { const int D0 = sp >> 2, ks = sp & 3; const bf16x8 pa = ks == 0 ? pa0 : ks == 1 ? pa1 : ks == 2 ? pa2 : pa3;
      o[D0] = __builtin_amdgcn_mfma_f32_32x32x16_bf16(pa, f[sp & 7], o[D0], 0, 0, 0); }
    if (sp + 8 < SE) f[sp & 7] = ld_frag2(sp + 8, kb, kx, vb);
    SBAR();
  }
}
template <int MODE>
__device__ __forceinline__ void attn_unit_pp(const bf16_t* Qb, const bf16_t* __restrict__ Kh, const bf16_t* __restrict__ Vh, unsigned char* Ob8, int kbeg, int kend, int q0, int head, char* lds, const Aux& aux) {
  int tid = threadIdx.x; asm volatile("" : "+v"(tid));
  const int wid = tid >> 6, lane = tid & 63, r32 = lane & 31, hi = lane >> 5;
  const int widu = __builtin_amdgcn_readfirstlane(wid), half = widu >> 2;
  const int hsub = widu >> 1, rsub = (widu & 1) * QBLK;
  const int rw0 = q0 + rsub;
#define NEED(j) (MODE == 0 || ((kbeg + (j) * KVBLK + KVBLK - 1 >= rw0 - 128) && (kbeg + (j) * KVBLK <= rw0 + QBLK - 1 + 128)))
  char* V_lds = lds; char* K_lds = lds + SHM_V;
  float* ws = (float*)(lds + OFF_WS) + wid * 64; float* li_l = ws; float* al_l = ws + 32;
  float* tab = (float*)(lds + OFF_TAB) + hsub * 768;
  float m_reg = -1e30f, l_reg = 0; f32x16 o[4] = {}; bf16x8 qr[8];
  const bf16_t* Qw = Qb + (long)(rsub + r32) * LDQ + hsub * HD + hi * 8;
#pragma unroll
  for (int d0 = 0; d0 < 8; ++d0) qr[d0] = *reinterpret_cast<const bf16x8*>(Qw + d0 * 16);
  if constexpr (MODE == 1) {
    m_reg = aux.sink[head + hsub] * LOG2E; l_reg = 1.0f;
  }
  const int tbase = kbeg - q0 - rsub - r32 + 383 + 4 * hi;
  float qk_init = 0.f;
  if constexpr (MODE == 0) {
    float mq = fmaxf(fabsf(aux.qn[lane]), fabsf(aux.qn[64 + lane])), mk = fmaxf(fabsf(aux.kn[lane]), fabsf(aux.kn[64 + lane]));
#pragma unroll
    for (int of = 1; of < 64; of <<= 1) { mq = fmaxf(mq, __shfl_xor(mq, of)); mk = fmaxf(mk, __shfl_xor(mk, of)); }
    const float bound = C * 128.0f * mq * mk * 1.01f + 0.5f;
    m_reg = __builtin_amdgcn_readfirstlane(__float_as_int(bound > 64.f ? bound - 64.f : 0.f)) ? (bound - 64.f) : 0.f; (void)qk_init; }
  const int sr = tid >> 4, sc = (tid & 15) * 8, vst0 = v_st(sr, sc), vst1 = v_st(32 + sr, sc);
  const int vb0 = (int)(uintptr_t)V_lds + v_rd_base(lane);
  int kx[4];
#pragma unroll
  for (int d = 0; d < 4; ++d) kx[d] = r32 * 256 + ((d * 32 + hi * 16) ^ ((r32 & 7) << 4));
  const LAS char* k3 = (const LAS char*)K_lds; const LAS char* v3 = (const LAS char*)V_lds + v_rd_base(lane);
  bf16x8 fr_[8];
  bf16x8 s_v0, s_v1, s_k0, s_k1;
#define SLOAD(k0) do { s_v0 = *reinterpret_cast<const bf16x8*>(&Vh[(long)(kbeg + (k0) + sr) * LDK + sc]); s_v1 = *reinterpret_cast<const bf16x8*>(&Vh[(long)(kbeg + (k0) + 32 + sr) * LDK + sc]); \
    s_k0 = *reinterpret_cast<const bf16x8*>(&Kh[(long)(kbeg + (k0) + sr) * LDK + sc]); s_k1 = *reinterpret_cast<const bf16x8*>(&Kh[(long)(kbeg + (k0) + 32 + sr) * LDK + sc]); } while (0)
#define SWRITE(bo) do { *(bf16x8*)(V_lds + (bo) + vst0) = s_v0; *(bf16x8*)(V_lds + (bo) + vst1) = s_v1; const int kc = sc * 2;  \
    *(bf16x8*)(K_lds + (bo) + KSWZ(sr, kc)) = s_k0; *(bf16x8*)(K_lds + (bo) + KSWZ(32 + sr, kc)) = s_k1; } while (0)
#define VMW0() asm volatile("s_waitcnt vmcnt(0)" ::: "memory")
#define BAR() asm volatile("s_waitcnt lgkmcnt(0)\n\ts_barrier" ::: "memory")
#define RESC(a) do { if (__any((a) < 1.f)) { if (hi == 0) al_l[r32] = (a); asm volatile("s_waitcnt lgkmcnt(0)" ::: "memory"); \
    _Pragma("unroll") for (int d = 0; d < 4; ++d) _Pragma("unroll") for (int r = 0; r < 16; ++r) o[d][r] *= al_l[crow(r, hi)]; } } while (0)
#define ROT() do { const int t_ = o_prev; o_prev = o_cur; o_cur = o_next; o_next = t_; } while (0)
#define VSEG(j) do { VMW0(); SWRITE(o_next); { const int nx_ = (j) + 2 + half; SLOAD((nx_ < NT ? nx_ : NT - 1) * KVBLK); } SBAR(); \
    if (NEED(j)) { softmax_tile<MODE>(p0, p1, m_reg, l_reg, alpha, pa0, pa1, pa2, pa3, tab + tbase + (j) * KVBLK); if constexpr (MODE == 1) { RESC(alpha); } } SBAR(); } while (0)
#define PVPRE() do { if constexpr (MODE == 0) { _Pragma("unroll") for (int s_ = 0; s_ < 8; ++s_) fr_[s_] = ld_frag2(s_, k3, kx, v3 + o_cur); SBAR(); } } while (0)
  f32x16 p0, p1; float alpha; bf16x8 pa0, pa1, pa2, pa3; const int NT = (kend - kbeg) / KVBLK;
  int o_prev = 2 * BUFB, o_cur = 0, o_next = BUFB;
  { bf16x8 t_v0, t_v1, t_k0, t_k1;
    t_v0 = *reinterpret_cast<const bf16x8*>(&Vh[(long)(kbeg + sr) * LDK + sc]); t_v1 = *reinterpret_cast<const bf16x8*>(&Vh[(long)(kbeg + 32 + sr) * LDK + sc]);
    t_k0 = *reinterpret_cast<const bf16x8*>(&Kh[(long)(kbeg + sr) * LDK + sc]); t_k1 = *reinterpret_cast<const bf16x8*>(&Kh[(long)(kbeg + 32 + sr) * LDK + sc]);
    SLOAD(KVBLK); VMW0();
    *(bf16x8*)(V_lds + vst0) = t_v0; *(bf16x8*)(V_lds + vst1) = t_v1; { const int kc = sc * 2; *(bf16x8*)(K_lds + KSWZ(sr, kc)) = t_k0; *(bf16x8*)(K_lds + KSWZ(32 + sr, kc)) = t_k1; }
    if (half) { SWRITE(BUFB); SLOAD(2 * KVBLK); } }
  BAR();
#define MSEG_QK(j) do { SBAR(); if (NEED(j)) qkt(p0, p1, (const bf16_t*)(K_lds + o_cur), qr, r32, hi, qk_init); SBAR(); } while (0)
#define MSEG(j) do { SBAR(); if (NEED(j)) qkt(p0, p1, (const bf16_t*)(K_lds + o_cur), qr, r32, hi, qk_init); if (NEED((j) - 1)) pv_d0(o, vb0 + o_prev, pa0, pa1, pa2, pa3); SBAR(); } while (0)
#define MSEG_PV() do { SBAR(); if (NEED(NT - 1)) pv_d0(o, vb0 + o_prev, pa0, pa1, pa2, pa3); SBAR(); } while (0)
  if (half == 0) {
    MSEG_QK(0); VSEG(0);
    BAR(); ROT();
    for (int j = 1; j < NT; ++j) { MSEG(j); VSEG(j); BAR(); ROT(); }
    MSEG_PV();
  } else {
    MSEG_QK(0);
    BAR(); ROT();
    for (int j = 1; j < NT; ++j) { VSEG(j - 1); MSEG(j); BAR(); ROT(); }
    VSEG(NT - 1); MSEG_PV();
  }
#undef MSEG_QK
#undef MSEG
#undef MSEG_PV
  if (hi == 0) li_l[r32] = l_reg; asm volatile("s_waitcnt lgkmcnt(0)" ::: "memory");
  float rli[16];
#pragma unroll
  for (int r = 0; r < 16; ++r) rli[r] = __builtin_amdgcn_rcpf(li_l[crow(r, hi)]);
  VMW0();
  __syncthreads();
  char* ost = lds + OFF_OST + wid * 4096;
#pragma unroll
  for (int r = 0; r < 16; ++r) { const int orow = crow(r, hi);
#pragma unroll
    for (int d0 = 0; d0 < 4; ++d0) { const float xo = o[d0][r] * rli[r] * OB8S; *(unsigned char*)(ost + orow * 128 + d0 * 32 + r32) = (unsigned char)(__builtin_amdgcn_cvt_pk_fp8_f32(xo, xo, 0, false) & 0xff); } }
  asm volatile("s_waitcnt lgkmcnt(0)" ::: "memory");
  unsigned char* Ow = Ob8 + (long)rsub * QW + hsub * HD;
#pragma unroll
  for (int i = 0; i < 4; ++i) { const int ch = i * 64 + lane, row = ch >> 3, c16 = ch & 7;
    const u32x4 v = *(const u32x4*)(ost + row * 128 + c16 * 16); *(u32x4*)(Ow + (long)row * QW + c16 * 16) = v; }
  asm volatile("s_waitcnt lgkmcnt(0)" ::: "memory");
  __syncthreads();
#undef SLOAD
#undef SWRITE
#undef VMW0
#undef BAR
#undef RESC
#undef ROT
#undef VSEG
#undef PVPRE
#undef NEED
}

__device__ __forceinline__ int offK16(int row, int ch) { return row * 256 + 16 * (ch ^ (row & 15)); }
__device__ __forceinline__ int offV16(int row, int ch) { return row * 256 + 16 * (ch ^ ((row & 7) << 1)); }
__device__ __forceinline__ bf16x8 ld_frag16(int sp, const LAS char* kb, const int (&ka)[4], const LAS char* vb, const int (&va)[8]) {
  if (sp >= 16) { const int s = sp - 16, kblk = s >> 2, ks = s & 3; return *(const LAS bf16x8*)(kb + ka[ks] + kblk * 4096); }
  const int db = sp >> 1, s = sp & 1;
  const s16x4 lo = __builtin_bit_cast(s16x4, __builtin_amdgcn_ds_read_tr16_b64_v4i16((LAS v4i16_t*)(vb + va[db] + s * 8192)));
  const s16x4 hi = __builtin_bit_cast(s16x4, __builtin_amdgcn_ds_read_tr16_b64_v4i16((LAS v4i16_t*)(vb + va[db] + s * 8192 + 4096)));
  return (bf16x8){lo[0], lo[1], lo[2], lo[3], hi[0], hi[1], hi[2], hi[3]};
}
template <int SB, int SE, bool PRE>
__device__ __forceinline__ void mrun16(bf16x8 (&f)[8], f32x4 (&S)[4][2], f32x4 (&O)[8][2], const bf16x8 (&qf)[2][4], const bf16x8 (&pf)[2][2], const LAS char* kb, const int (&ka)[4], const LAS char* vb, const int (&va)[8]) {
  if (SE > 16) {
#pragma unroll
    for (int i = 0; i < 4; ++i) { S[i][0] = (f32x4){0.f, 0.f, 0.f, 0.f}; S[i][1] = (f32x4){0.f, 0.f, 0.f, 0.f}; } }
  SBAR();
  if (!PRE) {
#pragma unroll
    for (int s = SB; s < SB + 8; ++s) f[s & 7] = ld_frag16(s, kb, ka, vb, va);
    SBAR(); }
#pragma unroll
  for (int sp = SB; sp < SE; ++sp) {
    if (sp >= 16) { const int s = sp - 16, kblk = s >> 2, ks = s & 3;
      S[kblk][0] = __builtin_amdgcn_mfma_f32_16x16x32_bf16(f[sp & 7], qf[0][ks], S[kblk][0], 0, 0, 0); S[kblk][1] = __builtin_amdgcn_mfma_f32_16x16x32_bf16(f[sp & 7], qf[1][ks], S[kblk][1], 0, 0, 0); }
    else { const int db = sp >> 1, s = sp & 1;
      O[db][0] = __builtin_amdgcn_mfma_f32_16x16x32_bf16(f[sp & 7], pf[0][s], O[db][0], 0, 0, 0); O[db][1] = __builtin_amdgcn_mfma_f32_16x16x32_bf16(f[sp & 7], pf[1][s], O[db][1], 0, 0, 0); }
    if (sp + 8 < SE) f[sp & 7] = ld_frag16(sp + 8, kb, ka, vb, va);
    SBAR();
  }
}
__device__ __forceinline__ void attn_unit16(const bf16_t* Qb, const bf16_t* __restrict__ Kh, const bf16_t* __restrict__ Vh, bf16_t* Ob, int nkeys, int q0, char* lds, const Aux& aux) {
  int tid = threadIdx.x; asm volatile("" : "+v"(tid));
  const int wid = tid >> 6, lane = tid & 63, fr = lane & 15, fq = lane >> 4;
  const int half = __builtin_amdgcn_readfirstlane(wid >> 2);
  char* V_lds = lds; char* K_lds = lds + SHM_V;
  float shift;
  { float mq = fmaxf(fabsf(aux.qn[lane]), fabsf(aux.qn[64 + lane])), mk = fmaxf(fabsf(aux.kn[lane]), fabsf(aux.kn[64 + lane]));
#pragma unroll
    for (int of = 1; of < 64; of <<= 1) { mq = fmaxf(mq, __shfl_xor(mq, of)); mk = fmaxf(mk, __shfl_xor(mk, of)); }
    const float bound = C * 128.0f * mq * mk * 1.01f + 0.5f; shift = bound > 64.f ? bound - 64.f : 0.f; }
  bf16x8 qf[2][4];
#pragma unroll
  for (int qb = 0; qb < 2; ++qb)
#pragma unroll
    for (int ks = 0; ks < 4; ++ks) qf[qb][ks] = *reinterpret_cast<const bf16x8*>(Qb + (long)(wid * QBLK + 16 * qb + fr) * LDQ + 32 * ks + 8 * fq);
#pragma unroll
  for (int qb = 0; qb < 2; ++qb) {
    float ss = 0.f;
#pragma unroll
    for (int ks = 0; ks < 4; ++ks) { const f32x8 x = bf8_to_f32(qf[qb][ks]);
#pragma unroll
      for (int e = 0; e < 8; ++e) ss += x[e] * x[e]; }
    ss += __shfl_xor(ss, 16); ss += __shfl_xor(ss, 32);
    const float rinv = C / sqrtf(ss * (1.0f / 128.0f) + EPS);
    const int t = q0 + wid * QBLK + 16 * qb + fr;
#pragma unroll
    for (int hf = 0; hf < 2; ++hf) { const int posx = hf ? (t & 63) : (t >> 6);
      const f32x8 cs = *reinterpret_cast<const f32x8*>(aux.cosT + posx * 32 + 8 * fq), sn = *reinterpret_cast<const f32x8*>(aux.sinT + posx * 32 + 8 * fq);
      const f32x8 g1 = *reinterpret_cast<const f32x8*>(aux.qn + hf * 64 + 8 * fq), g2 = *reinterpret_cast<const f32x8*>(aux.qn + hf * 64 + 32 + 8 * fq);
      const f32x8 x1 = bf8_to_f32(qf[qb][2 * hf]) * rinv * g1, x2 = bf8_to_f32(qf[qb][2 * hf + 1]) * rinv * g2;
      qf[qb][2 * hf] = f32_to_bf8(x1 * cs - x2 * sn); qf[qb][2 * hf + 1] = f32_to_bf8(x2 * cs + x1 * sn); } }
  f32x4 O[8][2], S[4][2]; bf16x8 pf[2][2]; float lsum[2] = {0.f, 0.f};
#pragma unroll
  for (int i = 0; i < 8; ++i) { O[i][0] = (f32x4){0.f, 0.f, 0.f, 0.f}; O[i][1] = (f32x4){0.f, 0.f, 0.f, 0.f}; }
  int ka[4], va[8];
#pragma unroll
  for (int ks = 0; ks < 4; ++ks) ka[ks] = offK16(fr, 4 * ks + fq);
  { const int q = (lane & 15) >> 2, p = lane & 3;
#pragma unroll
    for (int c = 0; c < 8; ++c) va[c] = offV16(4 * fq + q, 2 * c + (p >> 1)) + 8 * (p & 1); }
  const LAS char* k3 = (const LAS char*)K_lds; const LAS char* v3 = (const LAS char*)V_lds;
  bf16x8 fr_[8];
  const int sr = tid >> 4, scc = tid & 15, kst = offK16(sr, scc), vst = offV16(sr, scc);
  bf16x8 s_v0, s_v1, s_k0, s_k1;
#define SLOAD(k0) do { s_v0 = *reinterpret_cast<const bf16x8*>(&Vh[(long)((k0) + sr) * LDK + scc * 8]); s_v1 = *reinterpret_cast<const bf16x8*>(&Vh[(long)((k0) + 32 + sr) * LDK + scc * 8]); \
    s_k0 = *reinterpret_cast<const bf16x8*>(&Kh[(long)((k0) + sr) * LDK + scc * 8]); s_k1 = *reinterpret_cast<const bf16x8*>(&Kh[(long)((k0) + 32 + sr) * LDK + scc * 8]); } while (0)
#define SWRITE(bo) do { *(bf16x8*)(V_lds + (bo) + vst) = s_v0; *(bf16x8*)(V_lds + (bo) + vst + 8192) = s_v1; *(bf16x8*)(K_lds + (bo) + kst) = s_k0; *(bf16x8*)(K_lds + (bo) + kst + 8192) = s_k1; } while (0)
#define VMW0() asm volatile("s_waitcnt vmcnt(0)" ::: "memory")
#define BAR() asm volatile("s_waitcnt lgkmcnt(0)\n\ts_barrier" ::: "memory")
#define ROT() do { const int t_ = o_prev; o_prev = o_cur; o_cur = o_next; o_next = t_; } while (0)
#define VSEG(j, wbuf_, pbuf_) do { VMW0(); SWRITE(wbuf_); { const int nx_ = (j) + 2 + half; SLOAD((nx_ < NT ? nx_ : NT - 1) * KVBLK); } SBAR(); \
    if (__builtin_expect(shift != 0.f, 0)) { _Pragma("unroll") for (int i_ = 0; i_ < 4; ++i_) { S[i_][0] -= shift; S[i_][1] -= shift; } } \
    _Pragma("unroll") for (int qb_ = 0; qb_ < 2; ++qb_) { \
      _Pragma("unroll") for (int i_ = 0; i_ < 4; ++i_) _Pragma("unroll") for (int r_ = 0; r_ < 4; ++r_) S[i_][qb_][r_] = __builtin_amdgcn_exp2f(S[i_][qb_][r_]); \
      float a_ = 0.f; _Pragma("unroll") for (int i_ = 0; i_ < 4; ++i_) a_ += (S[i_][qb_][0] + S[i_][qb_][1]) + (S[i_][qb_][2] + S[i_][qb_][3]); lsum[qb_] += a_; \
      _Pragma("unroll") for (int s_ = 0; s_ < 2; ++s_) { u32x4 w_ = {cvtpk(S[2 * s_][qb_][0], S[2 * s_][qb_][1]), cvtpk(S[2 * s_][qb_][2], S[2 * s_][qb_][3]), cvtpk(S[2 * s_ + 1][qb_][0], S[2 * s_ + 1][qb_][1]), cvtpk(S[2 * s_ + 1][qb_][2], S[2 * s_ + 1][qb_][3])}; \
        pf[qb_][s_] = *reinterpret_cast<bf16x8*>(&w_); } } \
    SBAR(); _Pragma("unroll") for (int s_ = 0; s_ < 8; ++s_) fr_[s_] = ld_frag16(s_, k3, ka, v3 + (pbuf_), va); SBAR(); } while (0)
  const int NT = nkeys / KVBLK;
  int o_prev = 2 * BUFB, o_cur = 0, o_next = BUFB;
  SLOAD(0); VMW0(); SWRITE(0);
  if (half) { SLOAD(KVBLK); VMW0(); SWRITE(BUFB); SLOAD(2 * KVBLK); } else { SLOAD(KVBLK); }
  BAR();
  if (half == 0) {
    mrun16<16, 32, false>(fr_, S, O, qf, pf, k3 + o_cur, ka, v3 + o_prev, va);
    VSEG(0, o_next, o_cur);
    BAR(); ROT();
    for (int j = 1; j < NT; ++j) {
      mrun16<0, 32, true>(fr_, S, O, qf, pf, k3 + o_cur, ka, v3 + o_prev, va);
      VSEG(j, o_next, o_cur);
      BAR(); ROT();
    }
    mrun16<0, 16, true>(fr_, S, O, qf, pf, k3 + o_cur, ka, v3 + o_prev, va);
  } else {
    mrun16<16, 32, false>(fr_, S, O, qf, pf, k3 + o_cur, ka, v3 + o_prev, va);
    BAR(); ROT();
    for (int j = 1; j < NT; ++j) {
      VSEG(j - 1, o_next, o_prev);
      mrun16<0, 32, true>(fr_, S, O, qf, pf, k3 + o_cur, ka, v3 + o_prev, va);
      BAR(); ROT();
    }
    VSEG(NT - 1, o_next, o_prev);
    mrun16<0, 16, true>(fr_, S, O, qf, pf, k3 + o_cur, ka, v3 + o_prev, va);
  }
  float rl[2];
#pragma unroll
  for (int qb = 0; qb < 2; ++qb) { float l = lsum[qb]; l += __shfl_xor(l, 16); l += __shfl_xor(l, 32); rl[qb] = __builtin_amdgcn_rcpf(l); }
  VMW0();
  __syncthreads();
  char* ost = lds + OFF_OST + wid * 8192;
#pragma unroll
  for (int db = 0; db < 8; ++db)
#pragma unroll
    for (int qb = 0; qb < 2; ++qb) { const f32x4 v = O[db][qb] * rl[qb]; u32x2 w; w.x = cvtpk(v[0], v[1]); w.y = cvtpk(v[2], v[3]);
      *(u32x2*)(ost + (16 * qb + fr) * 256 + (16 * db + 4 * fq) * 2) = w; }
  asm volatile("s_waitcnt lgkmcnt(0)" ::: "memory");
  bf16_t* Ow = Ob + (long)(wid * QBLK) * LDQ;
#pragma unroll
  for (int i = 0; i < 8; ++i) { const int ch = i * 64 + lane, row = ch >> 4, c16 = ch & 15;
    const u32x4 v = *(const u32x4*)(ost + row * 256 + c16 * 16); *(u32x4*)(Ow + (long)row * LDQ + c16 * 8) = v; }
  asm volatile("s_waitcnt lgkmcnt(0)" ::: "memory");
  __syncthreads();
#undef SLOAD
#undef SWRITE
#undef VMW0
#undef BAR
#undef ROT
#undef VSEG
}

typedef int v8i_t __attribute__((ext_vector_type(8)));
typedef short v2s_t __attribute__((ext_vector_type(2)));
__device__ __forceinline__ int off8(int row, int c16) { return row * 128 + 16 * (c16 ^ (((row >> 1) & 1) | (((row >> 2) & 1) << 2))); }
__device__ __forceinline__ v8i_t ld_frag8(const LAS char* img, int a0, int a1, int blk) {
  const u32x4 lo = *(const LAS u32x4*)(img + blk * 2048 + a0), hi = *(const LAS u32x4*)(img + blk * 2048 + a1);
  return (v8i_t){(int)lo.x, (int)lo.y, (int)lo.z, (int)lo.w, (int)hi.x, (int)hi.y, (int)hi.z, (int)hi.w};
}
__device__ __forceinline__ void exp_pack8(f32x4 (&S)[4][2], v8i_t (&pf)[2], int h) {
#pragma unroll
  for (int qb = 0; qb < 2; ++qb) {
#pragma unroll
    for (int i = 0; i < 4; ++i) { f32x4 e;
#pragma unroll
      for (int r = 0; r < 4; ++r) e[r] = __builtin_amdgcn_exp2f(S[i][qb][r]);
      int w = __builtin_amdgcn_cvt_pk_bf8_f32(e[0], e[1], __builtin_bit_cast(int, e[0]), false); w = __builtin_amdgcn_cvt_pk_bf8_f32(e[2], e[3], w, true);
      if (h == 0) { if (i == 0) pf[qb][0] = w; else if (i == 1) pf[qb][1] = w; else if (i == 2) pf[qb][2] = w; else pf[qb][3] = w; }
      else { if (i == 0) pf[qb][4] = w; else if (i == 1) pf[qb][5] = w; else if (i == 2) pf[qb][6] = w; else pf[qb][7] = w; } } }
}
struct FRing { u32x4 l[4], h[4]; u32x2 k2[4]; };
template <int OFF> __device__ __forceinline__ void ldf8(u32x4& lo, u32x4& hi, unsigned ad0, unsigned ad1) {
  asm volatile("ds_read_b128 %0, %1 offset:%2" : "=&v"(lo) : "v"(ad0), "n"(OFF));
  asm volatile("ds_read_b128 %0, %1 offset:%2" : "=&v"(hi) : "v"(ad1), "n"(OFF));
}
template <int N> __device__ __forceinline__ v8i_t wtf8(u32x4& lo, u32x4& hi) {
  asm volatile("s_waitcnt lgkmcnt(%2)" : "+v"(lo), "+v"(hi) : "n"(N));
  return (v8i_t){(int)lo.x, (int)lo.y, (int)lo.z, (int)lo.w, (int)hi.x, (int)hi.y, (int)hi.z, (int)hi.w};
}
template <int OFF> __device__ __forceinline__ void ldf6(u32x4& lo, u32x2& h2, unsigned ad0, unsigned ad1) {
  asm volatile("ds_read_b128 %0, %1 offset:%2" : "=&v"(lo) : "v"(ad0), "n"(OFF));
  asm volatile("ds_read_b64 %0, %1 offset:%2" : "=&v"(h2) : "v"(ad1), "n"(OFF));
}
template <int N> __device__ __forceinline__ v8i_t wtf6(u32x4& lo, u32x2& h2) {
  asm volatile("s_waitcnt lgkmcnt(%2)" : "+v"(lo), "+v"(h2) : "n"(N));
  v8i_t f; f[0] = (int)lo.x; f[1] = (int)lo.y; f[2] = (int)lo.z; f[3] = (int)lo.w; f[4] = (int)h2.x; f[5] = (int)h2.y;
  return f;
}
template <int T> __device__ __forceinline__ void ldstep8(FRing& R, unsigned k0, unsigned k1, unsigned v0, unsigned v1) {
  if constexpr (T >= 8) ldf6<(T - 8) * 2048>(R.l[T & 3], R.k2[T & 3], k0, k1); else ldf8<T * 2048>(R.l[T & 3], R.h[T & 3], v0, v1);
}
template <int SP, int SE>
__device__ __forceinline__ void mstep8(FRing& R, f32x4 (&S)[4][2], f32x4 (&O)[8][2], const v8i_t (&qf)[2], v8i_t (&pf)[2], f32x4 (&L)[2], float nE, int sa, int sb, unsigned k0, unsigned k1, unsigned v0, unsigned v1) {
  if constexpr (SP < SE) {
    constexpr int NA = (SE - 1 - SP) < 2 ? (SE - 1 - SP) : 2;
    v8i_t f; if constexpr (SP >= 8) f = wtf6<2 * NA>(R.l[SP & 3], R.k2[SP & 3]); else f = wtf8<2 * NA>(R.l[SP & 3], R.h[SP & 3]);
    if constexpr (SP >= 8) { const f32x4 z = {nE, nE, nE, nE}; S[(SP - 8) & 3][0] = __builtin_amdgcn_mfma_scale_f32_16x16x128_f8f6f4(f, qf[0], z, 2, 2, 0, sa, 0, sb); }
    else O[SP][0] = __builtin_amdgcn_mfma_scale_f32_16x16x128_f8f6f4(f, pf[0], O[SP][0], 0, 1, 0, 0, 0, 0);
    if constexpr (SP + 3 < SE) ldstep8<SP + 3>(R, k0, k1, v0, v1);
    if constexpr (SP >= 8) { const f32x4 z = {nE, nE, nE, nE}; S[(SP - 8) & 3][1] = __builtin_amdgcn_mfma_scale_f32_16x16x128_f8f6f4(f, qf[1], z, 2, 2, 0, sa, 0, sb); }
    else O[SP][1] = __builtin_amdgcn_mfma_scale_f32_16x16x128_f8f6f4(f, pf[1], O[SP][1], 0, 1, 0, 0, 0, 0);
    if constexpr (SP == 0) { const int o1 = 0x38383838; const v8i_t ones = {o1, o1, o1, o1, o1, o1, o1, o1};
      L[0] = __builtin_amdgcn_mfma_scale_f32_16x16x128_f8f6f4(ones, pf[0], L[0], 0, 1, 0, 0, 0, 0); L[1] = __builtin_amdgcn_mfma_scale_f32_16x16x128_f8f6f4(ones, pf[1], L[1], 0, 1, 0, 0, 0, 0); }
    SBAR();
    if constexpr (SP == 11) { exp_pack8(S, pf, 0); SBAR(); }
  }
}
template <bool DO_PV, bool DO_QK, bool PRE>
__device__ __forceinline__ void mrun8(FRing& R, f32x4 (&S)[4][2], f32x4 (&O)[8][2], const v8i_t (&qf)[2], v8i_t (&pf)[2], f32x4 (&L)[2], float nE, int sa, int sb, const LAS char* kimg, const LAS char* vimg, int a0, int a1) {
  constexpr int SB = DO_PV ? 0 : 8, SE = DO_QK ? 16 : 8;
  const unsigned k0 = (unsigned)(size_t)kimg + (unsigned)a0, k1 = (unsigned)(size_t)kimg + (unsigned)a1, v0 = (unsigned)(size_t)vimg + (unsigned)a0, v1 = (unsigned)(size_t)vimg + (unsigned)a1;
  SBAR();
  if (!PRE) { ldstep8<SB>(R, k0, k1, v0, v1); ldstep8<SB + 1>(R, k0, k1, v0, v1); ldstep8<SB + 2>(R, k0, k1, v0, v1); SBAR(); }
#define MS8(sp_) mstep8<(SB + sp_ < SE ? SB + sp_ : SE), SE>(R, S, O, qf, pf, L, nE, sa, sb, k0, k1, v0, v1)
  MS8(0); MS8(1); MS8(2); MS8(3); MS8(4); MS8(5); MS8(6); MS8(7); MS8(8); MS8(9); MS8(10); MS8(11); MS8(12); MS8(13); MS8(14); MS8(15);
#undef MS8
}
__device__ __forceinline__ float xsum16(float x) { auto r = __builtin_amdgcn_permlane16_swap(__float_as_uint(x), __float_as_uint(x), false, false); return __uint_as_float(r[0]) + __uint_as_float(r[1]); }
__device__ __forceinline__ float xsum32(float x) { auto r = __builtin_amdgcn_permlane32_swap(__float_as_uint(x), __float_as_uint(x), false, false); return __uint_as_float(r[0]) + __uint_as_float(r[1]); }
__device__ __forceinline__ float xchg16(float x, bool odd) { auto r = __builtin_amdgcn_permlane16_swap(__float_as_uint(x), __float_as_uint(x), false, false); return __uint_as_float(odd ? r[0] : r[1]); }
__device__ __forceinline__ void attn_unit8(const bf16_t* Qb, const unsigned char* __restrict__ K8, const unsigned char* __restrict__ V8T, unsigned char* Ob8, int q0, char* lds, const Aux& aux, float nE, float qcv, int sa, int sb) {
  int tid = threadIdx.x; asm volatile("" : "+v"(tid));
  const int wid = tid >> 6, lane = tid & 63, fr = lane & 15, g = lane >> 4;
  const int half = __builtin_amdgcn_readfirstlane(wid >> 2);
  v8i_t qf[2];
  { char* qs = lds + 2 * BUFB + wid * 8192;
#pragma unroll
    for (int qb = 0; qb < 2; ++qb) {
      bf16x8 q16[4]; float ss = 0.f;
#pragma unroll
      for (int ks = 0; ks < 4; ++ks) { q16[ks] = *reinterpret_cast<const bf16x8*>(Qb + (long)(wid * QBLK + 16 * qb + fr) * LDQ + 32 * ks + 8 * g); const f32x8 x = bf8_to_f32(q16[ks]);
#pragma unroll
        for (int e = 0; e < 8; ++e) ss += x[e] * x[e]; }
      ss = xsum32(xsum16(ss));
      const float rinv = C / sqrtf(ss * (1.0f / 128.0f) + EPS);
      const int t = q0 + wid * QBLK + 16 * qb + fr;
#pragma unroll
      for (int hf = 0; hf < 2; ++hf) { const int posx = hf ? (t & 63) : (t >> 6);
        const f32x8 cs = *reinterpret_cast<const f32x8*>(aux.cosT + posx * 32 + 8 * g), sn = *reinterpret_cast<const f32x8*>(aux.sinT + posx * 32 + 8 * g);
        const f32x8 g1 = *reinterpret_cast<const f32x8*>(aux.qn + hf * 64 + 8 * g), g2 = *reinterpret_cast<const f32x8*>(aux.qn + hf * 64 + 32 + 8 * g);
        const f32x8 x1 = bf8_to_f32(q16[2 * hf]) * rinv * g1, x2 = bf8_to_f32(q16[2 * hf + 1]) * rinv * g2;
        const f32x8 y1 = x1 * cs - x2 * sn, y2 = x2 * cs + x1 * sn;
        *(u32x4*)(qs + (16 * qb + fr) * 256 + (32 * (2 * hf) + 8 * g) * 2) = (u32x4){cvt_pk_bf16(y1[0], y1[1]), cvt_pk_bf16(y1[2], y1[3]), cvt_pk_bf16(y1[4], y1[5]), cvt_pk_bf16(y1[6], y1[7])};
        *(u32x4*)(qs + (16 * qb + fr) * 256 + (32 * (2 * hf + 1) + 8 * g) * 2) = (u32x4){cvt_pk_bf16(y2[0], y2[1]), cvt_pk_bf16(y2[2], y2[3]), cvt_pk_bf16(y2[4], y2[5]), cvt_pk_bf16(y2[6], y2[7])}; }
    }
    asm volatile("s_waitcnt lgkmcnt(0)" ::: "memory");
#pragma unroll
    for (int qb = 0; qb < 2; ++qb) { const char* pr = qs + (16 * qb + fr) * 256 + 64 * g;
      union { u32x4 w[4]; v32bf_t v; } cv; cv.w[0] = *(const u32x4*)pr; cv.w[1] = *(const u32x4*)(pr + 16); cv.w[2] = *(const u32x4*)(pr + 32); cv.w[3] = *(const u32x4*)(pr + 48);
      const v6u_t p6 = __builtin_amdgcn_cvt_scalef32_pk32_fp6_bf16(cv.v, qcv);
      qf[qb] = (v8i_t){(int)p6[0], (int)p6[1], (int)p6[2], (int)p6[3], (int)p6[4], (int)p6[5], 0, 0}; }
    asm volatile("s_waitcnt lgkmcnt(0)" ::: "memory");
    __syncthreads(); }
  f32x4 O[8][2], S[4][2]; v8i_t pf[2]; f32x4 L[2] = {{0.f, 0.f, 0.f, 0.f}, {0.f, 0.f, 0.f, 0.f}};
#pragma unroll
  for (int i = 0; i < 8; ++i) { O[i][0] = (f32x4){0.f, 0.f, 0.f, 0.f}; O[i][1] = (f32x4){0.f, 0.f, 0.f, 0.f}; }
  const int a0 = off8(fr, 2 * g), a1 = off8(fr, 2 * g + 1);
  char* V_lds = lds; char* K_lds = lds + SHM_V;
  const LAS char* k3 = (const LAS char*)K_lds; const LAS char* v3 = (const LAS char*)V_lds;
  FRing fr_;
  const int widu = __builtin_amdgcn_readfirstlane(wid);
  unsigned dso[2];
#pragma unroll
  for (int i = 0; i < 2; ++i) { const int c = (wid * 2 + i) * 64 + lane, row = c >> 3, p = c & 7; dso[i] = (unsigned)(row * 128 + ((p ^ (((row >> 1) & 1) | (((row >> 2) & 1) << 2))) << 4)); }
  const unsigned ldsw = (unsigned)widu * 2048u; LAS unsigned char* l3 = (LAS unsigned char*)lds;
#define DMA_TILE(t_) do { const unsigned char* kg_ = K8 + (size_t)(t_) * 16384; const unsigned char* vg_ = V8T + (size_t)(t_) * 16384; const unsigned bo_ = (unsigned)(((t_) & 3) * BUFB); \
    _Pragma("unroll") for (int i_ = 0; i_ < 2; ++i_) { \
      __builtin_amdgcn_global_load_lds((const unsigned*)(vg_ + dso[i_]), (LAS unsigned*)(l3 + bo_ + ldsw + i_ * 1024), 16, 0, 0); \
      __builtin_amdgcn_global_load_lds((const unsigned*)(kg_ + dso[i_]), (LAS unsigned*)(l3 + bo_ + SHM_V + ldsw + i_ * 1024), 16, 0, 0); } } while (0)
#define VMW0() asm volatile("s_waitcnt vmcnt(0)" ::: "memory")
#define BAR() asm volatile("s_waitcnt lgkmcnt(0)\n\ts_barrier" ::: "memory")
#define VSEG(j, pbuf_) do { VMW0(); { const int nx_ = (j) + 2 + half; if (nx_ < NT) DMA_TILE(nx_); } SBAR(); \
    exp_pack8(S, pf, 1); \
    SBAR(); { const unsigned pv0_ = (unsigned)(size_t)(v3 + (pbuf_)) + (unsigned)a0, pv1_ = (unsigned)(size_t)(v3 + (pbuf_)) + (unsigned)a1; ldstep8<0>(fr_, 0u, 0u, pv0_, pv1_); ldstep8<1>(fr_, 0u, 0u, pv0_, pv1_); ldstep8<2>(fr_, 0u, 0u, pv0_, pv1_); } SBAR(); } while (0)
  constexpr int NT = SEQ / 128;
  DMA_TILE(0); DMA_TILE(1); if (half) DMA_TILE(2);
  VMW0(); BAR();
#define BARN() asm volatile("s_barrier" ::: "memory")
  if (half == 0) {
    mrun8<false, true, false>(fr_, S, O, qf, pf, L, nE, sa, sb, k3, v3, a0, a1);
    VSEG(0, 0);
    BARN();
    for (int j = 1; j < NT; ++j) {
      mrun8<true, true, true>(fr_, S, O, qf, pf, L, nE, sa, sb, k3 + (j & 3) * BUFB, v3 + ((j - 1) & 3) * BUFB, a0, a1);
      VSEG(j, (j & 3) * BUFB);
      BARN();
    }
    mrun8<true, false, true>(fr_, S, O, qf, pf, L, nE, sa, sb, k3, v3 + ((NT - 1) & 3) * BUFB, a0, a1);
  } else {
    mrun8<false, true, false>(fr_, S, O, qf, pf, L, nE, sa, sb, k3, v3, a0, a1);
    BARN();
    for (int j = 1; j < NT; ++j) {
      VSEG(j - 1, ((j - 1) & 3) * BUFB);
      mrun8<true, true, true>(fr_, S, O, qf, pf, L, nE, sa, sb, k3 + (j & 3) * BUFB, v3 + ((j - 1) & 3) * BUFB, a0, a1);
      BARN();
    }
    VSEG(NT - 1, ((NT - 1) & 3) * BUFB);
    mrun8<true, false, true>(fr_, S, O, qf, pf, L, nE, sa, sb, k3, v3 + ((NT - 1) & 3) * BUFB, a0, a1);
  }
#undef BARN
  float rl[2];
#pragma unroll
  for (int qb = 0; qb < 2; ++qb) rl[qb] = __builtin_amdgcn_rcpf(L[qb][0]);
  VMW0();
  __syncthreads();
  char* ost = lds + OFF_OST + wid * 4096;
#pragma unroll
  for (int db = 0; db < 8; ++db)
#pragma unroll
    for (int qb = 0; qb < 2; ++qb) { const f32x4 v = O[db][qb] * (rl[qb] * OA8S); int w = 0; w = __builtin_amdgcn_cvt_pk_fp8_f32(v[0], v[1], w, false); w = __builtin_amdgcn_cvt_pk_fp8_f32(v[2], v[3], w, true);
      *(int*)(ost + (16 * qb + fr) * 128 + 16 * db + 4 * g) = w; }
  asm volatile("s_waitcnt lgkmcnt(0)" ::: "memory");
  unsigned char* Ow = Ob8 + (long)(wid * QBLK) * QW;
#pragma unroll
  for (int i = 0; i < 4; ++i) { const int ch = i * 64 + lane, row = ch >> 3, c16 = ch & 7;
    const u32x4 v = *(const u32x4*)(ost + row * 128 + c16 * 16); *(u32x4*)(Ow + (long)row * QW + c16 * 16) = v; }
  asm volatile("s_waitcnt lgkmcnt(0)" ::: "memory");
  __syncthreads();
#undef DMA_TILE
#undef VMW0
#undef BAR
#undef VSEG
}
}

#define XB_TMO      128
#define XB_XCNT(j)  (256  + 64 * (j))
#define XB_XSUB(j)  (1280 + 64 * (j))
#define XB_XGEN(j)  (2304 + 64 * (j))
#define XB_TOP      3328
#define XB_TOPGEN   3392
#define XCD_BAR_WORDS 3456
#define XB_SPIN_CAP (1u << 18)
__device__ __forceinline__ unsigned xb_ld(unsigned* p)              { return __hip_atomic_load(p, __ATOMIC_RELAXED, __HIP_MEMORY_SCOPE_AGENT); }
__device__ __forceinline__ unsigned xb_add(unsigned* p, unsigned v) { return __hip_atomic_fetch_add(p, v, __ATOMIC_RELAXED, __HIP_MEMORY_SCOPE_AGENT); }
__device__ __forceinline__ unsigned xb_xcc_id() { return (unsigned)__builtin_amdgcn_s_getreg((3 << 11) | 20) & 0xFu; }
#define XB_SPIN(cond, bar) do { unsigned _sp = 0; while (cond) { __builtin_amdgcn_s_sleep(1); \
    if ((++_sp & 255u) == 0u) { if (xb_ld(&(bar)[XB_TMO])) break; if (_sp > XB_SPIN_CAP) { atomicAdd(&(bar)[XB_TMO], 1u); break; } } } } while (0)
struct XcdBarrier { unsigned* bar; unsigned x; volatile LAS unsigned* st; };
__device__ __forceinline__ XcdBarrier xcd_barrier_post(unsigned* bar, volatile LAS unsigned* st) {
    XcdBarrier b; b.bar = bar; b.x = xb_xcc_id(); b.st = st;
    if (threadIdx.x == 0) (void)xb_add(&bar[XB_XCNT(b.x)], 1u);
    return b;
}
__device__ __forceinline__ void xcd_barrier_complete(unsigned* bar, unsigned x, unsigned& nloc, unsigned& nx) {
    const unsigned G = gridDim.x * gridDim.y * gridDim.z;
    unsigned sum, cnt, mine, sp = 0u;
    for (;;) {
        sum = 0u; cnt = 0u; mine = 0u;
#pragma unroll
        for (unsigned j = 0; j < 16; ++j) { const unsigned c = xb_ld(&bar[XB_XCNT(j)]); sum += c; cnt += (c > 0u) ? 1u : 0u; mine = (j == x) ? c : mine; }
        if (sum == G) break;
        __builtin_amdgcn_s_sleep(1);
        if ((++sp & 255u) == 0u) { if (xb_ld(&bar[XB_TMO])) break; if (sp > XB_SPIN_CAP) { atomicAdd(&bar[XB_TMO], 1u); break; } }
    }
    nloc = mine > 0u ? mine : 1u; nx = cnt > 0u ? cnt : 1u;
}
__device__ __forceinline__ void xcd_barrier(const XcdBarrier& b) {
    asm volatile("s_waitcnt vmcnt(0)" ::: "memory");
    __syncthreads();
    if (threadIdx.x == 0) {
        unsigned* bar = b.bar;
        __builtin_amdgcn_s_waitcnt(0);
        unsigned nloc = b.st[0], nx = b.st[1];
        if (nloc == 0u) { xcd_barrier_complete(bar, b.x, nloc, nx); b.st[0] = nloc; b.st[1] = nx; }
        const unsigned old = xb_add(&bar[XB_XSUB(b.x)], 1u);
        const unsigned gen = old / nloc;
        if (old + 1u == (gen + 1u) * nloc) {
            __builtin_amdgcn_fence(__ATOMIC_RELEASE, "agent");
            asm volatile("s_waitcnt vmcnt(0)" ::: "memory");
            const unsigned og = xb_add(&bar[XB_TOP], 1u);
            const unsigned tg = og / nx;
            if (og + 1u == (tg + 1u) * nx) xb_add(&bar[XB_TOPGEN], 1u);
            else XB_SPIN(xb_ld(&bar[XB_TOPGEN]) == tg, bar);
            __builtin_amdgcn_fence(__ATOMIC_ACQUIRE, "agent");
            xb_add(&bar[XB_XGEN(b.x)], 1u);
            asm volatile("s_waitcnt vmcnt(0)" ::: "memory");
        } else {
            XB_SPIN(xb_ld(&bar[XB_XGEN(b.x)]) == gen, bar);
            __builtin_amdgcn_fence(__ATOMIC_ACQUIRE, "agent");
            asm volatile("s_waitcnt vmcnt(0)" ::: "memory");
        }
    }
    __syncthreads();
}

struct Args { const float* in[17]; float* out; unsigned char* ws; int ph_lo, ph_hi, li, pad; };
struct Frame { LAS unsigned char* lds; int tid, lane, wave, vcu, G; };
constexpr int NWAVES = 8;

__device__ __forceinline__ void tr_item(const float* W, int N, int k0, int n0, bf16_t* WT, int Kd, int drow0, LAS float* scr, int lane, unsigned char* WT8 = nullptr, bool wr16 = true) {
    float tv[32];
#pragma unroll
    for (int i = 0; i < 32; ++i) { const int kk = 2 * i + (lane >> 5); tv[i] = W[(size_t)(k0 + kk) * N + n0 + (lane & 31)]; }
#pragma unroll
    for (int i = 0; i < 32; ++i) { const int kk = 2 * i + (lane >> 5); scr[kk * 33 + (lane & 31)] = tv[i]; }
    LDS_WAIT(); asm volatile("" ::: "memory");
    const int c = lane & 7;
#pragma unroll
    for (int j = 0; j < 4; ++j) { const int n = (lane >> 3) + 8 * j; const LAS float* s = scr + (8 * c) * 33 + n;
        if (wr16) { u32x4 o; o.x = cvt_pk_bf16(s[0 * 33], s[1 * 33]); o.y = cvt_pk_bf16(s[2 * 33], s[3 * 33]); o.z = cvt_pk_bf16(s[4 * 33], s[5 * 33]); o.w = cvt_pk_bf16(s[6 * 33], s[7 * 33]);
            *(GAS u32x4*)(WT + (size_t)(drow0 + n) * Kd + k0 + 8 * c) = o; }
        if (WT8) { int w0 = 0, w1 = 0; w0 = __builtin_amdgcn_cvt_pk_fp8_f32(s[0 * 33] * W8S, s[1 * 33] * W8S, w0, false); w0 = __builtin_amdgcn_cvt_pk_fp8_f32(s[2 * 33] * W8S, s[3 * 33] * W8S, w0, true);
            w1 = __builtin_amdgcn_cvt_pk_fp8_f32(s[4 * 33] * W8S, s[5 * 33] * W8S, w1, false); w1 = __builtin_amdgcn_cvt_pk_fp8_f32(s[6 * 33] * W8S, s[7 * 33] * W8S, w1, true);
            *(GAS u32x2*)(WT8 + (size_t)(drow0 + n) * Kd + k0 + 8 * c) = (u32x2){(unsigned)w0, (unsigned)w1}; } }
    LDS_WAIT(); asm volatile("" ::: "memory");
}
__device__ __forceinline__ void rms_row_to_bf16(const float* xrow, const float* g, bf16_t* orow, int lane) {
    const GAS f32x4* xr = (const GAS f32x4*)xrow + lane; const GAS f32x4* gr = (const GAS f32x4*)g + lane;
    f32x4 v[8]; float s = 0.f;
#pragma unroll
    for (int j = 0; j < 8; ++j) { v[j] = xr[64 * j]; s += (v[j].x * v[j].x + v[j].y * v[j].y) + (v[j].z * v[j].z + v[j].w * v[j].w); }
    const float rinv = 1.0f / sqrtf(wave_sum(s) * (1.f / DM) + EPS);
    GAS u32x2* o8 = (GAS u32x2*)orow + lane;
#pragma unroll
    for (int j = 0; j < 8; ++j) { const f32x4 gv = gr[64 * j]; u32x2 w; w.x = cvt_pk_bf16(v[j].x * rinv * gv.x, v[j].y * rinv * gv.y); w.y = cvt_pk_bf16(v[j].z * rinv * gv.z, v[j].w * rinv * gv.w); o8[64 * j] = w; }
}

__device__ __forceinline__ void p0_prologue(const Frame& F, const Args& a) {
    unsigned char* ws = a.ws;
    LAS float* scr = (LAS float*)(F.lds + F.wave * 16384);
    const int gw = F.vcu * NWAVES + F.wave, NGW = F.G * NWAVES;
    constexpr int I_IN = (DM / 64) * (INW / 32), I_P = (QW / 64) * (DM / 32), I_O = (DM / 64) * (DM / 32);
    constexpr int NITEMS = I_IN + 2 * I_P + I_O;
    for (int it = gw; it < NITEMS; it += NGW) {
        int r = it;
        if (r < I_IN) { const int nb = INW / 32, kb = r / nb, n0 = (r % nb) * 32; tr_item(a.in[2], INW, kb * 64, n0, (bf16_t*)(ws + WS_WIN), DM, n0, scr, F.lane, ws + WS_WIN8, false); continue; } r -= I_IN;
        if (r < I_P) { const int nb = DM / 32, kb = r / nb, n0 = (r % nb) * 32; tr_item(a.in[6], DM, kb * 64, n0, (bf16_t*)(ws + WS_WPA), QW, n0, scr, F.lane, ws + WS_WPA8, false); continue; } r -= I_P;
        if (r < I_P) { const int nb = DM / 32, kb = r / nb, n0 = (r % nb) * 32; tr_item(a.in[9], DM, kb * 64, n0, (bf16_t*)(ws + WS_WPB), QW, n0, scr, F.lane, ws + WS_WPB8, false); continue; } r -= I_P;
        { const int nb = DM / 32, kb = r / nb, n0 = (r % nb) * 32; tr_item(a.in[10], DM, kb * 64, n0, (bf16_t*)(ws + WS_WO), DM, n0, scr, F.lane, ws + WS_WO8, false); }
    }
    float* cosT = (float*)(ws + WS_ROPE); float* sinT = cosT + 128 * 32;
    for (int i = blockIdx.x * 512 + F.tid; i < 128 * 32; i += F.G * 512) { const int pos = i >> 5, p = i & 31;
        const float inv = 1.0f / powf(10000.0f, (float)(2 * p) / 64.0f); const float ang = (float)pos * inv; cosT[i] = cosf(ang); sinT[i] = sinf(ang); }
    { const float* X = a.in[0]; const float* gm = a.in[1]; bf16_t* H = (bf16_t*)(ws + WS_H); const int lane = F.lane;
      f32x4 nx[8]; int m = gw;
      if (m < NTOK) { const GAS f32x4* xr = (const GAS f32x4*)(X + (size_t)m * DM) + lane;
#pragma unroll
          for (int j = 0; j < 8; ++j) nx[j] = xr[64 * j]; }
      for (; m < NTOK; m += NGW) { f32x4 v[8]; float s = 0.f;
#pragma unroll
          for (int j = 0; j < 8; ++j) { v[j] = nx[j]; s += (v[j].x * v[j].x + v[j].y * v[j].y) + (v[j].z * v[j].z + v[j].w * v[j].w); }
          { const int nm = m + NGW; if (nm < NTOK) { const GAS f32x4* xr = (const GAS f32x4*)(X + (size_t)nm * DM) + lane;
#pragma unroll
              for (int j = 0; j < 8; ++j) nx[j] = xr[64 * j]; } }
          const float rinv = 1.0f / sqrtf(wave_sum(s) * (1.f / DM) + EPS);
          GAS u32x2* o8 = (GAS u32x2*)(H + (size_t)m * DM) + lane;
#pragma unroll
          for (int j = 0; j < 8; ++j) { const f32x4 gv = ((const GAS f32x4*)gm + lane)[64 * j]; const f32x4 hv = v[j] * rinv * gv; (void)o8;
              int w8 = 0; w8 = __builtin_amdgcn_cvt_pk_fp8_f32(hv.x, hv.y, w8, false); w8 = __builtin_amdgcn_cvt_pk_fp8_f32(hv.z, hv.w, w8, true); ((GAS int*)(ws + WS_H8 + (size_t)m * DM) + lane)[64 * j] = w8; } } }
}

constexpr int CW_WCTR = 8192;
__device__ __forceinline__ void p_moe_weights(const Frame& F, const Args& a) {
    unsigned char* ws = a.ws; LAS float* scr = (LAS float*)(F.lds + F.wave * 16384);
    constexpr int I_GU = NEXP * (DM / 64) * (DFF / 32), I_D = NEXP * (DFF / 64) * (DM / 32), NIT = 2 * I_GU + I_D;
    unsigned* ctr = (unsigned*)(ws + WS_CTL) + CW_WCTR;
    for (;;) {
        unsigned it0 = 0; if (F.lane == 0) it0 = __hip_atomic_fetch_add(ctr, 4u, __ATOMIC_RELAXED, __HIP_MEMORY_SCOPE_AGENT);
        it0 = (unsigned)__builtin_amdgcn_readfirstlane((int)it0);
        if (it0 >= (unsigned)NIT) break;
        for (int k4 = 0; k4 < 4; ++k4) { int r = (int)it0 + k4; if (r >= NIT) break;
            if (r < 2 * I_GU) { const int up = r >= I_GU; if (up) r -= I_GU; constexpr int per = (DM / 64) * (DFF / 32); const int e = r / per, q = r % per, nb = DFF / 32, kb = q / nb, n0 = (q % nb) * 32;
                tr_item(a.in[up ? 14 : 13] + (size_t)e * DM * DFF, DFF, kb * 64, n0, (bf16_t*)(ws + WS_WGU), DM, (n0 >> 7) * 256 + (n0 & 127) + (up ? 128 : 0), scr, F.lane, ws + WS_WGU + (size_t)e * 2048 * DM, false); continue; }
            r -= 2 * I_GU;
            { constexpr int per = (DFF / 64) * (DM / 32); const int e = r / per, q = r % per, nb = DM / 32, kb = q / nb, n0 = (q % nb) * 32;
                tr_item(a.in[15] + (size_t)e * DFF * DM, DM, kb * 64, n0, (bf16_t*)(ws + WS_WD) + (size_t)e * 2048 * DFF, DFF, n0, scr, F.lane, ws + WS_WD8 + (size_t)e * 2048 * DFF, false); } }
    }
}

__device__ __forceinline__ void prep_vecs(const Frame& F, bf16_t* T, int ld, int nh_log2, const float* gain, const float* cosT, const float* sinT, float oscale, unsigned char* out8, float cvscale) {
    const int gw = F.vcu * NWAVES + F.wave, NGW = F.G * NWAVES;
    const int sub = F.lane & 15, half = sub >> 3, q = sub & 7;
    const int nvec = NTOK << nh_log2;
    const f32x4 g1 = *(const f32x4*)(gain + half * 64 + 4 * q), g2 = *(const f32x4*)(gain + half * 64 + 32 + 4 * q);
    for (int it = gw; it < nvec / 16; it += NGW) {
        bf16_t* base[4]; u32x2 w1[4], w2[4]; int posx[4];
#pragma unroll
        for (int u = 0; u < 4; ++u) { const int vec = it * 16 + u * 4 + (F.lane >> 4);
            const int tok = vec >> nh_log2, hd = vec & ((1 << nh_log2) - 1), pos = tok & (SEQ - 1); posx[u] = half ? (pos & 63) : (pos >> 6);
            base[u] = T + (size_t)tok * ld + hd * HD + half * 64 + 4 * q; w1[u] = *(const u32x2*)base[u]; w2[u] = *(const u32x2*)(base[u] + 32); }
#pragma unroll
        for (int u = 0; u < 4; ++u) {
            float x1[4] = {bf2f(w1[u].x & 0xffff), bf2f(w1[u].x >> 16), bf2f(w1[u].y & 0xffff), bf2f(w1[u].y >> 16)}, x2[4] = {bf2f(w2[u].x & 0xffff), bf2f(w2[u].x >> 16), bf2f(w2[u].y & 0xffff), bf2f(w2[u].y >> 16)};
            float ss = 0.f;
#pragma unroll
            for (int j = 0; j < 4; ++j) ss += x1[j] * x1[j] + x2[j] * x2[j];
            ss += __shfl_xor(ss, 1); ss += __shfl_xor(ss, 2); ss += __shfl_xor(ss, 4); ss += __shfl_xor(ss, 8);
            const float rinv = 1.0f / sqrtf(ss * (1.0f / 128.0f) + EPS);
            const f32x4 cs = *(const f32x4*)(cosT + posx[u] * 32 + 4 * q), sn = *(const f32x4*)(sinT + posx[u] * 32 + 4 * q);
            float y1[4], y2[4];
#pragma unroll
            for (int j = 0; j < 4; ++j) { const float a1 = x1[j] * rinv * g1[j], a2 = x2[j] * rinv * g2[j]; y1[j] = (a1 * cs[j] - a2 * sn[j]) * oscale; y2[j] = (a2 * cs[j] + a1 * sn[j]) * oscale; }
            if (out8) {
                LAS unsigned char* pt = F.lds + F.wave * 4096 + (u * 4 + (F.lane >> 4)) * 256 + (half * 64 + 4 * q) * 2;
                *(LAS u32x2*)pt = (u32x2){cvt_pk_bf16(y1[0], y1[1]), cvt_pk_bf16(y1[2], y1[3])}; *(LAS u32x2*)(pt + 64) = (u32x2){cvt_pk_bf16(y2[0], y2[1]), cvt_pk_bf16(y2[2], y2[3])};
            } else {
            u32x2 o1, o2; o1.x = cvt_pk_bf16(y1[0], y1[1]); o1.y = cvt_pk_bf16(y1[2], y1[3]); o2.x = cvt_pk_bf16(y2[0], y2[1]); o2.y = cvt_pk_bf16(y2[2], y2[3]);
            *(u32x2*)base[u] = o1; *(u32x2*)(base[u] + 32) = o2; } }
        if (out8) {
            asm volatile("s_waitcnt lgkmcnt(0)" ::: "memory");
            const int vl = F.lane >> 2, g = F.lane & 3, vec = it * 16 + vl, tok = vec >> nh_log2, hd = vec & ((1 << nh_log2) - 1);
            const LAS unsigned char* pr = F.lds + F.wave * 4096 + vl * 256 + g * 64;
            union { u32x4 w[4]; v32bf_t v; } cv; cv.w[0] = *(const LAS u32x4*)pr; cv.w[1] = *(const LAS u32x4*)(pr + 16); cv.w[2] = *(const LAS u32x4*)(pr + 32); cv.w[3] = *(const LAS u32x4*)(pr + 48);
            const v6u_t p6 = __builtin_amdgcn_cvt_scalef32_pk32_fp6_bf16(cv.v, cvscale);
            unsigned char* o6 = out8 + ((size_t)(((tok >> 13) << nh_log2) + hd) * SEQ + (tok & (SEQ - 1))) * HD + 32 * g;
            *(u32x4*)o6 = (u32x4){p6[0], p6[1], p6[2], p6[3]}; *(u32x4*)(o6 + 16) = (u32x4){p6[4], p6[5], 0u, 0u};
            asm volatile("s_waitcnt lgkmcnt(0)" ::: "memory"); }
    }
}
__device__ __forceinline__ void p2_qkprep(const Frame& F, const Args& a) {
    const float* cosT = (const float*)(a.ws + WS_ROPE); const float* sinT = cosT + 128 * 32;
    float mk = fmaxf(fabsf(a.in[5][F.lane]), fabsf(a.in[5][64 + F.lane]));
#pragma unroll
    for (int of = 1; of < 64; of <<= 1) mk = fmaxf(mk, __shfl_xor(mk, of));
    const float kexp = floorf(__builtin_amdgcn_logf(1.5f / mk));
    prep_vecs(F, (bf16_t*)(a.ws + WS_KA), KVW, 1, a.in[5], cosT, sinT, 1.0f, a.ws + WS_K8, __builtin_amdgcn_exp2f(-kexp));
    __syncthreads();
    { const bf16_t* VA = (const bf16_t*)(a.ws + WS_VA); unsigned char* V8T = a.ws + WS_V8T; LAS bf16_t* tl = (LAS bf16_t*)F.lds; constexpr int TP = 132;
      for (int T = F.vcu; T < BATCH * 2 * 64; T += F.G) { const int bk = T >> 6, t = T & 63, b = bk >> 1, kvh = bk & 1;
        { const int r = F.tid >> 2, qd = F.tid & 3; const bf16_t* src = VA + ((size_t)b * SEQ + 128 * t + r) * KVW + kvh * HD + qd * 32;
#pragma unroll
          for (int i = 0; i < 4; ++i) { const u32x4 v = *(const u32x4*)(src + 8 * i); LAS unsigned* d = (LAS unsigned*)(tl + r * TP + qd * 32 + 8 * i); d[0] = v.x; d[1] = v.y; d[2] = v.z; d[3] = v.w; } }
        __syncthreads();
        { const int d = F.tid >> 2, g = F.tid & 3; int w[8];
#pragma unroll
          for (int kb = 0; kb < 8; ++kb) { float x[4];
#pragma unroll
            for (int r = 0; r < 4; ++r) x[r] = bf2f(tl[(16 * kb + 4 * g + r) * TP + d]);
            int ww = 0; ww = __builtin_amdgcn_cvt_pk_fp8_f32(x[0], x[1], ww, false); ww = __builtin_amdgcn_cvt_pk_fp8_f32(x[2], x[3], ww, true); w[kb] = ww; }
          unsigned char* dst = V8T + ((size_t)T * HD + d) * 128 + 32 * g;
          *(u32x4*)dst = (u32x4){(unsigned)w[0], (unsigned)w[1], (unsigned)w[2], (unsigned)w[3]}; *(u32x4*)(dst + 16) = (u32x4){(unsigned)w[4], (unsigned)w[5], (unsigned)w[6], (unsigned)w[7]}; }
        __syncthreads(); } }
}

template <int MODE> __device__ __forceinline__ void p3_attention(const Frame& F, const Args& a, char* lds) {
    unsigned char* ws = a.ws;
    const bf16_t* Q = (const bf16_t*)(ws + (MODE == 0 ? WS_QA : WS_QB)); const bf16_t* K = (const bf16_t*)(ws + (MODE == 0 ? WS_KA : WS_KB)); const bf16_t* V = (const bf16_t*)(ws + (MODE == 0 ? WS_VA : WS_VB));
    att::Aux aux; aux.cosT = (const float*)(ws + WS_ROPE); aux.sinT = aux.cosT + 128 * 32; aux.qn = a.in[4]; aux.kn = a.in[5]; aux.relb = a.in[8]; aux.sink = a.in[7];
#define BUILD_TABS(kvh_) do { float* tabs_ = (float*)(lds + att::OFF_TAB); for (int i_ = F.tid; i_ < 4 * 768; i_ += 512) { const int hh_ = i_ / 768, ii_ = i_ - hh_ * 768, rel_ = ii_ - 383, n_ = rel_ < 0 ? -rel_ : rel_; float v_ = -1e30f; \
        if (n_ <= 128) v_ = aux.relb[att::t5_bucket(rel_) * NHB + (kvh_) * 4 + hh_] * LOG2E; tabs_[i_] = v_; } } while (0)
    float pscale = 1.f, qcv = 1.f; int sa6 = 0x7f7f7f7f, sb6 = 0x7f7f7f7f;
    if (MODE == 0) { float mq = fmaxf(fabsf(aux.qn[F.lane]), fabsf(aux.qn[64 + F.lane])), mk = fmaxf(fabsf(aux.kn[F.lane]), fabsf(aux.kn[64 + F.lane]));
#pragma unroll
        for (int of = 1; of < 64; of <<= 1) { mq = fmaxf(mq, __shfl_xor(mq, of)); mk = fmaxf(mk, __shfl_xor(mk, of)); }
        const float bound = att::C * 128.0f * mq * mk * 1.13f + 0.5f; pscale = -fmaxf(ceilf(bound) - 15.f, 0.f);
        const float kexp = floorf(__builtin_amdgcn_logf(1.5f / mk)), qexp = floorf(__builtin_amdgcn_logf(1.5f / (mq * att::C)));
        qcv = __builtin_amdgcn_exp2f(-qexp); sa6 = (127 - (int)kexp) * 0x01010101; sb6 = (127 - (int)qexp) * 0x01010101;
        qcv = __uint_as_float(__builtin_amdgcn_readfirstlane(__float_as_uint(qcv))); sa6 = __builtin_amdgcn_readfirstlane(sa6); sb6 = __builtin_amdgcn_readfirstlane(sb6);
        pscale = __uint_as_float(__builtin_amdgcn_readfirstlane(__float_as_uint(pscale))); }
    const bool shared_tabs = (F.G == 256);
    if (MODE == 1 && shared_tabs) { BUILD_TABS((F.vcu >> 5) & 1); __syncthreads(); }
    for (int i = 0;; ++i) {
        const int L = i * F.G + F.vcu; if (L >= 1024) break;
        const int x = (L & 255) >> 5, b = x >> 1, kvh = x & 1;
        const int qb = (MODE == 0) ? (L & 31) : ((L >> 8) * 32 + (L & 31));
        const int head = (MODE == 0) ? kvh * 4 + (L >> 8) : kvh * 4, q0 = qb * ((MODE == 0) ? 256 : 64);
        const bf16_t* Qb = Q + ((size_t)b * SEQ + q0) * QW + head * HD;
        const bf16_t* Kh = K + (size_t)b * SEQ * KVW + kvh * HD; const bf16_t* Vh = V + (size_t)b * SEQ * KVW + kvh * HD;
        int kbeg = 0, kend = SEQ;
        if (MODE == 1) { kbeg = q0 - 128 < 0 ? 0 : q0 - 128; kend = q0 + 192 > SEQ ? SEQ : q0 + 192; }
        if (MODE == 1 && !shared_tabs) { __syncthreads(); BUILD_TABS(kvh); __syncthreads(); }
        unsigned char* Ob8 = ws + (MODE == 0 ? WS_OA8 : WS_OB8) + ((size_t)b * SEQ + q0) * QW + head * HD;
        if constexpr (MODE == 0) att::attn_unit8(Qb, a.ws + WS_K8 + (size_t)(b * 2 + kvh) * SEQ * HD, a.ws + WS_V8T + (size_t)(b * 2 + kvh) * 64 * 16384, Ob8, q0, lds, aux, pscale, qcv, sa6, sb6);
        else att::attn_unit_pp<MODE>(Qb, Kh, Vh, Ob8, kbeg, kend, q0, head, lds, aux);
    }
#undef BUILD_TABS
}

__device__ __forceinline__ void p7_router(const Frame& F, const Args& a) {
    LAS float* wl = (LAS float*)F.lds;
    const float* wr = a.in[12];
    for (int i = F.tid; i < DM * NEXP / 4; i += 512) { const f32x4 v = *(const f32x4*)(wr + 4 * i); const int k = i >> 2, e0 = (i & 3) * 4;
        wl[(e0 + 0) * DM + k] = v.x; wl[(e0 + 1) * DM + k] = v.y; wl[(e0 + 2) * DM + k] = v.z; wl[(e0 + 3) * DM + k] = v.w; }
    __syncthreads();
    const float* X = a.in[0]; const unsigned char* ATT = a.ws + WS_ATT; bf16_t* H2 = (bf16_t*)(a.ws + WS_H); float* AFF = (float*)(a.ws + WS_AFF); const float* g = a.in[11];
    const int gw = F.vcu * NWAVES + F.wave, NGW = F.G * NWAVES, lane = F.lane;
    f32x4 nx[2][8]; unsigned na[2][8];
#define RT_LOAD(rp_) do { _Pragma("unroll") for (int rr = 0; rr < 2; ++rr) { const size_t row_ = (size_t)(2 * (rp_) + rr); const GAS f32x4* xr = (const GAS f32x4*)(X + row_ * DM) + lane; const GAS unsigned* ar = (const GAS unsigned*)(ATT + row_ * DM) + lane; \
        _Pragma("unroll") for (int j = 0; j < 8; ++j) { nx[rr][j] = xr[64 * j]; if (DBG_LEVEL >= 3) na[rr][j] = ar[64 * j]; else na[rr][j] = 0u; } } } while (0)
    int rp = gw;
    if (rp < NTOK / 2) RT_LOAD(rp);
    for (; rp < NTOK / 2; rp += NGW) {
        f32x4 h[2][8]; float rinv[2];
#pragma unroll
        for (int rr = 0; rr < 2; ++rr) { float s = 0.f;
#pragma unroll
            for (int j = 0; j < 8; ++j) { f32x4 v = nx[rr][j]; const int w = (int)na[rr][j]; const auto a01 = __builtin_amdgcn_cvt_pk_f32_fp8(w, false), a23 = __builtin_amdgcn_cvt_pk_f32_fp8(w, true);
                v.x += a01[0] * (1.0f / ATT8S); v.y += a01[1] * (1.0f / ATT8S); v.z += a23[0] * (1.0f / ATT8S); v.w += a23[1] * (1.0f / ATT8S);
                h[rr][j] = v; s += (v.x * v.x + v.y * v.y) + (v.z * v.z + v.w * v.w); }
            rinv[rr] = s; }
#if DBG_LEVEL >= 3
#pragma unroll
        for (int rr = 0; rr < 2; ++rr) { GAS u32x2* x8 = (GAS u32x2*)((bf16_t*)(a.ws + WS_X1B) + (size_t)(2 * rp + rr) * DM) + lane;
#pragma unroll
            for (int j = 0; j < 8; ++j) { u32x2 w; w.x = cvt_pk_bf16(h[rr][j].x, h[rr][j].y); w.y = cvt_pk_bf16(h[rr][j].z, h[rr][j].w); x8[64 * j] = w; } }
#endif
        { const int nrp = rp + NGW; if (nrp < NTOK / 2) RT_LOAD(nrp); }
#pragma unroll
        for (int rr = 0; rr < 2; ++rr) { rinv[rr] = 1.0f / sqrtf(wave_sum(rinv[rr]) * (1.f / DM) + EPS);
            GAS int* o8 = (GAS int*)((unsigned char*)H2 + (size_t)(2 * rp + rr) * DM) + lane;
#pragma unroll
            for (int j = 0; j < 8; ++j) { const f32x4 gv = ((const GAS f32x4*)g + lane)[64 * j]; h[rr][j] = h[rr][j] * rinv[rr] * gv;
                int w = 0; w = __builtin_amdgcn_cvt_pk_fp8_f32(h[rr][j].x, h[rr][j].y, w, false); w = __builtin_amdgcn_cvt_pk_fp8_f32(h[rr][j].z, h[rr][j].w, w, true); o8[64 * j] = w; } }
        float v[32];
#pragma unroll
        for (int e = 0; e < NEXP; ++e) { float s0 = 0.f, s1 = 0.f;
#pragma unroll
            for (int j = 0; j < 8; ++j) { const f32x4 w = *(const LAS f32x4*)(wl + e * DM + 4 * lane + 256 * j);
                s0 += (h[0][j].x * w.x + h[0][j].y * w.y) + (h[0][j].z * w.z + h[0][j].w * w.w); s1 += (h[1][j].x * w.x + h[1][j].y * w.y) + (h[1][j].z * w.z + h[1][j].w * w.w); }
            v[e] = s0; v[16 + e] = s1; }
#pragma unroll
        for (int off = 16; off >= 1; off >>= 1) { const bool up = (lane & off) != 0;
#pragma unroll
            for (int i = 0; i < off; ++i) { const float lo = v[i], hi = v[i + off]; const float keep = up ? hi : lo, send = up ? lo : hi; v[i] = keep + __shfl_xor(send, off); } }
        const float mine = v[0] + __shfl_xor(v[0], 32);
        float mx = mine; mx = fmaxf(mx, __shfl_xor(mx, 1)); mx = fmaxf(mx, __shfl_xor(mx, 2)); mx = fmaxf(mx, __shfl_xor(mx, 4)); mx = fmaxf(mx, __shfl_xor(mx, 8));
        const float ex = expf(mine - mx); float sm = ex; sm += __shfl_xor(sm, 1); sm += __shfl_xor(sm, 2); sm += __shfl_xor(sm, 4); sm += __shfl_xor(sm, 8);
        if (lane < 32) { const int row = 2 * rp + (lane >> 4), e = lane & 15, b = row >> 13, s = row & (SEQ - 1); AFF[((size_t)(b * NEXP + e)) * SEQ + s] = ex / sm; }
    }
#undef RT_LOAD
    __syncthreads();
}

__device__ __forceinline__ int block_excl_scan(int v, LAS int* sc, int tid, int& total) {
    const int lane = tid & 63, w = tid >> 6; int x = v;
#pragma unroll
    for (int o = 1; o < 64; o <<= 1) { const int y = __shfl_up(x, o); if (lane >= o) x += y; }
    __syncthreads();
    if (lane == 63) sc[w] = x;
    __syncthreads();
    int pre = 0, tot = 0;
#pragma unroll
    for (int j = 0; j < 8; ++j) { const int s = sc[j]; if (j < w) pre += s; tot += s; }
    total = tot; return pre + x - v;
}
__device__ __forceinline__ void p8_topk(const Frame& F, const Args& a) {
    const float* AFF = (const float*)(a.ws + WS_AFF); int* IDX = (int*)(a.ws + WS_IDX); float* GATEV = (float*)(a.ws + WS_GATEV); int* INV = (int*)(a.ws + WS_INV);
    LAS int* hist = (LAS int*)F.lds; LAS int* sc = hist + 256; LAS int* res = sc + 16;
    const int tid = F.tid, lane = F.lane;
    for (int list = F.vcu; list < NLIST; list += F.G) {
        const int b = list / NEXP, e = list % NEXP;
        unsigned key[16];
        { const u32x4* src = (const u32x4*)(AFF + (size_t)list * SEQ + tid * 16);
#pragma unroll
            for (int j = 0; j < 4; ++j) { const u32x4 v = src[j]; key[4 * j] = v.x; key[4 * j + 1] = v.y; key[4 * j + 2] = v.z; key[4 * j + 3] = v.w; } }
        unsigned prefix = 0u, pmask = 0u; int krem = CAP;
#pragma unroll 1
        for (int pass = 0; pass < 4; ++pass) { const int shift = 24 - 8 * pass;
            __syncthreads();
            if (tid < 256) hist[tid] = 0;
            __syncthreads();
#pragma unroll
            for (int j = 0; j < 16; ++j) if ((key[j] & pmask) == prefix) __hip_atomic_fetch_add(&hist[(key[j] >> shift) & 255u], 1, __ATOMIC_RELAXED, __HIP_MEMORY_SCOPE_WORKGROUP);
            __syncthreads();
            if (tid < 64) {
                int c[4]; int s = 0;
#pragma unroll
                for (int j = 0; j < 4; ++j) { c[j] = hist[4 * lane + j]; s += c[j]; }
                int suf = s;
#pragma unroll
                for (int o = 1; o < 64; o <<= 1) { const int y = __shfl_down(suf, o); if (lane + o < 64) suf += y; }
                const int excl = suf - s;
                if (suf >= krem && excl < krem) { int cum = excl, bin = 4 * lane, kn = krem;
#pragma unroll
                    for (int j = 3; j >= 0; --j) { if (cum < krem && cum + c[j] >= krem) { bin = 4 * lane + j; kn = krem - cum; } cum += c[j]; }
                    res[0] = bin; res[1] = kn; }
            }
            __syncthreads();
            const int bin = res[0]; krem = res[1];
            prefix |= ((unsigned)bin) << shift; pmask |= 255u << shift;
        }
        const unsigned T = prefix;
        int ceq = 0;
#pragma unroll
        for (int j = 0; j < 16; ++j) ceq += (key[j] == T) ? 1 : 0;
        int toteq; const int eqb = block_excl_scan(ceq, sc, tid, toteq);
        int csel = 0, er = eqb; unsigned selmask = 0u;
#pragma unroll
        for (int j = 0; j < 16; ++j) { bool s = key[j] > T; if (key[j] == T) { s = er < krem; ++er; } if (s) { selmask |= 1u << j; ++csel; } }
        int totsel; int pos = block_excl_scan(csel, sc, tid, totsel);
#pragma unroll
        for (int j = 0; j < 16; ++j) { const int tokpos = tid * 16 + j; int slot = -1;
            if (selmask & (1u << j)) { slot = list * CAP + pos; IDX[slot] = tokpos; GATEV[slot] = __uint_as_float(key[j]); ++pos; }
            INV[((size_t)b * SEQ + tokpos) * NEXP + e] = slot; }
        __syncthreads();
    }
}

__device__ __forceinline__ void p11_final(const Frame& F, const Args& a, bool with_moe) {
    const float* X = a.in[0]; float* OUT = a.out; const bf16_t* ATT = (const bf16_t*)(a.ws + WS_X1B); const bf16_t* Y = (const bf16_t*)(a.ws + WS_Y); const int* INV = (const int*)(a.ws + WS_INV); const float* g = a.in[16];
    const int gw = F.vcu * NWAVES + F.wave, NGW = F.G * NWAVES, lane = F.lane;
    f32x4 nx[8]; u32x2 na[8]; int ninv = -1;
#define FN_LOAD(m_) do { const GAS f32x4* xr = (const GAS f32x4*)(X + (size_t)(m_) * DM) + lane; const GAS u32x2* ar = (const GAS u32x2*)(ATT + (size_t)(m_) * DM) + lane; \
        _Pragma("unroll") for (int j = 0; j < 8; ++j) { if (DBG_LEVEL >= 3) na[j] = ar[64 * j]; else nx[j] = xr[64 * j]; } \
        ninv = (with_moe && lane < NEXP) ? INV[(size_t)(m_) * NEXP + lane] : -1; } while (0)
    int m = gw;
    if (m < NTOK) FN_LOAD(m);
    for (; m < NTOK; m += NGW) {
        f32x4 v[8]; const int myinv = ninv;
#pragma unroll
        for (int j = 0; j < 8; ++j) { if (DBG_LEVEL >= 3) { const u32x2 w = na[j]; v[j].x = __uint_as_float(w.x << 16); v[j].y = __uint_as_float(w.x & 0xffff0000u); v[j].z = __uint_as_float(w.y << 16); v[j].w = __uint_as_float(w.y & 0xffff0000u); } else v[j] = nx[j]; }
        unsigned long long mask = __ballot(myinv >= 0);
        u32x2 y0[8], y1[8], y2[8]; const bool has0 = mask != 0ull; bool has1 = false, has2 = false;
        if (has0) { const int e = __builtin_ctzll(mask); mask &= mask - 1; const int slot = __builtin_amdgcn_readlane(myinv, e); const GAS u32x2* yr = (const GAS u32x2*)(Y + (size_t)slot * DM) + lane;
#pragma unroll
            for (int j = 0; j < 8; ++j) y0[j] = yr[64 * j];
            has1 = mask != 0ull;
            if (has1) { const int e1 = __builtin_ctzll(mask); mask &= mask - 1; const int slot1 = __builtin_amdgcn_readlane(myinv, e1); const GAS u32x2* yr1 = (const GAS u32x2*)(Y + (size_t)slot1 * DM) + lane;
#pragma unroll
                for (int j = 0; j < 8; ++j) y1[j] = yr1[64 * j];
                has2 = mask != 0ull;
                if (has2) { const int e2 = __builtin_ctzll(mask); mask &= mask - 1; const int slot2 = __builtin_amdgcn_readlane(myinv, e2); const GAS u32x2* yr2 = (const GAS u32x2*)(Y + (size_t)slot2 * DM) + lane;
#pragma unroll
                    for (int j = 0; j < 8; ++j) y2[j] = yr2[64 * j]; } } }
        { const int nm = m + NGW; if (nm < NTOK) FN_LOAD(nm); }
#define ACC_Y(yy_) do { _Pragma("unroll") for (int j = 0; j < 8; ++j) { const u32x2 w = yy_[j]; v[j].x += __uint_as_float(w.x << 16); v[j].y += __uint_as_float(w.x & 0xffff0000u); v[j].z += __uint_as_float(w.y << 16); v[j].w += __uint_as_float(w.y & 0xffff0000u); } } while (0)
        if (has0) ACC_Y(y0);
        if (has1) ACC_Y(y1);
        if (has2) ACC_Y(y2);
#undef ACC_Y
        while (mask) { const int e = __builtin_ctzll(mask); mask &= mask - 1; const int slot = __builtin_amdgcn_readlane(myinv, e);
            const GAS u32x2* yr = (const GAS u32x2*)(Y + (size_t)slot * DM) + lane;
#pragma unroll
            for (int j = 0; j < 8; ++j) { const u32x2 w = yr[64 * j]; v[j].x += __uint_as_float(w.x << 16); v[j].y += __uint_as_float(w.x & 0xffff0000u); v[j].z += __uint_as_float(w.y << 16); v[j].w += __uint_as_float(w.y & 0xffff0000u); } }
        float s = 0.f;
#pragma unroll
        for (int j = 0; j < 8; ++j) s += (v[j].x * v[j].x + v[j].y * v[j].y) + (v[j].z * v[j].z + v[j].w * v[j].w);
        const float rinv = 1.0f / sqrtf(wave_sum(s) * (1.f / DM) + EPS);
        GAS f32x4* orow = (GAS f32x4*)(OUT + (size_t)m * DM) + lane;
#pragma unroll
        for (int j = 0; j < 8; ++j) { const f32x4 gv = ((const GAS f32x4*)g + lane)[64 * j]; orow[64 * j] = v[j] * rinv * gv; }
    }
#undef FN_LOAD
}
__device__ __forceinline__ void p_copy_x(const Frame& F, const Args& a) {
    const f32x4* src = (const f32x4*)a.in[0]; f32x4* dst = (f32x4*)a.out;
    for (size_t i = (size_t)blockIdx.x * 512 + F.tid; i < (size_t)NTOK * DM / 4; i += (size_t)F.G * 512) dst[i] = src[i];
}

constexpr int NPHASE = 10;
__global__ void __launch_bounds__(NWAVES * 64, 2) fwd_kernel(Args args) {
    extern __shared__ __attribute__((aligned(16))) unsigned char lds[];
    Frame F;
    F.lds = (LAS unsigned char*)lds;
    F.tid = threadIdx.x; F.lane = F.tid & 63; F.wave = __builtin_amdgcn_readfirstlane(F.tid >> 6);
    F.G = gridDim.x; { const int bx = blockIdx.x; F.vcu = (F.G % 8 == 0) ? (bx % 8) * (F.G / 8) + bx / 8 : bx; }
    unsigned char* ws = args.ws;
    gu32* ctl = (gu32*)(ws + WS_CTL);
    for (int u = F.tid; u < (LDS_BYTES - LDSCTL_OFF) / 4; u += NWAVES * 64) ((LAS unsigned*)(F.lds + LDSCTL_OFF))[u] = 0u;
    __syncthreads();
    XcdBarrier bar; bar.bar = (unsigned*)(ctl + CW_BAR); bar.x = 0; bar.st = nullptr;
    if (MK_N_LAUNCHES == 1) bar = xcd_barrier_post((unsigned*)(ctl + CW_BAR), (volatile LAS unsigned*)(F.lds + LDSCTL_OFF + 64));
    const int lo = args.ph_lo, hi = args.ph_hi;
#define IN(k) (lo <= (k) && (k) < hi)
#define SEAM(k) do { if (IN(k) && IN((k) + 1)) xcd_barrier(bar); } while (0)
#define REFRAME() do { int t_ = threadIdx.x; asm volatile("" : "+v"(t_)); F.tid = t_; F.lane = t_ & 63; F.wave = __builtin_amdgcn_readfirstlane(t_ >> 6); } while (0)

    if (IN(0)) { REFRAME(); for (int rep = 0; rep < REPS(0); ++rep) p0_prologue(F, args); }
    SEAM(0);
    if (IN(1)) { REFRAME();
#if DBG_LEVEL >= 3
        { pg8::MapProb<DM, 0, 1> P; P.A = ws + WS_H8; P.Bt = ws + WS_WIN8; P.S.init(NTOK, INW, F.G, (int)blockIdx.x);
          pg8::EpiInProj E{(bf16_t*)(ws + WS_QA), (bf16_t*)(ws + WS_KA), (bf16_t*)(ws + WS_VA), (bf16_t*)(ws + WS_QB), (bf16_t*)(ws + WS_KB), (bf16_t*)(ws + WS_VB), (bf16_t*)(ws + WS_GA), (bf16_t*)(ws + WS_GB), args.in[3], 1.0f / W8S};
          pg8::gemm_phase8<pg8::EpiInProj, pg8::MapProb<DM, 0, 1>, true>(F.lds, P, E); }
#endif
    }
    SEAM(1);
    if (IN(2)) { REFRAME();
#if DBG_LEVEL >= 4
        p2_qkprep(F, args);
#endif
    }
    SEAM(2);
    if (IN(3)) { REFRAME();
#if DBG_LEVEL >= 4
        for (int rep = 0; rep < REPS(3); ++rep) p3_attention<0>(F, args, (char*)lds);
#endif
#if DBG_LEVEL >= 3
        __syncthreads();
        for (int rep = 0; rep < REPS(13); ++rep) p3_attention<1>(F, args, (char*)lds);
        __syncthreads();
#endif
    }
    SEAM(3);
    if (IN(4)) { REFRAME();
#if DBG_LEVEL >= 4
        { pg8::MapProb<QW, 0, 1> P; P.A = ws + WS_OA8; P.Bt = ws + WS_WPA8; P.S.init(NTOK, DM, F.G, (int)blockIdx.x);
          pg8::EpiGated8<0> E{ws + WS_GA8, nullptr, ws + WS_M18, 1.0f / (OA8S * W8S)};
          pg8::gemm_phase8<pg8::EpiGated8<0>, pg8::MapProb<QW, 0, 1>, true>(F.lds, P, E); }
        { int gg_ = F.G; asm volatile("" : "+s"(gg_)); unsigned char* ws2_ = ws; asm volatile("" : "+s"(ws2_));
          pg8::MapProb<QW, 0, 1> P; P.A = ws2_ + WS_OB8; P.Bt = ws2_ + WS_WPB8; P.S.init(NTOK, DM, gg_, (int)blockIdx.x);
          pg8::EpiGated8<1> E{ws2_ + WS_GB8, ws2_ + WS_M18, ws2_ + WS_M8, 1.0f / (OB8S * W8S)};
          pg8::gemm_phase8<pg8::EpiGated8<1>, pg8::MapProb<QW, 0, 1>, true>(F.lds, P, E); }
#endif
    }
    SEAM(4);
    if (IN(5)) { REFRAME();
#if DBG_LEVEL >= 3
        pg8::MapProb<DM, 0, 1> P; P.A = ws + WS_M8; P.Bt = ws + WS_WO8; P.S.init(NTOK, DM, F.G, (int)blockIdx.x);
        pg8::EpiAtt E{ws + WS_ATT, ATT8S / (M8S * W8S)};
        for (int rep = 0; rep < REPS(5); ++rep) pg8::gemm_phase8<pg8::EpiAtt, pg8::MapProb<DM, 0, 1>, true>(F.lds, P, E);
#endif
    }
    SEAM(5);
    if (IN(6)) { REFRAME();
#if DBG_LEVEL >= 2
        for (int rep = 0; rep < REPS(6); ++rep) p7_router(F, args);
#endif
    }
    SEAM(6);
    if (IN(7)) { REFRAME();
#if DBG_LEVEL >= 2
        for (int rep = 0; rep < REPS(7); ++rep) p8_topk(F, args);
        __syncthreads();
        p_moe_weights(F, args);
#endif
    }
    SEAM(7);
    if (IN(8)) { REFRAME();
#if DBG_LEVEL >= 2
        LAS unsigned* rowoff = (LAS unsigned*)(F.lds + pg8::STAGE_BYTES);
        const int* IDX = (const int*)(ws + WS_IDX);
        for (int i = 0; i < 8; ++i) { pg8::Unit u; int e, b; if (!pg8::moe_unit(i, F.G, F.vcu, u, e, b)) break;
            if (F.tid < 256) rowoff[i * 256 + F.tid] = (unsigned)IDX[u.pm * 256 + F.tid] * (unsigned)DM; }
        __syncthreads();
        pg8::GuProb8 P; P.H2 = ws + WS_H; P.W = ws + WS_WGU; P.rowoff = rowoff; P.G = F.G; P.vcu = F.vcu;
        pg8::EpiSwiglu E{ws + WS_GA, 1.0f / W8S};
        for (int rep = 0; rep < REPS(8); ++rep) pg8::gemm_phase8<pg8::EpiSwiglu, pg8::GuProb8, true>(F.lds, P, E);
#endif
    }
    SEAM(8);
    if (IN(9)) { REFRAME();
#if DBG_LEVEL >= 2
        pg8::DownProb8 P; P.HID = ws + WS_GA; P.W = ws + WS_WD8; P.G = F.G; P.vcu = F.vcu;
        pg8::EpiDown E{(bf16_t*)(ws + WS_Y), (const float*)(ws + WS_GATEV), 1.0f / W8S};
        for (int rep = 0; rep < REPS(9); ++rep) pg8::gemm_phase8<pg8::EpiDown, pg8::DownProb8, true>(F.lds, P, E);
#endif
    }
    SEAM(9);
    if (IN(10)) { REFRAME(); p11_final(F, args, DBG_LEVEL >= 2); }
#undef IN
#undef SEAM
}

extern "C" void kernel_launch(void* const* d_in, const int* in_sizes, int n_in, void* d_out, int out_size, void* d_ws, size_t ws_size, hipStream_t stream) {
    static int grid = 0;
    if (grid == 0) {
        if (n_in != 17 || in_sizes[0] != NTOK * DM || out_size != NTOK * DM || ws_size < WS_END) { fprintf(stderr, "kernel_launch: unexpected shapes (n_in %d, in0 %d, out %d, ws %zu); nothing launched\n", n_in, n_in > 0 ? in_sizes[0] : -1, out_size, ws_size); grid = -1; return; }
        int dev = 0, cus = 0, per_cu = 0;
        if (hipGetDevice(&dev) != hipSuccess || hipDeviceGetAttribute(&cus, hipDeviceAttributeMultiprocessorCount, dev) != hipSuccess) { grid = -1; return; }
        if (hipFuncSetAttribute((const void*)fwd_kernel, hipFuncAttributeMaxDynamicSharedMemorySize, LDS_BYTES) != hipSuccess) { fprintf(stderr, "kernel_launch: hipFuncSetAttribute failed\n"); grid = -1; return; }
        if (hipOccupancyMaxActiveBlocksPerMultiprocessor(&per_cu, (const void*)fwd_kernel, NWAVES * 64, LDS_BYTES) != hipSuccess || per_cu < 1)
            fprintf(stderr, "kernel_launch: note: occupancy query reports %d workgroups per CU\n", per_cu);
        (void)hipGetLastError();
        grid = cus;
    }
    if (grid < 0) return;
    (void)hipMemsetAsync((char*)d_ws + WS_CTL, 0, CTL_ZERO_BYTES, stream);
    Args a{};
    for (int i = 0; i < 17; ++i) a.in[i] = (const float*)d_in[i];
    a.out = (float*)d_out; a.ws = (unsigned char*)d_ws;
#if MK_N_LAUNCHES == 1
    a.ph_lo = 0; a.ph_hi = NPHASE + 1; a.li = 0;
    hipLaunchKernelGGL(fwd_kernel, dim3(grid), dim3(NWAVES * 64), LDS_BYTES, stream, a);
#else
    for (int li = 0; li <= NPHASE; ++li) { a.ph_lo = li; a.ph_hi = li + 1; a.li = li;
        hipLaunchKernelGGL(fwd_kernel, dim3(grid), dim3(NWAVES * 64), LDS_BYTES, stream, a); }
#endif
    const hipError_t le = hipPeekAtLastError();
    if (le != hipSuccess) fprintf(stderr, "kernel_launch: launch failed: %s\n", hipGetErrorName(le));
}
```

```cpp
#include <hip/hip_runtime.h>
#include <cstdio>
#include <cstdint>

#ifndef MK_N_LAUNCHES
#define MK_N_LAUNCHES 1
#endif
#ifndef DBG_LEVEL
#define DBG_LEVEL 4
#endif

#ifndef REP_PHASE
#ifndef MOE_CLAIMS_PER_SLOT
#define MOE_CLAIMS_PER_SLOT 2
#endif
#define REP_PHASE -1
#endif
#define REPS(k) ((REP_PHASE == (k)) ? 2 : 1)
#define GAS __attribute__((address_space(1)))
#define LAS __attribute__((address_space(3)))
typedef unsigned short bf16_t;
typedef short bf16x8 __attribute__((ext_vector_type(8)));
typedef short s16x4 __attribute__((ext_vector_type(4)));
typedef float f32x2 __attribute__((ext_vector_type(2)));
typedef float f32x4 __attribute__((ext_vector_type(4)));
typedef float f32x8 __attribute__((ext_vector_type(8)));
typedef float f32x16 __attribute__((ext_vector_type(16)));
typedef unsigned u32x2 __attribute__((ext_vector_type(2)));
typedef unsigned u32x4 __attribute__((ext_vector_type(4)));
typedef GAS unsigned gu32;

constexpr int BATCH = 4, SEQ = 8192, DM = 2048, NTOK = BATCH * SEQ, HD = 128;
constexpr int NHA = 8, NHB = 8;
constexpr int QW = 1024, KVW = 256, INW = 7168;
constexpr int NEXP = 16, CAP = 1024, DFF = 1024, NLIST = BATCH * NEXP, NSLOT = NLIST * CAP;
constexpr float EPS = 1e-6f, LOG2E = 1.4426950408889634f;

constexpr size_t MiB = 1u << 20;
constexpr size_t WS_CTL = 0, CTL_ZERO_BYTES = 1 * MiB;
constexpr size_t WS_ROPE = 1 * MiB;
constexpr size_t WS_AFF = 2 * MiB;
constexpr size_t WS_IDX = 4 * MiB;
constexpr size_t WS_GATEV = 4 * MiB + 256 * 1024;
constexpr size_t WS_INV = 5 * MiB;
constexpr size_t WS_WIN = 8 * MiB;
constexpr size_t WS_WPA = 36 * MiB;
constexpr size_t WS_WPB = 40 * MiB;
constexpr size_t WS_WO = 44 * MiB;
constexpr size_t WS_WGU = 52 * MiB;
constexpr size_t WS_WD = 180 * MiB;
constexpr size_t WS_H = 244 * MiB;
constexpr size_t WS_GA = 372 * MiB;
constexpr size_t WS_GB = 500 * MiB;
constexpr size_t WS_QA = 628 * MiB, WS_KA = 692 * MiB, WS_VA = 708 * MiB, WS_QB = 724 * MiB, WS_KB = 788 * MiB, WS_VB = 804 * MiB;
constexpr size_t WS_Y = 500 * MiB;
constexpr size_t WS_OA = 820 * MiB, WS_OB = 884 * MiB;
constexpr size_t WS_ATT = 820 * MiB;
constexpr size_t WS_K8 = 948 * MiB;
constexpr size_t WS_V8T = 956 * MiB;
constexpr size_t WS_H8 = 820 * MiB;
constexpr size_t WS_WIN8 = 964 * MiB;
constexpr size_t WS_WPA8 = 978 * MiB, WS_WPB8 = 980 * MiB;
constexpr size_t WS_WO8 = 982 * MiB;
constexpr size_t WS_WD8 = 986 * MiB;
constexpr size_t WS_END = 1018 * MiB;
constexpr size_t WS_OA8 = 820 * MiB, WS_OB8 = 884 * MiB;
constexpr size_t WS_GA8 = WS_GA, WS_M18 = WS_GA + 64 * MiB, WS_GB8 = WS_GB;
constexpr size_t WS_M8 = 244 * MiB;
constexpr float OB8S = 8.f, M8S = 16.f, GATE8S = 256.f;
constexpr size_t WS_X1B = 116 * MiB;
constexpr float ATT8S = 16.f;
constexpr float W8S = 32.f, OA8S = 64.f;
constexpr int CW_TMO = 0;
constexpr int CW_BAR = 4096;

constexpr int LDS_SCRATCH = 155648;
constexpr int LDSCTL_OFF = LDS_SCRATCH;
constexpr int LDS_BYTES = LDS_SCRATCH + 512;

typedef __bf16 v32bf_t __attribute__((ext_vector_type(32)));
typedef unsigned v6u_t __attribute__((ext_vector_type(6)));
__device__ __forceinline__ unsigned cvt_pk_bf16(float lo, float hi) { unsigned r; asm volatile("v_cvt_pk_bf16_f32 %0, %1, %2" : "=v"(r) : "v"(lo), "v"(hi)); return r; }
__device__ __forceinline__ float bf2f(unsigned short v) { return __uint_as_float(((unsigned)v) << 16); }
__device__ __forceinline__ unsigned short f2bf(float f) { return (unsigned short)(cvt_pk_bf16(f, 0.f) & 0xffffu); }
__device__ __forceinline__ float wave_sum(float v) {
#pragma unroll
    for (int o = 1; o < 64; o <<= 1) v += __shfl_xor(v, o);
    return v;
}
__device__ __forceinline__ float sigmoidf_fast(float z) { return __builtin_amdgcn_rcpf(1.f + __builtin_amdgcn_exp2f(-z * LOG2E)); }
#define LDS_WAIT() asm volatile("s_waitcnt lgkmcnt(0)" ::: "memory")
#define VM_WAIT() asm volatile("s_waitcnt vmcnt(0)" ::: "memory")

namespace pg8 {
constexpr int BM = 256, BK = 64, HALF = 128, HTB = HALF * BK * 2, STAGE_BYTES = 8 * HTB;
__host__ __device__ __forceinline__ int lds_byte(int r, int c) { const int st = (r >> 4) * 2 + (c >> 5), rr = r & 15, cc = c & 31, ob = rr * 64 + cc * 2; return st * 1024 + (ob ^ (((ob >> 9) & 1) << 5)); }
__host__ __device__ __forceinline__ void stage_rc(int b, int& R, int& C) { const int st = b / 1024, sb = b % 1024, swz = sb ^ (((sb >> 9) & 1) << 5); R = (st >> 1) * 16 + swz / 64; C = (st & 1) * 32 + (swz % 64) / 2; }
__host__ __device__ __forceinline__ int perm32(int rho) { const int n = rho >> 4, i = rho & 15; return 8 * (i >> 2) + 4 * n + (i & 3); }

struct Unit { int pm, pn, ord; };

struct StaticOrder {
    int nM, nN, nwg, G, c;
    __device__ void init(int M, int N, int G_, int c_) { nM = M / BM; nN = N / BM; nwg = nM * nN; G = G_; c = c_; }
    __device__ bool next(int i, Unit& u) const {
        const long L = (long)i * G + c; if (L >= nwg) return false;
        int wgid = (int)L; { const int q = nwg / 8, r = nwg % 8, xcd = wgid % 8, off = wgid / 8; wgid = (xcd < r ? xcd * (q + 1) : r * (q + 1) + (xcd - r) * q) + off; }
        const int nig = 8 * nN, gid = wgid / nig, fm = gid * 8, gsz = (nM - fm) < 8 ? (nM - fm) : 8;
        u.pm = fm + ((wgid % nig) % gsz); u.pn = (wgid % nig) / gsz; u.ord = i; return true;
    }
};

template <class Epi, class Prob, bool ALIGN_EPI>
__device__ __forceinline__ void gemm_phase(LAS unsigned char* lds, const Prob& P, const Epi& E) {
    int tid = threadIdx.x; asm volatile("" : "+v"(tid));
    const int wid = __builtin_amdgcn_readfirstlane(tid >> 6), lane = tid & 63, wr = wid >> 2, wc = wid & 3, fr = lane & 15, fq = lane >> 4;
    constexpr int K = Prob::K, nt = K / BK;
    int Rs[2], Cs[2]; unsigned voffB[2];
#pragma unroll
    for (int i = 0; i < 2; ++i) { int R, C; stage_rc(tid * 16 + i * 8192, R, C); const int Rb = Epi::PERM ? ((R & ~31) + perm32(R & 31)) : R;
        Rs[i] = R; Cs[i] = C; voffB[i] = (unsigned)(Rb * K + C) * 2u; }
    constexpr size_t kstep = (size_t)(BK * 2);
    constexpr size_t hstepB = (size_t)HALF * K * 2;
    const unsigned ldsw = (unsigned)wid * 1024u;
    const int aoff = lds_byte(wr * 64 + fr, fq * 8), boff = lds_byte(wc * 32 + fr, fq * 8);
#define PG8_SA(b, h) (((b) * 2 + (h)) * HTB)
#define PG8_SB(b, h) ((4 + (b) * 2 + (h)) * HTB)
#define PG8_STAGE(bufoff, gbase, voff) do { _Pragma("unroll") for (int _i = 0; _i < 2; ++_i) \
        __builtin_amdgcn_global_load_lds((const unsigned*)((const char*)(gbase) + (voff)[_i]), (LAS unsigned*)(lds + (bufoff) + ldsw + _i * 8192), 16, 0, 0); } while (0)
#define PG8_LDA(dst, b, h) do { _Pragma("unroll") for (int m = 0; m < 4; ++m) _Pragma("unroll") for (int k = 0; k < 2; ++k) dst[m][k] = *(const LAS bf16x8*)(lds + PG8_SA(b, h) + aoff + m * 2048 + k * 1024); } while (0)
#define PG8_LDB(dst, b, h) do { _Pragma("unroll") for (int n = 0; n < 2; ++n) _Pragma("unroll") for (int k = 0; k < 2; ++k) dst[n][k] = *(const LAS bf16x8*)(lds + PG8_SB(b, h) + boff + n * 2048 + k * 1024); } while (0)
#define PG8_MMA(ai, bj, At, Bt) do { __builtin_amdgcn_s_setprio(1); _Pragma("unroll") for (int m = 0; m < 4; ++m) _Pragma("unroll") for (int n = 0; n < 2; ++n) _Pragma("unroll") for (int k = 0; k < 2; ++k) \
        acc[ai][bj][m][n] = __builtin_amdgcn_mfma_f32_16x16x32_bf16(Bt[n][k], At[m][k], acc[ai][bj][m][n], 0, 0, 0); __builtin_amdgcn_s_setprio(0); } while (0)
#define PG8_WAIT_V(n) asm volatile("s_waitcnt vmcnt(" #n ")" ::: "memory")
#define PG8_WAIT_L(n) asm volatile("s_waitcnt lgkmcnt(" #n ")" ::: "memory")
#define PG8_BAR __builtin_amdgcn_s_barrier()
#define PG8_SCHED __builtin_amdgcn_sched_barrier(0)
    Unit cur, nxt; int ui = 0;
    if (!P.next(0, cur)) return;
    unsigned vAc[2][2], vAn[2][2];
    P.a_voff(cur, Rs, Cs, vAc);
    f32x4 acc[2][2][4][2];
#pragma unroll
    for (int a = 0; a < 2; ++a)
#pragma unroll
        for (int b = 0; b < 2; ++b)
#pragma unroll
            for (int m = 0; m < 4; ++m)
#pragma unroll
                for (int n = 0; n < 2; ++n) acc[a][b][m][n] = (f32x4){0.f, 0.f, 0.f, 0.f};
    bf16x8 At[4][2], B0[2][2], B1[2][2];
    const char* cA = P.a_base(cur); const char* cB = P.b_base(cur);
    PG8_STAGE(PG8_SB(0, 0), cB, voffB); PG8_STAGE(PG8_SB(0, 1), cB + hstepB, voffB); PG8_STAGE(PG8_SA(0, 0), cA, vAc[0]); PG8_STAGE(PG8_SA(0, 1), cA, vAc[1]);
    if (wr == 1) PG8_BAR;
    PG8_WAIT_V(2); PG8_BAR;
    PG8_STAGE(PG8_SB(1, 0), cB + kstep, voffB); PG8_STAGE(PG8_SA(1, 0), cA + kstep, vAc[0]); PG8_STAGE(PG8_SB(1, 1), cB + hstepB + kstep, voffB);
    PG8_WAIT_V(6); PG8_BAR;
    for (;;) {
        const bool has_next = P.next(ui + 1, nxt);
        const char* nA = has_next ? P.a_base(nxt) : cA; const char* nB = has_next ? P.b_base(nxt) : cB;
        if constexpr (Prob::GATHER) { if (has_next) P.a_voff(nxt, Rs, Cs, vAn);
          else { vAn[0][0] = vAc[0][0]; vAn[0][1] = vAc[0][1]; vAn[1][0] = vAc[1][0]; vAn[1][1] = vAc[1][1]; } }
        for (int t = 0; t < nt; t += 2) {
            const bool last = (t == nt - 2);
            const char* a1 = cA + (size_t)(t + 1) * kstep;
            const char* a2 = last ? nA : cA + (size_t)(t + 2) * kstep; const char* b2 = last ? nB : cB + (size_t)(t + 2) * kstep;
            const char* a3 = a2 + kstep; const char* b3 = b2 + kstep;
            unsigned va2[2][2];
            if constexpr (Prob::GATHER) { va2[0][0] = last ? vAn[0][0] : vAc[0][0]; va2[0][1] = last ? vAn[0][1] : vAc[0][1]; va2[1][0] = last ? vAn[1][0] : vAc[1][0]; va2[1][1] = last ? vAn[1][1] : vAc[1][1]; }
            else { va2[0][0] = vAc[0][0]; va2[0][1] = vAc[0][1]; va2[1][0] = vAc[1][0]; va2[1][1] = vAc[1][1]; }
            PG8_LDB(B0, 0, 0); PG8_LDB(B1, 0, 1); PG8_SCHED; PG8_LDA(At, 0, 0); PG8_STAGE(PG8_SA(1, 1), a1, vAc[1]);
            PG8_WAIT_V(8); PG8_WAIT_L(0); PG8_BAR; PG8_MMA(0, 0, At, B0); PG8_MMA(0, 1, At, B1); PG8_BAR; PG8_SCHED;
            PG8_LDA(At, 0, 1); PG8_STAGE(PG8_SB(0, 0), b2, voffB); PG8_STAGE(PG8_SB(0, 1), b2 + hstepB, voffB); PG8_STAGE(PG8_SA(0, 0), a2, va2[0]);
            PG8_WAIT_V(8); PG8_WAIT_L(0); PG8_BAR; PG8_MMA(1, 0, At, B0); PG8_MMA(1, 1, At, B1); PG8_BAR; PG8_SCHED;
            PG8_LDB(B0, 1, 0); PG8_LDB(B1, 1, 1); PG8_SCHED; PG8_LDA(At, 1, 0); PG8_STAGE(PG8_SA(0, 1), a2, va2[1]);
            PG8_WAIT_V(8); PG8_WAIT_L(0); PG8_BAR; PG8_MMA(0, 0, At, B0); PG8_MMA(0, 1, At, B1); PG8_BAR; PG8_SCHED;
            PG8_LDA(At, 1, 1); PG8_STAGE(PG8_SB(1, 0), b3, voffB); PG8_STAGE(PG8_SB(1, 1), b3 + hstepB, voffB); PG8_STAGE(PG8_SA(1, 0), a3, va2[0]);
            PG8_WAIT_V(8); PG8_WAIT_L(0); PG8_BAR; PG8_MMA(1, 0, At, B0); PG8_MMA(1, 1, At, B1); PG8_BAR; PG8_SCHED;
        }
        if constexpr (ALIGN_EPI) { if (wr == 0) PG8_BAR; }
        E(acc, cur, wr, wc, fr, fq);
        if (!has_next) break;
#pragma unroll
        for (int a = 0; a < 2; ++a)
#pragma unroll
            for (int b = 0; b < 2; ++b)
#pragma unroll
                for (int m = 0; m < 4; ++m)
#pragma unroll
                    for (int n = 0; n < 2; ++n) acc[a][b][m][n] = (f32x4){0.f, 0.f, 0.f, 0.f};
        cur = nxt; cA = nA; cB = nB; ++ui;
        if constexpr (Prob::GATHER) { vAc[0][0] = vAn[0][0]; vAc[0][1] = vAn[0][1]; vAc[1][0] = vAn[1][0]; vAc[1][1] = vAn[1][1]; }
        if constexpr (ALIGN_EPI) { if (wr == 1) PG8_BAR; }
    }
    PG8_WAIT_V(0);
    if constexpr (!ALIGN_EPI) { if (wr == 0) PG8_BAR; }
    PG8_BAR;
#undef PG8_SA
#undef PG8_SB
#undef PG8_STAGE
#undef PG8_LDA
#undef PG8_LDB
#undef PG8_MMA
#undef PG8_WAIT_V
#undef PG8_WAIT_L
#undef PG8_BAR
#undef PG8_SCHED
}
typedef int v8i_g __attribute__((ext_vector_type(8)));
__device__ __forceinline__ void glds_saddr(const void* sbase, unsigned voff, unsigned lds_dst) { unsigned keep;
    asm volatile("s_mov_b32 %0, m0\n\ts_mov_b32 m0, %3\n\ts_nop 0\n\tglobal_load_lds_dwordx4 %2, %1\n\ts_mov_b32 m0, %0" : "=&s"(keep) : "s"(sbase), "v"(voff), "s"(lds_dst) : "memory"); }
template <class Epi, class Prob, bool ALIGN_EPI>
__device__ __forceinline__ void gemm_phase8(LAS unsigned char* lds, const Prob& P, const Epi& E) {
    int tid = threadIdx.x; asm volatile("" : "+v"(tid));
    const int wid = __builtin_amdgcn_readfirstlane(tid >> 6), lane = tid & 63, wr = wid >> 2, wc = wid & 3, fr = lane & 15, fq = lane >> 4;
    constexpr int K = Prob::K, nt = K / 128;
    int Rs[2], Cs[2]; unsigned voffB[2];
#pragma unroll
    for (int i = 0; i < 2; ++i) { int R, C; stage_rc(tid * 16 + i * 8192, R, C); const int Rb = Epi::PERM ? ((R & ~31) + perm32(R & 31)) : R;
        Rs[i] = R; Cs[i] = C; voffB[i] = (unsigned)(Rb * K + C * 2); }
    constexpr size_t kstep = (size_t)128;
    constexpr size_t hstepB = (size_t)HALF * K, hstepA = (size_t)HALF * K;
    const unsigned ldsw = (unsigned)wid * 1024u; const unsigned lds0 = (unsigned)__builtin_amdgcn_readfirstlane((int)(uintptr_t)lds);
    const int aoff = lds_byte(wr * 64 + fr, fq * 16), boff = lds_byte(wc * 32 + fr, fq * 16);
#define PG8_SA(b, h) (((b) * 2 + (h)) * HTB)
#define PG8_SB(b, h) ((4 + (b) * 2 + (h)) * HTB)
#define PG8_STAGE(bufoff, gbase, voff) do { _Pragma("unroll") for (int _i = 0; _i < 2; ++_i) glds_saddr((const void*)(gbase), (voff)[_i], lds0 + (unsigned)((bufoff) + _i * 8192) + ldsw); } while (0)
#define PG8_STAGE_A1(bufoff, gbase, vo) do { if constexpr (Prob::GATHER) { PG8_STAGE(bufoff, gbase, (vo)[1]); } else { PG8_STAGE(bufoff, (gbase) + hstepA, (vo)[0]); } } while (0)
#define PG8_LDA(dst, b, h) do { _Pragma("unroll") for (int m = 0; m < 4; ++m) dst[m] = *(const LAS v8i_g*)(lds + PG8_SA(b, h) + aoff + m * 2048); } while (0)
#define PG8_LDB(dst, b, h) do { _Pragma("unroll") for (int n = 0; n < 2; ++n) dst[n] = *(const LAS v8i_g*)(lds + PG8_SB(b, h) + boff + n * 2048); } while (0)
#define PG8_MMA(ai, bj, At, Bt) do { __builtin_amdgcn_s_setprio(1); _Pragma("unroll") for (int m = 0; m < 4; ++m) _Pragma("unroll") for (int n = 0; n < 2; ++n) \
        acc[ai][bj][m][n] = __builtin_amdgcn_mfma_scale_f32_16x16x128_f8f6f4(Bt[n], At[m], acc[ai][bj][m][n], 0, 0, 0, 0, 0, 0); __builtin_amdgcn_s_setprio(0); } while (0)
#define PG8_WAIT_V(n) asm volatile("s_waitcnt vmcnt(" #n ")" ::: "memory")
#define PG8_WAIT_L(n) asm volatile("s_waitcnt lgkmcnt(" #n ")" ::: "memory")
#define PG8_BAR __builtin_amdgcn_s_barrier()
#define PG8_SCHED __builtin_amdgcn_sched_barrier(0)
    Unit cur, nxt; int ui = 0;
    if (!P.next(0, cur)) return;
    unsigned vAc[2][2];
    P.a_voff(cur, Rs, Cs, vAc);
    f32x4 acc[2][2][4][2];
#pragma unroll
    for (int a = 0; a < 2; ++a)
#pragma unroll
        for (int b = 0; b < 2; ++b)
#pragma unroll
            for (int m = 0; m < 4; ++m)
#pragma unroll
                for (int n = 0; n < 2; ++n) acc[a][b][m][n] = (f32x4){0.f, 0.f, 0.f, 0.f};
    v8i_g At[4], B0[2], B1[2];
    const char* cA = P.a_base(cur); const char* cB = P.b_base(cur);
    PG8_STAGE(PG8_SB(0, 0), cB, voffB); PG8_STAGE(PG8_SB(0, 1), cB + hstepB, voffB); PG8_STAGE(PG8_SA(0, 0), cA, vAc[0]); PG8_STAGE_A1(PG8_SA(0, 1), cA, vAc);
    if (wr == 1) PG8_BAR;
    PG8_WAIT_V(2); PG8_BAR;
    PG8_STAGE(PG8_SB(1, 0), cB + kstep, voffB); PG8_STAGE(PG8_SA(1, 0), cA + kstep, vAc[0]); PG8_STAGE(PG8_SB(1, 1), cB + hstepB + kstep, voffB);
    PG8_WAIT_V(6); PG8_BAR;
    for (;;) {
        const bool has_next = P.next(ui + 1, nxt);
        const char* nA = has_next ? P.a_base(nxt) : cA; const char* nB = has_next ? P.b_base(nxt) : cB;
        unsigned va2[2][2];
#pragma nounroll
        for (int t = 0; t < nt; t += 2) {
            const bool last = (t == nt - 2);
            const char* a1 = cA + (size_t)(t + 1) * kstep;
            const char* a2 = last ? nA : cA + (size_t)(t + 2) * kstep; const char* b2 = last ? nB : cB + (size_t)(t + 2) * kstep;
            const char* a3 = a2 + kstep; const char* b3 = b2 + kstep;
            va2[0][0] = vAc[0][0]; va2[0][1] = vAc[0][1]; va2[1][0] = vAc[1][0]; va2[1][1] = vAc[1][1];
            if constexpr (Prob::GATHER) { if (last && has_next) { int Rn[2], Cn[2];
                int t2_ = tid; asm volatile("" : "+v"(t2_));
#pragma unroll
                for (int i = 0; i < 2; ++i) stage_rc(t2_ * 16 + i * 8192, Rn[i], Cn[i]);
                P.a_voff(nxt, Rn, Cn, va2); } }
            PG8_LDB(B0, 0, 0); PG8_LDB(B1, 0, 1); PG8_SCHED; PG8_LDA(At, 0, 0); PG8_STAGE_A1(PG8_SA(1, 1), a1, vAc);
            PG8_WAIT_V(8); PG8_WAIT_L(0); PG8_BAR; PG8_MMA(0, 0, At, B0); PG8_MMA(0, 1, At, B1); PG8_BAR; PG8_SCHED;
            PG8_LDA(At, 0, 1); PG8_STAGE(PG8_SB(0, 0), b2, voffB); PG8_STAGE(PG8_SB(0, 1), b2 + hstepB, voffB); PG8_STAGE(PG8_SA(0, 0), a2, va2[0]);
            PG8_WAIT_V(8); PG8_WAIT_L(0); PG8_BAR; PG8_MMA(1, 0, At, B0); PG8_MMA(1, 1, At, B1); PG8_BAR; PG8_SCHED;
            PG8_LDB(B0, 1, 0); PG8_LDB(B1, 1, 1); PG8_SCHED; PG8_LDA(At, 1, 0); PG8_STAGE_A1(PG8_SA(0, 1), a2, va2);
            PG8_WAIT_V(8); PG8_WAIT_L(0); PG8_BAR; PG8_MMA(0, 0, At, B0); PG8_MMA(0, 1, At, B1); PG8_BAR; PG8_SCHED;
            PG8_LDA(At, 1, 1); PG8_STAGE(PG8_SB(1, 0), b3, voffB); PG8_STAGE(PG8_SB(1, 1), b3 + hstepB, voffB); PG8_STAGE(PG8_SA(1, 0), a3, va2[0]);
            PG8_WAIT_V(8); PG8_WAIT_L(0); PG8_BAR; PG8_MMA(1, 0, At, B0); PG8_MMA(1, 1, At, B1); PG8_BAR; PG8_SCHED;
        }
        if constexpr (ALIGN_EPI) { if (wr == 0) PG8_BAR; }
        { int t3_ = tid; asm volatile("" : "+v"(t3_)); const int l3_ = t3_ & 63;
          E(acc, cur, wr, wc, l3_ & 15, l3_ >> 4); }
        if (!has_next) break;
#pragma unroll
        for (int a = 0; a < 2; ++a)
#pragma unroll
            for (int b = 0; b < 2; ++b)
#pragma unroll
                for (int m = 0; m < 4; ++m)
#pragma unroll
                    for (int n = 0; n < 2; ++n) acc[a][b][m][n] = (f32x4){0.f, 0.f, 0.f, 0.f};
        cur = nxt; cA = nA; cB = nB; ++ui;
        if constexpr (Prob::GATHER) { vAc[0][0] = va2[0][0]; vAc[0][1] = va2[0][1]; vAc[1][0] = va2[1][0]; vAc[1][1] = va2[1][1]; }
        if constexpr (ALIGN_EPI) { if (wr == 1) PG8_BAR; }
    }
    PG8_WAIT_V(0);
    if constexpr (!ALIGN_EPI) { if (wr == 0) PG8_BAR; }
    PG8_BAR;
#undef PG8_SA
#undef PG8_SB
#undef PG8_STAGE
#undef PG8_STAGE_A1
#undef PG8_LDA
#undef PG8_LDB
#undef PG8_MMA
#undef PG8_WAIT_V
#undef PG8_WAIT_L
#undef PG8_BAR
#undef PG8_SCHED
}

template <int K_> struct DenseProb {
    static constexpr int K = K_; static constexpr bool GATHER = false;
    const bf16_t* A; const bf16_t* Bt; StaticOrder S;
    __device__ __forceinline__ bool next(int i, Unit& u) const { return S.next(i, u); }
    __device__ __forceinline__ const char* a_base(const Unit& u) const { return (const char*)(A + (size_t)u.pm * BM * K); }
    __device__ __forceinline__ const char* b_base(const Unit& u) const { return (const char*)(Bt + (size_t)u.pn * BM * K); }
    __device__ __forceinline__ void a_voff(const Unit&, const int (&Rs)[2], const int (&Cs)[2], unsigned (&vo)[2][2]) const {
#pragma unroll
        for (int h = 0; h < 2; ++h)
#pragma unroll
            for (int i = 0; i < 2; ++i) vo[h][i] = (unsigned)((h * HALF + Rs[i]) * K + Cs[i]) * 2u;
    }
};
template <int K_, int PMAP, int EB> struct MapProb {
    static constexpr int K = K_; static constexpr bool GATHER = false;
    const unsigned char* A; const unsigned char* Bt; StaticOrder S;
    __device__ __forceinline__ bool next(int i, Unit& u) const { const bool ok = S.next(i, u); if (PMAP == 1) u.pn = u.pn < 6 ? u.pn : u.pn + 6; if (PMAP == 2) u.pn += 6; return ok; }
    __device__ __forceinline__ const char* a_base(const Unit& u) const { return (const char*)(A + (size_t)u.pm * BM * K * EB); }
    __device__ __forceinline__ const char* b_base(const Unit& u) const { return (const char*)(Bt + (size_t)u.pn * BM * K * EB); }
    __device__ __forceinline__ void a_voff(const Unit&, const int (&Rs)[2], const int (&Cs)[2], unsigned (&vo)[2][2]) const {
#pragma unroll
        for (int h = 0; h < 2; ++h)
#pragma unroll
            for (int i = 0; i < 2; ++i) vo[h][i] = (unsigned)((h * HALF + Rs[i]) * K * EB + Cs[i] * 2);
    }
};
__device__ __forceinline__ bool moe_unit(int i, int G, int vcu, Unit& u, int& e, int& b) {
    const int L = i * G + vcu; if (L >= 2048) return false;
    const int x = (L & 255) >> 5, w = L & 31, r = L >> 8;
    e = 2 * x + (r >> 2); b = r & 3; u.pm = (b * NEXP + e) * 4 + (w >> 3); u.pn = w & 7; u.ord = i; return true;
}
struct GuProb {
    static constexpr int K = DM; static constexpr bool GATHER = true;
    const bf16_t* H2; const bf16_t* W; const LAS unsigned* rowoff; int G, vcu;
    __device__ __forceinline__ bool next(int i, Unit& u) const { int e, b; return moe_unit(i, G, vcu, u, e, b); }
    __device__ __forceinline__ const char* a_base(const Unit& u) const { const int b = (u.pm >> 2) / NEXP; return (const char*)(H2 + (size_t)b * SEQ * DM); }
    __device__ __forceinline__ const char* b_base(const Unit& u) const { const int e = (u.pm >> 2) % NEXP; return (const char*)(W + ((size_t)e * 2048 + (size_t)u.pn * BM) * DM); }
    __device__ __forceinline__ void a_voff(const Unit& u, const int (&Rs)[2], const int (&Cs)[2], unsigned (&vo)[2][2]) const {
#pragma unroll
        for (int h = 0; h < 2; ++h)
#pragma unroll
            for (int i = 0; i < 2; ++i) vo[h][i] = rowoff[u.ord * 256 + h * HALF + Rs[i]] + (unsigned)Cs[i] * 2u;
    }
};
struct DownProb {
    static constexpr int K = DFF; static constexpr bool GATHER = false;
    const bf16_t* HID; const bf16_t* W; int G, vcu;
    __device__ __forceinline__ bool next(int i, Unit& u) const { int e, b; return moe_unit(i, G, vcu, u, e, b); }
    __device__ __forceinline__ const char* a_base(const Unit& u) const { return (const char*)(HID + (size_t)u.pm * BM * DFF); }
    __device__ __forceinline__ const char* b_base(const Unit& u) const { const int e = (u.pm >> 2) % NEXP; return (const char*)(W + ((size_t)e * 2048 + (size_t)u.pn * BM) * DFF); }
    __device__ __forceinline__ void a_voff(const Unit&, const int (&Rs)[2], const int (&Cs)[2], unsigned (&vo)[2][2]) const {
#pragma unroll
        for (int h = 0; h < 2; ++h)
#pragma unroll
            for (int i = 0; i < 2; ++i) vo[h][i] = (unsigned)((h * HALF + Rs[i]) * DFF + Cs[i]) * 2u;
    }
};

struct GuProb8 {
    static constexpr int K = DM; static constexpr bool GATHER = true;
    const unsigned char* H2; const unsigned char* W; const LAS unsigned* rowoff; int G, vcu;
    __device__ __forceinline__ bool next(int i, Unit& u) const { int e, b; return moe_unit(i, G, vcu, u, e, b); }
    __device__ __forceinline__ const char* a_base(const Unit& u) const { const int b = (u.pm >> 2) / NEXP; return (const char*)(H2 + (size_t)b * SEQ * DM); }
    __device__ __forceinline__ const char* b_base(const Unit& u) const { const int e = (u.pm >> 2) % NEXP; return (const char*)(W + ((size_t)e * 2048 + (size_t)u.pn * BM) * DM); }
    __device__ __forceinline__ void a_voff(const Unit& u, const int (&Rs)[2], const int (&Cs)[2], unsigned (&vo)[2][2]) const {
#pragma unroll
        for (int h = 0; h < 2; ++h)
#pragma unroll
            for (int i = 0; i < 2; ++i) vo[h][i] = rowoff[u.ord * 256 + h * HALF + Rs[i]] + (unsigned)Cs[i] * 2u;
    }
};
struct DownProb8 {
    static constexpr int K = DFF; static constexpr bool GATHER = false;
    const unsigned char* HID; const unsigned char* W; int G, vcu;
    __device__ __forceinline__ bool next(int i, Unit& u) const { int e, b; return moe_unit(i, G, vcu, u, e, b); }
    __device__ __forceinline__ const char* a_base(const Unit& u) const { return (const char*)(HID + (size_t)u.pm * BM * DFF); }
    __device__ __forceinline__ const char* b_base(const Unit& u) const { const int e = (u.pm >> 2) % NEXP; return (const char*)(W + ((size_t)e * 2048 + (size_t)u.pn * BM) * DFF); }
    __device__ __forceinline__ void a_voff(const Unit&, const int (&Rs)[2], const int (&Cs)[2], unsigned (&vo)[2][2]) const {
#pragma unroll
        for (int h = 0; h < 2; ++h)
#pragma unroll
            for (int i = 0; i < 2; ++i) vo[h][i] = (unsigned)((h * HALF + Rs[i]) * DFF + Cs[i] * 2);
    }
};
typedef const f32x4 (&AccRef)[2][2][4][2];
__device__ __forceinline__ void store_pair8(unsigned char* base, unsigned ld, int rowA, int rowB, int col0, u32x2 X, u32x2 Y, int fq) {
    const bool odd = (fq & 1) != 0;
    const unsigned sx = odd ? X.x : Y.x, sy = odd ? X.y : Y.y;
    const auto rx = __builtin_amdgcn_permlane16_swap(sx, sx, false, false); const auto ry = __builtin_amdgcn_permlane16_swap(sy, sy, false, false);
    const unsigned gx = odd ? rx[0] : rx[1], gy = odd ? ry[0] : ry[1];
    const u32x4 out = odd ? (u32x4){gx, gy, Y.x, Y.y} : (u32x4){X.x, X.y, gx, gy};
    *(u32x4*)(base + (size_t)(odd ? rowB : rowA) * ld + (odd ? col0 - 8 : col0)) = out;
}
struct EpiInProj {
    static constexpr bool PERM = true;
    bf16_t *QA, *KA, *VA, *QB, *KB, *VB, *GA, *GB; const float* bgate; float oscale;
    __device__ __forceinline__ void operator()(AccRef acc, const Unit& u, int wr, int wc, int fr, int fq) const {
        const int pn = u.pn; bf16_t* base; int ldc, colt; bool gate = false;
        if (pn < 4) { base = QA; ldc = QW; colt = pn * 256; }
        else if (pn == 4) { base = KA; ldc = KVW; colt = 0; }
        else if (pn == 5) { base = VA; ldc = KVW; colt = 0; }
        else if (pn < 10) { base = QB; ldc = QW; colt = (pn - 6) * 256; }
        else if (pn == 10) { base = KB; ldc = KVW; colt = 0; }
        else if (pn == 11) { base = VB; ldc = KVW; colt = 0; }
        else if (pn < 20) { base = GA; ldc = DM; colt = (pn - 12) * 256; gate = true; }
        else { base = GB; ldc = DM; colt = (pn - 20) * 256; gate = true; }
        const int row0 = u.pm * BM + wr * 64 + fr, col0 = colt + wc * 32 + 8 * fq;
        f32x4 bv[2][2];
#pragma unroll
        for (int bj = 0; bj < 2; ++bj)
#pragma unroll
            for (int n = 0; n < 2; ++n) bv[bj][n] = gate ? *(const f32x4*)(bgate + (pn - 12) * 256 + wc * 32 + 8 * fq + bj * HALF + 4 * n) : (f32x4){0.f, 0.f, 0.f, 0.f};
#pragma unroll
        for (int ai = 0; ai < 2; ++ai)
#pragma unroll
            for (int m = 0; m < 4; ++m) { bf16_t* rowp = base + (size_t)(row0 + ai * HALF + m * 16) * ldc + col0;
#pragma unroll
                for (int bj = 0; bj < 2; ++bj) { f32x4 v0 = acc[ai][bj][m][0] * oscale + bv[bj][0], v1 = acc[ai][bj][m][1] * oscale + bv[bj][1];
                    if (gate) {
#pragma unroll
                        for (int j = 0; j < 4; ++j) { v0[j] = sigmoidf_fast(v0[j]) * GATE8S; v1[j] = sigmoidf_fast(v1[j]) * GATE8S; }
                        int w0 = 0, w1 = 0; w0 = __builtin_amdgcn_cvt_pk_fp8_f32(v0[0], v0[1], w0, false); w0 = __builtin_amdgcn_cvt_pk_fp8_f32(v0[2], v0[3], w0, true);
                        w1 = __builtin_amdgcn_cvt_pk_fp8_f32(v1[0], v1[1], w1, false); w1 = __builtin_amdgcn_cvt_pk_fp8_f32(v1[2], v1[3], w1, true);
                        *(u32x2*)((unsigned char*)base + (size_t)(row0 + ai * HALF + m * 16) * DM + col0 + bj * HALF) = (u32x2){(unsigned)w0, (unsigned)w1};
                    } else {
                    u32x4 w; w.x = cvt_pk_bf16(v0[0], v0[1]); w.y = cvt_pk_bf16(v0[2], v0[3]); w.z = cvt_pk_bf16(v1[0], v1[1]); w.w = cvt_pk_bf16(v1[2], v1[3]);
                    *(u32x4*)(rowp + bj * HALF) = w; } } }
    }
};
template <int MODE> struct EpiGated {
    static constexpr bool PERM = true;
    bf16_t* G1; const bf16_t* G2; float oscale;
    __device__ __forceinline__ void operator()(AccRef acc, const Unit& u, int wr, int wc, int fr, int fq) const {
        const int row0 = u.pm * BM + wr * 64 + fr, col0 = u.pn * BM + wc * 32 + 8 * fq;
#pragma unroll
        for (int ai = 0; ai < 2; ++ai)
#pragma unroll
            for (int m = 0; m < 4; ++m) { const size_t off = (size_t)(row0 + ai * HALF + m * 16) * DM + col0;
#pragma unroll
                for (int bj = 0; bj < 2; ++bj) {
                    const bf16x8 g1 = (MODE == 2) ? (bf16x8){0, 0, 0, 0, 0, 0, 0, 0} : *(const bf16x8*)(G1 + off + bj * HALF);
                    bf16x8 g2 = g1; if (MODE >= 1) g2 = *(const bf16x8*)(G2 + off + bj * HALF);
                    float o[8];
#pragma unroll
                    for (int j = 0; j < 8; ++j) { const float a = acc[ai][bj][m][j >> 2][j & 3] * oscale;
                        if (MODE == 0) o[j] = bf2f((unsigned short)g1[j]) * a;
                        else if (MODE == 1) o[j] = bf2f((unsigned short)g1[j]) + bf2f((unsigned short)g2[j]) * a;
                        else o[j] = bf2f((unsigned short)g2[j]) * a; }
                    u32x4 w; w.x = cvt_pk_bf16(o[0], o[1]); w.y = cvt_pk_bf16(o[2], o[3]); w.z = cvt_pk_bf16(o[4], o[5]); w.w = cvt_pk_bf16(o[6], o[7]);
                    *(u32x4*)(G1 + off + bj * HALF) = w; } }
    }
};
template <int MODE> struct EpiGated8 {
    static constexpr bool PERM = true;
    const unsigned char* G8; const unsigned char* M1; unsigned char* OUT8; float oscale;
    __device__ __forceinline__ void operator()(AccRef acc, const Unit& u, int wr, int wc, int fr, int fq) const {
        const int row0 = u.pm * BM + wr * 64 + fr, col0 = u.pn * BM + wc * 32 + 8 * fq;
        u32x2 g[2][4][2], m1[2][4][2];
#pragma unroll
        for (int ai = 0; ai < 2; ++ai)
#pragma unroll
            for (int m = 0; m < 4; ++m)
#pragma unroll
                for (int bj = 0; bj < 2; ++bj) { const unsigned off = (unsigned)((row0 + ai * HALF + m * 16) * DM + col0) + bj * HALF; g[ai][m][bj] = *(const u32x2*)(G8 + off); if (MODE == 1) m1[ai][m][bj] = *(const u32x2*)(M1 + off); }
        const float gs = oscale * (M8S / GATE8S);
#pragma unroll
        for (int ai = 0; ai < 2; ++ai)
#pragma unroll
            for (int mp = 0; mp < 2; ++mp)
#pragma unroll
                for (int bj = 0; bj < 2; ++bj) { u32x2 wv[2];
#pragma unroll
                    for (int mi = 0; mi < 2; ++mi) { const int m = 2 * mp + mi; float o[8];
                      { const int gx = (int)g[ai][m][bj].x, gy = (int)g[ai][m][bj].y;
                        const auto g0 = __builtin_amdgcn_cvt_pk_f32_fp8(gx, false), g1 = __builtin_amdgcn_cvt_pk_f32_fp8(gx, true), g2 = __builtin_amdgcn_cvt_pk_f32_fp8(gy, false), g3 = __builtin_amdgcn_cvt_pk_f32_fp8(gy, true);
                        const f32x4 a0 = acc[ai][bj][m][0] * gs, a1 = acc[ai][bj][m][1] * gs;
                        o[0] = g0[0] * a0[0]; o[1] = g0[1] * a0[1]; o[2] = g1[0] * a0[2]; o[3] = g1[1] * a0[3]; o[4] = g2[0] * a1[0]; o[5] = g2[1] * a1[1]; o[6] = g3[0] * a1[2]; o[7] = g3[1] * a1[3];
                        if (MODE == 1) { const int mx = (int)m1[ai][m][bj].x, my = (int)m1[ai][m][bj].y;
                          const auto m0 = __builtin_amdgcn_cvt_pk_f32_fp8(mx, false), m1_ = __builtin_amdgcn_cvt_pk_f32_fp8(mx, true), m2 = __builtin_amdgcn_cvt_pk_f32_fp8(my, false), m3 = __builtin_amdgcn_cvt_pk_f32_fp8(my, true);
                          o[0] += m0[0]; o[1] += m0[1]; o[2] += m1_[0]; o[3] += m1_[1]; o[4] += m2[0]; o[5] += m2[1]; o[6] += m3[0]; o[7] += m3[1]; } }
                      int w0 = 0, w1 = 0; w0 = __builtin_amdgcn_cvt_pk_fp8_f32(o[0], o[1], w0, false); w0 = __builtin_amdgcn_cvt_pk_fp8_f32(o[2], o[3], w0, true);
                      w1 = __builtin_amdgcn_cvt_pk_fp8_f32(o[4], o[5], w1, false); w1 = __builtin_amdgcn_cvt_pk_fp8_f32(o[6], o[7], w1, true); wv[mi] = (u32x2){(unsigned)w0, (unsigned)w1}; }
                    store_pair8(OUT8, DM, row0 + ai * HALF + (2 * mp) * 16, row0 + ai * HALF + (2 * mp + 1) * 16, col0 + bj * HALF, wv[0], wv[1], fq); }
    }
};
struct EpiAtt {
    static constexpr bool PERM = true;
    unsigned char* O; float oscale;
    __device__ __forceinline__ void operator()(AccRef acc, const Unit& u, int wr, int wc, int fr, int fq) const {
        const int row0 = u.pm * BM + wr * 64 + fr, col0 = u.pn * BM + wc * 32 + 8 * fq;
#pragma unroll
        for (int ai = 0; ai < 2; ++ai)
#pragma unroll
            for (int mp = 0; mp < 2; ++mp)
#pragma unroll
                for (int bj = 0; bj < 2; ++bj) { u32x2 wv[2];
#pragma unroll
                    for (int mi = 0; mi < 2; ++mi) { const int m = 2 * mp + mi; const f32x4 v0 = acc[ai][bj][m][0] * oscale, v1 = acc[ai][bj][m][1] * oscale;
                        int w0 = 0, w1 = 0; w0 = __builtin_amdgcn_cvt_pk_fp8_f32(v0[0], v0[1], w0, false); w0 = __builtin_amdgcn_cvt_pk_fp8_f32(v0[2], v0[3], w0, true);
                        w1 = __builtin_amdgcn_cvt_pk_fp8_f32(v1[0], v1[1], w1, false); w1 = __builtin_amdgcn_cvt_pk_fp8_f32(v1[2], v1[3], w1, true); wv[mi] = (u32x2){(unsigned)w0, (unsigned)w1}; }
                    store_pair8(O, DM, row0 + ai * HALF + (2 * mp) * 16, row0 + ai * HALF + (2 * mp + 1) * 16, col0 + bj * HALF, wv[0], wv[1], fq); }
    }
};
struct EpiSwiglu {
    static constexpr bool PERM = true;
    unsigned char* HID; float oscale;
    __device__ __forceinline__ void operator()(AccRef acc, const Unit& u, int wr, int wc, int fr, int fq) const {
        const int row0 = u.pm * BM + wr * 64 + fr, col0 = u.pn * HALF + wc * 32 + 8 * fq;
#pragma unroll
        for (int ai = 0; ai < 2; ++ai)
#pragma unroll
            for (int m = 0; m < 4; ++m) { float o[8];
#pragma unroll
                for (int j = 0; j < 8; ++j) { const float a = acc[ai][0][m][j >> 2][j & 3] * oscale, up = acc[ai][1][m][j >> 2][j & 3] * oscale; o[j] = a * sigmoidf_fast(a) * up; }
                int w0 = 0, w1 = 0; w0 = __builtin_amdgcn_cvt_pk_fp8_f32(o[0], o[1], w0, false); w0 = __builtin_amdgcn_cvt_pk_fp8_f32(o[2], o[3], w0, true);
                w1 = __builtin_amdgcn_cvt_pk_fp8_f32(o[4], o[5], w1, false); w1 = __builtin_amdgcn_cvt_pk_fp8_f32(o[6], o[7], w1, true);
                *(u32x2*)(HID + (size_t)(row0 + ai * HALF + m * 16) * DFF + col0) = (u32x2){(unsigned)w0, (unsigned)w1}; }
    }
};
struct EpiDown {
    static constexpr bool PERM = true;
    bf16_t* Y; const float* gatev; float oscale;
    __device__ __forceinline__ void operator()(AccRef acc, const Unit& u, int wr, int wc, int fr, int fq) const {
        const int row0 = u.pm * BM + wr * 64 + fr, col0 = u.pn * BM + wc * 32 + 8 * fq;
#pragma unroll
        for (int ai = 0; ai < 2; ++ai)
#pragma unroll
            for (int m = 0; m < 4; ++m) { const int row = row0 + ai * HALF + m * 16; const float g = gatev[row] * oscale;
#pragma unroll
                for (int bj = 0; bj < 2; ++bj) { const f32x4 v0 = acc[ai][bj][m][0] * g, v1 = acc[ai][bj][m][1] * g;
                    u32x4 w; w.x = cvt_pk_bf16(v0[0], v0[1]); w.y = cvt_pk_bf16(v0[2], v0[3]); w.z = cvt_pk_bf16(v1[0], v1[1]); w.w = cvt_pk_bf16(v1[2], v1[3]);
                    *(u32x4*)(Y + (size_t)row * DM + col0 + bj * HALF) = w; } }
    }
};
}

namespace att {
constexpr int D = 128, NW = 8, QBLK = 32, KVBLK = 64;
constexpr float SCALE = 0.088388347648318440f, C = SCALE * LOG2E;
constexpr float THR = 8.f;
constexpr int LDQ = QW, LDK = KVW;
constexpr int SHM_V = KVBLK * D * 2, SHM_K = KVBLK * D * 2;
constexpr int BUFB = SHM_V + SHM_K, NBUF = 4;
constexpr int OFF_WS = NBUF * BUFB, OFF_TAB = OFF_WS + NW * 64 * 4, LDS_END = OFF_TAB + 4 * 768 * 4, OFF_OST = 0;
static_assert(LDS_END <= LDS_SCRATCH, "attention LDS");
#define KSWZ(row, colB) ((row) * 256 + ((colB) ^ (((row) & 7) << 4)))
#define SBAR() __builtin_amdgcn_sched_barrier(0)
__device__ __forceinline__ int crow(int r, int hi) { return (r & 3) + 8 * (r >> 2) + 4 * hi; }
__device__ __forceinline__ unsigned cvtpk(float lo, float hi) { unsigned r; asm volatile("v_cvt_pk_bf16_f32 %0, %1, %2" : "=v"(r) : "v"(lo), "v"(hi)); return r; }

__device__ __forceinline__ void partialSM(f32x16& p0, f32x16& p1, float& m_reg, float& mn, float& alpha) {
  float pmax = p0[0];
#pragma unroll
  for (int r = 1; r < 16; ++r) pmax = fmaxf(pmax, p0[r]);
#pragma unroll
  for (int r = 0; r < 16; ++r) pmax = fmaxf(pmax, p1[r]);
  { auto rr = __builtin_amdgcn_permlane32_swap(__float_as_uint(pmax), __float_as_uint(pmax), false, false);
    pmax = fmaxf(__uint_as_float(rr[0]), __uint_as_float(rr[1])); }
  if (__builtin_expect(__all(pmax - m_reg <= THR / SCALE), 1)) { mn = m_reg; alpha = 1.f; }
  else { mn = fmaxf(m_reg, pmax); alpha = __builtin_amdgcn_exp2f((m_reg - mn) * C); m_reg = mn; }
  float mnC = -mn * C;
#pragma unroll
  for (int r = 0; r < 16; ++r) p0[r] = fmaf(p0[r], C, mnC);
#pragma unroll
  for (int r = 0; r < 16; ++r) p1[r] = fmaf(p1[r], C, mnC);
#pragma unroll
  for (int r = 0; r < 16; ++r) p0[r] = __builtin_amdgcn_exp2f(p0[r]);
}
__device__ __forceinline__ void partialSM_B(f32x16& p0, f32x16& p1, float& m_reg, float& mn, float& alpha, const float* tb) {
#pragma unroll
  for (int r = 0; r < 16; ++r) { const int o = (r & 3) + 8 * (r >> 2); p0[r] = fmaf(p0[r], C, tb[o]); p1[r] = fmaf(p1[r], C, tb[32 + o]); }
  float pmax = p0[0];
#pragma unroll
  for (int r = 1; r < 16; ++r) pmax = fmaxf(pmax, p0[r]);
#pragma unroll
  for (int r = 0; r < 16; ++r) pmax = fmaxf(pmax, p1[r]);
  { auto rr = __builtin_amdgcn_permlane32_swap(__float_as_uint(pmax), __float_as_uint(pmax), false, false);
    pmax = fmaxf(__uint_as_float(rr[0]), __uint_as_float(rr[1])); }
  if (__builtin_expect(__all(pmax - m_reg <= THR * LOG2E), 1)) { mn = m_reg; alpha = 1.f; }
  else { mn = fmaxf(m_reg, pmax); alpha = __builtin_amdgcn_exp2f(m_reg - mn); m_reg = mn; }
#pragma unroll
  for (int r = 0; r < 16; ++r) p0[r] = p0[r] - mn;
#pragma unroll
  for (int r = 0; r < 16; ++r) p1[r] = p1[r] - mn;
#pragma unroll
  for (int r = 0; r < 16; ++r) p0[r] = __builtin_amdgcn_exp2f(p0[r]);
}
__device__ __forceinline__ void finishSM(f32x16& p0, f32x16& p1, float alpha, float& l_reg, bf16x8& pa0, bf16x8& pa1, bf16x8& pa2, bf16x8& pa3) {
#pragma unroll
  for (int r = 0; r < 16; ++r) p1[r] = __builtin_amdgcn_exp2f(p1[r]);
  float ps = 0;
#pragma unroll
  for (int r = 0; r < 16; ++r) ps += p0[r];
#pragma unroll
  for (int r = 0; r < 16; ++r) ps += p1[r];
  { auto rr = __builtin_amdgcn_permlane32_swap(__float_as_uint(ps), __float_as_uint(ps), false, false);
    ps = __uint_as_float(rr[0]) + __uint_as_float(rr[1]); }
  l_reg = l_reg * alpha + ps;
#define PK4(P, BASE, OUT) do { unsigned a0 = cvtpk(P[BASE + 0], P[BASE + 1]), a1 = cvtpk(P[BASE + 2], P[BASE + 3]);   \
    unsigned b0 = cvtpk(P[BASE + 4], P[BASE + 5]), b1 = cvtpk(P[BASE + 6], P[BASE + 7]);                              \
    auto r0 = __builtin_amdgcn_permlane32_swap(a0, b0, false, false); auto r1 = __builtin_amdgcn_permlane32_swap(a1, b1, false, false); \
    u32x4 w = {r0[0], r1[0], r0[1], r1[1]}; OUT = *reinterpret_cast<bf16x8*>(&w); } while (0)
  PK4(p0, 0, pa0); PK4(p0, 8, pa1); PK4(p1, 0, pa2); PK4(p1, 8, pa3);
#undef PK4
}
__device__ __forceinline__ void qkt(f32x16& p0, f32x16& p1, const bf16_t* Ks, const bf16x8* qr, int r32, int hi, float init = 0.f) {
#pragma unroll
  for (int r = 0; r < 16; ++r) { p0[r] = init; p1[r] = init; }
#pragma unroll
  for (int d0 = 0; d0 < 8; ++d0) { int cb = (d0 * 16 + hi * 8) * 2;
    bf16x8 b0 = *reinterpret_cast<const bf16x8*>((const char*)Ks + KSWZ(r32, cb));
    bf16x8 b1 = *reinterpret_cast<const bf16x8*>((const char*)Ks + KSWZ(32 + r32, cb));
    p0 = __builtin_amdgcn_mfma_f32_32x32x16_bf16(b0, qr[d0], p0, 0, 0, 0);
    p1 = __builtin_amdgcn_mfma_f32_32x32x16_bf16(b1, qr[d0], p1, 0, 0, 0); }
}
__device__ __forceinline__ int v_st(int k, int c) { const int kk = (k & ~0xC) | ((k & 4) << 1) | ((k & 8) >> 1); return ((kk >> 3) * 4 + (c >> 5)) * 512 + ((kk & 7) * 32 + (c & 31)) * 2; }
__device__ __forceinline__ int v_rd_base(int lane) { return ((lane & 3) << 3) | (((lane >> 2) & 3) << 6) | (((lane >> 4) & 1) << 5) | (((lane >> 5) & 1) << 8); }
constexpr int v_rd_off(int d0, int ks, int half) { return d0 * 512 + ks * 4096 + half * 2048; }
template <int OFF> __device__ __forceinline__ s16x4 tr_read(int vb) {
  s16x4 r; asm volatile("ds_read_b64_tr_b16 %0, %1 offset:%2" : "=&v"(r) : "v"(vb), "i"(OFF) : "memory"); return r;
}
template <int D0> __device__ __forceinline__ void pv_one(f32x16& od, int vb, bf16x8 pa0, bf16x8 pa1, bf16x8 pa2, bf16x8 pa3) {
  const s16x4 l0 = tr_read<v_rd_off(D0, 0, 0)>(vb), h0 = tr_read<v_rd_off(D0, 0, 1)>(vb), l1 = tr_read<v_rd_off(D0, 1, 0)>(vb), h1 = tr_read<v_rd_off(D0, 1, 1)>(vb);
  const s16x4 l2 = tr_read<v_rd_off(D0, 2, 0)>(vb), h2 = tr_read<v_rd_off(D0, 2, 1)>(vb), l3 = tr_read<v_rd_off(D0, 3, 0)>(vb), h3 = tr_read<v_rd_off(D0, 3, 1)>(vb);
  asm volatile("s_waitcnt lgkmcnt(0)" ::: "memory"); SBAR();
#define PK(L, H) (bf16x8){L[0], L[1], L[2], L[3], H[0], H[1], H[2], H[3]}
  od = __builtin_amdgcn_mfma_f32_32x32x16_bf16(pa0, PK(l0, h0), od, 0, 0, 0);
  od = __builtin_amdgcn_mfma_f32_32x32x16_bf16(pa1, PK(l1, h1), od, 0, 0, 0);
  od = __builtin_amdgcn_mfma_f32_32x32x16_bf16(pa2, PK(l2, h2), od, 0, 0, 0);
  od = __builtin_amdgcn_mfma_f32_32x32x16_bf16(pa3, PK(l3, h3), od, 0, 0, 0);
#undef PK
}
__device__ __forceinline__ void pv_d0(f32x16* o, int vb, bf16x8 pa0, bf16x8 pa1, bf16x8 pa2, bf16x8 pa3) {
  pv_one<0>(o[0], vb, pa0, pa1, pa2, pa3); pv_one<1>(o[1], vb, pa0, pa1, pa2, pa3); pv_one<2>(o[2], vb, pa0, pa1, pa2, pa3); pv_one<3>(o[3], vb, pa0, pa1, pa2, pa3);
}
template <int MODE>
__device__ __forceinline__ void pv_psm(f32x16* o, int vb, bf16x8 pa0, bf16x8 pa1, bf16x8 pa2, bf16x8 pa3, f32x16& p0, f32x16& p1, float& m_reg, float& mn, float& alpha, const float* tb) {
  pv_one<0>(o[0], vb, pa0, pa1, pa2, pa3);
  if constexpr (MODE == 1) {
#pragma unroll
    for (int r = 0; r < 16; ++r) { const int of = (r & 3) + 8 * (r >> 2); p0[r] = fmaf(p0[r], C, tb[of]); p1[r] = fmaf(p1[r], C, tb[32 + of]); }
  }
  float pmax = p0[0];
#pragma unroll
  for (int r = 1; r < 16; ++r) pmax = fmaxf(pmax, p0[r]);
#pragma unroll
  for (int r = 0; r < 16; ++r) pmax = fmaxf(pmax, p1[r]);
  { auto rr = __builtin_amdgcn_permlane32_swap(__float_as_uint(pmax), __float_as_uint(pmax), false, false);
    pmax = fmaxf(__uint_as_float(rr[0]), __uint_as_float(rr[1])); }
  SBAR();
  pv_one<1>(o[1], vb, pa0, pa1, pa2, pa3);
  float sub;
  if constexpr (MODE == 0) {
    if (__builtin_expect(__all(pmax - m_reg <= THR / SCALE), 1)) { mn = m_reg; alpha = 1.f; }
    else { mn = fmaxf(m_reg, pmax); alpha = __builtin_amdgcn_exp2f((m_reg - mn) * C); m_reg = mn; }
    sub = -mn * C;
#pragma unroll
    for (int r = 0; r < 16; ++r) p0[r] = fmaf(p0[r], C, sub);
  } else {
    if (__builtin_expect(__all(pmax - m_reg <= THR * LOG2E), 1)) { mn = m_reg; alpha = 1.f; }
    else { mn = fmaxf(m_reg, pmax); alpha = __builtin_amdgcn_exp2f(m_reg - mn); m_reg = mn; }
    sub = -mn;
#pragma unroll
    for (int r = 0; r < 16; ++r) p0[r] = p0[r] + sub;
  }
  SBAR();
  pv_one<2>(o[2], vb, pa0, pa1, pa2, pa3);
#pragma unroll
  for (int r = 0; r < 16; ++r) { if constexpr (MODE == 0) p1[r] = fmaf(p1[r], C, sub); else p1[r] = p1[r] + sub; }
#pragma unroll
  for (int r = 0; r < 6; ++r) p0[r] = __builtin_amdgcn_exp2f(p0[r]);
  SBAR();
  pv_one<3>(o[3], vb, pa0, pa1, pa2, pa3);
#pragma unroll
  for (int r = 6; r < 16; ++r) p0[r] = __builtin_amdgcn_exp2f(p0[r]);
}
__device__ __forceinline__ f32x8 bf8_to_f32(bf16x8 v) { f32x8 r;
#pragma unroll
  for (int j = 0; j < 8; ++j) r[j] = bf2f((unsigned short)v[j]);
  return r; }
__device__ __forceinline__ bf16x8 f32_to_bf8(f32x8 x) { u32x4 w = {cvtpk(x[0], x[1]), cvtpk(x[2], x[3]), cvtpk(x[4], x[5]), cvtpk(x[6], x[7])}; return *reinterpret_cast<bf16x8*>(&w); }
__device__ __forceinline__ int t5_bucket(int rel) {
  const int n = rel < 0 ? -rel : rel; int bk;
  if (n < 8) bk = n; else if (n < 12) bk = 8; else if (n < 16) bk = 9; else if (n < 23) bk = 10; else if (n < 32) bk = 11; else if (n < 46) bk = 12; else if (n < 64) bk = 13; else if (n < 91) bk = 14; else bk = 15;
  return bk + (rel > 0 ? 16 : 0);
}
struct Aux { const float* cosT; const float* sinT; const float* qn; const float* kn; const float* relb; const float* sink; };

template <int MODE>
__device__ __forceinline__ void attn_unit(const bf16_t* Qb, const bf16_t* __restrict__ Kh, const bf16_t* __restrict__ Vh, bf16_t* Ob, int kbeg, int kend, int q0, int head, char* lds, const Aux& aux) {
  int tid = threadIdx.x; asm volatile("" : "+v"(tid));
  const int wid = tid >> 6, lane = tid & 63, r32 = lane & 31, hi = lane >> 5;
  char* V_lds = lds; char* K_lds = lds + SHM_V;
  float* ws = (float*)(lds + OFF_WS) + wid * 64; float* li_l = ws; float* al_l = ws + 32;
  float* tab = (float*)(lds + OFF_TAB);
  float m_reg = -1e30f, l_reg = 0; f32x16 o[4] = {}; bf16x8 qr[8];
  const bf16_t* Qw = Qb + (long)(wid * QBLK + r32) * LDQ + hi * 8;
#pragma unroll
  for (int d0 = 0; d0 < 8; ++d0) qr[d0] = *reinterpret_cast<const bf16x8*>(Qw + d0 * 16);
  if constexpr (MODE == 1) {
    for (int i = tid; i < 768; i += 512) { const int rel = i - 383, n = rel < 0 ? -rel : rel; float v = -1e30f; if (n <= 128) v = aux.relb[t5_bucket(rel) * NHB + head] * LOG2E; tab[i] = v; }
    m_reg = aux.sink[head] * LOG2E; l_reg = 1.0f;
  }
  const int tbase = kbeg - q0 - wid * QBLK - r32 + 383 + 4 * hi;
  const int sr = tid >> 4, sc = (tid & 15) * 8, vst0 = v_st(sr, sc), vst1 = v_st(32 + sr, sc);
  const int vb0 = (int)(uintptr_t)V_lds + v_rd_base(lane);
  struct { bf16x8 vs0, vs1, ks0, ks1; } sr_[2];
#define SLOAD(i, k0) do { sr_[i].vs0 = *reinterpret_cast<const bf16x8*>(&Vh[(long)(kbeg + (k0) + sr) * LDK + sc]); sr_[i].vs1 = *reinterpret_cast<const bf16x8*>(&Vh[(long)(kbeg + (k0) + 32 + sr) * LDK + sc]); \
    sr_[i].ks0 = *reinterpret_cast<const bf16x8*>(&Kh[(long)(kbeg + (k0) + sr) * LDK + sc]); sr_[i].ks1 = *reinterpret_cast<const bf16x8*>(&Kh[(long)(kbeg + (k0) + 32 + sr) * LDK + sc]); } while (0)
#define SWRITE(bo, i) do { *(bf16x8*)(V_lds + (bo) + vst0) = sr_[i].vs0;          \
    *(bf16x8*)(V_lds + (bo) + vst1) = sr_[i].vs1; int kc = sc * 2;               \
    *(bf16x8*)(K_lds + (bo) + KSWZ(sr, kc)) = sr_[i].ks0;                       \
    *(bf16x8*)(K_lds + (bo) + KSWZ(32 + sr, kc)) = sr_[i].ks1; } while (0)
#define SWAIT() asm volatile("s_waitcnt vmcnt(4)" ::: "memory")
#define RESC(a) do { if (__any((a) < 1.f)) { if (hi == 0) al_l[r32] = (a); asm volatile("s_waitcnt lgkmcnt(0)" ::: "memory"); \
    _Pragma("unroll") for (int d = 0; d < 4; ++d) _Pragma("unroll") for (int r = 0; r < 16; ++r) o[d][r] *= al_l[crow(r, hi)]; } } while (0)
#define PSM(P0, P1, MN, AL, j) do { if constexpr (MODE == 0) partialSM(P0, P1, m_reg, MN, AL); else partialSM_B(P0, P1, m_reg, MN, AL, tab + tbase + (j) * KVBLK); } while (0)
#define ROT() do { const int t_ = o_prev; o_prev = o_cur; o_cur = o_next; o_next = t_; } while (0)
  f32x16 pA0, pA1, pB0, pB1; float mnA, mnB, alA, alB; bf16x8 pa0, pa1, pa2, pa3; const int NT = (kend - kbeg) / KVBLK;
  constexpr int SE = 0, SO = 1;
  int o_prev = 2 * BUFB, o_cur = 0, o_next = BUFB;
  SLOAD(SE, 0); asm volatile("s_waitcnt vmcnt(0)" ::: "memory"); SWRITE(0, SE);
  SLOAD(SO, KVBLK); SLOAD(SE, 2 * KVBLK);
  __syncthreads();
  qkt(pA0, pA1, (const bf16_t*)(K_lds + o_cur), qr, r32, hi); PSM(pA0, pA1, mnA, alA, 0);
  SWAIT(); SWRITE(o_next, SO); RESC(alA); __syncthreads();
  ROT();
  for (int j = 1; j + 1 < NT; j += 2) {
    SBAR(); qkt(pB0, pB1, (const bf16_t*)(K_lds + o_cur), qr, r32, hi);
    finishSM(pA0, pA1, alA, l_reg, pa0, pa1, pa2, pa3); SBAR();
    SLOAD(SO, (j + 2) * KVBLK); SBAR();
    pv_psm<MODE>(o, vb0 + o_prev, pa0, pa1, pa2, pa3, pB0, pB1, m_reg, mnB, alB, tab + tbase + j * KVBLK);
    SWAIT(); SWRITE(o_next, SE);
    RESC(alB); __syncthreads(); ROT();
    SBAR(); qkt(pA0, pA1, (const bf16_t*)(K_lds + o_cur), qr, r32, hi);
    finishSM(pB0, pB1, alB, l_reg, pa0, pa1, pa2, pa3); SBAR();
    SLOAD(SE, (j + 3 < NT ? j + 3 : NT - 1) * KVBLK); SBAR();
    pv_psm<MODE>(o, vb0 + o_prev, pa0, pa1, pa2, pa3, pA0, pA1, m_reg, mnA, alA, tab + tbase + (j + 1) * KVBLK);
    SWAIT(); SWRITE(o_next, SO);
    RESC(alA); __syncthreads(); ROT();
  }
  SBAR(); qkt(pB0, pB1, (const bf16_t*)(K_lds + o_cur), qr, r32, hi);
  finishSM(pA0, pA1, alA, l_reg, pa0, pa1, pa2, pa3); SBAR();
  pv_psm<MODE>(o, vb0 + o_prev, pa0, pa1, pa2, pa3, pB0, pB1, m_reg, mnB, alB, tab + tbase + (NT - 1) * KVBLK);
  RESC(alB);
  finishSM(pB0, pB1, alB, l_reg, pa0, pa1, pa2, pa3); SBAR();
  pv_d0(o, vb0 + o_cur, pa0, pa1, pa2, pa3);
  if (hi == 0) li_l[r32] = l_reg; asm volatile("s_waitcnt lgkmcnt(0)" ::: "memory");
  float rli[16];
#pragma unroll
  for (int r = 0; r < 16; ++r) rli[r] = __builtin_amdgcn_rcpf(li_l[crow(r, hi)]);
  asm volatile("s_waitcnt vmcnt(0)" ::: "memory");
  __syncthreads();
  char* ost = lds + OFF_OST + wid * 8192;
#pragma unroll
  for (int r = 0; r < 16; ++r) { const int orow = crow(r, hi);
#pragma unroll
    for (int d0 = 0; d0 < 4; ++d0) *(unsigned short*)(ost + orow * 256 + (d0 * 32 + r32) * 2) = f2bf(o[d0][r] * rli[r]); }
  asm volatile("s_waitcnt lgkmcnt(0)" ::: "memory");
  bf16_t* Ow = Ob + (long)(wid * QBLK) * LDQ;
#pragma unroll
  for (int i = 0; i < 8; ++i) { const int ch = i * 64 + lane, row = ch >> 4, c16 = ch & 15;
    const u32x4 v = *(const u32x4*)(ost + row * 256 + c16 * 16); *(u32x4*)(Ow + (long)row * LDQ + c16 * 8) = v; }
  asm volatile("s_waitcnt lgkmcnt(0)" ::: "memory");
  __syncthreads();
#undef ROT
#undef SLOAD
#undef SWRITE
#undef SWAIT
#undef RESC
#undef PSM
}

template <int MODE>
__device__ __forceinline__ void softmax_tile(f32x16& p0, f32x16& p1, float& m_reg, float& l_reg, float& alpha, bf16x8& pa0, bf16x8& pa1, bf16x8& pa2, bf16x8& pa3, const float* tb) {
  if constexpr (MODE == 0) {
    alpha = 1.f;
    if (__builtin_expect(m_reg != 0.f, 0)) {
#pragma unroll
      for (int r = 0; r < 16; ++r) { p0[r] -= m_reg; p1[r] -= m_reg; } }
#pragma unroll
    for (int r = 0; r < 16; ++r) { p0[r] = __builtin_amdgcn_exp2f(p0[r]); p1[r] = __builtin_amdgcn_exp2f(p1[r]); }
  } else {
  if constexpr (MODE == 1) {
#pragma unroll
    for (int r = 0; r < 16; ++r) { const int of = (r & 3) + 8 * (r >> 2); p0[r] = fmaf(p0[r], C, tb[of]); p1[r] = fmaf(p1[r], C, tb[32 + of]); }
  }
  float pmax = p0[0];
#pragma unroll
  for (int r = 1; r < 16; ++r) pmax = fmaxf(pmax, p0[r]);
#pragma unroll
  for (int r = 0; r < 16; ++r) pmax = fmaxf(pmax, p1[r]);
  { auto rr = __builtin_amdgcn_permlane32_swap(__float_as_uint(pmax), __float_as_uint(pmax), false, false);
    pmax = fmaxf(__uint_as_float(rr[0]), __uint_as_float(rr[1])); }
  float mn, sub;
  if constexpr (MODE == 0) {
    if (__builtin_expect(__all(pmax - m_reg <= THR / SCALE), 1)) { mn = m_reg; alpha = 1.f; }
    else { mn = fmaxf(m_reg, pmax); alpha = __builtin_amdgcn_exp2f((m_reg - mn) * C); m_reg = mn; }
    sub = -mn * C;
#pragma unroll
    for (int r = 0; r < 16; ++r) { p0[r] = __builtin_amdgcn_exp2f(fmaf(p0[r], C, sub)); p1[r] = __builtin_amdgcn_exp2f(fmaf(p1[r], C, sub)); }
  } else {
    if (__builtin_expect(__all(pmax - m_reg <= THR * LOG2E), 1)) { mn = m_reg; alpha = 1.f; }
    else { mn = fmaxf(m_reg, pmax); alpha = __builtin_amdgcn_exp2f(m_reg - mn); m_reg = mn; }
    sub = -mn;
#pragma unroll
    for (int r = 0; r < 16; ++r) { p0[r] = __builtin_amdgcn_exp2f(p0[r] + sub); p1[r] = __builtin_amdgcn_exp2f(p1[r] + sub); }
  }
  }
  float ps = 0;
#pragma unroll
  for (int r = 0; r < 16; ++r) ps += p0[r];
#pragma unroll
  for (int r = 0; r < 16; ++r) ps += p1[r];
  { auto rr = __builtin_amdgcn_permlane32_swap(__float_as_uint(ps), __float_as_uint(ps), false, false);
    ps = __uint_as_float(rr[0]) + __uint_as_float(rr[1]); }
  l_reg = l_reg * alpha + ps;
#define PK4(P, BASE, OUT) do { unsigned a0 = cvtpk(P[BASE + 0], P[BASE + 1]), a1 = cvtpk(P[BASE + 2], P[BASE + 3]);   \
    unsigned b0 = cvtpk(P[BASE + 4], P[BASE + 5]), b1 = cvtpk(P[BASE + 6], P[BASE + 7]);                              \
    auto r0 = __builtin_amdgcn_permlane32_swap(a0, b0, false, false); auto r1 = __builtin_amdgcn_permlane32_swap(a1, b1, false, false); \
    u32x4 w = {r0[0], r1[0], r0[1], r1[1]}; OUT = *reinterpret_cast<bf16x8*>(&w); } while (0)
  PK4(p0, 0, pa0); PK4(p0, 8, pa1); PK4(p1, 0, pa2); PK4(p1, 8, pa3);
#undef PK4
}
typedef short v4i16_t __attribute__((ext_vector_type(4)));
__device__ __forceinline__ bf16x8 ld_frag2(int sp, const LAS char* kb, const int (&kx)[4], const LAS char* vb) {
  if (sp >= 16) { const int s = sp - 16, d0 = s >> 1; return *(const LAS bf16x8*)(kb + kx[d0 & 3] + (d0 >> 2) * 128 + (s & 1) * 8192); }
  const int D0 = sp >> 2, ks = sp & 3;
  const s16x4 lo = __builtin_bit_cast(s16x4, __builtin_amdgcn_ds_read_tr16_b64_v4i16((LAS v4i16_t*)(vb + v_rd_off(D0, ks, 0))));
  const s16x4 hi = __builtin_bit_cast(s16x4, __builtin_amdgcn_ds_read_tr16_b64_v4i16((LAS v4i16_t*)(vb + v_rd_off(D0, ks, 1))));
  return (bf16x8){lo[0], lo[1], lo[2], lo[3], hi[0], hi[1], hi[2], hi[3]};
}
template <int SB, int SE, bool PRE>
__device__ __forceinline__ void mrun(bf16x8 (&f)[8], f32x16& p0, f32x16& p1, f32x16* o, const bf16x8* qr, bf16x8 pa0, bf16x8 pa1, bf16x8 pa2, bf16x8 pa3, const LAS char* kb, const int (&kx)[4], const LAS char* vb, float init) {
  if (SE > 16) { p0 = f32x16{}; p1 = f32x16{}; }
  SBAR();
  if (!PRE) {
#pragma unroll
    for (int s = SB; s < SB + 8; ++s) f[s & 7] = ld_frag2(s, kb, kx, vb);
    SBAR(); }
#pragma unroll
  for (int sp = SB; sp < SE; ++sp) {
    if (sp >= 16) { const int s = sp - 16; if (s & 1) p1 = __builtin_amdgcn_mfma_f32_32x32x16_bf16(f[sp & 7], qr[s >> 1], p1, 0, 0, 0); else p0 = __builtin_amdgcn_mfma_f32_32x32x16_bf16(f[sp & 7], qr[s >> 1], p0, 0, 0, 0); }
    else { const int D0 = sp >> 2, ks = sp & 3; const bf16x8 pa = ks == 0 ? pa0 : ks == 1 ? pa1 : ks == 2 ? pa2 : pa3;
      o[D0] = __builtin_amdgcn_mfma_f32_32x32x16_bf16(pa, f[sp & 7], o[D0], 0, 0, 0); }
    if (sp + 8 < SE) f[sp & 7] = ld_frag2(sp + 8, kb, kx, vb);
    SBAR();
  }
}
template <int MODE>
__device__ __forceinline__ void attn_unit_pp(const bf16_t* Qb, const bf16_t* __restrict__ Kh, const bf16_t* __restrict__ Vh, unsigned char* Ob8, int kbeg, int kend, int q0, int head, char* lds, const Aux& aux) {
  int tid = threadIdx.x; asm volatile("" : "+v"(tid));
  const int wid = tid >> 6, lane = tid & 63, r32 = lane & 31, hi = lane >> 5;
  const int widu = __builtin_amdgcn_readfirstlane(wid), half = widu >> 2;
  const int hsub = widu >> 1, rsub = (widu & 1) * QBLK;
  const int rw0 = q0 + rsub;
#define NEED(j) (MODE == 0 || ((kbeg + (j) * KVBLK + KVBLK - 1 >= rw0 - 128) && (kbeg + (j) * KVBLK <= rw0 + QBLK - 1 + 128)))
  char* V_lds = lds; char* K_lds = lds + SHM_V;
  float* ws = (float*)(lds + OFF_WS) + wid * 64; float* li_l = ws; float* al_l = ws + 32;
  float* tab = (float*)(lds + OFF_TAB) + hsub * 768;
  float m_reg = -1e30f, l_reg = 0; f32x16 o[4] = {}; bf16x8 qr[8];
  const bf16_t* Qw = Qb + (long)(rsub + r32) * LDQ + hsub * HD + hi * 8;
#pragma unroll
  for (int d0 = 0; d0 < 8; ++d0) qr[d0] = *reinterpret_cast<const bf16x8*>(Qw + d0 * 16);
  if constexpr (MODE == 1) {
    m_reg = aux.sink[head + hsub] * LOG2E; l_reg = 1.0f;
  }
  const int tbase = kbeg - q0 - rsub - r32 + 383 + 4 * hi;
  float qk_init = 0.f;
  if constexpr (MODE == 0) {
    float mq = fmaxf(fabsf(aux.qn[lane]), fabsf(aux.qn[64 + lane])), mk = fmaxf(fabsf(aux.kn[lane]), fabsf(aux.kn[64 + lane]));
#pragma unroll
    for (int of = 1; of < 64; of <<= 1) { mq = fmaxf(mq, __shfl_xor(mq, of)); mk = fmaxf(mk, __shfl_xor(mk, of)); }
    const float bound = C * 128.0f * mq * mk * 1.01f + 0.5f;
    m_reg = __builtin_amdgcn_readfirstlane(__float_as_int(bound > 64.f ? bound - 64.f : 0.f)) ? (bound - 64.f) : 0.f; (void)qk_init; }
  const int sr = tid >> 4, sc = (tid & 15) * 8, vst0 = v_st(sr, sc), vst1 = v_st(32 + sr, sc);
  const int vb0 = (int)(uintptr_t)V_lds + v_rd_base(lane);
  int kx[4];
#pragma unroll
  for (int d = 0; d < 4; ++d) kx[d] = r32 * 256 + ((d * 32 + hi * 16) ^ ((r32 & 7) << 4));
  const LAS char* k3 = (const LAS char*)K_lds; const LAS char* v3 = (const LAS char*)V_lds + v_rd_base(lane);
  bf16x8 fr_[8];
  bf16x8 s_v0, s_v1, s_k0, s_k1;
#define SLOAD(k0) do { s_v0 = *reinterpret_cast<const bf16x8*>(&Vh[(long)(kbeg + (k0) + sr) * LDK + sc]); s_v1 = *reinterpret_cast<const bf16x8*>(&Vh[(long)(kbeg + (k0) + 32 + sr) * LDK + sc]); \
    s_k0 = *reinterpret_cast<const bf16x8*>(&Kh[(long)(kbeg + (k0) + sr) * LDK + sc]); s_k1 = *reinterpret_cast<const bf16x8*>(&Kh[(long)(kbeg + (k0) + 32 + sr) * LDK + sc]); } while (0)
#define SWRITE(bo) do { *(bf16x8*)(V_lds + (bo) + vst0) = s_v0; *(bf16x8*)(V_lds + (bo) + vst1) = s_v1; const int kc = sc * 2;  \
    *(bf16x8*)(K_lds + (bo) + KSWZ(sr, kc)) = s_k0; *(bf16x8*)(K_lds + (bo) + KSWZ(32 + sr, kc)) = s_k1; } while (0)
#define VMW0() asm volatile("s_waitcnt vmcnt(0)" ::: "memory")
#define BAR() asm volatile("s_waitcnt lgkmcnt(0)\n\ts_barrier" ::: "memory")
#define RESC(a) do { if (__any((a) < 1.f)) { if (hi == 0) al_l[r32] = (a); asm volatile("s_waitcnt lgkmcnt(0)" ::: "memory"); \
    _Pragma("unroll") for (int d = 0; d < 4; ++d) _Pragma("unroll") for (int r = 0; r < 16; ++r) o[d][r] *= al_l[crow(r, hi)]; } } while (0)
#define ROT() do { const int t_ = o_prev; o_prev = o_cur; o_cur = o_next; o_next = t_; } while (0)
#define VSEG(j) do { VMW0(); SWRITE(o_next); { const int nx_ = (j) + 2 + half; SLOAD((nx_ < NT ? nx_ : NT - 1) * KVBLK); } SBAR(); \
    if (NEED(j)) { softmax_tile<MODE>(p0, p1, m_reg, l_reg, alpha, pa0, pa1, pa2, pa3, tab + tbase + (j) * KVBLK); if constexpr (MODE == 1) { RESC(alpha); } } SBAR(); } while (0)
#define PVPRE() do { if constexpr (MODE == 0) { _Pragma("unroll") for (int s_ = 0; s_ < 8; ++s_) fr_[s_] = ld_frag2(s_, k3, kx, v3 + o_cur); SBAR(); } } while (0)
  f32x16 p0, p1; float alpha; bf16x8 pa0, pa1, pa2, pa3; const int NT = (kend - kbeg) / KVBLK;
  int o_prev = 2 * BUFB, o_cur = 0, o_next = BUFB;
  { bf16x8 t_v0, t_v1, t_k0, t_k1;
    t_v0 = *reinterpret_cast<const bf16x8*>(&Vh[(long)(kbeg + sr) * LDK + sc]); t_v1 = *reinterpret_cast<const bf16x8*>(&Vh[(long)(kbeg + 32 + sr) * LDK + sc]);
    t_k0 = *reinterpret_cast<const bf16x8*>(&Kh[(long)(kbeg + sr) * LDK + sc]); t_k1 = *reinterpret_cast<const bf16x8*>(&Kh[(long)(kbeg + 32 + sr) * LDK + sc]);
    SLOAD(KVBLK); VMW0();
    *(bf16x8*)(V_lds + vst0) = t_v0; *(bf16x8*)(V_lds + vst1) = t_v1; { const int kc = sc * 2; *(bf16x8*)(K_lds + KSWZ(sr, kc)) = t_k0; *(bf16x8*)(K_lds + KSWZ(32 + sr, kc)) = t_k1; }
    if (half) { SWRITE(BUFB); SLOAD(2 * KVBLK); } }
  BAR();
#define MSEG_QK(j) do { SBAR(); if (NEED(j)) qkt(p0, p1, (const bf16_t*)(K_lds + o_cur), qr, r32, hi, qk_init); SBAR(); } while (0)
#define MSEG(j) do { SBAR(); if (NEED(j)) qkt(p0, p1, (const bf16_t*)(K_lds + o_cur), qr, r32, hi, qk_init); if (NEED((j) - 1)) pv_d0(o, vb0 + o_prev, pa0, pa1, pa2, pa3); SBAR(); } while (0)
#define MSEG_PV() do { SBAR(); if (NEED(NT - 1)) pv_d0(o, vb0 + o_prev, pa0, pa1, pa2, pa3); SBAR(); } while (0)
  if (half == 0) {
    MSEG_QK(0); VSEG(0);
    BAR(); ROT();
    for (int j = 1; j < NT; ++j) { MSEG(j); VSEG(j); BAR(); ROT(); }
    MSEG_PV();
  } else {
    MSEG_QK(0);
    BAR(); ROT();
    for (int j = 1; j < NT; ++j) { VSEG(j - 1); MSEG(j); BAR(); ROT(); }
    VSEG(NT - 1); MSEG_PV();
  }
#undef MSEG_QK
#undef MSEG
#undef MSEG_PV
  if (hi == 0) li_l[r32] = l_reg; asm volatile("s_waitcnt lgkmcnt(0)" ::: "memory");
  float rli[16];
#pragma unroll
  for (int r = 0; r < 16; ++r) rli[r] = __builtin_amdgcn_rcpf(li_l[crow(r, hi)]);
  VMW0();
  __syncthreads();
  char* ost = lds + OFF_OST + wid * 4096;
#pragma unroll
  for (int r = 0; r < 16; ++r) { const int orow = crow(r, hi);
#pragma unroll
    for (int d0 = 0; d0 < 4; ++d0) { const float xo = o[d0][r] * rli[r] * OB8S; *(unsigned char*)(ost + orow * 128 + d0 * 32 + r32) = (unsigned char)(__builtin_amdgcn_cvt_pk_fp8_f32(xo, xo, 0, false) & 0xff); } }
  asm volatile("s_waitcnt lgkmcnt(0)" ::: "memory");
  unsigned char* Ow = Ob8 + (long)rsub * QW + hsub * HD;
#pragma unroll
  for (int i = 0; i < 4; ++i) { const int ch = i * 64 + lane, row = ch >> 3, c16 = ch & 7;
    const u32x4 v = *(const u32x4*)(ost + row * 128 + c16 * 16); *(u32x4*)(Ow + (long)row * QW + c16 * 16) = v; }
  asm volatile("s_waitcnt lgkmcnt(0)" ::: "memory");
  __syncthreads();
#undef SLOAD
#undef SWRITE
#undef VMW0
#undef BAR
#undef RESC
#undef ROT
#undef VSEG
#undef PVPRE
#undef NEED
}

__device__ __forceinline__ int offK16(int row, int ch) { return row * 256 + 16 * (ch ^ (row & 15)); }
__device__ __forceinline__ int offV16(int row, int ch) { return row * 256 + 16 * (ch ^ ((row & 7) << 1)); }
__device__ __forceinline__ bf16x8 ld_frag16(int sp, const LAS char* kb, const int (&ka)[4], const LAS char* vb, const int (&va)[8]) {
  if (sp >= 16) { const int s = sp - 16, kblk = s >> 2, ks = s & 3; return *(const LAS bf16x8*)(kb + ka[ks] + kblk * 4096); }
  const int db = sp >> 1, s = sp & 1;
  const s16x4 lo = __builtin_bit_cast(s16x4, __builtin_amdgcn_ds_read_tr16_b64_v4i16((LAS v4i16_t*)(vb + va[db] + s * 8192)));
  const s16x4 hi = __builtin_bit_cast(s16x4, __builtin_amdgcn_ds_read_tr16_b64_v4i16((LAS v4i16_t*)(vb + va[db] + s * 8192 + 4096)));
  return (bf16x8){lo[0], lo[1], lo[2], lo[3], hi[0], hi[1], hi[2], hi[3]};
}
template <int SB, int SE, bool PRE>
__device__ __forceinline__ void mrun16(bf16x8 (&f)[8], f32x4 (&S)[4][2], f32x4 (&O)[8][2], const bf16x8 (&qf)[2][4], const bf16x8 (&pf)[2][2], const LAS char* kb, const int (&ka)[4], const LAS char* vb, const int (&va)[8]) {
  if (SE > 16) {
#pragma unroll
    for (int i = 0; i < 4; ++i) { S[i][0] = (f32x4){0.f, 0.f, 0.f, 0.f}; S[i][1] = (f32x4){0.f, 0.f, 0.f, 0.f}; } }
  SBAR();
  if (!PRE) {
#pragma unroll
    for (int s = SB; s < SB + 8; ++s) f[s & 7] = ld_frag16(s, kb, ka, vb, va);
    SBAR(); }
#pragma unroll
  for (int sp = SB; sp < SE; ++sp) {
    if (sp >= 16) { const int s = sp - 16, kblk = s >> 2, ks = s & 3;
      S[kblk][0] = __builtin_amdgcn_mfma_f32_16x16x32_bf16(f[sp & 7], qf[0][ks], S[kblk][0], 0, 0, 0); S[kblk][1] = __builtin_amdgcn_mfma_f32_16x16x32_bf16(f[sp & 7], qf[1][ks], S[kblk][1], 0, 0, 0); }
    else { const int db = sp >> 1, s = sp & 1;
      O[db][0] = __builtin_amdgcn_mfma_f32_16x16x32_bf16(f[sp & 7], pf[0][s], O[db][0], 0, 0, 0); O[db][1] = __builtin_amdgcn_mfma_f32_16x16x32_bf16(f[sp & 7], pf[1][s], O[db][1], 0, 0, 0); }
    if (sp + 8 < SE) f[sp & 7] = ld_frag16(sp + 8, kb, ka, vb, va);
    SBAR();
  }
}
__device__ __forceinline__ void attn_unit16(const bf16_t* Qb, const bf16_t* __restrict__ Kh, const bf16_t* __restrict__ Vh, bf16_t* Ob, int nkeys, int q0, char* lds, const Aux& aux) {
  int tid = threadIdx.x; asm volatile("" : "+v"(tid));
  const int wid = tid >> 6, lane = tid & 63, fr = lane & 15, fq = lane >> 4;
  const int half = __builtin_amdgcn_readfirstlane(wid >> 2);
  char* V_lds = lds; char* K_lds = lds + SHM_V;
  float shift;
  { float mq = fmaxf(fabsf(aux.qn[lane]), fabsf(aux.qn[64 + lane])), mk = fmaxf(fabsf(aux.kn[lane]), fabsf(aux.kn[64 + lane]));
#pragma unroll
    for (int of = 1; of < 64; of <<= 1) { mq = fmaxf(mq, __shfl_xor(mq, of)); mk = fmaxf(mk, __shfl_xor(mk, of)); }
    const float bound = C * 128.0f * mq * mk * 1.01f + 0.5f; shift = bound > 64.f ? bound - 64.f : 0.f; }
  bf16x8 qf[2][4];
#pragma unroll
  for (int qb = 0; qb < 2; ++qb)
#pragma unroll
    for (int ks = 0; ks < 4; ++ks) qf[qb][ks] = *reinterpret_cast<const bf16x8*>(Qb + (long)(wid * QBLK + 16 * qb + fr) * LDQ + 32 * ks + 8 * fq);
#pragma unroll
  for (int qb = 0; qb < 2; ++qb) {
    float ss = 0.f;
#pragma unroll
    for (int ks = 0; ks < 4; ++ks) { const f32x8 x = bf8_to_f32(qf[qb][ks]);
#pragma unroll
      for (int e = 0; e < 8; ++e) ss += x[e] * x[e]; }
    ss += __shfl_xor(ss, 16); ss += __shfl_xor(ss, 32);
    const float rinv = C / sqrtf(ss * (1.0f / 128.0f) + EPS);
    const int t = q0 + wid * QBLK + 16 * qb + fr;
#pragma unroll
    for (int hf = 0; hf < 2; ++hf) { const int posx = hf ? (t & 63) : (t >> 6);
      const f32x8 cs = *reinterpret_cast<const f32x8*>(aux.cosT + posx * 32 + 8 * fq), sn = *reinterpret_cast<const f32x8*>(aux.sinT + posx * 32 + 8 * fq);
      const f32x8 g1 = *reinterpret_cast<const f32x8*>(aux.qn + hf * 64 + 8 * fq), g2 = *reinterpret_cast<const f32x8*>(aux.qn + hf * 64 + 32 + 8 * fq);
      const f32x8 x1 = bf8_to_f32(qf[qb][2 * hf]) * rinv * g1, x2 = bf8_to_f32(qf[qb][2 * hf + 1]) * rinv * g2;
      qf[qb][2 * hf] = f32_to_bf8(x1 * cs - x2 * sn); qf[qb][2 * hf + 1] = f32_to_bf8(x2 * cs + x1 * sn); } }
  f32x4 O[8][2], S[4][2]; bf16x8 pf[2][2]; float lsum[2] = {0.f, 0.f};
#pragma unroll
  for (int i = 0; i < 8; ++i) { O[i][0] = (f32x4){0.f, 0.f, 0.f, 0.f}; O[i][1] = (f32x4){0.f, 0.f, 0.f, 0.f}; }
  int ka[4], va[8];
#pragma unroll
  for (int ks = 0; ks < 4; ++ks) ka[ks] = offK16(fr, 4 * ks + fq);
  { const int q = (lane & 15) >> 2, p = lane & 3;
#pragma unroll
    for (int c = 0; c < 8; ++c) va[c] = offV16(4 * fq + q, 2 * c + (p >> 1)) + 8 * (p & 1); }
  const LAS char* k3 = (const LAS char*)K_lds; const LAS char* v3 = (const LAS char*)V_lds;
  bf16x8 fr_[8];
  const int sr = tid >> 4, scc = tid & 15, kst = offK16(sr, scc), vst = offV16(sr, scc);
  bf16x8 s_v0, s_v1, s_k0, s_k1;
#define SLOAD(k0) do { s_v0 = *reinterpret_cast<const bf16x8*>(&Vh[(long)((k0) + sr) * LDK + scc * 8]); s_v1 = *reinterpret_cast<const bf16x8*>(&Vh[(long)((k0) + 32 + sr) * LDK + scc * 8]); \
    s_k0 = *reinterpret_cast<const bf16x8*>(&Kh[(long)((k0) + sr) * LDK + scc * 8]); s_k1 = *reinterpret_cast<const bf16x8*>(&Kh[(long)((k0) + 32 + sr) * LDK + scc * 8]); } while (0)
#define SWRITE(bo) do { *(bf16x8*)(V_lds + (bo) + vst) = s_v0; *(bf16x8*)(V_lds + (bo) + vst + 8192) = s_v1; *(bf16x8*)(K_lds + (bo) + kst) = s_k0; *(bf16x8*)(K_lds + (bo) + kst + 8192) = s_k1; } while (0)
#define VMW0() asm volatile("s_waitcnt vmcnt(0)" ::: "memory")
#define BAR() asm volatile("s_waitcnt lgkmcnt(0)\n\ts_barrier" ::: "memory")
#define ROT() do { const int t_ = o_prev; o_prev = o_cur; o_cur = o_next; o_next = t_; } while (0)
#define VSEG(j, wbuf_, pbuf_) do { VMW0(); SWRITE(wbuf_); { const int nx_ = (j) + 2 + half; SLOAD((nx_ < NT ? nx_ : NT - 1) * KVBLK); } SBAR(); \
    if (__builtin_expect(shift != 0.f, 0)) { _Pragma("unroll") for (int i_ = 0; i_ < 4; ++i_) { S[i_][0] -= shift; S[i_][1] -= shift; } } \
    _Pragma("unroll") for (int qb_ = 0; qb_ < 2; ++qb_) { \
      _Pragma("unroll") for (int i_ = 0; i_ < 4; ++i_) _Pragma("unroll") for (int r_ = 0; r_ < 4; ++r_) S[i_][qb_][r_] = __builtin_amdgcn_exp2f(S[i_][qb_][r_]); \
      float a_ = 0.f; _Pragma("unroll") for (int i_ = 0; i_ < 4; ++i_) a_ += (S[i_][qb_][0] + S[i_][qb_][1]) + (S[i_][qb_][2] + S[i_][qb_][3]); lsum[qb_] += a_; \
      _Pragma("unroll") for (int s_ = 0; s_ < 2; ++s_) { u32x4 w_ = {cvtpk(S[2 * s_][qb_][0], S[2 * s_][qb_][1]), cvtpk(S[2 * s_][qb_][2], S[2 * s_][qb_][3]), cvtpk(S[2 * s_ + 1][qb_][0], S[2 * s_ + 1][qb_][1]), cvtpk(S[2 * s_ + 1][qb_][2], S[2 * s_ + 1][qb_][3])}; \
        pf[qb_][s_] = *reinterpret_cast<bf16x8*>(&w_); } } \
    SBAR(); _Pragma("unroll") for (int s_ = 0; s_ < 8; ++s_) fr_[s_] = ld_frag16(s_, k3, ka, v3 + (pbuf_), va); SBAR(); } while (0)
  const int NT = nkeys / KVBLK;
  int o_prev = 2 * BUFB, o_cur = 0, o_next = BUFB;
  SLOAD(0); VMW0(); SWRITE(0);
  if (half) { SLOAD(KVBLK); VMW0(); SWRITE(BUFB); SLOAD(2 * KVBLK); } else { SLOAD(KVBLK); }
  BAR();
  if (half == 0) {
    mrun16<16, 32, false>(fr_, S, O, qf, pf, k3 + o_cur, ka, v3 + o_prev, va);
    VSEG(0, o_next, o_cur);
    BAR(); ROT();
    for (int j = 1; j < NT; ++j) {
      mrun16<0, 32, true>(fr_, S, O, qf, pf, k3 + o_cur, ka, v3 + o_prev, va);
      VSEG(j, o_next, o_cur);
      BAR(); ROT();
    }
    mrun16<0, 16, true>(fr_, S, O, qf, pf, k3 + o_cur, ka, v3 + o_prev, va);
  } else {
    mrun16<16, 32, false>(fr_, S, O, qf, pf, k3 + o_cur, ka, v3 + o_prev, va);
    BAR(); ROT();
    for (int j = 1; j < NT; ++j) {
      VSEG(j - 1, o_next, o_prev);
      mrun16<0, 32, true>(fr_, S, O, qf, pf, k3 + o_cur, ka, v3 + o_prev, va);
      BAR(); ROT();
    }
    VSEG(NT - 1, o_next, o_prev);
    mrun16<0, 16, true>(fr_, S, O, qf, pf, k3 + o_cur, ka, v3 + o_prev, va);
  }
  float rl[2];
#pragma unroll
  for (int qb = 0; qb < 2; ++qb) { float l = lsum[qb]; l += __shfl_xor(l, 16); l += __shfl_xor(l, 32); rl[qb] = __builtin_amdgcn_rcpf(l); }
  VMW0();
  __syncthreads();
  char* ost = lds + OFF_OST + wid * 8192;
#pragma unroll
  for (int db = 0; db < 8; ++db)
#pragma unroll
    for (int qb = 0; qb < 2; ++qb) { const f32x4 v = O[db][qb] * rl[qb]; u32x2 w; w.x = cvtpk(v[0], v[1]); w.y = cvtpk(v[2], v[3]);
      *(u32x2*)(ost + (16 * qb + fr) * 256 + (16 * db + 4 * fq) * 2) = w; }
  asm volatile("s_waitcnt lgkmcnt(0)" ::: "memory");
  bf16_t* Ow = Ob + (long)(wid * QBLK) * LDQ;
#pragma unroll
  for (int i = 0; i < 8; ++i) { const int ch = i * 64 + lane, row = ch >> 4, c16 = ch & 15;
    const u32x4 v = *(const u32x4*)(ost + row * 256 + c16 * 16); *(u32x4*)(Ow + (long)row * LDQ + c16 * 8) = v; }
  asm volatile("s_waitcnt lgkmcnt(0)" ::: "memory");
  __syncthreads();
#undef SLOAD
#undef SWRITE
#undef VMW0
#undef BAR
#undef ROT
#undef VSEG
}

typedef int v8i_t __attribute__((ext_vector_type(8)));
typedef short v2s_t __attribute__((ext_vector_type(2)));
__device__ __forceinline__ int off8(int row, int c16) { return row * 128 + 16 * (c16 ^ (((row >> 1) & 1) | (((row >> 2) & 1) << 2))); }
__device__ __forceinline__ v8i_t ld_frag8(const LAS char* img, int a0, int a1, int blk) {
  const u32x4 lo = *(const LAS u32x4*)(img + blk * 2048 + a0), hi = *(const LAS u32x4*)(img + blk * 2048 + a1);
  return (v8i_t){(int)lo.x, (int)lo.y, (int)lo.z, (int)lo.w, (int)hi.x, (int)hi.y, (int)hi.z, (int)hi.w};
}
__device__ __forceinline__ void exp_pack8(f32x4 (&S)[4][2], v8i_t (&pf)[2], int h) {
#pragma unroll
  for (int qb = 0; qb < 2; ++qb) {
#pragma unroll
    for (int i = 0; i < 4; ++i) { f32x4 e;
#pragma unroll
      for (int r = 0; r < 4; ++r) e[r] = __builtin_amdgcn_exp2f(S[i][qb][r]);
      int w = __builtin_amdgcn_cvt_pk_bf8_f32(e[0], e[1], __builtin_bit_cast(int, e[0]), false); w = __builtin_amdgcn_cvt_pk_bf8_f32(e[2], e[3], w, true);
      if (h == 0) { if (i == 0) pf[qb][0] = w; else if (i == 1) pf[qb][1] = w; else if (i == 2) pf[qb][2] = w; else pf[qb][3] = w; }
      else { if (i == 0) pf[qb][4] = w; else if (i == 1) pf[qb][5] = w; else if (i == 2) pf[qb][6] = w; else pf[qb][7] = w; } } }
}
struct FRing { u32x4 l[4], h[4]; u32x2 k2[4]; };
template <int OFF> __device__ __forceinline__ void ldf8(u32x4& lo, u32x4& hi, unsigned ad0, unsigned ad1) {
  asm volatile("ds_read_b128 %0, %1 offset:%2" : "=&v"(lo) : "v"(ad0), "n"(OFF));
  asm volatile("ds_read_b128 %0, %1 offset:%2" : "=&v"(hi) : "v"(ad1), "n"(OFF));
}
template <int N> __device__ __forceinline__ v8i_t wtf8(u32x4& lo, u32x4& hi) {
  asm volatile("s_waitcnt lgkmcnt(%2)" : "+v"(lo), "+v"(hi) : "n"(N));
  return (v8i_t){(int)lo.x, (int)lo.y, (int)lo.z, (int)lo.w, (int)hi.x, (int)hi.y, (int)hi.z, (int)hi.w};
}
template <int OFF> __device__ __forceinline__ void ldf6(u32x4& lo, u32x2& h2, unsigned ad0, unsigned ad1) {
  asm volatile("ds_read_b128 %0, %1 offset:%2" : "=&v"(lo) : "v"(ad0), "n"(OFF));
  asm volatile("ds_read_b64 %0, %1 offset:%2" : "=&v"(h2) : "v"(ad1), "n"(OFF));
}
template <int N> __device__ __forceinline__ v8i_t wtf6(u32x4& lo, u32x2& h2) {
  asm volatile("s_waitcnt lgkmcnt(%2)" : "+v"(lo), "+v"(h2) : "n"(N));
  v8i_t f; f[0] = (int)lo.x; f[1] = (int)lo.y; f[2] = (int)lo.z; f[3] = (int)lo.w; f[4] = (int)h2.x; f[5] = (int)h2.y;
  return f;
}
template <int T> __device__ __forceinline__ void ldstep8(FRing& R, unsigned k0, unsigned k1, unsigned v0, unsigned v1) {
  if constexpr (T >= 8) ldf6<(T - 8) * 2048>(R.l[T & 3], R.k2[T & 3], k0, k1); else ldf8<T * 2048>(R.l[T & 3], R.h[T & 3], v0, v1);
}
template <int SP, int SE>
__device__ __forceinline__ void mstep8(FRing& R, f32x4 (&S)[4][2], f32x4 (&O)[8][2], const v8i_t (&qf)[2], v8i_t (&pf)[2], f32x4 (&L)[2], float nE, int sa, int sb, unsigned k0, unsigned k1, unsigned v0, unsigned v1) {
  if constexpr (SP < SE) {
    constexpr int NA = (SE - 1 - SP) < 2 ? (SE - 1 - SP) : 2;
    v8i_t f; if constexpr (SP >= 8) f = wtf6<2 * NA>(R.l[SP & 3], R.k2[SP & 3]); else f = wtf8<2 * NA>(R.l[SP & 3], R.h[SP & 3]);
    if constexpr (SP >= 8) { const f32x4 z = {nE, nE, nE, nE}; S[(SP - 8) & 3][0] = __builtin_amdgcn_mfma_scale_f32_16x16x128_f8f6f4(f, qf[0], z, 2, 2, 0, sa, 0, sb); }
    else O[SP][0] = __builtin_amdgcn_mfma_scale_f32_16x16x128_f8f6f4(f, pf[0], O[SP][0], 0, 1, 0, 0, 0, 0);
    if constexpr (SP + 3 < SE) ldstep8<SP + 3>(R, k0, k1, v0, v1);
    if constexpr (SP >= 8) { const f32x4 z = {nE, nE, nE, nE}; S[(SP - 8) & 3][1] = __builtin_amdgcn_mfma_scale_f32_16x16x128_f8f6f4(f, qf[1], z, 2, 2, 0, sa, 0, sb); }
    else O[SP][1] = __builtin_amdgcn_mfma_scale_f32_16x16x128_f8f6f4(f, pf[1], O[SP][1], 0, 1, 0, 0, 0, 0);
    if constexpr (SP == 0) { const int o1 = 0x38383838; const v8i_t ones = {o1, o1, o1, o1, o1, o1, o1, o1};
      L[0] = __builtin_amdgcn_mfma_scale_f32_16x16x128_f8f6f4(ones, pf[0], L[0], 0, 1, 0, 0, 0, 0); L[1] = __builtin_amdgcn_mfma_scale_f32_16x16x128_f8f6f4(ones, pf[1], L[1], 0, 1, 0, 0, 0, 0); }
    SBAR();
    if constexpr (SP == 11) { exp_pack8(S, pf, 0); SBAR(); }
  }
}
template <bool DO_PV, bool DO_QK, bool PRE>
__device__ __forceinline__ void mrun8(FRing& R, f32x4 (&S)[4][2], f32x4 (&O)[8][2], const v8i_t (&qf)[2], v8i_t (&pf)[2], f32x4 (&L)[2], float nE, int sa, int sb, const LAS char* kimg, const LAS char* vimg, int a0, int a1) {
  constexpr int SB = DO_PV ? 0 : 8, SE = DO_QK ? 16 : 8;
  const unsigned k0 = (unsigned)(size_t)kimg + (unsigned)a0, k1 = (unsigned)(size_t)kimg + (unsigned)a1, v0 = (unsigned)(size_t)vimg + (unsigned)a0, v1 = (unsigned)(size_t)vimg + (unsigned)a1;
  SBAR();
  if (!PRE) { ldstep8<SB>(R, k0, k1, v0, v1); ldstep8<SB + 1>(R, k0, k1, v0, v1); ldstep8<SB + 2>(R, k0, k1, v0, v1); SBAR(); }
#define MS8(sp_) mstep8<(SB + sp_ < SE ? SB + sp_ : SE), SE>(R, S, O, qf, pf, L, nE, sa, sb, k0, k1, v0, v1)
  MS8(0); MS8(1); MS8(2); MS8(3); MS8(4); MS8(5); MS8(6); MS8(7); MS8(8); MS8(9); MS8(10); MS8(11); MS8(12); MS8(13); MS8(14); MS8(15);
#undef MS8
}
__device__ __forceinline__ float xsum16(float x) { auto r = __builtin_amdgcn_permlane16_swap(__float_as_uint(x), __float_as_uint(x), false, false); return __uint_as_float(r[0]) + __uint_as_float(r[1]); }
__device__ __forceinline__ float xsum32(float x) { auto r = __builtin_amdgcn_permlane32_swap(__float_as_uint(x), __float_as_uint(x), false, false); return __uint_as_float(r[0]) + __uint_as_float(r[1]); }
__device__ __forceinline__ float xchg16(float x, bool odd) { auto r = __builtin_amdgcn_permlane16_swap(__float_as_uint(x), __float_as_uint(x), false, false); return __uint_as_float(odd ? r[0] : r[1]); }
__device__ __forceinline__ void attn_unit8(const bf16_t* Qb, const unsigned char* __restrict__ K8, const unsigned char* __restrict__ V8T, unsigned char* Ob8, int q0, char* lds, const Aux& aux, float nE, float qcv, int sa, int sb) {
  int tid = threadIdx.x; asm volatile("" : "+v"(tid));
  const int wid = tid >> 6, lane = tid & 63, fr = lane & 15, g = lane >> 4;
  const int half = __builtin_amdgcn_readfirstlane(wid >> 2);
  v8i_t qf[2];
  { char* qs = lds + 2 * BUFB + wid * 8192;
#pragma unroll
    for (int qb = 0; qb < 2; ++qb) {
      bf16x8 q16[4]; float ss = 0.f;
#pragma unroll
      for (int ks = 0; ks < 4; ++ks) { q16[ks] = *reinterpret_cast<const bf16x8*>(Qb + (long)(wid * QBLK + 16 * qb + fr) * LDQ + 32 * ks + 8 * g); const f32x8 x = bf8_to_f32(q16[ks]);
#pragma unroll
        for (int e = 0; e < 8; ++e) ss += x[e] * x[e]; }
      ss = xsum32(xsum16(ss));
      const float rinv = C / sqrtf(ss * (1.0f / 128.0f) + EPS);
      const int t = q0 + wid * QBLK + 16 * qb + fr;
#pragma unroll
      for (int hf = 0; hf < 2; ++hf) { const int posx = hf ? (t & 63) : (t >> 6);
        const f32x8 cs = *reinterpret_cast<const f32x8*>(aux.cosT + posx * 32 + 8 * g), sn = *reinterpret_cast<const f32x8*>(aux.sinT + posx * 32 + 8 * g);
        const f32x8 g1 = *reinterpret_cast<const f32x8*>(aux.qn + hf * 64 + 8 * g), g2 = *reinterpret_cast<const f32x8*>(aux.qn + hf * 64 + 32 + 8 * g);
        const f32x8 x1 = bf8_to_f32(q16[2 * hf]) * rinv * g1, x2 = bf8_to_f32(q16[2 * hf + 1]) * rinv * g2;
        const f32x8 y1 = x1 * cs - x2 * sn, y2 = x2 * cs + x1 * sn;
        *(u32x4*)(qs + (16 * qb + fr) * 256 + (32 * (2 * hf) + 8 * g) * 2) = (u32x4){cvt_pk_bf16(y1[0], y1[1]), cvt_pk_bf16(y1[2], y1[3]), cvt_pk_bf16(y1[4], y1[5]), cvt_pk_bf16(y1[6], y1[7])};
        *(u32x4*)(qs + (16 * qb + fr) * 256 + (32 * (2 * hf + 1) + 8 * g) * 2) = (u32x4){cvt_pk_bf16(y2[0], y2[1]), cvt_pk_bf16(y2[2], y2[3]), cvt_pk_bf16(y2[4], y2[5]), cvt_pk_bf16(y2[6], y2[7])}; }
    }
    asm volatile("s_waitcnt lgkmcnt(0)" ::: "memory");
#pragma unroll
    for (int qb = 0; qb < 2; ++qb) { const char* pr = qs + (16 * qb + fr) * 256 + 64 * g;
      union { u32x4 w[4]; v32bf_t v; } cv; cv.w[0] = *(const u32x4*)pr; cv.w[1] = *(const u32x4*)(pr + 16); cv.w[2] = *(const u32x4*)(pr + 32); cv.w[3] = *(const u32x4*)(pr + 48);
      const v6u_t p6 = __builtin_amdgcn_cvt_scalef32_pk32_fp6_bf16(cv.v, qcv);
      qf[qb] = (v8i_t){(int)p6[0], (int)p6[1], (int)p6[2], (int)p6[3], (int)p6[4], (int)p6[5], 0, 0}; }
    asm volatile("s_waitcnt lgkmcnt(0)" ::: "memory");
    __syncthreads(); }
  f32x4 O[8][2], S[4][2]; v8i_t pf[2]; f32x4 L[2] = {{0.f, 0.f, 0.f, 0.f}, {0.f, 0.f, 0.f, 0.f}};
#pragma unroll
  for (int i = 0; i < 8; ++i) { O[i][0] = (f32x4){0.f, 0.f, 0.f, 0.f}; O[i][1] = (f32x4){0.f, 0.f, 0.f, 0.f}; }
  const int a0 = off8(fr, 2 * g), a1 = off8(fr, 2 * g + 1);
  char* V_lds = lds; char* K_lds = lds + SHM_V;
  const LAS char* k3 = (const LAS char*)K_lds; const LAS char* v3 = (const LAS char*)V_lds;
  FRing fr_;
  const int widu = __builtin_amdgcn_readfirstlane(wid);
  unsigned dso[2];
#pragma unroll
  for (int i = 0; i < 2; ++i) { const int c = (wid * 2 + i) * 64 + lane, row = c >> 3, p = c & 7; dso[i] = (unsigned)(row * 128 + ((p ^ (((row >> 1) & 1) | (((row >> 2) & 1) << 2))) << 4)); }
  const unsigned ldsw = (unsigned)widu * 2048u; LAS unsigned char* l3 = (LAS unsigned char*)lds;
#define DMA_TILE(t_) do { const unsigned char* kg_ = K8 + (size_t)(t_) * 16384; const unsigned char* vg_ = V8T + (size_t)(t_) * 16384; const unsigned bo_ = (unsigned)(((t_) & 3) * BUFB); \
    _Pragma("unroll") for (int i_ = 0; i_ < 2; ++i_) { \
      __builtin_amdgcn_global_load_lds((const unsigned*)(vg_ + dso[i_]), (LAS unsigned*)(l3 + bo_ + ldsw + i_ * 1024), 16, 0, 0); \
      __builtin_amdgcn_global_load_lds((const unsigned*)(kg_ + dso[i_]), (LAS unsigned*)(l3 + bo_ + SHM_V + ldsw + i_ * 1024), 16, 0, 0); } } while (0)
#define VMW0() asm volatile("s_waitcnt vmcnt(0)" ::: "memory")
#define BAR() asm volatile("s_waitcnt lgkmcnt(0)\n\ts_barrier" ::: "memory")
#define VSEG(j, pbuf_) do { VMW0(); { const int nx_ = (j) + 2 + half; if (nx_ < NT) DMA_TILE(nx_); } SBAR(); \
    exp_pack8(S, pf, 1); \
    SBAR(); { const unsigned pv0_ = (unsigned)(size_t)(v3 + (pbuf_)) + (unsigned)a0, pv1_ = (unsigned)(size_t)(v3 + (pbuf_)) + (unsigned)a1; ldstep8<0>(fr_, 0u, 0u, pv0_, pv1_); ldstep8<1>(fr_, 0u, 0u, pv0_, pv1_); ldstep8<2>(fr_, 0u, 0u, pv0_, pv1_); } SBAR(); } while (0)
  constexpr int NT = SEQ / 128;
  DMA_TILE(0); DMA_TILE(1); if (half) DMA_TILE(2);
  VMW0(); BAR();
#define BARN() asm volatile("s_barrier" ::: "memory")
  if (half == 0) __builtin_amdgcn_s_setprio(1);
  if (half == 0) {
    mrun8<false, true, false>(fr_, S, O, qf, pf, L, nE, sa, sb, k3, v3, a0, a1);
    VSEG(0, 0);
    BARN();
    for (int j = 1; j < NT; ++j) {
      mrun8<true, true, true>(fr_, S, O, qf, pf, L, nE, sa, sb, k3 + (j & 3) * BUFB, v3 + ((j - 1) & 3) * BUFB, a0, a1);
      VSEG(j, (j & 3) * BUFB);
      BARN();
    }
    mrun8<true, false, true>(fr_, S, O, qf, pf, L, nE, sa, sb, k3, v3 + ((NT - 1) & 3) * BUFB, a0, a1);
  } else {
    mrun8<false, true, false>(fr_, S, O, qf, pf, L, nE, sa, sb, k3, v3, a0, a1);
    BARN();
    for (int j = 1; j < NT; ++j) {
      VSEG(j - 1, ((j - 1) & 3) * BUFB);
      mrun8<true, true, true>(fr_, S, O, qf, pf, L, nE, sa, sb, k3 + (j & 3) * BUFB, v3 + ((j - 1) & 3) * BUFB, a0, a1);
      BARN();
    }
    VSEG(NT - 1, ((NT - 1) & 3) * BUFB);
    mrun8<true, false, true>(fr_, S, O, qf, pf, L, nE, sa, sb, k3, v3 + ((NT - 1) & 3) * BUFB, a0, a1);
  }
#undef BARN
  __builtin_amdgcn_s_setprio(0);
  float rl[2];
#pragma unroll
  for (int qb = 0; qb < 2; ++qb) rl[qb] = __builtin_amdgcn_rcpf(L[qb][0]);
  VMW0();
  __syncthreads();
  char* ost = lds + OFF_OST + wid * 4096;
#pragma unroll
  for (int db = 0; db < 8; ++db)
#pragma unroll
    for (int qb = 0; qb < 2; ++qb) { const f32x4 v = O[db][qb] * (rl[qb] * OA8S); int w = 0; w = __builtin_amdgcn_cvt_pk_fp8_f32(v[0], v[1], w, false); w = __builtin_amdgcn_cvt_pk_fp8_f32(v[2], v[3], w, true);
      *(int*)(ost + (16 * qb + fr) * 128 + 16 * db + 4 * g) = w; }
  asm volatile("s_waitcnt lgkmcnt(0)" ::: "memory");
  unsigned char* Ow = Ob8 + (long)(wid * QBLK) * QW;
#pragma unroll
  for (int i = 0; i < 4; ++i) { const int ch = i * 64 + lane, row = ch >> 3, c16 = ch & 7;
    const u32x4 v = *(const u32x4*)(ost + row * 128 + c16 * 16); *(u32x4*)(Ow + (long)row * QW + c16 * 16) = v; }
  asm volatile("s_waitcnt lgkmcnt(0)" ::: "memory");
  __syncthreads();
#undef DMA_TILE
#undef VMW0
#undef BAR
#undef VSEG
}
}

#define XB_TMO      128
#define XB_XCNT(j)  (256  + 64 * (j))
#define XB_XSUB(j)  (1280 + 64 * (j))
#define XB_XGEN(j)  (2304 + 64 * (j))
#define XB_TOP      3328
#define XB_TOPGEN   3392
#define XCD_BAR_WORDS 3456
#define XB_SPIN_CAP (1u << 18)
__device__ __forceinline__ unsigned xb_ld(unsigned* p)              { return __hip_atomic_load(p, __ATOMIC_RELAXED, __HIP_MEMORY_SCOPE_AGENT); }
__device__ __forceinline__ unsigned xb_add(unsigned* p, unsigned v) { return __hip_atomic_fetch_add(p, v, __ATOMIC_RELAXED, __HIP_MEMORY_SCOPE_AGENT); }
__device__ __forceinline__ unsigned xb_xcc_id() { return (unsigned)__builtin_amdgcn_s_getreg((3 << 11) | 20) & 0xFu; }
#define XB_SPIN(cond, bar) do { unsigned _sp = 0; while (cond) { __builtin_amdgcn_s_sleep(1); \
    if ((++_sp & 255u) == 0u) { if (xb_ld(&(bar)[XB_TMO])) break; if (_sp > XB_SPIN_CAP) { atomicAdd(&(bar)[XB_TMO], 1u); break; } } } } while (0)
struct XcdBarrier { unsigned* bar; unsigned x; volatile LAS unsigned* st; };
__device__ __forceinline__ XcdBarrier xcd_barrier_post(unsigned* bar, volatile LAS unsigned* st) {
    XcdBarrier b; b.bar = bar; b.x = xb_xcc_id(); b.st = st;
    if (threadIdx.x == 0) (void)xb_add(&bar[XB_XCNT(b.x)], 1u);
    return b;
}
__device__ __forceinline__ void xcd_barrier_complete(unsigned* bar, unsigned x, unsigned& nloc, unsigned& nx) {
    const unsigned G = gridDim.x * gridDim.y * gridDim.z;
    unsigned sum, cnt, mine, sp = 0u;
    for (;;) {
        sum = 0u; cnt = 0u; mine = 0u;
#pragma unroll
        for (unsigned j = 0; j < 16; ++j) { const unsigned c = xb_ld(&bar[XB_XCNT(j)]); sum += c; cnt += (c > 0u) ? 1u : 0u; mine = (j == x) ? c : mine; }
        if (sum == G) break;
        __builtin_amdgcn_s_sleep(1);
        if ((++sp & 255u) == 0u) { if (xb_ld(&bar[XB_TMO])) break; if (sp > XB_SPIN_CAP) { atomicAdd(&bar[XB_TMO], 1u); break; } }
    }
    nloc = mine > 0u ? mine : 1u; nx = cnt > 0u ? cnt : 1u;
}
__device__ __forceinline__ void xcd_barrier(const XcdBarrier& b) {
    asm volatile("s_waitcnt vmcnt(0)" ::: "memory");
    __syncthreads();
    if (threadIdx.x == 0) {
        unsigned* bar = b.bar;
        __builtin_amdgcn_s_waitcnt(0);
        unsigned nloc = b.st[0], nx = b.st[1];
        if (nloc == 0u) { xcd_barrier_complete(bar, b.x, nloc, nx); b.st[0] = nloc; b.st[1] = nx; }
        const unsigned old = xb_add(&bar[XB_XSUB(b.x)], 1u);
        const unsigned gen = old / nloc;
        if (old + 1u == (gen + 1u) * nloc) {
            __builtin_amdgcn_fence(__ATOMIC_RELEASE, "agent");
            asm volatile("s_waitcnt vmcnt(0)" ::: "memory");
            const unsigned og = xb_add(&bar[XB_TOP], 1u);
            const unsigned tg = og / nx;
            if (og + 1u == (tg + 1u) * nx) xb_add(&bar[XB_TOPGEN], 1u);
            else XB_SPIN(xb_ld(&bar[XB_TOPGEN]) == tg, bar);
            __builtin_amdgcn_fence(__ATOMIC_ACQUIRE, "agent");
            xb_add(&bar[XB_XGEN(b.x)], 1u);
            asm volatile("s_waitcnt vmcnt(0)" ::: "memory");
        } else {
            XB_SPIN(xb_ld(&bar[XB_XGEN(b.x)]) == gen, bar);
            __builtin_amdgcn_fence(__ATOMIC_ACQUIRE, "agent");
            asm volatile("s_waitcnt vmcnt(0)" ::: "memory");
        }
    }
    __syncthreads();
}

struct Args { const float* in[17]; float* out; unsigned char* ws; int ph_lo, ph_hi, li, pad; };
struct Frame { LAS unsigned char* lds; int tid, lane, wave, vcu, G; };
constexpr int NWAVES = 8;

__device__ __forceinline__ void tr_item(const float* W, int N, int k0, int n0, bf16_t* WT, int Kd, int drow0, LAS float* scr, int lane, unsigned char* WT8 = nullptr, bool wr16 = true) {
    float tv[32];
#pragma unroll
    for (int i = 0; i < 32; ++i) { const int kk = 2 * i + (lane >> 5); tv[i] = W[(size_t)(k0 + kk) * N + n0 + (lane & 31)]; }
#pragma unroll
    for (int i = 0; i < 32; ++i) { const int kk = 2 * i + (lane >> 5); scr[kk * 33 + (lane & 31)] = tv[i]; }
    LDS_WAIT(); asm volatile("" ::: "memory");
    const int c = lane & 7;
#pragma unroll
    for (int j = 0; j < 4; ++j) { const int n = (lane >> 3) + 8 * j; const LAS float* s = scr + (8 * c) * 33 + n;
        if (wr16) { u32x4 o; o.x = cvt_pk_bf16(s[0 * 33], s[1 * 33]); o.y = cvt_pk_bf16(s[2 * 33], s[3 * 33]); o.z = cvt_pk_bf16(s[4 * 33], s[5 * 33]); o.w = cvt_pk_bf16(s[6 * 33], s[7 * 33]);
            *(GAS u32x4*)(WT + (size_t)(drow0 + n) * Kd + k0 + 8 * c) = o; }
        if (WT8) { int w0 = 0, w1 = 0; w0 = __builtin_amdgcn_cvt_pk_fp8_f32(s[0 * 33] * W8S, s[1 * 33] * W8S, w0, false); w0 = __builtin_amdgcn_cvt_pk_fp8_f32(s[2 * 33] * W8S, s[3 * 33] * W8S, w0, true);
            w1 = __builtin_amdgcn_cvt_pk_fp8_f32(s[4 * 33] * W8S, s[5 * 33] * W8S, w1, false); w1 = __builtin_amdgcn_cvt_pk_fp8_f32(s[6 * 33] * W8S, s[7 * 33] * W8S, w1, true);
            *(GAS u32x2*)(WT8 + (size_t)(drow0 + n) * Kd + k0 + 8 * c) = (u32x2){(unsigned)w0, (unsigned)w1}; } }
    LDS_WAIT(); asm volatile("" ::: "memory");
}
__device__ __forceinline__ void rms_row_to_bf16(const float* xrow, const float* g, bf16_t* orow, int lane) {
    const GAS f32x4* xr = (const GAS f32x4*)xrow + lane; const GAS f32x4* gr = (const GAS f32x4*)g + lane;
    f32x4 v[8]; float s = 0.f;
#pragma unroll
    for (int j = 0; j < 8; ++j) { v[j] = xr[64 * j]; s += (v[j].x * v[j].x + v[j].y * v[j].y) + (v[j].z * v[j].z + v[j].w * v[j].w); }
    const float rinv = 1.0f / sqrtf(wave_sum(s) * (1.f / DM) + EPS);
    GAS u32x2* o8 = (GAS u32x2*)orow + lane;
#pragma unroll
    for (int j = 0; j < 8; ++j) { const f32x4 gv = gr[64 * j]; u32x2 w; w.x = cvt_pk_bf16(v[j].x * rinv * gv.x, v[j].y * rinv * gv.y); w.y = cvt_pk_bf16(v[j].z * rinv * gv.z, v[j].w * rinv * gv.w); o8[64 * j] = w; }
}

__device__ __forceinline__ void p0_prologue(const Frame& F, const Args& a) {
    unsigned char* ws = a.ws;
    LAS float* scr = (LAS float*)(F.lds + F.wave * 16384);
    const int gw = F.vcu * NWAVES + F.wave, NGW = F.G * NWAVES;
    constexpr int I_IN = (DM / 64) * (INW / 32), I_P = (QW / 64) * (DM / 32), I_O = (DM / 64) * (DM / 32);
    constexpr int NITEMS = I_IN; (void)I_P; (void)I_O;
    for (int it = gw; it < NITEMS; it += NGW) {
        int r = it;
        if (r < I_IN) { const int nb = INW / 32, kb = r / nb, n0 = (r % nb) * 32; tr_item(a.in[2], INW, kb * 64, n0, (bf16_t*)(ws + WS_WIN), DM, n0, scr, F.lane, ws + WS_WIN8, false); continue; } r -= I_IN;
        if (r < I_P) { const int nb = DM / 32, kb = r / nb, n0 = (r % nb) * 32; tr_item(a.in[6], DM, kb * 64, n0, (bf16_t*)(ws + WS_WPA), QW, n0, scr, F.lane, ws + WS_WPA8, false); continue; } r -= I_P;
        if (r < I_P) { const int nb = DM / 32, kb = r / nb, n0 = (r % nb) * 32; tr_item(a.in[9], DM, kb * 64, n0, (bf16_t*)(ws + WS_WPB), QW, n0, scr, F.lane, ws + WS_WPB8, false); continue; } r -= I_P;
        { const int nb = DM / 32, kb = r / nb, n0 = (r % nb) * 32; tr_item(a.in[10], DM, kb * 64, n0, (bf16_t*)(ws + WS_WO), DM, n0, scr, F.lane, ws + WS_WO8, false); }
    }
    float* cosT = (float*)(ws + WS_ROPE); float* sinT = cosT + 128 * 32;
    for (int i = blockIdx.x * 512 + F.tid; i < 128 * 32; i += F.G * 512) { const int pos = i >> 5, p = i & 31;
        const float inv = 1.0f / powf(10000.0f, (float)(2 * p) / 64.0f); const float ang = (float)pos * inv; cosT[i] = cosf(ang); sinT[i] = sinf(ang); }
    { const float* X = a.in[0]; const float* gm = a.in[1]; bf16_t* H = (bf16_t*)(ws + WS_H); const int lane = F.lane;
      f32x4 na[8], nb[8];
#define H_LOAD(dst_, m_) do { const int ml_ = (m_); if (ml_ < NTOK) { const GAS f32x4* xr = (const GAS f32x4*)(X + (size_t)ml_ * DM) + lane; _Pragma("unroll") for (int j = 0; j < 8; ++j) dst_[j] = xr[64 * j]; } } while (0)
#define H_ROW(src_, m_) do { const int mm_ = (m_); f32x4 v[8]; float s = 0.f; \
          _Pragma("unroll") for (int j = 0; j < 8; ++j) { v[j] = src_[j]; s += (v[j].x * v[j].x + v[j].y * v[j].y) + (v[j].z * v[j].z + v[j].w * v[j].w); } \
          H_LOAD(src_, mm_ + 2 * NGW); \
          const float rinv = 1.0f / sqrtf(wave_sum(s) * (1.f / DM) + EPS); \
          _Pragma("unroll") for (int j = 0; j < 8; ++j) { const f32x4 gv = ((const GAS f32x4*)gm + lane)[64 * j]; const f32x4 hv = v[j] * rinv * gv; \
              int w8 = 0; w8 = __builtin_amdgcn_cvt_pk_fp8_f32(hv.x, hv.y, w8, false); w8 = __builtin_amdgcn_cvt_pk_fp8_f32(hv.z, hv.w, w8, true); ((GAS int*)(ws + WS_H8 + (size_t)mm_ * DM) + lane)[64 * j] = w8; } } while (0)
      (void)H;
      H_LOAD(na, gw); H_LOAD(nb, gw + NGW);
      for (int m = gw; m < NTOK; m += 2 * NGW) { H_ROW(na, m); if (m + NGW < NTOK) H_ROW(nb, m + NGW); }
#undef H_LOAD
#undef H_ROW
    }
}

constexpr int CW_WCTR = 8192;
__device__ __forceinline__ void p_moe_weights(const Frame& F, const Args& a, int max_claims, int claim0) {
    unsigned char* ws = a.ws; LAS float* scr = (LAS float*)(F.lds + F.wave * 16384);
    constexpr int I_GU = NEXP * (DM / 64) * (DFF / 32), I_D = NEXP * (DFF / 64) * (DM / 32), I_P = (QW / 64) * (DM / 32), I_O = (DM / 64) * (DM / 32), NPRE = 2 * I_P + I_O, NIT = NPRE + 2 * I_GU + I_D;
    unsigned* ctr = (unsigned*)(ws + WS_CTL) + CW_WCTR;
    (void)ctr;
    for (int cl = 0; cl < max_claims; ++cl) {
        const unsigned it0 = (unsigned)__builtin_amdgcn_readfirstlane((claim0 + cl * 8192) * 4);
        if (it0 >= (unsigned)NIT) break;
        for (int k4 = 0; k4 < 4; ++k4) { int r = (int)it0 + k4; if (r >= NIT) break;
            const float* W; int N, kb, n0, Kd, drow0; unsigned char* dst;
            if (r < NPRE) {
                const int nb = DM / 32; N = DM;
                if (r < I_P) { W = a.in[6]; Kd = QW; dst = ws + WS_WPA8; } else if (r < 2 * I_P) { r -= I_P; W = a.in[9]; Kd = QW; dst = ws + WS_WPB8; } else { r -= 2 * I_P; W = a.in[10]; Kd = DM; dst = ws + WS_WO8; }
                kb = r / nb; n0 = (r % nb) * 32; drow0 = n0;
            } else { r -= NPRE;
                if (r < 2 * I_GU) { const int up = r >= I_GU; if (up) r -= I_GU; constexpr int per = (DM / 64) * (DFF / 32); const int e = r / per, q = r % per, nb = DFF / 32; kb = q / nb; n0 = (q % nb) * 32;
                    W = a.in[up ? 14 : 13] + (size_t)e * DM * DFF; N = DFF; Kd = DM; drow0 = (n0 >> 7) * 256 + (n0 & 127) + (up ? 128 : 0); dst = ws + WS_WGU + (size_t)e * 2048 * DM; }
                else { r -= 2 * I_GU; constexpr int per = (DFF / 64) * (DM / 32); const int e = r / per, q = r % per, nb = DM / 32; kb = q / nb; n0 = (q % nb) * 32;
                    W = a.in[15] + (size_t)e * DFF * DM; N = DM; Kd = DFF; drow0 = n0; dst = ws + WS_WD8 + (size_t)e * 2048 * DFF; } }
            tr_item(W, N, kb * 64, n0, (bf16_t*)nullptr, Kd, drow0, scr, F.lane, dst, false); }
    }
}

__device__ __forceinline__ void prep_vecs(const Frame& F, bf16_t* T, int ld, int nh_log2, const float* gain, const float* cosT, const float* sinT, float oscale, unsigned char* out8, float cvscale) {
    const int gw = F.vcu * NWAVES + F.wave, NGW = F.G * NWAVES;
    const int sub = F.lane & 15, half = sub >> 3, q = sub & 7;
    const int nvec = NTOK << nh_log2;
    const f32x4 g1 = *(const f32x4*)(gain + half * 64 + 4 * q), g2 = *(const f32x4*)(gain + half * 64 + 32 + 4 * q);
    for (int it = gw; it < nvec / 16; it += NGW) {
        bf16_t* base[4]; u32x2 w1[4], w2[4]; int posx[4];
#pragma unroll
        for (int u = 0; u < 4; ++u) { const int vec = it * 16 + u * 4 + (F.lane >> 4);
            const int tok = vec >> nh_log2, hd = vec & ((1 << nh_log2) - 1), pos = tok & (SEQ - 1); posx[u] = half ? (pos & 63) : (pos >> 6);
            base[u] = T + (size_t)tok * ld + hd * HD + half * 64 + 4 * q; w1[u] = *(const u32x2*)base[u]; w2[u] = *(const u32x2*)(base[u] + 32); }
#pragma unroll
        for (int u = 0; u < 4; ++u) {
            float x1[4] = {bf2f(w1[u].x & 0xffff), bf2f(w1[u].x >> 16), bf2f(w1[u].y & 0xffff), bf2f(w1[u].y >> 16)}, x2[4] = {bf2f(w2[u].x & 0xffff), bf2f(w2[u].x >> 16), bf2f(w2[u].y & 0xffff), bf2f(w2[u].y >> 16)};
            float ss = 0.f;
#pragma unroll
            for (int j = 0; j < 4; ++j) ss += x1[j] * x1[j] + x2[j] * x2[j];
            ss += __shfl_xor(ss, 1); ss += __shfl_xor(ss, 2); ss += __shfl_xor(ss, 4); ss += __shfl_xor(ss, 8);
            const float rinv = 1.0f / sqrtf(ss * (1.0f / 128.0f) + EPS);
            const f32x4 cs = *(const f32x4*)(cosT + posx[u] * 32 + 4 * q), sn = *(const f32x4*)(sinT + posx[u] * 32 + 4 * q);
            float y1[4], y2[4];
#pragma unroll
            for (int j = 0; j < 4; ++j) { const float a1 = x1[j] * rinv * g1[j], a2 = x2[j] * rinv * g2[j]; y1[j] = (a1 * cs[j] - a2 * sn[j]) * oscale; y2[j] = (a2 * cs[j] + a1 * sn[j]) * oscale; }
            if (out8) {
                LAS unsigned char* pt = F.lds + F.wave * 4096 + (u * 4 + (F.lane >> 4)) * 256 + (half * 64 + 4 * q) * 2;
                *(LAS u32x2*)pt = (u32x2){cvt_pk_bf16(y1[0], y1[1]), cvt_pk_bf16(y1[2], y1[3])}; *(LAS u32x2*)(pt + 64) = (u32x2){cvt_pk_bf16(y2[0], y2[1]), cvt_pk_bf16(y2[2], y2[3])};
            } else {
            u32x2 o1, o2; o1.x = cvt_pk_bf16(y1[0], y1[1]); o1.y = cvt_pk_bf16(y1[2], y1[3]); o2.x = cvt_pk_bf16(y2[0], y2[1]); o2.y = cvt_pk_bf16(y2[2], y2[3]);
            *(u32x2*)base[u] = o1; *(u32x2*)(base[u] + 32) = o2; } }
        if (out8) {
            asm volatile("s_waitcnt lgkmcnt(0)" ::: "memory");
            const int vl = F.lane >> 2, g = F.lane & 3, vec = it * 16 + vl, tok = vec >> nh_log2, hd = vec & ((1 << nh_log2) - 1);
            const LAS unsigned char* pr = F.lds + F.wave * 4096 + vl * 256 + g * 64;
            union { u32x4 w[4]; v32bf_t v; } cv; cv.w[0] = *(const LAS u32x4*)pr; cv.w[1] = *(const LAS u32x4*)(pr + 16); cv.w[2] = *(const LAS u32x4*)(pr + 32); cv.w[3] = *(const LAS u32x4*)(pr + 48);
            const v6u_t p6 = __builtin_amdgcn_cvt_scalef32_pk32_fp6_bf16(cv.v, cvscale);
            unsigned char* o6 = out8 + ((size_t)(((tok >> 13) << nh_log2) + hd) * SEQ + (tok & (SEQ - 1))) * HD + 32 * g;
            *(u32x4*)o6 = (u32x4){p6[0], p6[1], p6[2], p6[3]}; *(u32x4*)(o6 + 16) = (u32x4){p6[4], p6[5], 0u, 0u};
            asm volatile("s_waitcnt lgkmcnt(0)" ::: "memory"); }
    }
}
__device__ __forceinline__ void p2_qkprep(const Frame& F, const Args& a) {
    const float* cosT = (const float*)(a.ws + WS_ROPE); const float* sinT = cosT + 128 * 32;
    float mk = fmaxf(fabsf(a.in[5][F.lane]), fabsf(a.in[5][64 + F.lane]));
#pragma unroll
    for (int of = 1; of < 64; of <<= 1) mk = fmaxf(mk, __shfl_xor(mk, of));
    const float kexp = floorf(__builtin_amdgcn_logf(1.5f / mk));
    prep_vecs(F, (bf16_t*)(a.ws + WS_KA), KVW, 1, a.in[5], cosT, sinT, 1.0f, a.ws + WS_K8, __builtin_amdgcn_exp2f(-kexp));
    __syncthreads();
    { const bf16_t* VA = (const bf16_t*)(a.ws + WS_VA); unsigned char* V8T = a.ws + WS_V8T; LAS bf16_t* tl = (LAS bf16_t*)F.lds; constexpr int TP = 132;
      for (int T = F.vcu; T < BATCH * 2 * 64; T += F.G) { const int bk = T >> 6, t = T & 63, b = bk >> 1, kvh = bk & 1;
        { const int r = F.tid >> 2, qd = F.tid & 3; const bf16_t* src = VA + ((size_t)b * SEQ + 128 * t + r) * KVW + kvh * HD + qd * 32;
#pragma unroll
          for (int i = 0; i < 4; ++i) { const u32x4 v = *(const u32x4*)(src + 8 * i); LAS unsigned* d = (LAS unsigned*)(tl + r * TP + qd * 32 + 8 * i); d[0] = v.x; d[1] = v.y; d[2] = v.z; d[3] = v.w; } }
        __syncthreads();
        { const int d = F.tid >> 2, g = F.tid & 3; int w[8];
#pragma unroll
          for (int kb = 0; kb < 8; ++kb) { float x[4];
#pragma unroll
            for (int r = 0; r < 4; ++r) x[r] = bf2f(tl[(16 * kb + 4 * g + r) * TP + d]);
            int ww = 0; ww = __builtin_amdgcn_cvt_pk_fp8_f32(x[0], x[1], ww, false); ww = __builtin_amdgcn_cvt_pk_fp8_f32(x[2], x[3], ww, true); w[kb] = ww; }
          unsigned char* dst = V8T + ((size_t)T * HD + d) * 128 + 32 * g;
          *(u32x4*)dst = (u32x4){(unsigned)w[0], (unsigned)w[1], (unsigned)w[2], (unsigned)w[3]}; *(u32x4*)(dst + 16) = (u32x4){(unsigned)w[4], (unsigned)w[5], (unsigned)w[6], (unsigned)w[7]}; }
        __syncthreads(); } }
}

template <int MODE> __device__ __forceinline__ void p3_attention(const Frame& F, const Args& a, char* lds) {
    unsigned char* ws = a.ws;
    const bf16_t* Q = (const bf16_t*)(ws + (MODE == 0 ? WS_QA : WS_QB)); const bf16_t* K = (const bf16_t*)(ws + (MODE == 0 ? WS_KA : WS_KB)); const bf16_t* V = (const bf16_t*)(ws + (MODE == 0 ? WS_VA : WS_VB));
    att::Aux aux; aux.cosT = (const float*)(ws + WS_ROPE); aux.sinT = aux.cosT + 128 * 32; aux.qn = a.in[4]; aux.kn = a.in[5]; aux.relb = a.in[8]; aux.sink = a.in[7];
#define BUILD_TABS(kvh_) do { float* tabs_ = (float*)(lds + att::OFF_TAB); for (int i_ = F.tid; i_ < 4 * 768; i_ += 512) { const int hh_ = i_ / 768, ii_ = i_ - hh_ * 768, rel_ = ii_ - 383, n_ = rel_ < 0 ? -rel_ : rel_; float v_ = -1e30f; \
        if (n_ <= 128) v_ = aux.relb[att::t5_bucket(rel_) * NHB + (kvh_) * 4 + hh_] * LOG2E; tabs_[i_] = v_; } } while (0)
    float pscale = 1.f, qcv = 1.f; int sa6 = 0x7f7f7f7f, sb6 = 0x7f7f7f7f;
    if (MODE == 0) { float mq = fmaxf(fabsf(aux.qn[F.lane]), fabsf(aux.qn[64 + F.lane])), mk = fmaxf(fabsf(aux.kn[F.lane]), fabsf(aux.kn[64 + F.lane]));
#pragma unroll
        for (int of = 1; of < 64; of <<= 1) { mq = fmaxf(mq, __shfl_xor(mq, of)); mk = fmaxf(mk, __shfl_xor(mk, of)); }
        const float bound = att::C * 128.0f * mq * mk * 1.13f + 0.5f; pscale = -fmaxf(ceilf(bound) - 15.f, 0.f);
        const float kexp = floorf(__builtin_amdgcn_logf(1.5f / mk)), qexp = floorf(__builtin_amdgcn_logf(1.5f / (mq * att::C)));
        qcv = __builtin_amdgcn_exp2f(-qexp); sa6 = (127 - (int)kexp) * 0x01010101; sb6 = (127 - (int)qexp) * 0x01010101;
        qcv = __uint_as_float(__builtin_amdgcn_readfirstlane(__float_as_uint(qcv))); sa6 = __builtin_amdgcn_readfirstlane(sa6); sb6 = __builtin_amdgcn_readfirstlane(sb6);
        pscale = __uint_as_float(__builtin_amdgcn_readfirstlane(__float_as_uint(pscale))); }
    const bool shared_tabs = (F.G == 256);
    if (MODE == 1 && shared_tabs) { BUILD_TABS((F.vcu >> 5) & 1); __syncthreads(); }
    for (int i = 0;; ++i) {
        const int L = i * F.G + F.vcu; if (L >= 1024) break;
        const int x = (L & 255) >> 5, b = x >> 1, kvh = x & 1;
        const int qb = (MODE == 0) ? (L & 31) : ((L >> 8) * 32 + (L & 31));
        const int head = (MODE == 0) ? kvh * 4 + (L >> 8) : kvh * 4, q0 = qb * ((MODE == 0) ? 256 : 64);
        const bf16_t* Qb = Q + ((size_t)b * SEQ + q0) * QW + head * HD;
        const bf16_t* Kh = K + (size_t)b * SEQ * KVW + kvh * HD; const bf16_t* Vh = V + (size_t)b * SEQ * KVW + kvh * HD;
        int kbeg = 0, kend = SEQ;
        if (MODE == 1) { kbeg = q0 - 128 < 0 ? 0 : q0 - 128; kend = q0 + 192 > SEQ ? SEQ : q0 + 192; }
        if (MODE == 1 && !shared_tabs) { __syncthreads(); BUILD_TABS(kvh); __syncthreads(); }
        unsigned char* Ob8 = ws + (MODE == 0 ? WS_OA8 : WS_OB8) + ((size_t)b * SEQ + q0) * QW + head * HD;
        const bool conv_first = ((F.vcu + i) & 1) == 0;
        if (MODE == 1 && conv_first) { __syncthreads(); p_moe_weights(F, a, MOE_CLAIMS_PER_SLOT, L * NWAVES + F.wave); __syncthreads(); }
        if constexpr (MODE == 0) att::attn_unit8(Qb, a.ws + WS_K8 + (size_t)(b * 2 + kvh) * SEQ * HD, a.ws + WS_V8T + (size_t)(b * 2 + kvh) * 64 * 16384, Ob8, q0, lds, aux, pscale, qcv, sa6, sb6);
        else att::attn_unit_pp<MODE>(Qb, Kh, Vh, Ob8, kbeg, kend, q0, head, lds, aux);
        if (MODE == 1 && !conv_first) { __syncthreads(); p_moe_weights(F, a, MOE_CLAIMS_PER_SLOT, L * NWAVES + F.wave); __syncthreads(); }
    }
#undef BUILD_TABS
}

__device__ __forceinline__ void p7_router(const Frame& F, const Args& a) {
    LAS float* wl = (LAS float*)F.lds;
    const float* wr = a.in[12];
    for (int i = F.tid; i < DM * NEXP / 4; i += 512) { const f32x4 v = *(const f32x4*)(wr + 4 * i); const int k = i >> 2, e0 = (i & 3) * 4;
        wl[(e0 + 0) * DM + k] = v.x; wl[(e0 + 1) * DM + k] = v.y; wl[(e0 + 2) * DM + k] = v.z; wl[(e0 + 3) * DM + k] = v.w; }
    __syncthreads();
    const float* X = a.in[0]; const unsigned char* ATT = a.ws + WS_ATT; bf16_t* H2 = (bf16_t*)(a.ws + WS_H); float* AFF = (float*)(a.ws + WS_AFF); const float* g = a.in[11];
    const int gw = F.vcu * NWAVES + F.wave, NGW = F.G * NWAVES, lane = F.lane;
    f32x4 nx[2][8]; unsigned na[2][8];
#define RT_LOAD(rp_) do { _Pragma("unroll") for (int rr = 0; rr < 2; ++rr) { const size_t row_ = (size_t)(2 * (rp_) + rr); const GAS f32x4* xr = (const GAS f32x4*)(X + row_ * DM) + lane; const GAS unsigned* ar = (const GAS unsigned*)(ATT + row_ * DM) + lane; \
        _Pragma("unroll") for (int j = 0; j < 8; ++j) { nx[rr][j] = xr[64 * j]; if (DBG_LEVEL >= 3) na[rr][j] = ar[64 * j]; else na[rr][j] = 0u; } } } while (0)
    int rp = gw;
    if (rp < NTOK / 2) RT_LOAD(rp);
    for (; rp < NTOK / 2; rp += NGW) {
        f32x4 h[2][8]; float rinv[2];
#pragma unroll
        for (int rr = 0; rr < 2; ++rr) { float s = 0.f;
#pragma unroll
            for (int j = 0; j < 8; ++j) { f32x4 v = nx[rr][j]; const int w = (int)na[rr][j]; const auto a01 = __builtin_amdgcn_cvt_pk_f32_fp8(w, false), a23 = __builtin_amdgcn_cvt_pk_f32_fp8(w, true);
                v.x += a01[0] * (1.0f / ATT8S); v.y += a01[1] * (1.0f / ATT8S); v.z += a23[0] * (1.0f / ATT8S); v.w += a23[1] * (1.0f / ATT8S);
                h[rr][j] = v; s += (v.x * v.x + v.y * v.y) + (v.z * v.z + v.w * v.w); }
            rinv[rr] = s; }
#if DBG_LEVEL >= 3
#pragma unroll
        for (int rr = 0; rr < 2; ++rr) { GAS u32x2* x8 = (GAS u32x2*)((bf16_t*)(a.ws + WS_X1B) + (size_t)(2 * rp + rr) * DM) + lane;
#pragma unroll
            for (int j = 0; j < 8; ++j) { u32x2 w; w.x = cvt_pk_bf16(h[rr][j].x, h[rr][j].y); w.y = cvt_pk_bf16(h[rr][j].z, h[rr][j].w); x8[64 * j] = w; } }
#endif
        { const int nrp = rp + NGW; if (nrp < NTOK / 2) RT_LOAD(nrp); }
#pragma unroll
        for (int rr = 0; rr < 2; ++rr) { rinv[rr] = 1.0f / sqrtf(wave_sum(rinv[rr]) * (1.f / DM) + EPS);
            GAS int* o8 = (GAS int*)((unsigned char*)H2 + (size_t)(2 * rp + rr) * DM) + lane;
#pragma unroll
            for (int j = 0; j < 8; ++j) { const f32x4 gv = ((const GAS f32x4*)g + lane)[64 * j]; h[rr][j] = h[rr][j] * rinv[rr] * gv;
                int w = 0; w = __builtin_amdgcn_cvt_pk_fp8_f32(h[rr][j].x, h[rr][j].y, w, false); w = __builtin_amdgcn_cvt_pk_fp8_f32(h[rr][j].z, h[rr][j].w, w, true); o8[64 * j] = w; } }
        float v[32];
#pragma unroll
        for (int e = 0; e < NEXP; ++e) { float s0 = 0.f, s1 = 0.f;
#pragma unroll
            for (int j = 0; j < 8; ++j) { const f32x4 w = *(const LAS f32x4*)(wl + e * DM + 4 * lane + 256 * j);
                s0 += (h[0][j].x * w.x + h[0][j].y * w.y) + (h[0][j].z * w.z + h[0][j].w * w.w); s1 += (h[1][j].x * w.x + h[1][j].y * w.y) + (h[1][j].z * w.z + h[1][j].w * w.w); }
            v[e] = s0; v[16 + e] = s1; }
#pragma unroll
        for (int off = 16; off >= 1; off >>= 1) { const bool up = (lane & off) != 0;
#pragma unroll
            for (int i = 0; i < off; ++i) { const float lo = v[i], hi = v[i + off]; const float keep = up ? hi : lo, send = up ? lo : hi; v[i] = keep + __shfl_xor(send, off); } }
        const float mine = v[0] + __shfl_xor(v[0], 32);
        float mx = mine; mx = fmaxf(mx, __shfl_xor(mx, 1)); mx = fmaxf(mx, __shfl_xor(mx, 2)); mx = fmaxf(mx, __shfl_xor(mx, 4)); mx = fmaxf(mx, __shfl_xor(mx, 8));
        const float ex = expf(mine - mx); float sm = ex; sm += __shfl_xor(sm, 1); sm += __shfl_xor(sm, 2); sm += __shfl_xor(sm, 4); sm += __shfl_xor(sm, 8);
        if (lane < 32) { const int row = 2 * rp + (lane >> 4), e = lane & 15, b = row >> 13, s = row & (SEQ - 1); AFF[((size_t)(b * NEXP + e)) * SEQ + s] = ex / sm; }
    }
#undef RT_LOAD
    __syncthreads();
}

__device__ __forceinline__ int block_excl_scan(int v, LAS int* sc, int tid, int& total) {
    const int lane = tid & 63, w = tid >> 6; int x = v;
#pragma unroll
    for (int o = 1; o < 64; o <<= 1) { const int y = __shfl_up(x, o); if (lane >= o) x += y; }
    __syncthreads();
    if (lane == 63) sc[w] = x;
    __syncthreads();
    int pre = 0, tot = 0;
#pragma unroll
    for (int j = 0; j < 8; ++j) { const int s = sc[j]; if (j < w) pre += s; tot += s; }
    total = tot; return pre + x - v;
}
__device__ __forceinline__ void p8_topk(const Frame& F, const Args& a) {
    const float* AFF = (const float*)(a.ws + WS_AFF); int* IDX = (int*)(a.ws + WS_IDX); float* GATEV = (float*)(a.ws + WS_GATEV); int* INV = (int*)(a.ws + WS_INV);
    LAS int* hist = (LAS int*)F.lds; LAS int* sc = hist + 256; LAS int* res = sc + 16;
    const int tid = F.tid, lane = F.lane;
    const bool spread = (F.G == 256);
    for (int list = spread ? ((F.vcu & 3) == 0 ? (F.vcu >> 2) : NLIST) : F.vcu; list < NLIST; list += (spread ? NLIST : F.G)) {
        const int b = list / NEXP, e = list % NEXP;
        unsigned key[16];
        { const u32x4* src = (const u32x4*)(AFF + (size_t)list * SEQ + tid * 16);
#pragma unroll
            for (int j = 0; j < 4; ++j) { const u32x4 v = src[j]; key[4 * j] = v.x; key[4 * j + 1] = v.y; key[4 * j + 2] = v.z; key[4 * j + 3] = v.w; } }
        unsigned prefix = 0u, pmask = 0u; int krem = CAP;
#pragma unroll 1
        for (int pass = 0; pass < 4; ++pass) { const int shift = 24 - 8 * pass;
            __syncthreads();
            if (tid < 256) hist[tid] = 0;
            __syncthreads();
#pragma unroll
            for (int j = 0; j < 16; ++j) if ((key[j] & pmask) == prefix) __hip_atomic_fetch_add(&hist[(key[j] >> shift) & 255u], 1, __ATOMIC_RELAXED, __HIP_MEMORY_SCOPE_WORKGROUP);
            __syncthreads();
            if (tid < 64) {
                int c[4]; int s = 0;
#pragma unroll
                for (int j = 0; j < 4; ++j) { c[j] = hist[4 * lane + j]; s += c[j]; }
                int suf = s;
#pragma unroll
                for (int o = 1; o < 64; o <<= 1) { const int y = __shfl_down(suf, o); if (lane + o < 64) suf += y; }
                const int excl = suf - s;
                if (suf >= krem && excl < krem) { int cum = excl, bin = 4 * lane, kn = krem;
#pragma unroll
                    for (int j = 3; j >= 0; --j) { if (cum < krem && cum + c[j] >= krem) { bin = 4 * lane + j; kn = krem - cum; } cum += c[j]; }
                    res[0] = bin; res[1] = kn; }
            }
            __syncthreads();
            const int bin = res[0]; krem = res[1];
            prefix |= ((unsigned)bin) << shift; pmask |= 255u << shift;
        }
        const unsigned T = prefix;
        int ceq = 0;
#pragma unroll
        for (int j = 0; j < 16; ++j) ceq += (key[j] == T) ? 1 : 0;
        int toteq; const int eqb = block_excl_scan(ceq, sc, tid, toteq);
        int csel = 0, er = eqb; unsigned selmask = 0u;
#pragma unroll
        for (int j = 0; j < 16; ++j) { bool s = key[j] > T; if (key[j] == T) { s = er < krem; ++er; } if (s) { selmask |= 1u << j; ++csel; } }
        int totsel; int pos = block_excl_scan(csel, sc, tid, totsel);
#pragma unroll
        for (int j = 0; j < 16; ++j) { const int tokpos = tid * 16 + j; int slot = -1;
            if (selmask & (1u << j)) { slot = list * CAP + pos; IDX[slot] = tokpos; GATEV[slot] = __uint_as_float(key[j]); ++pos; }
            INV[((size_t)b * SEQ + tokpos) * NEXP + e] = slot; }
        __syncthreads();
    }
}

__device__ __forceinline__ void p11_final(const Frame& F, const Args& a, bool with_moe) {
    const float* X = a.in[0]; float* OUT = a.out; const bf16_t* ATT = (const bf16_t*)(a.ws + WS_X1B); const bf16_t* Y = (const bf16_t*)(a.ws + WS_Y); const int* INV = (const int*)(a.ws + WS_INV); const float* g = a.in[16];
    const int gw = F.vcu * NWAVES + F.wave, NGW = F.G * NWAVES, lane = F.lane;
    f32x4 nx[8]; u32x2 na[8]; int ninv = -1;
#define FN_LOAD(m_) do { const GAS f32x4* xr = (const GAS f32x4*)(X + (size_t)(m_) * DM) + lane; const GAS u32x2* ar = (const GAS u32x2*)(ATT + (size_t)(m_) * DM) + lane; \
        _Pragma("unroll") for (int j = 0; j < 8; ++j) { if (DBG_LEVEL >= 3) na[j] = ar[64 * j]; else nx[j] = xr[64 * j]; } \
        ninv = (with_moe && lane < NEXP) ? INV[(size_t)(m_) * NEXP + lane] : -1; } while (0)
    int m = gw;
    if (m < NTOK) FN_LOAD(m);
    for (; m < NTOK; m += NGW) {
        f32x4 v[8]; const int myinv = ninv;
#pragma unroll
        for (int j = 0; j < 8; ++j) { if (DBG_LEVEL >= 3) { const u32x2 w = na[j]; v[j].x = __uint_as_float(w.x << 16); v[j].y = __uint_as_float(w.x & 0xffff0000u); v[j].z = __uint_as_float(w.y << 16); v[j].w = __uint_as_float(w.y & 0xffff0000u); } else v[j] = nx[j]; }
        unsigned long long mask = __ballot(myinv >= 0);
        u32x2 y0[8], y1[8], y2[8]; const bool has0 = mask != 0ull; bool has1 = false, has2 = false;
        if (has0) { const int e = __builtin_ctzll(mask); mask &= mask - 1; const int slot = __builtin_amdgcn_readlane(myinv, e); const GAS u32x2* yr = (const GAS u32x2*)(Y + (size_t)slot * DM) + lane;
#pragma unroll
            for (int j = 0; j < 8; ++j) y0[j] = yr[64 * j];
            has1 = mask != 0ull;
            if (has1) { const int e1 = __builtin_ctzll(mask); mask &= mask - 1; const int slot1 = __builtin_amdgcn_readlane(myinv, e1); const GAS u32x2* yr1 = (const GAS u32x2*)(Y + (size_t)slot1 * DM) + lane;
#pragma unroll
                for (int j = 0; j < 8; ++j) y1[j] = yr1[64 * j];
                has2 = mask != 0ull;
                if (has2) { const int e2 = __builtin_ctzll(mask); mask &= mask - 1; const int slot2 = __builtin_amdgcn_readlane(myinv, e2); const GAS u32x2* yr2 = (const GAS u32x2*)(Y + (size_t)slot2 * DM) + lane;
#pragma unroll
                    for (int j = 0; j < 8; ++j) y2[j] = yr2[64 * j]; } } }
        { const int nm = m + NGW; if (nm < NTOK) FN_LOAD(nm); }
#define ACC_Y(yy_) do { _Pragma("unroll") for (int j = 0; j < 8; ++j) { const u32x2 w = yy_[j]; v[j].x += __uint_as_float(w.x << 16); v[j].y += __uint_as_float(w.x & 0xffff0000u); v[j].z += __uint_as_float(w.y << 16); v[j].w += __uint_as_float(w.y & 0xffff0000u); } } while (0)
        if (has0) ACC_Y(y0);
        if (has1) ACC_Y(y1);
        if (has2) ACC_Y(y2);
#undef ACC_Y
        while (mask) { const int e = __builtin_ctzll(mask); mask &= mask - 1; const int slot = __builtin_amdgcn_readlane(myinv, e);
            const GAS u32x2* yr = (const GAS u32x2*)(Y + (size_t)slot * DM) + lane;
#pragma unroll
            for (int j = 0; j < 8; ++j) { const u32x2 w = yr[64 * j]; v[j].x += __uint_as_float(w.x << 16); v[j].y += __uint_as_float(w.x & 0xffff0000u); v[j].z += __uint_as_float(w.y << 16); v[j].w += __uint_as_float(w.y & 0xffff0000u); } }
        float s = 0.f;
#pragma unroll
        for (int j = 0; j < 8; ++j) s += (v[j].x * v[j].x + v[j].y * v[j].y) + (v[j].z * v[j].z + v[j].w * v[j].w);
        const float rinv = 1.0f / sqrtf(wave_sum(s) * (1.f / DM) + EPS);
        GAS f32x4* orow = (GAS f32x4*)(OUT + (size_t)m * DM) + lane;
#pragma unroll
        for (int j = 0; j < 8; ++j) { const f32x4 gv = ((const GAS f32x4*)g + lane)[64 * j]; orow[64 * j] = v[j] * rinv * gv; }
    }
#undef FN_LOAD
}
__device__ __forceinline__ void p_copy_x(const Frame& F, const Args& a) {
    const f32x4* src = (const f32x4*)a.in[0]; f32x4* dst = (f32x4*)a.out;
    for (size_t i = (size_t)blockIdx.x * 512 + F.tid; i < (size_t)NTOK * DM / 4; i += (size_t)F.G * 512) dst[i] = src[i];
}

constexpr int NPHASE = 10;
__global__ void __launch_bounds__(NWAVES * 64, 2) fwd_kernel(Args args) {
    extern __shared__ __attribute__((aligned(16))) unsigned char lds[];
    Frame F;
    F.lds = (LAS unsigned char*)lds;
    F.tid = threadIdx.x; F.lane = F.tid & 63; F.wave = __builtin_amdgcn_readfirstlane(F.tid >> 6);
    F.G = gridDim.x; { const int bx = blockIdx.x; F.vcu = (F.G % 8 == 0) ? (bx % 8) * (F.G / 8) + bx / 8 : bx; }
    unsigned char* ws = args.ws;
    gu32* ctl = (gu32*)(ws + WS_CTL);
    for (int u = F.tid; u < (LDS_BYTES - LDSCTL_OFF) / 4; u += NWAVES * 64) ((LAS unsigned*)(F.lds + LDSCTL_OFF))[u] = 0u;
    __syncthreads();
    XcdBarrier bar; bar.bar = (unsigned*)(ctl + CW_BAR); bar.x = 0; bar.st = nullptr;
    if (MK_N_LAUNCHES == 1) bar = xcd_barrier_post((unsigned*)(ctl + CW_BAR), (volatile LAS unsigned*)(F.lds + LDSCTL_OFF + 64));
    const int lo = args.ph_lo, hi = args.ph_hi;
#define IN(k) (lo <= (k) && (k) < hi)
#define SEAM(k) do { if (IN(k) && IN((k) + 1)) xcd_barrier(bar); } while (0)
#define REFRAME() do { int t_ = threadIdx.x; asm volatile("" : "+v"(t_)); F.tid = t_; F.lane = t_ & 63; F.wave = __builtin_amdgcn_readfirstlane(t_ >> 6); } while (0)

    if (IN(0)) { REFRAME(); for (int rep = 0; rep < REPS(0); ++rep) p0_prologue(F, args); }
    SEAM(0);
    if (IN(1)) { REFRAME();
#if DBG_LEVEL >= 3
        { pg8::MapProb<DM, 0, 1> P; P.A = ws + WS_H8; P.Bt = ws + WS_WIN8; P.S.init(NTOK, INW, F.G, (int)blockIdx.x);
          pg8::EpiInProj E{(bf16_t*)(ws + WS_QA), (bf16_t*)(ws + WS_KA), (bf16_t*)(ws + WS_VA), (bf16_t*)(ws + WS_QB), (bf16_t*)(ws + WS_KB), (bf16_t*)(ws + WS_VB), (bf16_t*)(ws + WS_GA), (bf16_t*)(ws + WS_GB), args.in[3], 1.0f / W8S};
          pg8::gemm_phase8<pg8::EpiInProj, pg8::MapProb<DM, 0, 1>, true>(F.lds, P, E); }
#endif
    }
    SEAM(1);
    if (IN(2)) { REFRAME();
#if DBG_LEVEL >= 4
        p2_qkprep(F, args);
#endif
    }
    SEAM(2);
    if (IN(3)) { REFRAME();
#if DBG_LEVEL >= 4
        for (int rep = 0; rep < REPS(3); ++rep) p3_attention<0>(F, args, (char*)lds);
#endif
#if DBG_LEVEL >= 3
        __syncthreads();
        for (int rep = 0; rep < REPS(13); ++rep) p3_attention<1>(F, args, (char*)lds);
        __syncthreads();
#endif
    }
    SEAM(3);
    if (IN(4)) { REFRAME();
#if DBG_LEVEL >= 4
        { pg8::MapProb<QW, 0, 1> P; P.A = ws + WS_OA8; P.Bt = ws + WS_WPA8; P.S.init(NTOK, DM, F.G, (int)blockIdx.x);
          pg8::EpiGated8<0> E{ws + WS_GA8, nullptr, ws + WS_M18, 1.0f / (OA8S * W8S)};
          pg8::gemm_phase8<pg8::EpiGated8<0>, pg8::MapProb<QW, 0, 1>, true>(F.lds, P, E); }
        { int gg_ = F.G; asm volatile("" : "+s"(gg_)); unsigned char* ws2_ = ws; asm volatile("" : "+s"(ws2_));
          pg8::MapProb<QW, 0, 1> P; P.A = ws2_ + WS_OB8; P.Bt = ws2_ + WS_WPB8; P.S.init(NTOK, DM, gg_, (int)blockIdx.x);
          pg8::EpiGated8<1> E{ws2_ + WS_GB8, ws2_ + WS_M18, ws2_ + WS_M8, 1.0f / (OB8S * W8S)};
          pg8::gemm_phase8<pg8::EpiGated8<1>, pg8::MapProb<QW, 0, 1>, true>(F.lds, P, E); }
#endif
    }
    SEAM(4);
    if (IN(5)) { REFRAME();
#if DBG_LEVEL >= 3
        pg8::MapProb<DM, 0, 1> P; P.A = ws + WS_M8; P.Bt = ws + WS_WO8; P.S.init(NTOK, DM, F.G, (int)blockIdx.x);
        pg8::EpiAtt E{ws + WS_ATT, ATT8S / (M8S * W8S)};
        for (int rep = 0; rep < REPS(5); ++rep) pg8::gemm_phase8<pg8::EpiAtt, pg8::MapProb<DM, 0, 1>, true>(F.lds, P, E);
#endif
    }
    SEAM(5);
    if (IN(6)) { REFRAME();
#if DBG_LEVEL >= 2
        for (int rep = 0; rep < REPS(6); ++rep) p7_router(F, args);
#endif
    }
    SEAM(6);
    if (IN(7)) { REFRAME();
#if DBG_LEVEL >= 2
        for (int rep = 0; rep < REPS(7); ++rep) p8_topk(F, args);
        static_assert(MOE_CLAIMS_PER_SLOT * 4 * 8 * 1024 >= 53248, "the window-attention slots (1024 units x 8 waves x claims x 4 items) must drain every conversion item");
#endif
    }
    SEAM(7);
    if (IN(8)) { REFRAME();
#if DBG_LEVEL >= 2
        LAS unsigned* rowoff = (LAS unsigned*)(F.lds + pg8::STAGE_BYTES);
        const int* IDX = (const int*)(ws + WS_IDX);
        for (int i = 0; i < 8; ++i) { pg8::Unit u; int e, b; if (!pg8::moe_unit(i, F.G, F.vcu, u, e, b)) break;
            if (F.tid < 256) rowoff[i * 256 + F.tid] = (unsigned)IDX[u.pm * 256 + F.tid] * (unsigned)DM; }
        __syncthreads();
        pg8::GuProb8 P; P.H2 = ws + WS_H; P.W = ws + WS_WGU; P.rowoff = rowoff; P.G = F.G; P.vcu = F.vcu;
        pg8::EpiSwiglu E{ws + WS_GA, 1.0f / W8S};
        for (int rep = 0; rep < REPS(8); ++rep) pg8::gemm_phase8<pg8::EpiSwiglu, pg8::GuProb8, true>(F.lds, P, E);
#endif
    }
    SEAM(8);
    if (IN(9)) { REFRAME();
#if DBG_LEVEL >= 2
        pg8::DownProb8 P; P.HID = ws + WS_GA; P.W = ws + WS_WD8; P.G = F.G; P.vcu = F.vcu;
        pg8::EpiDown E{(bf16_t*)(ws + WS_Y), (const float*)(ws + WS_GATEV), 1.0f / W8S};
        for (int rep = 0; rep < REPS(9); ++rep) pg8::gemm_phase8<pg8::EpiDown, pg8::DownProb8, true>(F.lds, P, E);
#endif
    }
    SEAM(9);
    if (IN(10)) { REFRAME(); p11_final(F, args, DBG_LEVEL >= 2); }
#undef IN
#undef SEAM
}

extern "C" void kernel_launch(void* const* d_in, const int* in_sizes, int n_in, void* d_out, int out_size, void* d_ws, size_t ws_size, hipStream_t stream) {
    static int grid = 0;
    if (grid == 0) {
        if (n_in != 17 || in_sizes[0] != NTOK * DM || out_size != NTOK * DM || ws_size < WS_END) { fprintf(stderr, "kernel_launch: unexpected shapes (n_in %d, in0 %d, out %d, ws %zu); nothing launched\n", n_in, n_in > 0 ? in_sizes[0] : -1, out_size, ws_size); grid = -1; return; }
        int dev = 0, cus = 0, per_cu = 0;
        if (hipGetDevice(&dev) != hipSuccess || hipDeviceGetAttribute(&cus, hipDeviceAttributeMultiprocessorCount, dev) != hipSuccess) { grid = -1; return; }
        if (hipFuncSetAttribute((const void*)fwd_kernel, hipFuncAttributeMaxDynamicSharedMemorySize, LDS_BYTES) != hipSuccess) { fprintf(stderr, "kernel_launch: hipFuncSetAttribute failed\n"); grid = -1; return; }
        if (hipOccupancyMaxActiveBlocksPerMultiprocessor(&per_cu, (const void*)fwd_kernel, NWAVES * 64, LDS_BYTES) != hipSuccess || per_cu < 1)
            fprintf(stderr, "kernel_launch: note: occupancy query reports %d workgroups per CU\n", per_cu);
        (void)hipGetLastError();
        grid = cus;
    }
    if (grid < 0) return;
    (void)hipMemsetAsync((char*)d_ws + WS_CTL, 0, CTL_ZERO_BYTES, stream);
    Args a{};
    for (int i = 0; i < 17; ++i) a.in[i] = (const float*)d_in[i];
    a.out = (float*)d_out; a.ws = (unsigned char*)d_ws;
#if MK_N_LAUNCHES == 1
    a.ph_lo = 0; a.ph_hi = NPHASE + 1; a.li = 0;
    hipLaunchKernelGGL(fwd_kernel, dim3(grid), dim3(NWAVES * 64), LDS_BYTES, stream, a);
#else
    for (int li = 0; li <= NPHASE; ++li) { a.ph_lo = li; a.ph_hi = li + 1; a.li = li;
        hipLaunchKernelGGL(fwd_kernel, dim3(grid), dim3(NWAVES * 64), LDS_BYTES, stream, a); }
#endif
    const hipError_t le = hipPeekAtLastError();
    if (le != hipSuccess) fprintf(stderr, "kernel_launch: launch failed: %s\n", hipGetErrorName(le));
}
```
